# Optimizing an MI355X kernel written in HIP

```python
import math
import jax
import jax.numpy as jnp
from jax import lax
import numpy as np

D_MODEL = 2048
BATCH = 4
SEQ = 2048
DEPTH = 1

D_MIX = D_MODEL
NORM_EPS = 1e-6
ATT_HEADS = 8
ATT_QK_DIM = 64
ATT_V_DIM = 2 * ATT_QK_DIM
ATT_WIDTH = ATT_HEADS * ATT_V_DIM
ATT_QK_COLS = ATT_HEADS * 2 * ATT_QK_DIM
ATT_COLS = 2 * ATT_QK_COLS + ATT_WIDTH
ROPE_THETA = 500000.0
ROPE_DIM = ATT_QK_DIM // 4
Q_BLOCK = 128
SUBLN_EPS = 1e-5
RWKV_WIDTH = D_MIX - ATT_WIDTH
RWKV_HEAD = 64
RWKV_HEADS = RWKV_WIDTH // RWKV_HEAD
DECAY_LORA = 64
ICLR_LORA = 64
GATE_LORA = 160
GN_EPS = 64e-5
SHIFT_WIDTH = 3 * RWKV_WIDTH + DECAY_LORA + ICLR_LORA + GATE_LORA
SHIFT_SPLITS = [RWKV_WIDTH, 2 * RWKV_WIDTH, 3 * RWKV_WIDTH,
                3 * RWKV_WIDTH + DECAY_LORA, 3 * RWKV_WIDTH + DECAY_LORA + ICLR_LORA]
IN_COLS = ATT_COLS + SHIFT_WIDTH
N_DIRS = 2
N_EXPERTS = 16
CAPACITY_FACTOR = 2
EXPERT_FF = 2048

kernel_name = 'hybrid_diffattn_rwkv7_ecmoe'


def rms_norm(x, w, eps=NORM_EPS):
    xf = x.astype(jnp.float32)
    y = xf * lax.rsqrt(jnp.mean(xf * xf, axis=-1, keepdims=True) + eps)
    return (y * w.astype(jnp.float32)).astype(x.dtype)


def partial_rope(x, cos, sin):
    xf = x.astype(jnp.float32)
    half = ROPE_DIM // 2
    x1 = xf[..., :half]
    x2 = xf[..., half:ROPE_DIM]
    out = jnp.concatenate([x1 * cos - x2 * sin, x2 * cos + x1 * sin, xf[..., ROPE_DIM:]], axis=-1)
    return out.astype(x.dtype)


def diff_attention(q, k, v, positions, lq1, lk1, lq2, lk2, subln_w, lambda_init):
    bsz, seq = q.shape[0], q.shape[1]
    inv_freq = ROPE_THETA ** (-jnp.arange(0, ROPE_DIM, 2, dtype=jnp.float32) / ROPE_DIM)
    ang = positions.astype(jnp.float32)[..., None] * inv_freq
    cos = jnp.cos(ang)[:, :, None, None, :]
    sin = jnp.sin(ang)[:, :, None, None, :]
    q = partial_rope(q, cos, sin) * (ATT_QK_DIM ** -0.5)
    k = partial_rope(k, cos, sin)
    f32 = jnp.float32
    lam = (jnp.exp(jnp.sum(lq1.astype(f32) * lk1.astype(f32)))
           - jnp.exp(jnp.sum(lq2.astype(f32) * lk2.astype(f32))) + lambda_init)
    n_blocks = seq // Q_BLOCK
    q_blocks = jnp.moveaxis(q.reshape(bsz, n_blocks, Q_BLOCK, ATT_HEADS, 2, ATT_QK_DIM), 1, 0)

    def block(qb):
        s = jnp.einsum('bqhcd,bkhcd->bhcqk', qb, k).astype(f32)
        p = jax.nn.softmax(s, axis=-1)
        wgt = p[:, :, 0] - lam * p[:, :, 1]
        return jnp.einsum('bhqk,bkhe->bqhe', wgt.astype(v.dtype), v)

    o = lax.map(block, q_blocks)
    o = jnp.moveaxis(o, 0, 1).reshape(bsz, seq, ATT_HEADS, ATT_V_DIM)
    o = rms_norm(o, subln_w, eps=SUBLN_EPS) * (1.0 - lambda_init)
    return o.reshape(bsz, seq, ATT_WIDTH)


def _tm_shared(t):
    s = jnp.stack([t, jnp.flip(t, axis=1)], axis=0)
    return jnp.moveaxis(s, 2, 0).astype(jnp.float32)


def _tm_dir(t):
    s = jnp.stack([t[0], jnp.flip(t[1], axis=1)], axis=0)
    return jnp.moveaxis(s, 2, 0).astype(jnp.float32)


def _rwkv_step(state, inp):
    r_t, w_t, k_t, v_t, a_t, b_t = inp
    sa = jnp.einsum('dbhvk,dbhk->dbhv', state, a_t)
    state = state * w_t[..., None, :] + sa[..., None] * b_t[..., None, :] + v_t[..., None] * k_t[..., None, :]
    y = jnp.einsum('dbhvk,dbhk->dbhv', state, r_t)
    return state, y


def rwkv7_bidir(z, w0, decay_up, a0, iclr_up, gate_up, k_k, k_a, r_k, ln_x_w, ln_x_b):
    f32 = jnp.float32
    bsz, seq = z.shape[0], z.shape[1]
    r, k, v, wd, ad, gd = jnp.split(z, SHIFT_SPLITS, axis=-1)
    w_log = -jax.nn.softplus(-(w0.astype(f32)[:, None, None, :]
                               + jnp.einsum('btr,drc->dbtc', jnp.tanh(wd), decay_up).astype(f32))) - 0.5
    decay = jnp.exp(-jnp.exp(w_log))
    a = jax.nn.sigmoid(a0.astype(f32)[:, None, None, :]
                       + jnp.einsum('btr,drc->dbtc', ad, iclr_up).astype(f32))
    g = (jax.nn.sigmoid(gd) @ gate_up).astype(f32)

    def heads(t):
        return t.reshape(t.shape[:-1] + (RWKV_HEADS, RWKV_HEAD))

    kk = heads((k * k_k).astype(f32))
    kk = kk / jnp.maximum(jnp.sqrt(jnp.sum(kk * kk, axis=-1, keepdims=True)), 1e-12)
    k_dir = heads(k.astype(f32)[None] * (1.0 + (a - 1.0) * k_a.astype(f32)))
    r_h = heads(r.astype(f32))
    v_h = heads(v.astype(f32))
    a_h = heads(a)
    xs = (_tm_shared(r_h), _tm_dir(heads(decay)), _tm_dir(k_dir), _tm_shared(v_h),
          _tm_shared(-kk), _tm_dir(kk[None] * a_h))
    state0 = jnp.zeros((N_DIRS, bsz, RWKV_HEADS, RWKV_HEAD, RWKV_HEAD), f32)
    _, ys = lax.scan(_rwkv_step, state0, xs)
    ys = jnp.moveaxis(ys, 0, 2)
    y = ys[0] + jnp.flip(ys[1], axis=1)
    mu = jnp.mean(y, axis=-1, keepdims=True)
    var = jnp.mean(jnp.square(y - mu), axis=-1, keepdims=True)
    y = ((y - mu) * lax.rsqrt(var + GN_EPS)).reshape(bsz, seq, RWKV_WIDTH)
    y = y * ln_x_w.astype(f32) + ln_x_b.astype(f32)
    bonus = jnp.sum(jnp.sum(r_h[None] * k_dir * r_k.astype(f32), axis=-1, keepdims=True), axis=0) * v_h
    out = (y + bonus.reshape(bsz, seq, RWKV_WIDTH)) * g
    return out.astype(z.dtype)


def expert_choice_moe(h, w_router, e_gate, e_up, e_down):
    bsz, seq, d = h.shape
    cap = CAPACITY_FACTOR * seq // N_EXPERTS
    aff = jax.nn.softmax((h @ w_router).astype(jnp.float32), axis=-1)
    gates, idx = lax.top_k(jnp.swapaxes(aff, 1, 2), cap)
    flat_idx = idx.reshape(bsz, N_EXPERTS * cap)
    xe = jnp.take_along_axis(h, flat_idx[..., None], axis=1).reshape(bsz, N_EXPERTS, cap, d)
    hid = jax.nn.silu(jnp.einsum('becd,edf->becf', xe, e_gate)) * jnp.einsum('becd,edf->becf', xe, e_up)
    ye = jnp.einsum('becf,efd->becd', hid, e_down) * gates[..., None].astype(h.dtype)
    seg = (jnp.arange(bsz, dtype=jnp.int32)[:, None] * seq + flat_idx).reshape(-1)
    out = jax.ops.segment_sum(ye.reshape(-1, d), seg, num_segments=bsz * seq)
    return out.reshape(bsz, seq, d)


def setup_inputs(seed: int = 0) -> dict:
    key = jax.random.key(seed)
    ks = jax.random.split(key, 32)
    f32 = jnp.float32
    L = DEPTH

    def nrm(k, shape, scale):
        return jax.random.normal(k, shape, f32) * scale

    def gain(k, shape):
        return 1.0 + 0.02 * jax.random.normal(k, shape, f32)

    return {
        'x': jax.random.normal(ks[0], (BATCH, SEQ, D_MODEL), f32),
        'positions': jnp.broadcast_to(jnp.arange(SEQ, dtype=jnp.int32), (BATCH, SEQ)),
        'norm1_w': gain(ks[1], (L, D_MODEL)),
        'w_in': nrm(ks[2], (L, D_MODEL, IN_COLS), D_MODEL ** -0.5),
        'mu_prev': jax.random.uniform(ks[3], (L, SHIFT_WIDTH), f32, 0.0, 0.5),
        'mu_next': jax.random.uniform(ks[4], (L, SHIFT_WIDTH), f32, 0.0, 0.5),
        'lambda_q1': nrm(ks[5], (L, ATT_QK_DIM), 0.1),
        'lambda_k1': nrm(ks[6], (L, ATT_QK_DIM), 0.1),
        'lambda_q2': nrm(ks[7], (L, ATT_QK_DIM), 0.1),
        'lambda_k2': nrm(ks[8], (L, ATT_QK_DIM), 0.1),
        'subln_w': gain(ks[9], (L, ATT_V_DIM)),
        'w0': jax.random.uniform(ks[10], (L, N_DIRS, RWKV_WIDTH), f32, -6.0, -1.0),
        'decay_up': nrm(ks[11], (L, N_DIRS, DECAY_LORA, RWKV_WIDTH), 0.1),
        'a0': nrm(ks[12], (L, N_DIRS, RWKV_WIDTH), 0.5),
        'iclr_up': nrm(ks[13], (L, N_DIRS, ICLR_LORA, RWKV_WIDTH), ICLR_LORA ** -0.5),
        'gate_up': nrm(ks[14], (L, GATE_LORA, RWKV_WIDTH), GATE_LORA ** -0.5),
        'k_k': 0.85 + 0.05 * jax.random.normal(ks[15], (L, RWKV_WIDTH), f32),
        'k_a': 1.0 + 0.05 * jax.random.normal(ks[16], (L, RWKV_WIDTH), f32),
        'r_k': nrm(ks[17], (L, RWKV_HEADS, RWKV_HEAD), 0.1),
        'ln_x_w': gain(ks[18], (L, RWKV_WIDTH)),
        'ln_x_b': nrm(ks[19], (L, RWKV_WIDTH), 0.02),
        'w_out': nrm(ks[20], (L, D_MIX, D_MODEL), D_MIX ** -0.5),
        'norm2_w': gain(ks[21], (L, D_MODEL)),
        'w_router': nrm(ks[22], (L, D_MODEL, N_EXPERTS), D_MODEL ** -0.5),
        'e_gate': nrm(ks[23], (L, N_EXPERTS, D_MODEL, EXPERT_FF), D_MODEL ** -0.5),
        'e_up': nrm(ks[24], (L, N_EXPERTS, D_MODEL, EXPERT_FF), D_MODEL ** -0.5),
        'e_down': nrm(ks[25], (L, N_EXPERTS, EXPERT_FF, D_MODEL), EXPERT_FF ** -0.5),
        'norm_f_w': gain(ks[26], (D_MODEL,)),
    }


def reference(x, positions, norm1_w, w_in, mu_prev, mu_next, lambda_q1, lambda_k1, lambda_q2,
              lambda_k2, subln_w, w0, decay_up, a0, iclr_up, gate_up, k_k, k_a, r_k, ln_x_w,
              ln_x_b, w_out, norm2_w, w_router, e_gate, e_up, e_down, norm_f_w):
    bsz, seq, _ = x.shape
    for l in range(DEPTH):
        lambda_init = 0.8 - 0.6 * math.exp(-0.3 * l)
        h = rms_norm(x, norm1_w[l])
        proj = h @ w_in[l]
        q = proj[..., :ATT_QK_COLS].reshape(bsz, seq, ATT_HEADS, 2, ATT_QK_DIM)
        k = proj[..., ATT_QK_COLS:2 * ATT_QK_COLS].reshape(bsz, seq, ATT_HEADS, 2, ATT_QK_DIM)
        v = proj[..., 2 * ATT_QK_COLS:ATT_COLS].reshape(bsz, seq, ATT_HEADS, ATT_V_DIM)
        att = diff_attention(q, k, v, positions, lambda_q1[l], lambda_k1[l], lambda_q2[l],
                             lambda_k2[l], subln_w[l], lambda_init)
        z = proj[..., ATT_COLS:]
        z_prev = jnp.pad(z[:, :-1], ((0, 0), (1, 0), (0, 0)))
        z_next = jnp.pad(z[:, 1:], ((0, 0), (0, 1), (0, 0)))
        z = z + mu_prev[l] * (z_prev - z) + mu_next[l] * (z_next - z)
        rw = rwkv7_bidir(z, w0[l], decay_up[l], a0[l], iclr_up[l], gate_up[l], k_k[l], k_a[l],
                         r_k[l], ln_x_w[l], ln_x_b[l])
        x = x + jnp.concatenate([att, rw], axis=-1) @ w_out[l]
        x = x + expert_choice_moe(rms_norm(x, norm2_w[l]), w_router[l], e_gate[l], e_up[l], e_down[l])
    return rms_norm(x, norm_f_w)
```

```cpp
#include <hip/hip_runtime.h>
#include <hip/hip_bf16.h>
#include <cstdio>
#include <cstdint>

#ifndef MK_N_LAUNCHES
#define MK_N_LAUNCHES 12
#endif
constexpr int N_PHASES = 12;

constexpr int BATCH = 4, SEQ = 2048, DM = 2048, MTOK = BATCH * SEQ;
constexpr int IN_COLS = 6432, LDP = 6656;
constexpr int ZC0 = 3072;
constexpr int RW = 1024, NH_R = 16, HD_R = 64;
constexpr int NEXP = 16, CAP = 256, FF = 2048;
constexpr float QSCALE = 0.18033688011112042f;

constexpr size_t MiB = 1u << 20;
constexpr size_t WS_CTL = 0, CTL_ZERO_BYTES = 1 * MiB;
constexpr size_t WS_ROPE = 1 * MiB;
constexpr size_t WS_AFF = 3 * MiB;
constexpr size_t WS_GATEX = 3 * MiB + 512 * 1024;
constexpr size_t WS_SLOT = 4 * MiB;
constexpr size_t WS_BONUS = 5 * MiB;
constexpr size_t WS_WIN = 8 * MiB;
constexpr size_t WS_WOUT = 34 * MiB;
constexpr size_t WS_WGU = 48 * MiB;
constexpr size_t WS_WD = 304 * MiB;
constexpr size_t WS_H1 = 432 * MiB;
constexpr size_t WS_PROJ = 464 * MiB;
constexpr size_t WS_R = 568 * MiB, WS_KK = 584 * MiB, WS_V = 600 * MiB;
constexpr size_t WS_WDEC = 616 * MiB;
constexpr size_t WS_KD = 680 * MiB, WS_BB = 712 * MiB;
constexpr size_t WS_G = 744 * MiB;
constexpr size_t WS_OC = 760 * MiB;
constexpr size_t WS_YS = 792 * MiB;
constexpr size_t WS_MIX = 856 * MiB;
constexpr size_t WS_X1 = 888 * MiB;
constexpr size_t WS_H2 = 952 * MiB;
constexpr size_t WS_XE = 464 * MiB, WS_HID = 528 * MiB, WS_YE = 592 * MiB;
constexpr size_t WS_END = 984 * MiB;
constexpr int CW_BAR = 4096;

constexpr int LDS_BYTES = 147456;
constexpr int MISC_OFF = 131072 + 320;

#define GAS __attribute__((address_space(1)))
#define LAS __attribute__((address_space(3)))
typedef unsigned short bf16_t;
typedef float f32x4 __attribute__((ext_vector_type(4)));
typedef float f32x2 __attribute__((ext_vector_type(2)));
typedef float f32x16 __attribute__((ext_vector_type(16)));
typedef unsigned u32x4 __attribute__((ext_vector_type(4)));
typedef unsigned u32x2 __attribute__((ext_vector_type(2)));
typedef short bf16x8 __attribute__((ext_vector_type(8)));
typedef short s16x4 __attribute__((ext_vector_type(4)));
typedef __bf16 bf16x2_t __attribute__((ext_vector_type(2)));

__device__ __forceinline__ unsigned cvtpk(float lo, float hi) { f32x2 v = {lo, hi}; bf16x2_t b = __builtin_convertvector(v, bf16x2_t); return __builtin_bit_cast(unsigned, b); }
__device__ __forceinline__ float bf_lo(unsigned w) { return __uint_as_float(w << 16); }
__device__ __forceinline__ float bf_hi(unsigned w) { return __uint_as_float(w & 0xffff0000u); }
__device__ __forceinline__ float bf2f(bf16_t v) { return __uint_as_float((unsigned)v << 16); }
__device__ __forceinline__ float wave_sum(float v) {
#pragma unroll
    for (int o = 1; o < 64; o <<= 1) v += __shfl_xor(v, o);
    return v;
}
__device__ __forceinline__ float sigmoidf_(float x) { return 1.f / (1.f + __expf(-x)); }

struct Args { const void* in[28]; float* out; unsigned char* ws; int ph_lo, ph_hi, li, pad; };

namespace pg8 {
#define PG8_LAS __attribute__((address_space(3)))
typedef unsigned short bf16_t;
typedef short bf16x8 __attribute__((ext_vector_type(8)));
typedef float f32x4 __attribute__((ext_vector_type(4)));
typedef unsigned u32x4 __attribute__((ext_vector_type(4)));
constexpr int BM = 256, BK = 64, HALF = 128, HTB = HALF * BK * 2  , STAGE_BYTES = 8 * HTB, NXCD = 8, WGM = 8;

__host__ __device__ __forceinline__ int lds_byte(int r, int c) { const int st = (r >> 4) * 2 + (c >> 5), rr = r & 15, cc = c & 31, ob = rr * 64 + cc * 2; return st * 1024 + (ob ^ (((ob >> 9) & 1) << 5)); }
__host__ __device__ __forceinline__ void stage_rc(int b, int& R, int& C) { const int st = b / 1024, sb = b % 1024, swz = sb ^ (((sb >> 9) & 1) << 5); R = (st >> 1) * 16 + swz / 64; C = (st & 1) * 32 + (swz % 64) / 2; }
__host__ __device__ __forceinline__ int perm32(int rho) { const int n = rho >> 4, i = rho & 15; return 8 * (i >> 2) + 4 * n + (i & 3); }

struct Unit { int pm, pn; };
struct Gemm { const bf16_t* A; const bf16_t* Bt; int M, N, K; };

struct StaticOrder {
    int nM, nN, nwg, G, c;
    __host__ __device__ void init(int M, int N, int G_, int c_) { nM = M / BM; nN = N / BM; nwg = nM * nN; G = G_; c = c_; }
    __host__ __device__ bool next(int i, Unit& u) const {
        const long L = (long)i * G + c; if (L >= nwg) return false;
        int wgid = (int)L; { const int q = nwg / NXCD, r = nwg % NXCD, xcd = wgid % NXCD, off = wgid / NXCD; wgid = (xcd < r ? xcd * (q + 1) : r * (q + 1) + (xcd - r) * q) + off; }
        const int nig = WGM * nN, gid = wgid / nig, fm = gid * WGM, gsz = (nM - fm) < WGM ? (nM - fm) : WGM;
        u.pm = fm + ((wgid % nig) % gsz); u.pn = (wgid % nig) / gsz; return true;
    }
    __device__ __forceinline__ void a_ready(const Unit&) const {}
    __device__ __forceinline__ void done(const Unit&) const {}
};


typedef float f32x2 __attribute__((ext_vector_type(2)));
typedef __bf16 bf16x2_t __attribute__((ext_vector_type(2)));
__device__ __forceinline__ unsigned cvt_pk_bf16(float lo, float hi) { f32x2 v = {lo, hi}; bf16x2_t b = __builtin_convertvector(v, bf16x2_t); return __builtin_bit_cast(unsigned, b); }

struct MoeOrder {
    int G, vcu, npn, total;
    __device__ bool next(int i, Unit& u) const {
        const int L = i * G + vcu; if (L >= total) return false;
        const int per_e = 4 * npn, e = L / per_e, r = L % per_e;
        u.pm = e * 4 + (r & 3); u.pn = e * npn + (r >> 2); return true;
    }
    __device__ __forceinline__ void a_ready(const Unit&) const {}
    __device__ __forceinline__ void done(const Unit&) const {}
};

struct EpiProj {
    static constexpr bool PERM = true, AFTER_DRAIN = false;
    bf16_t* P; int ldp; const float* rope; float qscale;
    __device__ __forceinline__ void operator()(const f32x4 (&acc)[2][2][4][2], const Unit& u, int wr, int wc, int fr, int fq) const {
        const int row0 = u.pm * BM + wr * 64 + fr, colt = u.pn * BM, col0 = colt + wc * 32 + 8 * fq;
        const bool ropew = (colt < 2048) && ((wc & 1) == 0);
        const float sc = (colt < 1024) ? qscale : 1.f, sgn = (fq == 0) ? -1.f : 1.f;
#pragma unroll
        for (int ai = 0; ai < 2; ++ai)
#pragma unroll
            for (int m = 0; m < 4; ++m) {
                const int row = row0 + ai * HALF + m * 16;
                f32x4 c0 = {1.f, 1.f, 1.f, 1.f}, c1 = c0, s0 = {0.f, 0.f, 0.f, 0.f}, s1 = s0;
                if (ropew) { const f32x4* rp = (const f32x4*)(rope + (size_t)row * 16); c0 = rp[0]; c1 = rp[1]; s0 = rp[2]; s1 = rp[3]; }
                bf16_t* rowp = P + (size_t)row * ldp + col0;
#pragma unroll
                for (int bj = 0; bj < 2; ++bj) {
                    f32x4 v0 = acc[ai][bj][m][0], v1 = acc[ai][bj][m][1];
                    if (ropew) {
                        f32x4 p0, p1;
#pragma unroll
                        for (int i = 0; i < 4; ++i) { p0[i] = __shfl_xor(v0[i], 16); p1[i] = __shfl_xor(v1[i], 16); }
                        if (fq < 2) { v0 = v0 * c0 + (p0 * s0) * sgn; v1 = v1 * c1 + (p1 * s1) * sgn; }
                    }
                    v0 = v0 * sc; v1 = v1 * sc;
                    u32x4 w; w.x = cvt_pk_bf16(v0[0], v0[1]); w.y = cvt_pk_bf16(v0[2], v0[3]); w.z = cvt_pk_bf16(v1[0], v1[1]); w.w = cvt_pk_bf16(v1[2], v1[3]);
                    *(u32x4*)(rowp + bj * HALF) = w;
                }
            }
    }
};

struct EpiResid {
    static constexpr bool PERM = false, AFTER_DRAIN = false;
    const float* base; float* out; int ldc;
    __device__ __forceinline__ void operator()(const f32x4 (&acc)[2][2][4][2], const Unit& u, int wr, int wc, int fr, int fq) const {
        const int row0 = u.pm * BM + wr * 64 + fr, col0 = u.pn * BM + wc * 32 + 4 * fq;
#pragma unroll
        for (int ai = 0; ai < 2; ++ai)
#pragma unroll
            for (int m = 0; m < 4; ++m) {
                const size_t off = (size_t)(row0 + ai * HALF + m * 16) * ldc + col0;
#pragma unroll
                for (int bj = 0; bj < 2; ++bj)
#pragma unroll
                    for (int n = 0; n < 2; ++n) { const f32x4 bs = *(const f32x4*)(base + off + bj * HALF + n * 16); *(f32x4*)(out + off + bj * HALF + n * 16) = bs + acc[ai][bj][m][n]; }
            }
    }
};

struct EpiSwiglu {
    static constexpr bool PERM = true, AFTER_DRAIN = false;
    bf16_t* H; int npn;
    __device__ __forceinline__ void operator()(const f32x4 (&acc)[2][2][4][2], const Unit& u, int wr, int wc, int fr, int fq) const {
        const int row0 = u.pm * BM + wr * 64 + fr, pnl = u.pn % npn, col0 = pnl * HALF + wc * 32 + 8 * fq;
#pragma unroll
        for (int ai = 0; ai < 2; ++ai)
#pragma unroll
            for (int m = 0; m < 4; ++m) {
                bf16_t* rowp = H + (size_t)(row0 + ai * HALF + m * 16) * 2048 + col0;
                float h[8];
#pragma unroll
                for (int n = 0; n < 2; ++n)
#pragma unroll
                    for (int i = 0; i < 4; ++i) { const float g = acc[ai][0][m][n][i], up = acc[ai][1][m][n][i]; h[n * 4 + i] = g * up * __builtin_amdgcn_rcpf(1.f + __expf(-g)); }
                u32x4 w; w.x = cvt_pk_bf16(h[0], h[1]); w.y = cvt_pk_bf16(h[2], h[3]); w.z = cvt_pk_bf16(h[4], h[5]); w.w = cvt_pk_bf16(h[6], h[7]);
                *(u32x4*)rowp = w;
            }
    }
};

struct EpiDown {
    static constexpr bool PERM = true, AFTER_DRAIN = false;
    bf16_t* Y; const float* gate; int npn;
    __device__ __forceinline__ void operator()(const f32x4 (&acc)[2][2][4][2], const Unit& u, int wr, int wc, int fr, int fq) const {
        const int row0 = u.pm * BM + wr * 64 + fr, pnl = u.pn % npn, col0 = pnl * BM + wc * 32 + 8 * fq;
#pragma unroll
        for (int ai = 0; ai < 2; ++ai)
#pragma unroll
            for (int m = 0; m < 4; ++m) {
                const int row = row0 + ai * HALF + m * 16; const float gt = gate[row];
                bf16_t* rowp = Y + (size_t)row * 2048 + col0;
#pragma unroll
                for (int bj = 0; bj < 2; ++bj) { const f32x4 v0 = acc[ai][bj][m][0] * gt, v1 = acc[ai][bj][m][1] * gt;
                    u32x4 w; w.x = cvt_pk_bf16(v0[0], v0[1]); w.y = cvt_pk_bf16(v0[2], v0[3]); w.z = cvt_pk_bf16(v1[0], v1[1]); w.w = cvt_pk_bf16(v1[2], v1[3]);
                    *(u32x4*)(rowp + bj * HALF) = w; }
            }
    }
};

template <class Epi, class Sched, bool ALIGN_EPI = false, bool SP2 = false>
__device__ __forceinline__ void gemm_phase(PG8_LAS unsigned char* lds, const Gemm g, const Sched& S, const Epi& E) {
    const int tid = threadIdx.x, wid = __builtin_amdgcn_readfirstlane(tid >> 6), lane = tid & 63, wr = wid >> 2, wc = wid & 3, fr = lane & 15, fq = lane >> 4;
    const int K = g.K, nt = K / BK;
    unsigned voffA[2], voffB[2];
#pragma unroll
    for (int i = 0; i < 2; ++i) { int R, C; stage_rc(tid * 16 + i * 8192, R, C); const int Rb = Epi::PERM ? ((R & ~31) + perm32(R & 31)) : R;
        voffA[i] = (unsigned)(R * K + C) * 2u; voffB[i] = (unsigned)(Rb * K + C) * 2u; }
    const size_t kstep = (size_t)(BK * 2);
    const size_t hstep = (size_t)HALF * K * 2;
    const size_t tstep = 2 * hstep;
    const unsigned ldsw = (unsigned)wid * 1024u;
    const int aoff = lds_byte(wr * 64 + fr, fq * 8), boff = lds_byte(wc * 32 + fr, fq * 8);
#define PG8_SA(b, h) (((b) * 2 + (h)) * HTB)
#define PG8_SB(b, h) ((4 + (b) * 2 + (h)) * HTB)
#define PG8_STAGE(bufoff, gbase, voff) do { _Pragma("unroll") for (int _i = 0; _i < 2; ++_i) \
        __builtin_amdgcn_global_load_lds((const unsigned*)((const char*)(gbase) + (voff)[_i]), (PG8_LAS unsigned*)(lds + (bufoff) + ldsw + _i * 8192), 16, 0, 0); } while (0)
#define PG8_LDA(dst, b, h) do { _Pragma("unroll") for (int m = 0; m < 4; ++m) _Pragma("unroll") for (int k = 0; k < 2; ++k) dst[m][k] = *(const PG8_LAS bf16x8*)(lds + PG8_SA(b, h) + aoff + m * 2048 + k * 1024); } while (0)
#define PG8_LDB(dst, b, h) do { _Pragma("unroll") for (int n = 0; n < 2; ++n) _Pragma("unroll") for (int k = 0; k < 2; ++k) dst[n][k] = *(const PG8_LAS bf16x8*)(lds + PG8_SB(b, h) + boff + n * 2048 + k * 1024); } while (0)
#define PG8_MMA(ai, bj, At, Bt) do { __builtin_amdgcn_s_setprio(1); _Pragma("unroll") for (int m = 0; m < 4; ++m) _Pragma("unroll") for (int n = 0; n < 2; ++n) _Pragma("unroll") for (int k = 0; k < 2; ++k) \
        acc[ai][bj][m][n] = __builtin_amdgcn_mfma_f32_16x16x32_bf16(Bt[n][k], At[m][k], acc[ai][bj][m][n], 0, 0, 0); __builtin_amdgcn_s_setprio(0); } while (0)
#define PG8_WAIT_V(n) asm volatile("s_waitcnt vmcnt(" #n ")" ::: "memory")
#define PG8_WAIT_L(n) asm volatile("s_waitcnt lgkmcnt(" #n ")" ::: "memory")
#define PG8_BAR __builtin_amdgcn_s_barrier()
#define PG8_SCHED __builtin_amdgcn_sched_barrier(0)
    Unit cur, nxt; int ui = 0;
    if (!S.next(0, cur)) return;
    f32x4 acc[2][2][4][2];
#pragma unroll
    for (int a = 0; a < 2; ++a)
#pragma unroll
        for (int b = 0; b < 2; ++b)
#pragma unroll
            for (int m = 0; m < 4; ++m)
#pragma unroll
                for (int n = 0; n < 2; ++n) acc[a][b][m][n] = (f32x4){0.f, 0.f, 0.f, 0.f};
    bf16x8 At[4][2], B0[2][2], B1[2][2];
    const char* cA = (const char*)g.A + (size_t)cur.pm * tstep; const char* cB = (const char*)g.Bt + (size_t)cur.pn * tstep;
    S.a_ready(cur);
    if constexpr (SP2) {
        PG8_STAGE(PG8_SB(0, 0), cB, voffB); PG8_STAGE(PG8_SB(0, 1), cB + hstep, voffB); PG8_STAGE(PG8_SA(0, 0), cA, voffA); PG8_STAGE(PG8_SA(0, 1), cA + hstep, voffA);
        if (wr == 1) PG8_BAR;
        PG8_WAIT_V(2); PG8_BAR;
        PG8_STAGE(PG8_SB(1, 0), cB + kstep, voffB); PG8_STAGE(PG8_SA(1, 0), cA + kstep, voffA); PG8_STAGE(PG8_SB(1, 1), cB + hstep + kstep, voffB);
        PG8_WAIT_V(6); PG8_BAR;
    } else {
        PG8_STAGE(PG8_SB(0, 0), cB, voffB); PG8_STAGE(PG8_SA(0, 0), cA, voffA); PG8_STAGE(PG8_SB(0, 1), cB + hstep, voffB); PG8_STAGE(PG8_SA(0, 1), cA + hstep, voffA);
        if (wr == 1) PG8_BAR;
        PG8_WAIT_V(4); PG8_BAR;
        PG8_STAGE(PG8_SB(1, 0), cB + kstep, voffB); PG8_STAGE(PG8_SA(1, 0), cA + kstep, voffA); PG8_STAGE(PG8_SB(1, 1), cB + hstep + kstep, voffB);
        PG8_WAIT_V(6); PG8_BAR;
    }
    for (;;) {
        const bool has_next = S.next(ui + 1, nxt);
        const char* nA = has_next ? (const char*)g.A + (size_t)nxt.pm * tstep : cA; const char* nB = has_next ? (const char*)g.Bt + (size_t)nxt.pn * tstep : cB;
        for (int t = 0; t < nt; t += 2) {
            const bool last = (t == nt - 2);
            const char* a1 = cA + (size_t)(t + 1) * kstep;
            const char* a2 = last ? nA : cA + (size_t)(t + 2) * kstep; const char* b2 = last ? nB : cB + (size_t)(t + 2) * kstep;
            const char* a3 = a2 + kstep; const char* b3 = b2 + kstep;
            if (last && has_next) S.a_ready(nxt);
            if constexpr (SP2) {
            PG8_LDB(B0, 0, 0); PG8_LDB(B1, 0, 1); PG8_SCHED; PG8_LDA(At, 0, 0); PG8_STAGE(PG8_SA(1, 1), a1 + hstep, voffA);
            PG8_WAIT_V(8); PG8_WAIT_L(0); PG8_BAR; PG8_MMA(0, 0, At, B0); PG8_MMA(0, 1, At, B1); PG8_BAR; PG8_SCHED;
            PG8_LDA(At, 0, 1); PG8_STAGE(PG8_SB(0, 0), b2, voffB); PG8_STAGE(PG8_SB(0, 1), b2 + hstep, voffB); PG8_STAGE(PG8_SA(0, 0), a2, voffA);
            PG8_WAIT_V(8); PG8_WAIT_L(0); PG8_BAR; PG8_MMA(1, 0, At, B0); PG8_MMA(1, 1, At, B1); PG8_BAR; PG8_SCHED;
            PG8_LDB(B0, 1, 0); PG8_LDB(B1, 1, 1); PG8_SCHED; PG8_LDA(At, 1, 0); PG8_STAGE(PG8_SA(0, 1), a2 + hstep, voffA);
            PG8_WAIT_V(8); PG8_WAIT_L(0); PG8_BAR; PG8_MMA(0, 0, At, B0); PG8_MMA(0, 1, At, B1); PG8_BAR; PG8_SCHED;
            PG8_LDA(At, 1, 1); PG8_STAGE(PG8_SB(1, 0), b3, voffB); PG8_STAGE(PG8_SB(1, 1), b3 + hstep, voffB); PG8_STAGE(PG8_SA(1, 0), a3, voffA);
            PG8_WAIT_V(8); PG8_WAIT_L(0); PG8_BAR; PG8_MMA(1, 0, At, B0); PG8_MMA(1, 1, At, B1); PG8_BAR; PG8_SCHED;
            } else {
            PG8_LDB(B0, 0, 0); PG8_SCHED; PG8_LDA(At, 0, 0); PG8_STAGE(PG8_SA(1, 1), a1 + hstep, voffA);
            PG8_WAIT_L(8); PG8_BAR; PG8_WAIT_L(0); PG8_MMA(0, 0, At, B0); PG8_BAR; PG8_SCHED;
            PG8_LDB(B1, 0, 1); PG8_STAGE(PG8_SB(0, 0), b2, voffB);
            PG8_BAR; PG8_WAIT_L(0); PG8_MMA(0, 1, At, B1); PG8_BAR;
            PG8_LDA(At, 0, 1); PG8_STAGE(PG8_SA(0, 0), a2, voffA);
            PG8_BAR; PG8_WAIT_L(0); PG8_MMA(1, 0, At, B0); PG8_BAR; PG8_SCHED;
            PG8_STAGE(PG8_SB(0, 1), b2 + hstep, voffB);
            PG8_WAIT_V(6); PG8_BAR; PG8_MMA(1, 1, At, B1); PG8_BAR;
            PG8_LDB(B0, 1, 0); PG8_SCHED; PG8_LDA(At, 1, 0); PG8_STAGE(PG8_SA(0, 1), a2 + hstep, voffA);
            PG8_WAIT_L(8); PG8_BAR; PG8_WAIT_L(0); PG8_MMA(0, 0, At, B0); PG8_BAR; PG8_SCHED;
            PG8_LDB(B1, 1, 1); PG8_STAGE(PG8_SB(1, 0), b3, voffB);
            PG8_BAR; PG8_WAIT_L(0); PG8_MMA(0, 1, At, B1); PG8_BAR;
            PG8_LDA(At, 1, 1); PG8_STAGE(PG8_SA(1, 0), a3, voffA);
            PG8_BAR; PG8_WAIT_L(0); PG8_MMA(1, 0, At, B0); PG8_BAR; PG8_SCHED;
            PG8_STAGE(PG8_SB(1, 1), b3 + hstep, voffB);
            PG8_WAIT_V(6); PG8_BAR; PG8_MMA(1, 1, At, B1); PG8_BAR;
            }
        }
        if constexpr (ALIGN_EPI) { if (wr == 0) PG8_BAR; }
        if constexpr (!Epi::AFTER_DRAIN) { E(acc, cur, wr, wc, fr, fq); S.done(cur); }
        if (!has_next) break;
#pragma unroll
        for (int a = 0; a < 2; ++a)
#pragma unroll
            for (int b = 0; b < 2; ++b)
#pragma unroll
                for (int m = 0; m < 4; ++m)
#pragma unroll
                    for (int n = 0; n < 2; ++n) acc[a][b][m][n] = (f32x4){0.f, 0.f, 0.f, 0.f};
        cur = nxt; cA = nA; cB = nB; ++ui;
        if constexpr (ALIGN_EPI) { if (wr == 1) PG8_BAR; }
    }
    PG8_WAIT_V(0);
    if constexpr (!ALIGN_EPI) { if (wr == 0) PG8_BAR; }
    PG8_BAR;
    if constexpr (Epi::AFTER_DRAIN) { E.fused(acc, cur, wr, wc, fr, fq, lds, wid, lane); S.done(cur); }
#undef PG8_SA
#undef PG8_SB
#undef PG8_STAGE
#undef PG8_LDA
#undef PG8_LDB
#undef PG8_MMA
#undef PG8_WAIT_V
#undef PG8_WAIT_L
#undef PG8_BAR
#undef PG8_SCHED
}
}

namespace att {
constexpr int NW = 8, QBLK = 32, KVBLK = 64;
constexpr float THR = 8.f;
constexpr int SHM_V = KVBLK * 128 * 2, SHM_K = KVBLK * 64 * 2;
constexpr int SHM_ATTN = 2 * SHM_V + 2 * SHM_K + NW * 64 * 4;
#define KSWZ64(row, colB) ((row) * 128 + ((colB) ^ ((((row) >> 1) & 7) << 4)))
#define SBAR() __builtin_amdgcn_sched_barrier(0)
__device__ __forceinline__ int crow(int r, int hi) { return (r & 3) + 8 * (r >> 2) + 4 * hi; }

__device__ __forceinline__ void partialSM(f32x16& p0, f32x16& p1, float& m_reg, float& mn, float& alpha) {
  float pmax = p0[0];
#pragma unroll
  for (int r = 1; r < 16; ++r) pmax = fmaxf(pmax, p0[r]);
#pragma unroll
  for (int r = 0; r < 16; ++r) pmax = fmaxf(pmax, p1[r]);
  { auto rr = __builtin_amdgcn_permlane32_swap(__float_as_uint(pmax), __float_as_uint(pmax), false, false);
    pmax = fmaxf(__uint_as_float(rr[0]), __uint_as_float(rr[1])); }
  if (__builtin_expect(__all(pmax - m_reg <= THR), 1)) { mn = m_reg; alpha = 1.f; }
  else { mn = fmaxf(m_reg, pmax); alpha = __builtin_amdgcn_exp2f(m_reg - mn); m_reg = mn; }
#pragma unroll
  for (int r = 0; r < 16; ++r) p0[r] = p0[r] - mn;
#pragma unroll
  for (int r = 0; r < 16; ++r) p1[r] = p1[r] - mn;
#pragma unroll
  for (int r = 0; r < 16; ++r) p0[r] = __builtin_amdgcn_exp2f(p0[r]);
}
__device__ __forceinline__ void finishSM(f32x16& p0, f32x16& p1, float alpha, float& l_reg, bf16x8& pa0, bf16x8& pa1, bf16x8& pa2, bf16x8& pa3) {
#pragma unroll
  for (int r = 0; r < 16; ++r) p1[r] = __builtin_amdgcn_exp2f(p1[r]);
  float ps = 0;
#pragma unroll
  for (int r = 0; r < 16; ++r) ps += p0[r];
#pragma unroll
  for (int r = 0; r < 16; ++r) ps += p1[r];
  { auto rr = __builtin_amdgcn_permlane32_swap(__float_as_uint(ps), __float_as_uint(ps), false, false);
    ps = __uint_as_float(rr[0]) + __uint_as_float(rr[1]); }
  l_reg = l_reg * alpha + ps;
#define PK4(P, BASE, OUT) do { unsigned a0 = cvtpk(P[BASE + 0], P[BASE + 1]), a1 = cvtpk(P[BASE + 2], P[BASE + 3]);   \
    unsigned b0 = cvtpk(P[BASE + 4], P[BASE + 5]), b1 = cvtpk(P[BASE + 6], P[BASE + 7]);                              \
    auto r0 = __builtin_amdgcn_permlane32_swap(a0, b0, false, false); auto r1 = __builtin_amdgcn_permlane32_swap(a1, b1, false, false); \
    u32x4 w = {r0[0], r1[0], r0[1], r1[1]}; OUT = __builtin_bit_cast(bf16x8, w); } while (0)
  PK4(p0, 0, pa0); PK4(p0, 8, pa1); PK4(p1, 0, pa2); PK4(p1, 8, pa3);
#undef PK4
}
__device__ __forceinline__ void qkt(f32x16& p0, f32x16& p1, const char* Ks, const bf16x8* qr, int r32, int hi) {
  p0 = f32x16{}; p1 = f32x16{};
#pragma unroll
  for (int d0 = 0; d0 < 4; ++d0) { const int cb = (d0 * 16 + hi * 8) * 2;
    bf16x8 b0 = *reinterpret_cast<const bf16x8*>(Ks + KSWZ64(r32, cb));
    bf16x8 b1 = *reinterpret_cast<const bf16x8*>(Ks + KSWZ64(32 + r32, cb));
    p0 = __builtin_amdgcn_mfma_f32_32x32x16_bf16(b0, qr[d0], p0, 0, 0, 0);
    p1 = __builtin_amdgcn_mfma_f32_32x32x16_bf16(b1, qr[d0], p1, 0, 0, 0); }
}
__device__ __forceinline__ int v_st(int k, int c) { const int kk = (k & ~0xC) | ((k & 4) << 1) | ((k & 8) >> 1); return ((kk >> 3) * 4 + (c >> 5)) * 512 + ((kk & 7) * 32 + (c & 31)) * 2; }
__device__ __forceinline__ int v_rd_base(int lane) { return ((lane & 3) << 3) | (((lane >> 2) & 3) << 6) | (((lane >> 4) & 1) << 5) | (((lane >> 5) & 1) << 8); }
constexpr int v_rd_off(int d0, int ks, int half) { return d0 * 512 + ks * 4096 + half * 2048; }
template <int OFF> __device__ __forceinline__ s16x4 tr_read(int vb) {
  s16x4 r; asm volatile("ds_read_b64_tr_b16 %0, %1 offset:%2" : "=&v"(r) : "v"(vb), "i"(OFF) : "memory"); return r;
}
template <int D0> __device__ __forceinline__ void pv_one(f32x16& od, int vb, bf16x8 pa0, bf16x8 pa1, bf16x8 pa2, bf16x8 pa3) {
  const s16x4 l0 = tr_read<v_rd_off(D0, 0, 0)>(vb), h0 = tr_read<v_rd_off(D0, 0, 1)>(vb), l1 = tr_read<v_rd_off(D0, 1, 0)>(vb), h1 = tr_read<v_rd_off(D0, 1, 1)>(vb);
  const s16x4 l2 = tr_read<v_rd_off(D0, 2, 0)>(vb), h2 = tr_read<v_rd_off(D0, 2, 1)>(vb), l3 = tr_read<v_rd_off(D0, 3, 0)>(vb), h3 = tr_read<v_rd_off(D0, 3, 1)>(vb);
  asm volatile("s_waitcnt lgkmcnt(0)" ::: "memory"); SBAR();
#define PK(L, H) (bf16x8){L[0], L[1], L[2], L[3], H[0], H[1], H[2], H[3]}
  od = __builtin_amdgcn_mfma_f32_32x32x16_bf16(pa0, PK(l0, h0), od, 0, 0, 0);
  od = __builtin_amdgcn_mfma_f32_32x32x16_bf16(pa1, PK(l1, h1), od, 0, 0, 0);
  od = __builtin_amdgcn_mfma_f32_32x32x16_bf16(pa2, PK(l2, h2), od, 0, 0, 0);
  od = __builtin_amdgcn_mfma_f32_32x32x16_bf16(pa3, PK(l3, h3), od, 0, 0, 0);
#undef PK
}
__device__ __forceinline__ void pv_d0(f32x16* o, int vb, bf16x8 pa0, bf16x8 pa1, bf16x8 pa2, bf16x8 pa3) {
  pv_one<0>(o[0], vb, pa0, pa1, pa2, pa3); pv_one<1>(o[1], vb, pa0, pa1, pa2, pa3); pv_one<2>(o[2], vb, pa0, pa1, pa2, pa3); pv_one<3>(o[3], vb, pa0, pa1, pa2, pa3);
}

template <int LDQ>
__device__ __forceinline__ void attn_unit(const bf16_t* __restrict__ Qb, const bf16_t* __restrict__ Kh, const bf16_t* __restrict__ Vh, bf16_t* __restrict__ Ob, int seq, char* lds) {
  const int tid = threadIdx.x, wid = tid >> 6, lane = tid & 63, r32 = lane & 31, hi = lane >> 5;
  char* V_lds = lds; char* K_lds = lds + 2 * SHM_V;
  float* ws = (float*)(lds + 2 * SHM_V + 2 * SHM_K) + wid * 64; float* li_l = ws; float* al_l = ws + 32;
  float m_reg = -1e30f, l_reg = 0; f32x16 o[4] = {}; bf16x8 qr[4];
  const bf16_t* Qw = Qb + (long)(wid * QBLK + r32) * LDQ + hi * 8;
#pragma unroll
  for (int d0 = 0; d0 < 4; ++d0) qr[d0] = *reinterpret_cast<const bf16x8*>(Qw + d0 * 16);
  const int sr = tid >> 4, sc = (tid & 15) * 8, vst0 = v_st(sr, sc), vst1 = v_st(32 + sr, sc);
  const int kr = tid >> 3, kc8 = (tid & 7) * 8, kst = KSWZ64(kr, kc8 * 2);
  const int vb0 = (int)(uintptr_t)V_lds + v_rd_base(lane);
  struct { bf16x8 vs0, vs1, ks; } sr_[2];
#define SLOAD(i, k0) do { sr_[i].vs0 = *reinterpret_cast<const bf16x8*>(&Vh[(long)((k0) + sr) * LDQ + sc]); sr_[i].vs1 = *reinterpret_cast<const bf16x8*>(&Vh[(long)((k0) + 32 + sr) * LDQ + sc]); \
    sr_[i].ks = *reinterpret_cast<const bf16x8*>(&Kh[(long)((k0) + kr) * LDQ + kc8]); } while (0)
#define SWRITE(b, i) do { *(bf16x8*)(V_lds + (b) * SHM_V + vst0) = sr_[i].vs0; *(bf16x8*)(V_lds + (b) * SHM_V + vst1) = sr_[i].vs1; \
    *(bf16x8*)(K_lds + (b) * SHM_K + kst) = sr_[i].ks; } while (0)
#define SWAIT() asm volatile("s_waitcnt vmcnt(3)" ::: "memory")
#define RESC(a) do { if (__any((a) < 1.f)) { if (hi == 0) al_l[r32] = (a); asm volatile("s_waitcnt lgkmcnt(0)" ::: "memory"); \
    _Pragma("unroll") for (int d = 0; d < 4; ++d) _Pragma("unroll") for (int r = 0; r < 16; ++r) o[d][r] *= al_l[crow(r, hi)]; } } while (0)
  f32x16 pA0, pA1, pB0, pB1; float mnA, mnB, alA, alB; bf16x8 pa0, pa1, pa2, pa3; const int NT = seq / KVBLK;
  constexpr int SE = 0, SO = 1;
  SLOAD(SE, 0); asm volatile("s_waitcnt vmcnt(0)" ::: "memory"); SWRITE(0, SE); __syncthreads();
  qkt(pA0, pA1, K_lds, qr, r32, hi); partialSM(pA0, pA1, m_reg, mnA, alA);
  SLOAD(SO, KVBLK); if (2 < NT) SLOAD(SE, 2 * KVBLK);
  SWAIT(); SWRITE(1, SO); __syncthreads();
  for (int j = 1; j + 1 < NT; j += 2) {
    SBAR(); qkt(pB0, pB1, K_lds + SHM_K, qr, r32, hi);
    finishSM(pA0, pA1, alA, l_reg, pa0, pa1, pa2, pa3); SBAR();
    SLOAD(SO, (j + 2) * KVBLK); SBAR();
    pv_d0(o, vb0, pa0, pa1, pa2, pa3); partialSM(pB0, pB1, m_reg, mnB, alB);
    __syncthreads(); SWAIT(); SWRITE(0, SE);
    RESC(alB); __syncthreads();
    SBAR(); qkt(pA0, pA1, K_lds, qr, r32, hi);
    finishSM(pB0, pB1, alB, l_reg, pa0, pa1, pa2, pa3); SBAR();
    if (j + 3 < NT) SLOAD(SE, (j + 3) * KVBLK); SBAR();
    pv_d0(o, vb0 + SHM_V, pa0, pa1, pa2, pa3); partialSM(pA0, pA1, m_reg, mnA, alA);
    __syncthreads(); SWAIT(); SWRITE(1, SO);
    RESC(alA); __syncthreads();
  }
  SBAR(); qkt(pB0, pB1, K_lds + SHM_K, qr, r32, hi);
  finishSM(pA0, pA1, alA, l_reg, pa0, pa1, pa2, pa3); SBAR();
  pv_d0(o, vb0, pa0, pa1, pa2, pa3); partialSM(pB0, pB1, m_reg, mnB, alB);
  __syncthreads(); RESC(alB);
  finishSM(pB0, pB1, alB, l_reg, pa0, pa1, pa2, pa3); SBAR();
  pv_d0(o, vb0 + SHM_V, pa0, pa1, pa2, pa3);
  if (hi == 0) li_l[r32] = l_reg; asm volatile("s_waitcnt lgkmcnt(0)" ::: "memory");
  float rli[16];
#pragma unroll
  for (int r = 0; r < 16; ++r) rli[r] = __builtin_amdgcn_rcpf(li_l[crow(r, hi)]);
  bf16_t* Ow = Ob + (long)(wid * QBLK) * 1024;
#pragma unroll
  for (int r = 0; r < 16; ++r) { const int orow = crow(r, hi);
#pragma unroll
    for (int d0 = 0; d0 < 4; ++d0) Ow[(long)orow * 1024 + d0 * 32 + r32] = (bf16_t)(cvtpk(o[d0][r] * rli[r], 0.f) & 0xffffu); }
  __syncthreads();
#undef SLOAD
#undef SWRITE
#undef SWAIT
#undef RESC
}
#undef SBAR
}


typedef GAS unsigned gu32;
#define RLX_AGENT __ATOMIC_RELAXED, __HIP_MEMORY_SCOPE_AGENT
#define XB_TMO      128
#define XB_XCNT(j)  (256  + 64 * (j))
#define XB_XSUB(j)  (1280 + 64 * (j))
#define XB_XGEN(j)  (2304 + 64 * (j))
#define XB_TOP      3328
#define XB_TOPGEN   3392
#define XCD_BAR_WORDS 3456
#define XB_SPIN_CAP (1u << 22)
__device__ __forceinline__ unsigned xb_ld(unsigned* p)              { return __hip_atomic_load(p, __ATOMIC_RELAXED, __HIP_MEMORY_SCOPE_AGENT); }
__device__ __forceinline__ unsigned xb_add(unsigned* p, unsigned v) { return __hip_atomic_fetch_add(p, v, __ATOMIC_RELAXED, __HIP_MEMORY_SCOPE_AGENT); }
__device__ __forceinline__ unsigned xb_xcc_id() { return (unsigned)__builtin_amdgcn_s_getreg((3 << 11) | 20) & 0xFu; }
#define XB_SPIN(cond, bar) do { unsigned _sp = 0; while (cond) { __builtin_amdgcn_s_sleep(1); \
    if ((++_sp & 255u) == 0u) { if (xb_ld(&(bar)[XB_TMO])) break; if (_sp > XB_SPIN_CAP) { atomicAdd(&(bar)[XB_TMO], 1u); break; } } } } while (0)
struct XcdBarrier { unsigned* bar; unsigned x; volatile LAS unsigned* st; };
__device__ __forceinline__ XcdBarrier xcd_barrier_post(unsigned* bar, volatile LAS unsigned* st) {
    XcdBarrier b; b.bar = bar; b.x = xb_xcc_id(); b.st = st;
    if (threadIdx.x == 0) (void)xb_add(&bar[XB_XCNT(b.x)], 1u);
    return b;
}
__device__ __forceinline__ void xcd_barrier_complete(unsigned* bar, unsigned x, unsigned& nloc, unsigned& nx) {
    const unsigned G = gridDim.x * gridDim.y * gridDim.z;
    unsigned sum, cnt, mine, sp = 0u;
    for (;;) {
        sum = 0u; cnt = 0u; mine = 0u;
#pragma unroll
        for (unsigned j = 0; j < 16; ++j) { const unsigned c = xb_ld(&bar[XB_XCNT(j)]); sum += c; cnt += (c > 0u) ? 1u : 0u; mine = (j == x) ? c : mine; }
        if (sum == G) break;
        __builtin_amdgcn_s_sleep(1);
        if ((++sp & 255u) == 0u) { if (xb_ld(&bar[XB_TMO])) break; if (sp > XB_SPIN_CAP) { atomicAdd(&bar[XB_TMO], 1u); break; } }
    }
    nloc = mine > 0u ? mine : 1u; nx = cnt > 0u ? cnt : 1u;
}
__device__ __forceinline__ void xcd_barrier(const XcdBarrier& b) {
    asm volatile("s_waitcnt vmcnt(0)" ::: "memory");
    __syncthreads();
    if (threadIdx.x == 0) {
        unsigned* bar = b.bar;
        __builtin_amdgcn_s_waitcnt(0);
        unsigned nloc = b.st[0], nx = b.st[1];
        if (nloc == 0u) { xcd_barrier_complete(bar, b.x, nloc, nx); b.st[0] = nloc; b.st[1] = nx; }
        const unsigned old = xb_add(&bar[XB_XSUB(b.x)], 1u);
        const unsigned gen = old / nloc;
        if (old + 1u == (gen + 1u) * nloc) {
            __builtin_amdgcn_fence(__ATOMIC_RELEASE, "agent");
            asm volatile("s_waitcnt vmcnt(0)" ::: "memory");
            const unsigned og = xb_add(&bar[XB_TOP], 1u);
            const unsigned tg = og / nx;
            if (og + 1u == (tg + 1u) * nx) xb_add(&bar[XB_TOPGEN], 1u);
            else XB_SPIN(xb_ld(&bar[XB_TOPGEN]) == tg, bar);
            __builtin_amdgcn_fence(__ATOMIC_ACQUIRE, "agent");
            xb_add(&bar[XB_XGEN(b.x)], 1u);
            asm volatile("s_waitcnt vmcnt(0)" ::: "memory");
        } else {
            XB_SPIN(xb_ld(&bar[XB_XGEN(b.x)]) == gen, bar);
            __builtin_amdgcn_fence(__ATOMIC_ACQUIRE, "agent");
            asm volatile("s_waitcnt vmcnt(0)" ::: "memory");
        }
    }
    __syncthreads();
}

struct Frame {
    LAS unsigned char* lds; char* ldsg;
    int tid, lane, wave, vcu, G;
    const Args* a;
};
#define INP(F, i, T) ((const T*)(F).a->in[i])
#define WSP(F, off, T) ((T*)((F).a->ws + (off)))

__device__ __forceinline__ void cvt_tile(const float* __restrict__ W, int N, int nvalid, int k0, int n0, bf16_t* __restrict__ WT, int rowb, LAS unsigned char* scr, int lane) {
    const int kq = lane >> 4, nq = lane & 15;
    f32x4 v[16];
#pragma unroll
    for (int i = 0; i < 16; ++i) {
        const int k = 4 * i + kq;
        if (4 * nq < nvalid) v[i] = *(const f32x4*)(W + (size_t)(k0 + k) * N + n0 + 4 * nq); else v[i] = (f32x4){0.f, 0.f, 0.f, 0.f};
    }
#pragma unroll
    for (int i = 0; i < 16; ++i) {
        const int k = 4 * i + kq, s = ((k >> 1) & 1) | (((k >> 3) & 1) << 1);
        u32x2 w; w.x = cvtpk(v[i].x, v[i].y); w.y = cvtpk(v[i].z, v[i].w);
        *(LAS u32x2*)(scr + k * 128 + ((nq * 8) ^ (s << 5))) = w;
    }
    const int g = lane >> 4, i16 = lane & 15, q = i16 >> 2, p = i16 & 3;
#pragma unroll
    for (int nb = 0; nb < 4; ++nb)
#pragma unroll
        for (int hf = 0; hf < 2; ++hf) {
            const int kc = g + 4 * hf, klo = 8 * kc + q, s = ((klo >> 1) & 1) | (((klo >> 3) & 1) << 1);
            const int a_lo = klo * 128 + (((16 * nb + 4 * p) * 2) ^ (s << 5));
            typedef short v4i16_t __attribute__((ext_vector_type(4)));
            const s16x4 lo = __builtin_bit_cast(s16x4, __builtin_amdgcn_ds_read_tr16_b64_v4i16((LAS v4i16_t*)(scr + a_lo)));
            const s16x4 hi = __builtin_bit_cast(s16x4, __builtin_amdgcn_ds_read_tr16_b64_v4i16((LAS v4i16_t*)(scr + a_lo + 512)));
            bf16x8 o = {lo[0], lo[1], lo[2], lo[3], hi[0], hi[1], hi[2], hi[3]};
            *(bf16x8*)(WT + (size_t)(rowb + 16 * nb + i16) * 2048 + k0 + 8 * kc) = o;
        }
}

__device__ __forceinline__ void p0_prologue(Frame& F) {
    LAS unsigned char* scr = F.lds + F.wave * 8192;
    const int gw = F.vcu * 8 + F.wave, NGW = F.G * 8, lane = F.lane;
    const float* w_in = INP(F, 3, float); const float* w_out = INP(F, 21, float);
    const float* e_gate = INP(F, 24, float); const float* e_up = INP(F, 25, float); const float* e_down = INP(F, 26, float);
    bf16_t* WinT = WSP(F, WS_WIN, bf16_t); bf16_t* WoutT = WSP(F, WS_WOUT, bf16_t); bf16_t* WguT = WSP(F, WS_WGU, bf16_t); bf16_t* WdT = WSP(F, WS_WD, bf16_t);
    constexpr int I_IN = 32 * 101, I_OUT = 32 * 32, I_E = 16 * 32 * 32, NITEMS = I_IN + I_OUT + 3 * I_E;
    for (int it = gw; it < NITEMS; it += NGW) {
        int r = it;
        if (r < I_IN) { const int kt = r / 101, nt = r % 101; const int nv = (nt == 100) ? 32 : 64; cvt_tile(w_in, IN_COLS, nv, kt * 64, nt * 64, WinT, nt * 64, scr, lane); continue; }
        r -= I_IN;
        if (r < I_OUT) { const int kt = r >> 5, nt = r & 31; cvt_tile(w_out, 2048, 64, kt * 64, nt * 64, WoutT, nt * 64, scr, lane); continue; }
        r -= I_OUT;
        const int mat = r / I_E; r -= mat * I_E;
        const int e = r >> 10, kt = (r >> 5) & 31, nt = r & 31;
        if (mat < 2) {
            const float* W = (mat == 0 ? e_gate : e_up) + (size_t)e * 2048 * 2048;
            const int f0 = nt * 64, rowb = e * 4096 + (f0 >> 7) * 256 + mat * 128 + (f0 & 127);
            cvt_tile(W, 2048, 64, kt * 64, f0, WguT, rowb, scr, lane);
        } else {
            cvt_tile(e_down + (size_t)e * 2048 * 2048, 2048, 64, kt * 64, nt * 64, WdT, e * 2048 + nt * 64, scr, lane);
        }
    }
    { u32x4 z = {0u, 0u, 0u, 0u}; u32x4* zp = (u32x4*)(WinT + (size_t)6464 * 2048); const int nz = 192 * 2048 * 2 / 16;
      for (int i = gw * 64 + lane; i < nz; i += NGW * 64) zp[i] = z; }
    { const float* x = INP(F, 0, float); const float* nw = INP(F, 2, float); bf16_t* H1 = WSP(F, WS_H1, bf16_t);
      for (int m = gw; m < MTOK; m += NGW) {
          const f32x4* xr = (const f32x4*)(x + (size_t)m * DM) + lane; f32x4 v[8]; float s = 0.f;
#pragma unroll
          for (int j = 0; j < 8; ++j) { v[j] = xr[64 * j]; s += (v[j].x * v[j].x + v[j].y * v[j].y) + (v[j].z * v[j].z + v[j].w * v[j].w); }
          const float rstd = 1.f / sqrtf(wave_sum(s) * (1.f / DM) + 1e-6f);
          u32x2* o8 = (u32x2*)(H1 + (size_t)m * DM) + lane;
#pragma unroll
          for (int j = 0; j < 8; ++j) { const f32x4 w = ((const f32x4*)nw)[lane + 64 * j]; u32x2 o; o.x = cvtpk(v[j].x * rstd * w.x, v[j].y * rstd * w.y); o.y = cvtpk(v[j].z * rstd * w.z, v[j].w * rstd * w.w); o8[64 * j] = o; }
      } }
    { const int* pos = INP(F, 1, int); float* rope = WSP(F, WS_ROPE, float);
      const float invf[8] = {1.0f, 0.19392274474868576f, 0.03760603093086393f, 0.007292664737217109f, 0.001414213562373095f, 0.0002742481756762073f, 5.318295896944988e-05f, 1.031338537721246e-05f};
      for (int i = gw * 64 + lane; i < MTOK * 8; i += NGW * 64) { const int m = i >> 3, j = i & 7; float fj = invf[0];
#pragma unroll
          for (int q = 1; q < 8; ++q) fj = (j == q) ? invf[q] : fj;
          const float ang = (float)pos[m] * fj; rope[m * 16 + j] = cosf(ang); rope[m * 16 + 8 + j] = sinf(ang); } }
}

__device__ __forceinline__ float zshift(const bf16_t* P, int m, int t, int col, float mp, float mn) {
    const float z = bf2f(P[(size_t)m * LDP + ZC0 + col]);
    const float zp = (t > 0) ? bf2f(P[(size_t)(m - 1) * LDP + ZC0 + col]) : 0.f;
    const float zn = (t < SEQ - 1) ? bf2f(P[(size_t)(m + 1) * LDP + ZC0 + col]) : 0.f;
    return z + mp * (zp - z) + mn * (zn - z);
}
__device__ __forceinline__ void p3_prep(Frame& F) {
    constexpr int TT = 8;
    const bf16_t* P = WSP(F, WS_PROJ, bf16_t);
    const float* mu_p = INP(F, 4, float); const float* mu_n = INP(F, 5, float);
    const float* w0 = INP(F, 11, float); const float* dup = INP(F, 12, float); const float* a0 = INP(F, 13, float); const float* iup = INP(F, 14, float); const float* gup = INP(F, 15, float);
    const float* k_k = INP(F, 16, float); const float* k_a = INP(F, 17, float); const float* r_k = INP(F, 18, float);
    bf16_t* Ro = WSP(F, WS_R, bf16_t); bf16_t* KKo = WSP(F, WS_KK, bf16_t); bf16_t* Vo = WSP(F, WS_V, bf16_t); bf16_t* Go = WSP(F, WS_G, bf16_t);
    float* Wd = WSP(F, WS_WDEC, float); bf16_t* KDo = WSP(F, WS_KD, bf16_t); bf16_t* BBo = WSP(F, WS_BB, bf16_t); float* BON = WSP(F, WS_BONUS, float);
    LAS float* L = (LAS float*)F.lds;
    const int tid = F.tid;
    for (int tile = F.vcu; tile < MTOK / TT; tile += F.G) {
        const int m0 = tile * TT;
        __syncthreads();
        if (tid < 288) {
            const int zc = 3072 + tid; const float mp = mu_p[zc], mn = mu_n[zc];
            for (int i = 0; i < TT; ++i) { const int m = m0 + i; float z = zshift(P, m, m & (SEQ - 1), zc, mp, mn);
                if (tid < 64) z = tanhf(z); else if (tid >= 128) z = sigmoidf_(z);
                L[i * 288 + tid] = z; }
        }
        __syncthreads();
#pragma unroll 1
        for (int cc = 0; cc < 2; ++cc) {
            const int c = tid + cc * 512, h = c >> 6;
            float aw0[TT], aw1[TT], aa0[TT], aa1[TT], ag[TT];
#pragma unroll
            for (int i = 0; i < TT; ++i) { aw0[i] = 0.f; aw1[i] = 0.f; aa0[i] = 0.f; aa1[i] = 0.f; ag[i] = 0.f; }
            for (int j = 0; j < 64; ++j) {
                const float d0 = dup[(size_t)j * 1024 + c], d1 = dup[(size_t)(64 + j) * 1024 + c], i0 = iup[(size_t)j * 1024 + c], i1 = iup[(size_t)(64 + j) * 1024 + c];
#pragma unroll
                for (int i = 0; i < TT; ++i) { const float lw = L[i * 288 + j], la = L[i * 288 + 64 + j]; aw0[i] += lw * d0; aw1[i] += lw * d1; aa0[i] += la * i0; aa1[i] += la * i1; }
            }
            for (int j = 0; j < 160; ++j) { const float gu = gup[(size_t)j * 1024 + c];
#pragma unroll
                for (int i = 0; i < TT; ++i) ag[i] += L[i * 288 + 128 + j] * gu; }
            const float mpr = mu_p[c], mnr = mu_n[c], mpk = mu_p[1024 + c], mnk = mu_n[1024 + c], mpv = mu_p[2048 + c], mnv = mu_n[2048 + c];
            const float w00 = w0[c], w01 = w0[1024 + c], a00 = a0[c], a01 = a0[1024 + c], kkc = k_k[c], kac = k_a[c], rkc = r_k[c];
#pragma unroll
            for (int i = 0; i < TT; ++i) {
                const int m = m0 + i, t = m & (SEQ - 1);
                const float r = zshift(P, m, t, c, mpr, mnr), k = zshift(P, m, t, 1024 + c, mpk, mnk), v = zshift(P, m, t, 2048 + c, mpv, mnv);
                const float kr = k * kkc; const float ss = wave_sum(kr * kr);
                const float kk = kr / fmaxf(sqrtf(ss), 1e-12f);
                float dec[2], av[2];
                { const float x0 = w00 + aw0[i], x1 = w01 + aw1[i];
                  const float sp0 = (-x0 > 20.f) ? -x0 : log1pf(__expf(-x0)), sp1 = (-x1 > 20.f) ? -x1 : log1pf(__expf(-x1));
                  dec[0] = __expf(-__expf(-sp0 - 0.5f)); dec[1] = __expf(-__expf(-sp1 - 0.5f));
                  av[0] = sigmoidf_(a00 + aa0[i]); av[1] = sigmoidf_(a01 + aa1[i]); }
                const size_t o = (size_t)m * 1024 + c;
                Ro[o] = (bf16_t)(cvtpk(r, 0.f) & 0xffffu); KKo[o] = (bf16_t)(cvtpk(kk, 0.f) & 0xffffu); Vo[o] = (bf16_t)(cvtpk(v, 0.f) & 0xffffu); Go[o] = (bf16_t)(cvtpk(ag[i], 0.f) & 0xffffu);
                float bsum = 0.f;
#pragma unroll
                for (int d = 0; d < 2; ++d) {
                    const float kd = k * (1.f + (av[d] - 1.f) * kac), bb = kk * av[d];
                    const size_t od = (size_t)d * MTOK * 1024 + o;
                    Wd[od] = dec[d]; KDo[od] = (bf16_t)(cvtpk(kd, 0.f) & 0xffffu); BBo[od] = (bf16_t)(cvtpk(bb, 0.f) & 0xffffu);
                    bsum += r * kd * rkc;
                }
                bsum = wave_sum(bsum);
                if (F.lane == 0) BON[(size_t)m * 16 + h] = bsum;
            }
        }
    }
}

template <int CTRL> __device__ __forceinline__ float dpp_add(float x) {
    return x + __int_as_float(__builtin_amdgcn_update_dpp(0, __float_as_int(x), CTRL, 0xf, 0xf, false));
}
__device__ __forceinline__ float row16_allsum(float x) { x = dpp_add<0x128>(x); x = dpp_add<0x124>(x); x = dpp_add<0x122>(x); x = dpp_add<0x121>(x); return x; }
__device__ __forceinline__ void p4_scan(Frame& F) {
    constexpr int CH = 32, NCH = SEQ / CH;
    constexpr int VEC = CH * 64 * 4;
    constexpr int BUF = 5 * VEC + CH * 32 * 4;
    constexpr int YOFF = 2 * BUF;
    const float* Wdec = WSP(F, WS_WDEC, float); const bf16_t* KDg = WSP(F, WS_KD, bf16_t); const bf16_t* BBg = WSP(F, WS_BB, bf16_t);
    const bf16_t* Rg = WSP(F, WS_R, bf16_t); const bf16_t* KKg = WSP(F, WS_KK, bf16_t); const bf16_t* Vg = WSP(F, WS_V, bf16_t); float* YS = WSP(F, WS_YS, float);
    const int tid = F.tid, lane = F.lane, wid = F.wave, g = lane >> 4, j = lane & 15, rowl = wid * 4 + g;
    const int ss = tid >> 4, sk = (tid & 15) * 4;
    for (int item = F.vcu; item < 256; item += F.G) {
        const int chain = item >> 1, half = item & 1, d = chain >> 6, b = (chain >> 4) & 3, h = chain & 15;
        const size_t sh = (size_t)b * SEQ * 1024 + h * 64, pd = (size_t)d * MTOK * 1024 + sh;
        float S0 = 0.f, S1 = 0.f, S2 = 0.f, S3 = 0.f;
        f32x4 rw; u32x2 rkk, rbb, rkd, rr; unsigned rv;
#define SC_LOAD(c) do { const int tt_ = (c) * CH + ss; const int t_ = d ? (SEQ - 1 - tt_) : tt_; const size_t o_ = (size_t)t_ * 1024 + sk; \
        rw = *(const f32x4*)(Wdec + pd + o_); rkk = *(const u32x2*)(KKg + sh + o_); rbb = *(const u32x2*)(BBg + pd + o_); rkd = *(const u32x2*)(KDg + pd + o_); rr = *(const u32x2*)(Rg + sh + o_); \
        rv = *(const unsigned*)(Vg + sh + (size_t)t_ * 1024 + half * 32 + 2 * (tid & 15)); } while (0)
#define SC_STORE(bufi) do { LAS unsigned char* bp_ = F.lds + (bufi) * BUF; const int o_ = (ss * 64 + sk) * 4; \
        *(LAS f32x4*)(bp_ + o_) = rw; \
        *(LAS f32x4*)(bp_ + VEC + o_) = (f32x4){bf_lo(rkk.x), bf_hi(rkk.x), bf_lo(rkk.y), bf_hi(rkk.y)}; \
        *(LAS f32x4*)(bp_ + 2 * VEC + o_) = (f32x4){bf_lo(rbb.x), bf_hi(rbb.x), bf_lo(rbb.y), bf_hi(rbb.y)}; \
        *(LAS f32x4*)(bp_ + 3 * VEC + o_) = (f32x4){bf_lo(rkd.x), bf_hi(rkd.x), bf_lo(rkd.y), bf_hi(rkd.y)}; \
        *(LAS f32x4*)(bp_ + 4 * VEC + o_) = (f32x4){bf_lo(rr.x), bf_hi(rr.x), bf_lo(rr.y), bf_hi(rr.y)}; \
        *(LAS f32x2*)(bp_ + 5 * VEC + (ss * 32 + 2 * (tid & 15)) * 4) = (f32x2){bf_lo(rv), bf_hi(rv)}; } while (0)
        __syncthreads();
        SC_LOAD(0); SC_STORE(0);
        __syncthreads();
        for (int c = 0; c < NCH; ++c) {
            if (c + 1 < NCH) SC_LOAD(c + 1);
            const LAS unsigned char* bp = F.lds + (c & 1) * BUF;
            LAS float* yb = (LAS float*)(F.lds + YOFF + (c & 1) * (CH * 32 * 4));
#pragma unroll 4
            for (int s = 0; s < CH; ++s) {
                const f32x4 w = *(const LAS f32x4*)(bp + (s * 64 + j * 4) * 4);
                const f32x4 kk = *(const LAS f32x4*)(bp + VEC + (s * 64 + j * 4) * 4);
                const f32x4 bb = *(const LAS f32x4*)(bp + 2 * VEC + (s * 64 + j * 4) * 4);
                const f32x4 kd = *(const LAS f32x4*)(bp + 3 * VEC + (s * 64 + j * 4) * 4);
                const f32x4 r = *(const LAS f32x4*)(bp + 4 * VEC + (s * 64 + j * 4) * 4);
                const float v = *(const LAS float*)(bp + 5 * VEC + (s * 32 + rowl) * 4);
                float p = (S0 * kk.x + S1 * kk.y) + (S2 * kk.z + S3 * kk.w);
                const float u0 = S0 * w.x + v * kd.x, u1 = S1 * w.y + v * kd.y, u2 = S2 * w.z + v * kd.z, u3 = S3 * w.w + v * kd.w;
                p = row16_allsum(p);
                const float sa = -p;
                S0 = u0 + sa * bb.x; S1 = u1 + sa * bb.y; S2 = u2 + sa * bb.z; S3 = u3 + sa * bb.w;
                float y = (S0 * r.x + S1 * r.y) + (S2 * r.z + S3 * r.w);
                y = row16_allsum(y);
                if (j == 0) yb[s * 32 + rowl] = y;
            }
            if (c + 1 < NCH) SC_STORE((c + 1) & 1);
            __syncthreads();
            { const int tt = c * CH + ss, t = d ? (SEQ - 1 - tt) : tt;
              const f32x2 yv = *(const LAS f32x2*)(yb + ss * 32 + 2 * (tid & 15));
              *(f32x2*)(YS + pd + (size_t)t * 1024 + half * 32 + 2 * (tid & 15)) = yv; }
        }
#undef SC_LOAD
#undef SC_STORE
    }
}

__device__ __forceinline__ void p5_finalize(Frame& F) {
    const bf16_t* OC = WSP(F, WS_OC, bf16_t); const float* YS = WSP(F, WS_YS, float); const bf16_t* Vg = WSP(F, WS_V, bf16_t); const bf16_t* Gg = WSP(F, WS_G, bf16_t);
    const float* BON = WSP(F, WS_BONUS, float); bf16_t* MIX = WSP(F, WS_MIX, bf16_t);
    const float* subw = INP(F, 10, float); const float* lnw = INP(F, 19, float); const float* lnb = INP(F, 20, float);
    const int lane = F.lane, gw = F.vcu * 8 + F.wave, NGW = F.G * 8;
    float lam;
    { const float q1 = INP(F, 6, float)[lane] * INP(F, 7, float)[lane], q2 = INP(F, 8, float)[lane] * INP(F, 9, float)[lane];
      lam = __expf(wave_sum(q1)) - __expf(wave_sum(q2)) + 0.2f; }
    const int c0 = lane * 16;
    float sw[16], lw[16], lb[16];
#pragma unroll
    for (int i = 0; i < 16; ++i) { sw[i] = subw[(c0 + i) & 127] * 0.8f; lw[i] = lnw[c0 + i]; lb[i] = lnb[c0 + i]; }
    for (int m = gw; m < MTOK; m += NGW) {
        { const u32x4* p0 = (const u32x4*)(OC + (size_t)m * 1024 + c0); const u32x4* p1 = (const u32x4*)(OC + (size_t)MTOK * 1024 + (size_t)m * 1024 + c0);
          const u32x4 a0 = p0[0], a1 = p0[1], b0 = p1[0], b1 = p1[1];
          float dv[16]; const unsigned aw[8] = {a0.x, a0.y, a0.z, a0.w, a1.x, a1.y, a1.z, a1.w}, bw[8] = {b0.x, b0.y, b0.z, b0.w, b1.x, b1.y, b1.z, b1.w};
          float ssq = 0.f;
#pragma unroll
          for (int i = 0; i < 8; ++i) { dv[2 * i] = bf_lo(aw[i]) - lam * bf_lo(bw[i]); dv[2 * i + 1] = bf_hi(aw[i]) - lam * bf_hi(bw[i]); ssq += dv[2 * i] * dv[2 * i] + dv[2 * i + 1] * dv[2 * i + 1]; }
          ssq += __shfl_xor(ssq, 1); ssq += __shfl_xor(ssq, 2); ssq += __shfl_xor(ssq, 4);
          const float rstd = 1.f / sqrtf(ssq * (1.f / 128.f) + 1e-5f);
          unsigned ow[8];
#pragma unroll
          for (int i = 0; i < 8; ++i) ow[i] = cvtpk(dv[2 * i] * rstd * sw[2 * i], dv[2 * i + 1] * rstd * sw[2 * i + 1]);
          u32x4* op = (u32x4*)(MIX + (size_t)m * 2048 + c0); op[0] = (u32x4){ow[0], ow[1], ow[2], ow[3]}; op[1] = (u32x4){ow[4], ow[5], ow[6], ow[7]}; }
        { const f32x4* y0 = (const f32x4*)(YS + (size_t)m * 1024 + c0); const f32x4* y1 = (const f32x4*)(YS + (size_t)MTOK * 1024 + (size_t)m * 1024 + c0);
          float y[16]; float s = 0.f;
#pragma unroll
          for (int i = 0; i < 4; ++i) { const f32x4 a = y0[i], b = y1[i]; y[4 * i] = a.x + b.x; y[4 * i + 1] = a.y + b.y; y[4 * i + 2] = a.z + b.z; y[4 * i + 3] = a.w + b.w; }
#pragma unroll
          for (int i = 0; i < 16; ++i) s += y[i];
          s += __shfl_xor(s, 1); s += __shfl_xor(s, 2);
          const float mu = s * (1.f / 64.f); float q = 0.f;
#pragma unroll
          for (int i = 0; i < 16; ++i) { y[i] -= mu; q += y[i] * y[i]; }
          q += __shfl_xor(q, 1); q += __shfl_xor(q, 2);
          const float rstd = 1.f / sqrtf(q * (1.f / 64.f) + 64e-5f);
          const float bon = BON[(size_t)m * 16 + (lane >> 2)];
          const u32x4* vp = (const u32x4*)(Vg + (size_t)m * 1024 + c0); const u32x4* gp = (const u32x4*)(Gg + (size_t)m * 1024 + c0);
          const u32x4 v0 = vp[0], v1 = vp[1], g0 = gp[0], g1 = gp[1];
          const unsigned vw[8] = {v0.x, v0.y, v0.z, v0.w, v1.x, v1.y, v1.z, v1.w}, gq[8] = {g0.x, g0.y, g0.z, g0.w, g1.x, g1.y, g1.z, g1.w};
          unsigned ow[8];
#pragma unroll
          for (int i = 0; i < 8; ++i) {
              const float e0 = (y[2 * i] * rstd * lw[2 * i] + lb[2 * i] + bon * bf_lo(vw[i])) * bf_lo(gq[i]);
              const float e1 = (y[2 * i + 1] * rstd * lw[2 * i + 1] + lb[2 * i + 1] + bon * bf_hi(vw[i])) * bf_hi(gq[i]);
              ow[i] = cvtpk(e0, e1); }
          u32x4* op = (u32x4*)(MIX + (size_t)m * 2048 + 1024 + c0); op[0] = (u32x4){ow[0], ow[1], ow[2], ow[3]}; op[1] = (u32x4){ow[4], ow[5], ow[6], ow[7]}; }
    }
}

__device__ __forceinline__ void p7_router(Frame& F) {
    const float* X1 = WSP(F, WS_X1, float); const float* nw = INP(F, 22, float); const float* wr = INP(F, 23, float);
    bf16_t* H2 = WSP(F, WS_H2, bf16_t); float* AFF = WSP(F, WS_AFF, float);
    const int lane = F.lane, gw = F.vcu * 8 + F.wave, NGW = F.G * 8;
    for (int m = gw; m < MTOK; m += NGW) {
        const f32x4* xr = (const f32x4*)(X1 + (size_t)m * DM) + lane; f32x4 v[8]; float s = 0.f;
#pragma unroll
        for (int j = 0; j < 8; ++j) { v[j] = xr[64 * j]; s += (v[j].x * v[j].x + v[j].y * v[j].y) + (v[j].z * v[j].z + v[j].w * v[j].w); }
        const float rstd = 1.f / sqrtf(wave_sum(s) * (1.f / DM) + 1e-6f);
        u32x2* o8 = (u32x2*)(H2 + (size_t)m * DM) + lane;
        float lg[16];
#pragma unroll
        for (int e = 0; e < 16; ++e) lg[e] = 0.f;
#pragma unroll
        for (int j = 0; j < 8; ++j) {
            const f32x4 w = ((const f32x4*)nw)[lane + 64 * j];
            const float h0 = v[j].x * rstd * w.x, h1 = v[j].y * rstd * w.y, h2 = v[j].z * rstd * w.z, h3 = v[j].w * rstd * w.w;
            u32x2 o; o.x = cvtpk(h0, h1); o.y = cvtpk(h2, h3); o8[64 * j] = o;
            const float hh[4] = {h0, h1, h2, h3};
            const int col = (lane + 64 * j) * 4;
#pragma unroll
            for (int i = 0; i < 4; ++i) { const f32x4* wp = (const f32x4*)(wr + (size_t)(col + i) * 16);
#pragma unroll
                for (int q = 0; q < 4; ++q) { const f32x4 ww = wp[q]; lg[4 * q] += hh[i] * ww.x; lg[4 * q + 1] += hh[i] * ww.y; lg[4 * q + 2] += hh[i] * ww.z; lg[4 * q + 3] += hh[i] * ww.w; } }
        }
        float mx = -1e30f;
#pragma unroll
        for (int e = 0; e < 16; ++e) { lg[e] = wave_sum(lg[e]); mx = fmaxf(mx, lg[e]); }
        float den = 0.f;
#pragma unroll
        for (int e = 0; e < 16; ++e) { lg[e] = expf(lg[e] - mx); den += lg[e]; }
        float mine = lg[0];
#pragma unroll
        for (int e = 1; e < 16; ++e) mine = (lane == e) ? lg[e] : mine;
        if (lane < 16) AFF[((size_t)(m >> 11) * 16 + lane) * SEQ + (m & (SEQ - 1))] = mine / den;
    }
}

__device__ __forceinline__ void p8_select(Frame& F) {
    const float* AFF = WSP(F, WS_AFF, float); const bf16_t* H2 = WSP(F, WS_H2, bf16_t);
    bf16_t* XE = WSP(F, WS_XE, bf16_t); float* GATEX = WSP(F, WS_GATEX, float); int* SLOT = WSP(F, WS_SLOT, int);
    LAS float* A = (LAS float*)F.lds;
    LAS unsigned* cnt = (LAS unsigned*)(F.lds + 8192);
    LAS unsigned* list = (LAS unsigned*)(F.lds + 8192 + 64);
    const int tid = F.tid;
    for (int item = F.vcu; item < 256; item += F.G) {
        const int be = item >> 2, q = item & 3, b = be >> 4, e = be & 15;
        __syncthreads();
        { const f32x4* src = (const f32x4*)(AFF + (size_t)be * SEQ); ((LAS f32x4*)A)[tid] = src[tid]; if (tid == 0) *cnt = 0u; }
        __syncthreads();
        const int t = q * 512 + tid; const float a = A[t]; int rank = 0;
        for (int t2 = 0; t2 < SEQ; t2 += 4) { const f32x4 x = *(const LAS f32x4*)(A + t2);
            rank += (x.x > a || (x.x == a && t2 < t)) ? 1 : 0; rank += (x.y > a || (x.y == a && t2 + 1 < t)) ? 1 : 0;
            rank += (x.z > a || (x.z == a && t2 + 2 < t)) ? 1 : 0; rank += (x.w > a || (x.w == a && t2 + 3 < t)) ? 1 : 0; }
        const int m = b * SEQ + t;
        if (rank < CAP) { const int xrow = (e * 4 + b) * CAP + rank; GATEX[xrow] = a; SLOT[m * 16 + e] = rank; const unsigned pos = atomicAdd((unsigned*)cnt, 1u); list[pos] = ((unsigned)t << 16) | (unsigned)rank; }
        else SLOT[m * 16 + e] = -1;
        __syncthreads();
        const int n = (int)*cnt;
        for (int i = F.wave; i < n; i += 8) { const unsigned ent = list[i]; const int tt = ent >> 16, rk = ent & 0xffff;
            const u32x4* src = (const u32x4*)(H2 + (size_t)(b * SEQ + tt) * DM); u32x4* dst = (u32x4*)(XE + (size_t)((e * 4 + b) * CAP + rk) * DM);
#pragma unroll
            for (int jj = 0; jj < 4; ++jj) dst[F.lane + 64 * jj] = src[F.lane + 64 * jj]; }
    }
}

__device__ __forceinline__ void p11_final(Frame& F) {
    const float* X1 = WSP(F, WS_X1, float); const bf16_t* YE = WSP(F, WS_YE, bf16_t); const int* SLOT = WSP(F, WS_SLOT, int); const float* nw = INP(F, 27, float);
    float* out = F.a->out;
    const int lane = F.lane, gw = F.vcu * 8 + F.wave, NGW = F.G * 8;
    for (int m = gw; m < MTOK; m += NGW) {
        const int b = m >> 11;
        float v[32];
        { const f32x4* xr = (const f32x4*)(X1 + (size_t)m * DM + lane * 8);
#pragma unroll
          for (int j = 0; j < 4; ++j) { const f32x4 a = xr[0 + 64 * 2 * j], c = xr[1 + 64 * 2 * j]; v[8 * j] = a.x; v[8 * j + 1] = a.y; v[8 * j + 2] = a.z; v[8 * j + 3] = a.w; v[8 * j + 4] = c.x; v[8 * j + 5] = c.y; v[8 * j + 6] = c.z; v[8 * j + 7] = c.w; } }
        int sl = (lane < 16) ? SLOT[m * 16 + lane] : -1;
        for (int e = 0; e < 16; ++e) {
            const int s = __shfl(sl, e);
            if (s >= 0) { const u32x4* yr = (const u32x4*)(YE + (size_t)((e * 4 + b) * CAP + s) * DM + lane * 8);
#pragma unroll
                for (int j = 0; j < 4; ++j) { const u32x4 w = yr[64 * j];
                    v[8 * j] += bf_lo(w.x); v[8 * j + 1] += bf_hi(w.x); v[8 * j + 2] += bf_lo(w.y); v[8 * j + 3] += bf_hi(w.y); v[8 * j + 4] += bf_lo(w.z); v[8 * j + 5] += bf_hi(w.z); v[8 * j + 6] += bf_lo(w.w); v[8 * j + 7] += bf_hi(w.w); } }
        }
        float s = 0.f;
#pragma unroll
        for (int i = 0; i < 32; ++i) s += v[i] * v[i];
        const float rstd = 1.f / sqrtf(wave_sum(s) * (1.f / DM) + 1e-6f);
#pragma unroll
        for (int j = 0; j < 4; ++j) { const int col = 512 * j + lane * 8; const f32x4 w0 = *(const f32x4*)(nw + col), w1 = *(const f32x4*)(nw + col + 4);
            f32x4 o0 = {v[8 * j] * rstd * w0.x, v[8 * j + 1] * rstd * w0.y, v[8 * j + 2] * rstd * w0.z, v[8 * j + 3] * rstd * w0.w};
            f32x4 o1 = {v[8 * j + 4] * rstd * w1.x, v[8 * j + 5] * rstd * w1.y, v[8 * j + 6] * rstd * w1.z, v[8 * j + 7] * rstd * w1.w};
            *(f32x4*)(out + (size_t)m * DM + col) = o0; *(f32x4*)(out + (size_t)m * DM + col + 4) = o1; }
    }
}


template <int PHM> __global__ void __launch_bounds__(512, 2) mk_fwd(Args args) {
    extern __shared__ __attribute__((aligned(16))) unsigned char lds[];
    Frame F;
    F.lds = (LAS unsigned char*)lds; F.ldsg = (char*)lds; F.a = &args;
    F.tid = threadIdx.x; F.lane = F.tid & 63; F.wave = __builtin_amdgcn_readfirstlane(F.tid >> 6);
    F.G = gridDim.x; { const int bx = blockIdx.x; F.vcu = (F.G % 8 == 0) ? (bx % 8) * (F.G / 8) + bx / 8 : bx; }
    volatile LAS unsigned* MISC = (volatile LAS unsigned*)(F.lds + MISC_OFF);
    for (int u = F.tid; u < (LDS_BYTES - 131072) / 4; u += 512) ((LAS unsigned*)(F.lds + 131072))[u] = 0u;
    __syncthreads();
    gu32* ctl = (gu32*)(args.ws + WS_CTL);
    XcdBarrier bar; bar.bar = (unsigned*)(ctl + CW_BAR); bar.x = 0; bar.st = nullptr;
    if (MK_N_LAUNCHES == 1) bar = xcd_barrier_post((unsigned*)(ctl + CW_BAR), MISC + 8);
    const int lo = args.ph_lo, hi = args.ph_hi;
#define IN(k) (((PHM >> (k)) & 1) && lo <= (k) && (k) < hi)
#define SEAM(k) do { if (IN(k) && IN((k) + 1)) xcd_barrier(bar); } while (0)

    if (IN(0)) { p0_prologue(F); }
    SEAM(0);
    if (IN(1)) {
        pg8::Gemm g{WSP(F, WS_H1, bf16_t), WSP(F, WS_WIN, bf16_t), MTOK, LDP, DM}; pg8::StaticOrder S; S.init(MTOK, LDP, F.G, (int)blockIdx.x);
        pg8::EpiProj E{WSP(F, WS_PROJ, bf16_t), LDP, WSP(F, WS_ROPE, float), QSCALE};
        pg8::gemm_phase<pg8::EpiProj, pg8::StaticOrder, true, true>(F.lds, g, S, E);
    }
    SEAM(1);
    if (IN(2)) {
        const bf16_t* P = WSP(F, WS_PROJ, bf16_t); bf16_t* OC = WSP(F, WS_OC, bf16_t);
        for (int u = F.vcu * 2; u < 512; u += F.G * 2)
            for (int i = 0; i < 2; ++i) {
                const int uu = u + i, qb = uu & 7, c = (uu >> 3) & 1, h = (uu >> 4) & 7, b = uu >> 7;
                const size_t m0 = (size_t)b * SEQ;
                att::attn_unit<LDP>(P + (m0 + qb * 256) * LDP + h * 128 + c * 64, P + m0 * LDP + 1024 + h * 128 + c * 64, P + m0 * LDP + 2048 + h * 128,
                                    OC + (size_t)c * MTOK * 1024 + (m0 + qb * 256) * 1024 + h * 128, SEQ, F.ldsg);
            }
    }
    if (IN(3)) { p3_prep(F); }
    SEAM(3);
    if (IN(4)) { p4_scan(F); }
    SEAM(4);
    if (IN(5)) { p5_finalize(F); }
    SEAM(5);
    if (IN(6)) {
        pg8::Gemm g{WSP(F, WS_MIX, bf16_t), WSP(F, WS_WOUT, bf16_t), MTOK, DM, DM}; pg8::StaticOrder S; S.init(MTOK, DM, F.G, (int)blockIdx.x);
        pg8::EpiResid E{INP(F, 0, float), WSP(F, WS_X1, float), DM};
        pg8::gemm_phase<pg8::EpiResid, pg8::StaticOrder, true, true>(F.lds, g, S, E);
    }
    SEAM(6);
    if (IN(7)) { p7_router(F); }
    SEAM(7);
    if (IN(8)) { p8_select(F); }
    SEAM(8);
    if (IN(9)) {
        pg8::Gemm g{WSP(F, WS_XE, bf16_t), WSP(F, WS_WGU, bf16_t), 16384, 65536, DM}; pg8::MoeOrder S{F.G, F.vcu, 16, 1024};
        pg8::EpiSwiglu E{WSP(F, WS_HID, bf16_t), 16};
        pg8::gemm_phase<pg8::EpiSwiglu, pg8::MoeOrder, true, true>(F.lds, g, S, E);
    }
    SEAM(9);
    if (IN(10)) {
        pg8::Gemm g{WSP(F, WS_HID, bf16_t), WSP(F, WS_WD, bf16_t), 16384, 32768, DM}; pg8::MoeOrder S{F.G, F.vcu, 8, 512};
        pg8::EpiDown E{WSP(F, WS_YE, bf16_t), WSP(F, WS_GATEX, float), 8};
        pg8::gemm_phase<pg8::EpiDown, pg8::MoeOrder, true, true>(F.lds, g, S, E);
    }
    SEAM(10);
    if (IN(11)) { p11_final(F); }
#undef IN
#undef SEAM
}

static const void* kfn(int li) {
#if MK_N_LAUNCHES == 1
    (void)li; return (const void*)mk_fwd<0xFFF>;
#else
    switch (li) {
        case 0: return (const void*)mk_fwd<1>; case 1: return (const void*)mk_fwd<2>; case 2: return (const void*)mk_fwd<4>; case 3: return (const void*)mk_fwd<8>;
        case 4: return (const void*)mk_fwd<16>; case 5: return (const void*)mk_fwd<32>; case 6: return (const void*)mk_fwd<64>; case 7: return (const void*)mk_fwd<128>;
        case 8: return (const void*)mk_fwd<256>; case 9: return (const void*)mk_fwd<512>; case 10: return (const void*)mk_fwd<1024>; default: return (const void*)mk_fwd<2048>;
    }
#endif
}
extern "C" void kernel_launch(void* const* d_in, const int* in_sizes, int n_in, void* d_out, int out_size, void* d_ws, size_t ws_size, hipStream_t stream) {
    static int grid = 0;
    if (grid == 0) {
        if (n_in != 28 || out_size != MTOK * DM || ws_size < WS_END) { fprintf(stderr, "kernel_launch: unexpected shapes: n_in %d out %d ws %zu (need >= %zu)\n", n_in, out_size, ws_size, (size_t)WS_END); grid = -1; return; }
        int dev = 0, cus = 0, per_cu = 0;
        if (hipGetDevice(&dev) != hipSuccess || hipDeviceGetAttribute(&cus, hipDeviceAttributeMultiprocessorCount, dev) != hipSuccess) { fprintf(stderr, "kernel_launch: device query failed\n"); grid = -1; return; }
        for (int i = 0; i < MK_N_LAUNCHES; ++i) if (hipFuncSetAttribute(kfn(i), hipFuncAttributeMaxDynamicSharedMemorySize, LDS_BYTES) != hipSuccess) { fprintf(stderr, "kernel_launch: hipFuncSetAttribute failed\n"); grid = -1; return; }
        if (hipOccupancyMaxActiveBlocksPerMultiprocessor(&per_cu, kfn(0), 512, LDS_BYTES) != hipSuccess || per_cu < 1) { fprintf(stderr, "kernel_launch: occupancy query says %d blocks/CU\n", per_cu); }
        (void)hipGetLastError();
        grid = cus;
    }
    if (grid < 0) return;
    if (hipMemsetAsync((char*)d_ws + WS_CTL, 0, CTL_ZERO_BYTES, stream) != hipSuccess) { fprintf(stderr, "kernel_launch: memset failed\n"); return; }
    Args a{};
    for (int i = 0; i < 28; ++i) a.in[i] = d_in[i];
    a.out = (float*)d_out; a.ws = (unsigned char*)d_ws;
    const int nl = MK_N_LAUNCHES;
    for (int li = 0; li < nl; ++li) {
        a.ph_lo = (nl == 1) ? 0 : li; a.ph_hi = (nl == 1) ? N_PHASES : li + 1; a.li = li;
        void* kargs[] = {&a};
        (void)hipLaunchKernel(kfn(li), dim3(grid), dim3(512), kargs, LDS_BYTES, stream);
        const hipError_t le = hipPeekAtLastError();
        if (le != hipSuccess) { fprintf(stderr, "kernel_launch: launch %d failed: %s\n", li, hipGetErrorName(le)); break; }
    }
}
```

```cpp
#include <hip/hip_runtime.h>
#include <hip/hip_bf16.h>
#include <cstdio>
#include <cstdint>

#ifndef MK_N_LAUNCHES
#define MK_N_LAUNCHES 1
#endif
#ifndef CVT_IN_SCAN
#define CVT_IN_SCAN 1
#endif
constexpr int N_PHASES = 12;

constexpr int BATCH = 4, SEQ = 2048, DM = 2048, MTOK = BATCH * SEQ;
constexpr int IN_COLS = 6432, LDP = 6656;
constexpr int ZC0 = 3072;
constexpr int RW = 1024, NH_R = 16, HD_R = 64;
constexpr int NEXP = 16, CAP = 256, FF = 2048;
constexpr float QSCALE = 0.18033688011112042f;

constexpr size_t MiB = 1u << 20;
constexpr size_t WS_CTL = 0, CTL_ZERO_BYTES = 1 * MiB;
constexpr size_t WS_ROPE = 1 * MiB;
constexpr size_t WS_LORA = 2 * MiB;
constexpr size_t WS_AFF = 3 * MiB;
constexpr size_t WS_GATEX = 3 * MiB + 512 * 1024;
constexpr size_t WS_SLOT = 4 * MiB;
constexpr size_t WS_XEIDX = 6 * MiB;
constexpr size_t WS_BONUS = 5 * MiB;
constexpr size_t WS_WIN = 8 * MiB;
constexpr size_t WS_WOUT = 34 * MiB;
constexpr size_t WS_WGU = 48 * MiB;
constexpr size_t WS_WD = 304 * MiB;
constexpr size_t WS_H1 = 432 * MiB;
constexpr size_t WS_PROJ = 464 * MiB;
constexpr size_t WS_R = 568 * MiB, WS_KK = 584 * MiB, WS_V = 600 * MiB;
constexpr size_t WS_WDEC = 616 * MiB;
constexpr size_t WS_KD = 680 * MiB, WS_BB = 712 * MiB;
constexpr size_t WS_G = 744 * MiB;
constexpr size_t WS_OC = 760 * MiB;
constexpr size_t WS_YS = 792 * MiB;
constexpr size_t WS_MIX = 856 * MiB;
constexpr size_t WS_X1 = 888 * MiB;
constexpr size_t WS_H2 = 952 * MiB;
constexpr size_t WS_HID = 528 * MiB, WS_YE = 592 * MiB;
constexpr size_t WS_END = 984 * MiB;
constexpr int CW_BAR = 4096;

constexpr int LDS_BYTES = 147456;
constexpr int MISC_OFF = 131072 + 320;

#define GAS __attribute__((address_space(1)))
#define LAS __attribute__((address_space(3)))
typedef unsigned short bf16_t;
typedef float f32x4 __attribute__((ext_vector_type(4)));
typedef float f32x2 __attribute__((ext_vector_type(2)));
typedef float f32x16 __attribute__((ext_vector_type(16)));
typedef unsigned u32x4 __attribute__((ext_vector_type(4)));
typedef unsigned u32x2 __attribute__((ext_vector_type(2)));
typedef short bf16x8 __attribute__((ext_vector_type(8)));
typedef short s16x4 __attribute__((ext_vector_type(4)));
typedef __bf16 bf16x2_t __attribute__((ext_vector_type(2)));

__device__ __forceinline__ unsigned cvtpk(float lo, float hi) { f32x2 v = {lo, hi}; bf16x2_t b = __builtin_convertvector(v, bf16x2_t); return __builtin_bit_cast(unsigned, b); }
__device__ __forceinline__ float bf_lo(unsigned w) { return __uint_as_float(w << 16); }
__device__ __forceinline__ float bf_hi(unsigned w) { return __uint_as_float(w & 0xffff0000u); }
__device__ __forceinline__ float bf2f(bf16_t v) { return __uint_as_float((unsigned)v << 16); }
__device__ __forceinline__ float wave_sum(float v) {
#pragma unroll
    for (int o = 1; o < 64; o <<= 1) v += __shfl_xor(v, o);
    return v;
}
__device__ __forceinline__ float sigmoidf_(float x) { return 1.f / (1.f + __expf(-x)); }

struct Args { const void* in[28]; float* out; unsigned char* ws; int ph_lo, ph_hi, li, pad; };

namespace pg8 {
#define PG8_LAS __attribute__((address_space(3)))
typedef unsigned short bf16_t;
typedef short bf16x8 __attribute__((ext_vector_type(8)));
typedef float f32x4 __attribute__((ext_vector_type(4)));
typedef unsigned u32x4 __attribute__((ext_vector_type(4)));
constexpr int BM = 256, BK = 64, HALF = 128, HTB = HALF * BK * 2  , STAGE_BYTES = 8 * HTB, NXCD = 8, WGM = 8;

__host__ __device__ __forceinline__ int lds_byte(int r, int c) { const int st = (r >> 4) * 2 + (c >> 5), rr = r & 15, cc = c & 31, ob = rr * 64 + cc * 2; return st * 1024 + (ob ^ (((ob >> 9) & 1) << 5)); }
__host__ __device__ __forceinline__ void stage_rc(int b, int& R, int& C) { const int st = b / 1024, sb = b % 1024, swz = sb ^ (((sb >> 9) & 1) << 5); R = (st >> 1) * 16 + swz / 64; C = (st & 1) * 32 + (swz % 64) / 2; }
__host__ __device__ __forceinline__ int perm32(int rho) { const int n = rho >> 4, i = rho & 15; return 8 * (i >> 2) + 4 * n + (i & 3); }

struct Unit { int pm, pn, pk; };
struct Gemm { const bf16_t* A; const bf16_t* Bt; int M, N, K, Kp; };

struct StaticOrder {
    int nM, nN, nwg, G, c;
    __host__ __device__ void init(int M, int N, int G_, int c_) { nM = M / BM; nN = N / BM; nwg = nM * nN; G = G_; c = c_; }
    __host__ __device__ bool next(int i, Unit& u) const {
        const long L = (long)i * G + c; if (L >= nwg) return false;
        int wgid = (int)L; { const int q = nwg / NXCD, r = nwg % NXCD, xcd = wgid % NXCD, off = wgid / NXCD; wgid = (xcd < r ? xcd * (q + 1) : r * (q + 1) + (xcd - r) * q) + off; }
        const int nig = WGM * nN, gid = wgid / nig, fm = gid * WGM, gsz = (nM - fm) < WGM ? (nM - fm) : WGM;
        u.pm = fm + ((wgid % nig) % gsz); u.pn = (wgid % nig) / gsz; u.pk = 0; return true;
    }
    static constexpr bool GATHER = false;
    __device__ __forceinline__ int arow(const Unit&, int) const { return 0; }
    __device__ __forceinline__ void a_ready(const Unit&) const {}
    __device__ __forceinline__ void done(const Unit&) const {}
};


typedef float f32x2 __attribute__((ext_vector_type(2)));
typedef __bf16 bf16x2_t __attribute__((ext_vector_type(2)));
__device__ __forceinline__ unsigned cvt_pk_bf16(float lo, float hi) { f32x2 v = {lo, hi}; bf16x2_t b = __builtin_convertvector(v, bf16x2_t); return __builtin_bit_cast(unsigned, b); }

template <bool GATHER_> struct MoeOrderT {
    static constexpr bool GATHER = GATHER_;
    int G, vcu, npn, total; const int* idx;
    __device__ __forceinline__ int arow(const Unit& u, int r) const { return idx[u.pm * BM + r]; }
    __device__ bool next(int i, Unit& u) const {
        const int L = i * G + vcu; if (L >= total) return false;
        const int per_e = 4 * npn, e = L / per_e, r = L % per_e;
        u.pm = e * 4 + (r & 3); u.pn = e * npn + (r >> 2); u.pk = 0; return true;
    }
    __device__ __forceinline__ void a_ready(const Unit&) const {}
    __device__ __forceinline__ void done(const Unit&) const {}
};

struct EpiProj {
    static constexpr bool PERM = true, AFTER_DRAIN = false;
    bf16_t* P; int ldp; const float* rope; float qscale;
    __device__ __forceinline__ void operator()(const f32x4 (&acc)[2][2][4][2], const Unit& u, int wr, int wc, int fr, int fq) const {
        const int row0 = u.pm * BM + wr * 64 + fr, colt = u.pn * BM, col0 = colt + wc * 32 + 8 * fq;
        const bool ropew = (colt < 2048) && ((wc & 1) == 0);
        const float sc = (colt < 1024) ? qscale : 1.f, sgn = (fq == 0) ? -1.f : 1.f;
#pragma unroll
        for (int ai = 0; ai < 2; ++ai)
#pragma unroll
            for (int m = 0; m < 4; ++m) {
                const int row = row0 + ai * HALF + m * 16;
                f32x4 c0 = {1.f, 1.f, 1.f, 1.f}, c1 = c0, s0 = {0.f, 0.f, 0.f, 0.f}, s1 = s0;
                if (ropew) { const f32x4* rp = (const f32x4*)(rope + (size_t)row * 16); c0 = rp[0]; c1 = rp[1]; s0 = rp[2]; s1 = rp[3]; }
                bf16_t* rowp = P + (size_t)row * ldp + col0;
#pragma unroll
                for (int bj = 0; bj < 2; ++bj) {
                    f32x4 v0 = acc[ai][bj][m][0], v1 = acc[ai][bj][m][1];
                    if (ropew) {
                        f32x4 p0, p1;
#pragma unroll
                        for (int i = 0; i < 4; ++i) { p0[i] = __shfl_xor(v0[i], 16); p1[i] = __shfl_xor(v1[i], 16); }
                        if (fq < 2) { v0 = v0 * c0 + (p0 * s0) * sgn; v1 = v1 * c1 + (p1 * s1) * sgn; }
                    }
                    v0 = v0 * sc; v1 = v1 * sc;
                    u32x4 w; w.x = cvt_pk_bf16(v0[0], v0[1]); w.y = cvt_pk_bf16(v0[2], v0[3]); w.z = cvt_pk_bf16(v1[0], v1[1]); w.w = cvt_pk_bf16(v1[2], v1[3]);
                    *(u32x4*)(rowp + bj * HALF) = w;
                }
            }
    }
};

struct EpiResid {
    static constexpr bool PERM = true, AFTER_DRAIN = false;
    const float* base; bf16_t* out; int ldc;
    __device__ __forceinline__ void operator()(const f32x4 (&acc)[2][2][4][2], const Unit& u, int wr, int wc, int fr, int fq) const {
        const int row0 = u.pm * BM + wr * 64 + fr, col0 = u.pn * BM + wc * 32 + 8 * fq;
#pragma unroll
        for (int ai = 0; ai < 2; ++ai)
#pragma unroll
            for (int m = 0; m < 4; ++m) {
                const size_t off = (size_t)(row0 + ai * HALF + m * 16) * ldc + col0;
#pragma unroll
                for (int bj = 0; bj < 2; ++bj) { const f32x4 b0 = *(const f32x4*)(base + off + bj * HALF), b1 = *(const f32x4*)(base + off + bj * HALF + 4);
                    const f32x4 v0 = b0 + acc[ai][bj][m][0], v1 = b1 + acc[ai][bj][m][1];
                    u32x4 w; w.x = cvt_pk_bf16(v0[0], v0[1]); w.y = cvt_pk_bf16(v0[2], v0[3]); w.z = cvt_pk_bf16(v1[0], v1[1]); w.w = cvt_pk_bf16(v1[2], v1[3]);
                    *(u32x4*)(out + off + bj * HALF) = w; }
            }
    }
};

struct EpiSwiglu {
    static constexpr bool PERM = true, AFTER_DRAIN = false;
    bf16_t* H; int npn;
    __device__ __forceinline__ void operator()(const f32x4 (&acc)[2][2][4][2], const Unit& u, int wr, int wc, int fr, int fq) const {
        const int row0 = u.pm * BM + wr * 64 + fr, pnl = u.pn % npn, col0 = pnl * HALF + wc * 32 + 8 * fq;
#pragma unroll
        for (int ai = 0; ai < 2; ++ai)
#pragma unroll
            for (int m = 0; m < 4; ++m) {
                bf16_t* rowp = H + (size_t)(row0 + ai * HALF + m * 16) * 2048 + col0;
                float h[8];
#pragma unroll
                for (int n = 0; n < 2; ++n)
#pragma unroll
                    for (int i = 0; i < 4; ++i) { const float g = acc[ai][0][m][n][i], up = acc[ai][1][m][n][i]; h[n * 4 + i] = g * up * __builtin_amdgcn_rcpf(1.f + __expf(-g)); }
                u32x4 w; w.x = cvt_pk_bf16(h[0], h[1]); w.y = cvt_pk_bf16(h[2], h[3]); w.z = cvt_pk_bf16(h[4], h[5]); w.w = cvt_pk_bf16(h[6], h[7]);
                *(u32x4*)rowp = w;
            }
    }
};

struct EpiDown {
    static constexpr bool PERM = true, AFTER_DRAIN = false;
    bf16_t* Y; const float* gate; int npn;
    __device__ __forceinline__ void operator()(const f32x4 (&acc)[2][2][4][2], const Unit& u, int wr, int wc, int fr, int fq) const {
        const int row0 = u.pm * BM + wr * 64 + fr, pnl = u.pn % npn, col0 = pnl * BM + wc * 32 + 8 * fq;
#pragma unroll
        for (int ai = 0; ai < 2; ++ai)
#pragma unroll
            for (int m = 0; m < 4; ++m) {
                const int row = row0 + ai * HALF + m * 16; const float gt = gate[row];
                bf16_t* rowp = Y + (size_t)row * 2048 + col0;
#pragma unroll
                for (int bj = 0; bj < 2; ++bj) { const f32x4 v0 = acc[ai][bj][m][0] * gt, v1 = acc[ai][bj][m][1] * gt;
                    u32x4 w; w.x = cvt_pk_bf16(v0[0], v0[1]); w.y = cvt_pk_bf16(v0[2], v0[3]); w.z = cvt_pk_bf16(v1[0], v1[1]); w.w = cvt_pk_bf16(v1[2], v1[3]);
                    *(u32x4*)(rowp + bj * HALF) = w; }
            }
    }
};

template <class Epi, class Sched, bool ALIGN_EPI = false, bool SP2 = false>
__device__ __forceinline__ void gemm_phase(PG8_LAS unsigned char* lds, const Gemm g, const Sched& S, const Epi& E) {
    const int tid = threadIdx.x, wid = __builtin_amdgcn_readfirstlane(tid >> 6), lane = tid & 63, wr = wid >> 2, wc = wid & 3, fr = lane & 15, fq = lane >> 4;
    const int K = g.Kp, nt = g.K / BK;
    const size_t kslice = (size_t)g.K * 2;
    unsigned voffA[2], voffB[2];
#pragma unroll
    for (int i = 0; i < 2; ++i) { int R, C; stage_rc(tid * 16 + i * 8192, R, C); const int Rb = Epi::PERM ? ((R & ~31) + perm32(R & 31)) : R;
        voffA[i] = (unsigned)(R * K + C) * 2u; voffB[i] = (unsigned)(Rb * K + C) * 2u; }
    static_assert(!Sched::GATHER || SP2, "gathered A rows: SP2 loop only");
    const size_t kstep = (size_t)(BK * 2);
    const size_t hstep = (size_t)HALF * K * 2;
    const size_t tstep = 2 * hstep;
    const unsigned ldsw = (unsigned)wid * 1024u;
    const int aoff = lds_byte(wr * 64 + fr, fq * 8), boff = lds_byte(wc * 32 + fr, fq * 8);
#define PG8_SA(b, h) (((b) * 2 + (h)) * HTB)
#define PG8_SB(b, h) ((4 + (b) * 2 + (h)) * HTB)
#define PG8_STAGE(bufoff, gbase, voff) do { _Pragma("unroll") for (int _i = 0; _i < 2; ++_i) \
        __builtin_amdgcn_global_load_lds((const unsigned*)((const char*)(gbase) + (voff)[_i]), (PG8_LAS unsigned*)(lds + (bufoff) + ldsw + _i * 8192), 16, 0, 0); } while (0)
#define PG8_LDA(dst, b, h) do { _Pragma("unroll") for (int m = 0; m < 4; ++m) _Pragma("unroll") for (int k = 0; k < 2; ++k) dst[m][k] = *(const PG8_LAS bf16x8*)(lds + PG8_SA(b, h) + aoff + m * 2048 + k * 1024); } while (0)
#define PG8_LDB(dst, b, h) do { _Pragma("unroll") for (int n = 0; n < 2; ++n) _Pragma("unroll") for (int k = 0; k < 2; ++k) dst[n][k] = *(const PG8_LAS bf16x8*)(lds + PG8_SB(b, h) + boff + n * 2048 + k * 1024); } while (0)
#define PG8_MMA(ai, bj, At, Bt) do { __builtin_amdgcn_s_setprio(1); _Pragma("unroll") for (int m = 0; m < 4; ++m) _Pragma("unroll") for (int n = 0; n < 2; ++n) _Pragma("unroll") for (int k = 0; k < 2; ++k) \
        acc[ai][bj][m][n] = __builtin_amdgcn_mfma_f32_16x16x32_bf16(Bt[n][k], At[m][k], acc[ai][bj][m][n], 0, 0, 0); __builtin_amdgcn_s_setprio(0); } while (0)
#define PG8_WAIT_V(n) asm volatile("s_waitcnt vmcnt(" #n ")" ::: "memory")
#define PG8_WAIT_L(n) asm volatile("s_waitcnt lgkmcnt(" #n ")" ::: "memory")
#define PG8_BAR __builtin_amdgcn_s_barrier()
#define PG8_SCHED __builtin_amdgcn_sched_barrier(0)
    Unit cur, nxt; int ui = 0;
    if (!S.next(0, cur)) return;
    f32x4 acc[2][2][4][2];
#pragma unroll
    for (int a = 0; a < 2; ++a)
#pragma unroll
        for (int b = 0; b < 2; ++b)
#pragma unroll
            for (int m = 0; m < 4; ++m)
#pragma unroll
                for (int n = 0; n < 2; ++n) acc[a][b][m][n] = (f32x4){0.f, 0.f, 0.f, 0.f};
    bf16x8 At[4][2], B0[2][2], B1[2][2];
    const char* cA = (const char*)g.A + (size_t)cur.pm * tstep + (size_t)cur.pk * kslice; const char* cB = (const char*)g.Bt + (size_t)cur.pn * tstep + (size_t)cur.pk * kslice;
    unsigned cvA0[2], cvA1[2], nvA0[2], nvA1[2];
#pragma unroll
    for (int i = 0; i < 2; ++i) { int R, C; stage_rc(tid * 16 + i * 8192, R, C);
        if constexpr (Sched::GATHER) { cvA0[i] = (unsigned)(S.arow(cur, R) * K + C) * 2u; cvA1[i] = (unsigned)(S.arow(cur, HALF + R) * K + C) * 2u; }
        else { cvA0[i] = voffA[i]; cvA1[i] = voffA[i] + (unsigned)hstep; }
        nvA0[i] = cvA0[i]; nvA1[i] = cvA1[i]; }
    if constexpr (Sched::GATHER) cA = (const char*)g.A;
    S.a_ready(cur);
    if constexpr (SP2) {
        PG8_STAGE(PG8_SB(0, 0), cB, voffB); PG8_STAGE(PG8_SB(0, 1), cB + hstep, voffB); PG8_STAGE(PG8_SA(0, 0), cA, cvA0); PG8_STAGE(PG8_SA(0, 1), cA, cvA1);
        if (wr == 1) PG8_BAR;
        PG8_WAIT_V(2); PG8_BAR;
        PG8_STAGE(PG8_SB(1, 0), cB + kstep, voffB); PG8_STAGE(PG8_SA(1, 0), cA + kstep, cvA0); PG8_STAGE(PG8_SB(1, 1), cB + hstep + kstep, voffB);
        PG8_WAIT_V(6); PG8_BAR;
    } else {
        PG8_STAGE(PG8_SB(0, 0), cB, voffB); PG8_STAGE(PG8_SA(0, 0), cA, voffA); PG8_STAGE(PG8_SB(0, 1), cB + hstep, voffB); PG8_STAGE(PG8_SA(0, 1), cA + hstep, voffA);
        if (wr == 1) PG8_BAR;
        PG8_WAIT_V(4); PG8_BAR;
        PG8_STAGE(PG8_SB(1, 0), cB + kstep, voffB); PG8_STAGE(PG8_SA(1, 0), cA + kstep, voffA); PG8_STAGE(PG8_SB(1, 1), cB + hstep + kstep, voffB);
        PG8_WAIT_V(6); PG8_BAR;
    }
    for (;;) {
        const bool has_next = S.next(ui + 1, nxt);
        const char* nA = Sched::GATHER ? (const char*)g.A : (has_next ? (const char*)g.A + (size_t)nxt.pm * tstep + (size_t)nxt.pk * kslice : cA);
        if constexpr (Sched::GATHER) { if (has_next) {
#pragma unroll
            for (int i = 0; i < 2; ++i) { int R, C; stage_rc(tid * 16 + i * 8192, R, C); nvA0[i] = (unsigned)(S.arow(nxt, R) * K + C) * 2u; nvA1[i] = (unsigned)(S.arow(nxt, HALF + R) * K + C) * 2u; } } } const char* nB = has_next ? (const char*)g.Bt + (size_t)nxt.pn * tstep + (size_t)nxt.pk * kslice : cB;
        for (int t = 0; t < nt; t += 2) {
            const bool last = (t == nt - 2);
            const char* a1 = cA + (size_t)(t + 1) * kstep;
            const char* a2 = last ? nA : cA + (size_t)(t + 2) * kstep; const char* b2 = last ? nB : cB + (size_t)(t + 2) * kstep;
            const char* a3 = a2 + kstep; const char* b3 = b2 + kstep;
            if (last && has_next) S.a_ready(nxt);
            unsigned sA0[2], sA1[2];
#pragma unroll
            for (int i = 0; i < 2; ++i) { sA0[i] = last ? nvA0[i] : cvA0[i]; sA1[i] = last ? nvA1[i] : cvA1[i]; }
            if constexpr (SP2) {
            PG8_LDB(B0, 0, 0); PG8_LDB(B1, 0, 1); PG8_SCHED; PG8_LDA(At, 0, 0); PG8_STAGE(PG8_SA(1, 1), a1, cvA1);
            PG8_WAIT_V(8); PG8_WAIT_L(0); PG8_BAR; PG8_MMA(0, 0, At, B0); PG8_MMA(0, 1, At, B1); PG8_BAR; PG8_SCHED;
            PG8_LDA(At, 0, 1); PG8_STAGE(PG8_SB(0, 0), b2, voffB); PG8_STAGE(PG8_SB(0, 1), b2 + hstep, voffB); PG8_STAGE(PG8_SA(0, 0), a2, sA0);
            PG8_WAIT_V(8); PG8_WAIT_L(0); PG8_BAR; PG8_MMA(1, 0, At, B0); PG8_MMA(1, 1, At, B1); PG8_BAR; PG8_SCHED;
            PG8_LDB(B0, 1, 0); PG8_LDB(B1, 1, 1); PG8_SCHED; PG8_LDA(At, 1, 0); PG8_STAGE(PG8_SA(0, 1), a2, sA1);
            PG8_WAIT_V(8); PG8_WAIT_L(0); PG8_BAR; PG8_MMA(0, 0, At, B0); PG8_MMA(0, 1, At, B1); PG8_BAR; PG8_SCHED;
            PG8_LDA(At, 1, 1); PG8_STAGE(PG8_SB(1, 0), b3, voffB); PG8_STAGE(PG8_SB(1, 1), b3 + hstep, voffB); PG8_STAGE(PG8_SA(1, 0), a3, sA0);
            PG8_WAIT_V(8); PG8_WAIT_L(0); PG8_BAR; PG8_MMA(1, 0, At, B0); PG8_MMA(1, 1, At, B1); PG8_BAR; PG8_SCHED;
            } else {
            PG8_LDB(B0, 0, 0); PG8_SCHED; PG8_LDA(At, 0, 0); PG8_STAGE(PG8_SA(1, 1), a1 + hstep, voffA);
            PG8_WAIT_L(8); PG8_BAR; PG8_WAIT_L(0); PG8_MMA(0, 0, At, B0); PG8_BAR; PG8_SCHED;
            PG8_LDB(B1, 0, 1); PG8_STAGE(PG8_SB(0, 0), b2, voffB);
            PG8_BAR; PG8_WAIT_L(0); PG8_MMA(0, 1, At, B1); PG8_BAR;
            PG8_LDA(At, 0, 1); PG8_STAGE(PG8_SA(0, 0), a2, voffA);
            PG8_BAR; PG8_WAIT_L(0); PG8_MMA(1, 0, At, B0); PG8_BAR; PG8_SCHED;
            PG8_STAGE(PG8_SB(0, 1), b2 + hstep, voffB);
            PG8_WAIT_V(6); PG8_BAR; PG8_MMA(1, 1, At, B1); PG8_BAR;
            PG8_LDB(B0, 1, 0); PG8_SCHED; PG8_LDA(At, 1, 0); PG8_STAGE(PG8_SA(0, 1), a2 + hstep, voffA);
            PG8_WAIT_L(8); PG8_BAR; PG8_WAIT_L(0); PG8_MMA(0, 0, At, B0); PG8_BAR; PG8_SCHED;
            PG8_LDB(B1, 1, 1); PG8_STAGE(PG8_SB(1, 0), b3, voffB);
            PG8_BAR; PG8_WAIT_L(0); PG8_MMA(0, 1, At, B1); PG8_BAR;
            PG8_LDA(At, 1, 1); PG8_STAGE(PG8_SA(1, 0), a3, voffA);
            PG8_BAR; PG8_WAIT_L(0); PG8_MMA(1, 0, At, B0); PG8_BAR; PG8_SCHED;
            PG8_STAGE(PG8_SB(1, 1), b3 + hstep, voffB);
            PG8_WAIT_V(6); PG8_BAR; PG8_MMA(1, 1, At, B1); PG8_BAR;
            }
        }
        if constexpr (ALIGN_EPI) { if (wr == 0) PG8_BAR; }
        if constexpr (!Epi::AFTER_DRAIN) { E(acc, cur, wr, wc, fr, fq); S.done(cur); }
        if (!has_next) break;
#pragma unroll
        for (int a = 0; a < 2; ++a)
#pragma unroll
            for (int b = 0; b < 2; ++b)
#pragma unroll
                for (int m = 0; m < 4; ++m)
#pragma unroll
                    for (int n = 0; n < 2; ++n) acc[a][b][m][n] = (f32x4){0.f, 0.f, 0.f, 0.f};
        cur = nxt; cA = nA; cB = nB; ++ui;
#pragma unroll
        for (int i = 0; i < 2; ++i) { cvA0[i] = nvA0[i]; cvA1[i] = nvA1[i]; }
        if constexpr (ALIGN_EPI) { if (wr == 1) PG8_BAR; }
    }
    PG8_WAIT_V(0);
    if constexpr (!ALIGN_EPI) { if (wr == 0) PG8_BAR; }
    PG8_BAR;
    if constexpr (Epi::AFTER_DRAIN) { E.fused(acc, cur, wr, wc, fr, fq, lds, wid, lane); S.done(cur); }
#undef PG8_SA
#undef PG8_SB
#undef PG8_STAGE
#undef PG8_LDA
#undef PG8_LDB
#undef PG8_MMA
#undef PG8_WAIT_V
#undef PG8_WAIT_L
#undef PG8_BAR
#undef PG8_SCHED
}
}

namespace att {
constexpr int NW = 8, QBLK = 32, KVBLK = 64;
constexpr float THR = 8.f;
constexpr int SHM_V = KVBLK * 128 * 2, SHM_K = KVBLK * 64 * 2;
constexpr int SHM_ATTN = 2 * SHM_V + 2 * SHM_K + NW * 64 * 4;
#define KSWZ64(row, colB) ((row) * 128 + ((colB) ^ ((((row) >> 1) & 7) << 4)))
#define SBAR() __builtin_amdgcn_sched_barrier(0)
__device__ __forceinline__ int crow(int r, int hi) { return (r & 3) + 8 * (r >> 2) + 4 * hi; }

__device__ __forceinline__ void partialSM(f32x16& p0, f32x16& p1, float& m_reg, float& mn, float& alpha) {
  float pmax = p0[0];
#pragma unroll
  for (int r = 1; r < 16; ++r) pmax = fmaxf(pmax, p0[r]);
#pragma unroll
  for (int r = 0; r < 16; ++r) pmax = fmaxf(pmax, p1[r]);
  { auto rr = __builtin_amdgcn_permlane32_swap(__float_as_uint(pmax), __float_as_uint(pmax), false, false);
    pmax = fmaxf(__uint_as_float(rr[0]), __uint_as_float(rr[1])); }
  if (__builtin_expect(__all(pmax - m_reg <= THR), 1)) { mn = m_reg; alpha = 1.f; }
  else { mn = fmaxf(m_reg, pmax); alpha = __builtin_amdgcn_exp2f(m_reg - mn); m_reg = mn; }
#pragma unroll
  for (int r = 0; r < 16; ++r) p0[r] = p0[r] - mn;
#pragma unroll
  for (int r = 0; r < 16; ++r) p1[r] = p1[r] - mn;
#pragma unroll
  for (int r = 0; r < 16; ++r) p0[r] = __builtin_amdgcn_exp2f(p0[r]);
}
__device__ __forceinline__ void finishSM(f32x16& p0, f32x16& p1, float alpha, float& l_reg, bf16x8& pa0, bf16x8& pa1, bf16x8& pa2, bf16x8& pa3) {
#pragma unroll
  for (int r = 0; r < 16; ++r) p1[r] = __builtin_amdgcn_exp2f(p1[r]);
  float ps = 0;
#pragma unroll
  for (int r = 0; r < 16; ++r) ps += p0[r];
#pragma unroll
  for (int r = 0; r < 16; ++r) ps += p1[r];
  { auto rr = __builtin_amdgcn_permlane32_swap(__float_as_uint(ps), __float_as_uint(ps), false, false);
    ps = __uint_as_float(rr[0]) + __uint_as_float(rr[1]); }
  l_reg = l_reg * alpha + ps;
#define PK4(P, BASE, OUT) do { unsigned a0 = cvtpk(P[BASE + 0], P[BASE + 1]), a1 = cvtpk(P[BASE + 2], P[BASE + 3]);   \
    unsigned b0 = cvtpk(P[BASE + 4], P[BASE + 5]), b1 = cvtpk(P[BASE + 6], P[BASE + 7]);                              \
    auto r0 = __builtin_amdgcn_permlane32_swap(a0, b0, false, false); auto r1 = __builtin_amdgcn_permlane32_swap(a1, b1, false, false); \
    u32x4 w = {r0[0], r1[0], r0[1], r1[1]}; OUT = __builtin_bit_cast(bf16x8, w); } while (0)
  PK4(p0, 0, pa0); PK4(p0, 8, pa1); PK4(p1, 0, pa2); PK4(p1, 8, pa3);
#undef PK4
}
__device__ __forceinline__ void qkt(f32x16& p0, f32x16& p1, const char* Ks, const bf16x8* qr, int r32, int hi) {
  p0 = f32x16{}; p1 = f32x16{};
#pragma unroll
  for (int d0 = 0; d0 < 4; ++d0) { const int cb = (d0 * 16 + hi * 8) * 2;
    bf16x8 b0 = *reinterpret_cast<const bf16x8*>(Ks + KSWZ64(r32, cb));
    bf16x8 b1 = *reinterpret_cast<const bf16x8*>(Ks + KSWZ64(32 + r32, cb));
    p0 = __builtin_amdgcn_mfma_f32_32x32x16_bf16(b0, qr[d0], p0, 0, 0, 0);
    p1 = __builtin_amdgcn_mfma_f32_32x32x16_bf16(b1, qr[d0], p1, 0, 0, 0); }
}
__device__ __forceinline__ int v_st(int k, int c) { const int kk = (k & ~0xC) | ((k & 4) << 1) | ((k & 8) >> 1); return ((kk >> 3) * 4 + (c >> 5)) * 512 + ((kk & 7) * 32 + (c & 31)) * 2; }
__device__ __forceinline__ int v_rd_base(int lane) { return ((lane & 3) << 3) | (((lane >> 2) & 3) << 6) | (((lane >> 4) & 1) << 5) | (((lane >> 5) & 1) << 8); }
constexpr int v_rd_off(int d0, int ks, int half) { return d0 * 512 + ks * 4096 + half * 2048; }
template <int OFF> __device__ __forceinline__ s16x4 tr_read(int vb) {
  s16x4 r; asm volatile("ds_read_b64_tr_b16 %0, %1 offset:%2" : "=&v"(r) : "v"(vb), "i"(OFF) : "memory"); return r;
}
template <int D0> __device__ __forceinline__ void pv_one(f32x16& od, int vb, bf16x8 pa0, bf16x8 pa1, bf16x8 pa2, bf16x8 pa3) {
  const s16x4 l0 = tr_read<v_rd_off(D0, 0, 0)>(vb), h0 = tr_read<v_rd_off(D0, 0, 1)>(vb), l1 = tr_read<v_rd_off(D0, 1, 0)>(vb), h1 = tr_read<v_rd_off(D0, 1, 1)>(vb);
  const s16x4 l2 = tr_read<v_rd_off(D0, 2, 0)>(vb), h2 = tr_read<v_rd_off(D0, 2, 1)>(vb), l3 = tr_read<v_rd_off(D0, 3, 0)>(vb), h3 = tr_read<v_rd_off(D0, 3, 1)>(vb);
  asm volatile("s_waitcnt lgkmcnt(0)" ::: "memory"); SBAR();
#define PK(L, H) (bf16x8){L[0], L[1], L[2], L[3], H[0], H[1], H[2], H[3]}
  od = __builtin_amdgcn_mfma_f32_32x32x16_bf16(pa0, PK(l0, h0), od, 0, 0, 0);
  od = __builtin_amdgcn_mfma_f32_32x32x16_bf16(pa1, PK(l1, h1), od, 0, 0, 0);
  od = __builtin_amdgcn_mfma_f32_32x32x16_bf16(pa2, PK(l2, h2), od, 0, 0, 0);
  od = __builtin_amdgcn_mfma_f32_32x32x16_bf16(pa3, PK(l3, h3), od, 0, 0, 0);
#undef PK
}
__device__ __forceinline__ void pv_d0(f32x16* o, int vb, bf16x8 pa0, bf16x8 pa1, bf16x8 pa2, bf16x8 pa3) {
  pv_one<0>(o[0], vb, pa0, pa1, pa2, pa3); pv_one<1>(o[1], vb, pa0, pa1, pa2, pa3); pv_one<2>(o[2], vb, pa0, pa1, pa2, pa3); pv_one<3>(o[3], vb, pa0, pa1, pa2, pa3);
}

template <int LDQ>
__device__ __forceinline__ void attn_unit(const bf16_t* __restrict__ Qb, const bf16_t* __restrict__ Kh, const bf16_t* __restrict__ Vh, bf16_t* __restrict__ Ob, int seq, char* lds) {
  const int tid = threadIdx.x, wid = tid >> 6, lane = tid & 63, r32 = lane & 31, hi = lane >> 5;
  char* V_lds = lds; char* K_lds = lds + 2 * SHM_V;
  float* ws = (float*)(lds + 2 * SHM_V + 2 * SHM_K) + wid * 64; float* li_l = ws; float* al_l = ws + 32;
  float m_reg = -1e30f, l_reg = 0; f32x16 o[4] = {}; bf16x8 qr[4];
  const bf16_t* Qw = Qb + (long)(wid * QBLK + r32) * LDQ + hi * 8;
#pragma unroll
  for (int d0 = 0; d0 < 4; ++d0) qr[d0] = *reinterpret_cast<const bf16x8*>(Qw + d0 * 16);
  const int sr = tid >> 4, sc = (tid & 15) * 8, vst0 = v_st(sr, sc), vst1 = v_st(32 + sr, sc);
  const int kr = tid >> 3, kc8 = (tid & 7) * 8, kst = KSWZ64(kr, kc8 * 2);
  const int vb0 = (int)(uintptr_t)V_lds + v_rd_base(lane);
  struct { bf16x8 vs0, vs1, ks; } sr_[2];
  const bf16_t* Vp0 = Vh + (long)sr * LDQ + sc; const bf16_t* Kp0 = Kh + (long)kr * LDQ + kc8;
#define SLOAD(i, k0) do { const long ko_ = (long)(k0) * LDQ; sr_[i].vs0 = *reinterpret_cast<const bf16x8*>(Vp0 + ko_); sr_[i].vs1 = *reinterpret_cast<const bf16x8*>(Vp0 + ko_ + 32 * LDQ); \
    sr_[i].ks = *reinterpret_cast<const bf16x8*>(Kp0 + ko_); } while (0)
#define SWRITE(b, i) do { *(bf16x8*)(V_lds + (b) * SHM_V + vst0) = sr_[i].vs0; *(bf16x8*)(V_lds + (b) * SHM_V + vst1) = sr_[i].vs1; \
    *(bf16x8*)(K_lds + (b) * SHM_K + kst) = sr_[i].ks; } while (0)
#define SWAIT() asm volatile("s_waitcnt vmcnt(3)" ::: "memory")
#define RESC(a) do { if (__any((a) < 1.f)) { if (hi == 0) al_l[r32] = (a); asm volatile("s_waitcnt lgkmcnt(0)" ::: "memory"); \
    _Pragma("unroll") for (int d = 0; d < 4; ++d) _Pragma("unroll") for (int r = 0; r < 16; ++r) o[d][r] *= al_l[crow(r, hi)]; } } while (0)
  f32x16 pA0, pA1, pB0, pB1; float mnA, mnB, alA, alB; bf16x8 pa0, pa1, pa2, pa3; const int NT = seq / KVBLK;
  constexpr int SE = 0, SO = 1;
  SLOAD(SE, 0); asm volatile("s_waitcnt vmcnt(0)" ::: "memory"); SWRITE(0, SE); __syncthreads();
  qkt(pA0, pA1, K_lds, qr, r32, hi); partialSM(pA0, pA1, m_reg, mnA, alA);
  SLOAD(SO, KVBLK); if (2 < NT) SLOAD(SE, 2 * KVBLK);
  SWAIT(); SWRITE(1, SO); __syncthreads();
  for (int j = 1; j + 1 < NT; j += 2) {
    SBAR(); qkt(pB0, pB1, K_lds + SHM_K, qr, r32, hi);
    finishSM(pA0, pA1, alA, l_reg, pa0, pa1, pa2, pa3); SBAR();
    SLOAD(SO, (j + 2) * KVBLK); SBAR();
    pv_d0(o, vb0, pa0, pa1, pa2, pa3); partialSM(pB0, pB1, m_reg, mnB, alB);
    __syncthreads(); SWAIT(); SWRITE(0, SE);
    RESC(alB); __syncthreads();
    SBAR(); qkt(pA0, pA1, K_lds, qr, r32, hi);
    finishSM(pB0, pB1, alB, l_reg, pa0, pa1, pa2, pa3); SBAR();
    if (j + 3 < NT) SLOAD(SE, (j + 3) * KVBLK); SBAR();
    pv_d0(o, vb0 + SHM_V, pa0, pa1, pa2, pa3); partialSM(pA0, pA1, m_reg, mnA, alA);
    __syncthreads(); SWAIT(); SWRITE(1, SO);
    RESC(alA); __syncthreads();
  }
  SBAR(); qkt(pB0, pB1, K_lds + SHM_K, qr, r32, hi);
  finishSM(pA0, pA1, alA, l_reg, pa0, pa1, pa2, pa3); SBAR();
  pv_d0(o, vb0, pa0, pa1, pa2, pa3); partialSM(pB0, pB1, m_reg, mnB, alB);
  __syncthreads(); RESC(alB);
  finishSM(pB0, pB1, alB, l_reg, pa0, pa1, pa2, pa3); SBAR();
  pv_d0(o, vb0 + SHM_V, pa0, pa1, pa2, pa3);
  if (hi == 0) li_l[r32] = l_reg; asm volatile("s_waitcnt lgkmcnt(0)" ::: "memory");
  float rli[16];
#pragma unroll
  for (int r = 0; r < 16; ++r) rli[r] = __builtin_amdgcn_rcpf(li_l[crow(r, hi)]);
  bf16_t* Ow = Ob + (long)(wid * QBLK) * 1024;
#pragma unroll
  for (int r = 0; r < 16; ++r) { const int orow = crow(r, hi);
#pragma unroll
    for (int d0 = 0; d0 < 4; ++d0) Ow[(long)orow * 1024 + d0 * 32 + r32] = (bf16_t)(cvtpk(o[d0][r] * rli[r], 0.f) & 0xffffu); }
  __syncthreads();
#undef SLOAD
#undef SWRITE
#undef SWAIT
#undef RESC
}
#undef SBAR
}


typedef GAS unsigned gu32;
#define RLX_AGENT __ATOMIC_RELAXED, __HIP_MEMORY_SCOPE_AGENT
#define XB_TMO      128
#define XB_XCNT(j)  (256  + 64 * (j))
#define XB_XSUB(j)  (1280 + 64 * (j))
#define XB_XGEN(j)  (2304 + 64 * (j))
#define XB_TOP      3328
#define XB_TOPGEN   3392
#define XCD_BAR_WORDS 3456
#define XB_SPIN_CAP (1u << 22)
__device__ __forceinline__ unsigned xb_ld(unsigned* p)              { return __hip_atomic_load(p, __ATOMIC_RELAXED, __HIP_MEMORY_SCOPE_AGENT); }
__device__ __forceinline__ unsigned xb_add(unsigned* p, unsigned v) { return __hip_atomic_fetch_add(p, v, __ATOMIC_RELAXED, __HIP_MEMORY_SCOPE_AGENT); }
__device__ __forceinline__ unsigned xb_xcc_id() { return (unsigned)__builtin_amdgcn_s_getreg((3 << 11) | 20) & 0xFu; }
#define XB_SPIN(cond, bar) do { unsigned _sp = 0; while (cond) { __builtin_amdgcn_s_sleep(1); \
    if ((++_sp & 255u) == 0u) { if (xb_ld(&(bar)[XB_TMO])) break; if (_sp > XB_SPIN_CAP) { atomicAdd(&(bar)[XB_TMO], 1u); break; } } } } while (0)
struct XcdBarrier { unsigned* bar; unsigned x; volatile LAS unsigned* st; };
__device__ __forceinline__ XcdBarrier xcd_barrier_post(unsigned* bar, volatile LAS unsigned* st) {
    XcdBarrier b; b.bar = bar; b.x = xb_xcc_id(); b.st = st;
    if (threadIdx.x == 0) (void)xb_add(&bar[XB_XCNT(b.x)], 1u);
    return b;
}
__device__ __forceinline__ void xcd_barrier_complete(unsigned* bar, unsigned x, unsigned& nloc, unsigned& nx) {
    const unsigned G = gridDim.x * gridDim.y * gridDim.z;
    unsigned sum, cnt, mine, sp = 0u;
    for (;;) {
        sum = 0u; cnt = 0u; mine = 0u;
#pragma unroll
        for (unsigned j = 0; j < 16; ++j) { const unsigned c = xb_ld(&bar[XB_XCNT(j)]); sum += c; cnt += (c > 0u) ? 1u : 0u; mine = (j == x) ? c : mine; }
        if (sum == G) break;
        __builtin_amdgcn_s_sleep(1);
        if ((++sp & 255u) == 0u) { if (xb_ld(&bar[XB_TMO])) break; if (sp > XB_SPIN_CAP) { atomicAdd(&bar[XB_TMO], 1u); break; } }
    }
    nloc = mine > 0u ? mine : 1u; nx = cnt > 0u ? cnt : 1u;
}
__device__ __forceinline__ void xcd_barrier(const XcdBarrier& b) {
    asm volatile("s_waitcnt vmcnt(0)" ::: "memory");
    __syncthreads();
    if (threadIdx.x == 0) {
        unsigned* bar = b.bar;
        __builtin_amdgcn_s_waitcnt(0);
        unsigned nloc = b.st[0], nx = b.st[1];
        if (nloc == 0u) { xcd_barrier_complete(bar, b.x, nloc, nx); b.st[0] = nloc; b.st[1] = nx; }
        const unsigned old = xb_add(&bar[XB_XSUB(b.x)], 1u);
        const unsigned gen = old / nloc;
        if (old + 1u == (gen + 1u) * nloc) {
            __builtin_amdgcn_fence(__ATOMIC_RELEASE, "agent");
            asm volatile("s_waitcnt vmcnt(0)" ::: "memory");
            const unsigned og = xb_add(&bar[XB_TOP], 1u);
            const unsigned tg = og / nx;
            if (og + 1u == (tg + 1u) * nx) xb_add(&bar[XB_TOPGEN], 1u);
            else XB_SPIN(xb_ld(&bar[XB_TOPGEN]) == tg, bar);
            __builtin_amdgcn_fence(__ATOMIC_ACQUIRE, "agent");
            xb_add(&bar[XB_XGEN(b.x)], 1u);
            asm volatile("s_waitcnt vmcnt(0)" ::: "memory");
        } else {
            XB_SPIN(xb_ld(&bar[XB_XGEN(b.x)]) == gen, bar);
            __builtin_amdgcn_fence(__ATOMIC_ACQUIRE, "agent");
            asm volatile("s_waitcnt vmcnt(0)" ::: "memory");
        }
    }
    __syncthreads();
}

struct Frame {
    LAS unsigned char* lds; char* ldsg;
    int tid, lane, wave, vcu, G;
    const Args* a;
};
#define INP(F, i, T) ((const T*)(F).a->in[i])
#define WSP(F, off, T) ((T*)((F).a->ws + (off)))

__device__ __forceinline__ void cvt_load(f32x4 (&v)[16], const float* __restrict__ W, int N, int nvalid, int k0, int n0, int lane) {
    const int kq = lane >> 4, nq = lane & 15;
    const unsigned voff = (unsigned)(kq * N + 4 * nq) * 4u;
#pragma unroll
    for (int i = 0; i < 16; ++i) {
        const char* Wu = (const char*)(W + (size_t)(k0 + 4 * i) * N + n0);
        if (4 * nq < nvalid) v[i] = __builtin_nontemporal_load((const f32x4*)(Wu + (size_t)voff)); else v[i] = (f32x4){0.f, 0.f, 0.f, 0.f};
    }
}
__device__ __forceinline__ void cvt_finish(const f32x4 (&v)[16], int k0, bf16_t* __restrict__ WT, int rowb, LAS unsigned char* scr, int lane) {
    const int kq = lane >> 4, nq = lane & 15;
    const int g = lane >> 4, i16 = lane & 15, q = i16 >> 2, p = i16 & 3;
    typedef short v4i16_t __attribute__((ext_vector_type(4)));
#pragma unroll
    for (int hf = 0; hf < 2; ++hf) {
#pragma unroll
        for (int i = 0; i < 8; ++i) {
            const int k = 4 * i + kq, s = ((k >> 1) & 1) | (((k >> 3) & 1) << 1);
            u32x2 w; w.x = cvtpk(v[8 * hf + i].x, v[8 * hf + i].y); w.y = cvtpk(v[8 * hf + i].z, v[8 * hf + i].w);
            *(LAS u32x2*)(scr + k * 128 + ((nq * 8) ^ (s << 5))) = w;
        }
        const int klo = 8 * g + q, s = ((klo >> 1) & 1) | (((klo >> 3) & 1) << 1);
#pragma unroll
        for (int nb = 0; nb < 4; ++nb) {
            const int a_lo = klo * 128 + (((16 * nb + 4 * p) * 2) ^ (s << 5));
            const s16x4 lo = __builtin_bit_cast(s16x4, __builtin_amdgcn_ds_read_tr16_b64_v4i16((LAS v4i16_t*)(scr + a_lo)));
            const s16x4 hi = __builtin_bit_cast(s16x4, __builtin_amdgcn_ds_read_tr16_b64_v4i16((LAS v4i16_t*)(scr + a_lo + 512)));
            bf16x8 o = {lo[0], lo[1], lo[2], lo[3], hi[0], hi[1], hi[2], hi[3]};
            char* Wu = (char*)(WT + (size_t)(rowb + 16 * nb) * 2048 + k0 + 32 * hf);
            __builtin_nontemporal_store(o, (bf16x8*)(Wu + (size_t)(unsigned)((i16 * 2048 + 8 * g) * 2)));
        }
    }
}
__device__ __forceinline__ void cvt_expert_decode(const Frame& F, int r, const float*& W, int& k0, int& n0, bf16_t*& WT, int& rowb) {
    constexpr int I_E = 16 * 32 * 32;
    const int mat = r / I_E; r -= mat * I_E;
    const int e = r >> 10, kt = (r >> 5) & 31, nt = r & 31;
    k0 = kt * 64; n0 = nt * 64;
    if (mat < 2) { W = INP(F, 24 + mat, float) + (size_t)e * 2048 * 2048; WT = WSP(F, WS_WGU, bf16_t); rowb = e * 4096 + (n0 >> 7) * 256 + mat * 128 + (n0 & 127); }
    else { W = INP(F, 26, float) + (size_t)e * 2048 * 2048; WT = WSP(F, WS_WD, bf16_t); rowb = e * 2048 + n0; }
}
constexpr int N_EXPERT_ITEMS = 3 * 16 * 32 * 32;
__device__ __forceinline__ void p0_prologue(Frame& F) {
    LAS unsigned char* scr = F.lds + F.wave * 4096;
    const int gw = F.vcu * 8 + F.wave, NGW = F.G * 8, lane = F.lane;
    const float* w_in = INP(F, 3, float); const float* w_out = INP(F, 21, float);
    bf16_t* WinT = WSP(F, WS_WIN, bf16_t); bf16_t* WoutT = WSP(F, WS_WOUT, bf16_t);
    constexpr int I_IN = 32 * 101, I_OUT = 32 * 32, NITEMS = I_IN + I_OUT;
    for (int it = gw; it < NITEMS; it += NGW) {
        f32x4 v[16];
        if (it < I_IN) { const int kt = it / 101, nt = it % 101; const int nv = (nt == 100) ? 32 : 64; cvt_load(v, w_in, IN_COLS, nv, kt * 64, nt * 64, lane); cvt_finish(v, kt * 64, WinT, nt * 64, scr, lane); }
        else { const int r = it - I_IN, kt = r >> 5, nt = r & 31; cvt_load(v, w_out, 2048, 64, kt * 64, nt * 64, lane); cvt_finish(v, kt * 64, WoutT, nt * 64, scr, lane); }
    }
#if !CVT_IN_SCAN
    for (int it = gw; it < N_EXPERT_ITEMS; it += NGW) {
        f32x4 v[16]; const float* W; int k0, n0, rowb; bf16_t* WT;
        cvt_expert_decode(F, it, W, k0, n0, WT, rowb); cvt_load(v, W, 2048, 64, k0, n0, lane); cvt_finish(v, k0, WT, rowb, scr, lane);
    }
#endif
    { u32x4 z = {0u, 0u, 0u, 0u}; u32x4* zp = (u32x4*)(WinT + (size_t)6464 * 2048); const int nz = 192 * 2048 * 2 / 16;
      for (int i = gw * 64 + lane; i < nz; i += NGW * 64) zp[i] = z; }
    { const float* x = INP(F, 0, float); const float* nw = INP(F, 2, float); bf16_t* H1 = WSP(F, WS_H1, bf16_t);
      for (int m = gw; m < MTOK; m += NGW) {
          const f32x4* xr = (const f32x4*)(x + (size_t)m * DM) + lane; f32x4 v[8]; float s = 0.f;
#pragma unroll
          for (int j = 0; j < 8; ++j) { v[j] = xr[64 * j]; s += (v[j].x * v[j].x + v[j].y * v[j].y) + (v[j].z * v[j].z + v[j].w * v[j].w); }
          const float rstd = 1.f / sqrtf(wave_sum(s) * (1.f / DM) + 1e-6f);
          u32x2* o8 = (u32x2*)(H1 + (size_t)m * DM) + lane;
#pragma unroll
          for (int j = 0; j < 8; ++j) { const f32x4 w = ((const f32x4*)nw)[lane + 64 * j]; u32x2 o; o.x = cvtpk(v[j].x * rstd * w.x, v[j].y * rstd * w.y); o.y = cvtpk(v[j].z * rstd * w.z, v[j].w * rstd * w.w); o8[64 * j] = o; }
      } }
    { const float* dup = INP(F, 12, float); const float* iup = INP(F, 14, float); const float* gup = INP(F, 15, float);
      bf16_t* DUt = WSP(F, WS_LORA, bf16_t); bf16_t* IUt = DUt + 2 * 1024 * 64; bf16_t* GUt = IUt + 2 * 1024 * 64;
      for (int i = gw * 64 + lane; i < 2 * 1024 * 64; i += NGW * 64) { const int j = i & 63, c = (i >> 6) & 1023, d = i >> 16;
          DUt[i] = (bf16_t)(cvtpk(dup[(size_t)(d * 64 + j) * 1024 + c], 0.f) & 0xffffu); IUt[i] = (bf16_t)(cvtpk(iup[(size_t)(d * 64 + j) * 1024 + c], 0.f) & 0xffffu); }
      for (int i = gw * 64 + lane; i < 1024 * 160; i += NGW * 64) { const int c = i / 160, j = i - c * 160; GUt[i] = (bf16_t)(cvtpk(gup[(size_t)j * 1024 + c], 0.f) & 0xffffu); } }
    { const int* pos = INP(F, 1, int); float* rope = WSP(F, WS_ROPE, float);
      const float invf[8] = {1.0f, 0.19392274474868576f, 0.03760603093086393f, 0.007292664737217109f, 0.001414213562373095f, 0.0002742481756762073f, 5.318295896944988e-05f, 1.031338537721246e-05f};
      for (int i = gw * 64 + lane; i < MTOK * 8; i += NGW * 64) { const int m = i >> 3, j = i & 7; float fj = invf[0];
#pragma unroll
          for (int q = 1; q < 8; ++q) fj = (j == q) ? invf[q] : fj;
          const float ang = (float)pos[m] * fj; rope[m * 16 + j] = cosf(ang); rope[m * 16 + 8 + j] = sinf(ang); } }
}

#define WS32(F, T, byteoff) (*(T*)((F).a->ws + (size_t)(unsigned)(byteoff)))
template <int CTRL> __device__ __forceinline__ float dpp_add(float x) {
    return x + __int_as_float(__builtin_amdgcn_update_dpp(0, __float_as_int(x), CTRL, 0xf, 0xf, false));
}
__device__ __forceinline__ float row16_allsum(float x) { x = dpp_add<0x128>(x); x = dpp_add<0x124>(x); x = dpp_add<0x122>(x); x = dpp_add<0x121>(x); return x; }
__device__ __forceinline__ bf16_t f2bf(float x) { return (bf16_t)(cvtpk(x, 0.f) & 0xffffu); }
__device__ __forceinline__ u32x4 ld_row16(const Frame& F, unsigned off, bool ok) { u32x4 r = {0u, 0u, 0u, 0u}; if (ok) r = WS32(F, const u32x4, off); return r; }
__device__ __forceinline__ void unpack8(const u32x4 w, float (&o)[8]) { o[0] = bf_lo(w.x); o[1] = bf_hi(w.x); o[2] = bf_lo(w.y); o[3] = bf_hi(w.y); o[4] = bf_lo(w.z); o[5] = bf_hi(w.z); o[6] = bf_lo(w.w); o[7] = bf_hi(w.w); }
__device__ __forceinline__ void ld8f(const float* p, float (&o)[8]) { const f32x4 a = ((const f32x4*)p)[0], b = ((const f32x4*)p)[1]; o[0] = a.x; o[1] = a.y; o[2] = a.z; o[3] = a.w; o[4] = b.x; o[5] = b.y; o[6] = b.z; o[7] = b.w; }
__device__ __forceinline__ u32x4 pack8(const float (&v)[8]) { return (u32x4){cvtpk(v[0], v[1]), cvtpk(v[2], v[3]), cvtpk(v[4], v[5]), cvtpk(v[6], v[7])}; }
__device__ __forceinline__ void p3_prep(Frame& F, const int mode = 0) {
    constexpr int AP = 296;
    LAS float* Zl = (LAS float*)F.lds;
    LAS bf16_t* Al = (LAS bf16_t*)(F.lds + 18432);
    constexpr int PP = 520, PA = 16 * PP;
    LAS bf16_t* Pl = (LAS bf16_t*)(F.lds + 18432 + 9472);
    const int tid = F.tid, lane = F.lane, w = F.wave;
    const bf16_t* DUt = WSP(F, WS_LORA, bf16_t); const bf16_t* IUt = DUt + 2 * 1024 * 64; const bf16_t* GUt = IUt + 2 * 1024 * 64;
    for (int tile = F.vcu; tile < MTOK / 16; tile += F.G) {
        const int m0 = tile * 16, t0 = m0 & (SEQ - 1);
        __syncthreads();
        for (int p = tid; p < 16 * 36; p += 512) {
            const int i = p / 36, ch = p - i * 36, zc = 3072 + 8 * ch, t = t0 + i;
            const unsigned off = (unsigned)WS_PROJ + ((unsigned)(m0 + i) * LDP + ZC0 + zc) * 2u;
            float c[8], pv[8], nx[8], mp[8], mn[8];
            unpack8(ld_row16(F, off, true), c); unpack8(ld_row16(F, off - LDP * 2u, t > 0), pv); unpack8(ld_row16(F, off + LDP * 2u, t < SEQ - 1), nx);
            ld8f(INP(F, 4, float) + zc, mp); ld8f(INP(F, 5, float) + zc, mn);
            LAS f32x4* zp = (LAS f32x4*)(Zl + i * 288 + 8 * ch); float z[8];
#pragma unroll
            for (int e = 0; e < 8; ++e) z[e] = c[e] + mp[e] * (pv[e] - c[e]) + mn[e] * (nx[e] - c[e]);
            zp[0] = (f32x4){z[0], z[1], z[2], z[3]}; zp[1] = (f32x4){z[4], z[5], z[6], z[7]};
        }
        __syncthreads();
        for (int e = tid; e < 16 * 288; e += 512) { const int i = e / 288, j = e - i * 288; float z = Zl[e];
            if (j < 64) z = 1.f - 2.f * __builtin_amdgcn_rcpf(__expf(2.f * z) + 1.f); else if (j >= 128) z = __builtin_amdgcn_rcpf(1.f + __expf(-z));
            Al[i * AP + j] = f2bf(z); }
        __syncthreads();
        if (mode == 1) continue;
#pragma unroll 1
        for (int hfi = 0; hfi < 2; ++hfi) {
            const int hf = (hfi + (F.vcu >> 2)) & 1;
            u32x4 rawr[4], rawk[4], rawv[4];
            { const unsigned off = (unsigned)WS_PROJ + ((unsigned)(m0 + 2 * w) * LDP + ZC0 + 512 * hf + 8 * (tid & 63)) * 2u;
#pragma unroll
              for (int rr = 0; rr < 4; ++rr) { const int t = t0 + 2 * w + rr - 1; const bool ok = (t >= 0) && (t < SEQ); const unsigned o = off + (unsigned)((rr - 1) * LDP * 2);
                  rawr[rr] = ld_row16(F, o, ok); rawk[rr] = ld_row16(F, o + 1024u * 2u, ok); rawv[rr] = ld_row16(F, o + 2048u * 2u, ok); } }
            {
                const int n16 = lane & 15, q4 = lane >> 4;
                bf16x8 af[9];
#pragma unroll
                for (int ks = 0; ks < 9; ++ks) af[ks] = *(const LAS bf16x8*)(Al + n16 * AP + 32 * ks + 8 * q4);
                struct BF { bf16x8 d0[2], d1[2], i0[2], i1[2], g[5]; };
#define LD_BF(X, nb_) do { const int cl_ = 512 * hf + 64 * w + 16 * (nb_) + n16; _Pragma("unroll") for (int ks = 0; ks < 2; ++ks) { \
                    X.d0[ks] = *(const bf16x8*)(DUt + (size_t)cl_ * 64 + 32 * ks + 8 * q4); X.d1[ks] = *(const bf16x8*)(DUt + (size_t)(1024 + cl_) * 64 + 32 * ks + 8 * q4); \
                    X.i0[ks] = *(const bf16x8*)(IUt + (size_t)cl_ * 64 + 32 * ks + 8 * q4); X.i1[ks] = *(const bf16x8*)(IUt + (size_t)(1024 + cl_) * 64 + 32 * ks + 8 * q4); } \
                    _Pragma("unroll") for (int ks = 0; ks < 5; ++ks) X.g[ks] = *(const bf16x8*)(GUt + (size_t)cl_ * 160 + 32 * ks + 8 * q4); } while (0)
#define DO_NB(X, nb_) do { const int ch_ = 64 * w + 16 * (nb_); \
                    f32x4 aw0 = {0.f, 0.f, 0.f, 0.f}, aw1 = aw0, aa0 = aw0, aa1 = aw0, ag = aw0; \
                    _Pragma("unroll") for (int ks = 0; ks < 2; ++ks) { \
                        aw0 = __builtin_amdgcn_mfma_f32_16x16x32_bf16(X.d0[ks], af[ks], aw0, 0, 0, 0); aw1 = __builtin_amdgcn_mfma_f32_16x16x32_bf16(X.d1[ks], af[ks], aw1, 0, 0, 0); \
                        aa0 = __builtin_amdgcn_mfma_f32_16x16x32_bf16(X.i0[ks], af[2 + ks], aa0, 0, 0, 0); aa1 = __builtin_amdgcn_mfma_f32_16x16x32_bf16(X.i1[ks], af[2 + ks], aa1, 0, 0, 0); } \
                    _Pragma("unroll") for (int ks = 0; ks < 5; ++ks) ag = __builtin_amdgcn_mfma_f32_16x16x32_bf16(X.g[ks], af[4 + ks], ag, 0, 0, 0); \
                    LAS bf16_t* pp = Pl + n16 * PP + ch_ + 4 * q4; \
                    *(LAS u32x2*)(pp) = (u32x2){cvtpk(aw0[0], aw0[1]), cvtpk(aw0[2], aw0[3])}; *(LAS u32x2*)(pp + PA) = (u32x2){cvtpk(aw1[0], aw1[1]), cvtpk(aw1[2], aw1[3])}; \
                    *(LAS u32x2*)(pp + 2 * PA) = (u32x2){cvtpk(aa0[0], aa0[1]), cvtpk(aa0[2], aa0[3])}; *(LAS u32x2*)(pp + 3 * PA) = (u32x2){cvtpk(aa1[0], aa1[1]), cvtpk(aa1[2], aa1[3])}; \
                    *(LAS u32x2*)(pp + 4 * PA) = (u32x2){cvtpk(ag[0], ag[1]), cvtpk(ag[2], ag[3])}; } while (0)
                const int rot = F.vcu & 3;
                BF fa, fb; LD_BF(fa, (0 + rot) & 3); LD_BF(fb, (1 + rot) & 3);
                DO_NB(fa, (0 + rot) & 3); LD_BF(fa, (2 + rot) & 3); DO_NB(fb, (1 + rot) & 3); LD_BF(fb, (3 + rot) & 3); DO_NB(fa, (2 + rot) & 3); DO_NB(fb, (3 + rot) & 3);
#undef LD_BF
#undef DO_NB
            }
            __syncthreads();
            {
                const int chk = tid & 63, c = 512 * hf + 8 * chk;
                float r4[4][8], k4[4][8], v4[4][8];
#pragma unroll
                for (int rr = 0; rr < 4; ++rr) { unpack8(rawr[rr], r4[rr]); unpack8(rawk[rr], k4[rr]); unpack8(rawv[rr], v4[rr]); }
                float zr[2][8], zk[2][8], zv[2][8];
                { float mp[8], mn[8];
                  ld8f(INP(F, 4, float) + c, mp); ld8f(INP(F, 5, float) + c, mn);
#pragma unroll
                  for (int tk = 0; tk < 2; ++tk)
#pragma unroll
                      for (int e = 0; e < 8; ++e) zr[tk][e] = r4[tk + 1][e] + mp[e] * (r4[tk][e] - r4[tk + 1][e]) + mn[e] * (r4[tk + 2][e] - r4[tk + 1][e]);
                  ld8f(INP(F, 4, float) + 1024 + c, mp); ld8f(INP(F, 5, float) + 1024 + c, mn);
#pragma unroll
                  for (int tk = 0; tk < 2; ++tk)
#pragma unroll
                      for (int e = 0; e < 8; ++e) zk[tk][e] = k4[tk + 1][e] + mp[e] * (k4[tk][e] - k4[tk + 1][e]) + mn[e] * (k4[tk + 2][e] - k4[tk + 1][e]);
                  ld8f(INP(F, 4, float) + 2048 + c, mp); ld8f(INP(F, 5, float) + 2048 + c, mn);
#pragma unroll
                  for (int tk = 0; tk < 2; ++tk)
#pragma unroll
                      for (int e = 0; e < 8; ++e) zv[tk][e] = v4[tk + 1][e] + mp[e] * (v4[tk][e] - v4[tk + 1][e]) + mn[e] * (v4[tk + 2][e] - v4[tk + 1][e]); }
                float kkw[8], w00[8], w01[8], a00[8], a01[8], kac[8], rkc[8];
                ld8f(INP(F, 16, float) + c, kkw); ld8f(INP(F, 11, float) + c, w00); ld8f(INP(F, 11, float) + 1024 + c, w01);
                ld8f(INP(F, 13, float) + c, a00); ld8f(INP(F, 13, float) + 1024 + c, a01); ld8f(INP(F, 17, float) + c, kac); ld8f(INP(F, 18, float) + c, rkc);
#pragma unroll 1
                for (int tk = 0; tk < 2; ++tk) {
                    const int tkn = 2 * w + tk; const unsigned o = (unsigned)(m0 + tkn) * 1024u + (unsigned)c;
                    const LAS bf16_t* pp = Pl + tkn * PP + 8 * chk;
                    float zrt[8], zkt[8], zvt[8];
#pragma unroll
                    for (int e = 0; e < 8; ++e) { zrt[e] = tk ? zr[1][e] : zr[0][e]; zkt[e] = tk ? zk[1][e] : zk[0][e]; zvt[e] = tk ? zv[1][e] : zv[0][e]; }
                    WS32(F, u32x4, (unsigned)WS_R + o * 2u) = pack8(zrt); WS32(F, u32x4, (unsigned)WS_V + o * 2u) = pack8(zvt);
                    float kk[8];
                    { float ss = 0.f;
#pragma unroll
                      for (int e = 0; e < 8; ++e) { kk[e] = zkt[e] * kkw[e]; ss += kk[e] * kk[e]; }
                      ss += __shfl_xor(ss, 1); ss += __shfl_xor(ss, 2); ss += __shfl_xor(ss, 4);
                      const float inv = 1.f / fmaxf(sqrtf(ss), 1e-12f);
#pragma unroll
                      for (int e = 0; e < 8; ++e) kk[e] *= inv;
                      WS32(F, u32x4, (unsigned)WS_KK + o * 2u) = pack8(kk); }
                    {
                        float pw0[8], pw1[8], d0[8], d1[8];
                        unpack8(*(const LAS u32x4*)(pp), pw0); unpack8(*(const LAS u32x4*)(pp + PA), pw1);
#pragma unroll
                        for (int e = 0; e < 8; ++e) {
                            d0[e] = 0.6065306597126334f * __builtin_amdgcn_rcpf(1.f + __expf(-(w00[e] + pw0[e]))); d1[e] = 0.6065306597126334f * __builtin_amdgcn_rcpf(1.f + __expf(-(w01[e] + pw1[e]))); }
                        WS32(F, u32x4, (unsigned)WS_WDEC + o * 2u) = pack8(d0); WS32(F, u32x4, (unsigned)WS_WDEC + ((unsigned)(MTOK * 1024) + o) * 2u) = pack8(d1);
                    }
                    {
                        float pa0[8], pa1[8], kd0[8], kd1[8], b0v[8], b1v[8]; float bs = 0.f;
                        unpack8(*(const LAS u32x4*)(pp + 2 * PA), pa0); unpack8(*(const LAS u32x4*)(pp + 3 * PA), pa1);
#pragma unroll
                        for (int e = 0; e < 8; ++e) {
                            const float av0 = __builtin_amdgcn_rcpf(1.f + __expf(-(a00[e] + pa0[e]))), av1 = __builtin_amdgcn_rcpf(1.f + __expf(-(a01[e] + pa1[e])));
                            kd0[e] = zkt[e] * (1.f + (av0 - 1.f) * kac[e]); kd1[e] = zkt[e] * (1.f + (av1 - 1.f) * kac[e]);
                            b0v[e] = kk[e] * av0; b1v[e] = kk[e] * av1;
                            bs += zrt[e] * (kd0[e] + kd1[e]) * rkc[e]; }
                        bs += __shfl_xor(bs, 1); bs += __shfl_xor(bs, 2); bs += __shfl_xor(bs, 4);
                        if ((chk & 7) == 0) WS32(F, float, (unsigned)WS_BONUS + ((unsigned)(m0 + tkn) * 16u + (unsigned)(8 * hf + (chk >> 3))) * 4u) = bs;
                        WS32(F, u32x4, (unsigned)WS_KD + o * 2u) = pack8(kd0); WS32(F, u32x4, (unsigned)WS_KD + ((unsigned)(MTOK * 1024) + o) * 2u) = pack8(kd1);
                        WS32(F, u32x4, (unsigned)WS_BB + o * 2u) = pack8(b0v); WS32(F, u32x4, (unsigned)WS_BB + ((unsigned)(MTOK * 1024) + o) * 2u) = pack8(b1v);
                    }
                    WS32(F, u32x4, (unsigned)WS_G + o * 2u) = *(const LAS u32x4*)(pp + 4 * PA);
                }
            }
            __syncthreads();
        }
    }
}

__device__ __forceinline__ void p4_scan(Frame& F, const int mode = 0) {
    constexpr int CH = 32, NCH = SEQ / CH;
    constexpr int VEC = CH * 64 * 4;
    constexpr int BUF = 5 * VEC + CH * 32 * 4;
    constexpr int YOFF = 2 * BUF, YB = CH * 32 * 4;
    constexpr int CVT_SCR = 2 * BUF + 2 * YB;
    const bf16_t* Wdec = WSP(F, WS_WDEC, bf16_t); const bf16_t* KDg = WSP(F, WS_KD, bf16_t); const bf16_t* BBg = WSP(F, WS_BB, bf16_t);
    const bf16_t* Rg = WSP(F, WS_R, bf16_t); const bf16_t* KKg = WSP(F, WS_KK, bf16_t); const bf16_t* Vg = WSP(F, WS_V, bf16_t); bf16_t* YS = WSP(F, WS_YS, bf16_t);
    const int tid = F.tid, lane = F.lane, wid = F.wave;
    const bool is_comp = wid < 4;
    const int ri = wid & 3;
    if (is_comp) __builtin_amdgcn_s_setprio(3);
    const int g = lane >> 3, j = lane & 7, rowl = ri * 8 + g;
    const int mt = ri * 64 + lane, mw = ri;
    int cvt_it = F.vcu * 4 + mw; f32x4 cvv[16]; int ck0 = 0, crowb = 0; bf16_t* cWT = nullptr; bool cvt_pending = false;
    f32x4 cvvB[16]; int ck0B = 0, crowbB = 0; bf16_t* cWTB = nullptr; bool cvt_pendingB = false;
    LAS unsigned char* cscr = F.lds + CVT_SCR + (mw & 3) * 4096;
    LAS unsigned* st_cnt = (LAS unsigned*)(F.lds + CVT_SCR + 4 * 4096); LAS unsigned* cons_cnt = st_cnt + 16;
    for (int item = F.vcu; item < 256; item += F.G) {
        const int chain = item >> 1, half = item & 1, d = chain >> 6, b = (chain >> 4) & 3, h = chain & 15;
        const size_t sh = (size_t)b * SEQ * 1024 + h * 64, pd = (size_t)d * MTOK * 1024 + sh;
        f32x2 S2[4] = {{0.f, 0.f}, {0.f, 0.f}, {0.f, 0.f}, {0.f, 0.f}};
        u32x2 rw[2], rkk[2], rbb[2], rkd[2], rr[2]; unsigned rv[2];
        const int cstep = d ? -CH * 1024 : CH * 1024;
        unsigned po[2], pv[2];
#pragma unroll
        for (int q_ = 0; q_ < 2; ++q_) { const int sl_ = mt + 256 * q_, ss_ = sl_ >> 4, sk_ = (sl_ & 15) * 4, tq_ = d ? (SEQ - 1 - ss_) : ss_; po[q_] = (unsigned)(tq_ * 1024 + sk_); pv[q_] = (unsigned)(tq_ * 1024 + half * 32 + 2 * (sl_ & 15)); }
        const char* bW = (const char*)(Wdec + pd); const char* bKK = (const char*)(KKg + sh); const char* bBB = (const char*)(BBg + pd); const char* bKD = (const char*)(KDg + pd); const char* bR = (const char*)(Rg + sh); const char* bV = (const char*)(Vg + sh);
#define SC_LOAD(c) do { const unsigned cu_ = (unsigned)((c) * cstep); _Pragma("unroll") for (int q_ = 0; q_ < 2; ++q_) { const unsigned e_ = po[q_] + cu_; \
        rw[q_] = *(const u32x2*)(bW + (size_t)(e_ * 2u)); rkk[q_] = *(const u32x2*)(bKK + (size_t)(e_ * 2u)); rbb[q_] = *(const u32x2*)(bBB + (size_t)(e_ * 2u)); rkd[q_] = *(const u32x2*)(bKD + (size_t)(e_ * 2u)); rr[q_] = *(const u32x2*)(bR + (size_t)(e_ * 2u)); \
        rv[q_] = *(const unsigned*)(bV + (size_t)((pv[q_] + cu_) * 2u)); } } while (0)
#define SC_STORE(bufi) do { LAS unsigned char* bp_ = F.lds + (bufi) * BUF; _Pragma("unroll") for (int q_ = 0; q_ < 2; ++q_) { const int sl_ = mt + 256 * q_, ss_ = sl_ >> 4, sk_ = (sl_ & 15) * 4; const int o_ = (ss_ * 64 + sk_) * 4; \
        *(LAS f32x4*)(bp_ + o_) = (f32x4){__expf(-bf_lo(rw[q_].x)), __expf(-bf_hi(rw[q_].x)), __expf(-bf_lo(rw[q_].y)), __expf(-bf_hi(rw[q_].y))}; \
        *(LAS f32x4*)(bp_ + VEC + o_) = (f32x4){bf_lo(rkk[q_].x), bf_hi(rkk[q_].x), bf_lo(rkk[q_].y), bf_hi(rkk[q_].y)}; \
        *(LAS f32x4*)(bp_ + 2 * VEC + o_) = (f32x4){bf_lo(rbb[q_].x), bf_hi(rbb[q_].x), bf_lo(rbb[q_].y), bf_hi(rbb[q_].y)}; \
        *(LAS f32x4*)(bp_ + 3 * VEC + o_) = (f32x4){bf_lo(rkd[q_].x), bf_hi(rkd[q_].x), bf_lo(rkd[q_].y), bf_hi(rkd[q_].y)}; \
        *(LAS f32x4*)(bp_ + 4 * VEC + o_) = (f32x4){bf_lo(rr[q_].x), bf_hi(rr[q_].x), bf_lo(rr[q_].y), bf_hi(rr[q_].y)}; \
        *(LAS f32x2*)(bp_ + 5 * VEC + (ss_ * 32 + 2 * (sl_ & 15)) * 4) = (f32x2){bf_lo(rv[q_]), bf_hi(rv[q_])}; } } while (0)
#define Y_OUT(c) do { const int ys_ = mt >> 3, yr_ = (mt & 7) * 4; const int tt_ = (c) * CH + ys_, t_ = d ? (SEQ - 1 - tt_) : tt_; \
        const f32x4 yv_ = *(const LAS f32x4*)(F.lds + YOFF + ((c) & 1) * YB + (ys_ * 32 + yr_) * 4); \
        *(u32x2*)(YS + pd + (size_t)t_ * 1024 + half * 32 + yr_) = (u32x2){cvtpk(yv_.x, yv_.y), cvtpk(yv_.z, yv_.w)}; } while (0)
#define SC_WAIT(cnt_, tgt_) do { for (;;) { const u32x4 q_ = *(volatile LAS u32x4*)(cnt_); const unsigned a_ = q_.x < q_.y ? q_.x : q_.y, b_ = q_.z < q_.w ? q_.z : q_.w; \
        if ((a_ < b_ ? a_ : b_) >= (tgt_)) break; if (is_comp) __builtin_amdgcn_s_sleep(1); else __builtin_amdgcn_s_sleep(12); } asm volatile("" ::: "memory"); } while (0)
#define SC_SIGNAL(cnt_, val_) do { asm volatile("s_waitcnt lgkmcnt(0)" ::: "memory"); if (lane == 0) *(volatile LAS unsigned*)((cnt_) + ri) = (val_); } while (0)
        __syncthreads();
        if (tid < 4) { st_cnt[tid] = 0u; cons_cnt[tid] = 0u; }
        if (!is_comp) { SC_LOAD(0); SC_STORE(0); SC_LOAD(1); }
        __syncthreads();
        if (is_comp) {
          for (int c = 0; c < NCH; ++c) {
            SC_WAIT(st_cnt, (unsigned)c);
            if (mode != 2) {
                const LAS unsigned char* bp = F.lds + (c & 1) * BUF;
                LAS float* yb = (LAS float*)(F.lds + YOFF + (c & 1) * YB);
                f32x4 cw_[2], ckk[2], cbb[2], ckd[2], cr[2]; float cv;
#define SC_RD(s_) do { const int o_ = ((s_) * 64 + j * 8) * 4; cw_[0] = *(const LAS f32x4*)(bp + o_); cw_[1] = *(const LAS f32x4*)(bp + o_ + 16); ckk[0] = *(const LAS f32x4*)(bp + VEC + o_); ckk[1] = *(const LAS f32x4*)(bp + VEC + o_ + 16); \
                cbb[0] = *(const LAS f32x4*)(bp + 2 * VEC + o_); cbb[1] = *(const LAS f32x4*)(bp + 2 * VEC + o_ + 16); ckd[0] = *(const LAS f32x4*)(bp + 3 * VEC + o_); ckd[1] = *(const LAS f32x4*)(bp + 3 * VEC + o_ + 16); \
                cr[0] = *(const LAS f32x4*)(bp + 4 * VEC + o_); cr[1] = *(const LAS f32x4*)(bp + 4 * VEC + o_ + 16); cv = *(const LAS float*)(bp + 5 * VEC + ((s_) * 32 + rowl) * 4); } while (0)
#define H2(v_, i_) ((f32x2){v_[(i_) >> 1][((i_) & 1) * 2], v_[(i_) >> 1][((i_) & 1) * 2 + 1]})
                SC_RD(0);
                float yk = 0.f;
#pragma unroll
                for (int s = 0; s < CH; ++s) {
                    f32x4 w[2] = {cw_[0], cw_[1]}, kk[2] = {ckk[0], ckk[1]}, bb[2] = {cbb[0], cbb[1]}, kd[2] = {ckd[0], ckd[1]}, r[2] = {cr[0], cr[1]}; const float v = cv;
                    if (s + 1 < CH) SC_RD(s + 1);
                    f32x2 pa = S2[0] * H2(kk, 0), pb = S2[1] * H2(kk, 1); pa = S2[2] * H2(kk, 2) + pa; pb = S2[3] * H2(kk, 3) + pb; pa = pa + pb;
                    const f32x2 vv = {v, v};
                    f32x2 u[4];
#pragma unroll
                    for (int i = 0; i < 4; ++i) u[i] = S2[i] * H2(w, i) + vv * H2(kd, i);
                    float p = pa.x + pa.y;
                    p = dpp_add<0xB1>(p); p = dpp_add<0x4E>(p); p = dpp_add<0x141>(p);
                    const f32x2 sa = {-p, -p};
#pragma unroll
                    for (int i = 0; i < 4; ++i) S2[i] = sa * H2(bb, i) + u[i];
                    f32x2 ya = S2[0] * H2(r, 0), yc = S2[1] * H2(r, 1); ya = S2[2] * H2(r, 2) + ya; yc = S2[3] * H2(r, 3) + yc; ya = ya + yc;
                    float y = ya.x + ya.y;
                    y = dpp_add<0xB1>(y); y = dpp_add<0x4E>(y); y = dpp_add<0x141>(y);
                    yk = (j == (s & 7)) ? y : yk;
                    if ((s & 7) == 7) yb[((s & 24) + j) * 32 + rowl] = yk;
                }
#undef SC_RD
#undef H2
            }
            SC_SIGNAL(cons_cnt, (unsigned)(c + 1));
          }
        } else {
#define MEM_DUTIES(c_) do { SC_WAIT(cons_cnt, (unsigned)(c_)); if ((c_) >= 1 && mode != 2) Y_OUT((c_) - 1); if ((c_) + 1 < NCH) SC_STORE(((c_) + 1) & 1); SC_SIGNAL(st_cnt, (unsigned)((c_) + 1)); if ((c_) + 2 < NCH) SC_LOAD((c_) + 2); } while (0)
#define CVT_LOAD_SET(V_, K0_, WT_, RB_) do { const int it_ = cvt_it < N_EXPERT_ITEMS ? cvt_it : N_EXPERT_ITEMS - 1; const float* cW_; int cn0_; cvt_expert_decode(F, it_, cW_, K0_, cn0_, WT_, RB_); cvt_load(V_, cW_, 2048, 64, K0_, cn0_, lane); cvt_it += F.G * 4; } while (0)
          int ngrp = 0; { const int left = (N_EXPERT_ITEMS - cvt_it + F.G * 4 - 1) / (F.G * 4); ngrp = left > 0 ? left / 3 : 0; if (ngrp > NCH / 4) ngrp = NCH / 4; }
          int cg = 0;
#pragma unroll 1
          for (; cg < 4 * ngrp; cg += 4) {
            MEM_DUTIES(cg);
#if CVT_IN_SCAN
            if (cg > 0) cvt_finish(cvv, ck0, cWT, crowb, cscr, lane);
            CVT_LOAD_SET(cvv, ck0, cWT, crowb);
#endif
            MEM_DUTIES(cg + 1);
#if CVT_IN_SCAN
            CVT_LOAD_SET(cvvB, ck0B, cWTB, crowbB);
#endif
            MEM_DUTIES(cg + 2);
#if CVT_IN_SCAN
            cvt_finish(cvv, ck0, cWT, crowb, cscr, lane);
            CVT_LOAD_SET(cvv, ck0, cWT, crowb);
#endif
            MEM_DUTIES(cg + 3);
#if CVT_IN_SCAN
            cvt_finish(cvvB, ck0B, cWTB, crowbB, cscr, lane);
#endif
          }
#if CVT_IN_SCAN
          if (ngrp > 0) cvt_finish(cvv, ck0, cWT, crowb, cscr, lane);
#endif
#pragma unroll 1
          for (; cg < NCH; ++cg) MEM_DUTIES(cg);
#undef MEM_DUTIES
#undef CVT_LOAD_SET
          SC_WAIT(cons_cnt, (unsigned)NCH);
        }
        if (!is_comp && mode != 2) Y_OUT(NCH - 1);
#undef SC_LOAD
#undef SC_STORE
#undef Y_OUT
#undef SC_WAIT
#undef SC_SIGNAL
    }
    __builtin_amdgcn_s_setprio(0);
#if CVT_IN_SCAN
    if (!is_comp) {
        for (; cvt_it < N_EXPERT_ITEMS; cvt_it += F.G * 4) {
            const float* W; int k0, n0, rowb; bf16_t* WT;
            cvt_expert_decode(F, cvt_it, W, k0, n0, WT, rowb); cvt_load(cvv, W, 2048, 64, k0, n0, lane); cvt_finish(cvv, k0, WT, rowb, cscr, lane);
        }
    }
#endif
}

__device__ __forceinline__ void p5_finalize(Frame& F) {
    const bf16_t* OC = WSP(F, WS_OC, bf16_t); const bf16_t* YS = WSP(F, WS_YS, bf16_t); const bf16_t* Vg = WSP(F, WS_V, bf16_t); const bf16_t* Gg = WSP(F, WS_G, bf16_t);
    const float* BON = WSP(F, WS_BONUS, float); bf16_t* MIX = WSP(F, WS_MIX, bf16_t);
    const float* subw = INP(F, 10, float); const float* lnw = INP(F, 19, float); const float* lnb = INP(F, 20, float);
    const int lane = F.lane, gw = F.vcu * 8 + F.wave, NGW = F.G * 8;
    float lam;
    { const float q1 = INP(F, 6, float)[lane] * INP(F, 7, float)[lane], q2 = INP(F, 8, float)[lane] * INP(F, 9, float)[lane];
      lam = __expf(wave_sum(q1)) - __expf(wave_sum(q2)) + 0.2f; }
    const int c0 = lane * 16;
    float sw[16], lw[16], lb[16];
#pragma unroll
    for (int i = 0; i < 16; ++i) { sw[i] = subw[(c0 + i) & 127] * 0.8f; lw[i] = lnw[c0 + i]; lb[i] = lnb[c0 + i]; }
    for (int m = gw; m < MTOK; m += NGW) {
        { const u32x4* p0 = (const u32x4*)(OC + (size_t)m * 1024 + c0); const u32x4* p1 = (const u32x4*)(OC + (size_t)MTOK * 1024 + (size_t)m * 1024 + c0);
          const u32x4 a0 = p0[0], a1 = p0[1], b0 = p1[0], b1 = p1[1];
          float dv[16]; const unsigned aw[8] = {a0.x, a0.y, a0.z, a0.w, a1.x, a1.y, a1.z, a1.w}, bw[8] = {b0.x, b0.y, b0.z, b0.w, b1.x, b1.y, b1.z, b1.w};
          float ssq = 0.f;
#pragma unroll
          for (int i = 0; i < 8; ++i) { dv[2 * i] = bf_lo(aw[i]) - lam * bf_lo(bw[i]); dv[2 * i + 1] = bf_hi(aw[i]) - lam * bf_hi(bw[i]); ssq += dv[2 * i] * dv[2 * i] + dv[2 * i + 1] * dv[2 * i + 1]; }
          ssq += __shfl_xor(ssq, 1); ssq += __shfl_xor(ssq, 2); ssq += __shfl_xor(ssq, 4);
          const float rstd = 1.f / sqrtf(ssq * (1.f / 128.f) + 1e-5f);
          unsigned ow[8];
#pragma unroll
          for (int i = 0; i < 8; ++i) ow[i] = cvtpk(dv[2 * i] * rstd * sw[2 * i], dv[2 * i + 1] * rstd * sw[2 * i + 1]);
          u32x4* op = (u32x4*)(MIX + (size_t)m * 2048 + c0); op[0] = (u32x4){ow[0], ow[1], ow[2], ow[3]}; op[1] = (u32x4){ow[4], ow[5], ow[6], ow[7]}; }
        { const u32x4* y0 = (const u32x4*)(YS + (size_t)m * 1024 + c0); const u32x4* y1 = (const u32x4*)(YS + (size_t)MTOK * 1024 + (size_t)m * 1024 + c0);
          float y[16]; float s = 0.f;
          { const u32x4 a0 = y0[0], a1 = y0[1], b0 = y1[0], b1 = y1[1];
            const unsigned aw[8] = {a0.x, a0.y, a0.z, a0.w, a1.x, a1.y, a1.z, a1.w}, bw[8] = {b0.x, b0.y, b0.z, b0.w, b1.x, b1.y, b1.z, b1.w};
#pragma unroll
            for (int i = 0; i < 8; ++i) { y[2 * i] = bf_lo(aw[i]) + bf_lo(bw[i]); y[2 * i + 1] = bf_hi(aw[i]) + bf_hi(bw[i]); } }
#pragma unroll
          for (int i = 0; i < 16; ++i) s += y[i];
          s += __shfl_xor(s, 1); s += __shfl_xor(s, 2);
          const float mu = s * (1.f / 64.f); float q = 0.f;
#pragma unroll
          for (int i = 0; i < 16; ++i) { y[i] -= mu; q += y[i] * y[i]; }
          q += __shfl_xor(q, 1); q += __shfl_xor(q, 2);
          const float rstd = 1.f / sqrtf(q * (1.f / 64.f) + 64e-5f);
          const float bon = BON[(size_t)m * 16 + (lane >> 2)];
          const u32x4* vp = (const u32x4*)(Vg + (size_t)m * 1024 + c0); const u32x4* gp = (const u32x4*)(Gg + (size_t)m * 1024 + c0);
          const u32x4 v0 = vp[0], v1 = vp[1], g0 = gp[0], g1 = gp[1];
          const unsigned vw[8] = {v0.x, v0.y, v0.z, v0.w, v1.x, v1.y, v1.z, v1.w}, gq[8] = {g0.x, g0.y, g0.z, g0.w, g1.x, g1.y, g1.z, g1.w};
          unsigned ow[8];
#pragma unroll
          for (int i = 0; i < 8; ++i) {
              const float e0 = (y[2 * i] * rstd * lw[2 * i] + lb[2 * i] + bon * bf_lo(vw[i])) * bf_lo(gq[i]);
              const float e1 = (y[2 * i + 1] * rstd * lw[2 * i + 1] + lb[2 * i + 1] + bon * bf_hi(vw[i])) * bf_hi(gq[i]);
              ow[i] = cvtpk(e0, e1); }
          u32x4* op = (u32x4*)(MIX + (size_t)m * 2048 + 1024 + c0); op[0] = (u32x4){ow[0], ow[1], ow[2], ow[3]}; op[1] = (u32x4){ow[4], ow[5], ow[6], ow[7]}; }
    }
}

__device__ __forceinline__ void p7_router(Frame& F) {
    const bf16_t* X1 = WSP(F, WS_X1, bf16_t); const float* nw = INP(F, 22, float); const float* wr = INP(F, 23, float);
    bf16_t* H2 = WSP(F, WS_H2, bf16_t); float* AFF = WSP(F, WS_AFF, float);
    const int lane = F.lane, tid = F.tid, gw = F.vcu * 8 + F.wave, NGW = F.G * 8;
    volatile LAS unsigned* MISC = (volatile LAS unsigned*)(F.lds + MISC_OFF);
    const unsigned m8 = MISC[8], m9 = MISC[9];
    __syncthreads();
    for (int f = tid; f < 2048 * 4; f += 512) { const int col = f >> 2, q = f & 3; *(LAS f32x4*)(F.lds + (col >> 2) * 272 + (col & 3) * 64 + q * 16) = *(const f32x4*)(wr + (size_t)col * 16 + 4 * q); }
    __syncthreads();
    for (int pr = gw; pr < MTOK / 2; pr += NGW) {
        const int m = 2 * pr;
        const u32x2* xr0 = (const u32x2*)(X1 + (size_t)m * DM) + lane; const u32x2* xr1 = xr0 + DM / 4;
        f32x4 v0[8], v1[8]; float s0 = 0.f, s1 = 0.f;
#pragma unroll
        for (int j = 0; j < 8; ++j) { const u32x2 a_ = xr0[64 * j], b_ = xr1[64 * j]; v0[j] = (f32x4){bf_lo(a_.x), bf_hi(a_.x), bf_lo(a_.y), bf_hi(a_.y)}; v1[j] = (f32x4){bf_lo(b_.x), bf_hi(b_.x), bf_lo(b_.y), bf_hi(b_.y)}; }
#pragma unroll
        for (int j = 0; j < 8; ++j) { s0 += (v0[j].x * v0[j].x + v0[j].y * v0[j].y) + (v0[j].z * v0[j].z + v0[j].w * v0[j].w); s1 += (v1[j].x * v1[j].x + v1[j].y * v1[j].y) + (v1[j].z * v1[j].z + v1[j].w * v1[j].w); }
        const float r0 = 1.f / sqrtf(wave_sum(s0) * (1.f / DM) + 1e-6f), r1 = 1.f / sqrtf(wave_sum(s1) * (1.f / DM) + 1e-6f);
        u32x2* o0 = (u32x2*)(H2 + (size_t)m * DM) + lane; u32x2* o1 = o0 + DM / 4;
        float acc[32];
#pragma unroll
        for (int i = 0; i < 32; ++i) acc[i] = 0.f;
#pragma unroll
        for (int j = 0; j < 8; ++j) {
            const f32x4 w = ((const f32x4*)nw)[lane + 64 * j];
            const f32x4 a = v0[j] * w * r0, b = v1[j] * w * r1;
            u32x2 oa; oa.x = cvtpk(a.x, a.y); oa.y = cvtpk(a.z, a.w); o0[64 * j] = oa;
            u32x2 ob; ob.x = cvtpk(b.x, b.y); ob.y = cvtpk(b.z, b.w); o1[64 * j] = ob;
            const LAS f32x4* wp = (const LAS f32x4*)(F.lds + (lane + 64 * j) * 272);
#pragma unroll
            for (int i = 0; i < 4; ++i) {
#pragma unroll
                for (int q = 0; q < 4; ++q) { const f32x4 ww = wp[i * 4 + q];
#pragma unroll
                    for (int e = 0; e < 4; ++e) { acc[4 * q + e] += a[i] * ww[e]; acc[16 + 4 * q + e] += b[i] * ww[e]; } }
                asm volatile("" ::: "memory");
            }
        }
#define RSTAGE(N_, B_) do { const bool up_ = (lane & (B_)) != 0; _Pragma("unroll") for (int k = 0; k < (N_); ++k) { const float lo_ = acc[k], hi_ = acc[(N_) + k]; \
            const float snd_ = up_ ? lo_ : hi_, kp_ = up_ ? hi_ : lo_; acc[k] = kp_ + __shfl_xor(snd_, (B_)); } } while (0)
        RSTAGE(16, 32); RSTAGE(8, 16); RSTAGE(4, 8); RSTAGE(2, 4); RSTAGE(1, 2);
#undef RSTAGE
        float lg = acc[0] + __shfl_xor(acc[0], 1);
        float mx = lg;
        mx = fmaxf(mx, __shfl_xor(mx, 2)); mx = fmaxf(mx, __shfl_xor(mx, 4)); mx = fmaxf(mx, __shfl_xor(mx, 8)); mx = fmaxf(mx, __shfl_xor(mx, 16));
        const float p = expf(lg - mx);
        float den = p; den += __shfl_xor(den, 2); den += __shfl_xor(den, 4); den += __shfl_xor(den, 8); den += __shfl_xor(den, 16);
        if ((lane & 1) == 0) { const int row = lane >> 5, e = (lane >> 1) & 15, mm = m + row; AFF[((size_t)(mm >> 11) * 16 + e) * SEQ + (mm & (SEQ - 1))] = p / den; }
    }
    __syncthreads();
    if (tid == 0) { MISC[8] = m8; MISC[9] = m9; }
    __syncthreads();
}

__device__ __forceinline__ int wave_count4(bool f0, bool f1, bool f2, bool f3) {
    return __builtin_popcountll(__ballot(f0)) + __builtin_popcountll(__ballot(f1)) + __builtin_popcountll(__ballot(f2)) + __builtin_popcountll(__ballot(f3));
}
__device__ __forceinline__ void p8_select(Frame& F) {
    const float* AFF = WSP(F, WS_AFF, float); const bf16_t* H2 = WSP(F, WS_H2, bf16_t);
    int* XEIDX = WSP(F, WS_XEIDX, int); float* GATEX = WSP(F, WS_GATEX, float); int* SLOT = WSP(F, WS_SLOT, int);
    LAS int* part = (LAS int*)F.lds;
    LAS unsigned* cnt = (LAS unsigned*)(F.lds + 256);
    LAS unsigned* list = (LAS unsigned*)(F.lds + 512);
    const int tid = F.tid, lane = F.lane, w = F.wave;
    for (int item = F.vcu; item < 256; item += F.G) {
        const int be = item >> 2, q = item & 3, b = be >> 4, e = be & 15;
        __syncthreads();
        if (tid == 0) *cnt = 0u;
        const f32x4 a4 = ((const f32x4*)(AFF + (size_t)be * SEQ))[tid];
        const unsigned u0 = __float_as_uint(a4.x), u1 = __float_as_uint(a4.y), u2 = __float_as_uint(a4.z), u3 = __float_as_uint(a4.w);
        unsigned lo = 0u, hi = 0x7f800001u;
        int itn = 0;
        while (hi - lo > 1u) {
            const unsigned mid = lo + ((hi - lo) >> 1);
            const int c = wave_count4(u0 >= mid, u1 >= mid, u2 >= mid, u3 >= mid);
            LAS int* pp = part + (itn & 1) * 8;
            if (lane == 0) pp[w] = c;
            __syncthreads();
            int tot = 0;
#pragma unroll
            for (int i = 0; i < 8; ++i) tot += pp[i];
            if (tot >= CAP) lo = mid; else hi = mid;
            ++itn;
        }
        const unsigned T = lo;
        const bool g0 = u0 > T, g1 = u1 > T, g2 = u2 > T, g3 = u3 > T, q0 = u0 == T, q1 = u1 == T, q2 = u2 == T, q3 = u3 == T;
        const unsigned long long bg0 = __ballot(g0), bg1 = __ballot(g1), bg2 = __ballot(g2), bg3 = __ballot(g3), bq0 = __ballot(q0), bq1 = __ballot(q1), bq2 = __ballot(q2), bq3 = __ballot(q3);
        const unsigned long long below = (lane == 0) ? 0ull : (~0ull >> (64 - lane));
        int pg = __builtin_popcountll(bg0 & below) + __builtin_popcountll(bg1 & below) + __builtin_popcountll(bg2 & below) + __builtin_popcountll(bg3 & below);
        int pq = __builtin_popcountll(bq0 & below) + __builtin_popcountll(bq1 & below) + __builtin_popcountll(bq2 & below) + __builtin_popcountll(bq3 & below);
        const int wg = __builtin_popcountll(bg0) + __builtin_popcountll(bg1) + __builtin_popcountll(bg2) + __builtin_popcountll(bg3);
        const int wq = __builtin_popcountll(bq0) + __builtin_popcountll(bq1) + __builtin_popcountll(bq2) + __builtin_popcountll(bq3);
        if (lane == 0) { part[16 + w] = wg; part[32 + w] = wq; }
        __syncthreads();
        int gtc = 0, baseg = 0, baseq = 0;
#pragma unroll
        for (int i = 0; i < 8; ++i) { const int x = part[16 + i], y = part[32 + i]; gtc += x; if (i < w) { baseg += x; baseq += y; } }
        const int need = CAP - gtc;
        pg += baseg; pq += baseq;
        if ((w >> 1) == q) {
            const bool gs[4] = {g0, g1, g2, g3}, qs[4] = {q0, q1, q2, q3}; const float av[4] = {a4.x, a4.y, a4.z, a4.w};
            int cg_ = pg, cq_ = pq;
#pragma unroll
            for (int i = 0; i < 4; ++i) {
                const int t = 4 * tid + i, m = b * SEQ + t; int slot = -1;
                if (gs[i]) { slot = cg_; ++cg_; } else if (qs[i]) { if (cq_ < need) slot = gtc + cq_; ++cq_; }
                SLOT[m * 16 + e] = slot;
                if (slot >= 0) { GATEX[(e * 4 + b) * CAP + slot] = av[i]; XEIDX[(e * 4 + b) * CAP + slot] = m; }
            }
        }
    }
}

__device__ __forceinline__ void p11_final(Frame& F) {
    const bf16_t* X1 = WSP(F, WS_X1, bf16_t); const bf16_t* YE = WSP(F, WS_YE, bf16_t); const int* SLOT = WSP(F, WS_SLOT, int); const float* nw = INP(F, 27, float);
    float* out = F.a->out;
    const int lane = F.lane, gw = F.vcu * 8 + F.wave, NGW = F.G * 8;
    for (int m = gw; m < MTOK; m += NGW) {
        const int b = m >> 11;
        float v[32];
        { const u32x4* xr = (const u32x4*)(X1 + (size_t)m * DM + lane * 8);
#pragma unroll
          for (int j = 0; j < 4; ++j) { const u32x4 a = xr[64 * j]; v[8 * j] = bf_lo(a.x); v[8 * j + 1] = bf_hi(a.x); v[8 * j + 2] = bf_lo(a.y); v[8 * j + 3] = bf_hi(a.y); v[8 * j + 4] = bf_lo(a.z); v[8 * j + 5] = bf_hi(a.z); v[8 * j + 6] = bf_lo(a.w); v[8 * j + 7] = bf_hi(a.w); } }
        int sl = (lane < 16) ? SLOT[m * 16 + lane] : -1;
        for (int e = 0; e < 16; ++e) {
            const int s = __shfl(sl, e);
            if (s >= 0) { const u32x4* yr = (const u32x4*)(YE + (size_t)((e * 4 + b) * CAP + s) * DM + lane * 8);
#pragma unroll
                for (int j = 0; j < 4; ++j) { const u32x4 w = yr[64 * j];
                    v[8 * j] += bf_lo(w.x); v[8 * j + 1] += bf_hi(w.x); v[8 * j + 2] += bf_lo(w.y); v[8 * j + 3] += bf_hi(w.y); v[8 * j + 4] += bf_lo(w.z); v[8 * j + 5] += bf_hi(w.z); v[8 * j + 6] += bf_lo(w.w); v[8 * j + 7] += bf_hi(w.w); } }
        }
        float s = 0.f;
#pragma unroll
        for (int i = 0; i < 32; ++i) s += v[i] * v[i];
        const float rstd = 1.f / sqrtf(wave_sum(s) * (1.f / DM) + 1e-6f);
#pragma unroll
        for (int j = 0; j < 4; ++j) { const int col = 512 * j + lane * 8; const f32x4 w0 = *(const f32x4*)(nw + col), w1 = *(const f32x4*)(nw + col + 4);
            f32x4 o0 = {v[8 * j] * rstd * w0.x, v[8 * j + 1] * rstd * w0.y, v[8 * j + 2] * rstd * w0.z, v[8 * j + 3] * rstd * w0.w};
            f32x4 o1 = {v[8 * j + 4] * rstd * w1.x, v[8 * j + 5] * rstd * w1.y, v[8 * j + 6] * rstd * w1.z, v[8 * j + 7] * rstd * w1.w};
            *(f32x4*)(out + (size_t)m * DM + col) = o0; *(f32x4*)(out + (size_t)m * DM + col + 4) = o1; }
    }
}


template <int PHM> __global__ void __launch_bounds__(512, 2) mk_fwd(Args args) {
    extern __shared__ __attribute__((aligned(16))) unsigned char lds[];
    Frame F;
    F.lds = (LAS unsigned char*)lds; F.ldsg = (char*)lds; F.a = &args;
    F.tid = threadIdx.x; F.lane = F.tid & 63; F.wave = __builtin_amdgcn_readfirstlane(F.tid >> 6);
    F.G = gridDim.x; { const int bx = blockIdx.x; F.vcu = (F.G % 8 == 0) ? (bx % 8) * (F.G / 8) + bx / 8 : bx; }
    volatile LAS unsigned* MISC = (volatile LAS unsigned*)(F.lds + MISC_OFF);
    for (int u = F.tid; u < (LDS_BYTES - 131072) / 4; u += 512) ((LAS unsigned*)(F.lds + 131072))[u] = 0u;
    __syncthreads();
    gu32* ctl = (gu32*)(args.ws + WS_CTL);
    XcdBarrier bar; bar.bar = (unsigned*)(ctl + CW_BAR); bar.x = 0; bar.st = nullptr;
    if (MK_N_LAUNCHES == 1) bar = xcd_barrier_post((unsigned*)(ctl + CW_BAR), MISC + 8);
    const int lo = args.ph_lo, hi = args.ph_hi;
#define IN(k) (((PHM >> (k)) & 1) && lo <= (k) && (k) < hi)
#ifndef DUP_MASK
#define DUP_MASK 0
#endif
#define REP(k) for (int rep_ = 0; rep_ < 1 + ((DUP_MASK >> (k)) & 1); ++rep_)
#define SEAM(k) do { if (IN(k) && IN((k) + 1)) xcd_barrier(bar); } while (0)

    if (IN(0)) REP(0) { p0_prologue(F); }
    SEAM(0);
    if (IN(1)) REP(1) {
        pg8::Gemm g{WSP(F, WS_H1, bf16_t), WSP(F, WS_WIN, bf16_t), MTOK, LDP, DM, DM}; pg8::StaticOrder S; S.init(MTOK, LDP, F.G, (int)blockIdx.x);
        pg8::EpiProj E{WSP(F, WS_PROJ, bf16_t), LDP, WSP(F, WS_ROPE, float), QSCALE};
        pg8::gemm_phase<pg8::EpiProj, pg8::StaticOrder, true, true>(F.lds, g, S, E);
    }
    SEAM(1);
    if (IN(2)) REP(2) {
        const bf16_t* P = WSP(F, WS_PROJ, bf16_t); bf16_t* OC = WSP(F, WS_OC, bf16_t);
        for (int u = F.vcu * 2; u < 512; u += F.G * 2)
            for (int i = 0; i < 2; ++i) {
                const int uu = u + i, qb = uu & 7, c = (uu >> 3) & 1, h = (uu >> 4) & 7, b = uu >> 7;
                const size_t m0 = (size_t)b * SEQ;
                att::attn_unit<LDP>(P + (m0 + qb * 256) * LDP + h * 128 + c * 64, P + m0 * LDP + 1024 + h * 128 + c * 64, P + m0 * LDP + 2048 + h * 128,
                                    OC + (size_t)c * MTOK * 1024 + (m0 + qb * 256) * 1024 + h * 128, SEQ, F.ldsg);
            }
    }
    if (IN(3)) REP(3) { p3_prep(F, rep_ ? 1 : 0); }
    SEAM(3);
    #ifndef SCAN_PROBE
#define SCAN_PROBE 0
#endif
    if (IN(4)) REP(4) { p4_scan(F, rep_ ? SCAN_PROBE : 0); }
    SEAM(4);
    if (IN(5)) REP(5) { p5_finalize(F); }
    SEAM(5);
    if (IN(6)) REP(6) {
        pg8::Gemm g{WSP(F, WS_MIX, bf16_t), WSP(F, WS_WOUT, bf16_t), MTOK, DM, DM, DM}; pg8::StaticOrder S; S.init(MTOK, DM, F.G, (int)blockIdx.x);
        pg8::EpiResid E{INP(F, 0, float), WSP(F, WS_X1, bf16_t), DM};
        pg8::gemm_phase<pg8::EpiResid, pg8::StaticOrder, true, true>(F.lds, g, S, E);
    }
    SEAM(6);
    if (IN(7)) REP(7) { p7_router(F); }
    SEAM(7);
    if (IN(8)) REP(8) { p8_select(F); }
    SEAM(8);
    if (IN(9)) REP(9) {
        pg8::Gemm g{WSP(F, WS_H2, bf16_t), WSP(F, WS_WGU, bf16_t), 16384, 65536, DM, DM}; pg8::MoeOrderT<true> S{F.G, F.vcu, 16, 1024, WSP(F, WS_XEIDX, int)};
        pg8::EpiSwiglu E{WSP(F, WS_HID, bf16_t), 16};
        pg8::gemm_phase<pg8::EpiSwiglu, pg8::MoeOrderT<true>, true, true>(F.lds, g, S, E);
    }
    SEAM(9);
    if (IN(10)) REP(10) {
        pg8::Gemm g{WSP(F, WS_HID, bf16_t), WSP(F, WS_WD, bf16_t), 16384, 32768, DM, DM}; pg8::MoeOrderT<false> S{F.G, F.vcu, 8, 512, nullptr};
        pg8::EpiDown E{WSP(F, WS_YE, bf16_t), WSP(F, WS_GATEX, float), 8};
        pg8::gemm_phase<pg8::EpiDown, pg8::MoeOrderT<false>, true, true>(F.lds, g, S, E);
    }
    SEAM(10);
    if (IN(11)) REP(11) { p11_final(F); }
#undef IN
#undef SEAM
}

static const void* kfn(int li) {
#if MK_N_LAUNCHES == 1
    (void)li; return (const void*)mk_fwd<0xFFF>;
#else
    switch (li) {
        case 0: return (const void*)mk_fwd<1>; case 1: return (const void*)mk_fwd<2>; case 2: return (const void*)mk_fwd<4>; case 3: return (const void*)mk_fwd<8>;
        case 4: return (const void*)mk_fwd<16>; case 5: return (const void*)mk_fwd<32>; case 6: return (const void*)mk_fwd<64>; case 7: return (const void*)mk_fwd<128>;
        case 8: return (const void*)mk_fwd<256>; case 9: return (const void*)mk_fwd<512>; case 10: return (const void*)mk_fwd<1024>; default: return (const void*)mk_fwd<2048>;
    }
#endif
}
extern "C" void kernel_launch(void* const* d_in, const int* in_sizes, int n_in, void* d_out, int out_size, void* d_ws, size_t ws_size, hipStream_t stream) {
    static int grid = 0;
    if (grid == 0) {
        if (n_in != 28 || out_size != MTOK * DM || ws_size < WS_END) { fprintf(stderr, "kernel_launch: unexpected shapes: n_in %d out %d ws %zu (need >= %zu)\n", n_in, out_size, ws_size, (size_t)WS_END); grid = -1; return; }
        int dev = 0, cus = 0, per_cu = 0;
        if (hipGetDevice(&dev) != hipSuccess || hipDeviceGetAttribute(&cus, hipDeviceAttributeMultiprocessorCount, dev) != hipSuccess) { fprintf(stderr, "kernel_launch: device query failed\n"); grid = -1; return; }
        for (int i = 0; i < MK_N_LAUNCHES; ++i) if (hipFuncSetAttribute(kfn(i), hipFuncAttributeMaxDynamicSharedMemorySize, LDS_BYTES) != hipSuccess) { fprintf(stderr, "kernel_launch: hipFuncSetAttribute failed\n"); grid = -1; return; }
        if (hipOccupancyMaxActiveBlocksPerMultiprocessor(&per_cu, kfn(0), 512, LDS_BYTES) != hipSuccess || per_cu < 1) { fprintf(stderr, "kernel_launch: occupancy query says %d blocks/CU\n", per_cu); }
        (void)hipGetLastError();
        grid = cus;
    }
    if (grid < 0) return;
    if (hipMemsetAsync((char*)d_ws + WS_CTL, 0, CTL_ZERO_BYTES, stream) != hipSuccess) { fprintf(stderr, "kernel_launch: memset failed\n"); return; }
    Args a{};
    for (int i = 0; i < 28; ++i) a.in[i] = d_in[i];
    a.out = (float*)d_out; a.ws = (unsigned char*)d_ws;
    const int nl = MK_N_LAUNCHES;
    for (int li = 0; li < nl; ++li) {
        a.ph_lo = (nl == 1) ? 0 : li; a.ph_hi = (nl == 1) ? N_PHASES : li + 1; a.li = li;
        void* kargs[] = {&a};
        (void)hipLaunchKernel(kfn(li), dim3(grid), dim3(512), kargs, LDS_BYTES, stream);
        const hipError_t le = hipPeekAtLastError();
        if (le != hipSuccess) { fprintf(stderr, "kernel_launch: launch %d failed: %s\n", li, hipGetErrorName(le)); break; }
    }
}
```

```cpp
#include <hip/hip_runtime.h>
#include <hip/hip_bf16.h>
#include <cstdio>
#include <cstdint>

#ifndef MK_N_LAUNCHES
#define MK_N_LAUNCHES 1
#endif
#ifndef CVT_IN_SCAN
#define CVT_IN_SCAN 1
#endif
constexpr int N_PHASES = 12;

constexpr int BATCH = 4, SEQ = 2048, DM = 2048, MTOK = BATCH * SEQ;
constexpr int IN_COLS = 6432, LDP = 6656;
constexpr int ZC0 = 3072;
constexpr int RW = 1024, NH_R = 16, HD_R = 64;
constexpr int NEXP = 16, CAP = 256, FF = 2048;
constexpr float QSCALE = 0.18033688011112042f;

constexpr size_t MiB = 1u << 20;
constexpr size_t WS_CTL = 0, CTL_ZERO_BYTES = 1 * MiB;
constexpr size_t WS_ROPE = 1 * MiB;
constexpr size_t WS_LORA = 2 * MiB;
constexpr size_t WS_AFF = 3 * MiB;
constexpr size_t WS_GATEX = 3 * MiB + 512 * 1024;
constexpr size_t WS_SLOT = 4 * MiB;
constexpr size_t WS_XEIDX = 6 * MiB;
constexpr size_t WS_BONUS = 5 * MiB;
constexpr size_t WS_WIN = 8 * MiB;
constexpr size_t WS_WOUT = 34 * MiB;
constexpr size_t WS_WGU = 48 * MiB;
constexpr size_t WS_WD = 304 * MiB;
constexpr size_t WS_H1 = 432 * MiB;
constexpr size_t WS_PROJ = 464 * MiB;
constexpr size_t WS_R = 568 * MiB, WS_KK = 584 * MiB, WS_V = 600 * MiB;
constexpr size_t WS_WDEC = 616 * MiB;
constexpr size_t WS_KD = 680 * MiB, WS_BB = 712 * MiB;
constexpr size_t WS_G = 744 * MiB;
constexpr size_t WS_OC = 760 * MiB;
constexpr size_t WS_YS = 792 * MiB;
constexpr size_t WS_MIX = 856 * MiB;
constexpr size_t WS_X1 = 888 * MiB;
constexpr size_t WS_H2 = 952 * MiB;
constexpr size_t WS_HID = 528 * MiB, WS_YE = 592 * MiB;
constexpr size_t WS_END = 984 * MiB;
constexpr int CW_BAR = 4096;

constexpr int LDS_BYTES = 147456;
constexpr int MISC_OFF = 131072 + 320;

#define GAS __attribute__((address_space(1)))
#define LAS __attribute__((address_space(3)))
typedef unsigned short bf16_t;
typedef float f32x4 __attribute__((ext_vector_type(4)));
typedef float f32x2 __attribute__((ext_vector_type(2)));
typedef float f32x16 __attribute__((ext_vector_type(16)));
typedef unsigned u32x4 __attribute__((ext_vector_type(4)));
typedef unsigned u32x2 __attribute__((ext_vector_type(2)));
typedef short bf16x8 __attribute__((ext_vector_type(8)));
typedef short s16x4 __attribute__((ext_vector_type(4)));
typedef __bf16 bf16x2_t __attribute__((ext_vector_type(2)));

__device__ __forceinline__ unsigned cvtpk(float lo, float hi) { f32x2 v = {lo, hi}; bf16x2_t b = __builtin_convertvector(v, bf16x2_t); return __builtin_bit_cast(unsigned, b); }
__device__ __forceinline__ float bf_lo(unsigned w) { return __uint_as_float(w << 16); }
__device__ __forceinline__ float bf_hi(unsigned w) { return __uint_as_float(w & 0xffff0000u); }
__device__ __forceinline__ float bf2f(bf16_t v) { return __uint_as_float((unsigned)v << 16); }
__device__ __forceinline__ float wave_sum(float v) {
#pragma unroll
    for (int o = 1; o < 64; o <<= 1) v += __shfl_xor(v, o);
    return v;
}
__device__ __forceinline__ float sigmoidf_(float x) { return 1.f / (1.f + __expf(-x)); }

struct Args { const void* in[28]; float* out; unsigned char* ws; int ph_lo, ph_hi, li, pad; };

namespace pg8 {
#define PG8_LAS __attribute__((address_space(3)))
typedef unsigned short bf16_t;
typedef short bf16x8 __attribute__((ext_vector_type(8)));
typedef float f32x4 __attribute__((ext_vector_type(4)));
typedef unsigned u32x4 __attribute__((ext_vector_type(4)));
typedef unsigned u32x2 __attribute__((ext_vector_type(2)));
typedef int i32x4 __attribute__((ext_vector_type(4)));
typedef int i32x8 __attribute__((ext_vector_type(8)));
typedef float f32x8 __attribute__((ext_vector_type(8)));
typedef float f32x32 __attribute__((ext_vector_type(32)));
constexpr int BM = 256, BK = 64, HALF = 128, HTB = HALF * BK * 2  , STAGE_BYTES = 8 * HTB, NXCD = 8, WGM = 8;

__host__ __device__ __forceinline__ int lds_byte(int r, int c) { const int st = (r >> 4) * 2 + (c >> 5), rr = r & 15, cc = c & 31, ob = rr * 64 + cc * 2; return st * 1024 + (ob ^ (((ob >> 9) & 1) << 5)); }
__host__ __device__ __forceinline__ void stage_rc(int b, int& R, int& C) { const int st = b / 1024, sb = b % 1024, swz = sb ^ (((sb >> 9) & 1) << 5); R = (st >> 1) * 16 + swz / 64; C = (st & 1) * 32 + (swz % 64) / 2; }
__host__ __device__ __forceinline__ int perm32(int rho) { const int n = rho >> 4, i = rho & 15; return 8 * (i >> 2) + 4 * n + (i & 3); }

struct Unit { int pm, pn, pk; };
struct Gemm { const bf16_t* A; const bf16_t* Bt; int M, N, K, Kp; };

struct StaticOrder {
    int nM, nN, nwg, G, c;
    __host__ __device__ void init(int M, int N, int G_, int c_) { nM = M / BM; nN = N / BM; nwg = nM * nN; G = G_; c = c_; }
    __host__ __device__ bool next(int i, Unit& u) const {
        const long L = (long)i * G + c; if (L >= nwg) return false;
        int wgid = (int)L; { const int q = nwg / NXCD, r = nwg % NXCD, xcd = wgid % NXCD, off = wgid / NXCD; wgid = (xcd < r ? xcd * (q + 1) : r * (q + 1) + (xcd - r) * q) + off; }
        const int nig = WGM * nN, gid = wgid / nig, fm = gid * WGM, gsz = (nM - fm) < WGM ? (nM - fm) : WGM;
        u.pm = fm + ((wgid % nig) % gsz); u.pn = (wgid % nig) / gsz; u.pk = 0; return true;
    }
    static constexpr bool GATHER = false;
    __device__ __forceinline__ int arow(const Unit&, int) const { return 0; }
    __device__ __forceinline__ void a_ready(const Unit&) const {}
    __device__ __forceinline__ void done(const Unit&) const {}
};


typedef float f32x2 __attribute__((ext_vector_type(2)));
typedef __bf16 bf16x2_t __attribute__((ext_vector_type(2)));
__device__ __forceinline__ unsigned cvt_pk_bf16(float lo, float hi) { f32x2 v = {lo, hi}; bf16x2_t b = __builtin_convertvector(v, bf16x2_t); return __builtin_bit_cast(unsigned, b); }

template <bool GATHER_> struct MoeOrderT {
    static constexpr bool GATHER = GATHER_;
    int G, vcu, npn, total; const int* idx;
    __device__ __forceinline__ int arow(const Unit& u, int r) const { return idx[u.pm * BM + r]; }
    __device__ bool next(int i, Unit& u) const {
        const int L = i * G + vcu; if (L >= total) return false;
        const int per_e = 4 * npn, e = L / per_e, r = L % per_e;
        u.pm = e * 4 + (r & 3); u.pn = e * npn + (r >> 2); u.pk = 0; return true;
    }
    __device__ __forceinline__ void a_ready(const Unit&) const {}
    __device__ __forceinline__ void done(const Unit&) const {}
};

struct EpiProj {
    static constexpr bool PERM = true, AFTER_DRAIN = false;
    bf16_t* P; int ldp; const float* rope; float qscale;
    __device__ __forceinline__ void operator()(const f32x4 (&acc)[2][2][4][2], const Unit& u, int wr, int wc, int fr, int fq) const {
        const int row0 = u.pm * BM + wr * 64 + fr, colt = u.pn * BM, col0 = colt + wc * 32 + 8 * fq;
        const bool ropew = (colt < 2048) && ((wc & 1) == 0);
        const float sc = (colt < 1024) ? qscale : 1.f, sgn = (fq == 0) ? -1.f : 1.f;
#pragma unroll
        for (int ai = 0; ai < 2; ++ai)
#pragma unroll
            for (int m = 0; m < 4; ++m) {
                const int row = row0 + ai * HALF + m * 16;
                f32x4 c0 = {1.f, 1.f, 1.f, 1.f}, c1 = c0, s0 = {0.f, 0.f, 0.f, 0.f}, s1 = s0;
                if (ropew) { const f32x4* rp = (const f32x4*)(rope + (size_t)row * 16); c0 = rp[0]; c1 = rp[1]; s0 = rp[2]; s1 = rp[3]; }
                bf16_t* rowp = P + (size_t)row * ldp + col0;
#pragma unroll
                for (int bj = 0; bj < 2; ++bj) {
                    f32x4 v0 = acc[ai][bj][m][0], v1 = acc[ai][bj][m][1];
                    if (ropew) {
                        f32x4 p0, p1;
#pragma unroll
                        for (int i = 0; i < 4; ++i) { p0[i] = __shfl_xor(v0[i], 16); p1[i] = __shfl_xor(v1[i], 16); }
                        if (fq < 2) { v0 = v0 * c0 + (p0 * s0) * sgn; v1 = v1 * c1 + (p1 * s1) * sgn; }
                    }
                    v0 = v0 * sc; v1 = v1 * sc;
                    u32x4 w; w.x = cvt_pk_bf16(v0[0], v0[1]); w.y = cvt_pk_bf16(v0[2], v0[3]); w.z = cvt_pk_bf16(v1[0], v1[1]); w.w = cvt_pk_bf16(v1[2], v1[3]);
                    *(u32x4*)(rowp + bj * HALF) = w;
                }
            }
    }
};

struct EpiResid {
    static constexpr bool PERM = true, AFTER_DRAIN = false;
    const float* base; bf16_t* out; int ldc;
    __device__ __forceinline__ void operator()(const f32x4 (&acc)[2][2][4][2], const Unit& u, int wr, int wc, int fr, int fq) const {
        const int row0 = u.pm * BM + wr * 64 + fr, col0 = u.pn * BM + wc * 32 + 8 * fq;
#pragma unroll
        for (int ai = 0; ai < 2; ++ai)
#pragma unroll
            for (int m = 0; m < 4; ++m) {
                const size_t off = (size_t)(row0 + ai * HALF + m * 16) * ldc + col0;
#pragma unroll
                for (int bj = 0; bj < 2; ++bj) { const f32x4 b0 = *(const f32x4*)(base + off + bj * HALF), b1 = *(const f32x4*)(base + off + bj * HALF + 4);
                    const f32x4 v0 = b0 + acc[ai][bj][m][0], v1 = b1 + acc[ai][bj][m][1];
                    u32x4 w; w.x = cvt_pk_bf16(v0[0], v0[1]); w.y = cvt_pk_bf16(v0[2], v0[3]); w.z = cvt_pk_bf16(v1[0], v1[1]); w.w = cvt_pk_bf16(v1[2], v1[3]);
                    *(u32x4*)(out + off + bj * HALF) = w; }
            }
    }
};

__device__ __forceinline__ float clamp8(float x) { return __builtin_fminf(__builtin_fmaxf(x, -448.f), 448.f); }
__device__ __forceinline__ unsigned cvt4_fp8(float a, float b, float c, float d) {
    int w = __builtin_amdgcn_cvt_pk_fp8_f32(clamp8(a), clamp8(b), 0, false); w = __builtin_amdgcn_cvt_pk_fp8_f32(clamp8(c), clamp8(d), w, true); return (unsigned)w; }
constexpr float W8_SCALE = 64.f, W8_DESCALE = 1.f / 64.f;

struct EpiSwiglu {
    static constexpr bool PERM = true, AFTER_DRAIN = false;
    unsigned char* H; int npn;
    __device__ __forceinline__ void operator()(const f32x4 (&acc)[2][2][4][2], const Unit& u, int wr, int wc, int fr, int fq) const {
        const int row0 = u.pm * BM + wr * 64 + fr, pnl = u.pn % npn, col0 = pnl * HALF + wc * 32 + 8 * fq;
#pragma unroll
        for (int ai = 0; ai < 2; ++ai)
#pragma unroll
            for (int m = 0; m < 4; ++m) {
                unsigned char* rowp = H + (size_t)(row0 + ai * HALF + m * 16) * 2048 + col0;
                float h[8];
#pragma unroll
                for (int n = 0; n < 2; ++n)
#pragma unroll
                    for (int i = 0; i < 4; ++i) { const float g = acc[ai][0][m][n][i] * W8_DESCALE, up = acc[ai][1][m][n][i] * W8_DESCALE; h[n * 4 + i] = g * up * __builtin_amdgcn_rcpf(1.f + __expf(-g)); }
                u32x2 w; w.x = cvt4_fp8(h[0], h[1], h[2], h[3]); w.y = cvt4_fp8(h[4], h[5], h[6], h[7]);
                *(u32x2*)rowp = w;
            }
    }
};

struct EpiDown {
    static constexpr bool PERM = true, AFTER_DRAIN = false;
    bf16_t* Y; const float* gate; int npn;
    __device__ __forceinline__ void operator()(const f32x4 (&acc)[2][2][4][2], const Unit& u, int wr, int wc, int fr, int fq) const {
        const int row0 = u.pm * BM + wr * 64 + fr, pnl = u.pn % npn, col0 = pnl * BM + wc * 32 + 8 * fq;
#pragma unroll
        for (int ai = 0; ai < 2; ++ai)
#pragma unroll
            for (int m = 0; m < 4; ++m) {
                const int row = row0 + ai * HALF + m * 16; const float gt = gate[row] * W8_DESCALE;
                bf16_t* rowp = Y + (size_t)row * 2048 + col0;
#pragma unroll
                for (int bj = 0; bj < 2; ++bj) { const f32x4 v0 = acc[ai][bj][m][0] * gt, v1 = acc[ai][bj][m][1] * gt;
                    u32x4 w; w.x = cvt_pk_bf16(v0[0], v0[1]); w.y = cvt_pk_bf16(v0[2], v0[3]); w.z = cvt_pk_bf16(v1[0], v1[1]); w.w = cvt_pk_bf16(v1[2], v1[3]);
                    *(u32x4*)(rowp + bj * HALF) = w; }
            }
    }
};

template <class Epi, class Sched, bool ALIGN_EPI = false, bool SP2 = false, bool FP8 = false>
__device__ __forceinline__ void gemm_phase(PG8_LAS unsigned char* lds, const Gemm g, const Sched& S, const Epi& E) {
    const int tid = threadIdx.x, wid = __builtin_amdgcn_readfirstlane(tid >> 6), lane = tid & 63, wr = wid >> 2, wc = wid & 3, fr = lane & 15, fq = lane >> 4;
    const int K = g.Kp, nt = g.K / BK;
    const size_t kslice = (size_t)g.K * 2;
    unsigned voffA[2], voffB[2];
#pragma unroll
    for (int i = 0; i < 2; ++i) { int R, C; stage_rc(tid * 16 + i * 8192, R, C); const int Rb = Epi::PERM ? ((R & ~31) + perm32(R & 31)) : R;
        voffA[i] = (unsigned)(R * K + C) * 2u; voffB[i] = (unsigned)(Rb * K + C) * 2u; }
    static_assert(!Sched::GATHER || SP2, "gathered A rows: SP2 loop only");
    const size_t kstep = (size_t)(BK * 2);
    const size_t hstep = (size_t)HALF * K * 2;
    const size_t tstep = 2 * hstep;
    const unsigned ldsw = (unsigned)wid * 1024u;
    const int aoff = lds_byte(wr * 64 + fr, fq * 8), boff = lds_byte(wc * 32 + fr, fq * 8);
#define PG8_SA(b, h) (((b) * 2 + (h)) * HTB)
#define PG8_SB(b, h) ((4 + (b) * 2 + (h)) * HTB)
#define PG8_STAGE(bufoff, gbase, voff) do { _Pragma("unroll") for (int _i = 0; _i < 2; ++_i) \
        __builtin_amdgcn_global_load_lds((const unsigned*)((const char*)(gbase) + (voff)[_i]), (PG8_LAS unsigned*)(lds + (bufoff) + ldsw + _i * 8192), 16, 0, 0); } while (0)
#define PG8_LDA(dst, b, h) do { _Pragma("unroll") for (int m = 0; m < 4; ++m) _Pragma("unroll") for (int k = 0; k < 2; ++k) dst[m][k] = *(const PG8_LAS bf16x8*)(lds + PG8_SA(b, h) + aoff + m * 2048 + k * 1024); } while (0)
#define PG8_LDB(dst, b, h) do { _Pragma("unroll") for (int n = 0; n < 2; ++n) _Pragma("unroll") for (int k = 0; k < 2; ++k) dst[n][k] = *(const PG8_LAS bf16x8*)(lds + PG8_SB(b, h) + boff + n * 2048 + k * 1024); } while (0)
#define PG8_CAT8(x, y) __builtin_shufflevector(__builtin_bit_cast(i32x4, x), __builtin_bit_cast(i32x4, y), 0, 1, 2, 3, 4, 5, 6, 7)
#define PG8_W8(c) __builtin_shufflevector(c, c, 0, 1, 2, 3, -1, -1, -1, -1)
#define PG8_MMA(ai, bj, At, Bt) do { __builtin_amdgcn_s_setprio(1); \
        if constexpr (FP8) { f32x32 a_ = acc32[ai][bj]; _Pragma("unroll") for (int m = 0; m < 4; ++m) _Pragma("unroll") for (int n = 0; n < 2; ++n) { \
            f32x4 c_ = {a_[(m * 2 + n) * 4], a_[(m * 2 + n) * 4 + 1], a_[(m * 2 + n) * 4 + 2], a_[(m * 2 + n) * 4 + 3]}; \
            c_ = __builtin_amdgcn_mfma_scale_f32_16x16x128_f8f6f4(PG8_CAT8(Bt[n][0], Bt[n][1]), PG8_CAT8(At[m][0], At[m][1]), c_, 0, 0, 0, 0, 0, 0); \
            a_[(m * 2 + n) * 4] = c_[0]; a_[(m * 2 + n) * 4 + 1] = c_[1]; a_[(m * 2 + n) * 4 + 2] = c_[2]; a_[(m * 2 + n) * 4 + 3] = c_[3]; } acc32[ai][bj] = a_; } \
        else { _Pragma("unroll") for (int m = 0; m < 4; ++m) _Pragma("unroll") for (int n = 0; n < 2; ++n) _Pragma("unroll") for (int k = 0; k < 2; ++k) \
            acc[ai][bj][m][n] = __builtin_amdgcn_mfma_f32_16x16x32_bf16(Bt[n][k], At[m][k], acc[ai][bj][m][n], 0, 0, 0); } __builtin_amdgcn_s_setprio(0); } while (0)
#define PG8_WAIT_V(n) asm volatile("s_waitcnt vmcnt(" #n ")" ::: "memory")
#define PG8_WAIT_L(n) asm volatile("s_waitcnt lgkmcnt(" #n ")" ::: "memory")
#define PG8_BAR __builtin_amdgcn_s_barrier()
#define PG8_SCHED __builtin_amdgcn_sched_barrier(0)
    Unit cur, nxt; int ui = 0;
    if (!S.next(0, cur)) return;
    f32x4 acc[2][2][4][2]; f32x32 acc32[2][2];
#pragma unroll
    for (int a = 0; a < 2; ++a)
#pragma unroll
        for (int b = 0; b < 2; ++b)
#pragma unroll
            for (int m = 0; m < 4; ++m) {
#pragma unroll
                for (int n = 0; n < 2; ++n) { acc[a][b][m][n] = (f32x4){0.f, 0.f, 0.f, 0.f};
#pragma unroll
                    for (int i = 0; i < 4; ++i) acc32[a][b][(m * 2 + n) * 4 + i] = 0.f; } }
    bf16x8 At[4][2], B0[2][2], B1[2][2];
    const char* cA = (const char*)g.A + (size_t)cur.pm * tstep + (size_t)cur.pk * kslice; const char* cB = (const char*)g.Bt + (size_t)cur.pn * tstep + (size_t)cur.pk * kslice;
    unsigned cvA0[2], cvA1[2], nvA0[2], nvA1[2];
#pragma unroll
    for (int i = 0; i < 2; ++i) { int R, C; stage_rc(tid * 16 + i * 8192, R, C);
        if constexpr (Sched::GATHER) { cvA0[i] = (unsigned)(S.arow(cur, R) * K + C) * 2u; cvA1[i] = (unsigned)(S.arow(cur, HALF + R) * K + C) * 2u; }
        else { cvA0[i] = voffA[i]; cvA1[i] = voffA[i] + (unsigned)hstep; }
        nvA0[i] = cvA0[i]; nvA1[i] = cvA1[i]; }
    if constexpr (Sched::GATHER) cA = (const char*)g.A;
    S.a_ready(cur);
    if constexpr (SP2) {
        PG8_STAGE(PG8_SB(0, 0), cB, voffB); PG8_STAGE(PG8_SB(0, 1), cB + hstep, voffB); PG8_STAGE(PG8_SA(0, 0), cA, cvA0); PG8_STAGE(PG8_SA(0, 1), cA, cvA1);
        if (wr == 1) PG8_BAR;
        PG8_WAIT_V(2); PG8_BAR;
        PG8_STAGE(PG8_SB(1, 0), cB + kstep, voffB); PG8_STAGE(PG8_SA(1, 0), cA + kstep, cvA0); PG8_STAGE(PG8_SB(1, 1), cB + hstep + kstep, voffB);
        PG8_WAIT_V(6); PG8_BAR;
    } else {
        PG8_STAGE(PG8_SB(0, 0), cB, voffB); PG8_STAGE(PG8_SA(0, 0), cA, voffA); PG8_STAGE(PG8_SB(0, 1), cB + hstep, voffB); PG8_STAGE(PG8_SA(0, 1), cA + hstep, voffA);
        if (wr == 1) PG8_BAR;
        PG8_WAIT_V(4); PG8_BAR;
        PG8_STAGE(PG8_SB(1, 0), cB + kstep, voffB); PG8_STAGE(PG8_SA(1, 0), cA + kstep, voffA); PG8_STAGE(PG8_SB(1, 1), cB + hstep + kstep, voffB);
        PG8_WAIT_V(6); PG8_BAR;
    }
    for (;;) {
        const bool has_next = S.next(ui + 1, nxt);
        const char* nA = Sched::GATHER ? (const char*)g.A : (has_next ? (const char*)g.A + (size_t)nxt.pm * tstep + (size_t)nxt.pk * kslice : cA);
        if constexpr (Sched::GATHER) { if (has_next) {
#pragma unroll
            for (int i = 0; i < 2; ++i) { int R, C; stage_rc(tid * 16 + i * 8192, R, C); nvA0[i] = (unsigned)(S.arow(nxt, R) * K + C) * 2u; nvA1[i] = (unsigned)(S.arow(nxt, HALF + R) * K + C) * 2u; } } } const char* nB = has_next ? (const char*)g.Bt + (size_t)nxt.pn * tstep + (size_t)nxt.pk * kslice : cB;
        for (int t = 0; t < nt; t += 2) {
            const bool last = (t == nt - 2);
            const char* a1 = cA + (size_t)(t + 1) * kstep;
            const char* a2 = last ? nA : cA + (size_t)(t + 2) * kstep; const char* b2 = last ? nB : cB + (size_t)(t + 2) * kstep;
            const char* a3 = a2 + kstep; const char* b3 = b2 + kstep;
            if (last && has_next) S.a_ready(nxt);
            unsigned sA0[2], sA1[2];
#pragma unroll
            for (int i = 0; i < 2; ++i) { sA0[i] = last ? nvA0[i] : cvA0[i]; sA1[i] = last ? nvA1[i] : cvA1[i]; }
            if constexpr (SP2) {
            PG8_LDB(B0, 0, 0); PG8_LDB(B1, 0, 1); PG8_SCHED; PG8_LDA(At, 0, 0); PG8_STAGE(PG8_SA(1, 1), a1, cvA1);
            PG8_WAIT_V(8); PG8_WAIT_L(0); PG8_BAR; PG8_MMA(0, 0, At, B0); PG8_MMA(0, 1, At, B1); PG8_BAR; PG8_SCHED;
            PG8_LDA(At, 0, 1); PG8_STAGE(PG8_SB(0, 0), b2, voffB); PG8_STAGE(PG8_SB(0, 1), b2 + hstep, voffB); PG8_STAGE(PG8_SA(0, 0), a2, sA0);
            PG8_WAIT_V(8); PG8_WAIT_L(0); PG8_BAR; PG8_MMA(1, 0, At, B0); PG8_MMA(1, 1, At, B1); PG8_BAR; PG8_SCHED;
            PG8_LDB(B0, 1, 0); PG8_LDB(B1, 1, 1); PG8_SCHED; PG8_LDA(At, 1, 0); PG8_STAGE(PG8_SA(0, 1), a2, sA1);
            PG8_WAIT_V(8); PG8_WAIT_L(0); PG8_BAR; PG8_MMA(0, 0, At, B0); PG8_MMA(0, 1, At, B1); PG8_BAR; PG8_SCHED;
            PG8_LDA(At, 1, 1); PG8_STAGE(PG8_SB(1, 0), b3, voffB); PG8_STAGE(PG8_SB(1, 1), b3 + hstep, voffB); PG8_STAGE(PG8_SA(1, 0), a3, sA0);
            PG8_WAIT_V(8); PG8_WAIT_L(0); PG8_BAR; PG8_MMA(1, 0, At, B0); PG8_MMA(1, 1, At, B1); PG8_BAR; PG8_SCHED;
            } else {
            PG8_LDB(B0, 0, 0); PG8_SCHED; PG8_LDA(At, 0, 0); PG8_STAGE(PG8_SA(1, 1), a1 + hstep, voffA);
            PG8_WAIT_L(8); PG8_BAR; PG8_WAIT_L(0); PG8_MMA(0, 0, At, B0); PG8_BAR; PG8_SCHED;
            PG8_LDB(B1, 0, 1); PG8_STAGE(PG8_SB(0, 0), b2, voffB);
            PG8_BAR; PG8_WAIT_L(0); PG8_MMA(0, 1, At, B1); PG8_BAR;
            PG8_LDA(At, 0, 1); PG8_STAGE(PG8_SA(0, 0), a2, voffA);
            PG8_BAR; PG8_WAIT_L(0); PG8_MMA(1, 0, At, B0); PG8_BAR; PG8_SCHED;
            PG8_STAGE(PG8_SB(0, 1), b2 + hstep, voffB);
            PG8_WAIT_V(6); PG8_BAR; PG8_MMA(1, 1, At, B1); PG8_BAR;
            PG8_LDB(B0, 1, 0); PG8_SCHED; PG8_LDA(At, 1, 0); PG8_STAGE(PG8_SA(0, 1), a2 + hstep, voffA);
            PG8_WAIT_L(8); PG8_BAR; PG8_WAIT_L(0); PG8_MMA(0, 0, At, B0); PG8_BAR; PG8_SCHED;
            PG8_LDB(B1, 1, 1); PG8_STAGE(PG8_SB(1, 0), b3, voffB);
            PG8_BAR; PG8_WAIT_L(0); PG8_MMA(0, 1, At, B1); PG8_BAR;
            PG8_LDA(At, 1, 1); PG8_STAGE(PG8_SA(1, 0), a3, voffA);
            PG8_BAR; PG8_WAIT_L(0); PG8_MMA(1, 0, At, B0); PG8_BAR; PG8_SCHED;
            PG8_STAGE(PG8_SB(1, 1), b3 + hstep, voffB);
            PG8_WAIT_V(6); PG8_BAR; PG8_MMA(1, 1, At, B1); PG8_BAR;
            }
        }
        if constexpr (ALIGN_EPI) { if (wr == 0) PG8_BAR; }
        if constexpr (FP8) {
#pragma unroll
            for (int a = 0; a < 2; ++a)
#pragma unroll
                for (int b = 0; b < 2; ++b)
#pragma unroll
                    for (int m = 0; m < 4; ++m)
#pragma unroll
                        for (int n = 0; n < 2; ++n)
#pragma unroll
                            for (int i = 0; i < 4; ++i) acc[a][b][m][n][i] = acc32[a][b][(m * 2 + n) * 4 + i]; }
        if constexpr (!Epi::AFTER_DRAIN) { E(acc, cur, wr, wc, fr, fq); S.done(cur); }
        if (!has_next) break;
#pragma unroll
        for (int a = 0; a < 2; ++a)
#pragma unroll
            for (int b = 0; b < 2; ++b)
#pragma unroll
                for (int m = 0; m < 4; ++m) {
#pragma unroll
                    for (int n = 0; n < 2; ++n) { acc[a][b][m][n] = (f32x4){0.f, 0.f, 0.f, 0.f};
#pragma unroll
                        for (int i = 0; i < 4; ++i) acc32[a][b][(m * 2 + n) * 4 + i] = 0.f; } }
        cur = nxt; cA = nA; cB = nB; ++ui;
#pragma unroll
        for (int i = 0; i < 2; ++i) { cvA0[i] = nvA0[i]; cvA1[i] = nvA1[i]; }
        if constexpr (ALIGN_EPI) { if (wr == 1) PG8_BAR; }
    }
    PG8_WAIT_V(0);
    if constexpr (!ALIGN_EPI) { if (wr == 0) PG8_BAR; }
    PG8_BAR;
    if constexpr (Epi::AFTER_DRAIN) { E.fused(acc, cur, wr, wc, fr, fq, lds, wid, lane); S.done(cur); }
#undef PG8_SA
#undef PG8_SB
#undef PG8_STAGE
#undef PG8_LDA
#undef PG8_LDB
#undef PG8_MMA
#undef PG8_CAT8
#undef PG8_W8
#undef PG8_WAIT_V
#undef PG8_WAIT_L
#undef PG8_BAR
#undef PG8_SCHED
}
}

namespace att {
constexpr int NW = 8, QBLK = 32, KVBLK = 64;
constexpr float THR = 8.f;
constexpr int SHM_V = KVBLK * 128 * 2, SHM_K = KVBLK * 64 * 2;
constexpr int SHM_ATTN = 2 * SHM_V + 2 * SHM_K + NW * 64 * 4;
#define KSWZ64(row, colB) ((row) * 128 + ((colB) ^ ((((row) >> 1) & 7) << 4)))
#define SBAR() __builtin_amdgcn_sched_barrier(0)
__device__ __forceinline__ int crow(int r, int hi) { return (r & 3) + 8 * (r >> 2) + 4 * hi; }

__device__ __forceinline__ void partialSM(f32x16& p0, f32x16& p1, float& m_reg, float& mn, float& alpha) {
  float pmax = p0[0];
#pragma unroll
  for (int r = 1; r < 16; ++r) pmax = fmaxf(pmax, p0[r]);
#pragma unroll
  for (int r = 0; r < 16; ++r) pmax = fmaxf(pmax, p1[r]);
  { auto rr = __builtin_amdgcn_permlane32_swap(__float_as_uint(pmax), __float_as_uint(pmax), false, false);
    pmax = fmaxf(__uint_as_float(rr[0]), __uint_as_float(rr[1])); }
  if (__builtin_expect(__all(pmax - m_reg <= THR), 1)) { mn = m_reg; alpha = 1.f; }
  else { mn = fmaxf(m_reg, pmax); alpha = __builtin_amdgcn_exp2f(m_reg - mn); m_reg = mn; }
#pragma unroll
  for (int r = 0; r < 16; ++r) p0[r] = p0[r] - mn;
#pragma unroll
  for (int r = 0; r < 16; ++r) p1[r] = p1[r] - mn;
#pragma unroll
  for (int r = 0; r < 16; ++r) p0[r] = __builtin_amdgcn_exp2f(p0[r]);
}
__device__ __forceinline__ void finishSM(f32x16& p0, f32x16& p1, float alpha, float& l_reg, bf16x8& pa0, bf16x8& pa1, bf16x8& pa2, bf16x8& pa3) {
#pragma unroll
  for (int r = 0; r < 16; ++r) p1[r] = __builtin_amdgcn_exp2f(p1[r]);
  float ps = 0;
#pragma unroll
  for (int r = 0; r < 16; ++r) ps += p0[r];
#pragma unroll
  for (int r = 0; r < 16; ++r) ps += p1[r];
  { auto rr = __builtin_amdgcn_permlane32_swap(__float_as_uint(ps), __float_as_uint(ps), false, false);
    ps = __uint_as_float(rr[0]) + __uint_as_float(rr[1]); }
  l_reg = l_reg * alpha + ps;
#define PK4(P, BASE, OUT) do { unsigned a0 = cvtpk(P[BASE + 0], P[BASE + 1]), a1 = cvtpk(P[BASE + 2], P[BASE + 3]);   \
    unsigned b0 = cvtpk(P[BASE + 4], P[BASE + 5]), b1 = cvtpk(P[BASE + 6], P[BASE + 7]);                              \
    auto r0 = __builtin_amdgcn_permlane32_swap(a0, b0, false, false); auto r1 = __builtin_amdgcn_permlane32_swap(a1, b1, false, false); \
    u32x4 w = {r0[0], r1[0], r0[1], r1[1]}; OUT = __builtin_bit_cast(bf16x8, w); } while (0)
  PK4(p0, 0, pa0); PK4(p0, 8, pa1); PK4(p1, 0, pa2); PK4(p1, 8, pa3);
#undef PK4
}
__device__ __forceinline__ void qkt(f32x16& p0, f32x16& p1, const char* Ks, const bf16x8* qr, int r32, int hi) {
  p0 = f32x16{}; p1 = f32x16{};
#pragma unroll
  for (int d0 = 0; d0 < 4; ++d0) { const int cb = (d0 * 16 + hi * 8) * 2;
    bf16x8 b0 = *reinterpret_cast<const bf16x8*>(Ks + KSWZ64(r32, cb));
    bf16x8 b1 = *reinterpret_cast<const bf16x8*>(Ks + KSWZ64(32 + r32, cb));
    p0 = __builtin_amdgcn_mfma_f32_32x32x16_bf16(b0, qr[d0], p0, 0, 0, 0);
    p1 = __builtin_amdgcn_mfma_f32_32x32x16_bf16(b1, qr[d0], p1, 0, 0, 0); }
}
__device__ __forceinline__ int v_st(int k, int c) { const int kk = (k & ~0xC) | ((k & 4) << 1) | ((k & 8) >> 1); return ((kk >> 3) * 4 + (c >> 5)) * 512 + ((kk & 7) * 32 + (c & 31)) * 2; }
__device__ __forceinline__ int v_rd_base(int lane) { return ((lane & 3) << 3) | (((lane >> 2) & 3) << 6) | (((lane >> 4) & 1) << 5) | (((lane >> 5) & 1) << 8); }
constexpr int v_rd_off(int d0, int ks, int half) { return d0 * 512 + ks * 4096 + half * 2048; }
template <int OFF> __device__ __forceinline__ s16x4 tr_read(int vb) {
  s16x4 r; asm volatile("ds_read_b64_tr_b16 %0, %1 offset:%2" : "=&v"(r) : "v"(vb), "i"(OFF) : "memory"); return r;
}
template <int D0> __device__ __forceinline__ void pv_one(f32x16& od, int vb, bf16x8 pa0, bf16x8 pa1, bf16x8 pa2, bf16x8 pa3) {
  const s16x4 l0 = tr_read<v_rd_off(D0, 0, 0)>(vb), h0 = tr_read<v_rd_off(D0, 0, 1)>(vb), l1 = tr_read<v_rd_off(D0, 1, 0)>(vb), h1 = tr_read<v_rd_off(D0, 1, 1)>(vb);
  const s16x4 l2 = tr_read<v_rd_off(D0, 2, 0)>(vb), h2 = tr_read<v_rd_off(D0, 2, 1)>(vb), l3 = tr_read<v_rd_off(D0, 3, 0)>(vb), h3 = tr_read<v_rd_off(D0, 3, 1)>(vb);
  asm volatile("s_waitcnt lgkmcnt(0)" ::: "memory"); SBAR();
#define PK(L, H) (bf16x8){L[0], L[1], L[2], L[3], H[0], H[1], H[2], H[3]}
  od = __builtin_amdgcn_mfma_f32_32x32x16_bf16(pa0, PK(l0, h0), od, 0, 0, 0);
  od = __builtin_amdgcn_mfma_f32_32x32x16_bf16(pa1, PK(l1, h1), od, 0, 0, 0);
  od = __builtin_amdgcn_mfma_f32_32x32x16_bf16(pa2, PK(l2, h2), od, 0, 0, 0);
  od = __builtin_amdgcn_mfma_f32_32x32x16_bf16(pa3, PK(l3, h3), od, 0, 0, 0);
#undef PK
}
__device__ __forceinline__ void pv_d0(f32x16* o, int vb, bf16x8 pa0, bf16x8 pa1, bf16x8 pa2, bf16x8 pa3) {
  pv_one<0>(o[0], vb, pa0, pa1, pa2, pa3); pv_one<1>(o[1], vb, pa0, pa1, pa2, pa3); pv_one<2>(o[2], vb, pa0, pa1, pa2, pa3); pv_one<3>(o[3], vb, pa0, pa1, pa2, pa3);
}

template <int LDQ>
__device__ __forceinline__ void attn_unit(const bf16_t* __restrict__ Qb, const bf16_t* __restrict__ Kh, const bf16_t* __restrict__ Vh, bf16_t* __restrict__ Ob, int seq, char* lds) {
  const int tid = threadIdx.x, wid = tid >> 6, lane = tid & 63, r32 = lane & 31, hi = lane >> 5;
  char* V_lds = lds; char* K_lds = lds + 2 * SHM_V;
  float* ws = (float*)(lds + 2 * SHM_V + 2 * SHM_K) + wid * 64; float* li_l = ws; float* al_l = ws + 32;
  float m_reg = -1e30f, l_reg = 0; f32x16 o[4] = {}; bf16x8 qr[4];
  const bf16_t* Qw = Qb + (long)(wid * QBLK + r32) * LDQ + hi * 8;
#pragma unroll
  for (int d0 = 0; d0 < 4; ++d0) qr[d0] = *reinterpret_cast<const bf16x8*>(Qw + d0 * 16);
  const int sr = tid >> 4, sc = (tid & 15) * 8, vst0 = v_st(sr, sc), vst1 = v_st(32 + sr, sc);
  const int kr = tid >> 3, kc8 = (tid & 7) * 8, kst = KSWZ64(kr, kc8 * 2);
  const int vb0 = (int)(uintptr_t)V_lds + v_rd_base(lane);
  struct { bf16x8 vs0, vs1, ks; } sr_[2];
  const bf16_t* Vp0 = Vh + (long)sr * LDQ + sc; const bf16_t* Kp0 = Kh + (long)kr * LDQ + kc8;
#define SLOAD(i, k0) do { const long ko_ = (long)(k0) * LDQ; sr_[i].vs0 = *reinterpret_cast<const bf16x8*>(Vp0 + ko_); sr_[i].vs1 = *reinterpret_cast<const bf16x8*>(Vp0 + ko_ + 32 * LDQ); \
    sr_[i].ks = *reinterpret_cast<const bf16x8*>(Kp0 + ko_); } while (0)
#define SWRITE(b, i) do { *(bf16x8*)(V_lds + (b) * SHM_V + vst0) = sr_[i].vs0; *(bf16x8*)(V_lds + (b) * SHM_V + vst1) = sr_[i].vs1; \
    *(bf16x8*)(K_lds + (b) * SHM_K + kst) = sr_[i].ks; } while (0)
#define SWAIT() asm volatile("s_waitcnt vmcnt(3)" ::: "memory")
#define RESC(a) do { if (__any((a) < 1.f)) { if (hi == 0) al_l[r32] = (a); asm volatile("s_waitcnt lgkmcnt(0)" ::: "memory"); \
    _Pragma("unroll") for (int d = 0; d < 4; ++d) _Pragma("unroll") for (int r = 0; r < 16; ++r) o[d][r] *= al_l[crow(r, hi)]; } } while (0)
  f32x16 pA0, pA1, pB0, pB1; float mnA, mnB, alA, alB; bf16x8 pa0, pa1, pa2, pa3; const int NT = seq / KVBLK;
  constexpr int SE = 0, SO = 1;
  SLOAD(SE, 0); asm volatile("s_waitcnt vmcnt(0)" ::: "memory"); SWRITE(0, SE); __syncthreads();
  qkt(pA0, pA1, K_lds, qr, r32, hi); partialSM(pA0, pA1, m_reg, mnA, alA);
  SLOAD(SO, KVBLK); if (2 < NT) SLOAD(SE, 2 * KVBLK);
  SWAIT(); SWRITE(1, SO); __syncthreads();
  for (int j = 1; j + 1 < NT; j += 2) {
    SBAR(); qkt(pB0, pB1, K_lds + SHM_K, qr, r32, hi);
    finishSM(pA0, pA1, alA, l_reg, pa0, pa1, pa2, pa3); SBAR();
    SLOAD(SO, (j + 2) * KVBLK); SBAR();
    pv_d0(o, vb0, pa0, pa1, pa2, pa3); partialSM(pB0, pB1, m_reg, mnB, alB);
    __syncthreads(); SWAIT(); SWRITE(0, SE);
    RESC(alB); __syncthreads();
    SBAR(); qkt(pA0, pA1, K_lds, qr, r32, hi);
    finishSM(pB0, pB1, alB, l_reg, pa0, pa1, pa2, pa3); SBAR();
    if (j + 3 < NT) SLOAD(SE, (j + 3) * KVBLK); SBAR();
    pv_d0(o, vb0 + SHM_V, pa0, pa1, pa2, pa3); partialSM(pA0, pA1, m_reg, mnA, alA);
    __syncthreads(); SWAIT(); SWRITE(1, SO);
    RESC(alA); __syncthreads();
  }
  SBAR(); qkt(pB0, pB1, K_lds + SHM_K, qr, r32, hi);
  finishSM(pA0, pA1, alA, l_reg, pa0, pa1, pa2, pa3); SBAR();
  pv_d0(o, vb0, pa0, pa1, pa2, pa3); partialSM(pB0, pB1, m_reg, mnB, alB);
  __syncthreads(); RESC(alB);
  finishSM(pB0, pB1, alB, l_reg, pa0, pa1, pa2, pa3); SBAR();
  pv_d0(o, vb0 + SHM_V, pa0, pa1, pa2, pa3);
  if (hi == 0) li_l[r32] = l_reg; asm volatile("s_waitcnt lgkmcnt(0)" ::: "memory");
  float rli[16];
#pragma unroll
  for (int r = 0; r < 16; ++r) rli[r] = __builtin_amdgcn_rcpf(li_l[crow(r, hi)]);
  bf16_t* Ow = Ob + (long)(wid * QBLK) * 1024;
#pragma unroll
  for (int r = 0; r < 16; ++r) { const int orow = crow(r, hi);
#pragma unroll
    for (int d0 = 0; d0 < 4; ++d0) Ow[(long)orow * 1024 + d0 * 32 + r32] = (bf16_t)(cvtpk(o[d0][r] * rli[r], 0.f) & 0xffffu); }
  __syncthreads();
#undef SLOAD
#undef SWRITE
#undef SWAIT
#undef RESC
}
#undef SBAR
}


typedef GAS unsigned gu32;
#define RLX_AGENT __ATOMIC_RELAXED, __HIP_MEMORY_SCOPE_AGENT
#define XB_TMO      128
#define XB_XCNT(j)  (256  + 64 * (j))
#define XB_XSUB(j)  (1280 + 64 * (j))
#define XB_XGEN(j)  (2304 + 64 * (j))
#define XB_TOP      3328
#define XB_TOPGEN   3392
#define XCD_BAR_WORDS 3456
#define XB_SPIN_CAP (1u << 22)
__device__ __forceinline__ unsigned xb_ld(unsigned* p)              { return __hip_atomic_load(p, __ATOMIC_RELAXED, __HIP_MEMORY_SCOPE_AGENT); }
__device__ __forceinline__ unsigned xb_add(unsigned* p, unsigned v) { return __hip_atomic_fetch_add(p, v, __ATOMIC_RELAXED, __HIP_MEMORY_SCOPE_AGENT); }
__device__ __forceinline__ unsigned xb_xcc_id() { return (unsigned)__builtin_amdgcn_s_getreg((3 << 11) | 20) & 0xFu; }
#define XB_SPIN(cond, bar) do { unsigned _sp = 0; while (cond) { __builtin_amdgcn_s_sleep(1); \
    if ((++_sp & 255u) == 0u) { if (xb_ld(&(bar)[XB_TMO])) break; if (_sp > XB_SPIN_CAP) { atomicAdd(&(bar)[XB_TMO], 1u); break; } } } } while (0)
struct XcdBarrier { unsigned* bar; unsigned x; volatile LAS unsigned* st; };
__device__ __forceinline__ XcdBarrier xcd_barrier_post(unsigned* bar, volatile LAS unsigned* st) {
    XcdBarrier b; b.bar = bar; b.x = xb_xcc_id(); b.st = st;
    if (threadIdx.x == 0) (void)xb_add(&bar[XB_XCNT(b.x)], 1u);
    return b;
}
__device__ __forceinline__ void xcd_barrier_complete(unsigned* bar, unsigned x, unsigned& nloc, unsigned& nx) {
    const unsigned G = gridDim.x * gridDim.y * gridDim.z;
    unsigned sum, cnt, mine, sp = 0u;
    for (;;) {
        sum = 0u; cnt = 0u; mine = 0u;
#pragma unroll
        for (unsigned j = 0; j < 16; ++j) { const unsigned c = xb_ld(&bar[XB_XCNT(j)]); sum += c; cnt += (c > 0u) ? 1u : 0u; mine = (j == x) ? c : mine; }
        if (sum == G) break;
        __builtin_amdgcn_s_sleep(1);
        if ((++sp & 255u) == 0u) { if (xb_ld(&bar[XB_TMO])) break; if (sp > XB_SPIN_CAP) { atomicAdd(&bar[XB_TMO], 1u); break; } }
    }
    nloc = mine > 0u ? mine : 1u; nx = cnt > 0u ? cnt : 1u;
}
__device__ __forceinline__ void xcd_barrier(const XcdBarrier& b) {
    asm volatile("s_waitcnt vmcnt(0)" ::: "memory");
    __syncthreads();
    if (threadIdx.x == 0) {
        unsigned* bar = b.bar;
        __builtin_amdgcn_s_waitcnt(0);
        unsigned nloc = b.st[0], nx = b.st[1];
        if (nloc == 0u) { xcd_barrier_complete(bar, b.x, nloc, nx); b.st[0] = nloc; b.st[1] = nx; }
        const unsigned old = xb_add(&bar[XB_XSUB(b.x)], 1u);
        const unsigned gen = old / nloc;
        if (old + 1u == (gen + 1u) * nloc) {
            __builtin_amdgcn_fence(__ATOMIC_RELEASE, "agent");
            asm volatile("s_waitcnt vmcnt(0)" ::: "memory");
            const unsigned og = xb_add(&bar[XB_TOP], 1u);
            const unsigned tg = og / nx;
            if (og + 1u == (tg + 1u) * nx) xb_add(&bar[XB_TOPGEN], 1u);
            else XB_SPIN(xb_ld(&bar[XB_TOPGEN]) == tg, bar);
            __builtin_amdgcn_fence(__ATOMIC_ACQUIRE, "agent");
            xb_add(&bar[XB_XGEN(b.x)], 1u);
            asm volatile("s_waitcnt vmcnt(0)" ::: "memory");
        } else {
            XB_SPIN(xb_ld(&bar[XB_XGEN(b.x)]) == gen, bar);
            __builtin_amdgcn_fence(__ATOMIC_ACQUIRE, "agent");
            asm volatile("s_waitcnt vmcnt(0)" ::: "memory");
        }
    }
    __syncthreads();
}

struct Frame {
    LAS unsigned char* lds; char* ldsg;
    int tid, lane, wave, vcu, G;
    const Args* a;
};
#define INP(F, i, T) ((const T*)(F).a->in[i])
#define WSP(F, off, T) ((T*)((F).a->ws + (off)))

__device__ __forceinline__ void cvt_load(f32x4 (&v)[16], const float* __restrict__ W, int N, int nvalid, int k0, int n0, int lane) {
    const int kq = lane >> 4, nq = lane & 15;
    const unsigned voff = (unsigned)(kq * N + 4 * nq) * 4u;
#pragma unroll
    for (int i = 0; i < 16; ++i) {
        const char* Wu = (const char*)(W + (size_t)(k0 + 4 * i) * N + n0);
        if (4 * nq < nvalid) v[i] = __builtin_nontemporal_load((const f32x4*)(Wu + (size_t)voff)); else v[i] = (f32x4){0.f, 0.f, 0.f, 0.f};
    }
}
__device__ __forceinline__ void cvt_finish(const f32x4 (&v)[16], int k0, bf16_t* __restrict__ WT, int rowb, LAS unsigned char* scr, int lane) {
    const int kq = lane >> 4, nq = lane & 15;
    const int g = lane >> 4, i16 = lane & 15, q = i16 >> 2, p = i16 & 3;
    typedef short v4i16_t __attribute__((ext_vector_type(4)));
#pragma unroll
    for (int hf = 0; hf < 2; ++hf) {
#pragma unroll
        for (int i = 0; i < 8; ++i) {
            const int k = 4 * i + kq, s = ((k >> 1) & 1) | (((k >> 3) & 1) << 1);
            u32x2 w; w.x = cvtpk(v[8 * hf + i].x, v[8 * hf + i].y); w.y = cvtpk(v[8 * hf + i].z, v[8 * hf + i].w);
            *(LAS u32x2*)(scr + k * 128 + ((nq * 8) ^ (s << 5))) = w;
        }
        const int klo = 8 * g + q, s = ((klo >> 1) & 1) | (((klo >> 3) & 1) << 1);
#pragma unroll
        for (int nb = 0; nb < 4; ++nb) {
            const int a_lo = klo * 128 + (((16 * nb + 4 * p) * 2) ^ (s << 5));
            const s16x4 lo = __builtin_bit_cast(s16x4, __builtin_amdgcn_ds_read_tr16_b64_v4i16((LAS v4i16_t*)(scr + a_lo)));
            const s16x4 hi = __builtin_bit_cast(s16x4, __builtin_amdgcn_ds_read_tr16_b64_v4i16((LAS v4i16_t*)(scr + a_lo + 512)));
            bf16x8 o = {lo[0], lo[1], lo[2], lo[3], hi[0], hi[1], hi[2], hi[3]};
            char* Wu = (char*)(WT + (size_t)(rowb + 16 * nb) * 2048 + k0 + 32 * hf);
            __builtin_nontemporal_store(o, (bf16x8*)(Wu + (size_t)(unsigned)((i16 * 2048 + 8 * g) * 2)));
        }
    }
}
__device__ __forceinline__ void cvt8_load(f32x4 (&v)[16], const float* __restrict__ W, int k0, int n0, int lane) {
    const int kq = lane >> 4, nq = lane & 15;
    const unsigned voff = (unsigned)(16 * kq * 2048 + 4 * nq) * 4u;
#pragma unroll
    for (int i = 0; i < 16; ++i) {
        const char* Wu = (const char*)(W + (size_t)(k0 + i) * 2048 + n0);
        v[i] = __builtin_nontemporal_load((const f32x4*)(Wu + (size_t)voff));
    }
}
__device__ __forceinline__ void cvt8_finish(const f32x4 (&v)[16], int k0, unsigned char* __restrict__ W8, int rowb, int lane) {
    const int kq = lane >> 4, nq = lane & 15;
    char* Wu = (char*)(W8 + (size_t)rowb * 2048 + k0);
    const unsigned voff = (unsigned)(4 * nq * 2048 + 16 * kq);
#pragma unroll
    for (int j = 0; j < 4; ++j) {
        u32x4 o;
#pragma unroll
        for (int q = 0; q < 4; ++q) {
            int w = __builtin_amdgcn_cvt_pk_fp8_f32(v[4 * q][j] * pg8::W8_SCALE, v[4 * q + 1][j] * pg8::W8_SCALE, 0, false);
            w = __builtin_amdgcn_cvt_pk_fp8_f32(v[4 * q + 2][j] * pg8::W8_SCALE, v[4 * q + 3][j] * pg8::W8_SCALE, w, true);
            o[q] = (unsigned)w;
        }
        __builtin_nontemporal_store(o, (u32x4*)(Wu + (size_t)(voff + (unsigned)(j * 2048))));
    }
}
__device__ __forceinline__ void cvt_expert_decode(const Frame& F, int r, const float*& W, int& k0, int& n0, unsigned char*& WT, int& rowb) {
    constexpr int I_E = 16 * 32 * 32;
    const int mat = r / I_E; r -= mat * I_E;
    const int e = r >> 10, kt = (r >> 5) & 31, nt = r & 31;
    k0 = kt * 64; n0 = nt * 64;
    if (mat < 2) { W = INP(F, 24 + mat, float) + (size_t)e * 2048 * 2048; WT = WSP(F, WS_WGU, unsigned char); rowb = e * 4096 + (n0 >> 7) * 256 + mat * 128 + (n0 & 127); }
    else { W = INP(F, 26, float) + (size_t)e * 2048 * 2048; WT = WSP(F, WS_WD, unsigned char); rowb = e * 2048 + n0; }
}
constexpr int N_EXPERT_ITEMS = 3 * 16 * 32 * 32;
__device__ __forceinline__ void p0_prologue(Frame& F) {
    LAS unsigned char* scr = F.lds + F.wave * 4096;
    const int gw = F.vcu * 8 + F.wave, NGW = F.G * 8, lane = F.lane;
    const float* w_in = INP(F, 3, float); const float* w_out = INP(F, 21, float);
    bf16_t* WinT = WSP(F, WS_WIN, bf16_t); bf16_t* WoutT = WSP(F, WS_WOUT, bf16_t);
    constexpr int I_IN = 32 * 101, I_OUT = 32 * 32, NITEMS = I_IN + I_OUT;
    for (int it = gw; it < NITEMS; it += NGW) {
        f32x4 v[16];
        if (it < I_IN) { const int kt = it / 101, nt = it % 101; const int nv = (nt == 100) ? 32 : 64; cvt_load(v, w_in, IN_COLS, nv, kt * 64, nt * 64, lane); cvt_finish(v, kt * 64, WinT, nt * 64, scr, lane); }
        else { const int r = it - I_IN, kt = r >> 5, nt = r & 31; cvt_load(v, w_out, 2048, 64, kt * 64, nt * 64, lane); cvt_finish(v, kt * 64, WoutT, nt * 64, scr, lane); }
    }
#if !CVT_IN_SCAN
    for (int it = gw; it < N_EXPERT_ITEMS; it += NGW) {
        f32x4 v[16]; const float* W; int k0, n0, rowb; unsigned char* WT;
        cvt_expert_decode(F, it, W, k0, n0, WT, rowb); cvt8_load(v, W, k0, n0, lane); cvt8_finish(v, k0, WT, rowb, lane);
    }
#endif
    { u32x4 z = {0u, 0u, 0u, 0u}; u32x4* zp = (u32x4*)(WinT + (size_t)6464 * 2048); const int nz = 192 * 2048 * 2 / 16;
      for (int i = gw * 64 + lane; i < nz; i += NGW * 64) zp[i] = z; }
    { const float* x = INP(F, 0, float); const float* nw = INP(F, 2, float); bf16_t* H1 = WSP(F, WS_H1, bf16_t);
      for (int m = gw; m < MTOK; m += NGW) {
          const f32x4* xr = (const f32x4*)(x + (size_t)m * DM) + lane; f32x4 v[8]; float s = 0.f;
#pragma unroll
          for (int j = 0; j < 8; ++j) { v[j] = xr[64 * j]; s += (v[j].x * v[j].x + v[j].y * v[j].y) + (v[j].z * v[j].z + v[j].w * v[j].w); }
          const float rstd = 1.f / sqrtf(wave_sum(s) * (1.f / DM) + 1e-6f);
          u32x2* o8 = (u32x2*)(H1 + (size_t)m * DM) + lane;
#pragma unroll
          for (int j = 0; j < 8; ++j) { const f32x4 w = ((const f32x4*)nw)[lane + 64 * j]; u32x2 o; o.x = cvtpk(v[j].x * rstd * w.x, v[j].y * rstd * w.y); o.y = cvtpk(v[j].z * rstd * w.z, v[j].w * rstd * w.w); o8[64 * j] = o; }
      } }
    { const float* dup = INP(F, 12, float); const float* iup = INP(F, 14, float); const float* gup = INP(F, 15, float);
      bf16_t* DUt = WSP(F, WS_LORA, bf16_t); bf16_t* IUt = DUt + 2 * 1024 * 64; bf16_t* GUt = IUt + 2 * 1024 * 64;
      for (int i = gw * 64 + lane; i < 2 * 1024 * 64; i += NGW * 64) { const int j = i & 63, c = (i >> 6) & 1023, d = i >> 16;
          DUt[i] = (bf16_t)(cvtpk(dup[(size_t)(d * 64 + j) * 1024 + c], 0.f) & 0xffffu); IUt[i] = (bf16_t)(cvtpk(iup[(size_t)(d * 64 + j) * 1024 + c], 0.f) & 0xffffu); }
      for (int i = gw * 64 + lane; i < 1024 * 160; i += NGW * 64) { const int c = i / 160, j = i - c * 160; GUt[i] = (bf16_t)(cvtpk(gup[(size_t)j * 1024 + c], 0.f) & 0xffffu); } }
    { const int* pos = INP(F, 1, int); float* rope = WSP(F, WS_ROPE, float);
      const float invf[8] = {1.0f, 0.19392274474868576f, 0.03760603093086393f, 0.007292664737217109f, 0.001414213562373095f, 0.0002742481756762073f, 5.318295896944988e-05f, 1.031338537721246e-05f};
      for (int i = gw * 64 + lane; i < MTOK * 8; i += NGW * 64) { const int m = i >> 3, j = i & 7; float fj = invf[0];
#pragma unroll
          for (int q = 1; q < 8; ++q) fj = (j == q) ? invf[q] : fj;
          const float ang = (float)pos[m] * fj; rope[m * 16 + j] = cosf(ang); rope[m * 16 + 8 + j] = sinf(ang); } }
}

#define WS32(F, T, byteoff) (*(T*)((F).a->ws + (size_t)(unsigned)(byteoff)))
template <int CTRL> __device__ __forceinline__ float dpp_add(float x) {
    return x + __int_as_float(__builtin_amdgcn_update_dpp(0, __float_as_int(x), CTRL, 0xf, 0xf, false));
}
__device__ __forceinline__ float row16_allsum(float x) { x = dpp_add<0x128>(x); x = dpp_add<0x124>(x); x = dpp_add<0x122>(x); x = dpp_add<0x121>(x); return x; }
__device__ __forceinline__ bf16_t f2bf(float x) { return (bf16_t)(cvtpk(x, 0.f) & 0xffffu); }
__device__ __forceinline__ u32x4 ld_row16(const Frame& F, unsigned off, bool ok) { u32x4 r = {0u, 0u, 0u, 0u}; if (ok) r = WS32(F, const u32x4, off); return r; }
__device__ __forceinline__ void unpack8(const u32x4 w, float (&o)[8]) { o[0] = bf_lo(w.x); o[1] = bf_hi(w.x); o[2] = bf_lo(w.y); o[3] = bf_hi(w.y); o[4] = bf_lo(w.z); o[5] = bf_hi(w.z); o[6] = bf_lo(w.w); o[7] = bf_hi(w.w); }
__device__ __forceinline__ void ld8f(const float* p, float (&o)[8]) { const f32x4 a = ((const f32x4*)p)[0], b = ((const f32x4*)p)[1]; o[0] = a.x; o[1] = a.y; o[2] = a.z; o[3] = a.w; o[4] = b.x; o[5] = b.y; o[6] = b.z; o[7] = b.w; }
__device__ __forceinline__ u32x4 pack8(const float (&v)[8]) { return (u32x4){cvtpk(v[0], v[1]), cvtpk(v[2], v[3]), cvtpk(v[4], v[5]), cvtpk(v[6], v[7])}; }
__device__ __forceinline__ void p3_prep(Frame& F, const int mode = 0) {
    constexpr int AP = 296;
    LAS float* Zl = (LAS float*)F.lds;
    LAS bf16_t* Al = (LAS bf16_t*)(F.lds + 18432);
    constexpr int PP = 520, PA = 16 * PP;
    LAS bf16_t* Pl = (LAS bf16_t*)(F.lds + 18432 + 9472);
    const int tid = F.tid, lane = F.lane, w = F.wave;
    const bf16_t* DUt = WSP(F, WS_LORA, bf16_t); const bf16_t* IUt = DUt + 2 * 1024 * 64; const bf16_t* GUt = IUt + 2 * 1024 * 64;
    for (int tile = F.vcu; tile < MTOK / 16; tile += F.G) {
        const int m0 = tile * 16, t0 = m0 & (SEQ - 1);
        __syncthreads();
        for (int p = tid; p < 16 * 36; p += 512) {
            const int i = p / 36, ch = p - i * 36, zc = 3072 + 8 * ch, t = t0 + i;
            const unsigned off = (unsigned)WS_PROJ + ((unsigned)(m0 + i) * LDP + ZC0 + zc) * 2u;
            float c[8], pv[8], nx[8], mp[8], mn[8];
            unpack8(ld_row16(F, off, true), c); unpack8(ld_row16(F, off - LDP * 2u, t > 0), pv); unpack8(ld_row16(F, off + LDP * 2u, t < SEQ - 1), nx);
            ld8f(INP(F, 4, float) + zc, mp); ld8f(INP(F, 5, float) + zc, mn);
            LAS f32x4* zp = (LAS f32x4*)(Zl + i * 288 + 8 * ch); float z[8];
#pragma unroll
            for (int e = 0; e < 8; ++e) z[e] = c[e] + mp[e] * (pv[e] - c[e]) + mn[e] * (nx[e] - c[e]);
            zp[0] = (f32x4){z[0], z[1], z[2], z[3]}; zp[1] = (f32x4){z[4], z[5], z[6], z[7]};
        }
        __syncthreads();
        for (int e = tid; e < 16 * 288; e += 512) { const int i = e / 288, j = e - i * 288; float z = Zl[e];
            if (j < 64) z = 1.f - 2.f * __builtin_amdgcn_rcpf(__expf(2.f * z) + 1.f); else if (j >= 128) z = __builtin_amdgcn_rcpf(1.f + __expf(-z));
            Al[i * AP + j] = f2bf(z); }
        __syncthreads();
        if (mode == 1) continue;
#pragma unroll 1
        for (int hfi = 0; hfi < 2; ++hfi) {
            const int hf = (hfi + (F.vcu >> 2)) & 1;
            u32x4 rawr[4], rawk[4], rawv[4];
            { const unsigned off = (unsigned)WS_PROJ + ((unsigned)(m0 + 2 * w) * LDP + ZC0 + 512 * hf + 8 * (tid & 63)) * 2u;
#pragma unroll
              for (int rr = 0; rr < 4; ++rr) { const int t = t0 + 2 * w + rr - 1; const bool ok = (t >= 0) && (t < SEQ); const unsigned o = off + (unsigned)((rr - 1) * LDP * 2);
                  rawr[rr] = ld_row16(F, o, ok); rawk[rr] = ld_row16(F, o + 1024u * 2u, ok); rawv[rr] = ld_row16(F, o + 2048u * 2u, ok); } }
            {
                const int n16 = lane & 15, q4 = lane >> 4;
                bf16x8 af[9];
#pragma unroll
                for (int ks = 0; ks < 9; ++ks) af[ks] = *(const LAS bf16x8*)(Al + n16 * AP + 32 * ks + 8 * q4);
                struct BF { bf16x8 d0[2], d1[2], i0[2], i1[2], g[5]; };
#define LD_BF(X, nb_) do { const int cl_ = 512 * hf + 64 * w + 16 * (nb_) + n16; _Pragma("unroll") for (int ks = 0; ks < 2; ++ks) { \
                    X.d0[ks] = *(const bf16x8*)(DUt + (size_t)cl_ * 64 + 32 * ks + 8 * q4); X.d1[ks] = *(const bf16x8*)(DUt + (size_t)(1024 + cl_) * 64 + 32 * ks + 8 * q4); \
                    X.i0[ks] = *(const bf16x8*)(IUt + (size_t)cl_ * 64 + 32 * ks + 8 * q4); X.i1[ks] = *(const bf16x8*)(IUt + (size_t)(1024 + cl_) * 64 + 32 * ks + 8 * q4); } \
                    _Pragma("unroll") for (int ks = 0; ks < 5; ++ks) X.g[ks] = *(const bf16x8*)(GUt + (size_t)cl_ * 160 + 32 * ks + 8 * q4); } while (0)
#define DO_NB(X, nb_) do { const int ch_ = 64 * w + 16 * (nb_); \
                    f32x4 aw0 = {0.f, 0.f, 0.f, 0.f}, aw1 = aw0, aa0 = aw0, aa1 = aw0, ag = aw0; \
                    _Pragma("unroll") for (int ks = 0; ks < 2; ++ks) { \
                        aw0 = __builtin_amdgcn_mfma_f32_16x16x32_bf16(X.d0[ks], af[ks], aw0, 0, 0, 0); aw1 = __builtin_amdgcn_mfma_f32_16x16x32_bf16(X.d1[ks], af[ks], aw1, 0, 0, 0); \
                        aa0 = __builtin_amdgcn_mfma_f32_16x16x32_bf16(X.i0[ks], af[2 + ks], aa0, 0, 0, 0); aa1 = __builtin_amdgcn_mfma_f32_16x16x32_bf16(X.i1[ks], af[2 + ks], aa1, 0, 0, 0); } \
                    _Pragma("unroll") for (int ks = 0; ks < 5; ++ks) ag = __builtin_amdgcn_mfma_f32_16x16x32_bf16(X.g[ks], af[4 + ks], ag, 0, 0, 0); \
                    LAS bf16_t* pp = Pl + n16 * PP + ch_ + 4 * q4; \
                    *(LAS u32x2*)(pp) = (u32x2){cvtpk(aw0[0], aw0[1]), cvtpk(aw0[2], aw0[3])}; *(LAS u32x2*)(pp + PA) = (u32x2){cvtpk(aw1[0], aw1[1]), cvtpk(aw1[2], aw1[3])}; \
                    *(LAS u32x2*)(pp + 2 * PA) = (u32x2){cvtpk(aa0[0], aa0[1]), cvtpk(aa0[2], aa0[3])}; *(LAS u32x2*)(pp + 3 * PA) = (u32x2){cvtpk(aa1[0], aa1[1]), cvtpk(aa1[2], aa1[3])}; \
                    *(LAS u32x2*)(pp + 4 * PA) = (u32x2){cvtpk(ag[0], ag[1]), cvtpk(ag[2], ag[3])}; } while (0)
                const int rot = F.vcu & 3;
                BF fa, fb; LD_BF(fa, (0 + rot) & 3); LD_BF(fb, (1 + rot) & 3);
                DO_NB(fa, (0 + rot) & 3); LD_BF(fa, (2 + rot) & 3); DO_NB(fb, (1 + rot) & 3); LD_BF(fb, (3 + rot) & 3); DO_NB(fa, (2 + rot) & 3); DO_NB(fb, (3 + rot) & 3);
#undef LD_BF
#undef DO_NB
            }
            __syncthreads();
            {
                const int chk = tid & 63, c = 512 * hf + 8 * chk;
                float r4[4][8], k4[4][8], v4[4][8];
#pragma unroll
                for (int rr = 0; rr < 4; ++rr) { unpack8(rawr[rr], r4[rr]); unpack8(rawk[rr], k4[rr]); unpack8(rawv[rr], v4[rr]); }
                float zr[2][8], zk[2][8], zv[2][8];
                { float mp[8], mn[8];
                  ld8f(INP(F, 4, float) + c, mp); ld8f(INP(F, 5, float) + c, mn);
#pragma unroll
                  for (int tk = 0; tk < 2; ++tk)
#pragma unroll
                      for (int e = 0; e < 8; ++e) zr[tk][e] = r4[tk + 1][e] + mp[e] * (r4[tk][e] - r4[tk + 1][e]) + mn[e] * (r4[tk + 2][e] - r4[tk + 1][e]);
                  ld8f(INP(F, 4, float) + 1024 + c, mp); ld8f(INP(F, 5, float) + 1024 + c, mn);
#pragma unroll
                  for (int tk = 0; tk < 2; ++tk)
#pragma unroll
                      for (int e = 0; e < 8; ++e) zk[tk][e] = k4[tk + 1][e] + mp[e] * (k4[tk][e] - k4[tk + 1][e]) + mn[e] * (k4[tk + 2][e] - k4[tk + 1][e]);
                  ld8f(INP(F, 4, float) + 2048 + c, mp); ld8f(INP(F, 5, float) + 2048 + c, mn);
#pragma unroll
                  for (int tk = 0; tk < 2; ++tk)
#pragma unroll
                      for (int e = 0; e < 8; ++e) zv[tk][e] = v4[tk + 1][e] + mp[e] * (v4[tk][e] - v4[tk + 1][e]) + mn[e] * (v4[tk + 2][e] - v4[tk + 1][e]); }
                float kkw[8], w00[8], w01[8], a00[8], a01[8], kac[8], rkc[8];
                ld8f(INP(F, 16, float) + c, kkw); ld8f(INP(F, 11, float) + c, w00); ld8f(INP(F, 11, float) + 1024 + c, w01);
                ld8f(INP(F, 13, float) + c, a00); ld8f(INP(F, 13, float) + 1024 + c, a01); ld8f(INP(F, 17, float) + c, kac); ld8f(INP(F, 18, float) + c, rkc);
#pragma unroll 1
                for (int tk = 0; tk < 2; ++tk) {
                    const int tkn = 2 * w + tk; const unsigned o = (unsigned)(m0 + tkn) * 1024u + (unsigned)c;
                    const LAS bf16_t* pp = Pl + tkn * PP + 8 * chk;
                    float zrt[8], zkt[8], zvt[8];
#pragma unroll
                    for (int e = 0; e < 8; ++e) { zrt[e] = tk ? zr[1][e] : zr[0][e]; zkt[e] = tk ? zk[1][e] : zk[0][e]; zvt[e] = tk ? zv[1][e] : zv[0][e]; }
                    WS32(F, u32x4, (unsigned)WS_R + o * 2u) = pack8(zrt); WS32(F, u32x4, (unsigned)WS_V + o * 2u) = pack8(zvt);
                    float kk[8];
                    { float ss = 0.f;
#pragma unroll
                      for (int e = 0; e < 8; ++e) { kk[e] = zkt[e] * kkw[e]; ss += kk[e] * kk[e]; }
                      ss += __shfl_xor(ss, 1); ss += __shfl_xor(ss, 2); ss += __shfl_xor(ss, 4);
                      const float inv = 1.f / fmaxf(sqrtf(ss), 1e-12f);
#pragma unroll
                      for (int e = 0; e < 8; ++e) kk[e] *= inv;
                      WS32(F, u32x4, (unsigned)WS_KK + o * 2u) = pack8(kk); }
                    {
                        float pw0[8], pw1[8], d0[8], d1[8];
                        unpack8(*(const LAS u32x4*)(pp), pw0); unpack8(*(const LAS u32x4*)(pp + PA), pw1);
#pragma unroll
                        for (int e = 0; e < 8; ++e) {
                            d0[e] = 0.6065306597126334f * __builtin_amdgcn_rcpf(1.f + __expf(-(w00[e] + pw0[e]))); d1[e] = 0.6065306597126334f * __builtin_amdgcn_rcpf(1.f + __expf(-(w01[e] + pw1[e]))); }
                        WS32(F, u32x4, (unsigned)WS_WDEC + o * 2u) = pack8(d0); WS32(F, u32x4, (unsigned)WS_WDEC + ((unsigned)(MTOK * 1024) + o) * 2u) = pack8(d1);
                    }
                    {
                        float pa0[8], pa1[8], kd0[8], kd1[8], b0v[8], b1v[8]; float bs = 0.f;
                        unpack8(*(const LAS u32x4*)(pp + 2 * PA), pa0); unpack8(*(const LAS u32x4*)(pp + 3 * PA), pa1);
#pragma unroll
                        for (int e = 0; e < 8; ++e) {
                            const float av0 = __builtin_amdgcn_rcpf(1.f + __expf(-(a00[e] + pa0[e]))), av1 = __builtin_amdgcn_rcpf(1.f + __expf(-(a01[e] + pa1[e])));
                            kd0[e] = zkt[e] * (1.f + (av0 - 1.f) * kac[e]); kd1[e] = zkt[e] * (1.f + (av1 - 1.f) * kac[e]);
                            b0v[e] = kk[e] * av0; b1v[e] = kk[e] * av1;
                            bs += zrt[e] * (kd0[e] + kd1[e]) * rkc[e]; }
                        bs += __shfl_xor(bs, 1); bs += __shfl_xor(bs, 2); bs += __shfl_xor(bs, 4);
                        if ((chk & 7) == 0) WS32(F, float, (unsigned)WS_BONUS + ((unsigned)(m0 + tkn) * 16u + (unsigned)(8 * hf + (chk >> 3))) * 4u) = bs;
                        WS32(F, u32x4, (unsigned)WS_KD + o * 2u) = pack8(kd0); WS32(F, u32x4, (unsigned)WS_KD + ((unsigned)(MTOK * 1024) + o) * 2u) = pack8(kd1);
                        WS32(F, u32x4, (unsigned)WS_BB + o * 2u) = pack8(b0v); WS32(F, u32x4, (unsigned)WS_BB + ((unsigned)(MTOK * 1024) + o) * 2u) = pack8(b1v);
                    }
                    WS32(F, u32x4, (unsigned)WS_G + o * 2u) = *(const LAS u32x4*)(pp + 4 * PA);
                }
            }
            __syncthreads();
        }
    }
}

__device__ __forceinline__ void p4_scan(Frame& F, const int mode = 0) {
    constexpr int CH = 32, NCH = SEQ / CH;
    constexpr int VEC = CH * 64 * 4;
    constexpr int BUF = 5 * VEC + CH * 32 * 4;
    constexpr int YOFF = 2 * BUF, YB = CH * 32 * 4;
    constexpr int CVT_SCR = 2 * BUF + 2 * YB;
    const bf16_t* Wdec = WSP(F, WS_WDEC, bf16_t); const bf16_t* KDg = WSP(F, WS_KD, bf16_t); const bf16_t* BBg = WSP(F, WS_BB, bf16_t);
    const bf16_t* Rg = WSP(F, WS_R, bf16_t); const bf16_t* KKg = WSP(F, WS_KK, bf16_t); const bf16_t* Vg = WSP(F, WS_V, bf16_t); bf16_t* YS = WSP(F, WS_YS, bf16_t);
    const int tid = F.tid, lane = F.lane, wid = F.wave;
    const bool is_comp = wid < 4;
    const int ri = wid & 3;
    if (is_comp) __builtin_amdgcn_s_setprio(3);
    const int g = lane >> 3, j = lane & 7, rowl = ri * 8 + g;
    const int mt = ri * 64 + lane, mw = ri;
    int cvt_it = F.vcu * 4 + mw; f32x4 cvv[16]; int ck0 = 0, crowb = 0; unsigned char* cWT = nullptr;
    f32x4 cvvB[16]; int ck0B = 0, crowbB = 0; unsigned char* cWTB = nullptr;
    LAS unsigned* st_cnt = (LAS unsigned*)(F.lds + CVT_SCR + 4 * 4096); LAS unsigned* cons_cnt = st_cnt + 16;
    for (int item = F.vcu; item < 256; item += F.G) {
        const int chain = item >> 1, half = item & 1, d = chain >> 6, b = (chain >> 4) & 3, h = chain & 15;
        const size_t sh = (size_t)b * SEQ * 1024 + h * 64, pd = (size_t)d * MTOK * 1024 + sh;
        f32x2 S2[4] = {{0.f, 0.f}, {0.f, 0.f}, {0.f, 0.f}, {0.f, 0.f}};
        u32x2 rw[2], rkk[2], rbb[2], rkd[2], rr[2]; unsigned rv[2];
        const int cstep = d ? -CH * 1024 : CH * 1024;
        unsigned po[2], pv[2];
#pragma unroll
        for (int q_ = 0; q_ < 2; ++q_) { const int sl_ = mt + 256 * q_, ss_ = sl_ >> 4, sk_ = (sl_ & 15) * 4, tq_ = d ? (SEQ - 1 - ss_) : ss_; po[q_] = (unsigned)(tq_ * 1024 + sk_); pv[q_] = (unsigned)(tq_ * 1024 + half * 32 + 2 * (sl_ & 15)); }
        const char* bW = (const char*)(Wdec + pd); const char* bKK = (const char*)(KKg + sh); const char* bBB = (const char*)(BBg + pd); const char* bKD = (const char*)(KDg + pd); const char* bR = (const char*)(Rg + sh); const char* bV = (const char*)(Vg + sh);
#define SC_LOAD(c) do { const unsigned cu_ = (unsigned)((c) * cstep); _Pragma("unroll") for (int q_ = 0; q_ < 2; ++q_) { const unsigned e_ = po[q_] + cu_; \
        rw[q_] = *(const u32x2*)(bW + (size_t)(e_ * 2u)); rkk[q_] = *(const u32x2*)(bKK + (size_t)(e_ * 2u)); rbb[q_] = *(const u32x2*)(bBB + (size_t)(e_ * 2u)); rkd[q_] = *(const u32x2*)(bKD + (size_t)(e_ * 2u)); rr[q_] = *(const u32x2*)(bR + (size_t)(e_ * 2u)); \
        rv[q_] = *(const unsigned*)(bV + (size_t)((pv[q_] + cu_) * 2u)); } } while (0)
#define SC_STORE(bufi) do { LAS unsigned char* bp_ = F.lds + (bufi) * BUF; _Pragma("unroll") for (int q_ = 0; q_ < 2; ++q_) { const int sl_ = mt + 256 * q_, ss_ = sl_ >> 4, sk_ = (sl_ & 15) * 4; const int o_ = (ss_ * 64 + sk_) * 4; \
        *(LAS f32x4*)(bp_ + o_) = (f32x4){__expf(-bf_lo(rw[q_].x)), __expf(-bf_hi(rw[q_].x)), __expf(-bf_lo(rw[q_].y)), __expf(-bf_hi(rw[q_].y))}; \
        *(LAS f32x4*)(bp_ + VEC + o_) = (f32x4){bf_lo(rkk[q_].x), bf_hi(rkk[q_].x), bf_lo(rkk[q_].y), bf_hi(rkk[q_].y)}; \
        *(LAS f32x4*)(bp_ + 2 * VEC + o_) = (f32x4){bf_lo(rbb[q_].x), bf_hi(rbb[q_].x), bf_lo(rbb[q_].y), bf_hi(rbb[q_].y)}; \
        *(LAS f32x4*)(bp_ + 3 * VEC + o_) = (f32x4){bf_lo(rkd[q_].x), bf_hi(rkd[q_].x), bf_lo(rkd[q_].y), bf_hi(rkd[q_].y)}; \
        *(LAS f32x4*)(bp_ + 4 * VEC + o_) = (f32x4){bf_lo(rr[q_].x), bf_hi(rr[q_].x), bf_lo(rr[q_].y), bf_hi(rr[q_].y)}; \
        *(LAS f32x2*)(bp_ + 5 * VEC + (ss_ * 32 + 2 * (sl_ & 15)) * 4) = (f32x2){bf_lo(rv[q_]), bf_hi(rv[q_])}; } } while (0)
#define Y_OUT(c) do { const int ys_ = mt >> 3, yr_ = (mt & 7) * 4; const int tt_ = (c) * CH + ys_, t_ = d ? (SEQ - 1 - tt_) : tt_; \
        const f32x4 yv_ = *(const LAS f32x4*)(F.lds + YOFF + ((c) & 1) * YB + (ys_ * 32 + yr_) * 4); \
        *(u32x2*)(YS + pd + (size_t)t_ * 1024 + half * 32 + yr_) = (u32x2){cvtpk(yv_.x, yv_.y), cvtpk(yv_.z, yv_.w)}; } while (0)
#define SC_WAIT(cnt_, tgt_) do { for (;;) { const u32x4 q_ = *(volatile LAS u32x4*)(cnt_); const unsigned a_ = q_.x < q_.y ? q_.x : q_.y, b_ = q_.z < q_.w ? q_.z : q_.w; \
        if ((a_ < b_ ? a_ : b_) >= (tgt_)) break; if (is_comp) __builtin_amdgcn_s_sleep(1); else __builtin_amdgcn_s_sleep(12); } asm volatile("" ::: "memory"); } while (0)
#define SC_SIGNAL(cnt_, val_) do { asm volatile("s_waitcnt lgkmcnt(0)" ::: "memory"); if (lane == 0) *(volatile LAS unsigned*)((cnt_) + ri) = (val_); } while (0)
        __syncthreads();
        if (tid < 4) { st_cnt[tid] = 0u; cons_cnt[tid] = 0u; }
        if (!is_comp) { SC_LOAD(0); SC_STORE(0); SC_LOAD(1); }
        __syncthreads();
        if (is_comp) {
          for (int c = 0; c < NCH; ++c) {
            SC_WAIT(st_cnt, (unsigned)c);
            if (mode != 2) {
                const LAS unsigned char* bp = F.lds + (c & 1) * BUF;
                LAS float* yb = (LAS float*)(F.lds + YOFF + (c & 1) * YB);
                f32x4 cw_[2], ckk[2], cbb[2], ckd[2], cr[2]; float cv;
#define SC_RD(s_) do { const int o_ = ((s_) * 64 + j * 8) * 4; cw_[0] = *(const LAS f32x4*)(bp + o_); cw_[1] = *(const LAS f32x4*)(bp + o_ + 16); ckk[0] = *(const LAS f32x4*)(bp + VEC + o_); ckk[1] = *(const LAS f32x4*)(bp + VEC + o_ + 16); \
                cbb[0] = *(const LAS f32x4*)(bp + 2 * VEC + o_); cbb[1] = *(const LAS f32x4*)(bp + 2 * VEC + o_ + 16); ckd[0] = *(const LAS f32x4*)(bp + 3 * VEC + o_); ckd[1] = *(const LAS f32x4*)(bp + 3 * VEC + o_ + 16); \
                cr[0] = *(const LAS f32x4*)(bp + 4 * VEC + o_); cr[1] = *(const LAS f32x4*)(bp + 4 * VEC + o_ + 16); cv = *(const LAS float*)(bp + 5 * VEC + ((s_) * 32 + rowl) * 4); } while (0)
#define H2(v_, i_) ((f32x2){v_[(i_) >> 1][((i_) & 1) * 2], v_[(i_) >> 1][((i_) & 1) * 2 + 1]})
                SC_RD(0);
                float yk = 0.f;
#pragma unroll
                for (int s = 0; s < CH; ++s) {
                    f32x4 w[2] = {cw_[0], cw_[1]}, kk[2] = {ckk[0], ckk[1]}, bb[2] = {cbb[0], cbb[1]}, kd[2] = {ckd[0], ckd[1]}, r[2] = {cr[0], cr[1]}; const float v = cv;
                    if (s + 1 < CH) SC_RD(s + 1);
                    f32x2 pa = S2[0] * H2(kk, 0), pb = S2[1] * H2(kk, 1); pa = S2[2] * H2(kk, 2) + pa; pb = S2[3] * H2(kk, 3) + pb; pa = pa + pb;
                    const f32x2 vv = {v, v};
                    f32x2 u[4];
#pragma unroll
                    for (int i = 0; i < 4; ++i) u[i] = S2[i] * H2(w, i) + vv * H2(kd, i);
                    float p = pa.x + pa.y;
                    p = dpp_add<0xB1>(p); p = dpp_add<0x4E>(p); p = dpp_add<0x141>(p);
                    const f32x2 sa = {-p, -p};
#pragma unroll
                    for (int i = 0; i < 4; ++i) S2[i] = sa * H2(bb, i) + u[i];
                    f32x2 ya = S2[0] * H2(r, 0), yc = S2[1] * H2(r, 1); ya = S2[2] * H2(r, 2) + ya; yc = S2[3] * H2(r, 3) + yc; ya = ya + yc;
                    float y = ya.x + ya.y;
                    y = dpp_add<0xB1>(y); y = dpp_add<0x4E>(y); y = dpp_add<0x141>(y);
                    yk = (j == (s & 7)) ? y : yk;
                    if ((s & 7) == 7) yb[((s & 24) + j) * 32 + rowl] = yk;
                }
#undef SC_RD
#undef H2
            }
            SC_SIGNAL(cons_cnt, (unsigned)(c + 1));
          }
        } else {
#define MEM_DUTIES(c_) do { SC_WAIT(cons_cnt, (unsigned)(c_)); if ((c_) >= 1 && mode != 2) Y_OUT((c_) - 1); if ((c_) + 1 < NCH) SC_STORE(((c_) + 1) & 1); SC_SIGNAL(st_cnt, (unsigned)((c_) + 1)); if ((c_) + 2 < NCH) SC_LOAD((c_) + 2); } while (0)
#define CVT_LOAD_SET(V_, K0_, WT_, RB_) do { const int it_ = cvt_it < N_EXPERT_ITEMS ? cvt_it : N_EXPERT_ITEMS - 1; const float* cW_; int cn0_; cvt_expert_decode(F, it_, cW_, K0_, cn0_, WT_, RB_); cvt8_load(V_, cW_, K0_, cn0_, lane); cvt_it += F.G * 4; } while (0)
          int ngrp = 0; { const int left = (N_EXPERT_ITEMS - cvt_it + F.G * 4 - 1) / (F.G * 4); ngrp = left > 0 ? left / 3 : 0; if (ngrp > NCH / 4) ngrp = NCH / 4; }
          int cg = 0;
#pragma unroll 1
          for (; cg < 4 * ngrp; cg += 4) {
            MEM_DUTIES(cg);
#if CVT_IN_SCAN
            if (cg > 0) cvt8_finish(cvv, ck0, cWT, crowb, lane);
            CVT_LOAD_SET(cvv, ck0, cWT, crowb);
#endif
            MEM_DUTIES(cg + 1);
#if CVT_IN_SCAN
            CVT_LOAD_SET(cvvB, ck0B, cWTB, crowbB);
#endif
            MEM_DUTIES(cg + 2);
#if CVT_IN_SCAN
            cvt8_finish(cvv, ck0, cWT, crowb, lane);
            CVT_LOAD_SET(cvv, ck0, cWT, crowb);
#endif
            MEM_DUTIES(cg + 3);
#if CVT_IN_SCAN
            cvt8_finish(cvvB, ck0B, cWTB, crowbB, lane);
#endif
          }
#if CVT_IN_SCAN
          if (ngrp > 0) cvt8_finish(cvv, ck0, cWT, crowb, lane);
#endif
#pragma unroll 1
          for (; cg < NCH; ++cg) MEM_DUTIES(cg);
#undef MEM_DUTIES
#undef CVT_LOAD_SET
          SC_WAIT(cons_cnt, (unsigned)NCH);
        }
        if (!is_comp && mode != 2) Y_OUT(NCH - 1);
#undef SC_LOAD
#undef SC_STORE
#undef Y_OUT
#undef SC_WAIT
#undef SC_SIGNAL
    }
    __builtin_amdgcn_s_setprio(0);
#if CVT_IN_SCAN
    if (!is_comp) {
        for (; cvt_it < N_EXPERT_ITEMS; cvt_it += F.G * 4) {
            const float* W; int k0, n0, rowb; unsigned char* WT;
            cvt_expert_decode(F, cvt_it, W, k0, n0, WT, rowb); cvt8_load(cvv, W, k0, n0, lane); cvt8_finish(cvv, k0, WT, rowb, lane);
        }
    }
#endif
}

__device__ __forceinline__ void p5_finalize(Frame& F) {
    const bf16_t* OC = WSP(F, WS_OC, bf16_t); const bf16_t* YS = WSP(F, WS_YS, bf16_t); const bf16_t* Vg = WSP(F, WS_V, bf16_t); const bf16_t* Gg = WSP(F, WS_G, bf16_t);
    const float* BON = WSP(F, WS_BONUS, float); bf16_t* MIX = WSP(F, WS_MIX, bf16_t);
    const float* subw = INP(F, 10, float); const float* lnw = INP(F, 19, float); const float* lnb = INP(F, 20, float);
    const int lane = F.lane, gw = F.vcu * 8 + F.wave, NGW = F.G * 8;
    float lam;
    { const float q1 = INP(F, 6, float)[lane] * INP(F, 7, float)[lane], q2 = INP(F, 8, float)[lane] * INP(F, 9, float)[lane];
      lam = __expf(wave_sum(q1)) - __expf(wave_sum(q2)) + 0.2f; }
    const int c0 = lane * 16;
    float sw[16], lw[16], lb[16];
#pragma unroll
    for (int i = 0; i < 16; ++i) { sw[i] = subw[(c0 + i) & 127] * 0.8f; lw[i] = lnw[c0 + i]; lb[i] = lnb[c0 + i]; }
    for (int m = gw; m < MTOK; m += NGW) {
        { const u32x4* p0 = (const u32x4*)(OC + (size_t)m * 1024 + c0); const u32x4* p1 = (const u32x4*)(OC + (size_t)MTOK * 1024 + (size_t)m * 1024 + c0);
          const u32x4 a0 = p0[0], a1 = p0[1], b0 = p1[0], b1 = p1[1];
          float dv[16]; const unsigned aw[8] = {a0.x, a0.y, a0.z, a0.w, a1.x, a1.y, a1.z, a1.w}, bw[8] = {b0.x, b0.y, b0.z, b0.w, b1.x, b1.y, b1.z, b1.w};
          float ssq = 0.f;
#pragma unroll
          for (int i = 0; i < 8; ++i) { dv[2 * i] = bf_lo(aw[i]) - lam * bf_lo(bw[i]); dv[2 * i + 1] = bf_hi(aw[i]) - lam * bf_hi(bw[i]); ssq += dv[2 * i] * dv[2 * i] + dv[2 * i + 1] * dv[2 * i + 1]; }
          ssq += __shfl_xor(ssq, 1); ssq += __shfl_xor(ssq, 2); ssq += __shfl_xor(ssq, 4);
          const float rstd = 1.f / sqrtf(ssq * (1.f / 128.f) + 1e-5f);
          unsigned ow[8];
#pragma unroll
          for (int i = 0; i < 8; ++i) ow[i] = cvtpk(dv[2 * i] * rstd * sw[2 * i], dv[2 * i + 1] * rstd * sw[2 * i + 1]);
          u32x4* op = (u32x4*)(MIX + (size_t)m * 2048 + c0); op[0] = (u32x4){ow[0], ow[1], ow[2], ow[3]}; op[1] = (u32x4){ow[4], ow[5], ow[6], ow[7]}; }
        { const u32x4* y0 = (const u32x4*)(YS + (size_t)m * 1024 + c0); const u32x4* y1 = (const u32x4*)(YS + (size_t)MTOK * 1024 + (size_t)m * 1024 + c0);
          float y[16]; float s = 0.f;
          { const u32x4 a0 = y0[0], a1 = y0[1], b0 = y1[0], b1 = y1[1];
            const unsigned aw[8] = {a0.x, a0.y, a0.z, a0.w, a1.x, a1.y, a1.z, a1.w}, bw[8] = {b0.x, b0.y, b0.z, b0.w, b1.x, b1.y, b1.z, b1.w};
#pragma unroll
            for (int i = 0; i < 8; ++i) { y[2 * i] = bf_lo(aw[i]) + bf_lo(bw[i]); y[2 * i + 1] = bf_hi(aw[i]) + bf_hi(bw[i]); } }
#pragma unroll
          for (int i = 0; i < 16; ++i) s += y[i];
          s += __shfl_xor(s, 1); s += __shfl_xor(s, 2);
          const float mu = s * (1.f / 64.f); float q = 0.f;
#pragma unroll
          for (int i = 0; i < 16; ++i) { y[i] -= mu; q += y[i] * y[i]; }
          q += __shfl_xor(q, 1); q += __shfl_xor(q, 2);
          const float rstd = 1.f / sqrtf(q * (1.f / 64.f) + 64e-5f);
          const float bon = BON[(size_t)m * 16 + (lane >> 2)];
          const u32x4* vp = (const u32x4*)(Vg + (size_t)m * 1024 + c0); const u32x4* gp = (const u32x4*)(Gg + (size_t)m * 1024 + c0);
          const u32x4 v0 = vp[0], v1 = vp[1], g0 = gp[0], g1 = gp[1];
          const unsigned vw[8] = {v0.x, v0.y, v0.z, v0.w, v1.x, v1.y, v1.z, v1.w}, gq[8] = {g0.x, g0.y, g0.z, g0.w, g1.x, g1.y, g1.z, g1.w};
          unsigned ow[8];
#pragma unroll
          for (int i = 0; i < 8; ++i) {
              const float e0 = (y[2 * i] * rstd * lw[2 * i] + lb[2 * i] + bon * bf_lo(vw[i])) * bf_lo(gq[i]);
              const float e1 = (y[2 * i + 1] * rstd * lw[2 * i + 1] + lb[2 * i + 1] + bon * bf_hi(vw[i])) * bf_hi(gq[i]);
              ow[i] = cvtpk(e0, e1); }
          u32x4* op = (u32x4*)(MIX + (size_t)m * 2048 + 1024 + c0); op[0] = (u32x4){ow[0], ow[1], ow[2], ow[3]}; op[1] = (u32x4){ow[4], ow[5], ow[6], ow[7]}; }
    }
}

__device__ __forceinline__ void p7_router(Frame& F) {
    const bf16_t* X1 = WSP(F, WS_X1, bf16_t); const float* nw = INP(F, 22, float); const float* wr = INP(F, 23, float);
    unsigned char* H2 = WSP(F, WS_H2, unsigned char); float* AFF = WSP(F, WS_AFF, float);
    const int lane = F.lane, tid = F.tid, gw = F.vcu * 8 + F.wave, NGW = F.G * 8;
    volatile LAS unsigned* MISC = (volatile LAS unsigned*)(F.lds + MISC_OFF);
    const unsigned m8 = MISC[8], m9 = MISC[9];
    __syncthreads();
    for (int f = tid; f < 2048 * 4; f += 512) { const int col = f >> 2, q = f & 3; *(LAS f32x4*)(F.lds + (col >> 2) * 272 + (col & 3) * 64 + q * 16) = *(const f32x4*)(wr + (size_t)col * 16 + 4 * q); }
    __syncthreads();
    for (int pr = gw; pr < MTOK / 2; pr += NGW) {
        const int m = 2 * pr;
        const u32x2* xr0 = (const u32x2*)(X1 + (size_t)m * DM) + lane; const u32x2* xr1 = xr0 + DM / 4;
        f32x4 v0[8], v1[8]; float s0 = 0.f, s1 = 0.f;
#pragma unroll
        for (int j = 0; j < 8; ++j) { const u32x2 a_ = xr0[64 * j], b_ = xr1[64 * j]; v0[j] = (f32x4){bf_lo(a_.x), bf_hi(a_.x), bf_lo(a_.y), bf_hi(a_.y)}; v1[j] = (f32x4){bf_lo(b_.x), bf_hi(b_.x), bf_lo(b_.y), bf_hi(b_.y)}; }
#pragma unroll
        for (int j = 0; j < 8; ++j) { s0 += (v0[j].x * v0[j].x + v0[j].y * v0[j].y) + (v0[j].z * v0[j].z + v0[j].w * v0[j].w); s1 += (v1[j].x * v1[j].x + v1[j].y * v1[j].y) + (v1[j].z * v1[j].z + v1[j].w * v1[j].w); }
        const float r0 = 1.f / sqrtf(wave_sum(s0) * (1.f / DM) + 1e-6f), r1 = 1.f / sqrtf(wave_sum(s1) * (1.f / DM) + 1e-6f);
        unsigned* o0 = (unsigned*)(H2 + (size_t)m * DM) + lane; unsigned* o1 = o0 + DM / 4;
        float acc[32];
#pragma unroll
        for (int i = 0; i < 32; ++i) acc[i] = 0.f;
#pragma unroll
        for (int j = 0; j < 8; ++j) {
            const f32x4 w = ((const f32x4*)nw)[lane + 64 * j];
            const f32x4 a = v0[j] * w * r0, b = v1[j] * w * r1;
            o0[64 * j] = pg8::cvt4_fp8(a.x, a.y, a.z, a.w);
            o1[64 * j] = pg8::cvt4_fp8(b.x, b.y, b.z, b.w);
            const LAS f32x4* wp = (const LAS f32x4*)(F.lds + (lane + 64 * j) * 272);
#pragma unroll
            for (int i = 0; i < 4; ++i) {
#pragma unroll
                for (int q = 0; q < 4; ++q) { const f32x4 ww = wp[i * 4 + q];
#pragma unroll
                    for (int e = 0; e < 4; ++e) { acc[4 * q + e] += a[i] * ww[e]; acc[16 + 4 * q + e] += b[i] * ww[e]; } }
                asm volatile("" ::: "memory");
            }
        }
#define RSTAGE(N_, B_) do { const bool up_ = (lane & (B_)) != 0; _Pragma("unroll") for (int k = 0; k < (N_); ++k) { const float lo_ = acc[k], hi_ = acc[(N_) + k]; \
            const float snd_ = up_ ? lo_ : hi_, kp_ = up_ ? hi_ : lo_; acc[k] = kp_ + __shfl_xor(snd_, (B_)); } } while (0)
        RSTAGE(16, 32); RSTAGE(8, 16); RSTAGE(4, 8); RSTAGE(2, 4); RSTAGE(1, 2);
#undef RSTAGE
        float lg = acc[0] + __shfl_xor(acc[0], 1);
        float mx = lg;
        mx = fmaxf(mx, __shfl_xor(mx, 2)); mx = fmaxf(mx, __shfl_xor(mx, 4)); mx = fmaxf(mx, __shfl_xor(mx, 8)); mx = fmaxf(mx, __shfl_xor(mx, 16));
        const float p = expf(lg - mx);
        float den = p; den += __shfl_xor(den, 2); den += __shfl_xor(den, 4); den += __shfl_xor(den, 8); den += __shfl_xor(den, 16);
        if ((lane & 1) == 0) { const int row = lane >> 5, e = (lane >> 1) & 15, mm = m + row; AFF[((size_t)(mm >> 11) * 16 + e) * SEQ + (mm & (SEQ - 1))] = p / den; }
    }
    __syncthreads();
    if (tid == 0) { MISC[8] = m8; MISC[9] = m9; }
    __syncthreads();
}

__device__ __forceinline__ int wave_count4(bool f0, bool f1, bool f2, bool f3) {
    return __builtin_popcountll(__ballot(f0)) + __builtin_popcountll(__ballot(f1)) + __builtin_popcountll(__ballot(f2)) + __builtin_popcountll(__ballot(f3));
}
__device__ __forceinline__ void p8_select(Frame& F) {
    const float* AFF = WSP(F, WS_AFF, float);
    int* XEIDX = WSP(F, WS_XEIDX, int); float* GATEX = WSP(F, WS_GATEX, float); int* SLOT = WSP(F, WS_SLOT, int);
    LAS int* part = (LAS int*)F.lds;
    LAS unsigned* cnt = (LAS unsigned*)(F.lds + 256);
    LAS unsigned* list = (LAS unsigned*)(F.lds + 512);
    const int tid = F.tid, lane = F.lane, w = F.wave;
    for (int item = F.vcu; item < 256; item += F.G) {
        const int be = item >> 2, q = item & 3, b = be >> 4, e = be & 15;
        __syncthreads();
        if (tid == 0) *cnt = 0u;
        const f32x4 a4 = ((const f32x4*)(AFF + (size_t)be * SEQ))[tid];
        const unsigned u0 = __float_as_uint(a4.x), u1 = __float_as_uint(a4.y), u2 = __float_as_uint(a4.z), u3 = __float_as_uint(a4.w);
        unsigned lo = 0u, hi = 0x7f800001u;
        int itn = 0;
        while (hi - lo > 1u) {
            const unsigned mid = lo + ((hi - lo) >> 1);
            const int c = wave_count4(u0 >= mid, u1 >= mid, u2 >= mid, u3 >= mid);
            LAS int* pp = part + (itn & 1) * 8;
            if (lane == 0) pp[w] = c;
            __syncthreads();
            int tot = 0;
#pragma unroll
            for (int i = 0; i < 8; ++i) tot += pp[i];
            if (tot >= CAP) lo = mid; else hi = mid;
            ++itn;
        }
        const unsigned T = lo;
        const bool g0 = u0 > T, g1 = u1 > T, g2 = u2 > T, g3 = u3 > T, q0 = u0 == T, q1 = u1 == T, q2 = u2 == T, q3 = u3 == T;
        const unsigned long long bg0 = __ballot(g0), bg1 = __ballot(g1), bg2 = __ballot(g2), bg3 = __ballot(g3), bq0 = __ballot(q0), bq1 = __ballot(q1), bq2 = __ballot(q2), bq3 = __ballot(q3);
        const unsigned long long below = (lane == 0) ? 0ull : (~0ull >> (64 - lane));
        int pg = __builtin_popcountll(bg0 & below) + __builtin_popcountll(bg1 & below) + __builtin_popcountll(bg2 & below) + __builtin_popcountll(bg3 & below);
        int pq = __builtin_popcountll(bq0 & below) + __builtin_popcountll(bq1 & below) + __builtin_popcountll(bq2 & below) + __builtin_popcountll(bq3 & below);
        const int wg = __builtin_popcountll(bg0) + __builtin_popcountll(bg1) + __builtin_popcountll(bg2) + __builtin_popcountll(bg3);
        const int wq = __builtin_popcountll(bq0) + __builtin_popcountll(bq1) + __builtin_popcountll(bq2) + __builtin_popcountll(bq3);
        if (lane == 0) { part[16 + w] = wg; part[32 + w] = wq; }
        __syncthreads();
        int gtc = 0, baseg = 0, baseq = 0;
#pragma unroll
        for (int i = 0; i < 8; ++i) { const int x = part[16 + i], y = part[32 + i]; gtc += x; if (i < w) { baseg += x; baseq += y; } }
        const int need = CAP - gtc;
        pg += baseg; pq += baseq;
        if ((w >> 1) == q) {
            const bool gs[4] = {g0, g1, g2, g3}, qs[4] = {q0, q1, q2, q3}; const float av[4] = {a4.x, a4.y, a4.z, a4.w};
            int cg_ = pg, cq_ = pq;
#pragma unroll
            for (int i = 0; i < 4; ++i) {
                const int t = 4 * tid + i, m = b * SEQ + t; int slot = -1;
                if (gs[i]) { slot = cg_; ++cg_; } else if (qs[i]) { if (cq_ < need) slot = gtc + cq_; ++cq_; }
                SLOT[m * 16 + e] = slot;
                if (slot >= 0) { GATEX[(e * 4 + b) * CAP + slot] = av[i]; XEIDX[(e * 4 + b) * CAP + slot] = m; }
            }
        }
    }
}

__device__ __forceinline__ void p11_final(Frame& F) {
    const bf16_t* X1 = WSP(F, WS_X1, bf16_t); const bf16_t* YE = WSP(F, WS_YE, bf16_t); const int* SLOT = WSP(F, WS_SLOT, int); const float* nw = INP(F, 27, float);
    float* out = F.a->out;
    const int lane = F.lane, gw = F.vcu * 8 + F.wave, NGW = F.G * 8;
    for (int m = gw; m < MTOK; m += NGW) {
        const int b = m >> 11;
        float v[32];
        { const u32x4* xr = (const u32x4*)(X1 + (size_t)m * DM + lane * 8);
#pragma unroll
          for (int j = 0; j < 4; ++j) { const u32x4 a = xr[64 * j]; v[8 * j] = bf_lo(a.x); v[8 * j + 1] = bf_hi(a.x); v[8 * j + 2] = bf_lo(a.y); v[8 * j + 3] = bf_hi(a.y); v[8 * j + 4] = bf_lo(a.z); v[8 * j + 5] = bf_hi(a.z); v[8 * j + 6] = bf_lo(a.w); v[8 * j + 7] = bf_hi(a.w); } }
        int sl = (lane < 16) ? SLOT[m * 16 + lane] : -1;
        for (int e = 0; e < 16; ++e) {
            const int s = __shfl(sl, e);
            if (s >= 0) { const u32x4* yr = (const u32x4*)(YE + (size_t)((e * 4 + b) * CAP + s) * DM + lane * 8);
#pragma unroll
                for (int j = 0; j < 4; ++j) { const u32x4 w = yr[64 * j];
                    v[8 * j] += bf_lo(w.x); v[8 * j + 1] += bf_hi(w.x); v[8 * j + 2] += bf_lo(w.y); v[8 * j + 3] += bf_hi(w.y); v[8 * j + 4] += bf_lo(w.z); v[8 * j + 5] += bf_hi(w.z); v[8 * j + 6] += bf_lo(w.w); v[8 * j + 7] += bf_hi(w.w); } }
        }
        float s = 0.f;
#pragma unroll
        for (int i = 0; i < 32; ++i) s += v[i] * v[i];
        const float rstd = 1.f / sqrtf(wave_sum(s) * (1.f / DM) + 1e-6f);
#pragma unroll
        for (int j = 0; j < 4; ++j) { const int col = 512 * j + lane * 8; const f32x4 w0 = *(const f32x4*)(nw + col), w1 = *(const f32x4*)(nw + col + 4);
            f32x4 o0 = {v[8 * j] * rstd * w0.x, v[8 * j + 1] * rstd * w0.y, v[8 * j + 2] * rstd * w0.z, v[8 * j + 3] * rstd * w0.w};
            f32x4 o1 = {v[8 * j + 4] * rstd * w1.x, v[8 * j + 5] * rstd * w1.y, v[8 * j + 6] * rstd * w1.z, v[8 * j + 7] * rstd * w1.w};
            *(f32x4*)(out + (size_t)m * DM + col) = o0; *(f32x4*)(out + (size_t)m * DM + col + 4) = o1; }
    }
}


template <int PHM> __global__ void __launch_bounds__(512, 2) mk_fwd(Args args) {
    extern __shared__ __attribute__((aligned(16))) unsigned char lds[];
    Frame F;
    F.lds = (LAS unsigned char*)lds; F.ldsg = (char*)lds; F.a = &args;
    F.tid = threadIdx.x; F.lane = F.tid & 63; F.wave = __builtin_amdgcn_readfirstlane(F.tid >> 6);
    F.G = gridDim.x; { const int bx = blockIdx.x; F.vcu = (F.G % 8 == 0) ? (bx % 8) * (F.G / 8) + bx / 8 : bx; }
    volatile LAS unsigned* MISC = (volatile LAS unsigned*)(F.lds + MISC_OFF);
    for (int u = F.tid; u < (LDS_BYTES - 131072) / 4; u += 512) ((LAS unsigned*)(F.lds + 131072))[u] = 0u;
    __syncthreads();
    gu32* ctl = (gu32*)(args.ws + WS_CTL);
    XcdBarrier bar; bar.bar = (unsigned*)(ctl + CW_BAR); bar.x = 0; bar.st = nullptr;
    if (MK_N_LAUNCHES == 1) bar = xcd_barrier_post((unsigned*)(ctl + CW_BAR), MISC + 8);
    const int lo = args.ph_lo, hi = args.ph_hi;
#define IN(k) (((PHM >> (k)) & 1) && lo <= (k) && (k) < hi)
#ifndef DUP_MASK
#define DUP_MASK 0
#endif
#define REP(k) for (int rep_ = 0; rep_ < 1 + ((DUP_MASK >> (k)) & 1); ++rep_)
#define SEAM(k) do { if (IN(k) && IN((k) + 1)) xcd_barrier(bar); } while (0)

    if (IN(0)) REP(0) { p0_prologue(F); }
    SEAM(0);
    if (IN(1)) REP(1) {
        pg8::Gemm g{WSP(F, WS_H1, bf16_t), WSP(F, WS_WIN, bf16_t), MTOK, LDP, DM, DM}; pg8::StaticOrder S; S.init(MTOK, LDP, F.G, (int)blockIdx.x);
        pg8::EpiProj E{WSP(F, WS_PROJ, bf16_t), LDP, WSP(F, WS_ROPE, float), QSCALE};
        pg8::gemm_phase<pg8::EpiProj, pg8::StaticOrder, true, true>(F.lds, g, S, E);
    }
    SEAM(1);
    if (IN(2)) REP(2) {
        const bf16_t* P = WSP(F, WS_PROJ, bf16_t); bf16_t* OC = WSP(F, WS_OC, bf16_t);
        for (int u = F.vcu * 2; u < 512; u += F.G * 2)
            for (int i = 0; i < 2; ++i) {
                const int uu = u + i, qb = uu & 7, c = (uu >> 3) & 1, h = (uu >> 4) & 7, b = uu >> 7;
                const size_t m0 = (size_t)b * SEQ;
                att::attn_unit<LDP>(P + (m0 + qb * 256) * LDP + h * 128 + c * 64, P + m0 * LDP + 1024 + h * 128 + c * 64, P + m0 * LDP + 2048 + h * 128,
                                    OC + (size_t)c * MTOK * 1024 + (m0 + qb * 256) * 1024 + h * 128, SEQ, F.ldsg);
            }
    }
    if (IN(3)) REP(3) { p3_prep(F, rep_ ? 1 : 0); }
    SEAM(3);
    #ifndef SCAN_PROBE
#define SCAN_PROBE 0
#endif
    if (IN(4)) REP(4) { p4_scan(F, rep_ ? SCAN_PROBE : 0); }
    SEAM(4);
    if (IN(5)) REP(5) { p5_finalize(F); }
    SEAM(5);
    if (IN(6)) REP(6) {
        pg8::Gemm g{WSP(F, WS_MIX, bf16_t), WSP(F, WS_WOUT, bf16_t), MTOK, DM, DM, DM}; pg8::StaticOrder S; S.init(MTOK, DM, F.G, (int)blockIdx.x);
        pg8::EpiResid E{INP(F, 0, float), WSP(F, WS_X1, bf16_t), DM};
        pg8::gemm_phase<pg8::EpiResid, pg8::StaticOrder, true, true>(F.lds, g, S, E);
    }
    SEAM(6);
    if (IN(7)) REP(7) { p7_router(F); }
    SEAM(7);
    if (IN(8)) REP(8) { p8_select(F); }
    SEAM(8);
    if (IN(9)) REP(9) {
        pg8::Gemm g{WSP(F, WS_H2, bf16_t), WSP(F, WS_WGU, bf16_t), 16384, 65536, DM / 2, DM / 2}; pg8::MoeOrderT<true> S{F.G, F.vcu, 16, 1024, WSP(F, WS_XEIDX, int)};
        pg8::EpiSwiglu E{WSP(F, WS_HID, unsigned char), 16};
        pg8::gemm_phase<pg8::EpiSwiglu, pg8::MoeOrderT<true>, true, true, true>(F.lds, g, S, E);
    }
    SEAM(9);
    if (IN(10)) REP(10) {
        pg8::Gemm g{WSP(F, WS_HID, bf16_t), WSP(F, WS_WD, bf16_t), 16384, 32768, DM / 2, DM / 2}; pg8::MoeOrderT<false> S{F.G, F.vcu, 8, 512, nullptr};
        pg8::EpiDown E{WSP(F, WS_YE, bf16_t), WSP(F, WS_GATEX, float), 8};
        pg8::gemm_phase<pg8::EpiDown, pg8::MoeOrderT<false>, true, true, true>(F.lds, g, S, E);
    }
    SEAM(10);
    if (IN(11)) REP(11) { p11_final(F); }
#undef IN
#undef SEAM
}

static const void* kfn(int li) {
#if MK_N_LAUNCHES == 1
    (void)li; return (const void*)mk_fwd<0xFFF>;
#else
    switch (li) {
        case 0: return (const void*)mk_fwd<1>; case 1: return (const void*)mk_fwd<2>; case 2: return (const void*)mk_fwd<4>; case 3: return (const void*)mk_fwd<8>;
        case 4: return (const void*)mk_fwd<16>; case 5: return (const void*)mk_fwd<32>; case 6: return (const void*)mk_fwd<64>; case 7: return (const void*)mk_fwd<128>;
        case 8: return (const void*)mk_fwd<256>; case 9: return (const void*)mk_fwd<512>; case 10: return (const void*)mk_fwd<1024>; default: return (const void*)mk_fwd<2048>;
    }
#endif
}
extern "C" void kernel_launch(void* const* d_in, const int* in_sizes, int n_in, void* d_out, int out_size, void* d_ws, size_t ws_size, hipStream_t stream) {
    static int grid = 0;
    if (grid == 0) {
        if (n_in != 28 || out_size != MTOK * DM || ws_size < WS_END) { fprintf(stderr, "kernel_launch: unexpected shapes: n_in %d out %d ws %zu (need >= %zu)\n", n_in, out_size, ws_size, (size_t)WS_END); grid = -1; return; }
        int dev = 0, cus = 0, per_cu = 0;
        if (hipGetDevice(&dev) != hipSuccess || hipDeviceGetAttribute(&cus, hipDeviceAttributeMultiprocessorCount, dev) != hipSuccess) { fprintf(stderr, "kernel_launch: device query failed\n"); grid = -1; return; }
        for (int i = 0; i < MK_N_LAUNCHES; ++i) if (hipFuncSetAttribute(kfn(i), hipFuncAttributeMaxDynamicSharedMemorySize, LDS_BYTES) != hipSuccess) { fprintf(stderr, "kernel_launch: hipFuncSetAttribute failed\n"); grid = -1; return; }
        if (hipOccupancyMaxActiveBlocksPerMultiprocessor(&per_cu, kfn(0), 512, LDS_BYTES) != hipSuccess || per_cu < 1) { fprintf(stderr, "kernel_launch: occupancy query says %d blocks/CU\n", per_cu); }
        (void)hipGetLastError();
        grid = cus;
    }
    if (grid < 0) return;
    if (hipMemsetAsync((char*)d_ws + WS_CTL, 0, CTL_ZERO_BYTES, stream) != hipSuccess) { fprintf(stderr, "kernel_launch: memset failed\n"); return; }
    Args a{};
    for (int i = 0; i < 28; ++i) a.in[i] = d_in[i];
    a.out = (float*)d_out; a.ws = (unsigned char*)d_ws;
    const int nl = MK_N_LAUNCHES;
    for (int li = 0; li < nl; ++li) {
        a.ph_lo = (nl == 1) ? 0 : li; a.ph_hi = (nl == 1) ? N_PHASES : li + 1; a.li = li;
        void* kargs[] = {&a};
        (void)hipLaunchKernel(kfn(li), dim3(grid), dim3(512), kargs, LDS_BYTES, stream);
        const hipError_t le = hipPeekAtLastError();
        if (le != hipSuccess) { fprintf(stderr, "kernel_launch: launch %d failed: %s\n", li, hipGetErrorName(le)); break; }
    }
}
```

```cpp
#include <hip/hip_runtime.h>
#include <hip/hip_bf16.h>
#include <cstdio>
#include <cstdint>

#ifndef MK_N_LAUNCHES
#define MK_N_LAUNCHES 1
#endif
#ifndef CVT_IN_SCAN
#define CVT_IN_SCAN 1
#endif
constexpr int N_PHASES = 12;

constexpr int BATCH = 4, SEQ = 2048, DM = 2048, MTOK = BATCH * SEQ;
constexpr int IN_COLS = 6432, LDP = 6656;
constexpr int ZC0 = 3072;
constexpr int RW = 1024, NH_R = 16, HD_R = 64;
constexpr int NEXP = 16, CAP = 256, FF = 2048;
constexpr float QSCALE = 0.18033688011112042f;

constexpr size_t MiB = 1u << 20;
constexpr size_t WS_CTL = 0, CTL_ZERO_BYTES = 1 * MiB;
constexpr size_t WS_ROPE = 1 * MiB;
constexpr size_t WS_LORA = 2 * MiB;
constexpr size_t WS_AFF = 3 * MiB;
constexpr size_t WS_GATEX = 3 * MiB + 512 * 1024;
constexpr size_t WS_SLOT = 4 * MiB;
constexpr size_t WS_XEIDX = 6 * MiB;
constexpr size_t WS_BONUS = 5 * MiB;
constexpr size_t WS_WIN = 8 * MiB;
constexpr size_t WS_WOUT = 34 * MiB;
constexpr size_t WS_WGU = 48 * MiB;
constexpr size_t WS_WD = 304 * MiB;
constexpr size_t WS_H1 = 432 * MiB;
constexpr size_t WS_PROJ = 464 * MiB;
constexpr size_t WS_R = 568 * MiB, WS_KK = 584 * MiB, WS_V = 600 * MiB;
constexpr size_t WS_WDEC = 616 * MiB;
constexpr size_t WS_KD = 680 * MiB, WS_BB = 712 * MiB;
constexpr size_t WS_G = 744 * MiB;
constexpr size_t WS_OC = 760 * MiB;
constexpr size_t WS_YS = 792 * MiB;
constexpr size_t WS_MIX = 856 * MiB;
constexpr size_t WS_X1 = 888 * MiB;
constexpr size_t WS_H2 = 952 * MiB;
constexpr size_t WS_HID = 528 * MiB, WS_YE = 592 * MiB;
constexpr size_t WS_PART = WS_X1;
constexpr size_t WS_END = 984 * MiB;
constexpr int CW_BAR = 4096;

constexpr int LDS_BYTES = 147456;
constexpr int MISC_OFF = 131072 + 320;

#define GAS __attribute__((address_space(1)))
#define LAS __attribute__((address_space(3)))
typedef unsigned short bf16_t;
typedef float f32x4 __attribute__((ext_vector_type(4)));
typedef float f32x2 __attribute__((ext_vector_type(2)));
typedef float f32x16 __attribute__((ext_vector_type(16)));
typedef unsigned u32x4 __attribute__((ext_vector_type(4)));
typedef unsigned u32x2 __attribute__((ext_vector_type(2)));
typedef short bf16x8 __attribute__((ext_vector_type(8)));
typedef short s16x4 __attribute__((ext_vector_type(4)));
typedef __bf16 bf16x2_t __attribute__((ext_vector_type(2)));

__device__ __forceinline__ unsigned cvtpk(float lo, float hi) { f32x2 v = {lo, hi}; bf16x2_t b = __builtin_convertvector(v, bf16x2_t); return __builtin_bit_cast(unsigned, b); }
__device__ __forceinline__ float bf_lo(unsigned w) { return __uint_as_float(w << 16); }
__device__ __forceinline__ float bf_hi(unsigned w) { return __uint_as_float(w & 0xffff0000u); }
__device__ __forceinline__ float bf2f(bf16_t v) { return __uint_as_float((unsigned)v << 16); }
__device__ __forceinline__ float wave_sum(float v) {
#pragma unroll
    for (int o = 1; o < 64; o <<= 1) v += __shfl_xor(v, o);
    return v;
}
__device__ __forceinline__ float sigmoidf_(float x) { return 1.f / (1.f + __expf(-x)); }

struct Args { const void* in[28]; float* out; unsigned char* ws; int ph_lo, ph_hi, li, pad; };

namespace pg8 {
#define PG8_LAS __attribute__((address_space(3)))
typedef unsigned short bf16_t;
typedef short bf16x8 __attribute__((ext_vector_type(8)));
typedef float f32x4 __attribute__((ext_vector_type(4)));
typedef unsigned u32x4 __attribute__((ext_vector_type(4)));
typedef unsigned u32x2 __attribute__((ext_vector_type(2)));
typedef int i32x4 __attribute__((ext_vector_type(4)));
typedef int i32x8 __attribute__((ext_vector_type(8)));
typedef float f32x8 __attribute__((ext_vector_type(8)));
typedef float f32x32 __attribute__((ext_vector_type(32)));
constexpr int BM = 256, BK = 64, HALF = 128, HTB = HALF * BK * 2  , STAGE_BYTES = 8 * HTB, NXCD = 8, WGM = 8;

__host__ __device__ __forceinline__ int lds_byte(int r, int c) { const int st = (r >> 4) * 2 + (c >> 5), rr = r & 15, cc = c & 31, ob = rr * 64 + cc * 2; return st * 1024 + (ob ^ (((ob >> 9) & 1) << 5)); }
__host__ __device__ __forceinline__ void stage_rc(int b, int& R, int& C) { const int st = b / 1024, sb = b % 1024, swz = sb ^ (((sb >> 9) & 1) << 5); R = (st >> 1) * 16 + swz / 64; C = (st & 1) * 32 + (swz % 64) / 2; }
__host__ __device__ __forceinline__ int perm32(int rho) { const int n = rho >> 4, i = rho & 15; return 8 * (i >> 2) + 4 * n + (i & 3); }

struct Unit { int pm, pn, pk; };
struct Gemm { const bf16_t* A; const bf16_t* Bt; int M, N, K, Kp; };

struct StaticOrder {
    int nM, nN, nwg, G, c;
    __host__ __device__ void init(int M, int N, int G_, int c_) { nM = M / BM; nN = N / BM; nwg = nM * nN; G = G_; c = c_; }
    __host__ __device__ bool next(int i, Unit& u) const {
        const long L = (long)i * G + c; if (L >= nwg) return false;
        int wgid = (int)L; { const int q = nwg / NXCD, r = nwg % NXCD, xcd = wgid % NXCD, off = wgid / NXCD; wgid = (xcd < r ? xcd * (q + 1) : r * (q + 1) + (xcd - r) * q) + off; }
        const int nig = WGM * nN, gid = wgid / nig, fm = gid * WGM, gsz = (nM - fm) < WGM ? (nM - fm) : WGM;
        u.pm = fm + ((wgid % nig) % gsz); u.pn = (wgid % nig) / gsz; u.pk = 0; return true;
    }
    static constexpr bool GATHER = false;
    __device__ __forceinline__ int arow(const Unit&, int) const { return 0; }
    __device__ __forceinline__ void a_ready(const Unit&) const {}
    __device__ __forceinline__ void done(const Unit&) const {}
};


typedef float f32x2 __attribute__((ext_vector_type(2)));
typedef __bf16 bf16x2_t __attribute__((ext_vector_type(2)));
__device__ __forceinline__ unsigned cvt_pk_bf16(float lo, float hi) { f32x2 v = {lo, hi}; bf16x2_t b = __builtin_convertvector(v, bf16x2_t); return __builtin_bit_cast(unsigned, b); }

template <bool GATHER_> struct MoeOrderT {
    static constexpr bool GATHER = GATHER_;
    int G, vcu, npn, total; const int* idx;
    __device__ __forceinline__ int arow(const Unit& u, int r) const { return idx[u.pm * BM + r]; }
    __device__ bool next(int i, Unit& u) const {
        const int L = i * G + vcu; if (L >= total) return false;
        const int per_e = 4 * npn, e = L / per_e, r = L % per_e;
        u.pm = e * 4 + (r & 3); u.pn = e * npn + (r >> 2); u.pk = 0; return true;
    }
    __device__ __forceinline__ void a_ready(const Unit&) const {}
    __device__ __forceinline__ void done(const Unit&) const {}
};

struct TailOrder {
    int G, c; static constexpr bool GATHER = false;
    __device__ bool next(int i, Unit& u) const { const int L = i * G + c; if (L >= 256) return false; u.pk = L & 3; const int t = L >> 2; u.pm = t & 31; u.pn = 24 + (t >> 5); return true; }
    __device__ __forceinline__ int arow(const Unit&, int) const { return 0; }
    __device__ __forceinline__ void a_ready(const Unit&) const {}
    __device__ __forceinline__ void done(const Unit&) const {}
};
struct EpiPart {
    static constexpr bool PERM = true, AFTER_DRAIN = false;
    bf16_t* P;
    __device__ __forceinline__ void operator()(const f32x4 (&acc)[2][2][4][2], const Unit& u, int wr, int wc, int fr, int fq) const {
        bf16_t* base = P + ((size_t)(((u.pn - 24) * 32 + u.pm) * 4 + u.pk) << 16);
        const int row0 = wr * 64 + fr, col0 = wc * 32 + 8 * fq;
        const bool thin = (u.pn == 25);
        if (thin && wc != 0) return;
#pragma unroll
        for (int ai = 0; ai < 2; ++ai)
#pragma unroll
            for (int m = 0; m < 4; ++m) {
                bf16_t* rowp = base + (row0 + ai * HALF + m * 16) * 256 + col0;
#pragma unroll
                for (int bj = 0; bj < 2; ++bj) { if (bj == 1 && thin) break; const f32x4 v0 = acc[ai][bj][m][0], v1 = acc[ai][bj][m][1];
                    u32x4 w; w.x = cvt_pk_bf16(v0[0], v0[1]); w.y = cvt_pk_bf16(v0[2], v0[3]); w.z = cvt_pk_bf16(v1[0], v1[1]); w.w = cvt_pk_bf16(v1[2], v1[3]);
                    *(u32x4*)(rowp + bj * HALF) = w; }
            }
    }
};

struct EpiProj {
    static constexpr bool PERM = true, AFTER_DRAIN = false;
    bf16_t* P; int ldp; const float* rope; float qscale;
    __device__ __forceinline__ void operator()(const f32x4 (&acc)[2][2][4][2], const Unit& u, int wr, int wc, int fr, int fq) const {
        const int row0 = u.pm * BM + wr * 64 + fr, colt = u.pn * BM, col0 = colt + wc * 32 + 8 * fq;
        const bool ropew = (colt < 2048) && ((wc & 1) == 0);
        const float sc = (colt < 1024) ? qscale : 1.f, sgn = (fq == 0) ? -1.f : 1.f;
#pragma unroll
        for (int ai = 0; ai < 2; ++ai)
#pragma unroll
            for (int m = 0; m < 4; ++m) {
                const int row = row0 + ai * HALF + m * 16;
                f32x4 c0 = {1.f, 1.f, 1.f, 1.f}, c1 = c0, s0 = {0.f, 0.f, 0.f, 0.f}, s1 = s0;
                if (ropew) { const f32x4* rp = (const f32x4*)(rope + (size_t)row * 16); c0 = rp[0]; c1 = rp[1]; s0 = rp[2]; s1 = rp[3]; }
                bf16_t* rowp = P + (size_t)row * ldp + col0;
#pragma unroll
                for (int bj = 0; bj < 2; ++bj) {
                    f32x4 v0 = acc[ai][bj][m][0], v1 = acc[ai][bj][m][1];
                    if (ropew) {
                        f32x4 p0, p1;
#pragma unroll
                        for (int i = 0; i < 4; ++i) { p0[i] = __shfl_xor(v0[i], 16); p1[i] = __shfl_xor(v1[i], 16); }
                        if (fq < 2) { v0 = v0 * c0 + (p0 * s0) * sgn; v1 = v1 * c1 + (p1 * s1) * sgn; }
                    }
                    v0 = v0 * sc; v1 = v1 * sc;
                    u32x4 w; w.x = cvt_pk_bf16(v0[0], v0[1]); w.y = cvt_pk_bf16(v0[2], v0[3]); w.z = cvt_pk_bf16(v1[0], v1[1]); w.w = cvt_pk_bf16(v1[2], v1[3]);
                    *(u32x4*)(rowp + bj * HALF) = w;
                }
            }
    }
};

struct EpiResid {
    static constexpr bool PERM = true, AFTER_DRAIN = false;
    const float* base; bf16_t* out; int ldc;
    __device__ __forceinline__ void operator()(const f32x4 (&acc)[2][2][4][2], const Unit& u, int wr, int wc, int fr, int fq) const {
        const int row0 = u.pm * BM + wr * 64 + fr, col0 = u.pn * BM + wc * 32 + 8 * fq;
#pragma unroll
        for (int ai = 0; ai < 2; ++ai)
#pragma unroll
            for (int m = 0; m < 4; ++m) {
                const size_t off = (size_t)(row0 + ai * HALF + m * 16) * ldc + col0;
#pragma unroll
                for (int bj = 0; bj < 2; ++bj) { const f32x4 b0 = *(const f32x4*)(base + off + bj * HALF), b1 = *(const f32x4*)(base + off + bj * HALF + 4);
                    const f32x4 v0 = b0 + acc[ai][bj][m][0], v1 = b1 + acc[ai][bj][m][1];
                    u32x4 w; w.x = cvt_pk_bf16(v0[0], v0[1]); w.y = cvt_pk_bf16(v0[2], v0[3]); w.z = cvt_pk_bf16(v1[0], v1[1]); w.w = cvt_pk_bf16(v1[2], v1[3]);
                    *(u32x4*)(out + off + bj * HALF) = w; }
            }
    }
};

__device__ __forceinline__ float clamp8(float x) { return __builtin_fminf(__builtin_fmaxf(x, -448.f), 448.f); }
__device__ __forceinline__ unsigned cvt4_fp8(float a, float b, float c, float d) {
    int w = __builtin_amdgcn_cvt_pk_fp8_f32(clamp8(a), clamp8(b), 0, false); w = __builtin_amdgcn_cvt_pk_fp8_f32(clamp8(c), clamp8(d), w, true); return (unsigned)w; }
constexpr float W8_SCALE = 64.f, W8_DESCALE = 1.f / 64.f;

struct EpiSwiglu {
    static constexpr bool PERM = true, AFTER_DRAIN = false;
    unsigned char* H; int npn;
    __device__ __forceinline__ void operator()(const f32x4 (&acc)[2][2][4][2], const Unit& u, int wr, int wc, int fr, int fq) const {
        const int row0 = u.pm * BM + wr * 64 + fr, pnl = u.pn % npn, col0 = pnl * HALF + wc * 32 + 8 * fq;
#pragma unroll
        for (int ai = 0; ai < 2; ++ai)
#pragma unroll
            for (int m = 0; m < 4; ++m) {
                unsigned char* rowp = H + (size_t)(row0 + ai * HALF + m * 16) * 2048 + col0;
                float h[8];
#pragma unroll
                for (int n = 0; n < 2; ++n)
#pragma unroll
                    for (int i = 0; i < 4; ++i) { const float g = acc[ai][0][m][n][i] * W8_DESCALE, up = acc[ai][1][m][n][i] * W8_DESCALE; h[n * 4 + i] = g * up * __builtin_amdgcn_rcpf(1.f + __expf(-g)); }
                u32x2 w; w.x = cvt4_fp8(h[0], h[1], h[2], h[3]); w.y = cvt4_fp8(h[4], h[5], h[6], h[7]);
                *(u32x2*)rowp = w;
            }
    }
};

struct EpiDown {
    static constexpr bool PERM = true, AFTER_DRAIN = false;
    bf16_t* Y; const float* gate; int npn;
    __device__ __forceinline__ void operator()(const f32x4 (&acc)[2][2][4][2], const Unit& u, int wr, int wc, int fr, int fq) const {
        const int row0 = u.pm * BM + wr * 64 + fr, pnl = u.pn % npn, col0 = pnl * BM + wc * 32 + 8 * fq;
#pragma unroll
        for (int ai = 0; ai < 2; ++ai)
#pragma unroll
            for (int m = 0; m < 4; ++m) {
                const int row = row0 + ai * HALF + m * 16; const float gt = gate[row] * W8_DESCALE;
                bf16_t* rowp = Y + (size_t)row * 2048 + col0;
#pragma unroll
                for (int bj = 0; bj < 2; ++bj) { const f32x4 v0 = acc[ai][bj][m][0] * gt, v1 = acc[ai][bj][m][1] * gt;
                    u32x4 w; w.x = cvt_pk_bf16(v0[0], v0[1]); w.y = cvt_pk_bf16(v0[2], v0[3]); w.z = cvt_pk_bf16(v1[0], v1[1]); w.w = cvt_pk_bf16(v1[2], v1[3]);
                    *(u32x4*)(rowp + bj * HALF) = w; }
            }
    }
};

template <class Epi, class Sched, bool ALIGN_EPI = false, bool SP2 = false, bool FP8 = false>
__device__ __forceinline__ void gemm_phase(PG8_LAS unsigned char* lds, const Gemm g, const Sched& S, const Epi& E) {
    const int tid = threadIdx.x, wid = __builtin_amdgcn_readfirstlane(tid >> 6), lane = tid & 63, wr = wid >> 2, wc = wid & 3, fr = lane & 15, fq = lane >> 4;
    const int K = g.Kp, nt = g.K / BK;
    const size_t kslice = (size_t)g.K * 2;
    unsigned voffA[2], voffB[2];
#pragma unroll
    for (int i = 0; i < 2; ++i) { int R, C; stage_rc(tid * 16 + i * 8192, R, C); const int Rb = Epi::PERM ? ((R & ~31) + perm32(R & 31)) : R;
        voffA[i] = (unsigned)(R * K + C) * 2u; voffB[i] = (unsigned)(Rb * K + C) * 2u; }
    static_assert(!Sched::GATHER || SP2, "gathered A rows: SP2 loop only");
    const size_t kstep = (size_t)(BK * 2);
    const size_t hstep = (size_t)HALF * K * 2;
    const size_t tstep = 2 * hstep;
    const unsigned ldsw = (unsigned)wid * 1024u;
    const int aoff = lds_byte(wr * 64 + fr, fq * 8), boff = lds_byte(wc * 32 + fr, fq * 8);
#define PG8_SA(b, h) (((b) * 2 + (h)) * HTB)
#define PG8_SB(b, h) ((4 + (b) * 2 + (h)) * HTB)
#define PG8_STAGE(bufoff, gbase, voff) do { _Pragma("unroll") for (int _i = 0; _i < 2; ++_i) \
        __builtin_amdgcn_global_load_lds((const unsigned*)((const char*)(gbase) + (voff)[_i]), (PG8_LAS unsigned*)(lds + (bufoff) + ldsw + _i * 8192), 16, 0, 0); } while (0)
#define PG8_LDA(dst, b, h) do { _Pragma("unroll") for (int m = 0; m < 4; ++m) _Pragma("unroll") for (int k = 0; k < 2; ++k) dst[m][k] = *(const PG8_LAS bf16x8*)(lds + PG8_SA(b, h) + aoff + m * 2048 + k * 1024); } while (0)
#define PG8_LDB(dst, b, h) do { _Pragma("unroll") for (int n = 0; n < 2; ++n) _Pragma("unroll") for (int k = 0; k < 2; ++k) dst[n][k] = *(const PG8_LAS bf16x8*)(lds + PG8_SB(b, h) + boff + n * 2048 + k * 1024); } while (0)
#define PG8_CAT8(x, y) __builtin_shufflevector(__builtin_bit_cast(i32x4, x), __builtin_bit_cast(i32x4, y), 0, 1, 2, 3, 4, 5, 6, 7)
#define PG8_W8(c) __builtin_shufflevector(c, c, 0, 1, 2, 3, -1, -1, -1, -1)
#define PG8_MMA(ai, bj, At, Bt) do { __builtin_amdgcn_s_setprio(1); \
        if constexpr (FP8) { f32x32 a_ = acc32[ai][bj]; _Pragma("unroll") for (int m = 0; m < 4; ++m) _Pragma("unroll") for (int n = 0; n < 2; ++n) { \
            f32x4 c_ = {a_[(m * 2 + n) * 4], a_[(m * 2 + n) * 4 + 1], a_[(m * 2 + n) * 4 + 2], a_[(m * 2 + n) * 4 + 3]}; \
            c_ = __builtin_amdgcn_mfma_scale_f32_16x16x128_f8f6f4(PG8_CAT8(Bt[n][0], Bt[n][1]), PG8_CAT8(At[m][0], At[m][1]), c_, 0, 0, 0, 0, 0, 0); \
            a_[(m * 2 + n) * 4] = c_[0]; a_[(m * 2 + n) * 4 + 1] = c_[1]; a_[(m * 2 + n) * 4 + 2] = c_[2]; a_[(m * 2 + n) * 4 + 3] = c_[3]; } acc32[ai][bj] = a_; } \
        else { _Pragma("unroll") for (int m = 0; m < 4; ++m) _Pragma("unroll") for (int n = 0; n < 2; ++n) _Pragma("unroll") for (int k = 0; k < 2; ++k) \
            acc[ai][bj][m][n] = __builtin_amdgcn_mfma_f32_16x16x32_bf16(Bt[n][k], At[m][k], acc[ai][bj][m][n], 0, 0, 0); } __builtin_amdgcn_s_setprio(0); } while (0)
#define PG8_WAIT_V(n) asm volatile("s_waitcnt vmcnt(" #n ")" ::: "memory")
#define PG8_WAIT_L(n) asm volatile("s_waitcnt lgkmcnt(" #n ")" ::: "memory")
#define PG8_BAR __builtin_amdgcn_s_barrier()
#define PG8_SCHED __builtin_amdgcn_sched_barrier(0)
    Unit cur, nxt; int ui = 0;
    if (!S.next(0, cur)) return;
    f32x4 acc[2][2][4][2]; f32x32 acc32[2][2];
#pragma unroll
    for (int a = 0; a < 2; ++a)
#pragma unroll
        for (int b = 0; b < 2; ++b)
#pragma unroll
            for (int m = 0; m < 4; ++m) {
#pragma unroll
                for (int n = 0; n < 2; ++n) { acc[a][b][m][n] = (f32x4){0.f, 0.f, 0.f, 0.f};
#pragma unroll
                    for (int i = 0; i < 4; ++i) acc32[a][b][(m * 2 + n) * 4 + i] = 0.f; } }
    bf16x8 At[4][2], B0[2][2], B1[2][2];
    const char* cA = (const char*)g.A + (size_t)cur.pm * tstep + (size_t)cur.pk * kslice; const char* cB = (const char*)g.Bt + (size_t)cur.pn * tstep + (size_t)cur.pk * kslice;
    unsigned cvA0[2], cvA1[2], nvA0[2], nvA1[2];
#pragma unroll
    for (int i = 0; i < 2; ++i) { int R, C; stage_rc(tid * 16 + i * 8192, R, C);
        if constexpr (Sched::GATHER) { cvA0[i] = (unsigned)(S.arow(cur, R) * K + C) * 2u; cvA1[i] = (unsigned)(S.arow(cur, HALF + R) * K + C) * 2u; }
        else { cvA0[i] = voffA[i]; cvA1[i] = voffA[i] + (unsigned)hstep; }
        nvA0[i] = cvA0[i]; nvA1[i] = cvA1[i]; }
    if constexpr (Sched::GATHER) cA = (const char*)g.A;
    S.a_ready(cur);
    if constexpr (SP2) {
        PG8_STAGE(PG8_SB(0, 0), cB, voffB); PG8_STAGE(PG8_SB(0, 1), cB + hstep, voffB); PG8_STAGE(PG8_SA(0, 0), cA, cvA0); PG8_STAGE(PG8_SA(0, 1), cA, cvA1);
        if (wr == 1) PG8_BAR;
        PG8_WAIT_V(2); PG8_BAR;
        PG8_STAGE(PG8_SB(1, 0), cB + kstep, voffB); PG8_STAGE(PG8_SA(1, 0), cA + kstep, cvA0); PG8_STAGE(PG8_SB(1, 1), cB + hstep + kstep, voffB);
        PG8_WAIT_V(6); PG8_BAR;
    } else {
        PG8_STAGE(PG8_SB(0, 0), cB, voffB); PG8_STAGE(PG8_SA(0, 0), cA, voffA); PG8_STAGE(PG8_SB(0, 1), cB + hstep, voffB); PG8_STAGE(PG8_SA(0, 1), cA + hstep, voffA);
        if (wr == 1) PG8_BAR;
        PG8_WAIT_V(4); PG8_BAR;
        PG8_STAGE(PG8_SB(1, 0), cB + kstep, voffB); PG8_STAGE(PG8_SA(1, 0), cA + kstep, voffA); PG8_STAGE(PG8_SB(1, 1), cB + hstep + kstep, voffB);
        PG8_WAIT_V(6); PG8_BAR;
    }
    for (;;) {
        const bool has_next = S.next(ui + 1, nxt);
        const char* nA = Sched::GATHER ? (const char*)g.A : (has_next ? (const char*)g.A + (size_t)nxt.pm * tstep + (size_t)nxt.pk * kslice : cA);
        if constexpr (Sched::GATHER) { if (has_next) {
#pragma unroll
            for (int i = 0; i < 2; ++i) { int R, C; stage_rc(tid * 16 + i * 8192, R, C); nvA0[i] = (unsigned)(S.arow(nxt, R) * K + C) * 2u; nvA1[i] = (unsigned)(S.arow(nxt, HALF + R) * K + C) * 2u; } } } const char* nB = has_next ? (const char*)g.Bt + (size_t)nxt.pn * tstep + (size_t)nxt.pk * kslice : cB;
        for (int t = 0; t < nt; t += 2) {
            const bool last = (t == nt - 2);
            const char* a1 = cA + (size_t)(t + 1) * kstep;
            const char* a2 = last ? nA : cA + (size_t)(t + 2) * kstep; const char* b2 = last ? nB : cB + (size_t)(t + 2) * kstep;
            const char* a3 = a2 + kstep; const char* b3 = b2 + kstep;
            if (last && has_next) S.a_ready(nxt);
            unsigned sA0[2], sA1[2];
#pragma unroll
            for (int i = 0; i < 2; ++i) { sA0[i] = last ? nvA0[i] : cvA0[i]; sA1[i] = last ? nvA1[i] : cvA1[i]; }
            if constexpr (SP2) {
            PG8_LDB(B0, 0, 0); PG8_LDB(B1, 0, 1); PG8_SCHED; PG8_LDA(At, 0, 0); PG8_STAGE(PG8_SA(1, 1), a1, cvA1);
            PG8_WAIT_V(8); PG8_WAIT_L(0); PG8_BAR; PG8_MMA(0, 0, At, B0); PG8_MMA(0, 1, At, B1); PG8_BAR; PG8_SCHED;
            PG8_LDA(At, 0, 1); PG8_STAGE(PG8_SB(0, 0), b2, voffB); PG8_STAGE(PG8_SB(0, 1), b2 + hstep, voffB); PG8_STAGE(PG8_SA(0, 0), a2, sA0);
            PG8_WAIT_V(8); PG8_WAIT_L(0); PG8_BAR; PG8_MMA(1, 0, At, B0); PG8_MMA(1, 1, At, B1); PG8_BAR; PG8_SCHED;
            PG8_LDB(B0, 1, 0); PG8_LDB(B1, 1, 1); PG8_SCHED; PG8_LDA(At, 1, 0); PG8_STAGE(PG8_SA(0, 1), a2, sA1);
            PG8_WAIT_V(8); PG8_WAIT_L(0); PG8_BAR; PG8_MMA(0, 0, At, B0); PG8_MMA(0, 1, At, B1); PG8_BAR; PG8_SCHED;
            PG8_LDA(At, 1, 1); PG8_STAGE(PG8_SB(1, 0), b3, voffB); PG8_STAGE(PG8_SB(1, 1), b3 + hstep, voffB); PG8_STAGE(PG8_SA(1, 0), a3, sA0);
            PG8_WAIT_V(8); PG8_WAIT_L(0); PG8_BAR; PG8_MMA(1, 0, At, B0); PG8_MMA(1, 1, At, B1); PG8_BAR; PG8_SCHED;
            } else {
            PG8_LDB(B0, 0, 0); PG8_SCHED; PG8_LDA(At, 0, 0); PG8_STAGE(PG8_SA(1, 1), a1 + hstep, voffA);
            PG8_WAIT_L(8); PG8_BAR; PG8_WAIT_L(0); PG8_MMA(0, 0, At, B0); PG8_BAR; PG8_SCHED;
            PG8_LDB(B1, 0, 1); PG8_STAGE(PG8_SB(0, 0), b2, voffB);
            PG8_BAR; PG8_WAIT_L(0); PG8_MMA(0, 1, At, B1); PG8_BAR;
            PG8_LDA(At, 0, 1); PG8_STAGE(PG8_SA(0, 0), a2, voffA);
            PG8_BAR; PG8_WAIT_L(0); PG8_MMA(1, 0, At, B0); PG8_BAR; PG8_SCHED;
            PG8_STAGE(PG8_SB(0, 1), b2 + hstep, voffB);
            PG8_WAIT_V(6); PG8_BAR; PG8_MMA(1, 1, At, B1); PG8_BAR;
            PG8_LDB(B0, 1, 0); PG8_SCHED; PG8_LDA(At, 1, 0); PG8_STAGE(PG8_SA(0, 1), a2 + hstep, voffA);
            PG8_WAIT_L(8); PG8_BAR; PG8_WAIT_L(0); PG8_MMA(0, 0, At, B0); PG8_BAR; PG8_SCHED;
            PG8_LDB(B1, 1, 1); PG8_STAGE(PG8_SB(1, 0), b3, voffB);
            PG8_BAR; PG8_WAIT_L(0); PG8_MMA(0, 1, At, B1); PG8_BAR;
            PG8_LDA(At, 1, 1); PG8_STAGE(PG8_SA(1, 0), a3, voffA);
            PG8_BAR; PG8_WAIT_L(0); PG8_MMA(1, 0, At, B0); PG8_BAR; PG8_SCHED;
            PG8_STAGE(PG8_SB(1, 1), b3 + hstep, voffB);
            PG8_WAIT_V(6); PG8_BAR; PG8_MMA(1, 1, At, B1); PG8_BAR;
            }
        }
        if constexpr (ALIGN_EPI) { if (wr == 0) PG8_BAR; }
        if constexpr (FP8) {
#pragma unroll
            for (int a = 0; a < 2; ++a)
#pragma unroll
                for (int b = 0; b < 2; ++b)
#pragma unroll
                    for (int m = 0; m < 4; ++m)
#pragma unroll
                        for (int n = 0; n < 2; ++n)
#pragma unroll
                            for (int i = 0; i < 4; ++i) acc[a][b][m][n][i] = acc32[a][b][(m * 2 + n) * 4 + i]; }
        if constexpr (!Epi::AFTER_DRAIN) { E(acc, cur, wr, wc, fr, fq); S.done(cur); }
        if (!has_next) break;
#pragma unroll
        for (int a = 0; a < 2; ++a)
#pragma unroll
            for (int b = 0; b < 2; ++b)
#pragma unroll
                for (int m = 0; m < 4; ++m) {
#pragma unroll
                    for (int n = 0; n < 2; ++n) { acc[a][b][m][n] = (f32x4){0.f, 0.f, 0.f, 0.f};
#pragma unroll
                        for (int i = 0; i < 4; ++i) acc32[a][b][(m * 2 + n) * 4 + i] = 0.f; } }
        cur = nxt; cA = nA; cB = nB; ++ui;
#pragma unroll
        for (int i = 0; i < 2; ++i) { cvA0[i] = nvA0[i]; cvA1[i] = nvA1[i]; }
        if constexpr (ALIGN_EPI) { if (wr == 1) PG8_BAR; }
    }
    PG8_WAIT_V(0);
    if constexpr (!ALIGN_EPI) { if (wr == 0) PG8_BAR; }
    PG8_BAR;
    if constexpr (Epi::AFTER_DRAIN) { E.fused(acc, cur, wr, wc, fr, fq, lds, wid, lane); S.done(cur); }
#undef PG8_SA
#undef PG8_SB
#undef PG8_STAGE
#undef PG8_LDA
#undef PG8_LDB
#undef PG8_MMA
#undef PG8_CAT8
#undef PG8_W8
#undef PG8_WAIT_V
#undef PG8_WAIT_L
#undef PG8_BAR
#undef PG8_SCHED
}
}

namespace att {
constexpr int NW = 8, QBLK = 32, KVBLK = 64;
constexpr float THR = 8.f;
constexpr int SHM_V = KVBLK * 128 * 2, SHM_K = KVBLK * 64 * 2;
constexpr int SHM_ATTN = 2 * SHM_V + 2 * SHM_K + NW * 64 * 4;
#define KSWZ64(row, colB) ((row) * 128 + ((colB) ^ ((((row) >> 1) & 7) << 4)))
#define SBAR() __builtin_amdgcn_sched_barrier(0)
__device__ __forceinline__ int crow(int r, int hi) { return (r & 3) + 8 * (r >> 2) + 4 * hi; }

__device__ __forceinline__ void partialSM(f32x16& p0, f32x16& p1, float& m_reg, float& mn, float& alpha) {
  float pmax = p0[0];
#pragma unroll
  for (int r = 1; r < 16; ++r) pmax = fmaxf(pmax, p0[r]);
#pragma unroll
  for (int r = 0; r < 16; ++r) pmax = fmaxf(pmax, p1[r]);
  { auto rr = __builtin_amdgcn_permlane32_swap(__float_as_uint(pmax), __float_as_uint(pmax), false, false);
    pmax = fmaxf(__uint_as_float(rr[0]), __uint_as_float(rr[1])); }
  if (__builtin_expect(__all(pmax - m_reg <= THR), 1)) { mn = m_reg; alpha = 1.f; }
  else { mn = fmaxf(m_reg, pmax); alpha = __builtin_amdgcn_exp2f(m_reg - mn); m_reg = mn; }
#pragma unroll
  for (int r = 0; r < 16; ++r) p0[r] = p0[r] - mn;
#pragma unroll
  for (int r = 0; r < 16; ++r) p1[r] = p1[r] - mn;
#pragma unroll
  for (int r = 0; r < 16; ++r) p0[r] = __builtin_amdgcn_exp2f(p0[r]);
}
__device__ __forceinline__ void finishSM(f32x16& p0, f32x16& p1, float alpha, float& l_reg, bf16x8& pa0, bf16x8& pa1, bf16x8& pa2, bf16x8& pa3) {
#pragma unroll
  for (int r = 0; r < 16; ++r) p1[r] = __builtin_amdgcn_exp2f(p1[r]);
  float ps = 0;
#pragma unroll
  for (int r = 0; r < 16; ++r) ps += p0[r];
#pragma unroll
  for (int r = 0; r < 16; ++r) ps += p1[r];
  { auto rr = __builtin_amdgcn_permlane32_swap(__float_as_uint(ps), __float_as_uint(ps), false, false);
    ps = __uint_as_float(rr[0]) + __uint_as_float(rr[1]); }
  l_reg = l_reg * alpha + ps;
#define PK4(P, BASE, OUT) do { unsigned a0 = cvtpk(P[BASE + 0], P[BASE + 1]), a1 = cvtpk(P[BASE + 2], P[BASE + 3]);   \
    unsigned b0 = cvtpk(P[BASE + 4], P[BASE + 5]), b1 = cvtpk(P[BASE + 6], P[BASE + 7]);                              \
    auto r0 = __builtin_amdgcn_permlane32_swap(a0, b0, false, false); auto r1 = __builtin_amdgcn_permlane32_swap(a1, b1, false, false); \
    u32x4 w = {r0[0], r1[0], r0[1], r1[1]}; OUT = __builtin_bit_cast(bf16x8, w); } while (0)
  PK4(p0, 0, pa0); PK4(p0, 8, pa1); PK4(p1, 0, pa2); PK4(p1, 8, pa3);
#undef PK4
}
__device__ __forceinline__ void qkt(f32x16& p0, f32x16& p1, const char* Ks, const bf16x8* qr, int r32, int hi) {
  p0 = f32x16{}; p1 = f32x16{};
#pragma unroll
  for (int d0 = 0; d0 < 4; ++d0) { const int cb = (d0 * 16 + hi * 8) * 2;
    bf16x8 b0 = *reinterpret_cast<const bf16x8*>(Ks + KSWZ64(r32, cb));
    bf16x8 b1 = *reinterpret_cast<const bf16x8*>(Ks + KSWZ64(32 + r32, cb));
    p0 = __builtin_amdgcn_mfma_f32_32x32x16_bf16(b0, qr[d0], p0, 0, 0, 0);
    p1 = __builtin_amdgcn_mfma_f32_32x32x16_bf16(b1, qr[d0], p1, 0, 0, 0); }
}
__device__ __forceinline__ int v_st(int k, int c) { const int kk = (k & ~0xC) | ((k & 4) << 1) | ((k & 8) >> 1); return ((kk >> 3) * 4 + (c >> 5)) * 512 + ((kk & 7) * 32 + (c & 31)) * 2; }
__device__ __forceinline__ int v_rd_base(int lane) { return ((lane & 3) << 3) | (((lane >> 2) & 3) << 6) | (((lane >> 4) & 1) << 5) | (((lane >> 5) & 1) << 8); }
constexpr int v_rd_off(int d0, int ks, int half) { return d0 * 512 + ks * 4096 + half * 2048; }
template <int OFF> __device__ __forceinline__ s16x4 tr_read(int vb) {
  s16x4 r; asm volatile("ds_read_b64_tr_b16 %0, %1 offset:%2" : "=&v"(r) : "v"(vb), "i"(OFF) : "memory"); return r;
}
template <int D0> __device__ __forceinline__ void pv_one(f32x16& od, int vb, bf16x8 pa0, bf16x8 pa1, bf16x8 pa2, bf16x8 pa3) {
  const s16x4 l0 = tr_read<v_rd_off(D0, 0, 0)>(vb), h0 = tr_read<v_rd_off(D0, 0, 1)>(vb), l1 = tr_read<v_rd_off(D0, 1, 0)>(vb), h1 = tr_read<v_rd_off(D0, 1, 1)>(vb);
  const s16x4 l2 = tr_read<v_rd_off(D0, 2, 0)>(vb), h2 = tr_read<v_rd_off(D0, 2, 1)>(vb), l3 = tr_read<v_rd_off(D0, 3, 0)>(vb), h3 = tr_read<v_rd_off(D0, 3, 1)>(vb);
  asm volatile("s_waitcnt lgkmcnt(0)" ::: "memory"); SBAR();
#define PK(L, H) (bf16x8){L[0], L[1], L[2], L[3], H[0], H[1], H[2], H[3]}
  od = __builtin_amdgcn_mfma_f32_32x32x16_bf16(pa0, PK(l0, h0), od, 0, 0, 0);
  od = __builtin_amdgcn_mfma_f32_32x32x16_bf16(pa1, PK(l1, h1), od, 0, 0, 0);
  od = __builtin_amdgcn_mfma_f32_32x32x16_bf16(pa2, PK(l2, h2), od, 0, 0, 0);
  od = __builtin_amdgcn_mfma_f32_32x32x16_bf16(pa3, PK(l3, h3), od, 0, 0, 0);
#undef PK
}
__device__ __forceinline__ void pv_d0(f32x16* o, int vb, bf16x8 pa0, bf16x8 pa1, bf16x8 pa2, bf16x8 pa3) {
  pv_one<0>(o[0], vb, pa0, pa1, pa2, pa3); pv_one<1>(o[1], vb, pa0, pa1, pa2, pa3); pv_one<2>(o[2], vb, pa0, pa1, pa2, pa3); pv_one<3>(o[3], vb, pa0, pa1, pa2, pa3);
}

template <int LDQ>
__device__ __forceinline__ void attn_unit(const bf16_t* __restrict__ Qb, const bf16_t* __restrict__ Kh, const bf16_t* __restrict__ Vh, bf16_t* __restrict__ Ob, int seq, char* lds) {
  const int tid = threadIdx.x, wid = tid >> 6, lane = tid & 63, r32 = lane & 31, hi = lane >> 5;
  char* V_lds = lds; char* K_lds = lds + 2 * SHM_V;
  float* ws = (float*)(lds + 2 * SHM_V + 2 * SHM_K) + wid * 64; float* li_l = ws; float* al_l = ws + 32;
  float m_reg = -1e30f, l_reg = 0; f32x16 o[4] = {}; bf16x8 qr[4];
  const bf16_t* Qw = Qb + (long)(wid * QBLK + r32) * LDQ + hi * 8;
#pragma unroll
  for (int d0 = 0; d0 < 4; ++d0) qr[d0] = *reinterpret_cast<const bf16x8*>(Qw + d0 * 16);
  const int sr = tid >> 4, sc = (tid & 15) * 8, vst0 = v_st(sr, sc), vst1 = v_st(32 + sr, sc);
  const int kr = tid >> 3, kc8 = (tid & 7) * 8, kst = KSWZ64(kr, kc8 * 2);
  const int vb0 = (int)(uintptr_t)V_lds + v_rd_base(lane);
  struct { bf16x8 vs0, vs1, ks; } sr_[2];
  const bf16_t* Vp0 = Vh + (long)sr * LDQ + sc; const bf16_t* Kp0 = Kh + (long)kr * LDQ + kc8;
#define SLOAD(i, k0) do { const long ko_ = (long)(k0) * LDQ; sr_[i].vs0 = *reinterpret_cast<const bf16x8*>(Vp0 + ko_); sr_[i].vs1 = *reinterpret_cast<const bf16x8*>(Vp0 + ko_ + 32 * LDQ); \
    sr_[i].ks = *reinterpret_cast<const bf16x8*>(Kp0 + ko_); } while (0)
#define SWRITE(b, i) do { *(bf16x8*)(V_lds + (b) * SHM_V + vst0) = sr_[i].vs0; *(bf16x8*)(V_lds + (b) * SHM_V + vst1) = sr_[i].vs1; \
    *(bf16x8*)(K_lds + (b) * SHM_K + kst) = sr_[i].ks; } while (0)
#define SWAIT() asm volatile("s_waitcnt vmcnt(3)" ::: "memory")
#define RESC(a) do { if (__any((a) < 1.f)) { if (hi == 0) al_l[r32] = (a); asm volatile("s_waitcnt lgkmcnt(0)" ::: "memory"); \
    _Pragma("unroll") for (int d = 0; d < 4; ++d) _Pragma("unroll") for (int r = 0; r < 16; ++r) o[d][r] *= al_l[crow(r, hi)]; } } while (0)
  f32x16 pA0, pA1, pB0, pB1; float mnA, mnB, alA, alB; bf16x8 pa0, pa1, pa2, pa3; const int NT = seq / KVBLK;
  constexpr int SE = 0, SO = 1;
  SLOAD(SE, 0); asm volatile("s_waitcnt vmcnt(0)" ::: "memory"); SWRITE(0, SE); __syncthreads();
  qkt(pA0, pA1, K_lds, qr, r32, hi); partialSM(pA0, pA1, m_reg, mnA, alA);
  SLOAD(SO, KVBLK); if (2 < NT) SLOAD(SE, 2 * KVBLK);
  SWAIT(); SWRITE(1, SO); __syncthreads();
  for (int j = 1; j + 1 < NT; j += 2) {
    SBAR(); qkt(pB0, pB1, K_lds + SHM_K, qr, r32, hi);
    finishSM(pA0, pA1, alA, l_reg, pa0, pa1, pa2, pa3); SBAR();
    SLOAD(SO, (j + 2) * KVBLK); SBAR();
    pv_d0(o, vb0, pa0, pa1, pa2, pa3); partialSM(pB0, pB1, m_reg, mnB, alB);
    __syncthreads(); SWAIT(); SWRITE(0, SE);
    RESC(alB); __syncthreads();
    SBAR(); qkt(pA0, pA1, K_lds, qr, r32, hi);
    finishSM(pB0, pB1, alB, l_reg, pa0, pa1, pa2, pa3); SBAR();
    if (j + 3 < NT) SLOAD(SE, (j + 3) * KVBLK); SBAR();
    pv_d0(o, vb0 + SHM_V, pa0, pa1, pa2, pa3); partialSM(pA0, pA1, m_reg, mnA, alA);
    __syncthreads(); SWAIT(); SWRITE(1, SO);
    RESC(alA); __syncthreads();
  }
  SBAR(); qkt(pB0, pB1, K_lds + SHM_K, qr, r32, hi);
  finishSM(pA0, pA1, alA, l_reg, pa0, pa1, pa2, pa3); SBAR();
  pv_d0(o, vb0, pa0, pa1, pa2, pa3); partialSM(pB0, pB1, m_reg, mnB, alB);
  __syncthreads(); RESC(alB);
  finishSM(pB0, pB1, alB, l_reg, pa0, pa1, pa2, pa3); SBAR();
  pv_d0(o, vb0 + SHM_V, pa0, pa1, pa2, pa3);
  if (hi == 0) li_l[r32] = l_reg; asm volatile("s_waitcnt lgkmcnt(0)" ::: "memory");
  float rli[16];
#pragma unroll
  for (int r = 0; r < 16; ++r) rli[r] = __builtin_amdgcn_rcpf(li_l[crow(r, hi)]);
  bf16_t* Ow = Ob + (long)(wid * QBLK) * 1024;
#pragma unroll
  for (int r = 0; r < 16; ++r) { const int orow = crow(r, hi);
#pragma unroll
    for (int d0 = 0; d0 < 4; ++d0) Ow[(long)orow * 1024 + d0 * 32 + r32] = (bf16_t)(cvtpk(o[d0][r] * rli[r], 0.f) & 0xffffu); }
  __syncthreads();
#undef SLOAD
#undef SWRITE
#undef SWAIT
#undef RESC
}
#undef SBAR
}


typedef GAS unsigned gu32;
#define RLX_AGENT __ATOMIC_RELAXED, __HIP_MEMORY_SCOPE_AGENT
#define XB_TMO      128
#define XB_XCNT(j)  (256  + 64 * (j))
#define XB_XSUB(j)  (1280 + 64 * (j))
#define XB_XGEN(j)  (2304 + 64 * (j))
#define XB_TOP      3328
#define XB_TOPGEN   3392
#define XCD_BAR_WORDS 3456
#define XB_SPIN_CAP (1u << 22)
__device__ __forceinline__ unsigned xb_ld(unsigned* p)              { return __hip_atomic_load(p, __ATOMIC_RELAXED, __HIP_MEMORY_SCOPE_AGENT); }
__device__ __forceinline__ unsigned xb_add(unsigned* p, unsigned v) { return __hip_atomic_fetch_add(p, v, __ATOMIC_RELAXED, __HIP_MEMORY_SCOPE_AGENT); }
__device__ __forceinline__ unsigned xb_xcc_id() { return (unsigned)__builtin_amdgcn_s_getreg((3 << 11) | 20) & 0xFu; }
#define XB_SPIN(cond, bar) do { unsigned _sp = 0; while (cond) { __builtin_amdgcn_s_sleep(1); \
    if ((++_sp & 255u) == 0u) { if (xb_ld(&(bar)[XB_TMO])) break; if (_sp > XB_SPIN_CAP) { atomicAdd(&(bar)[XB_TMO], 1u); break; } } } } while (0)
struct XcdBarrier { unsigned* bar; unsigned x; volatile LAS unsigned* st; };
__device__ __forceinline__ XcdBarrier xcd_barrier_post(unsigned* bar, volatile LAS unsigned* st) {
    XcdBarrier b; b.bar = bar; b.x = xb_xcc_id(); b.st = st;
    if (threadIdx.x == 0) (void)xb_add(&bar[XB_XCNT(b.x)], 1u);
    return b;
}
__device__ __forceinline__ void xcd_barrier_complete(unsigned* bar, unsigned x, unsigned& nloc, unsigned& nx) {
    const unsigned G = gridDim.x * gridDim.y * gridDim.z;
    unsigned sum, cnt, mine, sp = 0u;
    for (;;) {
        sum = 0u; cnt = 0u; mine = 0u;
#pragma unroll
        for (unsigned j = 0; j < 16; ++j) { const unsigned c = xb_ld(&bar[XB_XCNT(j)]); sum += c; cnt += (c > 0u) ? 1u : 0u; mine = (j == x) ? c : mine; }
        if (sum == G) break;
        __builtin_amdgcn_s_sleep(1);
        if ((++sp & 255u) == 0u) { if (xb_ld(&bar[XB_TMO])) break; if (sp > XB_SPIN_CAP) { atomicAdd(&bar[XB_TMO], 1u); break; } }
    }
    nloc = mine > 0u ? mine : 1u; nx = cnt > 0u ? cnt : 1u;
}
__device__ __forceinline__ void xcd_barrier(const XcdBarrier& b) {
    asm volatile("s_waitcnt vmcnt(0)" ::: "memory");
    __syncthreads();
    if (threadIdx.x == 0) {
        unsigned* bar = b.bar;
        __builtin_amdgcn_s_waitcnt(0);
        unsigned nloc = b.st[0], nx = b.st[1];
        if (nloc == 0u) { xcd_barrier_complete(bar, b.x, nloc, nx); b.st[0] = nloc; b.st[1] = nx; }
        const unsigned old = xb_add(&bar[XB_XSUB(b.x)], 1u);
        const unsigned gen = old / nloc;
        if (old + 1u == (gen + 1u) * nloc) {
            __builtin_amdgcn_fence(__ATOMIC_RELEASE, "agent");
            asm volatile("s_waitcnt vmcnt(0)" ::: "memory");
            const unsigned og = xb_add(&bar[XB_TOP], 1u);
            const unsigned tg = og / nx;
            if (og + 1u == (tg + 1u) * nx) xb_add(&bar[XB_TOPGEN], 1u);
            else XB_SPIN(xb_ld(&bar[XB_TOPGEN]) == tg, bar);
            __builtin_amdgcn_fence(__ATOMIC_ACQUIRE, "agent");
            xb_add(&bar[XB_XGEN(b.x)], 1u);
            asm volatile("s_waitcnt vmcnt(0)" ::: "memory");
        } else {
            XB_SPIN(xb_ld(&bar[XB_XGEN(b.x)]) == gen, bar);
            __builtin_amdgcn_fence(__ATOMIC_ACQUIRE, "agent");
            asm volatile("s_waitcnt vmcnt(0)" ::: "memory");
        }
    }
    __syncthreads();
}

struct Frame {
    LAS unsigned char* lds; char* ldsg;
    int tid, lane, wave, vcu, G;
    const Args* a;
};
#define INP(F, i, T) ((const T*)(F).a->in[i])
#define WSP(F, off, T) ((T*)((F).a->ws + (off)))

__device__ __forceinline__ void cvt_load(f32x4 (&v)[16], const float* __restrict__ W, int N, int nvalid, int k0, int n0, int lane) {
    const int kq = lane >> 4, nq = lane & 15;
    const unsigned voff = (unsigned)(kq * N + 4 * nq) * 4u;
#pragma unroll
    for (int i = 0; i < 16; ++i) {
        const char* Wu = (const char*)(W + (size_t)(k0 + 4 * i) * N + n0);
        if (4 * nq < nvalid) v[i] = __builtin_nontemporal_load((const f32x4*)(Wu + (size_t)voff)); else v[i] = (f32x4){0.f, 0.f, 0.f, 0.f};
    }
}
__device__ __forceinline__ void cvt_finish(const f32x4 (&v)[16], int k0, bf16_t* __restrict__ WT, int rowb, LAS unsigned char* scr, int lane) {
    const int kq = lane >> 4, nq = lane & 15;
    const int g = lane >> 4, i16 = lane & 15, q = i16 >> 2, p = i16 & 3;
    typedef short v4i16_t __attribute__((ext_vector_type(4)));
#pragma unroll
    for (int hf = 0; hf < 2; ++hf) {
#pragma unroll
        for (int i = 0; i < 8; ++i) {
            const int k = 4 * i + kq, s = ((k >> 1) & 1) | (((k >> 3) & 1) << 1);
            u32x2 w; w.x = cvtpk(v[8 * hf + i].x, v[8 * hf + i].y); w.y = cvtpk(v[8 * hf + i].z, v[8 * hf + i].w);
            *(LAS u32x2*)(scr + k * 128 + ((nq * 8) ^ (s << 5))) = w;
        }
        const int klo = 8 * g + q, s = ((klo >> 1) & 1) | (((klo >> 3) & 1) << 1);
#pragma unroll
        for (int nb = 0; nb < 4; ++nb) {
            const int a_lo = klo * 128 + (((16 * nb + 4 * p) * 2) ^ (s << 5));
            const s16x4 lo = __builtin_bit_cast(s16x4, __builtin_amdgcn_ds_read_tr16_b64_v4i16((LAS v4i16_t*)(scr + a_lo)));
            const s16x4 hi = __builtin_bit_cast(s16x4, __builtin_amdgcn_ds_read_tr16_b64_v4i16((LAS v4i16_t*)(scr + a_lo + 512)));
            bf16x8 o = {lo[0], lo[1], lo[2], lo[3], hi[0], hi[1], hi[2], hi[3]};
            char* Wu = (char*)(WT + (size_t)(rowb + 16 * nb) * 2048 + k0 + 32 * hf);
            __builtin_nontemporal_store(o, (bf16x8*)(Wu + (size_t)(unsigned)((i16 * 2048 + 8 * g) * 2)));
        }
    }
}
__device__ __forceinline__ void cvt8_load(f32x4 (&v)[16], const float* __restrict__ W, int k0, int n0, int lane) {
    const int kq = lane >> 4, nq = lane & 15;
    const unsigned voff = (unsigned)(16 * kq * 2048 + 4 * nq) * 4u;
#pragma unroll
    for (int i = 0; i < 16; ++i) {
        const char* Wu = (const char*)(W + (size_t)(k0 + i) * 2048 + n0);
        v[i] = __builtin_nontemporal_load((const f32x4*)(Wu + (size_t)voff));
    }
}
__device__ __forceinline__ void cvt8_finish(const f32x4 (&v)[16], int k0, unsigned char* __restrict__ W8, int rowb, int lane) {
    const int kq = lane >> 4, nq = lane & 15;
    char* Wu = (char*)(W8 + (size_t)rowb * 2048 + k0);
    const unsigned voff = (unsigned)(4 * nq * 2048 + 16 * kq);
#pragma unroll
    for (int j = 0; j < 4; ++j) {
        u32x4 o;
#pragma unroll
        for (int q = 0; q < 4; ++q) {
            int w = __builtin_amdgcn_cvt_pk_fp8_f32(v[4 * q][j] * pg8::W8_SCALE, v[4 * q + 1][j] * pg8::W8_SCALE, 0, false);
            w = __builtin_amdgcn_cvt_pk_fp8_f32(v[4 * q + 2][j] * pg8::W8_SCALE, v[4 * q + 3][j] * pg8::W8_SCALE, w, true);
            o[q] = (unsigned)w;
        }
        __builtin_nontemporal_store(o, (u32x4*)(Wu + (size_t)(voff + (unsigned)(j * 2048))));
    }
}
__device__ __forceinline__ void cvt_expert_decode(const Frame& F, int r, const float*& W, int& k0, int& n0, unsigned char*& WT, int& rowb) {
    constexpr int I_E = 16 * 32 * 32;
    const int mat = r / I_E; r -= mat * I_E;
    const int e = r >> 10, kt = (r >> 5) & 31, nt = r & 31;
    k0 = kt * 64; n0 = nt * 64;
    if (mat < 2) { W = INP(F, 24 + mat, float) + (size_t)e * 2048 * 2048; WT = WSP(F, WS_WGU, unsigned char); rowb = e * 4096 + (n0 >> 7) * 256 + mat * 128 + (n0 & 127); }
    else { W = INP(F, 26, float) + (size_t)e * 2048 * 2048; WT = WSP(F, WS_WD, unsigned char); rowb = e * 2048 + n0; }
}
constexpr int N_EXPERT_ITEMS = 3 * 16 * 32 * 32;
__device__ __forceinline__ void p0_prologue(Frame& F) {
    LAS unsigned char* scr = F.lds + F.wave * 4096;
    const int gw = F.vcu * 8 + F.wave, NGW = F.G * 8, lane = F.lane;
    const float* w_in = INP(F, 3, float); const float* w_out = INP(F, 21, float);
    bf16_t* WinT = WSP(F, WS_WIN, bf16_t); bf16_t* WoutT = WSP(F, WS_WOUT, bf16_t);
    constexpr int I_IN = 32 * 101, I_OUT = 32 * 32, NITEMS = I_IN + I_OUT;
    for (int it = gw; it < NITEMS; it += NGW) {
        f32x4 v[16];
        if (it < I_IN) { const int kt = it / 101, nt = it % 101; const int nv = (nt == 100) ? 32 : 64; cvt_load(v, w_in, IN_COLS, nv, kt * 64, nt * 64, lane); cvt_finish(v, kt * 64, WinT, nt * 64, scr, lane); }
        else { const int r = it - I_IN, kt = r >> 5, nt = r & 31; cvt_load(v, w_out, 2048, 64, kt * 64, nt * 64, lane); cvt_finish(v, kt * 64, WoutT, nt * 64, scr, lane); }
    }
#if !CVT_IN_SCAN
    for (int it = gw; it < N_EXPERT_ITEMS; it += NGW) {
        f32x4 v[16]; const float* W; int k0, n0, rowb; unsigned char* WT;
        cvt_expert_decode(F, it, W, k0, n0, WT, rowb); cvt8_load(v, W, k0, n0, lane); cvt8_finish(v, k0, WT, rowb, lane);
    }
#endif
    { u32x4 z = {0u, 0u, 0u, 0u}; u32x4* zp = (u32x4*)(WinT + (size_t)6464 * 2048); const int nz = 192 * 2048 * 2 / 16;
      for (int i = gw * 64 + lane; i < nz; i += NGW * 64) zp[i] = z; }
    { const float* x = INP(F, 0, float); const float* nw = INP(F, 2, float); bf16_t* H1 = WSP(F, WS_H1, bf16_t);
      for (int m = gw; m < MTOK; m += NGW) {
          const f32x4* xr = (const f32x4*)(x + (size_t)m * DM) + lane; f32x4 v[8]; float s = 0.f;
#pragma unroll
          for (int j = 0; j < 8; ++j) { v[j] = xr[64 * j]; s += (v[j].x * v[j].x + v[j].y * v[j].y) + (v[j].z * v[j].z + v[j].w * v[j].w); }
          const float rstd = 1.f / sqrtf(wave_sum(s) * (1.f / DM) + 1e-6f);
          u32x2* o8 = (u32x2*)(H1 + (size_t)m * DM) + lane;
#pragma unroll
          for (int j = 0; j < 8; ++j) { const f32x4 w = ((const f32x4*)nw)[lane + 64 * j]; u32x2 o; o.x = cvtpk(v[j].x * rstd * w.x, v[j].y * rstd * w.y); o.y = cvtpk(v[j].z * rstd * w.z, v[j].w * rstd * w.w); o8[64 * j] = o; }
      } }
    { const float* dup = INP(F, 12, float); const float* iup = INP(F, 14, float); const float* gup = INP(F, 15, float);
      bf16_t* DUt = WSP(F, WS_LORA, bf16_t); bf16_t* IUt = DUt + 2 * 1024 * 64; bf16_t* GUt = IUt + 2 * 1024 * 64;
      for (int i = gw * 64 + lane; i < 2 * 1024 * 64; i += NGW * 64) { const int j = i & 63, c = (i >> 6) & 1023, d = i >> 16;
          DUt[i] = (bf16_t)(cvtpk(dup[(size_t)(d * 64 + j) * 1024 + c], 0.f) & 0xffffu); IUt[i] = (bf16_t)(cvtpk(iup[(size_t)(d * 64 + j) * 1024 + c], 0.f) & 0xffffu); }
      for (int i = gw * 64 + lane; i < 1024 * 160; i += NGW * 64) { const int c = i / 160, j = i - c * 160; GUt[i] = (bf16_t)(cvtpk(gup[(size_t)j * 1024 + c], 0.f) & 0xffffu); } }
    { const int* pos = INP(F, 1, int); float* rope = WSP(F, WS_ROPE, float);
      const float invf[8] = {1.0f, 0.19392274474868576f, 0.03760603093086393f, 0.007292664737217109f, 0.001414213562373095f, 0.0002742481756762073f, 5.318295896944988e-05f, 1.031338537721246e-05f};
      for (int i = gw * 64 + lane; i < MTOK * 8; i += NGW * 64) { const int m = i >> 3, j = i & 7; float fj = invf[0];
#pragma unroll
          for (int q = 1; q < 8; ++q) fj = (j == q) ? invf[q] : fj;
          const float ang = (float)pos[m] * fj; rope[m * 16 + j] = cosf(ang); rope[m * 16 + 8 + j] = sinf(ang); } }
}

#define WS32(F, T, byteoff) (*(T*)((F).a->ws + (size_t)(unsigned)(byteoff)))
template <int CTRL> __device__ __forceinline__ float dpp_add(float x) {
    return x + __int_as_float(__builtin_amdgcn_update_dpp(0, __float_as_int(x), CTRL, 0xf, 0xf, false));
}
__device__ __forceinline__ float row16_allsum(float x) { x = dpp_add<0x128>(x); x = dpp_add<0x124>(x); x = dpp_add<0x122>(x); x = dpp_add<0x121>(x); return x; }
__device__ __forceinline__ bf16_t f2bf(float x) { return (bf16_t)(cvtpk(x, 0.f) & 0xffffu); }
__device__ __forceinline__ u32x4 ld_row16(const Frame& F, unsigned off, bool ok) { u32x4 r = {0u, 0u, 0u, 0u}; if (ok) r = WS32(F, const u32x4, off); return r; }
__device__ __forceinline__ void unpack8(const u32x4 w, float (&o)[8]) { o[0] = bf_lo(w.x); o[1] = bf_hi(w.x); o[2] = bf_lo(w.y); o[3] = bf_hi(w.y); o[4] = bf_lo(w.z); o[5] = bf_hi(w.z); o[6] = bf_lo(w.w); o[7] = bf_hi(w.w); }
__device__ __forceinline__ void ld8f(const float* p, float (&o)[8]) { const f32x4 a = ((const f32x4*)p)[0], b = ((const f32x4*)p)[1]; o[0] = a.x; o[1] = a.y; o[2] = a.z; o[3] = a.w; o[4] = b.x; o[5] = b.y; o[6] = b.z; o[7] = b.w; }
__device__ __forceinline__ u32x4 pack8(const float (&v)[8]) { return (u32x4){cvtpk(v[0], v[1]), cvtpk(v[2], v[3]), cvtpk(v[4], v[5]), cvtpk(v[6], v[7])}; }
__device__ __forceinline__ void p3_prep(Frame& F, const int mode = 0) {
    constexpr int AP = 296;
    LAS float* Zl = (LAS float*)F.lds;
    LAS bf16_t* Al = (LAS bf16_t*)(F.lds + 18432);
    constexpr int PP = 520, PA = 16 * PP;
    LAS bf16_t* Pl = (LAS bf16_t*)(F.lds + 18432 + 9472);
    LAS float* Zr = (LAS float*)(F.lds + 18432 + 9472);
    const int tid = F.tid, lane = F.lane, w = F.wave;
    const bf16_t* DUt = WSP(F, WS_LORA, bf16_t); const bf16_t* IUt = DUt + 2 * 1024 * 64; const bf16_t* GUt = IUt + 2 * 1024 * 64;
    for (int tile = F.vcu; tile < MTOK / 16; tile += F.G) {
        const int m0 = tile * 16, t0 = m0 & (SEQ - 1);
        __syncthreads();
        for (int p = tid; p < 18 * 36; p += 512) {
            const int rr = p / 36, ch = p - rr * 36, t = t0 + rr - 1, m = m0 + rr - 1;
            f32x4 a0 = {0.f, 0.f, 0.f, 0.f}, a1 = a0;
            if (t >= 0 && t < SEQ) {
                const bf16_t* pp = WSP(F, WS_PART, bf16_t) + (((size_t)((ch >> 5) * 32 + (m >> 8)) * 4) << 16) + (size_t)(m & 255) * 256 + ((8 * ch) & 255);
                u32x4 q[4];
#pragma unroll
                for (int k = 0; k < 4; ++k) q[k] = *(const u32x4*)(pp + ((size_t)k << 16));
#pragma unroll
                for (int k = 0; k < 4; ++k) { a0 += (f32x4){bf_lo(q[k].x), bf_hi(q[k].x), bf_lo(q[k].y), bf_hi(q[k].y)}; a1 += (f32x4){bf_lo(q[k].z), bf_hi(q[k].z), bf_lo(q[k].w), bf_hi(q[k].w)}; }
            }
            LAS f32x4* zp = (LAS f32x4*)(Zr + rr * 288 + 8 * ch); zp[0] = a0; zp[1] = a1;
        }
        __syncthreads();
        for (int p = tid; p < 16 * 36; p += 512) {
            const int i = p / 36, ch = p - i * 36, zc = 3072 + 8 * ch;
            float c[8], pv[8], nx[8], mp[8], mn[8];
            { const LAS f32x4* q = (const LAS f32x4*)(Zr + i * 288 + 8 * ch); const f32x4 x0 = q[0], x1 = q[1], y0 = q[72], y1 = q[73], w0 = q[144], w1 = q[145];
              pv[0] = x0.x; pv[1] = x0.y; pv[2] = x0.z; pv[3] = x0.w; pv[4] = x1.x; pv[5] = x1.y; pv[6] = x1.z; pv[7] = x1.w;
              c[0] = y0.x; c[1] = y0.y; c[2] = y0.z; c[3] = y0.w; c[4] = y1.x; c[5] = y1.y; c[6] = y1.z; c[7] = y1.w;
              nx[0] = w0.x; nx[1] = w0.y; nx[2] = w0.z; nx[3] = w0.w; nx[4] = w1.x; nx[5] = w1.y; nx[6] = w1.z; nx[7] = w1.w; }
            ld8f(INP(F, 4, float) + zc, mp); ld8f(INP(F, 5, float) + zc, mn);
            LAS f32x4* zp = (LAS f32x4*)(Zl + i * 288 + 8 * ch); float z[8];
#pragma unroll
            for (int e = 0; e < 8; ++e) z[e] = c[e] + mp[e] * (pv[e] - c[e]) + mn[e] * (nx[e] - c[e]);
            zp[0] = (f32x4){z[0], z[1], z[2], z[3]}; zp[1] = (f32x4){z[4], z[5], z[6], z[7]};
        }
        __syncthreads();
        for (int e = tid; e < 16 * 288; e += 512) { const int i = e / 288, j = e - i * 288; float z = Zl[e];
            if (j < 64) z = 1.f - 2.f * __builtin_amdgcn_rcpf(__expf(2.f * z) + 1.f); else if (j >= 128) z = __builtin_amdgcn_rcpf(1.f + __expf(-z));
            Al[i * AP + j] = f2bf(z); }
        __syncthreads();
        if (mode == 1) continue;
#pragma unroll 1
        for (int hfi = 0; hfi < 2; ++hfi) {
            const int hf = (hfi + (F.vcu >> 2)) & 1;
            u32x4 rawr[4], rawk[4], rawv[4];
            { const unsigned off = (unsigned)WS_PROJ + ((unsigned)(m0 + 2 * w) * LDP + ZC0 + 512 * hf + 8 * (tid & 63)) * 2u;
#pragma unroll
              for (int rr = 0; rr < 4; ++rr) { const int t = t0 + 2 * w + rr - 1; const bool ok = (t >= 0) && (t < SEQ); const unsigned o = off + (unsigned)((rr - 1) * LDP * 2);
                  rawr[rr] = ld_row16(F, o, ok); rawk[rr] = ld_row16(F, o + 1024u * 2u, ok); rawv[rr] = ld_row16(F, o + 2048u * 2u, ok); } }
            {
                const int n16 = lane & 15, q4 = lane >> 4;
                bf16x8 af[9];
#pragma unroll
                for (int ks = 0; ks < 9; ++ks) af[ks] = *(const LAS bf16x8*)(Al + n16 * AP + 32 * ks + 8 * q4);
                struct BF { bf16x8 d0[2], d1[2], i0[2], i1[2], g[5]; };
#define LD_BF(X, nb_) do { const int cl_ = 512 * hf + 64 * w + 16 * (nb_) + n16; _Pragma("unroll") for (int ks = 0; ks < 2; ++ks) { \
                    X.d0[ks] = *(const bf16x8*)(DUt + (size_t)cl_ * 64 + 32 * ks + 8 * q4); X.d1[ks] = *(const bf16x8*)(DUt + (size_t)(1024 + cl_) * 64 + 32 * ks + 8 * q4); \
                    X.i0[ks] = *(const bf16x8*)(IUt + (size_t)cl_ * 64 + 32 * ks + 8 * q4); X.i1[ks] = *(const bf16x8*)(IUt + (size_t)(1024 + cl_) * 64 + 32 * ks + 8 * q4); } \
                    _Pragma("unroll") for (int ks = 0; ks < 5; ++ks) X.g[ks] = *(const bf16x8*)(GUt + (size_t)cl_ * 160 + 32 * ks + 8 * q4); } while (0)
#define DO_NB(X, nb_) do { const int ch_ = 64 * w + 16 * (nb_); \
                    f32x4 aw0 = {0.f, 0.f, 0.f, 0.f}, aw1 = aw0, aa0 = aw0, aa1 = aw0, ag = aw0; \
                    _Pragma("unroll") for (int ks = 0; ks < 2; ++ks) { \
                        aw0 = __builtin_amdgcn_mfma_f32_16x16x32_bf16(X.d0[ks], af[ks], aw0, 0, 0, 0); aw1 = __builtin_amdgcn_mfma_f32_16x16x32_bf16(X.d1[ks], af[ks], aw1, 0, 0, 0); \
                        aa0 = __builtin_amdgcn_mfma_f32_16x16x32_bf16(X.i0[ks], af[2 + ks], aa0, 0, 0, 0); aa1 = __builtin_amdgcn_mfma_f32_16x16x32_bf16(X.i1[ks], af[2 + ks], aa1, 0, 0, 0); } \
                    _Pragma("unroll") for (int ks = 0; ks < 5; ++ks) ag = __builtin_amdgcn_mfma_f32_16x16x32_bf16(X.g[ks], af[4 + ks], ag, 0, 0, 0); \
                    LAS bf16_t* pp = Pl + n16 * PP + ch_ + 4 * q4; \
                    *(LAS u32x2*)(pp) = (u32x2){cvtpk(aw0[0], aw0[1]), cvtpk(aw0[2], aw0[3])}; *(LAS u32x2*)(pp + PA) = (u32x2){cvtpk(aw1[0], aw1[1]), cvtpk(aw1[2], aw1[3])}; \
                    *(LAS u32x2*)(pp + 2 * PA) = (u32x2){cvtpk(aa0[0], aa0[1]), cvtpk(aa0[2], aa0[3])}; *(LAS u32x2*)(pp + 3 * PA) = (u32x2){cvtpk(aa1[0], aa1[1]), cvtpk(aa1[2], aa1[3])}; \
                    *(LAS u32x2*)(pp + 4 * PA) = (u32x2){cvtpk(ag[0], ag[1]), cvtpk(ag[2], ag[3])}; } while (0)
                const int rot = F.vcu & 3;
                BF fa, fb; LD_BF(fa, (0 + rot) & 3); LD_BF(fb, (1 + rot) & 3);
                DO_NB(fa, (0 + rot) & 3); LD_BF(fa, (2 + rot) & 3); DO_NB(fb, (1 + rot) & 3); LD_BF(fb, (3 + rot) & 3); DO_NB(fa, (2 + rot) & 3); DO_NB(fb, (3 + rot) & 3);
#undef LD_BF
#undef DO_NB
            }
            __syncthreads();
            {
                const int chk = tid & 63, c = 512 * hf + 8 * chk;
                float r4[4][8], k4[4][8], v4[4][8];
#pragma unroll
                for (int rr = 0; rr < 4; ++rr) { unpack8(rawr[rr], r4[rr]); unpack8(rawk[rr], k4[rr]); unpack8(rawv[rr], v4[rr]); }
                float zr[2][8], zk[2][8], zv[2][8];
                { float mp[8], mn[8];
                  ld8f(INP(F, 4, float) + c, mp); ld8f(INP(F, 5, float) + c, mn);
#pragma unroll
                  for (int tk = 0; tk < 2; ++tk)
#pragma unroll
                      for (int e = 0; e < 8; ++e) zr[tk][e] = r4[tk + 1][e] + mp[e] * (r4[tk][e] - r4[tk + 1][e]) + mn[e] * (r4[tk + 2][e] - r4[tk + 1][e]);
                  ld8f(INP(F, 4, float) + 1024 + c, mp); ld8f(INP(F, 5, float) + 1024 + c, mn);
#pragma unroll
                  for (int tk = 0; tk < 2; ++tk)
#pragma unroll
                      for (int e = 0; e < 8; ++e) zk[tk][e] = k4[tk + 1][e] + mp[e] * (k4[tk][e] - k4[tk + 1][e]) + mn[e] * (k4[tk + 2][e] - k4[tk + 1][e]);
                  ld8f(INP(F, 4, float) + 2048 + c, mp); ld8f(INP(F, 5, float) + 2048 + c, mn);
#pragma unroll
                  for (int tk = 0; tk < 2; ++tk)
#pragma unroll
                      for (int e = 0; e < 8; ++e) zv[tk][e] = v4[tk + 1][e] + mp[e] * (v4[tk][e] - v4[tk + 1][e]) + mn[e] * (v4[tk + 2][e] - v4[tk + 1][e]); }
                float kkw[8], w00[8], w01[8], a00[8], a01[8], kac[8], rkc[8];
                ld8f(INP(F, 16, float) + c, kkw); ld8f(INP(F, 11, float) + c, w00); ld8f(INP(F, 11, float) + 1024 + c, w01);
                ld8f(INP(F, 13, float) + c, a00); ld8f(INP(F, 13, float) + 1024 + c, a01); ld8f(INP(F, 17, float) + c, kac); ld8f(INP(F, 18, float) + c, rkc);
#pragma unroll 1
                for (int tk = 0; tk < 2; ++tk) {
                    const int tkn = 2 * w + tk; const unsigned o = (unsigned)(m0 + tkn) * 1024u + (unsigned)c;
                    const LAS bf16_t* pp = Pl + tkn * PP + 8 * chk;
                    float zrt[8], zkt[8], zvt[8];
#pragma unroll
                    for (int e = 0; e < 8; ++e) { zrt[e] = tk ? zr[1][e] : zr[0][e]; zkt[e] = tk ? zk[1][e] : zk[0][e]; zvt[e] = tk ? zv[1][e] : zv[0][e]; }
                    WS32(F, u32x4, (unsigned)WS_R + o * 2u) = pack8(zrt); WS32(F, u32x4, (unsigned)WS_V + o * 2u) = pack8(zvt);
                    float kk[8];
                    { float ss = 0.f;
#pragma unroll
                      for (int e = 0; e < 8; ++e) { kk[e] = zkt[e] * kkw[e]; ss += kk[e] * kk[e]; }
                      ss += __shfl_xor(ss, 1); ss += __shfl_xor(ss, 2); ss += __shfl_xor(ss, 4);
                      const float inv = 1.f / fmaxf(sqrtf(ss), 1e-12f);
#pragma unroll
                      for (int e = 0; e < 8; ++e) kk[e] *= inv;
                      WS32(F, u32x4, (unsigned)WS_KK + o * 2u) = pack8(kk); }
                    {
                        float pw0[8], pw1[8], d0[8], d1[8];
                        unpack8(*(const LAS u32x4*)(pp), pw0); unpack8(*(const LAS u32x4*)(pp + PA), pw1);
#pragma unroll
                        for (int e = 0; e < 8; ++e) {
                            d0[e] = 0.6065306597126334f * __builtin_amdgcn_rcpf(1.f + __expf(-(w00[e] + pw0[e]))); d1[e] = 0.6065306597126334f * __builtin_amdgcn_rcpf(1.f + __expf(-(w01[e] + pw1[e]))); }
                        WS32(F, u32x4, (unsigned)WS_WDEC + o * 2u) = pack8(d0); WS32(F, u32x4, (unsigned)WS_WDEC + ((unsigned)(MTOK * 1024) + o) * 2u) = pack8(d1);
                    }
                    {
                        float pa0[8], pa1[8], kd0[8], kd1[8], b0v[8], b1v[8]; float bs = 0.f;
                        unpack8(*(const LAS u32x4*)(pp + 2 * PA), pa0); unpack8(*(const LAS u32x4*)(pp + 3 * PA), pa1);
#pragma unroll
                        for (int e = 0; e < 8; ++e) {
                            const float av0 = __builtin_amdgcn_rcpf(1.f + __expf(-(a00[e] + pa0[e]))), av1 = __builtin_amdgcn_rcpf(1.f + __expf(-(a01[e] + pa1[e])));
                            kd0[e] = zkt[e] * (1.f + (av0 - 1.f) * kac[e]); kd1[e] = zkt[e] * (1.f + (av1 - 1.f) * kac[e]);
                            b0v[e] = kk[e] * av0; b1v[e] = kk[e] * av1;
                            bs += zrt[e] * (kd0[e] + kd1[e]) * rkc[e]; }
                        bs += __shfl_xor(bs, 1); bs += __shfl_xor(bs, 2); bs += __shfl_xor(bs, 4);
                        if ((chk & 7) == 0) WS32(F, float, (unsigned)WS_BONUS + ((unsigned)(m0 + tkn) * 16u + (unsigned)(8 * hf + (chk >> 3))) * 4u) = bs;
                        WS32(F, u32x4, (unsigned)WS_KD + o * 2u) = pack8(kd0); WS32(F, u32x4, (unsigned)WS_KD + ((unsigned)(MTOK * 1024) + o) * 2u) = pack8(kd1);
                        WS32(F, u32x4, (unsigned)WS_BB + o * 2u) = pack8(b0v); WS32(F, u32x4, (unsigned)WS_BB + ((unsigned)(MTOK * 1024) + o) * 2u) = pack8(b1v);
                    }
                    WS32(F, u32x4, (unsigned)WS_G + o * 2u) = *(const LAS u32x4*)(pp + 4 * PA);
                }
            }
            __syncthreads();
        }
    }
}

struct P5aConst { float lam; };
__device__ __forceinline__ void p5a_init(const Frame& F, P5aConst& K) {
    const int lane = F.lane;
    const float q1 = INP(F, 6, float)[lane] * INP(F, 7, float)[lane], q2 = INP(F, 8, float)[lane] * INP(F, 9, float)[lane];
    K.lam = __expf(wave_sum(q1)) - __expf(wave_sum(q2)) + 0.2f;
}
__device__ __forceinline__ void p5a_token(const Frame& F, const P5aConst& K, int m) {
    const bf16_t* OC = WSP(F, WS_OC, bf16_t); bf16_t* MIX = WSP(F, WS_MIX, bf16_t); const float* subw = INP(F, 10, float);
    const int c0 = F.lane * 16; const float lam = K.lam;
    const u32x4* p0 = (const u32x4*)(OC + (size_t)m * 1024 + c0); const u32x4* p1 = (const u32x4*)(OC + (size_t)MTOK * 1024 + (size_t)m * 1024 + c0);
    const u32x4 a0 = p0[0], a1 = p0[1], b0 = p1[0], b1 = p1[1];
    float dv[16]; const unsigned aw[8] = {a0.x, a0.y, a0.z, a0.w, a1.x, a1.y, a1.z, a1.w}, bw[8] = {b0.x, b0.y, b0.z, b0.w, b1.x, b1.y, b1.z, b1.w};
    float ssq = 0.f;
#pragma unroll
    for (int i = 0; i < 8; ++i) { dv[2 * i] = bf_lo(aw[i]) - lam * bf_lo(bw[i]); dv[2 * i + 1] = bf_hi(aw[i]) - lam * bf_hi(bw[i]); ssq += dv[2 * i] * dv[2 * i] + dv[2 * i + 1] * dv[2 * i + 1]; }
    ssq += __shfl_xor(ssq, 1); ssq += __shfl_xor(ssq, 2); ssq += __shfl_xor(ssq, 4);
    const float rstd = 1.f / sqrtf(ssq * (1.f / 128.f) + 1e-5f);
    unsigned ow[8];
#pragma unroll
    for (int i = 0; i < 8; ++i) { const float s0 = subw[(c0 + 2 * i) & 127] * 0.8f, s1 = subw[(c0 + 2 * i + 1) & 127] * 0.8f; ow[i] = cvtpk(dv[2 * i] * rstd * s0, dv[2 * i + 1] * rstd * s1); }
    u32x4* op = (u32x4*)(MIX + (size_t)m * 2048 + c0); op[0] = (u32x4){ow[0], ow[1], ow[2], ow[3]}; op[1] = (u32x4){ow[4], ow[5], ow[6], ow[7]};
}

__device__ __forceinline__ void p4_scan(Frame& F, const int mode = 0) {
    constexpr int CH = 32, NCH = SEQ / CH;
    constexpr int VEC = CH * 64 * 4;
    constexpr int BUF = 5 * VEC + CH * 32 * 4;
    constexpr int YOFF = 2 * BUF, YB = CH * 32 * 4;
    constexpr int CVT_SCR = 2 * BUF + 2 * YB;
    const bf16_t* Wdec = WSP(F, WS_WDEC, bf16_t); const bf16_t* KDg = WSP(F, WS_KD, bf16_t); const bf16_t* BBg = WSP(F, WS_BB, bf16_t);
    const bf16_t* Rg = WSP(F, WS_R, bf16_t); const bf16_t* KKg = WSP(F, WS_KK, bf16_t); const bf16_t* Vg = WSP(F, WS_V, bf16_t); bf16_t* YS = WSP(F, WS_YS, bf16_t);
    const int tid = F.tid, lane = F.lane, wid = F.wave;
    const bool is_comp = wid < 4;
    const int ri = wid & 3;
    if (is_comp) __builtin_amdgcn_s_setprio(3);
    const int g = lane >> 3, j = lane & 7, rowl = ri * 8 + g;
    const int mt = ri * 64 + lane, mw = ri;
    int cvt_it = F.vcu * 4 + mw; f32x4 cvv[16]; int ck0 = 0, crowb = 0; unsigned char* cWT = nullptr;
    f32x4 cvvB[16]; int ck0B = 0, crowbB = 0; unsigned char* cWTB = nullptr;
    LAS unsigned* st_cnt = (LAS unsigned*)(F.lds + CVT_SCR + 4 * 4096); LAS unsigned* cons_cnt = st_cnt + 16;
    for (int item = F.vcu; item < 256; item += F.G) {
        const int chain = item >> 1, half = item & 1, d = chain >> 6, b = (chain >> 4) & 3, h = chain & 15;
        const size_t sh = (size_t)b * SEQ * 1024 + h * 64, pd = (size_t)d * MTOK * 1024 + sh;
        f32x2 S2[4] = {{0.f, 0.f}, {0.f, 0.f}, {0.f, 0.f}, {0.f, 0.f}};
        u32x2 rw[2], rkk[2], rbb[2], rkd[2], rr[2]; unsigned rv[2];
        const int cstep = d ? -CH * 1024 : CH * 1024;
        unsigned po[2], pv[2];
#pragma unroll
        for (int q_ = 0; q_ < 2; ++q_) { const int sl_ = mt + 256 * q_, ss_ = sl_ >> 4, sk_ = (sl_ & 15) * 4, tq_ = d ? (SEQ - 1 - ss_) : ss_; po[q_] = (unsigned)(tq_ * 1024 + sk_); pv[q_] = (unsigned)(tq_ * 1024 + half * 32 + 2 * (sl_ & 15)); }
        const char* bW = (const char*)(Wdec + pd); const char* bKK = (const char*)(KKg + sh); const char* bBB = (const char*)(BBg + pd); const char* bKD = (const char*)(KDg + pd); const char* bR = (const char*)(Rg + sh); const char* bV = (const char*)(Vg + sh);
#define SC_LOAD(c) do { const unsigned cu_ = (unsigned)((c) * cstep); _Pragma("unroll") for (int q_ = 0; q_ < 2; ++q_) { const unsigned e_ = po[q_] + cu_; \
        rw[q_] = *(const u32x2*)(bW + (size_t)(e_ * 2u)); rkk[q_] = *(const u32x2*)(bKK + (size_t)(e_ * 2u)); rbb[q_] = *(const u32x2*)(bBB + (size_t)(e_ * 2u)); rkd[q_] = *(const u32x2*)(bKD + (size_t)(e_ * 2u)); rr[q_] = *(const u32x2*)(bR + (size_t)(e_ * 2u)); \
        rv[q_] = *(const unsigned*)(bV + (size_t)((pv[q_] + cu_) * 2u)); } } while (0)
#define SC_STORE(bufi) do { LAS unsigned char* bp_ = F.lds + (bufi) * BUF; _Pragma("unroll") for (int q_ = 0; q_ < 2; ++q_) { const int sl_ = mt + 256 * q_, ss_ = sl_ >> 4, sk_ = (sl_ & 15) * 4; const int o_ = (ss_ * 64 + sk_) * 4; \
        *(LAS f32x4*)(bp_ + o_) = (f32x4){__expf(-bf_lo(rw[q_].x)), __expf(-bf_hi(rw[q_].x)), __expf(-bf_lo(rw[q_].y)), __expf(-bf_hi(rw[q_].y))}; \
        *(LAS f32x4*)(bp_ + VEC + o_) = (f32x4){bf_lo(rkk[q_].x), bf_hi(rkk[q_].x), bf_lo(rkk[q_].y), bf_hi(rkk[q_].y)}; \
        *(LAS f32x4*)(bp_ + 2 * VEC + o_) = (f32x4){bf_lo(rbb[q_].x), bf_hi(rbb[q_].x), bf_lo(rbb[q_].y), bf_hi(rbb[q_].y)}; \
        *(LAS f32x4*)(bp_ + 3 * VEC + o_) = (f32x4){bf_lo(rkd[q_].x), bf_hi(rkd[q_].x), bf_lo(rkd[q_].y), bf_hi(rkd[q_].y)}; \
        *(LAS f32x4*)(bp_ + 4 * VEC + o_) = (f32x4){bf_lo(rr[q_].x), bf_hi(rr[q_].x), bf_lo(rr[q_].y), bf_hi(rr[q_].y)}; \
        *(LAS f32x2*)(bp_ + 5 * VEC + (ss_ * 32 + 2 * (sl_ & 15)) * 4) = (f32x2){bf_lo(rv[q_]), bf_hi(rv[q_])}; } } while (0)
#define Y_OUT(c) do { const int ys_ = mt >> 3, yr_ = (mt & 7) * 4; const int tt_ = (c) * CH + ys_, t_ = d ? (SEQ - 1 - tt_) : tt_; \
        const f32x4 yv_ = *(const LAS f32x4*)(F.lds + YOFF + ((c) & 1) * YB + (ys_ * 32 + yr_) * 4); \
        *(u32x2*)(YS + pd + (size_t)t_ * 1024 + half * 32 + yr_) = (u32x2){cvtpk(yv_.x, yv_.y), cvtpk(yv_.z, yv_.w)}; } while (0)
#define SC_WAIT(cnt_, tgt_) do { for (;;) { const u32x4 q_ = *(volatile LAS u32x4*)(cnt_); const unsigned a_ = q_.x < q_.y ? q_.x : q_.y, b_ = q_.z < q_.w ? q_.z : q_.w; \
        if ((a_ < b_ ? a_ : b_) >= (tgt_)) break; if (is_comp) __builtin_amdgcn_s_sleep(1); else __builtin_amdgcn_s_sleep(12); } asm volatile("" ::: "memory"); } while (0)
#define SC_SIGNAL(cnt_, val_) do { asm volatile("s_waitcnt lgkmcnt(0)" ::: "memory"); if (lane == 0) *(volatile LAS unsigned*)((cnt_) + ri) = (val_); } while (0)
        __syncthreads();
        if (tid < 4) { st_cnt[tid] = 0u; cons_cnt[tid] = 0u; }
        if (!is_comp) { SC_LOAD(0); SC_STORE(0); SC_LOAD(1); }
        __syncthreads();
        if (is_comp) {
          for (int c = 0; c < NCH; ++c) {
            SC_WAIT(st_cnt, (unsigned)c);
            if (mode != 2) {
                const LAS unsigned char* bp = F.lds + (c & 1) * BUF;
                LAS float* yb = (LAS float*)(F.lds + YOFF + (c & 1) * YB);
                f32x4 cw_[2], ckk[2], cbb[2], ckd[2], cr[2]; float cv;
#define SC_RD(s_) do { const int o_ = ((s_) * 64 + j * 8) * 4; cw_[0] = *(const LAS f32x4*)(bp + o_); cw_[1] = *(const LAS f32x4*)(bp + o_ + 16); ckk[0] = *(const LAS f32x4*)(bp + VEC + o_); ckk[1] = *(const LAS f32x4*)(bp + VEC + o_ + 16); \
                cbb[0] = *(const LAS f32x4*)(bp + 2 * VEC + o_); cbb[1] = *(const LAS f32x4*)(bp + 2 * VEC + o_ + 16); ckd[0] = *(const LAS f32x4*)(bp + 3 * VEC + o_); ckd[1] = *(const LAS f32x4*)(bp + 3 * VEC + o_ + 16); \
                cr[0] = *(const LAS f32x4*)(bp + 4 * VEC + o_); cr[1] = *(const LAS f32x4*)(bp + 4 * VEC + o_ + 16); cv = *(const LAS float*)(bp + 5 * VEC + ((s_) * 32 + rowl) * 4); } while (0)
#define H2(v_, i_) ((f32x2){v_[(i_) >> 1][((i_) & 1) * 2], v_[(i_) >> 1][((i_) & 1) * 2 + 1]})
                SC_RD(0);
                float yk = 0.f;
#pragma unroll
                for (int s = 0; s < CH; ++s) {
                    f32x4 w[2] = {cw_[0], cw_[1]}, kk[2] = {ckk[0], ckk[1]}, bb[2] = {cbb[0], cbb[1]}, kd[2] = {ckd[0], ckd[1]}, r[2] = {cr[0], cr[1]}; const float v = cv;
                    if (s + 1 < CH) SC_RD(s + 1);
                    f32x2 pa = S2[0] * H2(kk, 0), pb = S2[1] * H2(kk, 1); pa = S2[2] * H2(kk, 2) + pa; pb = S2[3] * H2(kk, 3) + pb; pa = pa + pb;
                    const f32x2 vv = {v, v};
                    f32x2 u[4];
#pragma unroll
                    for (int i = 0; i < 4; ++i) u[i] = S2[i] * H2(w, i) + vv * H2(kd, i);
                    float p = pa.x + pa.y;
                    p = dpp_add<0xB1>(p); p = dpp_add<0x4E>(p); p = dpp_add<0x141>(p);
                    const f32x2 sa = {-p, -p};
#pragma unroll
                    for (int i = 0; i < 4; ++i) S2[i] = sa * H2(bb, i) + u[i];
                    f32x2 ya = S2[0] * H2(r, 0), yc = S2[1] * H2(r, 1); ya = S2[2] * H2(r, 2) + ya; yc = S2[3] * H2(r, 3) + yc; ya = ya + yc;
                    float y = ya.x + ya.y;
                    y = dpp_add<0xB1>(y); y = dpp_add<0x4E>(y); y = dpp_add<0x141>(y);
                    yk = (j == (s & 7)) ? y : yk;
                    if ((s & 7) == 7) yb[((s & 24) + j) * 32 + rowl] = yk;
                }
#undef SC_RD
#undef H2
            }
            SC_SIGNAL(cons_cnt, (unsigned)(c + 1));
          }
        } else {
#define MEM_DUTIES(c_) do { SC_WAIT(cons_cnt, (unsigned)(c_)); if ((c_) >= 1 && mode != 2) Y_OUT((c_) - 1); if ((c_) + 1 < NCH) SC_STORE(((c_) + 1) & 1); SC_SIGNAL(st_cnt, (unsigned)((c_) + 1)); if ((c_) + 2 < NCH) SC_LOAD((c_) + 2); } while (0)
#define CVT_LOAD_SET(V_, K0_, WT_, RB_) do { const int it_ = cvt_it < N_EXPERT_ITEMS ? cvt_it : N_EXPERT_ITEMS - 1; const float* cW_; int cn0_; cvt_expert_decode(F, it_, cW_, K0_, cn0_, WT_, RB_); cvt8_load(V_, cW_, K0_, cn0_, lane); cvt_it += F.G * 4; } while (0)
          if (item == F.vcu) { P5aConst p5k; p5a_init(F, p5k); for (int xm = F.vcu * 4 + mw; xm < MTOK; xm += F.G * 4) p5a_token(F, p5k, xm); }
          int ngrp = 0; { const int left = (N_EXPERT_ITEMS - cvt_it + F.G * 4 - 1) / (F.G * 4); ngrp = left > 0 ? left / 3 : 0; if (ngrp > NCH / 4) ngrp = NCH / 4; }
          int cg = 0;
#pragma unroll 1
          for (; cg < 4 * ngrp; cg += 4) {
            MEM_DUTIES(cg);
#if CVT_IN_SCAN
            if (cg > 0) cvt8_finish(cvv, ck0, cWT, crowb, lane);
            CVT_LOAD_SET(cvv, ck0, cWT, crowb);
#endif
            MEM_DUTIES(cg + 1);
#if CVT_IN_SCAN
            CVT_LOAD_SET(cvvB, ck0B, cWTB, crowbB);
#endif
            MEM_DUTIES(cg + 2);
#if CVT_IN_SCAN
            cvt8_finish(cvv, ck0, cWT, crowb, lane);
            CVT_LOAD_SET(cvv, ck0, cWT, crowb);
#endif
            MEM_DUTIES(cg + 3);
#if CVT_IN_SCAN
            cvt8_finish(cvvB, ck0B, cWTB, crowbB, lane);
#endif
          }
#if CVT_IN_SCAN
          if (ngrp > 0) cvt8_finish(cvv, ck0, cWT, crowb, lane);
#endif
#pragma unroll 1
          for (; cg < NCH; ++cg) MEM_DUTIES(cg);
#undef MEM_DUTIES
#undef CVT_LOAD_SET
          SC_WAIT(cons_cnt, (unsigned)NCH);
        }
        if (!is_comp && mode != 2) Y_OUT(NCH - 1);
#undef SC_LOAD
#undef SC_STORE
#undef Y_OUT
#undef SC_WAIT
#undef SC_SIGNAL
    }
    __builtin_amdgcn_s_setprio(0);
#if CVT_IN_SCAN
    if (!is_comp) {
        for (; cvt_it < N_EXPERT_ITEMS; cvt_it += F.G * 4) {
            const float* W; int k0, n0, rowb; unsigned char* WT;
            cvt_expert_decode(F, cvt_it, W, k0, n0, WT, rowb); cvt8_load(cvv, W, k0, n0, lane); cvt8_finish(cvv, k0, WT, rowb, lane);
        }
    }
#endif
}

__device__ __forceinline__ void p5_finalize(Frame& F) {
    const bf16_t* OC = WSP(F, WS_OC, bf16_t); const bf16_t* YS = WSP(F, WS_YS, bf16_t); const bf16_t* Vg = WSP(F, WS_V, bf16_t); const bf16_t* Gg = WSP(F, WS_G, bf16_t);
    const float* BON = WSP(F, WS_BONUS, float); bf16_t* MIX = WSP(F, WS_MIX, bf16_t);
    const float* subw = INP(F, 10, float); const float* lnw = INP(F, 19, float); const float* lnb = INP(F, 20, float);
    const int lane = F.lane, gw = F.vcu * 8 + F.wave, NGW = F.G * 8;
    float lam;
    { const float q1 = INP(F, 6, float)[lane] * INP(F, 7, float)[lane], q2 = INP(F, 8, float)[lane] * INP(F, 9, float)[lane];
      lam = __expf(wave_sum(q1)) - __expf(wave_sum(q2)) + 0.2f; }
    const int c0 = lane * 16;
    float sw[16], lw[16], lb[16];
#pragma unroll
    for (int i = 0; i < 16; ++i) { sw[i] = subw[(c0 + i) & 127] * 0.8f; lw[i] = lnw[c0 + i]; lb[i] = lnb[c0 + i]; }
    for (int m = gw; m < MTOK; m += NGW) {
        { const u32x4* y0 = (const u32x4*)(YS + (size_t)m * 1024 + c0); const u32x4* y1 = (const u32x4*)(YS + (size_t)MTOK * 1024 + (size_t)m * 1024 + c0);
          float y[16]; float s = 0.f;
          { const u32x4 a0 = y0[0], a1 = y0[1], b0 = y1[0], b1 = y1[1];
            const unsigned aw[8] = {a0.x, a0.y, a0.z, a0.w, a1.x, a1.y, a1.z, a1.w}, bw[8] = {b0.x, b0.y, b0.z, b0.w, b1.x, b1.y, b1.z, b1.w};
#pragma unroll
            for (int i = 0; i < 8; ++i) { y[2 * i] = bf_lo(aw[i]) + bf_lo(bw[i]); y[2 * i + 1] = bf_hi(aw[i]) + bf_hi(bw[i]); } }
#pragma unroll
          for (int i = 0; i < 16; ++i) s += y[i];
          s += __shfl_xor(s, 1); s += __shfl_xor(s, 2);
          const float mu = s * (1.f / 64.f); float q = 0.f;
#pragma unroll
          for (int i = 0; i < 16; ++i) { y[i] -= mu; q += y[i] * y[i]; }
          q += __shfl_xor(q, 1); q += __shfl_xor(q, 2);
          const float rstd = 1.f / sqrtf(q * (1.f / 64.f) + 64e-5f);
          const float bon = BON[(size_t)m * 16 + (lane >> 2)];
          const u32x4* vp = (const u32x4*)(Vg + (size_t)m * 1024 + c0); const u32x4* gp = (const u32x4*)(Gg + (size_t)m * 1024 + c0);
          const u32x4 v0 = vp[0], v1 = vp[1], g0 = gp[0], g1 = gp[1];
          const unsigned vw[8] = {v0.x, v0.y, v0.z, v0.w, v1.x, v1.y, v1.z, v1.w}, gq[8] = {g0.x, g0.y, g0.z, g0.w, g1.x, g1.y, g1.z, g1.w};
          unsigned ow[8];
#pragma unroll
          for (int i = 0; i < 8; ++i) {
              const float e0 = (y[2 * i] * rstd * lw[2 * i] + lb[2 * i] + bon * bf_lo(vw[i])) * bf_lo(gq[i]);
              const float e1 = (y[2 * i + 1] * rstd * lw[2 * i + 1] + lb[2 * i + 1] + bon * bf_hi(vw[i])) * bf_hi(gq[i]);
              ow[i] = cvtpk(e0, e1); }
          u32x4* op = (u32x4*)(MIX + (size_t)m * 2048 + 1024 + c0); op[0] = (u32x4){ow[0], ow[1], ow[2], ow[3]}; op[1] = (u32x4){ow[4], ow[5], ow[6], ow[7]}; }
    }
}

__device__ __forceinline__ void p7_router(Frame& F) {
    const bf16_t* X1 = WSP(F, WS_X1, bf16_t); const float* nw = INP(F, 22, float); const float* wr = INP(F, 23, float);
    unsigned char* H2 = WSP(F, WS_H2, unsigned char); float* AFF = WSP(F, WS_AFF, float);
    const int lane = F.lane, tid = F.tid, gw = F.vcu * 8 + F.wave, NGW = F.G * 8;
    volatile LAS unsigned* MISC = (volatile LAS unsigned*)(F.lds + MISC_OFF);
    const unsigned m8 = MISC[8], m9 = MISC[9];
    __syncthreads();
    for (int f = tid; f < 2048 * 4; f += 512) { const int col = f >> 2, q = f & 3; *(LAS f32x4*)(F.lds + (col >> 2) * 272 + (col & 3) * 64 + q * 16) = *(const f32x4*)(wr + (size_t)col * 16 + 4 * q); }
    __syncthreads();
    for (int pr = gw; pr < MTOK / 2; pr += NGW) {
        const int m = 2 * pr;
        const u32x2* xr0 = (const u32x2*)(X1 + (size_t)m * DM) + lane; const u32x2* xr1 = xr0 + DM / 4;
        f32x4 v0[8], v1[8]; float s0 = 0.f, s1 = 0.f;
#pragma unroll
        for (int j = 0; j < 8; ++j) { const u32x2 a_ = xr0[64 * j], b_ = xr1[64 * j]; v0[j] = (f32x4){bf_lo(a_.x), bf_hi(a_.x), bf_lo(a_.y), bf_hi(a_.y)}; v1[j] = (f32x4){bf_lo(b_.x), bf_hi(b_.x), bf_lo(b_.y), bf_hi(b_.y)}; }
#pragma unroll
        for (int j = 0; j < 8; ++j) { s0 += (v0[j].x * v0[j].x + v0[j].y * v0[j].y) + (v0[j].z * v0[j].z + v0[j].w * v0[j].w); s1 += (v1[j].x * v1[j].x + v1[j].y * v1[j].y) + (v1[j].z * v1[j].z + v1[j].w * v1[j].w); }
        const float r0 = 1.f / sqrtf(wave_sum(s0) * (1.f / DM) + 1e-6f), r1 = 1.f / sqrtf(wave_sum(s1) * (1.f / DM) + 1e-6f);
        unsigned* o0 = (unsigned*)(H2 + (size_t)m * DM) + lane; unsigned* o1 = o0 + DM / 4;
        float acc[32];
#pragma unroll
        for (int i = 0; i < 32; ++i) acc[i] = 0.f;
#pragma unroll
        for (int j = 0; j < 8; ++j) {
            const f32x4 w = ((const f32x4*)nw)[lane + 64 * j];
            const f32x4 a = v0[j] * w * r0, b = v1[j] * w * r1;
            o0[64 * j] = pg8::cvt4_fp8(a.x, a.y, a.z, a.w);
            o1[64 * j] = pg8::cvt4_fp8(b.x, b.y, b.z, b.w);
            const LAS f32x4* wp = (const LAS f32x4*)(F.lds + (lane + 64 * j) * 272);
#pragma unroll
            for (int i = 0; i < 4; ++i) {
#pragma unroll
                for (int q = 0; q < 4; ++q) { const f32x4 ww = wp[i * 4 + q];
#pragma unroll
                    for (int e = 0; e < 4; ++e) { acc[4 * q + e] += a[i] * ww[e]; acc[16 + 4 * q + e] += b[i] * ww[e]; } }
                asm volatile("" ::: "memory");
            }
        }
#define RSTAGE(N_, B_) do { const bool up_ = (lane & (B_)) != 0; _Pragma("unroll") for (int k = 0; k < (N_); ++k) { const float lo_ = acc[k], hi_ = acc[(N_) + k]; \
            const float snd_ = up_ ? lo_ : hi_, kp_ = up_ ? hi_ : lo_; acc[k] = kp_ + __shfl_xor(snd_, (B_)); } } while (0)
        RSTAGE(16, 32); RSTAGE(8, 16); RSTAGE(4, 8); RSTAGE(2, 4); RSTAGE(1, 2);
#undef RSTAGE
        float lg = acc[0] + __shfl_xor(acc[0], 1);
        float mx = lg;
        mx = fmaxf(mx, __shfl_xor(mx, 2)); mx = fmaxf(mx, __shfl_xor(mx, 4)); mx = fmaxf(mx, __shfl_xor(mx, 8)); mx = fmaxf(mx, __shfl_xor(mx, 16));
        const float p = expf(lg - mx);
        float den = p; den += __shfl_xor(den, 2); den += __shfl_xor(den, 4); den += __shfl_xor(den, 8); den += __shfl_xor(den, 16);
        if ((lane & 1) == 0) { const int row = lane >> 5, e = (lane >> 1) & 15, mm = m + row; AFF[((size_t)(mm >> 11) * 16 + e) * SEQ + (mm & (SEQ - 1))] = p / den; }
    }
    __syncthreads();
    if (tid == 0) { MISC[8] = m8; MISC[9] = m9; }
    __syncthreads();
}

__device__ __forceinline__ int wave_count4(bool f0, bool f1, bool f2, bool f3) {
    return __builtin_popcountll(__ballot(f0)) + __builtin_popcountll(__ballot(f1)) + __builtin_popcountll(__ballot(f2)) + __builtin_popcountll(__ballot(f3));
}
__device__ __forceinline__ void p8_select(Frame& F) {
    const float* AFF = WSP(F, WS_AFF, float);
    int* XEIDX = WSP(F, WS_XEIDX, int); float* GATEX = WSP(F, WS_GATEX, float); int* SLOT = WSP(F, WS_SLOT, int);
    LAS int* part = (LAS int*)F.lds;
    LAS unsigned* cnt = (LAS unsigned*)(F.lds + 256);
    LAS unsigned* list = (LAS unsigned*)(F.lds + 512);
    const int tid = F.tid, lane = F.lane, w = F.wave;
    for (int item = F.vcu; item < 256; item += F.G) {
        const int be = item >> 2, q = item & 3, b = be >> 4, e = be & 15;
        __syncthreads();
        if (tid == 0) *cnt = 0u;
        const f32x4 a4 = ((const f32x4*)(AFF + (size_t)be * SEQ))[tid];
        const unsigned u0 = __float_as_uint(a4.x), u1 = __float_as_uint(a4.y), u2 = __float_as_uint(a4.z), u3 = __float_as_uint(a4.w);
        unsigned lo = 0u, hi = 0x7f800001u;
        int itn = 0;
        while (hi - lo > 1u) {
            const unsigned mid = lo + ((hi - lo) >> 1);
            const int c = wave_count4(u0 >= mid, u1 >= mid, u2 >= mid, u3 >= mid);
            LAS int* pp = part + (itn & 1) * 8;
            if (lane == 0) pp[w] = c;
            __syncthreads();
            int tot = 0;
#pragma unroll
            for (int i = 0; i < 8; ++i) tot += pp[i];
            if (tot >= CAP) lo = mid; else hi = mid;
            ++itn;
        }
        const unsigned T = lo;
        const bool g0 = u0 > T, g1 = u1 > T, g2 = u2 > T, g3 = u3 > T, q0 = u0 == T, q1 = u1 == T, q2 = u2 == T, q3 = u3 == T;
        const unsigned long long bg0 = __ballot(g0), bg1 = __ballot(g1), bg2 = __ballot(g2), bg3 = __ballot(g3), bq0 = __ballot(q0), bq1 = __ballot(q1), bq2 = __ballot(q2), bq3 = __ballot(q3);
        const unsigned long long below = (lane == 0) ? 0ull : (~0ull >> (64 - lane));
        int pg = __builtin_popcountll(bg0 & below) + __builtin_popcountll(bg1 & below) + __builtin_popcountll(bg2 & below) + __builtin_popcountll(bg3 & below);
        int pq = __builtin_popcountll(bq0 & below) + __builtin_popcountll(bq1 & below) + __builtin_popcountll(bq2 & below) + __builtin_popcountll(bq3 & below);
        const int wg = __builtin_popcountll(bg0) + __builtin_popcountll(bg1) + __builtin_popcountll(bg2) + __builtin_popcountll(bg3);
        const int wq = __builtin_popcountll(bq0) + __builtin_popcountll(bq1) + __builtin_popcountll(bq2) + __builtin_popcountll(bq3);
        if (lane == 0) { part[16 + w] = wg; part[32 + w] = wq; }
        __syncthreads();
        int gtc = 0, baseg = 0, baseq = 0;
#pragma unroll
        for (int i = 0; i < 8; ++i) { const int x = part[16 + i], y = part[32 + i]; gtc += x; if (i < w) { baseg += x; baseq += y; } }
        const int need = CAP - gtc;
        pg += baseg; pq += baseq;
        if ((w >> 1) == q) {
            const bool gs[4] = {g0, g1, g2, g3}, qs[4] = {q0, q1, q2, q3}; const float av[4] = {a4.x, a4.y, a4.z, a4.w};
            int cg_ = pg, cq_ = pq;
#pragma unroll
            for (int i = 0; i < 4; ++i) {
                const int t = 4 * tid + i, m = b * SEQ + t; int slot = -1;
                if (gs[i]) { slot = cg_; ++cg_; } else if (qs[i]) { if (cq_ < need) slot = gtc + cq_; ++cq_; }
                SLOT[m * 16 + e] = slot;
                if (slot >= 0) { GATEX[(e * 4 + b) * CAP + slot] = av[i]; XEIDX[(e * 4 + b) * CAP + slot] = m; }
            }
        }
    }
}

__device__ __forceinline__ void p11_final(Frame& F) {
    const bf16_t* X1 = WSP(F, WS_X1, bf16_t); const bf16_t* YE = WSP(F, WS_YE, bf16_t); const int* SLOT = WSP(F, WS_SLOT, int); const float* nw = INP(F, 27, float);
    float* out = F.a->out;
    const int lane = F.lane, gw = F.vcu * 8 + F.wave, NGW = F.G * 8;
    for (int m = gw; m < MTOK; m += NGW) {
        const int b = m >> 11;
        float v[32];
        { const u32x4* xr = (const u32x4*)(X1 + (size_t)m * DM + lane * 8);
#pragma unroll
          for (int j = 0; j < 4; ++j) { const u32x4 a = xr[64 * j]; v[8 * j] = bf_lo(a.x); v[8 * j + 1] = bf_hi(a.x); v[8 * j + 2] = bf_lo(a.y); v[8 * j + 3] = bf_hi(a.y); v[8 * j + 4] = bf_lo(a.z); v[8 * j + 5] = bf_hi(a.z); v[8 * j + 6] = bf_lo(a.w); v[8 * j + 7] = bf_hi(a.w); } }
        int sl = (lane < 16) ? SLOT[m * 16 + lane] : -1;
        for (int e = 0; e < 16; ++e) {
            const int s = __shfl(sl, e);
            if (s >= 0) { const u32x4* yr = (const u32x4*)(YE + (size_t)((e * 4 + b) * CAP + s) * DM + lane * 8);
#pragma unroll
                for (int j = 0; j < 4; ++j) { const u32x4 w = yr[64 * j];
                    v[8 * j] += bf_lo(w.x); v[8 * j + 1] += bf_hi(w.x); v[8 * j + 2] += bf_lo(w.y); v[8 * j + 3] += bf_hi(w.y); v[8 * j + 4] += bf_lo(w.z); v[8 * j + 5] += bf_hi(w.z); v[8 * j + 6] += bf_lo(w.w); v[8 * j + 7] += bf_hi(w.w); } }
        }
        float s = 0.f;
#pragma unroll
        for (int i = 0; i < 32; ++i) s += v[i] * v[i];
        const float rstd = 1.f / sqrtf(wave_sum(s) * (1.f / DM) + 1e-6f);
#pragma unroll
        for (int j = 0; j < 4; ++j) { const int col = 512 * j + lane * 8; const f32x4 w0 = *(const f32x4*)(nw + col), w1 = *(const f32x4*)(nw + col + 4);
            f32x4 o0 = {v[8 * j] * rstd * w0.x, v[8 * j + 1] * rstd * w0.y, v[8 * j + 2] * rstd * w0.z, v[8 * j + 3] * rstd * w0.w};
            f32x4 o1 = {v[8 * j + 4] * rstd * w1.x, v[8 * j + 5] * rstd * w1.y, v[8 * j + 6] * rstd * w1.z, v[8 * j + 7] * rstd * w1.w};
            *(f32x4*)(out + (size_t)m * DM + col) = o0; *(f32x4*)(out + (size_t)m * DM + col + 4) = o1; }
    }
}


template <int PHM> __global__ void __launch_bounds__(512, 2) mk_fwd(Args args) {
    extern __shared__ __attribute__((aligned(16))) unsigned char lds[];
    Frame F;
    F.lds = (LAS unsigned char*)lds; F.ldsg = (char*)lds; F.a = &args;
    F.tid = threadIdx.x; F.lane = F.tid & 63; F.wave = __builtin_amdgcn_readfirstlane(F.tid >> 6);
    F.G = gridDim.x; { const int bx = blockIdx.x; F.vcu = (F.G % 8 == 0) ? (bx % 8) * (F.G / 8) + bx / 8 : bx; }
    volatile LAS unsigned* MISC = (volatile LAS unsigned*)(F.lds + MISC_OFF);
    for (int u = F.tid; u < (LDS_BYTES - 131072) / 4; u += 512) ((LAS unsigned*)(F.lds + 131072))[u] = 0u;
    __syncthreads();
    gu32* ctl = (gu32*)(args.ws + WS_CTL);
    XcdBarrier bar; bar.bar = (unsigned*)(ctl + CW_BAR); bar.x = 0; bar.st = nullptr;
    if (MK_N_LAUNCHES == 1) bar = xcd_barrier_post((unsigned*)(ctl + CW_BAR), MISC + 8);
    const int lo = args.ph_lo, hi = args.ph_hi;
#define IN(k) (((PHM >> (k)) & 1) && lo <= (k) && (k) < hi)
#ifndef DUP_MASK
#define DUP_MASK 0
#endif
#define REP(k) for (int rep_ = 0; rep_ < 1 + ((DUP_MASK >> (k)) & 1); ++rep_)
#define SEAM(k) do { if (IN(k) && IN((k) + 1)) xcd_barrier(bar); } while (0)

    if (IN(0)) REP(0) { p0_prologue(F); }
    SEAM(0);
    if (IN(1)) REP(1) {
        pg8::Gemm g{WSP(F, WS_H1, bf16_t), WSP(F, WS_WIN, bf16_t), MTOK, 6144, DM, DM}; pg8::StaticOrder S; S.init(MTOK, 6144, F.G, (int)blockIdx.x);
        pg8::EpiProj E{WSP(F, WS_PROJ, bf16_t), LDP, WSP(F, WS_ROPE, float), QSCALE};
        pg8::gemm_phase<pg8::EpiProj, pg8::StaticOrder, true, true>(F.lds, g, S, E);
        pg8::Gemm g2{WSP(F, WS_H1, bf16_t), WSP(F, WS_WIN, bf16_t), MTOK, 512, DM / 4, DM}; pg8::TailOrder S2{F.G, (int)blockIdx.x};
        pg8::EpiPart E2{WSP(F, WS_PART, bf16_t)};
        pg8::gemm_phase<pg8::EpiPart, pg8::TailOrder, true, true>(F.lds, g2, S2, E2);
    }
    SEAM(1);
    if (IN(2)) REP(2) {
        const bf16_t* P = WSP(F, WS_PROJ, bf16_t); bf16_t* OC = WSP(F, WS_OC, bf16_t);
        for (int u = F.vcu * 2; u < 512; u += F.G * 2)
            for (int i = 0; i < 2; ++i) {
                const int uu = u + i, qb = uu & 7, c = (uu >> 3) & 1, h = (uu >> 4) & 7, b = uu >> 7;
                const size_t m0 = (size_t)b * SEQ;
                att::attn_unit<LDP>(P + (m0 + qb * 256) * LDP + h * 128 + c * 64, P + m0 * LDP + 1024 + h * 128 + c * 64, P + m0 * LDP + 2048 + h * 128,
                                    OC + (size_t)c * MTOK * 1024 + (m0 + qb * 256) * 1024 + h * 128, SEQ, F.ldsg);
            }
    }
    if (IN(3)) REP(3) { p3_prep(F, rep_ ? 1 : 0); }
    SEAM(3);
    #ifndef SCAN_PROBE
#define SCAN_PROBE 0
#endif
    if (IN(4)) REP(4) { p4_scan(F, rep_ ? SCAN_PROBE : 0); }
    SEAM(4);
    if (IN(5)) REP(5) { p5_finalize(F); }
    SEAM(5);
    if (IN(6)) REP(6) {
        pg8::Gemm g{WSP(F, WS_MIX, bf16_t), WSP(F, WS_WOUT, bf16_t), MTOK, DM, DM, DM}; pg8::StaticOrder S; S.init(MTOK, DM, F.G, (int)blockIdx.x);
        pg8::EpiResid E{INP(F, 0, float), WSP(F, WS_X1, bf16_t), DM};
        pg8::gemm_phase<pg8::EpiResid, pg8::StaticOrder, true, true>(F.lds, g, S, E);
    }
    SEAM(6);
    if (IN(7)) REP(7) { p7_router(F); }
    SEAM(7);
    if (IN(8)) REP(8) { p8_select(F); }
    SEAM(8);
    if (IN(9)) REP(9) {
        pg8::Gemm g{WSP(F, WS_H2, bf16_t), WSP(F, WS_WGU, bf16_t), 16384, 65536, DM / 2, DM / 2}; pg8::MoeOrderT<true> S{F.G, F.vcu, 16, 1024, WSP(F, WS_XEIDX, int)};
        pg8::EpiSwiglu E{WSP(F, WS_HID, unsigned char), 16};
        pg8::gemm_phase<pg8::EpiSwiglu, pg8::MoeOrderT<true>, true, true, true>(F.lds, g, S, E);
    }
    SEAM(9);
    if (IN(10)) REP(10) {
        pg8::Gemm g{WSP(F, WS_HID, bf16_t), WSP(F, WS_WD, bf16_t), 16384, 32768, DM / 2, DM / 2}; pg8::MoeOrderT<false> S{F.G, F.vcu, 8, 512, nullptr};
        pg8::EpiDown E{WSP(F, WS_YE, bf16_t), WSP(F, WS_GATEX, float), 8};
        pg8::gemm_phase<pg8::EpiDown, pg8::MoeOrderT<false>, true, true, true>(F.lds, g, S, E);
    }
    SEAM(10);
    if (IN(11)) REP(11) { p11_final(F); }
#undef IN
#undef SEAM
}

static const void* kfn(int li) {
#if MK_N_LAUNCHES == 1
    (void)li; return (const void*)mk_fwd<0xFFF>;
#else
    switch (li) {
        case 0: return (const void*)mk_fwd<1>; case 1: return (const void*)mk_fwd<2>; case 2: return (const void*)mk_fwd<4>; case 3: return (const void*)mk_fwd<8>;
        case 4: return (const void*)mk_fwd<16>; case 5: return (const void*)mk_fwd<32>; case 6: return (const void*)mk_fwd<64>; case 7: return (const void*)mk_fwd<128>;
        case 8: return (const void*)mk_fwd<256>; case 9: return (const void*)mk_fwd<512>; case 10: return (const void*)mk_fwd<1024>; default: return (const void*)mk_fwd<2048>;
    }
#endif
}
extern "C" void kernel_launch(void* const* d_in, const int* in_sizes, int n_in, void* d_out, int out_size, void* d_ws, size_t ws_size, hipStream_t stream) {
    static int grid = 0;
    if (grid == 0) {
        if (n_in != 28 || out_size != MTOK * DM || ws_size < WS_END) { fprintf(stderr, "kernel_launch: unexpected shapes: n_in %d out %d ws %zu (need >= %zu)\n", n_in, out_size, ws_size, (size_t)WS_END); grid = -1; return; }
        int dev = 0, cus = 0, per_cu = 0;
        if (hipGetDevice(&dev) != hipSuccess || hipDeviceGetAttribute(&cus, hipDeviceAttributeMultiprocessorCount, dev) != hipSuccess) { fprintf(stderr, "kernel_launch: device query failed\n"); grid = -1; return; }
        for (int i = 0; i < MK_N_LAUNCHES; ++i) if (hipFuncSetAttribute(kfn(i), hipFuncAttributeMaxDynamicSharedMemorySize, LDS_BYTES) != hipSuccess) { fprintf(stderr, "kernel_launch: hipFuncSetAttribute failed\n"); grid = -1; return; }
        if (hipOccupancyMaxActiveBlocksPerMultiprocessor(&per_cu, kfn(0), 512, LDS_BYTES) != hipSuccess || per_cu < 1) { fprintf(stderr, "kernel_launch: occupancy query says %d blocks/CU\n", per_cu); }
        (void)hipGetLastError();
        grid = cus;
    }
    if (grid < 0) return;
    if (hipMemsetAsync((char*)d_ws + WS_CTL, 0, CTL_ZERO_BYTES, stream) != hipSuccess) { fprintf(stderr, "kernel_launch: memset failed\n"); return; }
    Args a{};
    for (int i = 0; i < 28; ++i) a.in[i] = d_in[i];
    a.out = (float*)d_out; a.ws = (unsigned char*)d_ws;
    const int nl = MK_N_LAUNCHES;
    for (int li = 0; li < nl; ++li) {
        a.ph_lo = (nl == 1) ? 0 : li; a.ph_hi = (nl == 1) ? N_PHASES : li + 1; a.li = li;
        void* kargs[] = {&a};
        (void)hipLaunchKernel(kfn(li), dim3(grid), dim3(512), kargs, LDS_BYTES, stream);
        const hipError_t le = hipPeekAtLastError();
        if (le != hipSuccess) { fprintf(stderr, "kernel_launch: launch %d failed: %s\n", li, hipGetErrorName(le)); break; }
    }
}
```

```cpp
#include <hip/hip_runtime.h>
#include <hip/hip_bf16.h>
#include <cstdio>
#include <cstdint>

#ifndef MK_N_LAUNCHES
#define MK_N_LAUNCHES 1
#endif
#ifndef CVT_IN_SCAN
#define CVT_IN_SCAN 1
#endif
constexpr int N_PHASES = 12;

constexpr int BATCH = 4, SEQ = 2048, DM = 2048, MTOK = BATCH * SEQ;
constexpr int IN_COLS = 6432, LDP = 6656;
constexpr int ZC0 = 3072;
constexpr int RW = 1024, NH_R = 16, HD_R = 64;
constexpr int NEXP = 16, CAP = 256, FF = 2048;
constexpr float QSCALE = 0.18033688011112042f;

constexpr size_t MiB = 1u << 20;
constexpr size_t WS_CTL = 0, CTL_ZERO_BYTES = 1 * MiB;
constexpr size_t WS_ROPE = 1 * MiB;
constexpr size_t WS_LORA = 2 * MiB;
constexpr size_t WS_AFF = 3 * MiB;
constexpr size_t WS_GATEX = 3 * MiB + 512 * 1024;
constexpr size_t WS_SLOT = 4 * MiB;
constexpr size_t WS_XEIDX = 6 * MiB;
constexpr size_t WS_BONUS = 5 * MiB;
constexpr size_t WS_WIN = 8 * MiB;
constexpr size_t WS_WOUT = 34 * MiB;
constexpr size_t WS_WGU = 48 * MiB;
constexpr size_t WS_WD = 304 * MiB;
constexpr size_t WS_H1 = 432 * MiB;
constexpr size_t WS_PROJ = 464 * MiB;
constexpr size_t WS_R = 568 * MiB, WS_KK = 584 * MiB, WS_V = 600 * MiB;
constexpr size_t WS_WDEC = 616 * MiB;
constexpr size_t WS_KD = 680 * MiB, WS_BB = 712 * MiB;
constexpr size_t WS_G = 744 * MiB;
constexpr size_t WS_OC = 760 * MiB;
constexpr size_t WS_YS = 792 * MiB;
constexpr size_t WS_MIX = 856 * MiB;
constexpr size_t WS_X1 = 888 * MiB;
constexpr size_t WS_H2 = 952 * MiB;
constexpr size_t WS_HID = 528 * MiB, WS_YE = 592 * MiB;
constexpr size_t WS_PART = WS_X1;
constexpr size_t WS_END = 984 * MiB;
constexpr int CW_BAR = 4096;

constexpr int LDS_BYTES = 147456;
constexpr int MISC_OFF = 131072 + 320;

#define GAS __attribute__((address_space(1)))
#define LAS __attribute__((address_space(3)))
typedef unsigned short bf16_t;
typedef float f32x4 __attribute__((ext_vector_type(4)));
typedef float f32x2 __attribute__((ext_vector_type(2)));
typedef float f32x16 __attribute__((ext_vector_type(16)));
typedef unsigned u32x4 __attribute__((ext_vector_type(4)));
typedef unsigned u32x2 __attribute__((ext_vector_type(2)));
typedef short bf16x8 __attribute__((ext_vector_type(8)));
typedef short s16x4 __attribute__((ext_vector_type(4)));
typedef __bf16 bf16x2_t __attribute__((ext_vector_type(2)));

__device__ __forceinline__ unsigned cvtpk(float lo, float hi) { f32x2 v = {lo, hi}; bf16x2_t b = __builtin_convertvector(v, bf16x2_t); return __builtin_bit_cast(unsigned, b); }
__device__ __forceinline__ float bf_lo(unsigned w) { return __uint_as_float(w << 16); }
__device__ __forceinline__ float bf_hi(unsigned w) { return __uint_as_float(w & 0xffff0000u); }
__device__ __forceinline__ float bf2f(bf16_t v) { return __uint_as_float((unsigned)v << 16); }
__device__ __forceinline__ float wave_sum(float v) {
#pragma unroll
    for (int o = 1; o < 64; o <<= 1) v += __shfl_xor(v, o);
    return v;
}
__device__ __forceinline__ float sigmoidf_(float x) { return 1.f / (1.f + __expf(-x)); }

struct Args { const void* in[28]; float* out; unsigned char* ws; int ph_lo, ph_hi, li, pad; };

namespace pg8 {
#define PG8_LAS __attribute__((address_space(3)))
typedef unsigned short bf16_t;
typedef short bf16x8 __attribute__((ext_vector_type(8)));
typedef float f32x4 __attribute__((ext_vector_type(4)));
typedef unsigned u32x4 __attribute__((ext_vector_type(4)));
typedef unsigned u32x2 __attribute__((ext_vector_type(2)));
typedef int i32x4 __attribute__((ext_vector_type(4)));
typedef int i32x8 __attribute__((ext_vector_type(8)));
typedef float f32x8 __attribute__((ext_vector_type(8)));
typedef float f32x32 __attribute__((ext_vector_type(32)));
constexpr int BM = 256, BK = 64, HALF = 128, HTB = HALF * BK * 2  , STAGE_BYTES = 8 * HTB, NXCD = 8, WGM = 8;

__host__ __device__ __forceinline__ int lds_byte(int r, int c) { const int st = (r >> 4) * 2 + (c >> 5), rr = r & 15, cc = c & 31, ob = rr * 64 + cc * 2; return st * 1024 + (ob ^ (((ob >> 9) & 1) << 5)); }
__host__ __device__ __forceinline__ void stage_rc(int b, int& R, int& C) { const int st = b / 1024, sb = b % 1024, swz = sb ^ (((sb >> 9) & 1) << 5); R = (st >> 1) * 16 + swz / 64; C = (st & 1) * 32 + (swz % 64) / 2; }
__host__ __device__ __forceinline__ int perm32(int rho) { const int n = rho >> 4, i = rho & 15; return 8 * (i >> 2) + 4 * n + (i & 3); }

struct Unit { int pm, pn, pk; };
struct Gemm { const bf16_t* A; const bf16_t* Bt; int M, N, K, Kp; };

struct StaticOrder {
    int nM, nN, nwg, G, c;
    __host__ __device__ void init(int M, int N, int G_, int c_) { nM = M / BM; nN = N / BM; nwg = nM * nN; G = G_; c = c_; }
    __host__ __device__ bool next(int i, Unit& u) const {
        const long L = (long)i * G + c; if (L >= nwg) return false;
        int wgid = (int)L; { const int q = nwg / NXCD, r = nwg % NXCD, xcd = wgid % NXCD, off = wgid / NXCD; wgid = (xcd < r ? xcd * (q + 1) : r * (q + 1) + (xcd - r) * q) + off; }
        const int nig = WGM * nN, gid = wgid / nig, fm = gid * WGM, gsz = (nM - fm) < WGM ? (nM - fm) : WGM;
        u.pm = fm + ((wgid % nig) % gsz); u.pn = (wgid % nig) / gsz; u.pk = 0; return true;
    }
    static constexpr bool GATHER = false;
    __device__ __forceinline__ int arow(const Unit&, int) const { return 0; }
    __device__ __forceinline__ void a_ready(const Unit&) const {}
    __device__ __forceinline__ void done(const Unit&) const {}
};


typedef float f32x2 __attribute__((ext_vector_type(2)));
typedef __bf16 bf16x2_t __attribute__((ext_vector_type(2)));
__device__ __forceinline__ unsigned cvt_pk_bf16(float lo, float hi) { f32x2 v = {lo, hi}; bf16x2_t b = __builtin_convertvector(v, bf16x2_t); return __builtin_bit_cast(unsigned, b); }

template <bool GATHER_> struct MoeOrderT {
    static constexpr bool GATHER = GATHER_;
    int G, vcu, npn, total; const int* idx;
    __device__ __forceinline__ int arow(const Unit& u, int r) const { return idx[u.pm * BM + r]; }
    __device__ bool next(int i, Unit& u) const {
        const int L = i * G + vcu; if (L >= total) return false;
        const int per_e = 4 * npn, e = L / per_e, r = L % per_e;
        u.pm = e * 4 + (r & 3); u.pn = e * npn + (r >> 2); u.pk = 0; return true;
    }
    __device__ __forceinline__ void a_ready(const Unit&) const {}
    __device__ __forceinline__ void done(const Unit&) const {}
};

struct TailOrder {
    int G, c; static constexpr bool GATHER = false;
    __device__ bool next(int i, Unit& u) const { const int L = i * G + c; if (L >= 256) return false; u.pk = L & 3; const int t = L >> 2; u.pm = t & 31; u.pn = 24 + (t >> 5); return true; }
    __device__ __forceinline__ int arow(const Unit&, int) const { return 0; }
    __device__ __forceinline__ void a_ready(const Unit&) const {}
    __device__ __forceinline__ void done(const Unit&) const {}
};
struct EpiPart {
    static constexpr bool PERM = true, AFTER_DRAIN = false;
    bf16_t* P;
    __device__ __forceinline__ void operator()(const f32x4 (&acc)[2][2][4][2], const Unit& u, int wr, int wc, int fr, int fq) const {
        bf16_t* base = P + ((size_t)(((u.pn - 24) * 32 + u.pm) * 4 + u.pk) << 16);
        const int row0 = wr * 64 + fr, col0 = wc * 32 + 8 * fq;
        const bool thin = (u.pn == 25);
        if (thin && wc != 0) return;
#pragma unroll
        for (int ai = 0; ai < 2; ++ai)
#pragma unroll
            for (int m = 0; m < 4; ++m) {
                bf16_t* rowp = base + (row0 + ai * HALF + m * 16) * 256 + col0;
#pragma unroll
                for (int bj = 0; bj < 2; ++bj) { if (bj == 1 && thin) break; const f32x4 v0 = acc[ai][bj][m][0], v1 = acc[ai][bj][m][1];
                    u32x4 w; w.x = cvt_pk_bf16(v0[0], v0[1]); w.y = cvt_pk_bf16(v0[2], v0[3]); w.z = cvt_pk_bf16(v1[0], v1[1]); w.w = cvt_pk_bf16(v1[2], v1[3]);
                    *(u32x4*)(rowp + bj * HALF) = w; }
            }
    }
};

struct EpiProj {
    static constexpr bool PERM = true, AFTER_DRAIN = false;
    bf16_t* P; int ldp; const float* rope; float qscale;
    __device__ __forceinline__ void operator()(const f32x4 (&acc)[2][2][4][2], const Unit& u, int wr, int wc, int fr, int fq) const {
        const int row0 = u.pm * BM + wr * 64 + fr, colt = u.pn * BM, col0 = colt + wc * 32 + 8 * fq;
        const bool ropew = (colt < 2048) && ((wc & 1) == 0);
        const float sc = (colt < 1024) ? qscale : 1.f, sgn = (fq == 0) ? -1.f : 1.f;
#pragma unroll
        for (int ai = 0; ai < 2; ++ai)
#pragma unroll
            for (int m = 0; m < 4; ++m) {
                const int row = row0 + ai * HALF + m * 16;
                f32x4 c0 = {1.f, 1.f, 1.f, 1.f}, c1 = c0, s0 = {0.f, 0.f, 0.f, 0.f}, s1 = s0;
                if (ropew) { const f32x4* rp = (const f32x4*)(rope + (size_t)row * 16); c0 = rp[0]; c1 = rp[1]; s0 = rp[2]; s1 = rp[3]; }
                bf16_t* rowp = P + (size_t)row * ldp + col0;
#pragma unroll
                for (int bj = 0; bj < 2; ++bj) {
                    f32x4 v0 = acc[ai][bj][m][0], v1 = acc[ai][bj][m][1];
                    if (ropew) {
                        f32x4 p0, p1;
#pragma unroll
                        for (int i = 0; i < 4; ++i) { p0[i] = __shfl_xor(v0[i], 16); p1[i] = __shfl_xor(v1[i], 16); }
                        if (fq < 2) { v0 = v0 * c0 + (p0 * s0) * sgn; v1 = v1 * c1 + (p1 * s1) * sgn; }
                    }
                    v0 = v0 * sc; v1 = v1 * sc;
                    u32x4 w; w.x = cvt_pk_bf16(v0[0], v0[1]); w.y = cvt_pk_bf16(v0[2], v0[3]); w.z = cvt_pk_bf16(v1[0], v1[1]); w.w = cvt_pk_bf16(v1[2], v1[3]);
                    *(u32x4*)(rowp + bj * HALF) = w;
                }
            }
    }
};

struct EpiResid {
    static constexpr bool PERM = true, AFTER_DRAIN = false;
    const float* base; bf16_t* out; int ldc;
    __device__ __forceinline__ void operator()(const f32x4 (&acc)[2][2][4][2], const Unit& u, int wr, int wc, int fr, int fq) const {
        const int row0 = u.pm * BM + wr * 64 + fr, col0 = u.pn * BM + wc * 32 + 8 * fq;
#pragma unroll
        for (int ai = 0; ai < 2; ++ai)
#pragma unroll
            for (int m = 0; m < 4; ++m) {
                const size_t off = (size_t)(row0 + ai * HALF + m * 16) * ldc + col0;
#pragma unroll
                for (int bj = 0; bj < 2; ++bj) { const f32x4 b0 = *(const f32x4*)(base + off + bj * HALF), b1 = *(const f32x4*)(base + off + bj * HALF + 4);
                    const f32x4 v0 = b0 + acc[ai][bj][m][0], v1 = b1 + acc[ai][bj][m][1];
                    u32x4 w; w.x = cvt_pk_bf16(v0[0], v0[1]); w.y = cvt_pk_bf16(v0[2], v0[3]); w.z = cvt_pk_bf16(v1[0], v1[1]); w.w = cvt_pk_bf16(v1[2], v1[3]);
                    *(u32x4*)(out + off + bj * HALF) = w; }
            }
    }
};

__device__ __forceinline__ float clamp8(float x) { return __builtin_fminf(__builtin_fmaxf(x, -448.f), 448.f); }
__device__ __forceinline__ unsigned cvt4_fp8(float a, float b, float c, float d) {
    int w = __builtin_amdgcn_cvt_pk_fp8_f32(clamp8(a), clamp8(b), 0, false); w = __builtin_amdgcn_cvt_pk_fp8_f32(clamp8(c), clamp8(d), w, true); return (unsigned)w; }
constexpr float W8_SCALE = 64.f, W8_DESCALE = 1.f / 64.f;

struct EpiSwiglu {
    static constexpr bool PERM = true, AFTER_DRAIN = false;
    unsigned char* H; int npn;
    __device__ __forceinline__ void operator()(const f32x4 (&acc)[2][2][4][2], const Unit& u, int wr, int wc, int fr, int fq) const {
        const int row0 = u.pm * BM + wr * 64 + fr, pnl = u.pn % npn, col0 = pnl * HALF + wc * 32 + 8 * fq;
#pragma unroll
        for (int ai = 0; ai < 2; ++ai)
#pragma unroll
            for (int m = 0; m < 4; ++m) {
                unsigned char* rowp = H + (size_t)(row0 + ai * HALF + m * 16) * 2048 + col0;
                float h[8];
#pragma unroll
                for (int n = 0; n < 2; ++n)
#pragma unroll
                    for (int i = 0; i < 4; ++i) { const float g = acc[ai][0][m][n][i] * W8_DESCALE, up = acc[ai][1][m][n][i] * W8_DESCALE; h[n * 4 + i] = g * up * __builtin_amdgcn_rcpf(1.f + __expf(-g)); }
                u32x2 w; w.x = cvt4_fp8(h[0], h[1], h[2], h[3]); w.y = cvt4_fp8(h[4], h[5], h[6], h[7]);
                *(u32x2*)rowp = w;
            }
    }
};

struct EpiDown {
    static constexpr bool PERM = true, AFTER_DRAIN = false;
    bf16_t* Y; const float* gate; int npn;
    __device__ __forceinline__ void operator()(const f32x4 (&acc)[2][2][4][2], const Unit& u, int wr, int wc, int fr, int fq) const {
        const int row0 = u.pm * BM + wr * 64 + fr, pnl = u.pn % npn, col0 = pnl * BM + wc * 32 + 8 * fq;
#pragma unroll
        for (int ai = 0; ai < 2; ++ai)
#pragma unroll
            for (int m = 0; m < 4; ++m) {
                const int row = row0 + ai * HALF + m * 16; const float gt = gate[row] * W8_DESCALE;
                bf16_t* rowp = Y + (size_t)row * 2048 + col0;
#pragma unroll
                for (int bj = 0; bj < 2; ++bj) { const f32x4 v0 = acc[ai][bj][m][0] * gt, v1 = acc[ai][bj][m][1] * gt;
                    u32x4 w; w.x = cvt_pk_bf16(v0[0], v0[1]); w.y = cvt_pk_bf16(v0[2], v0[3]); w.z = cvt_pk_bf16(v1[0], v1[1]); w.w = cvt_pk_bf16(v1[2], v1[3]);
                    *(u32x4*)(rowp + bj * HALF) = w; }
            }
    }
};

template <class Epi, class Sched, bool ALIGN_EPI = false, bool SP2 = false, bool FP8 = false>
__device__ __forceinline__ void gemm_phase(PG8_LAS unsigned char* lds, const Gemm g, const Sched& S, const Epi& E) {
    const int tid = threadIdx.x, wid = __builtin_amdgcn_readfirstlane(tid >> 6), lane = tid & 63, wr = wid >> 2, wc = wid & 3, fr = lane & 15, fq = lane >> 4;
    const int K = g.Kp, nt = g.K / BK;
    const size_t kslice = (size_t)g.K * 2;
    unsigned voffA[2], voffB[2];
#pragma unroll
    for (int i = 0; i < 2; ++i) { int R, C; stage_rc(tid * 16 + i * 8192, R, C); const int Rb = Epi::PERM ? ((R & ~31) + perm32(R & 31)) : R;
        voffA[i] = (unsigned)(R * K + C) * 2u; voffB[i] = (unsigned)(Rb * K + C) * 2u; }
    static_assert(!Sched::GATHER || SP2, "gathered A rows: SP2 loop only");
    const size_t kstep = (size_t)(BK * 2);
    const size_t hstep = (size_t)HALF * K * 2;
    const size_t tstep = 2 * hstep;
    const unsigned ldsw = (unsigned)wid * 1024u;
    const int aoff = lds_byte(wr * 64 + fr, fq * 8), boff = lds_byte(wc * 32 + fr, fq * 8);
#define PG8_SA(b, h) (((b) * 2 + (h)) * HTB)
#define PG8_SB(b, h) ((4 + (b) * 2 + (h)) * HTB)
#define PG8_STAGE(bufoff, gbase, voff) do { _Pragma("unroll") for (int _i = 0; _i < 2; ++_i) \
        __builtin_amdgcn_global_load_lds((const unsigned*)((const char*)(gbase) + (voff)[_i]), (PG8_LAS unsigned*)(lds + (bufoff) + ldsw + _i * 8192), 16, 0, 0); } while (0)
#define PG8_LDA(dst, b, h) do { _Pragma("unroll") for (int m = 0; m < 4; ++m) _Pragma("unroll") for (int k = 0; k < 2; ++k) dst[m][k] = *(const PG8_LAS bf16x8*)(lds + PG8_SA(b, h) + aoff + m * 2048 + k * 1024); } while (0)
#define PG8_LDB(dst, b, h) do { _Pragma("unroll") for (int n = 0; n < 2; ++n) _Pragma("unroll") for (int k = 0; k < 2; ++k) dst[n][k] = *(const PG8_LAS bf16x8*)(lds + PG8_SB(b, h) + boff + n * 2048 + k * 1024); } while (0)
#define PG8_CAT8(x, y) __builtin_shufflevector(__builtin_bit_cast(i32x4, x), __builtin_bit_cast(i32x4, y), 0, 1, 2, 3, 4, 5, 6, 7)
#define PG8_W8(c) __builtin_shufflevector(c, c, 0, 1, 2, 3, -1, -1, -1, -1)
#define PG8_MMA(ai, bj, At, Bt) do { __builtin_amdgcn_s_setprio(1); \
        if constexpr (FP8) { f32x32 a_ = acc32[ai][bj]; _Pragma("unroll") for (int m = 0; m < 4; ++m) _Pragma("unroll") for (int n = 0; n < 2; ++n) { \
            f32x4 c_ = {a_[(m * 2 + n) * 4], a_[(m * 2 + n) * 4 + 1], a_[(m * 2 + n) * 4 + 2], a_[(m * 2 + n) * 4 + 3]}; \
            c_ = __builtin_amdgcn_mfma_scale_f32_16x16x128_f8f6f4(PG8_CAT8(Bt[n][0], Bt[n][1]), PG8_CAT8(At[m][0], At[m][1]), c_, 0, 0, 0, 0, 0, 0); \
            a_[(m * 2 + n) * 4] = c_[0]; a_[(m * 2 + n) * 4 + 1] = c_[1]; a_[(m * 2 + n) * 4 + 2] = c_[2]; a_[(m * 2 + n) * 4 + 3] = c_[3]; } acc32[ai][bj] = a_; } \
        else { _Pragma("unroll") for (int m = 0; m < 4; ++m) _Pragma("unroll") for (int n = 0; n < 2; ++n) _Pragma("unroll") for (int k = 0; k < 2; ++k) \
            acc[ai][bj][m][n] = __builtin_amdgcn_mfma_f32_16x16x32_bf16(Bt[n][k], At[m][k], acc[ai][bj][m][n], 0, 0, 0); } __builtin_amdgcn_s_setprio(0); } while (0)
#define PG8_WAIT_V(n) asm volatile("s_waitcnt vmcnt(" #n ")" ::: "memory")
#define PG8_WAIT_L(n) asm volatile("s_waitcnt lgkmcnt(" #n ")" ::: "memory")
#define PG8_BAR __builtin_amdgcn_s_barrier()
#define PG8_SCHED __builtin_amdgcn_sched_barrier(0)
    Unit cur, nxt; int ui = 0;
    if (!S.next(0, cur)) return;
    f32x4 acc[2][2][4][2]; f32x32 acc32[2][2];
#pragma unroll
    for (int a = 0; a < 2; ++a)
#pragma unroll
        for (int b = 0; b < 2; ++b)
#pragma unroll
            for (int m = 0; m < 4; ++m) {
#pragma unroll
                for (int n = 0; n < 2; ++n) { acc[a][b][m][n] = (f32x4){0.f, 0.f, 0.f, 0.f};
#pragma unroll
                    for (int i = 0; i < 4; ++i) acc32[a][b][(m * 2 + n) * 4 + i] = 0.f; } }
    bf16x8 At[4][2], B0[2][2], B1[2][2];
    const char* cA = (const char*)g.A + (size_t)cur.pm * tstep + (size_t)cur.pk * kslice; const char* cB = (const char*)g.Bt + (size_t)cur.pn * tstep + (size_t)cur.pk * kslice;
    unsigned cvA0[2], cvA1[2], nvA0[2], nvA1[2];
#pragma unroll
    for (int i = 0; i < 2; ++i) { int R, C; stage_rc(tid * 16 + i * 8192, R, C);
        if constexpr (Sched::GATHER) { cvA0[i] = (unsigned)(S.arow(cur, R) * K + C) * 2u; cvA1[i] = (unsigned)(S.arow(cur, HALF + R) * K + C) * 2u; }
        else { cvA0[i] = voffA[i]; cvA1[i] = voffA[i] + (unsigned)hstep; }
        nvA0[i] = cvA0[i]; nvA1[i] = cvA1[i]; }
    if constexpr (Sched::GATHER) cA = (const char*)g.A;
    S.a_ready(cur);
    if constexpr (SP2) {
        PG8_STAGE(PG8_SB(0, 0), cB, voffB); PG8_STAGE(PG8_SB(0, 1), cB + hstep, voffB); PG8_STAGE(PG8_SA(0, 0), cA, cvA0); PG8_STAGE(PG8_SA(0, 1), cA, cvA1);
        if (wr == 1) PG8_BAR;
        PG8_WAIT_V(2); PG8_BAR;
        PG8_STAGE(PG8_SB(1, 0), cB + kstep, voffB); PG8_STAGE(PG8_SA(1, 0), cA + kstep, cvA0); PG8_STAGE(PG8_SB(1, 1), cB + hstep + kstep, voffB);
        PG8_WAIT_V(6); PG8_BAR;
    } else {
        PG8_STAGE(PG8_SB(0, 0), cB, voffB); PG8_STAGE(PG8_SA(0, 0), cA, voffA); PG8_STAGE(PG8_SB(0, 1), cB + hstep, voffB); PG8_STAGE(PG8_SA(0, 1), cA + hstep, voffA);
        if (wr == 1) PG8_BAR;
        PG8_WAIT_V(4); PG8_BAR;
        PG8_STAGE(PG8_SB(1, 0), cB + kstep, voffB); PG8_STAGE(PG8_SA(1, 0), cA + kstep, voffA); PG8_STAGE(PG8_SB(1, 1), cB + hstep + kstep, voffB);
        PG8_WAIT_V(6); PG8_BAR;
    }
    for (;;) {
        const bool has_next = S.next(ui + 1, nxt);
        const char* nA = Sched::GATHER ? (const char*)g.A : (has_next ? (const char*)g.A + (size_t)nxt.pm * tstep + (size_t)nxt.pk * kslice : cA);
        if constexpr (Sched::GATHER) { if (has_next) {
#pragma unroll
            for (int i = 0; i < 2; ++i) { int R, C; stage_rc(tid * 16 + i * 8192, R, C); nvA0[i] = (unsigned)(S.arow(nxt, R) * K + C) * 2u; nvA1[i] = (unsigned)(S.arow(nxt, HALF + R) * K + C) * 2u; } } } const char* nB = has_next ? (const char*)g.Bt + (size_t)nxt.pn * tstep + (size_t)nxt.pk * kslice : cB;
        for (int t = 0; t < nt; t += 2) {
            const bool last = (t == nt - 2);
            const char* a1 = cA + (size_t)(t + 1) * kstep;
            const char* a2 = last ? nA : cA + (size_t)(t + 2) * kstep; const char* b2 = last ? nB : cB + (size_t)(t + 2) * kstep;
            const char* a3 = a2 + kstep; const char* b3 = b2 + kstep;
            if (last && has_next) S.a_ready(nxt);
            unsigned sA0[2], sA1[2];
#pragma unroll
            for (int i = 0; i < 2; ++i) { sA0[i] = last ? nvA0[i] : cvA0[i]; sA1[i] = last ? nvA1[i] : cvA1[i]; }
            if constexpr (SP2) {
            PG8_LDB(B0, 0, 0); PG8_LDB(B1, 0, 1); PG8_SCHED; PG8_LDA(At, 0, 0); PG8_STAGE(PG8_SA(1, 1), a1, cvA1);
            PG8_WAIT_V(8); PG8_WAIT_L(0); PG8_BAR; PG8_MMA(0, 0, At, B0); PG8_MMA(0, 1, At, B1); PG8_BAR; PG8_SCHED;
            PG8_LDA(At, 0, 1); PG8_STAGE(PG8_SB(0, 0), b2, voffB); PG8_STAGE(PG8_SB(0, 1), b2 + hstep, voffB); PG8_STAGE(PG8_SA(0, 0), a2, sA0);
            PG8_WAIT_V(8); PG8_WAIT_L(0); PG8_BAR; PG8_MMA(1, 0, At, B0); PG8_MMA(1, 1, At, B1); PG8_BAR; PG8_SCHED;
            PG8_LDB(B0, 1, 0); PG8_LDB(B1, 1, 1); PG8_SCHED; PG8_LDA(At, 1, 0); PG8_STAGE(PG8_SA(0, 1), a2, sA1);
            PG8_WAIT_V(8); PG8_WAIT_L(0); PG8_BAR; PG8_MMA(0, 0, At, B0); PG8_MMA(0, 1, At, B1); PG8_BAR; PG8_SCHED;
            PG8_LDA(At, 1, 1); PG8_STAGE(PG8_SB(1, 0), b3, voffB); PG8_STAGE(PG8_SB(1, 1), b3 + hstep, voffB); PG8_STAGE(PG8_SA(1, 0), a3, sA0);
            PG8_WAIT_V(8); PG8_WAIT_L(0); PG8_BAR; PG8_MMA(1, 0, At, B0); PG8_MMA(1, 1, At, B1); PG8_BAR; PG8_SCHED;
            } else {
            PG8_LDB(B0, 0, 0); PG8_SCHED; PG8_LDA(At, 0, 0); PG8_STAGE(PG8_SA(1, 1), a1 + hstep, voffA);
            PG8_WAIT_L(8); PG8_BAR; PG8_WAIT_L(0); PG8_MMA(0, 0, At, B0); PG8_BAR; PG8_SCHED;
            PG8_LDB(B1, 0, 1); PG8_STAGE(PG8_SB(0, 0), b2, voffB);
            PG8_BAR; PG8_WAIT_L(0); PG8_MMA(0, 1, At, B1); PG8_BAR;
            PG8_LDA(At, 0, 1); PG8_STAGE(PG8_SA(0, 0), a2, voffA);
            PG8_BAR; PG8_WAIT_L(0); PG8_MMA(1, 0, At, B0); PG8_BAR; PG8_SCHED;
            PG8_STAGE(PG8_SB(0, 1), b2 + hstep, voffB);
            PG8_WAIT_V(6); PG8_BAR; PG8_MMA(1, 1, At, B1); PG8_BAR;
            PG8_LDB(B0, 1, 0); PG8_SCHED; PG8_LDA(At, 1, 0); PG8_STAGE(PG8_SA(0, 1), a2 + hstep, voffA);
            PG8_WAIT_L(8); PG8_BAR; PG8_WAIT_L(0); PG8_MMA(0, 0, At, B0); PG8_BAR; PG8_SCHED;
            PG8_LDB(B1, 1, 1); PG8_STAGE(PG8_SB(1, 0), b3, voffB);
            PG8_BAR; PG8_WAIT_L(0); PG8_MMA(0, 1, At, B1); PG8_BAR;
            PG8_LDA(At, 1, 1); PG8_STAGE(PG8_SA(1, 0), a3, voffA);
            PG8_BAR; PG8_WAIT_L(0); PG8_MMA(1, 0, At, B0); PG8_BAR; PG8_SCHED;
            PG8_STAGE(PG8_SB(1, 1), b3 + hstep, voffB);
            PG8_WAIT_V(6); PG8_BAR; PG8_MMA(1, 1, At, B1); PG8_BAR;
            }
        }
        if constexpr (ALIGN_EPI) { if (wr == 0) PG8_BAR; }
        if constexpr (FP8) {
#pragma unroll
            for (int a = 0; a < 2; ++a)
#pragma unroll
                for (int b = 0; b < 2; ++b)
#pragma unroll
                    for (int m = 0; m < 4; ++m)
#pragma unroll
                        for (int n = 0; n < 2; ++n)
#pragma unroll
                            for (int i = 0; i < 4; ++i) acc[a][b][m][n][i] = acc32[a][b][(m * 2 + n) * 4 + i]; }
        if constexpr (!Epi::AFTER_DRAIN) { E(acc, cur, wr, wc, fr, fq); S.done(cur); }
        if (!has_next) break;
#pragma unroll
        for (int a = 0; a < 2; ++a)
#pragma unroll
            for (int b = 0; b < 2; ++b)
#pragma unroll
                for (int m = 0; m < 4; ++m) {
#pragma unroll
                    for (int n = 0; n < 2; ++n) { acc[a][b][m][n] = (f32x4){0.f, 0.f, 0.f, 0.f};
#pragma unroll
                        for (int i = 0; i < 4; ++i) acc32[a][b][(m * 2 + n) * 4 + i] = 0.f; } }
        cur = nxt; cA = nA; cB = nB; ++ui;
#pragma unroll
        for (int i = 0; i < 2; ++i) { cvA0[i] = nvA0[i]; cvA1[i] = nvA1[i]; }
        if constexpr (ALIGN_EPI) { if (wr == 1) PG8_BAR; }
    }
    PG8_WAIT_V(0);
    if constexpr (!ALIGN_EPI) { if (wr == 0) PG8_BAR; }
    PG8_BAR;
    if constexpr (Epi::AFTER_DRAIN) { E.fused(acc, cur, wr, wc, fr, fq, lds, wid, lane); S.done(cur); }
#undef PG8_SA
#undef PG8_SB
#undef PG8_STAGE
#undef PG8_LDA
#undef PG8_LDB
#undef PG8_MMA
#undef PG8_CAT8
#undef PG8_W8
#undef PG8_WAIT_V
#undef PG8_WAIT_L
#undef PG8_BAR
#undef PG8_SCHED
}
}

namespace att {
constexpr int NW = 8, QBLK = 32, KVBLK = 64;
constexpr float THR = 8.f;
constexpr int SHM_V = KVBLK * 128 * 2, SHM_K = KVBLK * 64 * 2;
constexpr int SHM_ATTN = 2 * SHM_V + 2 * SHM_K + NW * 64 * 4;
#define KSWZ64(row, colB) ((row) * 128 + ((colB) ^ ((((row) >> 1) & 7) << 4)))
#define SBAR() __builtin_amdgcn_sched_barrier(0)
__device__ __forceinline__ int crow(int r, int hi) { return (r & 3) + 8 * (r >> 2) + 4 * hi; }

__device__ __forceinline__ void partialSM(f32x16& p0, f32x16& p1, float& m_reg, float& mn, float& alpha) {
  float pmax = p0[0];
#pragma unroll
  for (int r = 1; r < 16; ++r) pmax = fmaxf(pmax, p0[r]);
#pragma unroll
  for (int r = 0; r < 16; ++r) pmax = fmaxf(pmax, p1[r]);
  { auto rr = __builtin_amdgcn_permlane32_swap(__float_as_uint(pmax), __float_as_uint(pmax), false, false);
    pmax = fmaxf(__uint_as_float(rr[0]), __uint_as_float(rr[1])); }
  if (__builtin_expect(__all(pmax - m_reg <= THR), 1)) { mn = m_reg; alpha = 1.f; }
  else { mn = fmaxf(m_reg, pmax); alpha = __builtin_amdgcn_exp2f(m_reg - mn); m_reg = mn; }
#pragma unroll
  for (int r = 0; r < 16; ++r) p0[r] = p0[r] - mn;
#pragma unroll
  for (int r = 0; r < 16; ++r) p1[r] = p1[r] - mn;
#pragma unroll
  for (int r = 0; r < 16; ++r) p0[r] = __builtin_amdgcn_exp2f(p0[r]);
}
__device__ __forceinline__ void finishSM(f32x16& p0, f32x16& p1, float alpha, float& l_reg, bf16x8& pa0, bf16x8& pa1, bf16x8& pa2, bf16x8& pa3) {
#pragma unroll
  for (int r = 0; r < 16; ++r) p1[r] = __builtin_amdgcn_exp2f(p1[r]);
  float ps = 0;
#pragma unroll
  for (int r = 0; r < 16; ++r) ps += p0[r];
#pragma unroll
  for (int r = 0; r < 16; ++r) ps += p1[r];
  { auto rr = __builtin_amdgcn_permlane32_swap(__float_as_uint(ps), __float_as_uint(ps), false, false);
    ps = __uint_as_float(rr[0]) + __uint_as_float(rr[1]); }
  l_reg = l_reg * alpha + ps;
#define PK4(P, BASE, OUT) do { unsigned a0 = cvtpk(P[BASE + 0], P[BASE + 1]), a1 = cvtpk(P[BASE + 2], P[BASE + 3]);   \
    unsigned b0 = cvtpk(P[BASE + 4], P[BASE + 5]), b1 = cvtpk(P[BASE + 6], P[BASE + 7]);                              \
    auto r0 = __builtin_amdgcn_permlane32_swap(a0, b0, false, false); auto r1 = __builtin_amdgcn_permlane32_swap(a1, b1, false, false); \
    u32x4 w = {r0[0], r1[0], r0[1], r1[1]}; OUT = __builtin_bit_cast(bf16x8, w); } while (0)
  PK4(p0, 0, pa0); PK4(p0, 8, pa1); PK4(p1, 0, pa2); PK4(p1, 8, pa3);
#undef PK4
}
__device__ __forceinline__ void qkt(f32x16& p0, f32x16& p1, const char* Ks, const bf16x8* qr, int r32, int hi) {
  p0 = f32x16{}; p1 = f32x16{};
#pragma unroll
  for (int d0 = 0; d0 < 4; ++d0) { const int cb = (d0 * 16 + hi * 8) * 2;
    bf16x8 b0 = *reinterpret_cast<const bf16x8*>(Ks + KSWZ64(r32, cb));
    bf16x8 b1 = *reinterpret_cast<const bf16x8*>(Ks + KSWZ64(32 + r32, cb));
    p0 = __builtin_amdgcn_mfma_f32_32x32x16_bf16(b0, qr[d0], p0, 0, 0, 0);
    p1 = __builtin_amdgcn_mfma_f32_32x32x16_bf16(b1, qr[d0], p1, 0, 0, 0); }
}
__device__ __forceinline__ int v_st(int k, int c) { const int kk = (k & ~0xC) | ((k & 4) << 1) | ((k & 8) >> 1); return ((kk >> 3) * 4 + (c >> 5)) * 512 + ((kk & 7) * 32 + (c & 31)) * 2; }
__device__ __forceinline__ int v_rd_base(int lane) { return ((lane & 3) << 3) | (((lane >> 2) & 3) << 6) | (((lane >> 4) & 1) << 5) | (((lane >> 5) & 1) << 8); }
constexpr int v_rd_off(int d0, int ks, int half) { return d0 * 512 + ks * 4096 + half * 2048; }
template <int OFF> __device__ __forceinline__ s16x4 tr_read(int vb) {
  s16x4 r; asm volatile("ds_read_b64_tr_b16 %0, %1 offset:%2" : "=&v"(r) : "v"(vb), "i"(OFF) : "memory"); return r;
}
template <int D0> __device__ __forceinline__ void pv_one(f32x16& od, int vb, bf16x8 pa0, bf16x8 pa1, bf16x8 pa2, bf16x8 pa3) {
  const s16x4 l0 = tr_read<v_rd_off(D0, 0, 0)>(vb), h0 = tr_read<v_rd_off(D0, 0, 1)>(vb), l1 = tr_read<v_rd_off(D0, 1, 0)>(vb), h1 = tr_read<v_rd_off(D0, 1, 1)>(vb);
  const s16x4 l2 = tr_read<v_rd_off(D0, 2, 0)>(vb), h2 = tr_read<v_rd_off(D0, 2, 1)>(vb), l3 = tr_read<v_rd_off(D0, 3, 0)>(vb), h3 = tr_read<v_rd_off(D0, 3, 1)>(vb);
  asm volatile("s_waitcnt lgkmcnt(0)" ::: "memory"); SBAR();
#define PK(L, H) (bf16x8){L[0], L[1], L[2], L[3], H[0], H[1], H[2], H[3]}
  od = __builtin_amdgcn_mfma_f32_32x32x16_bf16(pa0, PK(l0, h0), od, 0, 0, 0);
  od = __builtin_amdgcn_mfma_f32_32x32x16_bf16(pa1, PK(l1, h1), od, 0, 0, 0);
  od = __builtin_amdgcn_mfma_f32_32x32x16_bf16(pa2, PK(l2, h2), od, 0, 0, 0);
  od = __builtin_amdgcn_mfma_f32_32x32x16_bf16(pa3, PK(l3, h3), od, 0, 0, 0);
#undef PK
}
__device__ __forceinline__ void pv_d0(f32x16* o, int vb, bf16x8 pa0, bf16x8 pa1, bf16x8 pa2, bf16x8 pa3) {
  pv_one<0>(o[0], vb, pa0, pa1, pa2, pa3); pv_one<1>(o[1], vb, pa0, pa1, pa2, pa3); pv_one<2>(o[2], vb, pa0, pa1, pa2, pa3); pv_one<3>(o[3], vb, pa0, pa1, pa2, pa3);
}

template <int LDQ>
__device__ __forceinline__ void attn_unit(const bf16_t* __restrict__ Qb, const bf16_t* __restrict__ Kh, const bf16_t* __restrict__ Vh, bf16_t* __restrict__ Ob, int seq, char* lds) {
  const int tid = threadIdx.x, wid = tid >> 6, lane = tid & 63, r32 = lane & 31, hi = lane >> 5;
  char* V_lds = lds; char* K_lds = lds + 2 * SHM_V;
  float* ws = (float*)(lds + 2 * SHM_V + 2 * SHM_K) + wid * 64; float* li_l = ws; float* al_l = ws + 32;
  float m_reg = -1e30f, l_reg = 0; f32x16 o[4] = {}; bf16x8 qr[4];
  const bf16_t* Qw = Qb + (long)(wid * QBLK + r32) * LDQ + hi * 8;
#pragma unroll
  for (int d0 = 0; d0 < 4; ++d0) qr[d0] = *reinterpret_cast<const bf16x8*>(Qw + d0 * 16);
  const int sr = tid >> 4, sc = (tid & 15) * 8, vst0 = v_st(sr, sc), vst1 = v_st(32 + sr, sc);
  const int kr = tid >> 3, kc8 = (tid & 7) * 8, kst = KSWZ64(kr, kc8 * 2);
  const int vb0 = (int)(uintptr_t)V_lds + v_rd_base(lane);
  struct { bf16x8 vs0, vs1, ks; } sr_[2];
  const bf16_t* Vp0 = Vh + (long)sr * LDQ + sc; const bf16_t* Kp0 = Kh + (long)kr * LDQ + kc8;
#define SLOAD(i, k0) do { const long ko_ = (long)(k0) * LDQ; sr_[i].vs0 = *reinterpret_cast<const bf16x8*>(Vp0 + ko_); sr_[i].vs1 = *reinterpret_cast<const bf16x8*>(Vp0 + ko_ + 32 * LDQ); \
    sr_[i].ks = *reinterpret_cast<const bf16x8*>(Kp0 + ko_); } while (0)
#define SWRITE(b, i) do { *(bf16x8*)(V_lds + (b) * SHM_V + vst0) = sr_[i].vs0; *(bf16x8*)(V_lds + (b) * SHM_V + vst1) = sr_[i].vs1; \
    *(bf16x8*)(K_lds + (b) * SHM_K + kst) = sr_[i].ks; } while (0)
#define SWAIT() asm volatile("s_waitcnt vmcnt(3)" ::: "memory")
#define RESC(a) do { if (__any((a) < 1.f)) { if (hi == 0) al_l[r32] = (a); asm volatile("s_waitcnt lgkmcnt(0)" ::: "memory"); \
    _Pragma("unroll") for (int d = 0; d < 4; ++d) _Pragma("unroll") for (int r = 0; r < 16; ++r) o[d][r] *= al_l[crow(r, hi)]; } } while (0)
  f32x16 pA0, pA1, pB0, pB1; float mnA, mnB, alA, alB; bf16x8 pa0, pa1, pa2, pa3; const int NT = seq / KVBLK;
  constexpr int SE = 0, SO = 1;
  SLOAD(SE, 0); asm volatile("s_waitcnt vmcnt(0)" ::: "memory"); SWRITE(0, SE); __syncthreads();
  qkt(pA0, pA1, K_lds, qr, r32, hi); partialSM(pA0, pA1, m_reg, mnA, alA);
  SLOAD(SO, KVBLK); if (2 < NT) SLOAD(SE, 2 * KVBLK);
  SWAIT(); SWRITE(1, SO); __syncthreads();
  for (int j = 1; j + 1 < NT; j += 2) {
    SBAR(); qkt(pB0, pB1, K_lds + SHM_K, qr, r32, hi);
    finishSM(pA0, pA1, alA, l_reg, pa0, pa1, pa2, pa3); SBAR();
    SLOAD(SO, (j + 2) * KVBLK); SBAR();
    pv_d0(o, vb0, pa0, pa1, pa2, pa3); partialSM(pB0, pB1, m_reg, mnB, alB);
    __syncthreads(); SWAIT(); SWRITE(0, SE);
    RESC(alB); __syncthreads();
    SBAR(); qkt(pA0, pA1, K_lds, qr, r32, hi);
    finishSM(pB0, pB1, alB, l_reg, pa0, pa1, pa2, pa3); SBAR();
    if (j + 3 < NT) SLOAD(SE, (j + 3) * KVBLK); SBAR();
    pv_d0(o, vb0 + SHM_V, pa0, pa1, pa2, pa3); partialSM(pA0, pA1, m_reg, mnA, alA);
    __syncthreads(); SWAIT(); SWRITE(1, SO);
    RESC(alA); __syncthreads();
  }
  SBAR(); qkt(pB0, pB1, K_lds + SHM_K, qr, r32, hi);
  finishSM(pA0, pA1, alA, l_reg, pa0, pa1, pa2, pa3); SBAR();
  pv_d0(o, vb0, pa0, pa1, pa2, pa3); partialSM(pB0, pB1, m_reg, mnB, alB);
  __syncthreads(); RESC(alB);
  finishSM(pB0, pB1, alB, l_reg, pa0, pa1, pa2, pa3); SBAR();
  pv_d0(o, vb0 + SHM_V, pa0, pa1, pa2, pa3);
  if (hi == 0) li_l[r32] = l_reg; asm volatile("s_waitcnt lgkmcnt(0)" ::: "memory");
  float rli[16];
#pragma unroll
  for (int r = 0; r < 16; ++r) rli[r] = __builtin_amdgcn_rcpf(li_l[crow(r, hi)]);
  bf16_t* Ow = Ob + (long)(wid * QBLK) * 1024;
#pragma unroll
  for (int r = 0; r < 16; ++r) { const int orow = crow(r, hi);
#pragma unroll
    for (int d0 = 0; d0 < 4; ++d0) Ow[(long)orow * 1024 + d0 * 32 + r32] = (bf16_t)(cvtpk(o[d0][r] * rli[r], 0.f) & 0xffffu); }
  __syncthreads();
#undef SLOAD
#undef SWRITE
#undef SWAIT
#undef RESC
}
#undef SBAR
}


typedef GAS unsigned gu32;
#define RLX_AGENT __ATOMIC_RELAXED, __HIP_MEMORY_SCOPE_AGENT
#define XB_TMO      128
#define XB_XCNT(j)  (256  + 64 * (j))
#define XB_XSUB(j)  (1280 + 64 * (j))
#define XB_XGEN(j)  (2304 + 64 * (j))
#define XB_TOP      3328
#define XB_TOPGEN   3392
#define XCD_BAR_WORDS 3456
#define XB_SPIN_CAP (1u << 22)
__device__ __forceinline__ unsigned xb_ld(unsigned* p)              { return __hip_atomic_load(p, __ATOMIC_RELAXED, __HIP_MEMORY_SCOPE_AGENT); }
__device__ __forceinline__ unsigned xb_add(unsigned* p, unsigned v) { return __hip_atomic_fetch_add(p, v, __ATOMIC_RELAXED, __HIP_MEMORY_SCOPE_AGENT); }
__device__ __forceinline__ unsigned xb_xcc_id() { return (unsigned)__builtin_amdgcn_s_getreg((3 << 11) | 20) & 0xFu; }
#define XB_SPIN(cond, bar) do { unsigned _sp = 0; while (cond) { __builtin_amdgcn_s_sleep(1); \
    if ((++_sp & 255u) == 0u) { if (xb_ld(&(bar)[XB_TMO])) break; if (_sp > XB_SPIN_CAP) { atomicAdd(&(bar)[XB_TMO], 1u); break; } } } } while (0)
struct XcdBarrier { unsigned* bar; unsigned x; volatile LAS unsigned* st; };
__device__ __forceinline__ XcdBarrier xcd_barrier_post(unsigned* bar, volatile LAS unsigned* st) {
    XcdBarrier b; b.bar = bar; b.x = xb_xcc_id(); b.st = st;
    if (threadIdx.x == 0) (void)xb_add(&bar[XB_XCNT(b.x)], 1u);
    return b;
}
__device__ __forceinline__ void xcd_barrier_complete(unsigned* bar, unsigned x, unsigned& nloc, unsigned& nx) {
    const unsigned G = gridDim.x * gridDim.y * gridDim.z;
    unsigned sum, cnt, mine, sp = 0u;
    for (;;) {
        sum = 0u; cnt = 0u; mine = 0u;
#pragma unroll
        for (unsigned j = 0; j < 16; ++j) { const unsigned c = xb_ld(&bar[XB_XCNT(j)]); sum += c; cnt += (c > 0u) ? 1u : 0u; mine = (j == x) ? c : mine; }
        if (sum == G) break;
        __builtin_amdgcn_s_sleep(1);
        if ((++sp & 255u) == 0u) { if (xb_ld(&bar[XB_TMO])) break; if (sp > XB_SPIN_CAP) { atomicAdd(&bar[XB_TMO], 1u); break; } }
    }
    nloc = mine > 0u ? mine : 1u; nx = cnt > 0u ? cnt : 1u;
}
__device__ __forceinline__ void xcd_barrier(const XcdBarrier& b) {
    asm volatile("s_waitcnt vmcnt(0)" ::: "memory");
    __syncthreads();
    if (threadIdx.x == 0) {
        unsigned* bar = b.bar;
        __builtin_amdgcn_s_waitcnt(0);
        unsigned nloc = b.st[0], nx = b.st[1];
        if (nloc == 0u) { xcd_barrier_complete(bar, b.x, nloc, nx); b.st[0] = nloc; b.st[1] = nx; }
        const unsigned old = xb_add(&bar[XB_XSUB(b.x)], 1u);
        const unsigned gen = old / nloc;
        if (old + 1u == (gen + 1u) * nloc) {
            __builtin_amdgcn_fence(__ATOMIC_RELEASE, "agent");
            asm volatile("s_waitcnt vmcnt(0)" ::: "memory");
            const unsigned og = xb_add(&bar[XB_TOP], 1u);
            const unsigned tg = og / nx;
            if (og + 1u == (tg + 1u) * nx) xb_add(&bar[XB_TOPGEN], 1u);
            else XB_SPIN(xb_ld(&bar[XB_TOPGEN]) == tg, bar);
            __builtin_amdgcn_fence(__ATOMIC_ACQUIRE, "agent");
            xb_add(&bar[XB_XGEN(b.x)], 1u);
            asm volatile("s_waitcnt vmcnt(0)" ::: "memory");
        } else {
            XB_SPIN(xb_ld(&bar[XB_XGEN(b.x)]) == gen, bar);
            __builtin_amdgcn_fence(__ATOMIC_ACQUIRE, "agent");
            asm volatile("s_waitcnt vmcnt(0)" ::: "memory");
        }
    }
    __syncthreads();
}

struct Frame {
    LAS unsigned char* lds; char* ldsg;
    int tid, lane, wave, vcu, G;
    const Args* a;
};
#define INP(F, i, T) ((const T*)(F).a->in[i])
#define WSP(F, off, T) ((T*)((F).a->ws + (off)))

__device__ __forceinline__ void cvt_load(f32x4 (&v)[16], const float* __restrict__ W, int N, int nvalid, int k0, int n0, int lane) {
    const int kq = lane >> 4, nq = lane & 15;
    const unsigned voff = (unsigned)(kq * N + 4 * nq) * 4u;
#pragma unroll
    for (int i = 0; i < 16; ++i) {
        const char* Wu = (const char*)(W + (size_t)(k0 + 4 * i) * N + n0);
        if (4 * nq < nvalid) v[i] = __builtin_nontemporal_load((const f32x4*)(Wu + (size_t)voff)); else v[i] = (f32x4){0.f, 0.f, 0.f, 0.f};
    }
}
__device__ __forceinline__ void cvt_finish(const f32x4 (&v)[16], int k0, bf16_t* __restrict__ WT, int rowb, LAS unsigned char* scr, int lane) {
    const int kq = lane >> 4, nq = lane & 15;
    const int g = lane >> 4, i16 = lane & 15, q = i16 >> 2, p = i16 & 3;
    typedef short v4i16_t __attribute__((ext_vector_type(4)));
#pragma unroll
    for (int hf = 0; hf < 2; ++hf) {
#pragma unroll
        for (int i = 0; i < 8; ++i) {
            const int k = 4 * i + kq, s = ((k >> 1) & 1) | (((k >> 3) & 1) << 1);
            u32x2 w; w.x = cvtpk(v[8 * hf + i].x, v[8 * hf + i].y); w.y = cvtpk(v[8 * hf + i].z, v[8 * hf + i].w);
            *(LAS u32x2*)(scr + k * 128 + ((nq * 8) ^ (s << 5))) = w;
        }
        const int klo = 8 * g + q, s = ((klo >> 1) & 1) | (((klo >> 3) & 1) << 1);
#pragma unroll
        for (int nb = 0; nb < 4; ++nb) {
            const int a_lo = klo * 128 + (((16 * nb + 4 * p) * 2) ^ (s << 5));
            const s16x4 lo = __builtin_bit_cast(s16x4, __builtin_amdgcn_ds_read_tr16_b64_v4i16((LAS v4i16_t*)(scr + a_lo)));
            const s16x4 hi = __builtin_bit_cast(s16x4, __builtin_amdgcn_ds_read_tr16_b64_v4i16((LAS v4i16_t*)(scr + a_lo + 512)));
            bf16x8 o = {lo[0], lo[1], lo[2], lo[3], hi[0], hi[1], hi[2], hi[3]};
            char* Wu = (char*)(WT + (size_t)(rowb + 16 * nb) * 2048 + k0 + 32 * hf);
            __builtin_nontemporal_store(o, (bf16x8*)(Wu + (size_t)(unsigned)((i16 * 2048 + 8 * g) * 2)));
        }
    }
}
__device__ __forceinline__ void cvt8_load(f32x4 (&v)[16], const float* __restrict__ W, int k0, int n0, int lane) {
    const int kq = lane >> 4, nq = lane & 15;
    const unsigned voff = (unsigned)(16 * kq * 2048 + 4 * nq) * 4u;
#pragma unroll
    for (int i = 0; i < 16; ++i) {
        const char* Wu = (const char*)(W + (size_t)(k0 + i) * 2048 + n0);
        v[i] = __builtin_nontemporal_load((const f32x4*)(Wu + (size_t)voff));
    }
}
__device__ __forceinline__ void cvt8_finish(const f32x4 (&v)[16], int k0, unsigned char* __restrict__ W8, int rowb, int lane) {
    const int kq = lane >> 4, nq = lane & 15;
    char* Wu = (char*)(W8 + (size_t)rowb * 2048 + k0);
    const unsigned voff = (unsigned)(4 * nq * 2048 + 16 * kq);
#pragma unroll
    for (int j = 0; j < 4; ++j) {
        u32x4 o;
#pragma unroll
        for (int q = 0; q < 4; ++q) {
            int w = __builtin_amdgcn_cvt_pk_fp8_f32(v[4 * q][j] * pg8::W8_SCALE, v[4 * q + 1][j] * pg8::W8_SCALE, 0, false);
            w = __builtin_amdgcn_cvt_pk_fp8_f32(v[4 * q + 2][j] * pg8::W8_SCALE, v[4 * q + 3][j] * pg8::W8_SCALE, w, true);
            o[q] = (unsigned)w;
        }
        __builtin_nontemporal_store(o, (u32x4*)(Wu + (size_t)(voff + (unsigned)(j * 2048))));
    }
}
__device__ __forceinline__ void cvt_expert_decode(const Frame& F, int r, const float*& W, int& k0, int& n0, unsigned char*& WT, int& rowb) {
    constexpr int I_E = 16 * 32 * 32;
    const int mat = r / I_E; r -= mat * I_E;
    const int e = r >> 10, kt = (r >> 5) & 31, nt = r & 31;
    k0 = kt * 64; n0 = nt * 64;
    if (mat < 2) { W = INP(F, 24 + mat, float) + (size_t)e * 2048 * 2048; WT = WSP(F, WS_WGU, unsigned char); rowb = e * 4096 + (n0 >> 7) * 256 + mat * 128 + (n0 & 127); }
    else { W = INP(F, 26, float) + (size_t)e * 2048 * 2048; WT = WSP(F, WS_WD, unsigned char); rowb = e * 2048 + n0; }
}
constexpr int N_EXPERT_ITEMS = 3 * 16 * 32 * 32;
__device__ __forceinline__ void p0_prologue(Frame& F) {
    LAS unsigned char* scr = F.lds + F.wave * 4096;
    const int gw = F.vcu * 8 + F.wave, NGW = F.G * 8, lane = F.lane;
    const float* w_in = INP(F, 3, float); const float* w_out = INP(F, 21, float);
    bf16_t* WinT = WSP(F, WS_WIN, bf16_t); bf16_t* WoutT = WSP(F, WS_WOUT, bf16_t);
    constexpr int I_IN = 32 * 101, I_OUT = 32 * 32, NITEMS = I_IN + I_OUT;
    for (int it = gw; it < NITEMS; it += NGW) {
        f32x4 v[16];
        if (it < I_IN) { const int kt = it / 101, nt = it % 101; const int nv = (nt == 100) ? 32 : 64; cvt_load(v, w_in, IN_COLS, nv, kt * 64, nt * 64, lane); cvt_finish(v, kt * 64, WinT, nt * 64, scr, lane); }
        else { const int r = it - I_IN, kt = r >> 5, nt = r & 31; cvt_load(v, w_out, 2048, 64, kt * 64, nt * 64, lane); cvt_finish(v, kt * 64, WoutT, nt * 64, scr, lane); }
    }
#if !CVT_IN_SCAN
    for (int it = gw; it < N_EXPERT_ITEMS; it += NGW) {
        f32x4 v[16]; const float* W; int k0, n0, rowb; unsigned char* WT;
        cvt_expert_decode(F, it, W, k0, n0, WT, rowb); cvt8_load(v, W, k0, n0, lane); cvt8_finish(v, k0, WT, rowb, lane);
    }
#endif
    { u32x4 z = {0u, 0u, 0u, 0u}; u32x4* zp = (u32x4*)(WinT + (size_t)6464 * 2048); const int nz = 192 * 2048 * 2 / 16;
      for (int i = gw * 64 + lane; i < nz; i += NGW * 64) zp[i] = z; }
    { const float* x = INP(F, 0, float); const float* nw = INP(F, 2, float); bf16_t* H1 = WSP(F, WS_H1, bf16_t);
      for (int m = gw; m < MTOK; m += NGW) {
          const f32x4* xr = (const f32x4*)(x + (size_t)m * DM) + lane; f32x4 v[8]; float s = 0.f;
#pragma unroll
          for (int j = 0; j < 8; ++j) { v[j] = xr[64 * j]; s += (v[j].x * v[j].x + v[j].y * v[j].y) + (v[j].z * v[j].z + v[j].w * v[j].w); }
          const float rstd = 1.f / sqrtf(wave_sum(s) * (1.f / DM) + 1e-6f);
          u32x2* o8 = (u32x2*)(H1 + (size_t)m * DM) + lane;
#pragma unroll
          for (int j = 0; j < 8; ++j) { const f32x4 w = ((const f32x4*)nw)[lane + 64 * j]; u32x2 o; o.x = cvtpk(v[j].x * rstd * w.x, v[j].y * rstd * w.y); o.y = cvtpk(v[j].z * rstd * w.z, v[j].w * rstd * w.w); o8[64 * j] = o; }
      } }
    { const float* dup = INP(F, 12, float); const float* iup = INP(F, 14, float); const float* gup = INP(F, 15, float);
      bf16_t* DUt = WSP(F, WS_LORA, bf16_t); bf16_t* IUt = DUt + 2 * 1024 * 64; bf16_t* GUt = IUt + 2 * 1024 * 64;
      for (int i = gw * 64 + lane; i < 2 * 1024 * 64; i += NGW * 64) { const int j = i & 63, c = (i >> 6) & 1023, d = i >> 16;
          DUt[i] = (bf16_t)(cvtpk(dup[(size_t)(d * 64 + j) * 1024 + c], 0.f) & 0xffffu); IUt[i] = (bf16_t)(cvtpk(iup[(size_t)(d * 64 + j) * 1024 + c], 0.f) & 0xffffu); }
      for (int i = gw * 64 + lane; i < 1024 * 160; i += NGW * 64) { const int c = i / 160, j = i - c * 160; GUt[i] = (bf16_t)(cvtpk(gup[(size_t)j * 1024 + c], 0.f) & 0xffffu); } }
    { const int* pos = INP(F, 1, int); float* rope = WSP(F, WS_ROPE, float);
      const float invf[8] = {1.0f, 0.19392274474868576f, 0.03760603093086393f, 0.007292664737217109f, 0.001414213562373095f, 0.0002742481756762073f, 5.318295896944988e-05f, 1.031338537721246e-05f};
      for (int i = gw * 64 + lane; i < MTOK * 8; i += NGW * 64) { const int m = i >> 3, j = i & 7; float fj = invf[0];
#pragma unroll
          for (int q = 1; q < 8; ++q) fj = (j == q) ? invf[q] : fj;
          const float ang = (float)pos[m] * fj; rope[m * 16 + j] = cosf(ang); rope[m * 16 + 8 + j] = sinf(ang); } }
}

#define WS32(F, T, byteoff) (*(T*)((F).a->ws + (size_t)(unsigned)(byteoff)))
template <int CTRL> __device__ __forceinline__ float dpp_add(float x) {
    return x + __int_as_float(__builtin_amdgcn_update_dpp(0, __float_as_int(x), CTRL, 0xf, 0xf, false));
}
__device__ __forceinline__ float row16_allsum(float x) { x = dpp_add<0x128>(x); x = dpp_add<0x124>(x); x = dpp_add<0x122>(x); x = dpp_add<0x121>(x); return x; }
__device__ __forceinline__ bf16_t f2bf(float x) { return (bf16_t)(cvtpk(x, 0.f) & 0xffffu); }
__device__ __forceinline__ u32x4 ld_row16(const Frame& F, unsigned off, bool ok) { u32x4 r = {0u, 0u, 0u, 0u}; if (ok) r = WS32(F, const u32x4, off); return r; }
__device__ __forceinline__ void unpack8(const u32x4 w, float (&o)[8]) { o[0] = bf_lo(w.x); o[1] = bf_hi(w.x); o[2] = bf_lo(w.y); o[3] = bf_hi(w.y); o[4] = bf_lo(w.z); o[5] = bf_hi(w.z); o[6] = bf_lo(w.w); o[7] = bf_hi(w.w); }
__device__ __forceinline__ void ld8f(const float* p, float (&o)[8]) { const f32x4 a = ((const f32x4*)p)[0], b = ((const f32x4*)p)[1]; o[0] = a.x; o[1] = a.y; o[2] = a.z; o[3] = a.w; o[4] = b.x; o[5] = b.y; o[6] = b.z; o[7] = b.w; }
__device__ __forceinline__ u32x4 pack8(const float (&v)[8]) { return (u32x4){cvtpk(v[0], v[1]), cvtpk(v[2], v[3]), cvtpk(v[4], v[5]), cvtpk(v[6], v[7])}; }
__device__ __forceinline__ void p3_prep(Frame& F, const int mode = 0) {
    constexpr int AP = 296;
    LAS float* Zl = (LAS float*)F.lds;
    LAS bf16_t* Al = (LAS bf16_t*)(F.lds + 18432);
    constexpr int PP = 520, PA = 16 * PP;
    LAS bf16_t* Pl = (LAS bf16_t*)(F.lds + 18432 + 9472);
    LAS float* Zr = (LAS float*)(F.lds + 18432 + 9472);
    const int tid = F.tid, lane = F.lane, w = F.wave;
    const bf16_t* DUt = WSP(F, WS_LORA, bf16_t); const bf16_t* IUt = DUt + 2 * 1024 * 64; const bf16_t* GUt = IUt + 2 * 1024 * 64;
    for (int tile = F.vcu; tile < MTOK / 16; tile += F.G) {
        const int m0 = tile * 16, t0 = m0 & (SEQ - 1);
        __syncthreads();
        for (int p = tid; p < 18 * 36; p += 512) {
            const int rr = p / 36, ch = p - rr * 36, t = t0 + rr - 1, m = m0 + rr - 1;
            f32x4 a0 = {0.f, 0.f, 0.f, 0.f}, a1 = a0;
            if (t >= 0 && t < SEQ) {
                const bf16_t* pp = WSP(F, WS_PART, bf16_t) + (((size_t)((ch >> 5) * 32 + (m >> 8)) * 4) << 16) + (size_t)(m & 255) * 256 + ((8 * ch) & 255);
                u32x4 q[4];
#pragma unroll
                for (int k = 0; k < 4; ++k) q[k] = *(const u32x4*)(pp + ((size_t)k << 16));
#pragma unroll
                for (int k = 0; k < 4; ++k) { a0 += (f32x4){bf_lo(q[k].x), bf_hi(q[k].x), bf_lo(q[k].y), bf_hi(q[k].y)}; a1 += (f32x4){bf_lo(q[k].z), bf_hi(q[k].z), bf_lo(q[k].w), bf_hi(q[k].w)}; }
            }
            LAS f32x4* zp = (LAS f32x4*)(Zr + rr * 288 + 8 * ch); zp[0] = a0; zp[1] = a1;
        }
        __syncthreads();
        for (int p = tid; p < 16 * 36; p += 512) {
            const int i = p / 36, ch = p - i * 36, zc = 3072 + 8 * ch;
            float c[8], pv[8], nx[8], mp[8], mn[8];
            { const LAS f32x4* q = (const LAS f32x4*)(Zr + i * 288 + 8 * ch); const f32x4 x0 = q[0], x1 = q[1], y0 = q[72], y1 = q[73], w0 = q[144], w1 = q[145];
              pv[0] = x0.x; pv[1] = x0.y; pv[2] = x0.z; pv[3] = x0.w; pv[4] = x1.x; pv[5] = x1.y; pv[6] = x1.z; pv[7] = x1.w;
              c[0] = y0.x; c[1] = y0.y; c[2] = y0.z; c[3] = y0.w; c[4] = y1.x; c[5] = y1.y; c[6] = y1.z; c[7] = y1.w;
              nx[0] = w0.x; nx[1] = w0.y; nx[2] = w0.z; nx[3] = w0.w; nx[4] = w1.x; nx[5] = w1.y; nx[6] = w1.z; nx[7] = w1.w; }
            ld8f(INP(F, 4, float) + zc, mp); ld8f(INP(F, 5, float) + zc, mn);
            LAS f32x4* zp = (LAS f32x4*)(Zl + i * 288 + 8 * ch); float z[8];
#pragma unroll
            for (int e = 0; e < 8; ++e) z[e] = c[e] + mp[e] * (pv[e] - c[e]) + mn[e] * (nx[e] - c[e]);
            zp[0] = (f32x4){z[0], z[1], z[2], z[3]}; zp[1] = (f32x4){z[4], z[5], z[6], z[7]};
        }
        __syncthreads();
        for (int e = tid; e < 16 * 288; e += 512) { const int i = e / 288, j = e - i * 288; float z = Zl[e];
            if (j < 64) z = 1.f - 2.f * __builtin_amdgcn_rcpf(__expf(2.f * z) + 1.f); else if (j >= 128) z = __builtin_amdgcn_rcpf(1.f + __expf(-z));
            Al[i * AP + j] = f2bf(z); }
        __syncthreads();
        if (mode == 1) continue;
#pragma unroll 1
        for (int hfi = 0; hfi < 2; ++hfi) {
            const int hf = (hfi + (F.vcu >> 2)) & 1;
            u32x4 rawr[4], rawk[4], rawv[4];
            { const unsigned off = (unsigned)WS_PROJ + ((unsigned)(m0 + 2 * w) * LDP + ZC0 + 512 * hf + 8 * (tid & 63)) * 2u;
#pragma unroll
              for (int rr = 0; rr < 4; ++rr) { const int t = t0 + 2 * w + rr - 1; const bool ok = (t >= 0) && (t < SEQ); const unsigned o = off + (unsigned)((rr - 1) * LDP * 2);
                  rawr[rr] = ld_row16(F, o, ok); rawk[rr] = ld_row16(F, o + 1024u * 2u, ok); rawv[rr] = ld_row16(F, o + 2048u * 2u, ok); } }
            {
                const int n16 = lane & 15, q4 = lane >> 4;
                bf16x8 af[9];
#pragma unroll
                for (int ks = 0; ks < 9; ++ks) af[ks] = *(const LAS bf16x8*)(Al + n16 * AP + 32 * ks + 8 * q4);
                struct BF { bf16x8 d0[2], d1[2], i0[2], i1[2], g[5]; };
#define LD_BF(X, nb_) do { const int cl_ = 512 * hf + 64 * w + 16 * (nb_) + n16; _Pragma("unroll") for (int ks = 0; ks < 2; ++ks) { \
                    X.d0[ks] = *(const bf16x8*)(DUt + (size_t)cl_ * 64 + 32 * ks + 8 * q4); X.d1[ks] = *(const bf16x8*)(DUt + (size_t)(1024 + cl_) * 64 + 32 * ks + 8 * q4); \
                    X.i0[ks] = *(const bf16x8*)(IUt + (size_t)cl_ * 64 + 32 * ks + 8 * q4); X.i1[ks] = *(const bf16x8*)(IUt + (size_t)(1024 + cl_) * 64 + 32 * ks + 8 * q4); } \
                    _Pragma("unroll") for (int ks = 0; ks < 5; ++ks) X.g[ks] = *(const bf16x8*)(GUt + (size_t)cl_ * 160 + 32 * ks + 8 * q4); } while (0)
#define DO_NB(X, nb_) do { const int ch_ = 64 * w + 16 * (nb_); \
                    f32x4 aw0 = {0.f, 0.f, 0.f, 0.f}, aw1 = aw0, aa0 = aw0, aa1 = aw0, ag = aw0; \
                    _Pragma("unroll") for (int ks = 0; ks < 2; ++ks) { \
                        aw0 = __builtin_amdgcn_mfma_f32_16x16x32_bf16(X.d0[ks], af[ks], aw0, 0, 0, 0); aw1 = __builtin_amdgcn_mfma_f32_16x16x32_bf16(X.d1[ks], af[ks], aw1, 0, 0, 0); \
                        aa0 = __builtin_amdgcn_mfma_f32_16x16x32_bf16(X.i0[ks], af[2 + ks], aa0, 0, 0, 0); aa1 = __builtin_amdgcn_mfma_f32_16x16x32_bf16(X.i1[ks], af[2 + ks], aa1, 0, 0, 0); } \
                    _Pragma("unroll") for (int ks = 0; ks < 5; ++ks) ag = __builtin_amdgcn_mfma_f32_16x16x32_bf16(X.g[ks], af[4 + ks], ag, 0, 0, 0); \
                    LAS bf16_t* pp = Pl + n16 * PP + ch_ + 4 * q4; \
                    *(LAS u32x2*)(pp) = (u32x2){cvtpk(aw0[0], aw0[1]), cvtpk(aw0[2], aw0[3])}; *(LAS u32x2*)(pp + PA) = (u32x2){cvtpk(aw1[0], aw1[1]), cvtpk(aw1[2], aw1[3])}; \
                    *(LAS u32x2*)(pp + 2 * PA) = (u32x2){cvtpk(aa0[0], aa0[1]), cvtpk(aa0[2], aa0[3])}; *(LAS u32x2*)(pp + 3 * PA) = (u32x2){cvtpk(aa1[0], aa1[1]), cvtpk(aa1[2], aa1[3])}; \
                    *(LAS u32x2*)(pp + 4 * PA) = (u32x2){cvtpk(ag[0], ag[1]), cvtpk(ag[2], ag[3])}; } while (0)
                const int rot = F.vcu & 3;
                BF fa, fb; LD_BF(fa, (0 + rot) & 3); LD_BF(fb, (1 + rot) & 3);
                DO_NB(fa, (0 + rot) & 3); LD_BF(fa, (2 + rot) & 3); DO_NB(fb, (1 + rot) & 3); LD_BF(fb, (3 + rot) & 3); DO_NB(fa, (2 + rot) & 3); DO_NB(fb, (3 + rot) & 3);
#undef LD_BF
#undef DO_NB
            }
            __syncthreads();
            {
                const int chk = tid & 63, c = 512 * hf + 8 * chk;
                float r4[4][8], k4[4][8], v4[4][8];
#pragma unroll
                for (int rr = 0; rr < 4; ++rr) { unpack8(rawr[rr], r4[rr]); unpack8(rawk[rr], k4[rr]); unpack8(rawv[rr], v4[rr]); }
                float zr[2][8], zk[2][8], zv[2][8];
                { float mp[8], mn[8];
                  ld8f(INP(F, 4, float) + c, mp); ld8f(INP(F, 5, float) + c, mn);
#pragma unroll
                  for (int tk = 0; tk < 2; ++tk)
#pragma unroll
                      for (int e = 0; e < 8; ++e) zr[tk][e] = r4[tk + 1][e] + mp[e] * (r4[tk][e] - r4[tk + 1][e]) + mn[e] * (r4[tk + 2][e] - r4[tk + 1][e]);
                  ld8f(INP(F, 4, float) + 1024 + c, mp); ld8f(INP(F, 5, float) + 1024 + c, mn);
#pragma unroll
                  for (int tk = 0; tk < 2; ++tk)
#pragma unroll
                      for (int e = 0; e < 8; ++e) zk[tk][e] = k4[tk + 1][e] + mp[e] * (k4[tk][e] - k4[tk + 1][e]) + mn[e] * (k4[tk + 2][e] - k4[tk + 1][e]);
                  ld8f(INP(F, 4, float) + 2048 + c, mp); ld8f(INP(F, 5, float) + 2048 + c, mn);
#pragma unroll
                  for (int tk = 0; tk < 2; ++tk)
#pragma unroll
                      for (int e = 0; e < 8; ++e) zv[tk][e] = v4[tk + 1][e] + mp[e] * (v4[tk][e] - v4[tk + 1][e]) + mn[e] * (v4[tk + 2][e] - v4[tk + 1][e]); }
                float kkw[8], w00[8], w01[8], a00[8], a01[8], kac[8], rkc[8];
                ld8f(INP(F, 16, float) + c, kkw); ld8f(INP(F, 11, float) + c, w00); ld8f(INP(F, 11, float) + 1024 + c, w01);
                ld8f(INP(F, 13, float) + c, a00); ld8f(INP(F, 13, float) + 1024 + c, a01); ld8f(INP(F, 17, float) + c, kac); ld8f(INP(F, 18, float) + c, rkc);
#pragma unroll 1
                for (int tk = 0; tk < 2; ++tk) {
                    const int tkn = 2 * w + tk; const unsigned o = (unsigned)(m0 + tkn) * 1024u + (unsigned)c;
                    const LAS bf16_t* pp = Pl + tkn * PP + 8 * chk;
                    float zrt[8], zkt[8], zvt[8];
#pragma unroll
                    for (int e = 0; e < 8; ++e) { zrt[e] = tk ? zr[1][e] : zr[0][e]; zkt[e] = tk ? zk[1][e] : zk[0][e]; zvt[e] = tk ? zv[1][e] : zv[0][e]; }
                    WS32(F, u32x4, (unsigned)WS_R + o * 2u) = pack8(zrt); WS32(F, u32x4, (unsigned)WS_V + o * 2u) = pack8(zvt);
                    float kk[8];
                    { float ss = 0.f;
#pragma unroll
                      for (int e = 0; e < 8; ++e) { kk[e] = zkt[e] * kkw[e]; ss += kk[e] * kk[e]; }
                      ss += __shfl_xor(ss, 1); ss += __shfl_xor(ss, 2); ss += __shfl_xor(ss, 4);
                      const float inv = 1.f / fmaxf(sqrtf(ss), 1e-12f);
#pragma unroll
                      for (int e = 0; e < 8; ++e) kk[e] *= inv;
                      WS32(F, u32x4, (unsigned)WS_KK + o * 2u) = pack8(kk); }
                    {
                        float pw0[8], pw1[8], d0[8], d1[8];
                        unpack8(*(const LAS u32x4*)(pp), pw0); unpack8(*(const LAS u32x4*)(pp + PA), pw1);
#pragma unroll
                        for (int e = 0; e < 8; ++e) {
                            d0[e] = 0.6065306597126334f * __builtin_amdgcn_rcpf(1.f + __expf(-(w00[e] + pw0[e]))); d1[e] = 0.6065306597126334f * __builtin_amdgcn_rcpf(1.f + __expf(-(w01[e] + pw1[e]))); }
                        WS32(F, u32x4, (unsigned)WS_WDEC + o * 2u) = pack8(d0); WS32(F, u32x4, (unsigned)WS_WDEC + ((unsigned)(MTOK * 1024) + o) * 2u) = pack8(d1);
                    }
                    {
                        float pa0[8], pa1[8], kd0[8], kd1[8], b0v[8], b1v[8]; float bs = 0.f;
                        unpack8(*(const LAS u32x4*)(pp + 2 * PA), pa0); unpack8(*(const LAS u32x4*)(pp + 3 * PA), pa1);
#pragma unroll
                        for (int e = 0; e < 8; ++e) {
                            const float av0 = __builtin_amdgcn_rcpf(1.f + __expf(-(a00[e] + pa0[e]))), av1 = __builtin_amdgcn_rcpf(1.f + __expf(-(a01[e] + pa1[e])));
                            kd0[e] = zkt[e] * (1.f + (av0 - 1.f) * kac[e]); kd1[e] = zkt[e] * (1.f + (av1 - 1.f) * kac[e]);
                            b0v[e] = kk[e] * av0; b1v[e] = kk[e] * av1;
                            bs += zrt[e] * (kd0[e] + kd1[e]) * rkc[e]; }
                        bs += __shfl_xor(bs, 1); bs += __shfl_xor(bs, 2); bs += __shfl_xor(bs, 4);
                        if ((chk & 7) == 0) WS32(F, float, (unsigned)WS_BONUS + ((unsigned)(m0 + tkn) * 16u + (unsigned)(8 * hf + (chk >> 3))) * 4u) = bs;
                        WS32(F, u32x4, (unsigned)WS_KD + o * 2u) = pack8(kd0); WS32(F, u32x4, (unsigned)WS_KD + ((unsigned)(MTOK * 1024) + o) * 2u) = pack8(kd1);
                        WS32(F, u32x4, (unsigned)WS_BB + o * 2u) = pack8(b0v); WS32(F, u32x4, (unsigned)WS_BB + ((unsigned)(MTOK * 1024) + o) * 2u) = pack8(b1v);
                    }
                    WS32(F, u32x4, (unsigned)WS_G + o * 2u) = *(const LAS u32x4*)(pp + 4 * PA);
                }
            }
            __syncthreads();
        }
    }
}

struct P5aConst { float lam; };
__device__ __forceinline__ void p5a_init(const Frame& F, P5aConst& K) {
    const int lane = F.lane;
    const float q1 = INP(F, 6, float)[lane] * INP(F, 7, float)[lane], q2 = INP(F, 8, float)[lane] * INP(F, 9, float)[lane];
    K.lam = __expf(wave_sum(q1)) - __expf(wave_sum(q2)) + 0.2f;
}
__device__ __forceinline__ void p5a_token(const Frame& F, const P5aConst& K, int m) {
    const bf16_t* OC = WSP(F, WS_OC, bf16_t); bf16_t* MIX = WSP(F, WS_MIX, bf16_t); const float* subw = INP(F, 10, float);
    const int c0 = F.lane * 16; const float lam = K.lam;
    const u32x4* p0 = (const u32x4*)(OC + (size_t)m * 1024 + c0); const u32x4* p1 = (const u32x4*)(OC + (size_t)MTOK * 1024 + (size_t)m * 1024 + c0);
    const u32x4 a0 = p0[0], a1 = p0[1], b0 = p1[0], b1 = p1[1];
    float dv[16]; const unsigned aw[8] = {a0.x, a0.y, a0.z, a0.w, a1.x, a1.y, a1.z, a1.w}, bw[8] = {b0.x, b0.y, b0.z, b0.w, b1.x, b1.y, b1.z, b1.w};
    float ssq = 0.f;
#pragma unroll
    for (int i = 0; i < 8; ++i) { dv[2 * i] = bf_lo(aw[i]) - lam * bf_lo(bw[i]); dv[2 * i + 1] = bf_hi(aw[i]) - lam * bf_hi(bw[i]); ssq += dv[2 * i] * dv[2 * i] + dv[2 * i + 1] * dv[2 * i + 1]; }
    ssq += __shfl_xor(ssq, 1); ssq += __shfl_xor(ssq, 2); ssq += __shfl_xor(ssq, 4);
    const float rstd = 1.f / sqrtf(ssq * (1.f / 128.f) + 1e-5f);
    unsigned ow[8];
#pragma unroll
    for (int i = 0; i < 8; ++i) { const float s0 = subw[(c0 + 2 * i) & 127] * 0.8f, s1 = subw[(c0 + 2 * i + 1) & 127] * 0.8f; ow[i] = cvtpk(dv[2 * i] * rstd * s0, dv[2 * i + 1] * rstd * s1); }
    u32x4* op = (u32x4*)(MIX + (size_t)m * 2048 + c0); op[0] = (u32x4){ow[0], ow[1], ow[2], ow[3]}; op[1] = (u32x4){ow[4], ow[5], ow[6], ow[7]};
}

__device__ __forceinline__ void p4_scan(Frame& F, const int mode = 0) {
    constexpr int CH = 32, NCH = SEQ / CH;
    constexpr int VEC = CH * 64 * 4;
    constexpr int BUF = 5 * VEC + CH * 32 * 4;
    constexpr int YOFF = 2 * BUF, YB = CH * 32 * 4;
    constexpr int CVT_SCR = 2 * BUF + 2 * YB;
    const bf16_t* Wdec = WSP(F, WS_WDEC, bf16_t); const bf16_t* KDg = WSP(F, WS_KD, bf16_t); const bf16_t* BBg = WSP(F, WS_BB, bf16_t);
    const bf16_t* Rg = WSP(F, WS_R, bf16_t); const bf16_t* KKg = WSP(F, WS_KK, bf16_t); const bf16_t* Vg = WSP(F, WS_V, bf16_t); bf16_t* YS = WSP(F, WS_YS, bf16_t);
    const int tid = F.tid, lane = F.lane, wid = F.wave;
    const bool is_comp = wid < 4;
    const int ri = wid & 3;
    if (is_comp) __builtin_amdgcn_s_setprio(3);
    const int g = lane >> 3, j = lane & 7, rowl = ri * 8 + g;
    const int mt = ri * 64 + lane, mw = ri;
    int cvt_it = F.vcu * 4 + mw; f32x4 cvv[16]; int ck0 = 0, crowb = 0; unsigned char* cWT = nullptr;
    f32x4 cvvB[16]; int ck0B = 0, crowbB = 0; unsigned char* cWTB = nullptr;
    LAS unsigned* st_cnt = (LAS unsigned*)(F.lds + CVT_SCR + 4 * 4096); LAS unsigned* cons_cnt = st_cnt + 16;
    for (int item = F.vcu; item < 256; item += F.G) {
        const int chain = item >> 1, half = item & 1, d = chain >> 6, b = (chain >> 4) & 3, h = chain & 15;
        const size_t sh = (size_t)b * SEQ * 1024 + h * 64, pd = (size_t)d * MTOK * 1024 + sh;
        f32x2 S2[4] = {{0.f, 0.f}, {0.f, 0.f}, {0.f, 0.f}, {0.f, 0.f}};
        u32x2 rw[2], rkk[2], rbb[2], rkd[2], rr[2]; unsigned rv[2];
        const int cstep = d ? -CH * 1024 : CH * 1024;
        unsigned po[2], pv[2];
#pragma unroll
        for (int q_ = 0; q_ < 2; ++q_) { const int sl_ = mt + 256 * q_, ss_ = sl_ >> 4, sk_ = (sl_ & 15) * 4, tq_ = d ? (SEQ - 1 - ss_) : ss_; po[q_] = (unsigned)(tq_ * 1024 + sk_); pv[q_] = (unsigned)(tq_ * 1024 + half * 32 + 2 * (sl_ & 15)); }
        const char* bW = (const char*)(Wdec + pd); const char* bKK = (const char*)(KKg + sh); const char* bBB = (const char*)(BBg + pd); const char* bKD = (const char*)(KDg + pd); const char* bR = (const char*)(Rg + sh); const char* bV = (const char*)(Vg + sh);
#define SC_LOAD(c) do { const unsigned cu_ = (unsigned)((c) * cstep); _Pragma("unroll") for (int q_ = 0; q_ < 2; ++q_) { const unsigned e_ = po[q_] + cu_; \
        rw[q_] = *(const u32x2*)(bW + (size_t)(e_ * 2u)); rkk[q_] = *(const u32x2*)(bKK + (size_t)(e_ * 2u)); rbb[q_] = *(const u32x2*)(bBB + (size_t)(e_ * 2u)); rkd[q_] = *(const u32x2*)(bKD + (size_t)(e_ * 2u)); rr[q_] = *(const u32x2*)(bR + (size_t)(e_ * 2u)); \
        rv[q_] = *(const unsigned*)(bV + (size_t)((pv[q_] + cu_) * 2u)); } } while (0)
#define SC_STORE(bufi) do { LAS unsigned char* bp_ = F.lds + (bufi) * BUF; _Pragma("unroll") for (int q_ = 0; q_ < 2; ++q_) { const int sl_ = mt + 256 * q_, ss_ = sl_ >> 4, sk_ = (sl_ & 15) * 4; const int o_ = (ss_ * 64 + sk_) * 4; \
        *(LAS f32x4*)(bp_ + o_) = (f32x4){__expf(-bf_lo(rw[q_].x)), __expf(-bf_hi(rw[q_].x)), __expf(-bf_lo(rw[q_].y)), __expf(-bf_hi(rw[q_].y))}; \
        *(LAS f32x4*)(bp_ + VEC + o_) = (f32x4){bf_lo(rkk[q_].x), bf_hi(rkk[q_].x), bf_lo(rkk[q_].y), bf_hi(rkk[q_].y)}; \
        *(LAS f32x4*)(bp_ + 2 * VEC + o_) = (f32x4){bf_lo(rbb[q_].x), bf_hi(rbb[q_].x), bf_lo(rbb[q_].y), bf_hi(rbb[q_].y)}; \
        *(LAS f32x4*)(bp_ + 3 * VEC + o_) = (f32x4){bf_lo(rkd[q_].x), bf_hi(rkd[q_].x), bf_lo(rkd[q_].y), bf_hi(rkd[q_].y)}; \
        *(LAS f32x4*)(bp_ + 4 * VEC + o_) = (f32x4){bf_lo(rr[q_].x), bf_hi(rr[q_].x), bf_lo(rr[q_].y), bf_hi(rr[q_].y)}; \
        *(LAS f32x2*)(bp_ + 5 * VEC + (ss_ * 32 + 2 * (sl_ & 15)) * 4) = (f32x2){bf_lo(rv[q_]), bf_hi(rv[q_])}; } } while (0)
#define Y_OUT(c) do { const int ys_ = mt >> 3, yr_ = (mt & 7) * 4; const int tt_ = (c) * CH + ys_, t_ = d ? (SEQ - 1 - tt_) : tt_; \
        const f32x4 yv_ = *(const LAS f32x4*)(F.lds + YOFF + ((c) & 1) * YB + (ys_ * 32 + yr_) * 4); \
        *(u32x2*)(YS + pd + (size_t)t_ * 1024 + half * 32 + yr_) = (u32x2){cvtpk(yv_.x, yv_.y), cvtpk(yv_.z, yv_.w)}; } while (0)
#define SC_WAIT(cnt_, tgt_) do { for (;;) { const u32x4 q_ = *(volatile LAS u32x4*)(cnt_); const unsigned a_ = q_.x < q_.y ? q_.x : q_.y, b_ = q_.z < q_.w ? q_.z : q_.w; \
        if ((a_ < b_ ? a_ : b_) >= (tgt_)) break; if (is_comp) __builtin_amdgcn_s_sleep(1); else __builtin_amdgcn_s_sleep(12); } asm volatile("" ::: "memory"); } while (0)
#define SC_SIGNAL(cnt_, val_) do { asm volatile("s_waitcnt lgkmcnt(0)" ::: "memory"); if (lane == 0) *(volatile LAS unsigned*)((cnt_) + ri) = (val_); } while (0)
        __syncthreads();
        if (tid < 4) { st_cnt[tid] = 0u; cons_cnt[tid] = 0u; }
        if (!is_comp) { SC_LOAD(0); SC_STORE(0); SC_LOAD(1); }
        __syncthreads();
        if (is_comp) {
          for (int c = 0; c < NCH; ++c) {
            SC_WAIT(st_cnt, (unsigned)c);
            if (mode != 2) {
                const LAS unsigned char* bp = F.lds + (c & 1) * BUF;
                LAS float* yb = (LAS float*)(F.lds + YOFF + (c & 1) * YB);
                f32x4 cw_[2], ckk[2], cbb[2], ckd[2], cr[2]; float cv;
#define SC_RD(s_) do { const int o_ = ((s_) * 64 + j * 8) * 4; cw_[0] = *(const LAS f32x4*)(bp + o_); cw_[1] = *(const LAS f32x4*)(bp + o_ + 16); ckk[0] = *(const LAS f32x4*)(bp + VEC + o_); ckk[1] = *(const LAS f32x4*)(bp + VEC + o_ + 16); \
                cbb[0] = *(const LAS f32x4*)(bp + 2 * VEC + o_); cbb[1] = *(const LAS f32x4*)(bp + 2 * VEC + o_ + 16); ckd[0] = *(const LAS f32x4*)(bp + 3 * VEC + o_); ckd[1] = *(const LAS f32x4*)(bp + 3 * VEC + o_ + 16); \
                cr[0] = *(const LAS f32x4*)(bp + 4 * VEC + o_); cr[1] = *(const LAS f32x4*)(bp + 4 * VEC + o_ + 16); cv = *(const LAS float*)(bp + 5 * VEC + ((s_) * 32 + rowl) * 4); } while (0)
#define H2(v_, i_) ((f32x2){v_[(i_) >> 1][((i_) & 1) * 2], v_[(i_) >> 1][((i_) & 1) * 2 + 1]})
                SC_RD(0);
                float yk = 0.f;
#pragma unroll
                for (int s = 0; s < CH; ++s) {
                    f32x4 w[2] = {cw_[0], cw_[1]}, kk[2] = {ckk[0], ckk[1]}, bb[2] = {cbb[0], cbb[1]}, kd[2] = {ckd[0], ckd[1]}, r[2] = {cr[0], cr[1]}; const float v = cv;
                    if (s + 1 < CH) SC_RD(s + 1);
                    f32x2 pa = S2[0] * H2(kk, 0), pb = S2[1] * H2(kk, 1); pa = S2[2] * H2(kk, 2) + pa; pb = S2[3] * H2(kk, 3) + pb; pa = pa + pb;
                    const f32x2 vv = {v, v};
                    f32x2 u[4];
#pragma unroll
                    for (int i = 0; i < 4; ++i) u[i] = S2[i] * H2(w, i) + vv * H2(kd, i);
                    float p = pa.x + pa.y;
                    p = dpp_add<0xB1>(p); p = dpp_add<0x4E>(p); p = dpp_add<0x141>(p);
                    const f32x2 sa = {-p, -p};
#pragma unroll
                    for (int i = 0; i < 4; ++i) S2[i] = sa * H2(bb, i) + u[i];
                    f32x2 ya = S2[0] * H2(r, 0), yc = S2[1] * H2(r, 1); ya = S2[2] * H2(r, 2) + ya; yc = S2[3] * H2(r, 3) + yc; ya = ya + yc;
                    float y = ya.x + ya.y;
                    y = dpp_add<0xB1>(y); y = dpp_add<0x4E>(y); y = dpp_add<0x141>(y);
                    yk = (j == (s & 7)) ? y : yk;
                    if ((s & 7) == 7) yb[((s & 24) + j) * 32 + rowl] = yk;
                }
#undef SC_RD
#undef H2
            }
            SC_SIGNAL(cons_cnt, (unsigned)(c + 1));
          }
        } else {
#define MEM_DUTIES(c_) do { SC_WAIT(cons_cnt, (unsigned)(c_)); if ((c_) >= 1 && mode != 2) Y_OUT((c_) - 1); if ((c_) + 1 < NCH) SC_STORE(((c_) + 1) & 1); SC_SIGNAL(st_cnt, (unsigned)((c_) + 1)); if ((c_) + 2 < NCH) SC_LOAD((c_) + 2); } while (0)
#define CVT_LOAD_SET(V_, K0_, WT_, RB_) do { const int it_ = cvt_it < N_EXPERT_ITEMS ? cvt_it : N_EXPERT_ITEMS - 1; const float* cW_; int cn0_; cvt_expert_decode(F, it_, cW_, K0_, cn0_, WT_, RB_); cvt8_load(V_, cW_, K0_, cn0_, lane); cvt_it += F.G * 4; } while (0)
          if (item == F.vcu) { P5aConst p5k; p5a_init(F, p5k); for (int xm = F.vcu * 4 + mw; xm < MTOK; xm += F.G * 4) p5a_token(F, p5k, xm); }
          int ngrp = 0; { const int left = (N_EXPERT_ITEMS - cvt_it + F.G * 4 - 1) / (F.G * 4); ngrp = left > 0 ? left / 3 : 0; if (ngrp > NCH / 4) ngrp = NCH / 4; }
          int cg = 0;
#pragma unroll 1
          for (; cg < 4 * ngrp; cg += 4) {
            MEM_DUTIES(cg);
#if CVT_IN_SCAN
            if (cg > 0) cvt8_finish(cvv, ck0, cWT, crowb, lane);
            CVT_LOAD_SET(cvv, ck0, cWT, crowb);
#endif
            MEM_DUTIES(cg + 1);
#if CVT_IN_SCAN
            CVT_LOAD_SET(cvvB, ck0B, cWTB, crowbB);
#endif
            MEM_DUTIES(cg + 2);
#if CVT_IN_SCAN
            cvt8_finish(cvv, ck0, cWT, crowb, lane);
            CVT_LOAD_SET(cvv, ck0, cWT, crowb);
#endif
            MEM_DUTIES(cg + 3);
#if CVT_IN_SCAN
            cvt8_finish(cvvB, ck0B, cWTB, crowbB, lane);
#endif
          }
#if CVT_IN_SCAN
          if (ngrp > 0) cvt8_finish(cvv, ck0, cWT, crowb, lane);
#endif
#pragma unroll 1
          for (; cg < NCH; ++cg) MEM_DUTIES(cg);
#undef MEM_DUTIES
#undef CVT_LOAD_SET
          SC_WAIT(cons_cnt, (unsigned)NCH);
        }
        if (!is_comp && mode != 2) Y_OUT(NCH - 1);
#undef SC_LOAD
#undef SC_STORE
#undef Y_OUT
#undef SC_WAIT
#undef SC_SIGNAL
    }
    __builtin_amdgcn_s_setprio(0);
#if CVT_IN_SCAN
    if (!is_comp) {
        for (; cvt_it < N_EXPERT_ITEMS; cvt_it += F.G * 4) {
            const float* W; int k0, n0, rowb; unsigned char* WT;
            cvt_expert_decode(F, cvt_it, W, k0, n0, WT, rowb); cvt8_load(cvv, W, k0, n0, lane); cvt8_finish(cvv, k0, WT, rowb, lane);
        }
    }
#endif
}

__device__ __forceinline__ void p5_finalize(Frame& F) {
    const bf16_t* OC = WSP(F, WS_OC, bf16_t); const bf16_t* YS = WSP(F, WS_YS, bf16_t); const bf16_t* Vg = WSP(F, WS_V, bf16_t); const bf16_t* Gg = WSP(F, WS_G, bf16_t);
    const float* BON = WSP(F, WS_BONUS, float); bf16_t* MIX = WSP(F, WS_MIX, bf16_t);
    const float* subw = INP(F, 10, float); const float* lnw = INP(F, 19, float); const float* lnb = INP(F, 20, float);
    const int lane = F.lane, gw = F.vcu * 8 + F.wave, NGW = F.G * 8;
    float lam;
    { const float q1 = INP(F, 6, float)[lane] * INP(F, 7, float)[lane], q2 = INP(F, 8, float)[lane] * INP(F, 9, float)[lane];
      lam = __expf(wave_sum(q1)) - __expf(wave_sum(q2)) + 0.2f; }
    const int c0 = lane * 16;
    float sw[16], lw[16], lb[16];
#pragma unroll
    for (int i = 0; i < 16; ++i) { sw[i] = subw[(c0 + i) & 127] * 0.8f; lw[i] = lnw[c0 + i]; lb[i] = lnb[c0 + i]; }
    for (int m = gw; m < MTOK; m += NGW) {
        { const u32x4* y0 = (const u32x4*)(YS + (size_t)m * 1024 + c0); const u32x4* y1 = (const u32x4*)(YS + (size_t)MTOK * 1024 + (size_t)m * 1024 + c0);
          float y[16]; float s = 0.f;
          { const u32x4 a0 = y0[0], a1 = y0[1], b0 = y1[0], b1 = y1[1];
            const unsigned aw[8] = {a0.x, a0.y, a0.z, a0.w, a1.x, a1.y, a1.z, a1.w}, bw[8] = {b0.x, b0.y, b0.z, b0.w, b1.x, b1.y, b1.z, b1.w};
#pragma unroll
            for (int i = 0; i < 8; ++i) { y[2 * i] = bf_lo(aw[i]) + bf_lo(bw[i]); y[2 * i + 1] = bf_hi(aw[i]) + bf_hi(bw[i]); } }
#pragma unroll
          for (int i = 0; i < 16; ++i) s += y[i];
          s += __shfl_xor(s, 1); s += __shfl_xor(s, 2);
          const float mu = s * (1.f / 64.f); float q = 0.f;
#pragma unroll
          for (int i = 0; i < 16; ++i) { y[i] -= mu; q += y[i] * y[i]; }
          q += __shfl_xor(q, 1); q += __shfl_xor(q, 2);
          const float rstd = 1.f / sqrtf(q * (1.f / 64.f) + 64e-5f);
          const float bon = BON[(size_t)m * 16 + (lane >> 2)];
          const u32x4* vp = (const u32x4*)(Vg + (size_t)m * 1024 + c0); const u32x4* gp = (const u32x4*)(Gg + (size_t)m * 1024 + c0);
          const u32x4 v0 = vp[0], v1 = vp[1], g0 = gp[0], g1 = gp[1];
          const unsigned vw[8] = {v0.x, v0.y, v0.z, v0.w, v1.x, v1.y, v1.z, v1.w}, gq[8] = {g0.x, g0.y, g0.z, g0.w, g1.x, g1.y, g1.z, g1.w};
          unsigned ow[8];
#pragma unroll
          for (int i = 0; i < 8; ++i) {
              const float e0 = (y[2 * i] * rstd * lw[2 * i] + lb[2 * i] + bon * bf_lo(vw[i])) * bf_lo(gq[i]);
              const float e1 = (y[2 * i + 1] * rstd * lw[2 * i + 1] + lb[2 * i + 1] + bon * bf_hi(vw[i])) * bf_hi(gq[i]);
              ow[i] = cvtpk(e0, e1); }
          u32x4* op = (u32x4*)(MIX + (size_t)m * 2048 + 1024 + c0); op[0] = (u32x4){ow[0], ow[1], ow[2], ow[3]}; op[1] = (u32x4){ow[4], ow[5], ow[6], ow[7]}; }
    }
}

__device__ __forceinline__ void p7_router(Frame& F) {
    const bf16_t* X1 = WSP(F, WS_X1, bf16_t); const float* nw = INP(F, 22, float); const float* wr = INP(F, 23, float);
    unsigned char* H2 = WSP(F, WS_H2, unsigned char); float* AFF = WSP(F, WS_AFF, float);
    const int lane = F.lane, tid = F.tid, gw = F.vcu * 8 + F.wave, NGW = F.G * 8;
    volatile LAS unsigned* MISC = (volatile LAS unsigned*)(F.lds + MISC_OFF);
    const unsigned m8 = MISC[8], m9 = MISC[9];
    __syncthreads();
    for (int f = tid; f < 2048 * 4; f += 512) { const int col = f >> 2, q = f & 3; *(LAS f32x4*)(F.lds + (col >> 2) * 272 + (col & 3) * 64 + q * 16) = *(const f32x4*)(wr + (size_t)col * 16 + 4 * q); }
    __syncthreads();
    for (int pr = gw; pr < MTOK / 2; pr += NGW) {
        const int m = 2 * pr;
        const u32x2* xr0 = (const u32x2*)(X1 + (size_t)m * DM) + lane; const u32x2* xr1 = xr0 + DM / 4;
        f32x4 v0[8], v1[8]; float s0 = 0.f, s1 = 0.f;
#pragma unroll
        for (int j = 0; j < 8; ++j) { const u32x2 a_ = xr0[64 * j], b_ = xr1[64 * j]; v0[j] = (f32x4){bf_lo(a_.x), bf_hi(a_.x), bf_lo(a_.y), bf_hi(a_.y)}; v1[j] = (f32x4){bf_lo(b_.x), bf_hi(b_.x), bf_lo(b_.y), bf_hi(b_.y)}; }
#pragma unroll
        for (int j = 0; j < 8; ++j) { s0 += (v0[j].x * v0[j].x + v0[j].y * v0[j].y) + (v0[j].z * v0[j].z + v0[j].w * v0[j].w); s1 += (v1[j].x * v1[j].x + v1[j].y * v1[j].y) + (v1[j].z * v1[j].z + v1[j].w * v1[j].w); }
        const float r0 = 1.f / sqrtf(wave_sum(s0) * (1.f / DM) + 1e-6f), r1 = 1.f / sqrtf(wave_sum(s1) * (1.f / DM) + 1e-6f);
        unsigned* o0 = (unsigned*)(H2 + (size_t)m * DM) + lane; unsigned* o1 = o0 + DM / 4;
        float acc[32];
#pragma unroll
        for (int i = 0; i < 32; ++i) acc[i] = 0.f;
#pragma unroll
        for (int j = 0; j < 8; ++j) {
            const f32x4 w = ((const f32x4*)nw)[lane + 64 * j];
            const f32x4 a = v0[j] * w * r0, b = v1[j] * w * r1;
            o0[64 * j] = pg8::cvt4_fp8(a.x, a.y, a.z, a.w);
            o1[64 * j] = pg8::cvt4_fp8(b.x, b.y, b.z, b.w);
            const LAS f32x4* wp = (const LAS f32x4*)(F.lds + (lane + 64 * j) * 272);
#pragma unroll
            for (int i = 0; i < 4; ++i) {
#pragma unroll
                for (int q = 0; q < 4; ++q) { const f32x4 ww = wp[i * 4 + q];
#pragma unroll
                    for (int e = 0; e < 4; ++e) { acc[4 * q + e] += a[i] * ww[e]; acc[16 + 4 * q + e] += b[i] * ww[e]; } }
                asm volatile("" ::: "memory");
            }
        }
#define RSTAGE(N_, B_) do { const bool up_ = (lane & (B_)) != 0; _Pragma("unroll") for (int k = 0; k < (N_); ++k) { const float lo_ = acc[k], hi_ = acc[(N_) + k]; \
            const float snd_ = up_ ? lo_ : hi_, kp_ = up_ ? hi_ : lo_; acc[k] = kp_ + __shfl_xor(snd_, (B_)); } } while (0)
        RSTAGE(16, 32); RSTAGE(8, 16); RSTAGE(4, 8); RSTAGE(2, 4); RSTAGE(1, 2);
#undef RSTAGE
        float lg = acc[0] + __shfl_xor(acc[0], 1);
        float mx = lg;
        mx = fmaxf(mx, __shfl_xor(mx, 2)); mx = fmaxf(mx, __shfl_xor(mx, 4)); mx = fmaxf(mx, __shfl_xor(mx, 8)); mx = fmaxf(mx, __shfl_xor(mx, 16));
        const float p = expf(lg - mx);
        float den = p; den += __shfl_xor(den, 2); den += __shfl_xor(den, 4); den += __shfl_xor(den, 8); den += __shfl_xor(den, 16);
        if ((lane & 1) == 0) { const int row = lane >> 5, e = (lane >> 1) & 15, mm = m + row; AFF[((size_t)(mm >> 11) * 16 + e) * SEQ + (mm & (SEQ - 1))] = p / den; }
    }
    __syncthreads();
    if (tid == 0) { MISC[8] = m8; MISC[9] = m9; }
    __syncthreads();
}

__device__ __forceinline__ int wave_count4(bool f0, bool f1, bool f2, bool f3) {
    return __builtin_popcountll(__ballot(f0)) + __builtin_popcountll(__ballot(f1)) + __builtin_popcountll(__ballot(f2)) + __builtin_popcountll(__ballot(f3));
}
__device__ __forceinline__ void p8_select(Frame& F) {
    const float* AFF = WSP(F, WS_AFF, float);
    int* XEIDX = WSP(F, WS_XEIDX, int); float* GATEX = WSP(F, WS_GATEX, float); int* SLOT = WSP(F, WS_SLOT, int);
    LAS int* part = (LAS int*)F.lds;
    LAS unsigned* cnt = (LAS unsigned*)(F.lds + 256);
    LAS unsigned* list = (LAS unsigned*)(F.lds + 512);
    const int tid = F.tid, lane = F.lane, w = F.wave;
    for (int item = F.vcu; item < 256; item += F.G) {
        const int be = item >> 2, q = item & 3, b = be >> 4, e = be & 15;
        __syncthreads();
        if (tid == 0) *cnt = 0u;
        const f32x4 a4 = ((const f32x4*)(AFF + (size_t)be * SEQ))[tid];
        const unsigned u0 = __float_as_uint(a4.x), u1 = __float_as_uint(a4.y), u2 = __float_as_uint(a4.z), u3 = __float_as_uint(a4.w);
        unsigned lo = 0u, hi = 0x7f800001u;
        int itn = 0;
        while (hi - lo > 1u) {
            const unsigned mid = lo + ((hi - lo) >> 1);
            const int c = wave_count4(u0 >= mid, u1 >= mid, u2 >= mid, u3 >= mid);
            LAS int* pp = part + (itn & 1) * 8;
            if (lane == 0) pp[w] = c;
            __syncthreads();
            int tot = 0;
#pragma unroll
            for (int i = 0; i < 8; ++i) tot += pp[i];
            if (tot >= CAP) lo = mid; else hi = mid;
            ++itn;
        }
        const unsigned T = lo;
        const bool g0 = u0 > T, g1 = u1 > T, g2 = u2 > T, g3 = u3 > T, q0 = u0 == T, q1 = u1 == T, q2 = u2 == T, q3 = u3 == T;
        const unsigned long long bg0 = __ballot(g0), bg1 = __ballot(g1), bg2 = __ballot(g2), bg3 = __ballot(g3), bq0 = __ballot(q0), bq1 = __ballot(q1), bq2 = __ballot(q2), bq3 = __ballot(q3);
        const unsigned long long below = (lane == 0) ? 0ull : (~0ull >> (64 - lane));
        int pg = __builtin_popcountll(bg0 & below) + __builtin_popcountll(bg1 & below) + __builtin_popcountll(bg2 & below) + __builtin_popcountll(bg3 & below);
        int pq = __builtin_popcountll(bq0 & below) + __builtin_popcountll(bq1 & below) + __builtin_popcountll(bq2 & below) + __builtin_popcountll(bq3 & below);
        const int wg = __builtin_popcountll(bg0) + __builtin_popcountll(bg1) + __builtin_popcountll(bg2) + __builtin_popcountll(bg3);
        const int wq = __builtin_popcountll(bq0) + __builtin_popcountll(bq1) + __builtin_popcountll(bq2) + __builtin_popcountll(bq3);
        if (lane == 0) { part[16 + w] = wg; part[32 + w] = wq; }
        __syncthreads();
        int gtc = 0, baseg = 0, baseq = 0;
#pragma unroll
        for (int i = 0; i < 8; ++i) { const int x = part[16 + i], y = part[32 + i]; gtc += x; if (i < w) { baseg += x; baseq += y; } }
        const int need = CAP - gtc;
        pg += baseg; pq += baseq;
        if ((w >> 1) == q) {
            const bool gs[4] = {g0, g1, g2, g3}, qs[4] = {q0, q1, q2, q3}; const float av[4] = {a4.x, a4.y, a4.z, a4.w};
            int cg_ = pg, cq_ = pq;
#pragma unroll
            for (int i = 0; i < 4; ++i) {
                const int t = 4 * tid + i, m = b * SEQ + t; int slot = -1;
                if (gs[i]) { slot = cg_; ++cg_; } else if (qs[i]) { if (cq_ < need) slot = gtc + cq_; ++cq_; }
                SLOT[m * 16 + e] = slot;
                if (slot >= 0) { GATEX[(e * 4 + b) * CAP + slot] = av[i]; XEIDX[(e * 4 + b) * CAP + slot] = m; }
            }
        }
    }
}

__device__ __forceinline__ void p11_final(Frame& F) {
    const bf16_t* X1 = WSP(F, WS_X1, bf16_t); const bf16_t* YE = WSP(F, WS_YE, bf16_t); const int* SLOT = WSP(F, WS_SLOT, int); const float* nw = INP(F, 27, float);
    float* out = F.a->out;
    const int lane = F.lane, gw = F.vcu * 8 + F.wave, NGW = F.G * 8;
    for (int m = gw; m < MTOK; m += NGW) {
        const int b = m >> 11;
        float v[32];
        { const u32x4* xr = (const u32x4*)(X1 + (size_t)m * DM + lane * 8);
#pragma unroll
          for (int j = 0; j < 4; ++j) { const u32x4 a = xr[64 * j]; v[8 * j] = bf_lo(a.x); v[8 * j + 1] = bf_hi(a.x); v[8 * j + 2] = bf_lo(a.y); v[8 * j + 3] = bf_hi(a.y); v[8 * j + 4] = bf_lo(a.z); v[8 * j + 5] = bf_hi(a.z); v[8 * j + 6] = bf_lo(a.w); v[8 * j + 7] = bf_hi(a.w); } }
        int sl = (lane < 16) ? SLOT[m * 16 + lane] : -1;
        for (int e = 0; e < 16; ++e) {
            const int s = __shfl(sl, e);
            if (s >= 0) { const u32x4* yr = (const u32x4*)(YE + (size_t)((e * 4 + b) * CAP + s) * DM + lane * 8);
#pragma unroll
                for (int j = 0; j < 4; ++j) { const u32x4 w = yr[64 * j];
                    v[8 * j] += bf_lo(w.x); v[8 * j + 1] += bf_hi(w.x); v[8 * j + 2] += bf_lo(w.y); v[8 * j + 3] += bf_hi(w.y); v[8 * j + 4] += bf_lo(w.z); v[8 * j + 5] += bf_hi(w.z); v[8 * j + 6] += bf_lo(w.w); v[8 * j + 7] += bf_hi(w.w); } }
        }
        float s = 0.f;
#pragma unroll
        for (int i = 0; i < 32; ++i) s += v[i] * v[i];
        const float rstd = 1.f / sqrtf(wave_sum(s) * (1.f / DM) + 1e-6f);
#pragma unroll
        for (int j = 0; j < 4; ++j) { const int col = 512 * j + lane * 8; const f32x4 w0 = *(const f32x4*)(nw + col), w1 = *(const f32x4*)(nw + col + 4);
            f32x4 o0 = {v[8 * j] * rstd * w0.x, v[8 * j + 1] * rstd * w0.y, v[8 * j + 2] * rstd * w0.z, v[8 * j + 3] * rstd * w0.w};
            f32x4 o1 = {v[8 * j + 4] * rstd * w1.x, v[8 * j + 5] * rstd * w1.y, v[8 * j + 6] * rstd * w1.z, v[8 * j + 7] * rstd * w1.w};
            *(f32x4*)(out + (size_t)m * DM + col) = o0; *(f32x4*)(out + (size_t)m * DM + col + 4) = o1; }
    }
}


template <int PHM> __global__ void __launch_bounds__(512, 2) mk_fwd(Args args) {
    extern __shared__ __attribute__((aligned(16))) unsigned char lds[];
    Frame F;
    F.lds = (LAS unsigned char*)lds; F.ldsg = (char*)lds; F.a = &args;
    F.tid = threadIdx.x; F.lane = F.tid & 63; F.wave = __builtin_amdgcn_readfirstlane(F.tid >> 6);
    F.G = gridDim.x; { const int bx = blockIdx.x; F.vcu = (F.G % 8 == 0) ? (bx % 8) * (F.G / 8) + bx / 8 : bx; }
    volatile LAS unsigned* MISC = (volatile LAS unsigned*)(F.lds + MISC_OFF);
    for (int u = F.tid; u < (LDS_BYTES - 131072) / 4; u += 512) ((LAS unsigned*)(F.lds + 131072))[u] = 0u;
    __syncthreads();
    gu32* ctl = (gu32*)(args.ws + WS_CTL);
    XcdBarrier bar; bar.bar = (unsigned*)(ctl + CW_BAR); bar.x = 0; bar.st = nullptr;
    if (MK_N_LAUNCHES == 1) bar = xcd_barrier_post((unsigned*)(ctl + CW_BAR), MISC + 8);
    const int lo = args.ph_lo, hi = args.ph_hi;
#define IN(k) (((PHM >> (k)) & 1) && lo <= (k) && (k) < hi)
#ifndef DUP_MASK
#define DUP_MASK 0
#endif
#define REP(k) for (int rep_ = 0; rep_ < 1 + ((DUP_MASK >> (k)) & 1); ++rep_)
#define SEAM(k) do { if (IN(k) && IN((k) + 1)) xcd_barrier(bar); } while (0)

    if (IN(0)) REP(0) { p0_prologue(F); }
    SEAM(0);
    if (IN(1)) REP(1) {
        pg8::Gemm g{WSP(F, WS_H1, bf16_t), WSP(F, WS_WIN, bf16_t), MTOK, 6144, DM, DM}; pg8::StaticOrder S; S.init(MTOK, 6144, F.G, (int)blockIdx.x);
        pg8::EpiProj E{WSP(F, WS_PROJ, bf16_t), LDP, WSP(F, WS_ROPE, float), QSCALE};
        pg8::gemm_phase<pg8::EpiProj, pg8::StaticOrder, true, true>(F.lds, g, S, E);
        pg8::Gemm g2{WSP(F, WS_H1, bf16_t), WSP(F, WS_WIN, bf16_t), MTOK, 512, DM / 4, DM}; pg8::TailOrder S2{F.G, (int)blockIdx.x};
        pg8::EpiPart E2{WSP(F, WS_PART, bf16_t)};
        pg8::gemm_phase<pg8::EpiPart, pg8::TailOrder, true, true>(F.lds, g2, S2, E2);
    }
    SEAM(1);
    const bool prep_first = (F.vcu & 1) != 0;
    if (IN(3) && prep_first) { p3_prep(F, 0); }
    if (IN(2)) {
        const bf16_t* P = WSP(F, WS_PROJ, bf16_t); bf16_t* OC = WSP(F, WS_OC, bf16_t);
        for (int u = F.vcu * 2; u < 512; u += F.G * 2)
            for (int i = 0; i < 2; ++i) {
                const int uu = u + i, qb = uu & 7, c = (uu >> 3) & 1, h = (uu >> 4) & 7, b = uu >> 7;
                const size_t m0 = (size_t)b * SEQ;
                att::attn_unit<LDP>(P + (m0 + qb * 256) * LDP + h * 128 + c * 64, P + m0 * LDP + 1024 + h * 128 + c * 64, P + m0 * LDP + 2048 + h * 128,
                                    OC + (size_t)c * MTOK * 1024 + (m0 + qb * 256) * 1024 + h * 128, SEQ, F.ldsg);
            }
    }
    if (IN(3) && !prep_first) { p3_prep(F, 0); }
    SEAM(3);
    #ifndef SCAN_PROBE
#define SCAN_PROBE 0
#endif
    if (IN(4)) REP(4) { p4_scan(F, rep_ ? SCAN_PROBE : 0); }
    SEAM(4);
    if (IN(5)) REP(5) { p5_finalize(F); }
    SEAM(5);
    if (IN(6)) REP(6) {
        pg8::Gemm g{WSP(F, WS_MIX, bf16_t), WSP(F, WS_WOUT, bf16_t), MTOK, DM, DM, DM}; pg8::StaticOrder S; S.init(MTOK, DM, F.G, (int)blockIdx.x);
        pg8::EpiResid E{INP(F, 0, float), WSP(F, WS_X1, bf16_t), DM};
        pg8::gemm_phase<pg8::EpiResid, pg8::StaticOrder, true, true>(F.lds, g, S, E);
    }
    SEAM(6);
    if (IN(7)) REP(7) { p7_router(F); }
    SEAM(7);
    if (IN(8)) REP(8) { p8_select(F); }
    SEAM(8);
    if (IN(9)) REP(9) {
        pg8::Gemm g{WSP(F, WS_H2, bf16_t), WSP(F, WS_WGU, bf16_t), 16384, 65536, DM / 2, DM / 2}; pg8::MoeOrderT<true> S{F.G, F.vcu, 16, 1024, WSP(F, WS_XEIDX, int)};
        pg8::EpiSwiglu E{WSP(F, WS_HID, unsigned char), 16};
        pg8::gemm_phase<pg8::EpiSwiglu, pg8::MoeOrderT<true>, true, true, true>(F.lds, g, S, E);
    }
    SEAM(9);
    if (IN(10)) REP(10) {
        pg8::Gemm g{WSP(F, WS_HID, bf16_t), WSP(F, WS_WD, bf16_t), 16384, 32768, DM / 2, DM / 2}; pg8::MoeOrderT<false> S{F.G, F.vcu, 8, 512, nullptr};
        pg8::EpiDown E{WSP(F, WS_YE, bf16_t), WSP(F, WS_GATEX, float), 8};
        pg8::gemm_phase<pg8::EpiDown, pg8::MoeOrderT<false>, true, true, true>(F.lds, g, S, E);
    }
    SEAM(10);
    if (IN(11)) REP(11) { p11_final(F); }
#undef IN
#undef SEAM
}

static const void* kfn(int li) {
#if MK_N_LAUNCHES == 1
    (void)li; return (const void*)mk_fwd<0xFFF>;
#else
    switch (li) {
        case 0: return (const void*)mk_fwd<1>; case 1: return (const void*)mk_fwd<2>; case 2: return (const void*)mk_fwd<4>; case 3: return (const void*)mk_fwd<8>;
        case 4: return (const void*)mk_fwd<16>; case 5: return (const void*)mk_fwd<32>; case 6: return (const void*)mk_fwd<64>; case 7: return (const void*)mk_fwd<128>;
        case 8: return (const void*)mk_fwd<256>; case 9: return (const void*)mk_fwd<512>; case 10: return (const void*)mk_fwd<1024>; default: return (const void*)mk_fwd<2048>;
    }
#endif
}
extern "C" void kernel_launch(void* const* d_in, const int* in_sizes, int n_in, void* d_out, int out_size, void* d_ws, size_t ws_size, hipStream_t stream) {
    static int grid = 0;
    if (grid == 0) {
        if (n_in != 28 || out_size != MTOK * DM || ws_size < WS_END) { fprintf(stderr, "kernel_launch: unexpected shapes: n_in %d out %d ws %zu (need >= %zu)\n", n_in, out_size, ws_size, (size_t)WS_END); grid = -1; return; }
        int dev = 0, cus = 0, per_cu = 0;
        if (hipGetDevice(&dev) != hipSuccess || hipDeviceGetAttribute(&cus, hipDeviceAttributeMultiprocessorCount, dev) != hipSuccess) { fprintf(stderr, "kernel_launch: device query failed\n"); grid = -1; return; }
        for (int i = 0; i < MK_N_LAUNCHES; ++i) if (hipFuncSetAttribute(kfn(i), hipFuncAttributeMaxDynamicSharedMemorySize, LDS_BYTES) != hipSuccess) { fprintf(stderr, "kernel_launch: hipFuncSetAttribute failed\n"); grid = -1; return; }
        if (hipOccupancyMaxActiveBlocksPerMultiprocessor(&per_cu, kfn(0), 512, LDS_BYTES) != hipSuccess || per_cu < 1) { fprintf(stderr, "kernel_launch: occupancy query says %d blocks/CU\n", per_cu); }
        (void)hipGetLastError();
        grid = cus;
    }
    if (grid < 0) return;
    if (hipMemsetAsync((char*)d_ws + WS_CTL, 0, CTL_ZERO_BYTES, stream) != hipSuccess) { fprintf(stderr, "kernel_launch: memset failed\n"); return; }
    Args a{};
    for (int i = 0; i < 28; ++i) a.in[i] = d_in[i];
    a.out = (float*)d_out; a.ws = (unsigned char*)d_ws;
    const int nl = MK_N_LAUNCHES;
    for (int li = 0; li < nl; ++li) {
        a.ph_lo = (nl == 1) ? 0 : li; a.ph_hi = (nl == 1) ? N_PHASES : li + 1; a.li = li;
        void* kargs[] = {&a};
        (void)hipLaunchKernel(kfn(li), dim3(grid), dim3(512), kargs, LDS_BYTES, stream);
        const hipError_t le = hipPeekAtLastError();
        if (le != hipSuccess) { fprintf(stderr, "kernel_launch: launch %d failed: %s\n", li, hipGetErrorName(le)); break; }
    }
}
```

```cpp
#include <hip/hip_runtime.h>
#include <hip/hip_bf16.h>
#include <cstdio>
#include <cstdint>

#ifndef MK_N_LAUNCHES
#define MK_N_LAUNCHES 1
#endif
#ifndef CVT_IN_SCAN
#define CVT_IN_SCAN 1
#endif
constexpr int N_PHASES = 12;

constexpr int BATCH = 4, SEQ = 2048, DM = 2048, MTOK = BATCH * SEQ;
constexpr int IN_COLS = 6432, LDP = 6656;
constexpr int ZC0 = 3072;
constexpr int RW = 1024, NH_R = 16, HD_R = 64;
constexpr int NEXP = 16, CAP = 256, FF = 2048;
constexpr float QSCALE = 0.18033688011112042f;

constexpr size_t MiB = 1u << 20;
constexpr size_t WS_CTL = 0, CTL_ZERO_BYTES = 1 * MiB;
constexpr size_t WS_ROPE = 1 * MiB;
constexpr size_t WS_LORA = 2 * MiB;
constexpr size_t WS_AFF = 3 * MiB;
constexpr size_t WS_GATEX = 3 * MiB + 512 * 1024;
constexpr size_t WS_SLOT = 4 * MiB;
constexpr size_t WS_XEIDX = 6 * MiB;
constexpr size_t WS_BONUS = 5 * MiB;
constexpr size_t WS_WIN = 8 * MiB;
constexpr size_t WS_WOUT = 34 * MiB;
constexpr size_t WS_WGU = 48 * MiB;
constexpr size_t WS_WD = 304 * MiB;
constexpr size_t WS_H1 = 432 * MiB;
constexpr size_t WS_PROJ = 464 * MiB;
constexpr size_t WS_R = 568 * MiB, WS_KK = 584 * MiB, WS_V = 600 * MiB;
constexpr size_t WS_WDEC = 616 * MiB;
constexpr size_t WS_KD = 680 * MiB, WS_BB = 712 * MiB;
constexpr size_t WS_G = 744 * MiB;
constexpr size_t WS_OC = 760 * MiB;
constexpr size_t WS_YS = 792 * MiB;
constexpr size_t WS_MIX = 856 * MiB;
constexpr size_t WS_X1 = 888 * MiB;
constexpr size_t WS_H2 = 952 * MiB;
constexpr size_t WS_HID = 528 * MiB, WS_YE = 592 * MiB;
constexpr size_t WS_PART = WS_X1;
constexpr size_t WS_END = 984 * MiB;
constexpr int CW_BAR = 4096;

constexpr int LDS_BYTES = 147456;
constexpr int MISC_OFF = 131072 + 320;

#define GAS __attribute__((address_space(1)))
#define LAS __attribute__((address_space(3)))
typedef unsigned short bf16_t;
typedef float f32x4 __attribute__((ext_vector_type(4)));
typedef float f32x2 __attribute__((ext_vector_type(2)));
typedef float f32x16 __attribute__((ext_vector_type(16)));
typedef unsigned u32x4 __attribute__((ext_vector_type(4)));
typedef unsigned u32x2 __attribute__((ext_vector_type(2)));
typedef short bf16x8 __attribute__((ext_vector_type(8)));
typedef short s16x4 __attribute__((ext_vector_type(4)));
typedef __bf16 bf16x2_t __attribute__((ext_vector_type(2)));

__device__ __forceinline__ unsigned cvtpk(float lo, float hi) { f32x2 v = {lo, hi}; bf16x2_t b = __builtin_convertvector(v, bf16x2_t); return __builtin_bit_cast(unsigned, b); }
__device__ __forceinline__ float bf_lo(unsigned w) { return __uint_as_float(w << 16); }
__device__ __forceinline__ float bf_hi(unsigned w) { return __uint_as_float(w & 0xffff0000u); }
__device__ __forceinline__ float bf2f(bf16_t v) { return __uint_as_float((unsigned)v << 16); }
__device__ __forceinline__ float wave_sum(float v) {
#pragma unroll
    for (int o = 1; o < 64; o <<= 1) v += __shfl_xor(v, o);
    return v;
}
__device__ __forceinline__ float sigmoidf_(float x) { return 1.f / (1.f + __expf(-x)); }

struct Args { const void* in[28]; float* out; unsigned char* ws; int ph_lo, ph_hi, li, pad; };

namespace pg8 {
#define PG8_LAS __attribute__((address_space(3)))
typedef unsigned short bf16_t;
typedef short bf16x8 __attribute__((ext_vector_type(8)));
typedef float f32x4 __attribute__((ext_vector_type(4)));
typedef unsigned u32x4 __attribute__((ext_vector_type(4)));
typedef unsigned u32x2 __attribute__((ext_vector_type(2)));
typedef int i32x4 __attribute__((ext_vector_type(4)));
typedef int i32x8 __attribute__((ext_vector_type(8)));
typedef float f32x8 __attribute__((ext_vector_type(8)));
typedef float f32x32 __attribute__((ext_vector_type(32)));
constexpr int BM = 256, BK = 64, HALF = 128, HTB = HALF * BK * 2  , STAGE_BYTES = 8 * HTB, NXCD = 8, WGM = 8;

__host__ __device__ __forceinline__ int lds_byte(int r, int c) { const int st = (r >> 4) * 2 + (c >> 5), rr = r & 15, cc = c & 31, ob = rr * 64 + cc * 2; return st * 1024 + (ob ^ (((ob >> 9) & 1) << 5)); }
__host__ __device__ __forceinline__ void stage_rc(int b, int& R, int& C) { const int st = b / 1024, sb = b % 1024, swz = sb ^ (((sb >> 9) & 1) << 5); R = (st >> 1) * 16 + swz / 64; C = (st & 1) * 32 + (swz % 64) / 2; }
__host__ __device__ __forceinline__ int perm32(int rho) { const int n = rho >> 4, i = rho & 15; return 8 * (i >> 2) + 4 * n + (i & 3); }

struct Unit { int pm, pn, pk; };
struct Gemm { const bf16_t* A; const bf16_t* Bt; int M, N, K, Kp; };

struct StaticOrder {
    int nM, nN, nwg, G, c;
    __host__ __device__ void init(int M, int N, int G_, int c_) { nM = M / BM; nN = N / BM; nwg = nM * nN; G = G_; c = c_; }
    __host__ __device__ bool next(int i, Unit& u) const {
        const long L = (long)i * G + c; if (L >= nwg) return false;
        int wgid = (int)L; { const int q = nwg / NXCD, r = nwg % NXCD, xcd = wgid % NXCD, off = wgid / NXCD; wgid = (xcd < r ? xcd * (q + 1) : r * (q + 1) + (xcd - r) * q) + off; }
        const int nig = WGM * nN, gid = wgid / nig, fm = gid * WGM, gsz = (nM - fm) < WGM ? (nM - fm) : WGM;
        u.pm = fm + ((wgid % nig) % gsz); u.pn = (wgid % nig) / gsz; u.pk = 0; return true;
    }
    static constexpr bool GATHER = false;
    __device__ __forceinline__ int arow(const Unit&, int) const { return 0; }
    __device__ __forceinline__ void a_ready(const Unit&) const {}
    __device__ __forceinline__ void done(const Unit&) const {}
};


typedef float f32x2 __attribute__((ext_vector_type(2)));
typedef __bf16 bf16x2_t __attribute__((ext_vector_type(2)));
__device__ __forceinline__ unsigned cvt_pk_bf16(float lo, float hi) { f32x2 v = {lo, hi}; bf16x2_t b = __builtin_convertvector(v, bf16x2_t); return __builtin_bit_cast(unsigned, b); }

template <bool GATHER_> struct MoeOrderT {
    static constexpr bool GATHER = GATHER_;
    int G, vcu, npn, total; const int* idx;
    __device__ __forceinline__ int arow(const Unit& u, int r) const { return idx[u.pm * BM + r]; }
    __device__ bool next(int i, Unit& u) const {
        const int L = i * G + vcu; if (L >= total) return false;
        const int per_e = 4 * npn, e = L / per_e, r = L % per_e;
        u.pm = e * 4 + (r & 3); u.pn = e * npn + (r >> 2); u.pk = 0; return true;
    }
    __device__ __forceinline__ void a_ready(const Unit&) const {}
    __device__ __forceinline__ void done(const Unit&) const {}
};

struct TailOrder {
    int G, c; static constexpr bool GATHER = false;
    __device__ bool next(int i, Unit& u) const { const int L = i * G + c; if (L >= 256) return false; u.pk = L & 3; const int t = L >> 2; u.pm = t & 31; u.pn = 24 + (t >> 5); return true; }
    __device__ __forceinline__ int arow(const Unit&, int) const { return 0; }
    __device__ __forceinline__ void a_ready(const Unit&) const {}
    __device__ __forceinline__ void done(const Unit&) const {}
};
struct EpiPart {
    static constexpr bool PERM = true, AFTER_DRAIN = false;
    bf16_t* P;
    __device__ __forceinline__ void operator()(const f32x4 (&acc)[2][2][4][2], const Unit& u, int wr, int wc, int fr, int fq) const {
        bf16_t* base = P + ((size_t)(((u.pn - 24) * 32 + u.pm) * 4 + u.pk) << 16);
        const int row0 = wr * 64 + fr, col0 = wc * 32 + 8 * fq;
        const bool thin = (u.pn == 25);
        if (thin && wc != 0) return;
#pragma unroll
        for (int ai = 0; ai < 2; ++ai)
#pragma unroll
            for (int m = 0; m < 4; ++m) {
                bf16_t* rowp = base + (row0 + ai * HALF + m * 16) * 256 + col0;
#pragma unroll
                for (int bj = 0; bj < 2; ++bj) { if (bj == 1 && thin) break; const f32x4 v0 = acc[ai][bj][m][0], v1 = acc[ai][bj][m][1];
                    u32x4 w; w.x = cvt_pk_bf16(v0[0], v0[1]); w.y = cvt_pk_bf16(v0[2], v0[3]); w.z = cvt_pk_bf16(v1[0], v1[1]); w.w = cvt_pk_bf16(v1[2], v1[3]);
                    *(u32x4*)(rowp + bj * HALF) = w; }
            }
    }
};

struct EpiProj {
    static constexpr bool PERM = true, AFTER_DRAIN = false;
    bf16_t* P; int ldp; const float* rope; float qscale;
    __device__ __forceinline__ void operator()(const f32x4 (&acc)[2][2][4][2], const Unit& u, int wr, int wc, int fr, int fq) const {
        const int row0 = u.pm * BM + wr * 64 + fr, colt = u.pn * BM, col0 = colt + wc * 32 + 8 * fq;
        const bool ropew = (colt < 2048) && ((wc & 1) == 0);
        const float sc = (colt < 1024) ? qscale : 1.f, sgn = (fq == 0) ? -1.f : 1.f;
#pragma unroll
        for (int ai = 0; ai < 2; ++ai)
#pragma unroll
            for (int m = 0; m < 4; ++m) {
                const int row = row0 + ai * HALF + m * 16;
                f32x4 c0 = {1.f, 1.f, 1.f, 1.f}, c1 = c0, s0 = {0.f, 0.f, 0.f, 0.f}, s1 = s0;
                if (ropew) { const f32x4* rp = (const f32x4*)(rope + (size_t)row * 16); c0 = rp[0]; c1 = rp[1]; s0 = rp[2]; s1 = rp[3]; }
                bf16_t* rowp = P + (size_t)row * ldp + col0;
#pragma unroll
                for (int bj = 0; bj < 2; ++bj) {
                    f32x4 v0 = acc[ai][bj][m][0], v1 = acc[ai][bj][m][1];
                    if (ropew) {
                        f32x4 p0, p1;
#pragma unroll
                        for (int i = 0; i < 4; ++i) { p0[i] = __shfl_xor(v0[i], 16); p1[i] = __shfl_xor(v1[i], 16); }
                        if (fq < 2) { v0 = v0 * c0 + (p0 * s0) * sgn; v1 = v1 * c1 + (p1 * s1) * sgn; }
                    }
                    v0 = v0 * sc; v1 = v1 * sc;
                    u32x4 w; w.x = cvt_pk_bf16(v0[0], v0[1]); w.y = cvt_pk_bf16(v0[2], v0[3]); w.z = cvt_pk_bf16(v1[0], v1[1]); w.w = cvt_pk_bf16(v1[2], v1[3]);
                    *(u32x4*)(rowp + bj * HALF) = w;
                }
            }
    }
};

struct EpiResid {
    static constexpr bool PERM = true, AFTER_DRAIN = false;
    const float* base; bf16_t* out; int ldc;
    __device__ __forceinline__ void operator()(const f32x4 (&acc)[2][2][4][2], const Unit& u, int wr, int wc, int fr, int fq) const {
        const int row0 = u.pm * BM + wr * 64 + fr, col0 = u.pn * BM + wc * 32 + 8 * fq;
#pragma unroll
        for (int ai = 0; ai < 2; ++ai)
#pragma unroll
            for (int m = 0; m < 4; ++m) {
                const size_t off = (size_t)(row0 + ai * HALF + m * 16) * ldc + col0;
#pragma unroll
                for (int bj = 0; bj < 2; ++bj) { const f32x4 b0 = *(const f32x4*)(base + off + bj * HALF), b1 = *(const f32x4*)(base + off + bj * HALF + 4);
                    const f32x4 v0 = b0 + acc[ai][bj][m][0], v1 = b1 + acc[ai][bj][m][1];
                    u32x4 w; w.x = cvt_pk_bf16(v0[0], v0[1]); w.y = cvt_pk_bf16(v0[2], v0[3]); w.z = cvt_pk_bf16(v1[0], v1[1]); w.w = cvt_pk_bf16(v1[2], v1[3]);
                    *(u32x4*)(out + off + bj * HALF) = w; }
            }
    }
};

__device__ __forceinline__ float clamp8(float x) { return __builtin_fminf(__builtin_fmaxf(x, -448.f), 448.f); }
__device__ __forceinline__ unsigned cvt4_fp8(float a, float b, float c, float d) {
    int w = __builtin_amdgcn_cvt_pk_fp8_f32(clamp8(a), clamp8(b), 0, false); w = __builtin_amdgcn_cvt_pk_fp8_f32(clamp8(c), clamp8(d), w, true); return (unsigned)w; }
constexpr float W8_SCALE = 64.f, W8_DESCALE = 1.f / 64.f;

struct EpiSwiglu {
    static constexpr bool PERM = true, AFTER_DRAIN = false;
    unsigned char* H; int npn;
    __device__ __forceinline__ void operator()(const f32x4 (&acc)[2][2][4][2], const Unit& u, int wr, int wc, int fr, int fq) const {
        const int row0 = u.pm * BM + wr * 64 + fr, pnl = u.pn % npn, col0 = pnl * HALF + wc * 32 + 8 * fq;
#pragma unroll
        for (int ai = 0; ai < 2; ++ai)
#pragma unroll
            for (int m = 0; m < 4; ++m) {
                unsigned char* rowp = H + (size_t)(row0 + ai * HALF + m * 16) * 2048 + col0;
                float h[8];
#pragma unroll
                for (int n = 0; n < 2; ++n)
#pragma unroll
                    for (int i = 0; i < 4; ++i) { const float g = acc[ai][0][m][n][i] * W8_DESCALE, up = acc[ai][1][m][n][i] * W8_DESCALE; h[n * 4 + i] = g * up * __builtin_amdgcn_rcpf(1.f + __expf(-g)); }
                u32x2 w; w.x = cvt4_fp8(h[0], h[1], h[2], h[3]); w.y = cvt4_fp8(h[4], h[5], h[6], h[7]);
                *(u32x2*)rowp = w;
            }
    }
};

struct EpiDown {
    static constexpr bool PERM = true, AFTER_DRAIN = false;
    bf16_t* Y; const float* gate; int npn;
    __device__ __forceinline__ void operator()(const f32x4 (&acc)[2][2][4][2], const Unit& u, int wr, int wc, int fr, int fq) const {
        const int row0 = u.pm * BM + wr * 64 + fr, pnl = u.pn % npn, col0 = pnl * BM + wc * 32 + 8 * fq;
#pragma unroll
        for (int ai = 0; ai < 2; ++ai)
#pragma unroll
            for (int m = 0; m < 4; ++m) {
                const int row = row0 + ai * HALF + m * 16; const float gt = gate[row] * W8_DESCALE;
                bf16_t* rowp = Y + (size_t)row * 2048 + col0;
#pragma unroll
                for (int bj = 0; bj < 2; ++bj) { const f32x4 v0 = acc[ai][bj][m][0] * gt, v1 = acc[ai][bj][m][1] * gt;
                    u32x4 w; w.x = cvt_pk_bf16(v0[0], v0[1]); w.y = cvt_pk_bf16(v0[2], v0[3]); w.z = cvt_pk_bf16(v1[0], v1[1]); w.w = cvt_pk_bf16(v1[2], v1[3]);
                    *(u32x4*)(rowp + bj * HALF) = w; }
            }
    }
};

template <class Epi, class Sched, bool ALIGN_EPI = false, bool SP2 = false, bool FP8 = false>
__device__ __forceinline__ void gemm_phase(PG8_LAS unsigned char* lds, const Gemm g, const Sched& S, const Epi& E) {
    const int tid = threadIdx.x, wid = __builtin_amdgcn_readfirstlane(tid >> 6), lane = tid & 63, wr = wid >> 2, wc = wid & 3, fr = lane & 15, fq = lane >> 4;
    const int K = g.Kp, nt = g.K / BK;
    const size_t kslice = (size_t)g.K * 2;
    unsigned voffA[2], voffB[2];
#pragma unroll
    for (int i = 0; i < 2; ++i) { int R, C; stage_rc(tid * 16 + i * 8192, R, C); const int Rb = Epi::PERM ? ((R & ~31) + perm32(R & 31)) : R;
        voffA[i] = (unsigned)(R * K + C) * 2u; voffB[i] = (unsigned)(Rb * K + C) * 2u; }
    static_assert(!Sched::GATHER || SP2, "gathered A rows: SP2 loop only");
    const size_t kstep = (size_t)(BK * 2);
    const size_t hstep = (size_t)HALF * K * 2;
    const size_t tstep = 2 * hstep;
    const unsigned ldsw = (unsigned)wid * 1024u;
    const int aoff = lds_byte(wr * 64 + fr, fq * 8), boff = lds_byte(wc * 32 + fr, fq * 8);
#define PG8_SA(b, h) (((b) * 2 + (h)) * HTB)
#define PG8_SB(b, h) ((4 + (b) * 2 + (h)) * HTB)
#define PG8_STAGE(bufoff, gbase, voff) do { _Pragma("unroll") for (int _i = 0; _i < 2; ++_i) \
        __builtin_amdgcn_global_load_lds((const unsigned*)((const char*)(gbase) + (voff)[_i]), (PG8_LAS unsigned*)(lds + (bufoff) + ldsw + _i * 8192), 16, 0, 0); } while (0)
#define PG8_LDA(dst, b, h) do { _Pragma("unroll") for (int m = 0; m < 4; ++m) _Pragma("unroll") for (int k = 0; k < 2; ++k) dst[m][k] = *(const PG8_LAS bf16x8*)(lds + PG8_SA(b, h) + aoff + m * 2048 + k * 1024); } while (0)
#define PG8_LDB(dst, b, h) do { _Pragma("unroll") for (int n = 0; n < 2; ++n) _Pragma("unroll") for (int k = 0; k < 2; ++k) dst[n][k] = *(const PG8_LAS bf16x8*)(lds + PG8_SB(b, h) + boff + n * 2048 + k * 1024); } while (0)
#define PG8_CAT8(x, y) __builtin_shufflevector(__builtin_bit_cast(i32x4, x), __builtin_bit_cast(i32x4, y), 0, 1, 2, 3, 4, 5, 6, 7)
#define PG8_W8(c) __builtin_shufflevector(c, c, 0, 1, 2, 3, -1, -1, -1, -1)
#define PG8_MMA(ai, bj, At, Bt) do { __builtin_amdgcn_s_setprio(1); \
        if constexpr (FP8) { f32x32 a_ = acc32[ai][bj]; _Pragma("unroll") for (int m = 0; m < 4; ++m) _Pragma("unroll") for (int n = 0; n < 2; ++n) { \
            f32x4 c_ = {a_[(m * 2 + n) * 4], a_[(m * 2 + n) * 4 + 1], a_[(m * 2 + n) * 4 + 2], a_[(m * 2 + n) * 4 + 3]}; \
            c_ = __builtin_amdgcn_mfma_scale_f32_16x16x128_f8f6f4(PG8_CAT8(Bt[n][0], Bt[n][1]), PG8_CAT8(At[m][0], At[m][1]), c_, 0, 0, 0, 0, 0, 0); \
            a_[(m * 2 + n) * 4] = c_[0]; a_[(m * 2 + n) * 4 + 1] = c_[1]; a_[(m * 2 + n) * 4 + 2] = c_[2]; a_[(m * 2 + n) * 4 + 3] = c_[3]; } acc32[ai][bj] = a_; } \
        else { _Pragma("unroll") for (int m = 0; m < 4; ++m) _Pragma("unroll") for (int n = 0; n < 2; ++n) _Pragma("unroll") for (int k = 0; k < 2; ++k) \
            acc[ai][bj][m][n] = __builtin_amdgcn_mfma_f32_16x16x32_bf16(Bt[n][k], At[m][k], acc[ai][bj][m][n], 0, 0, 0); } __builtin_amdgcn_s_setprio(0); } while (0)
#define PG8_WAIT_V(n) asm volatile("s_waitcnt vmcnt(" #n ")" ::: "memory")
#define PG8_WAIT_L(n) asm volatile("s_waitcnt lgkmcnt(" #n ")" ::: "memory")
#define PG8_BAR __builtin_amdgcn_s_barrier()
#define PG8_SCHED __builtin_amdgcn_sched_barrier(0)
    Unit cur, nxt; int ui = 0;
    if (!S.next(0, cur)) return;
    f32x4 acc[2][2][4][2]; f32x32 acc32[2][2];
#pragma unroll
    for (int a = 0; a < 2; ++a)
#pragma unroll
        for (int b = 0; b < 2; ++b)
#pragma unroll
            for (int m = 0; m < 4; ++m) {
#pragma unroll
                for (int n = 0; n < 2; ++n) { acc[a][b][m][n] = (f32x4){0.f, 0.f, 0.f, 0.f};
#pragma unroll
                    for (int i = 0; i < 4; ++i) acc32[a][b][(m * 2 + n) * 4 + i] = 0.f; } }
    bf16x8 At[4][2], B0[2][2], B1[2][2];
    const char* cA = (const char*)g.A + (size_t)cur.pm * tstep + (size_t)cur.pk * kslice; const char* cB = (const char*)g.Bt + (size_t)cur.pn * tstep + (size_t)cur.pk * kslice;
    unsigned cvA0[2], cvA1[2], nvA0[2], nvA1[2];
#pragma unroll
    for (int i = 0; i < 2; ++i) { int R, C; stage_rc(tid * 16 + i * 8192, R, C);
        if constexpr (Sched::GATHER) { cvA0[i] = (unsigned)(S.arow(cur, R) * K + C) * 2u; cvA1[i] = (unsigned)(S.arow(cur, HALF + R) * K + C) * 2u; }
        else { cvA0[i] = voffA[i]; cvA1[i] = voffA[i] + (unsigned)hstep; }
        nvA0[i] = cvA0[i]; nvA1[i] = cvA1[i]; }
    if constexpr (Sched::GATHER) cA = (const char*)g.A;
    S.a_ready(cur);
    if constexpr (SP2) {
        PG8_STAGE(PG8_SB(0, 0), cB, voffB); PG8_STAGE(PG8_SB(0, 1), cB + hstep, voffB); PG8_STAGE(PG8_SA(0, 0), cA, cvA0); PG8_STAGE(PG8_SA(0, 1), cA, cvA1);
        if (wr == 1) PG8_BAR;
        PG8_WAIT_V(2); PG8_BAR;
        PG8_STAGE(PG8_SB(1, 0), cB + kstep, voffB); PG8_STAGE(PG8_SA(1, 0), cA + kstep, cvA0); PG8_STAGE(PG8_SB(1, 1), cB + hstep + kstep, voffB);
        PG8_WAIT_V(6); PG8_BAR;
    } else {
        PG8_STAGE(PG8_SB(0, 0), cB, voffB); PG8_STAGE(PG8_SA(0, 0), cA, voffA); PG8_STAGE(PG8_SB(0, 1), cB + hstep, voffB); PG8_STAGE(PG8_SA(0, 1), cA + hstep, voffA);
        if (wr == 1) PG8_BAR;
        PG8_WAIT_V(4); PG8_BAR;
        PG8_STAGE(PG8_SB(1, 0), cB + kstep, voffB); PG8_STAGE(PG8_SA(1, 0), cA + kstep, voffA); PG8_STAGE(PG8_SB(1, 1), cB + hstep + kstep, voffB);
        PG8_WAIT_V(6); PG8_BAR;
    }
    for (;;) {
        const bool has_next = S.next(ui + 1, nxt);
        const char* nA = Sched::GATHER ? (const char*)g.A : (has_next ? (const char*)g.A + (size_t)nxt.pm * tstep + (size_t)nxt.pk * kslice : cA);
        if constexpr (Sched::GATHER) { if (has_next) {
#pragma unroll
            for (int i = 0; i < 2; ++i) { int R, C; stage_rc(tid * 16 + i * 8192, R, C); nvA0[i] = (unsigned)(S.arow(nxt, R) * K + C) * 2u; nvA1[i] = (unsigned)(S.arow(nxt, HALF + R) * K + C) * 2u; } } } const char* nB = has_next ? (const char*)g.Bt + (size_t)nxt.pn * tstep + (size_t)nxt.pk * kslice : cB;
        for (int t = 0; t < nt; t += 2) {
            const bool last = (t == nt - 2);
            const char* a1 = cA + (size_t)(t + 1) * kstep;
            const char* a2 = last ? nA : cA + (size_t)(t + 2) * kstep; const char* b2 = last ? nB : cB + (size_t)(t + 2) * kstep;
            const char* a3 = a2 + kstep; const char* b3 = b2 + kstep;
            if (last && has_next) S.a_ready(nxt);
            unsigned sA0[2], sA1[2];
#pragma unroll
            for (int i = 0; i < 2; ++i) { sA0[i] = last ? nvA0[i] : cvA0[i]; sA1[i] = last ? nvA1[i] : cvA1[i]; }
            if constexpr (SP2) {
            PG8_LDB(B0, 0, 0); PG8_LDB(B1, 0, 1); PG8_SCHED; PG8_LDA(At, 0, 0); PG8_STAGE(PG8_SA(1, 1), a1, cvA1);
            PG8_WAIT_V(8); PG8_WAIT_L(0); PG8_BAR; PG8_MMA(0, 0, At, B0); PG8_MMA(0, 1, At, B1); PG8_BAR; PG8_SCHED;
            PG8_LDA(At, 0, 1); PG8_STAGE(PG8_SB(0, 0), b2, voffB); PG8_STAGE(PG8_SB(0, 1), b2 + hstep, voffB); PG8_STAGE(PG8_SA(0, 0), a2, sA0);
            PG8_WAIT_V(8); PG8_WAIT_L(0); PG8_BAR; PG8_MMA(1, 0, At, B0); PG8_MMA(1, 1, At, B1); PG8_BAR; PG8_SCHED;
            PG8_LDB(B0, 1, 0); PG8_LDB(B1, 1, 1); PG8_SCHED; PG8_LDA(At, 1, 0); PG8_STAGE(PG8_SA(0, 1), a2, sA1);
            PG8_WAIT_V(8); PG8_WAIT_L(0); PG8_BAR; PG8_MMA(0, 0, At, B0); PG8_MMA(0, 1, At, B1); PG8_BAR; PG8_SCHED;
            PG8_LDA(At, 1, 1); PG8_STAGE(PG8_SB(1, 0), b3, voffB); PG8_STAGE(PG8_SB(1, 1), b3 + hstep, voffB); PG8_STAGE(PG8_SA(1, 0), a3, sA0);
            PG8_WAIT_V(8); PG8_WAIT_L(0); PG8_BAR; PG8_MMA(1, 0, At, B0); PG8_MMA(1, 1, At, B1); PG8_BAR; PG8_SCHED;
            } else {
            PG8_LDB(B0, 0, 0); PG8_SCHED; PG8_LDA(At, 0, 0); PG8_STAGE(PG8_SA(1, 1), a1 + hstep, voffA);
            PG8_WAIT_L(8); PG8_BAR; PG8_WAIT_L(0); PG8_MMA(0, 0, At, B0); PG8_BAR; PG8_SCHED;
            PG8_LDB(B1, 0, 1); PG8_STAGE(PG8_SB(0, 0), b2, voffB);
            PG8_BAR; PG8_WAIT_L(0); PG8_MMA(0, 1, At, B1); PG8_BAR;
            PG8_LDA(At, 0, 1); PG8_STAGE(PG8_SA(0, 0), a2, voffA);
            PG8_BAR; PG8_WAIT_L(0); PG8_MMA(1, 0, At, B0); PG8_BAR; PG8_SCHED;
            PG8_STAGE(PG8_SB(0, 1), b2 + hstep, voffB);
            PG8_WAIT_V(6); PG8_BAR; PG8_MMA(1, 1, At, B1); PG8_BAR;
            PG8_LDB(B0, 1, 0); PG8_SCHED; PG8_LDA(At, 1, 0); PG8_STAGE(PG8_SA(0, 1), a2 + hstep, voffA);
            PG8_WAIT_L(8); PG8_BAR; PG8_WAIT_L(0); PG8_MMA(0, 0, At, B0); PG8_BAR; PG8_SCHED;
            PG8_LDB(B1, 1, 1); PG8_STAGE(PG8_SB(1, 0), b3, voffB);
            PG8_BAR; PG8_WAIT_L(0); PG8_MMA(0, 1, At, B1); PG8_BAR;
            PG8_LDA(At, 1, 1); PG8_STAGE(PG8_SA(1, 0), a3, voffA);
            PG8_BAR; PG8_WAIT_L(0); PG8_MMA(1, 0, At, B0); PG8_BAR; PG8_SCHED;
            PG8_STAGE(PG8_SB(1, 1), b3 + hstep, voffB);
            PG8_WAIT_V(6); PG8_BAR; PG8_MMA(1, 1, At, B1); PG8_BAR;
            }
        }
        if constexpr (ALIGN_EPI) { if (wr == 0) PG8_BAR; }
        if constexpr (FP8) {
#pragma unroll
            for (int a = 0; a < 2; ++a)
#pragma unroll
                for (int b = 0; b < 2; ++b)
#pragma unroll
                    for (int m = 0; m < 4; ++m)
#pragma unroll
                        for (int n = 0; n < 2; ++n)
#pragma unroll
                            for (int i = 0; i < 4; ++i) acc[a][b][m][n][i] = acc32[a][b][(m * 2 + n) * 4 + i]; }
        if constexpr (!Epi::AFTER_DRAIN) { E(acc, cur, wr, wc, fr, fq); S.done(cur); }
        if (!has_next) break;
#pragma unroll
        for (int a = 0; a < 2; ++a)
#pragma unroll
            for (int b = 0; b < 2; ++b)
#pragma unroll
                for (int m = 0; m < 4; ++m) {
#pragma unroll
                    for (int n = 0; n < 2; ++n) { acc[a][b][m][n] = (f32x4){0.f, 0.f, 0.f, 0.f};
#pragma unroll
                        for (int i = 0; i < 4; ++i) acc32[a][b][(m * 2 + n) * 4 + i] = 0.f; } }
        cur = nxt; cA = nA; cB = nB; ++ui;
#pragma unroll
        for (int i = 0; i < 2; ++i) { cvA0[i] = nvA0[i]; cvA1[i] = nvA1[i]; }
        if constexpr (ALIGN_EPI) { if (wr == 1) PG8_BAR; }
    }
    PG8_WAIT_V(0);
    if constexpr (!ALIGN_EPI) { if (wr == 0) PG8_BAR; }
    PG8_BAR;
    if constexpr (Epi::AFTER_DRAIN) { E.fused(acc, cur, wr, wc, fr, fq, lds, wid, lane); S.done(cur); }
#undef PG8_SA
#undef PG8_SB
#undef PG8_STAGE
#undef PG8_LDA
#undef PG8_LDB
#undef PG8_MMA
#undef PG8_CAT8
#undef PG8_W8
#undef PG8_WAIT_V
#undef PG8_WAIT_L
#undef PG8_BAR
#undef PG8_SCHED
}
}

namespace att {
constexpr int NW = 8, QBLK = 32, KVBLK = 64;
constexpr float THR = 8.f;
constexpr int SHM_V = KVBLK * 128 * 2, SHM_K = KVBLK * 64 * 2;
constexpr int SHM_ATTN = 2 * SHM_V + 2 * SHM_K + NW * 64 * 4;
#define KSWZ64(row, colB) ((row) * 128 + ((colB) ^ ((((row) >> 1) & 7) << 4)))
#define SBAR() __builtin_amdgcn_sched_barrier(0)
__device__ __forceinline__ int crow(int r, int hi) { return (r & 3) + 8 * (r >> 2) + 4 * hi; }

__device__ __forceinline__ void partialSM(f32x16& p0, f32x16& p1, float& m_reg, float& mn, float& alpha) {
  float pmax = p0[0];
#pragma unroll
  for (int r = 1; r < 16; ++r) pmax = fmaxf(pmax, p0[r]);
#pragma unroll
  for (int r = 0; r < 16; ++r) pmax = fmaxf(pmax, p1[r]);
  { auto rr = __builtin_amdgcn_permlane32_swap(__float_as_uint(pmax), __float_as_uint(pmax), false, false);
    pmax = fmaxf(__uint_as_float(rr[0]), __uint_as_float(rr[1])); }
  if (__builtin_expect(__all(pmax - m_reg <= THR), 1)) { mn = m_reg; alpha = 1.f; }
  else { mn = fmaxf(m_reg, pmax); alpha = __builtin_amdgcn_exp2f(m_reg - mn); m_reg = mn; }
#pragma unroll
  for (int r = 0; r < 16; ++r) p0[r] = p0[r] - mn;
#pragma unroll
  for (int r = 0; r < 16; ++r) p1[r] = p1[r] - mn;
#pragma unroll
  for (int r = 0; r < 16; ++r) p0[r] = __builtin_amdgcn_exp2f(p0[r]);
}
__device__ __forceinline__ void finishSM(f32x16& p0, f32x16& p1, float alpha, float& l_reg, bf16x8& pa0, bf16x8& pa1, bf16x8& pa2, bf16x8& pa3) {
#pragma unroll
  for (int r = 0; r < 16; ++r) p1[r] = __builtin_amdgcn_exp2f(p1[r]);
  float ps = 0;
#pragma unroll
  for (int r = 0; r < 16; ++r) ps += p0[r];
#pragma unroll
  for (int r = 0; r < 16; ++r) ps += p1[r];
  { auto rr = __builtin_amdgcn_permlane32_swap(__float_as_uint(ps), __float_as_uint(ps), false, false);
    ps = __uint_as_float(rr[0]) + __uint_as_float(rr[1]); }
  l_reg = l_reg * alpha + ps;
#define PK4(P, BASE, OUT) do { unsigned a0 = cvtpk(P[BASE + 0], P[BASE + 1]), a1 = cvtpk(P[BASE + 2], P[BASE + 3]);   \
    unsigned b0 = cvtpk(P[BASE + 4], P[BASE + 5]), b1 = cvtpk(P[BASE + 6], P[BASE + 7]);                              \
    auto r0 = __builtin_amdgcn_permlane32_swap(a0, b0, false, false); auto r1 = __builtin_amdgcn_permlane32_swap(a1, b1, false, false); \
    u32x4 w = {r0[0], r1[0], r0[1], r1[1]}; OUT = __builtin_bit_cast(bf16x8, w); } while (0)
  PK4(p0, 0, pa0); PK4(p0, 8, pa1); PK4(p1, 0, pa2); PK4(p1, 8, pa3);
#undef PK4
}
__device__ __forceinline__ void qkt(f32x16& p0, f32x16& p1, const char* Ks, const bf16x8* qr, int r32, int hi) {
  p0 = f32x16{}; p1 = f32x16{};
#pragma unroll
  for (int d0 = 0; d0 < 4; ++d0) { const int cb = (d0 * 16 + hi * 8) * 2;
    bf16x8 b0 = *reinterpret_cast<const bf16x8*>(Ks + KSWZ64(r32, cb));
    bf16x8 b1 = *reinterpret_cast<const bf16x8*>(Ks + KSWZ64(32 + r32, cb));
    p0 = __builtin_amdgcn_mfma_f32_32x32x16_bf16(b0, qr[d0], p0, 0, 0, 0);
    p1 = __builtin_amdgcn_mfma_f32_32x32x16_bf16(b1, qr[d0], p1, 0, 0, 0); }
}
__device__ __forceinline__ int v_st(int k, int c) { const int kk = (k & ~0xC) | ((k & 4) << 1) | ((k & 8) >> 1); return ((kk >> 3) * 4 + (c >> 5)) * 512 + ((kk & 7) * 32 + (c & 31)) * 2; }
__device__ __forceinline__ int v_rd_base(int lane) { return ((lane & 3) << 3) | (((lane >> 2) & 3) << 6) | (((lane >> 4) & 1) << 5) | (((lane >> 5) & 1) << 8); }
constexpr int v_rd_off(int d0, int ks, int half) { return d0 * 512 + ks * 4096 + half * 2048; }
template <int OFF> __device__ __forceinline__ s16x4 tr_read(int vb) {
  s16x4 r; asm volatile("ds_read_b64_tr_b16 %0, %1 offset:%2" : "=&v"(r) : "v"(vb), "i"(OFF) : "memory"); return r;
}
template <int D0> __device__ __forceinline__ void pv_one(f32x16& od, int vb, bf16x8 pa0, bf16x8 pa1, bf16x8 pa2, bf16x8 pa3) {
  const s16x4 l0 = tr_read<v_rd_off(D0, 0, 0)>(vb), h0 = tr_read<v_rd_off(D0, 0, 1)>(vb), l1 = tr_read<v_rd_off(D0, 1, 0)>(vb), h1 = tr_read<v_rd_off(D0, 1, 1)>(vb);
  const s16x4 l2 = tr_read<v_rd_off(D0, 2, 0)>(vb), h2 = tr_read<v_rd_off(D0, 2, 1)>(vb), l3 = tr_read<v_rd_off(D0, 3, 0)>(vb), h3 = tr_read<v_rd_off(D0, 3, 1)>(vb);
  asm volatile("s_waitcnt lgkmcnt(0)" ::: "memory"); SBAR();
#define PK(L, H) (bf16x8){L[0], L[1], L[2], L[3], H[0], H[1], H[2], H[3]}
  od = __builtin_amdgcn_mfma_f32_32x32x16_bf16(pa0, PK(l0, h0), od, 0, 0, 0);
  od = __builtin_amdgcn_mfma_f32_32x32x16_bf16(pa1, PK(l1, h1), od, 0, 0, 0);
  od = __builtin_amdgcn_mfma_f32_32x32x16_bf16(pa2, PK(l2, h2), od, 0, 0, 0);
  od = __builtin_amdgcn_mfma_f32_32x32x16_bf16(pa3, PK(l3, h3), od, 0, 0, 0);
#undef PK
}
__device__ __forceinline__ void pv_d0(f32x16* o, int vb, bf16x8 pa0, bf16x8 pa1, bf16x8 pa2, bf16x8 pa3) {
  pv_one<0>(o[0], vb, pa0, pa1, pa2, pa3); pv_one<1>(o[1], vb, pa0, pa1, pa2, pa3); pv_one<2>(o[2], vb, pa0, pa1, pa2, pa3); pv_one<3>(o[3], vb, pa0, pa1, pa2, pa3);
}

template <int LDQ>
__device__ __forceinline__ void attn_unit(const bf16_t* __restrict__ Qb, const bf16_t* __restrict__ Kh, const bf16_t* __restrict__ Vh, bf16_t* __restrict__ Ob, int seq, char* lds) {
  const int tid = threadIdx.x, wid = tid >> 6, lane = tid & 63, r32 = lane & 31, hi = lane >> 5;
  char* V_lds = lds; char* K_lds = lds + 2 * SHM_V;
  float* ws = (float*)(lds + 2 * SHM_V + 2 * SHM_K) + wid * 64; float* li_l = ws; float* al_l = ws + 32;
  float m_reg = -1e30f, l_reg = 0; f32x16 o[4] = {}; bf16x8 qr[4];
  const bf16_t* Qw = Qb + (long)(wid * QBLK + r32) * LDQ + hi * 8;
#pragma unroll
  for (int d0 = 0; d0 < 4; ++d0) qr[d0] = *reinterpret_cast<const bf16x8*>(Qw + d0 * 16);
  const int sr = tid >> 4, sc = (tid & 15) * 8, vst0 = v_st(sr, sc), vst1 = v_st(32 + sr, sc);
  const int kr = tid >> 3, kc8 = (tid & 7) * 8, kst = KSWZ64(kr, kc8 * 2);
  const int vb0 = (int)(uintptr_t)V_lds + v_rd_base(lane);
  struct { bf16x8 vs0, vs1, ks; } sr_[2];
  const bf16_t* Vp0 = Vh + (long)sr * LDQ + sc; const bf16_t* Kp0 = Kh + (long)kr * LDQ + kc8;
#define SLOAD(i, k0) do { const long ko_ = (long)(k0) * LDQ; sr_[i].vs0 = *reinterpret_cast<const bf16x8*>(Vp0 + ko_); sr_[i].vs1 = *reinterpret_cast<const bf16x8*>(Vp0 + ko_ + 32 * LDQ); \
    sr_[i].ks = *reinterpret_cast<const bf16x8*>(Kp0 + ko_); } while (0)
#define SWRITE(b, i) do { *(bf16x8*)(V_lds + (b) * SHM_V + vst0) = sr_[i].vs0; *(bf16x8*)(V_lds + (b) * SHM_V + vst1) = sr_[i].vs1; \
    *(bf16x8*)(K_lds + (b) * SHM_K + kst) = sr_[i].ks; } while (0)
#define SWAIT() asm volatile("s_waitcnt vmcnt(3)" ::: "memory")
#define RESC(a) do { if (__any((a) < 1.f)) { if (hi == 0) al_l[r32] = (a); asm volatile("s_waitcnt lgkmcnt(0)" ::: "memory"); \
    _Pragma("unroll") for (int d = 0; d < 4; ++d) _Pragma("unroll") for (int r = 0; r < 16; ++r) o[d][r] *= al_l[crow(r, hi)]; } } while (0)
  f32x16 pA0, pA1, pB0, pB1; float mnA, mnB, alA, alB; bf16x8 pa0, pa1, pa2, pa3; const int NT = seq / KVBLK;
  constexpr int SE = 0, SO = 1;
  SLOAD(SE, 0); asm volatile("s_waitcnt vmcnt(0)" ::: "memory"); SWRITE(0, SE); __syncthreads();
  qkt(pA0, pA1, K_lds, qr, r32, hi); partialSM(pA0, pA1, m_reg, mnA, alA);
  SLOAD(SO, KVBLK); if (2 < NT) SLOAD(SE, 2 * KVBLK);
  SWAIT(); SWRITE(1, SO); __syncthreads();
  for (int j = 1; j + 1 < NT; j += 2) {
    SBAR(); qkt(pB0, pB1, K_lds + SHM_K, qr, r32, hi);
    finishSM(pA0, pA1, alA, l_reg, pa0, pa1, pa2, pa3); SBAR();
    SLOAD(SO, (j + 2) * KVBLK); SBAR();
    pv_d0(o, vb0, pa0, pa1, pa2, pa3); partialSM(pB0, pB1, m_reg, mnB, alB);
    __syncthreads(); SWAIT(); SWRITE(0, SE);
    RESC(alB); __syncthreads();
    SBAR(); qkt(pA0, pA1, K_lds, qr, r32, hi);
    finishSM(pB0, pB1, alB, l_reg, pa0, pa1, pa2, pa3); SBAR();
    if (j + 3 < NT) SLOAD(SE, (j + 3) * KVBLK); SBAR();
    pv_d0(o, vb0 + SHM_V, pa0, pa1, pa2, pa3); partialSM(pA0, pA1, m_reg, mnA, alA);
    __syncthreads(); SWAIT(); SWRITE(1, SO);
    RESC(alA); __syncthreads();
  }
  SBAR(); qkt(pB0, pB1, K_lds + SHM_K, qr, r32, hi);
  finishSM(pA0, pA1, alA, l_reg, pa0, pa1, pa2, pa3); SBAR();
  pv_d0(o, vb0, pa0, pa1, pa2, pa3); partialSM(pB0, pB1, m_reg, mnB, alB);
  __syncthreads(); RESC(alB);
  finishSM(pB0, pB1, alB, l_reg, pa0, pa1, pa2, pa3); SBAR();
  pv_d0(o, vb0 + SHM_V, pa0, pa1, pa2, pa3);
  if (hi == 0) li_l[r32] = l_reg; asm volatile("s_waitcnt lgkmcnt(0)" ::: "memory");
  float rli[16];
#pragma unroll
  for (int r = 0; r < 16; ++r) rli[r] = __builtin_amdgcn_rcpf(li_l[crow(r, hi)]);
  bf16_t* Ow = Ob + (long)(wid * QBLK) * 1024;
#pragma unroll
  for (int r = 0; r < 16; ++r) { const int orow = crow(r, hi);
#pragma unroll
    for (int d0 = 0; d0 < 4; ++d0) Ow[(long)orow * 1024 + d0 * 32 + r32] = (bf16_t)(cvtpk(o[d0][r] * rli[r], 0.f) & 0xffffu); }
  __syncthreads();
#undef SLOAD
#undef SWRITE
#undef SWAIT
#undef RESC
}
#undef SBAR
}


typedef GAS unsigned gu32;
#define RLX_AGENT __ATOMIC_RELAXED, __HIP_MEMORY_SCOPE_AGENT
#define XB_TMO      128
#define XB_XCNT(j)  (256  + 64 * (j))
#define XB_XSUB(j)  (1280 + 64 * (j))
#define XB_XGEN(j)  (2304 + 64 * (j))
#define XB_TOP      3328
#define XB_TOPGEN   3392
#define XCD_BAR_WORDS 3456
#define XB_SPIN_CAP (1u << 22)
__device__ __forceinline__ unsigned xb_ld(unsigned* p)              { return __hip_atomic_load(p, __ATOMIC_RELAXED, __HIP_MEMORY_SCOPE_AGENT); }
__device__ __forceinline__ unsigned xb_add(unsigned* p, unsigned v) { return __hip_atomic_fetch_add(p, v, __ATOMIC_RELAXED, __HIP_MEMORY_SCOPE_AGENT); }
__device__ __forceinline__ unsigned xb_xcc_id() { return (unsigned)__builtin_amdgcn_s_getreg((3 << 11) | 20) & 0xFu; }
#define XB_SPIN(cond, bar) do { unsigned _sp = 0; while (cond) { __builtin_amdgcn_s_sleep(1); \
    if ((++_sp & 255u) == 0u) { if (xb_ld(&(bar)[XB_TMO])) break; if (_sp > XB_SPIN_CAP) { atomicAdd(&(bar)[XB_TMO], 1u); break; } } } } while (0)
struct XcdBarrier { unsigned* bar; unsigned x; volatile LAS unsigned* st; };
__device__ __forceinline__ XcdBarrier xcd_barrier_post(unsigned* bar, volatile LAS unsigned* st) {
    XcdBarrier b; b.bar = bar; b.x = xb_xcc_id(); b.st = st;
    if (threadIdx.x == 0) (void)xb_add(&bar[XB_XCNT(b.x)], 1u);
    return b;
}
__device__ __forceinline__ void xcd_barrier_complete(unsigned* bar, unsigned x, unsigned& nloc, unsigned& nx) {
    const unsigned G = gridDim.x * gridDim.y * gridDim.z;
    unsigned sum, cnt, mine, sp = 0u;
    for (;;) {
        sum = 0u; cnt = 0u; mine = 0u;
#pragma unroll
        for (unsigned j = 0; j < 16; ++j) { const unsigned c = xb_ld(&bar[XB_XCNT(j)]); sum += c; cnt += (c > 0u) ? 1u : 0u; mine = (j == x) ? c : mine; }
        if (sum == G) break;
        __builtin_amdgcn_s_sleep(1);
        if ((++sp & 255u) == 0u) { if (xb_ld(&bar[XB_TMO])) break; if (sp > XB_SPIN_CAP) { atomicAdd(&bar[XB_TMO], 1u); break; } }
    }
    nloc = mine > 0u ? mine : 1u; nx = cnt > 0u ? cnt : 1u;
}
__device__ __forceinline__ void xcd_barrier(const XcdBarrier& b) {
    asm volatile("s_waitcnt vmcnt(0)" ::: "memory");
    __syncthreads();
    if (threadIdx.x == 0) {
        unsigned* bar = b.bar;
        __builtin_amdgcn_s_waitcnt(0);
        unsigned nloc = b.st[0], nx = b.st[1];
        if (nloc == 0u) { xcd_barrier_complete(bar, b.x, nloc, nx); b.st[0] = nloc; b.st[1] = nx; }
        const unsigned old = xb_add(&bar[XB_XSUB(b.x)], 1u);
        const unsigned gen = old / nloc;
        if (old + 1u == (gen + 1u) * nloc) {
            __builtin_amdgcn_fence(__ATOMIC_RELEASE, "agent");
            asm volatile("s_waitcnt vmcnt(0)" ::: "memory");
            const unsigned og = xb_add(&bar[XB_TOP], 1u);
            const unsigned tg = og / nx;
            if (og + 1u == (tg + 1u) * nx) xb_add(&bar[XB_TOPGEN], 1u);
            else XB_SPIN(xb_ld(&bar[XB_TOPGEN]) == tg, bar);
            __builtin_amdgcn_fence(__ATOMIC_ACQUIRE, "agent");
            xb_add(&bar[XB_XGEN(b.x)], 1u);
            asm volatile("s_waitcnt vmcnt(0)" ::: "memory");
        } else {
            XB_SPIN(xb_ld(&bar[XB_XGEN(b.x)]) == gen, bar);
            __builtin_amdgcn_fence(__ATOMIC_ACQUIRE, "agent");
            asm volatile("s_waitcnt vmcnt(0)" ::: "memory");
        }
    }
    __syncthreads();
}

struct Frame {
    LAS unsigned char* lds; char* ldsg;
    int tid, lane, wave, vcu, G;
    const Args* a;
};
#define INP(F, i, T) ((const T*)(F).a->in[i])
#define WSP(F, off, T) ((T*)((F).a->ws + (off)))

__device__ __forceinline__ void cvt_load(f32x4 (&v)[16], const float* __restrict__ W, int N, int nvalid, int k0, int n0, int lane) {
    const int kq = lane >> 4, nq = lane & 15;
    const unsigned voff = (unsigned)(kq * N + 4 * nq) * 4u;
#pragma unroll
    for (int i = 0; i < 16; ++i) {
        const char* Wu = (const char*)(W + (size_t)(k0 + 4 * i) * N + n0);
        if (4 * nq < nvalid) v[i] = __builtin_nontemporal_load((const f32x4*)(Wu + (size_t)voff)); else v[i] = (f32x4){0.f, 0.f, 0.f, 0.f};
    }
}
__device__ __forceinline__ void cvt_finish(const f32x4 (&v)[16], int k0, bf16_t* __restrict__ WT, int rowb, LAS unsigned char* scr, int lane) {
    const int kq = lane >> 4, nq = lane & 15;
    const int g = lane >> 4, i16 = lane & 15, q = i16 >> 2, p = i16 & 3;
    typedef short v4i16_t __attribute__((ext_vector_type(4)));
#pragma unroll
    for (int hf = 0; hf < 2; ++hf) {
#pragma unroll
        for (int i = 0; i < 8; ++i) {
            const int k = 4 * i + kq, s = ((k >> 1) & 1) | (((k >> 3) & 1) << 1);
            u32x2 w; w.x = cvtpk(v[8 * hf + i].x, v[8 * hf + i].y); w.y = cvtpk(v[8 * hf + i].z, v[8 * hf + i].w);
            *(LAS u32x2*)(scr + k * 128 + ((nq * 8) ^ (s << 5))) = w;
        }
        const int klo = 8 * g + q, s = ((klo >> 1) & 1) | (((klo >> 3) & 1) << 1);
#pragma unroll
        for (int nb = 0; nb < 4; ++nb) {
            const int a_lo = klo * 128 + (((16 * nb + 4 * p) * 2) ^ (s << 5));
            const s16x4 lo = __builtin_bit_cast(s16x4, __builtin_amdgcn_ds_read_tr16_b64_v4i16((LAS v4i16_t*)(scr + a_lo)));
            const s16x4 hi = __builtin_bit_cast(s16x4, __builtin_amdgcn_ds_read_tr16_b64_v4i16((LAS v4i16_t*)(scr + a_lo + 512)));
            bf16x8 o = {lo[0], lo[1], lo[2], lo[3], hi[0], hi[1], hi[2], hi[3]};
            char* Wu = (char*)(WT + (size_t)(rowb + 16 * nb) * 2048 + k0 + 32 * hf);
            __builtin_nontemporal_store(o, (bf16x8*)(Wu + (size_t)(unsigned)((i16 * 2048 + 8 * g) * 2)));
        }
    }
}
__device__ __forceinline__ void cvt8_load(f32x4 (&v)[16], const float* __restrict__ W, int k0, int n0, int lane) {
    const int kq = lane >> 4, nq = lane & 15;
    const unsigned voff = (unsigned)(16 * kq * 2048 + 4 * nq) * 4u;
#pragma unroll
    for (int i = 0; i < 16; ++i) {
        const char* Wu = (const char*)(W + (size_t)(k0 + i) * 2048 + n0);
        v[i] = __builtin_nontemporal_load((const f32x4*)(Wu + (size_t)voff));
    }
}
__device__ __forceinline__ void cvt8_finish(const f32x4 (&v)[16], int k0, unsigned char* __restrict__ W8, int rowb, int lane) {
    const int kq = lane >> 4, nq = lane & 15;
    char* Wu = (char*)(W8 + (size_t)rowb * 2048 + k0);
    const unsigned voff = (unsigned)(4 * nq * 2048 + 16 * kq);
#pragma unroll
    for (int j = 0; j < 4; ++j) {
        u32x4 o;
#pragma unroll
        for (int q = 0; q < 4; ++q) {
            int w = __builtin_amdgcn_cvt_pk_fp8_f32(v[4 * q][j] * pg8::W8_SCALE, v[4 * q + 1][j] * pg8::W8_SCALE, 0, false);
            w = __builtin_amdgcn_cvt_pk_fp8_f32(v[4 * q + 2][j] * pg8::W8_SCALE, v[4 * q + 3][j] * pg8::W8_SCALE, w, true);
            o[q] = (unsigned)w;
        }
        __builtin_nontemporal_store(o, (u32x4*)(Wu + (size_t)(voff + (unsigned)(j * 2048))));
    }
}
__device__ __forceinline__ void cvt_expert_decode(const Frame& F, int r, const float*& W, int& k0, int& n0, unsigned char*& WT, int& rowb) {
    constexpr int I_E = 16 * 32 * 32;
    const int mat = r / I_E; r -= mat * I_E;
    const int e = r >> 10, kt = (r >> 5) & 31, nt = r & 31;
    k0 = kt * 64; n0 = nt * 64;
    if (mat < 2) { W = INP(F, 24 + mat, float) + (size_t)e * 2048 * 2048; WT = WSP(F, WS_WGU, unsigned char); rowb = e * 4096 + (n0 >> 7) * 256 + mat * 128 + (n0 & 127); }
    else { W = INP(F, 26, float) + (size_t)e * 2048 * 2048; WT = WSP(F, WS_WD, unsigned char); rowb = e * 2048 + n0; }
}
constexpr int N_EXPERT_ITEMS = 3 * 16 * 32 * 32;
__device__ __forceinline__ void p0_prologue(Frame& F) {
    LAS unsigned char* scr = F.lds + F.wave * 4096;
    const int gw = F.vcu * 8 + F.wave, NGW = F.G * 8, lane = F.lane;
    const float* w_in = INP(F, 3, float); const float* w_out = INP(F, 21, float);
    bf16_t* WinT = WSP(F, WS_WIN, bf16_t); bf16_t* WoutT = WSP(F, WS_WOUT, bf16_t);
    constexpr int I_IN = 32 * 101, I_OUT = 32 * 32, NITEMS = I_IN + I_OUT;
    for (int it = gw; it < NITEMS; it += NGW) {
        f32x4 v[16];
        if (it < I_IN) { const int kt = it / 101, nt = it % 101; const int nv = (nt == 100) ? 32 : 64; cvt_load(v, w_in, IN_COLS, nv, kt * 64, nt * 64, lane); cvt_finish(v, kt * 64, WinT, nt * 64, scr, lane); }
        else { const int r = it - I_IN, kt = r >> 5, nt = r & 31; cvt_load(v, w_out, 2048, 64, kt * 64, nt * 64, lane); cvt_finish(v, kt * 64, WoutT, nt * 64, scr, lane); }
    }
#if !CVT_IN_SCAN
    for (int it = gw; it < N_EXPERT_ITEMS; it += NGW) {
        f32x4 v[16]; const float* W; int k0, n0, rowb; unsigned char* WT;
        cvt_expert_decode(F, it, W, k0, n0, WT, rowb); cvt8_load(v, W, k0, n0, lane); cvt8_finish(v, k0, WT, rowb, lane);
    }
#endif
    { u32x4 z = {0u, 0u, 0u, 0u}; u32x4* zp = (u32x4*)(WinT + (size_t)6464 * 2048); const int nz = 192 * 2048 * 2 / 16;
      for (int i = gw * 64 + lane; i < nz; i += NGW * 64) zp[i] = z; }
    { const float* x = INP(F, 0, float); const float* nw = INP(F, 2, float); bf16_t* H1 = WSP(F, WS_H1, bf16_t);
      for (int m = gw; m < MTOK; m += NGW) {
          const f32x4* xr = (const f32x4*)(x + (size_t)m * DM) + lane; f32x4 v[8]; float s = 0.f;
#pragma unroll
          for (int j = 0; j < 8; ++j) { v[j] = xr[64 * j]; s += (v[j].x * v[j].x + v[j].y * v[j].y) + (v[j].z * v[j].z + v[j].w * v[j].w); }
          const float rstd = 1.f / sqrtf(wave_sum(s) * (1.f / DM) + 1e-6f);
          u32x2* o8 = (u32x2*)(H1 + (size_t)m * DM) + lane;
#pragma unroll
          for (int j = 0; j < 8; ++j) { const f32x4 w = ((const f32x4*)nw)[lane + 64 * j]; u32x2 o; o.x = cvtpk(v[j].x * rstd * w.x, v[j].y * rstd * w.y); o.y = cvtpk(v[j].z * rstd * w.z, v[j].w * rstd * w.w); o8[64 * j] = o; }
      } }
    { const float* dup = INP(F, 12, float); const float* iup = INP(F, 14, float); const float* gup = INP(F, 15, float);
      bf16_t* DUt = WSP(F, WS_LORA, bf16_t); bf16_t* IUt = DUt + 2 * 1024 * 64; bf16_t* GUt = IUt + 2 * 1024 * 64;
      for (int i = gw * 64 + lane; i < 2 * 1024 * 64; i += NGW * 64) { const int j = i & 63, c = (i >> 6) & 1023, d = i >> 16;
          DUt[i] = (bf16_t)(cvtpk(dup[(size_t)(d * 64 + j) * 1024 + c], 0.f) & 0xffffu); IUt[i] = (bf16_t)(cvtpk(iup[(size_t)(d * 64 + j) * 1024 + c], 0.f) & 0xffffu); }
      for (int i = gw * 64 + lane; i < 1024 * 160; i += NGW * 64) { const int c = i / 160, j = i - c * 160; GUt[i] = (bf16_t)(cvtpk(gup[(size_t)j * 1024 + c], 0.f) & 0xffffu); } }
    { const int* pos = INP(F, 1, int); float* rope = WSP(F, WS_ROPE, float);
      const float invf[8] = {1.0f, 0.19392274474868576f, 0.03760603093086393f, 0.007292664737217109f, 0.001414213562373095f, 0.0002742481756762073f, 5.318295896944988e-05f, 1.031338537721246e-05f};
      for (int i = gw * 64 + lane; i < MTOK * 8; i += NGW * 64) { const int m = i >> 3, j = i & 7; float fj = invf[0];
#pragma unroll
          for (int q = 1; q < 8; ++q) fj = (j == q) ? invf[q] : fj;
          const float ang = (float)pos[m] * fj; rope[m * 16 + j] = cosf(ang); rope[m * 16 + 8 + j] = sinf(ang); } }
}

#define WS32(F, T, byteoff) (*(T*)((F).a->ws + (size_t)(unsigned)(byteoff)))
template <int CTRL> __device__ __forceinline__ float dpp_add(float x) {
    return x + __int_as_float(__builtin_amdgcn_update_dpp(0, __float_as_int(x), CTRL, 0xf, 0xf, false));
}
__device__ __forceinline__ float row16_allsum(float x) { x = dpp_add<0x128>(x); x = dpp_add<0x124>(x); x = dpp_add<0x122>(x); x = dpp_add<0x121>(x); return x; }
__device__ __forceinline__ bf16_t f2bf(float x) { return (bf16_t)(cvtpk(x, 0.f) & 0xffffu); }
__device__ __forceinline__ u32x4 ld_row16(const Frame& F, unsigned off, bool ok) { u32x4 r = {0u, 0u, 0u, 0u}; if (ok) r = WS32(F, const u32x4, off); return r; }
__device__ __forceinline__ void unpack8(const u32x4 w, float (&o)[8]) { o[0] = bf_lo(w.x); o[1] = bf_hi(w.x); o[2] = bf_lo(w.y); o[3] = bf_hi(w.y); o[4] = bf_lo(w.z); o[5] = bf_hi(w.z); o[6] = bf_lo(w.w); o[7] = bf_hi(w.w); }
__device__ __forceinline__ void ld8f(const float* p, float (&o)[8]) { const f32x4 a = ((const f32x4*)p)[0], b = ((const f32x4*)p)[1]; o[0] = a.x; o[1] = a.y; o[2] = a.z; o[3] = a.w; o[4] = b.x; o[5] = b.y; o[6] = b.z; o[7] = b.w; }
__device__ __forceinline__ u32x4 pack8(const float (&v)[8]) { return (u32x4){cvtpk(v[0], v[1]), cvtpk(v[2], v[3]), cvtpk(v[4], v[5]), cvtpk(v[6], v[7])}; }
__device__ __forceinline__ void p3_prep(Frame& F, const int mode = 0) {
    constexpr int AP = 296;
    constexpr int PP = 264, PA = 16 * PP, PT = 5 * PA;
    LAS bf16_t* Al = (LAS bf16_t*)F.lds;
    LAS bf16_t* Pl = (LAS bf16_t*)(F.lds + 18944);
    LAS float* Zr = (LAS float*)(F.lds + 18944);
    LAS float* Zl = (LAS float*)(F.lds + 18944 + 20736);
    const int tid = F.tid, lane = F.lane, w = F.wave;
    const bf16_t* DUt = WSP(F, WS_LORA, bf16_t); const bf16_t* IUt = DUt + 2 * 1024 * 64; const bf16_t* GUt = IUt + 2 * 1024 * 64;
    for (int item = F.vcu; item < MTOK / 32; item += F.G) {
        __syncthreads();
#pragma unroll 1
        for (int tl = 0; tl < 2; ++tl) {
            const int m0 = item * 32 + tl * 16, t0 = m0 & (SEQ - 1);
            for (int p = tid; p < 18 * 36; p += 512) {
                const int rr = p / 36, ch = p - rr * 36, t = t0 + rr - 1, m = m0 + rr - 1;
                f32x4 a0 = {0.f, 0.f, 0.f, 0.f}, a1 = a0;
                if (t >= 0 && t < SEQ) {
                    const bf16_t* pp = WSP(F, WS_PART, bf16_t) + (((size_t)((ch >> 5) * 32 + (m >> 8)) * 4) << 16) + (size_t)(m & 255) * 256 + ((8 * ch) & 255);
                    u32x4 q[4];
#pragma unroll
                    for (int k = 0; k < 4; ++k) q[k] = *(const u32x4*)(pp + ((size_t)k << 16));
#pragma unroll
                    for (int k = 0; k < 4; ++k) { a0 += (f32x4){bf_lo(q[k].x), bf_hi(q[k].x), bf_lo(q[k].y), bf_hi(q[k].y)}; a1 += (f32x4){bf_lo(q[k].z), bf_hi(q[k].z), bf_lo(q[k].w), bf_hi(q[k].w)}; }
                }
                LAS f32x4* zp = (LAS f32x4*)(Zr + rr * 288 + 8 * ch); zp[0] = a0; zp[1] = a1;
            }
            __syncthreads();
            for (int p = tid; p < 16 * 36; p += 512) {
                const int i = p / 36, ch = p - i * 36, zc = 3072 + 8 * ch;
                float c[8], pv[8], nx[8], mp[8], mn[8];
                { const LAS f32x4* q = (const LAS f32x4*)(Zr + i * 288 + 8 * ch); const f32x4 x0 = q[0], x1 = q[1], y0 = q[72], y1 = q[73], w0 = q[144], w1 = q[145];
                  pv[0] = x0.x; pv[1] = x0.y; pv[2] = x0.z; pv[3] = x0.w; pv[4] = x1.x; pv[5] = x1.y; pv[6] = x1.z; pv[7] = x1.w;
                  c[0] = y0.x; c[1] = y0.y; c[2] = y0.z; c[3] = y0.w; c[4] = y1.x; c[5] = y1.y; c[6] = y1.z; c[7] = y1.w;
                  nx[0] = w0.x; nx[1] = w0.y; nx[2] = w0.z; nx[3] = w0.w; nx[4] = w1.x; nx[5] = w1.y; nx[6] = w1.z; nx[7] = w1.w; }
                ld8f(INP(F, 4, float) + zc, mp); ld8f(INP(F, 5, float) + zc, mn);
                LAS f32x4* zp = (LAS f32x4*)(Zl + i * 288 + 8 * ch); float z[8];
#pragma unroll
                for (int e = 0; e < 8; ++e) z[e] = c[e] + mp[e] * (pv[e] - c[e]) + mn[e] * (nx[e] - c[e]);
                zp[0] = (f32x4){z[0], z[1], z[2], z[3]}; zp[1] = (f32x4){z[4], z[5], z[6], z[7]};
            }
            __syncthreads();
            for (int e = tid; e < 16 * 288; e += 512) { const int i = e / 288, j = e - i * 288; float z = Zl[e];
                if (j < 64) z = 1.f - 2.f * __builtin_amdgcn_rcpf(__expf(2.f * z) + 1.f); else if (j >= 128) z = __builtin_amdgcn_rcpf(1.f + __expf(-z));
                Al[tl * 16 * AP + i * AP + j] = f2bf(z); }
        }
        __syncthreads();
        if (mode == 1) continue;
        const int chk = tid & 31, pidx = tid >> 5, tb = pidx >> 3, tp = pidx & 7;
        const int m0t = item * 32 + tb * 16, t0t = m0t & (SEQ - 1);
#pragma unroll 1
        for (int qi = 0; qi < 4; ++qi) {
            const int q = (qi + (F.vcu >> 2)) & 3;
            u32x4 rawr[4], rawk[4], rawv[4];
            { const unsigned off = (unsigned)WS_PROJ + ((unsigned)(m0t + 2 * tp) * LDP + ZC0 + 256 * q + 8 * chk) * 2u;
#pragma unroll
              for (int rr = 0; rr < 4; ++rr) { const int t = t0t + 2 * tp + rr - 1; const bool ok = (t >= 0) && (t < SEQ); const unsigned o = off + (unsigned)((rr - 1) * LDP * 2);
                  rawr[rr] = ld_row16(F, o, ok); rawk[rr] = ld_row16(F, o + 1024u * 2u, ok); rawv[rr] = ld_row16(F, o + 2048u * 2u, ok); } }
            {
                const int n16 = lane & 15, q4 = lane >> 4;
                struct BF { bf16x8 d0[2], d1[2], i0[2], i1[2], g[5]; };
#define LD_BF(X, nb_) do { const int cl_ = 256 * q + 32 * w + 16 * (nb_) + n16; _Pragma("unroll") for (int ks = 0; ks < 2; ++ks) { \
                    X.d0[ks] = *(const bf16x8*)(DUt + (size_t)cl_ * 64 + 32 * ks + 8 * q4); X.d1[ks] = *(const bf16x8*)(DUt + (size_t)(1024 + cl_) * 64 + 32 * ks + 8 * q4); \
                    X.i0[ks] = *(const bf16x8*)(IUt + (size_t)cl_ * 64 + 32 * ks + 8 * q4); X.i1[ks] = *(const bf16x8*)(IUt + (size_t)(1024 + cl_) * 64 + 32 * ks + 8 * q4); } \
                    _Pragma("unroll") for (int ks = 0; ks < 5; ++ks) X.g[ks] = *(const bf16x8*)(GUt + (size_t)cl_ * 160 + 32 * ks + 8 * q4); } while (0)
#define DO_NB(X, nb_, tl_) do { const int ch_ = 32 * w + 16 * (nb_); \
                    f32x4 aw0 = {0.f, 0.f, 0.f, 0.f}, aw1 = aw0, aa0 = aw0, aa1 = aw0, ag = aw0; \
                    _Pragma("unroll") for (int ks = 0; ks < 2; ++ks) { \
                        aw0 = __builtin_amdgcn_mfma_f32_16x16x32_bf16(X.d0[ks], af[ks], aw0, 0, 0, 0); aw1 = __builtin_amdgcn_mfma_f32_16x16x32_bf16(X.d1[ks], af[ks], aw1, 0, 0, 0); \
                        aa0 = __builtin_amdgcn_mfma_f32_16x16x32_bf16(X.i0[ks], af[2 + ks], aa0, 0, 0, 0); aa1 = __builtin_amdgcn_mfma_f32_16x16x32_bf16(X.i1[ks], af[2 + ks], aa1, 0, 0, 0); } \
                    _Pragma("unroll") for (int ks = 0; ks < 5; ++ks) ag = __builtin_amdgcn_mfma_f32_16x16x32_bf16(X.g[ks], af[4 + ks], ag, 0, 0, 0); \
                    LAS bf16_t* pp = Pl + (tl_) * PT + n16 * PP + ch_ + 4 * q4; \
                    *(LAS u32x2*)(pp) = (u32x2){cvtpk(aw0[0], aw0[1]), cvtpk(aw0[2], aw0[3])}; *(LAS u32x2*)(pp + PA) = (u32x2){cvtpk(aw1[0], aw1[1]), cvtpk(aw1[2], aw1[3])}; \
                    *(LAS u32x2*)(pp + 2 * PA) = (u32x2){cvtpk(aa0[0], aa0[1]), cvtpk(aa0[2], aa0[3])}; *(LAS u32x2*)(pp + 3 * PA) = (u32x2){cvtpk(aa1[0], aa1[1]), cvtpk(aa1[2], aa1[3])}; \
                    *(LAS u32x2*)(pp + 4 * PA) = (u32x2){cvtpk(ag[0], ag[1]), cvtpk(ag[2], ag[3])}; } while (0)
                BF fa, fb; LD_BF(fa, 0); LD_BF(fb, 1);
#pragma unroll
                for (int tl = 0; tl < 2; ++tl) {
                    bf16x8 af[9];
#pragma unroll
                    for (int ks = 0; ks < 9; ++ks) af[ks] = *(const LAS bf16x8*)(Al + tl * 16 * AP + n16 * AP + 32 * ks + 8 * q4);
                    DO_NB(fa, 0, tl); DO_NB(fb, 1, tl);
                }
#undef LD_BF
#undef DO_NB
            }
            __syncthreads();
            if (mode != 2) {
                const int c = 256 * q + 8 * chk;
                float r4[4][8], k4[4][8], v4[4][8];
#pragma unroll
                for (int rr = 0; rr < 4; ++rr) { unpack8(rawr[rr], r4[rr]); unpack8(rawk[rr], k4[rr]); unpack8(rawv[rr], v4[rr]); }
                float zr[2][8], zk[2][8], zv[2][8];
                { float mp[8], mn[8];
                  ld8f(INP(F, 4, float) + c, mp); ld8f(INP(F, 5, float) + c, mn);
#pragma unroll
                  for (int tk = 0; tk < 2; ++tk)
#pragma unroll
                      for (int e = 0; e < 8; ++e) zr[tk][e] = r4[tk + 1][e] + mp[e] * (r4[tk][e] - r4[tk + 1][e]) + mn[e] * (r4[tk + 2][e] - r4[tk + 1][e]);
                  ld8f(INP(F, 4, float) + 1024 + c, mp); ld8f(INP(F, 5, float) + 1024 + c, mn);
#pragma unroll
                  for (int tk = 0; tk < 2; ++tk)
#pragma unroll
                      for (int e = 0; e < 8; ++e) zk[tk][e] = k4[tk + 1][e] + mp[e] * (k4[tk][e] - k4[tk + 1][e]) + mn[e] * (k4[tk + 2][e] - k4[tk + 1][e]);
                  ld8f(INP(F, 4, float) + 2048 + c, mp); ld8f(INP(F, 5, float) + 2048 + c, mn);
#pragma unroll
                  for (int tk = 0; tk < 2; ++tk)
#pragma unroll
                      for (int e = 0; e < 8; ++e) zv[tk][e] = v4[tk + 1][e] + mp[e] * (v4[tk][e] - v4[tk + 1][e]) + mn[e] * (v4[tk + 2][e] - v4[tk + 1][e]); }
                float kkw[8], w00[8], w01[8], a00[8], a01[8], kac[8], rkc[8];
                ld8f(INP(F, 16, float) + c, kkw); ld8f(INP(F, 11, float) + c, w00); ld8f(INP(F, 11, float) + 1024 + c, w01);
                ld8f(INP(F, 13, float) + c, a00); ld8f(INP(F, 13, float) + 1024 + c, a01); ld8f(INP(F, 17, float) + c, kac); ld8f(INP(F, 18, float) + c, rkc);
#pragma unroll 1
                for (int tk = 0; tk < 2; ++tk) {
                    const int tkn = 2 * tp + tk; const unsigned o = (unsigned)(m0t + tkn) * 1024u + (unsigned)c;
                    const LAS bf16_t* pp = Pl + tb * PT + tkn * PP + 8 * chk;
                    float zrt[8], zkt[8], zvt[8];
#pragma unroll
                    for (int e = 0; e < 8; ++e) { zrt[e] = tk ? zr[1][e] : zr[0][e]; zkt[e] = tk ? zk[1][e] : zk[0][e]; zvt[e] = tk ? zv[1][e] : zv[0][e]; }
                    WS32(F, u32x4, (unsigned)WS_R + o * 2u) = pack8(zrt); WS32(F, u32x4, (unsigned)WS_V + o * 2u) = pack8(zvt);
                    float kk[8];
                    { float ss = 0.f;
#pragma unroll
                      for (int e = 0; e < 8; ++e) { kk[e] = zkt[e] * kkw[e]; ss += kk[e] * kk[e]; }
                      ss += __shfl_xor(ss, 1); ss += __shfl_xor(ss, 2); ss += __shfl_xor(ss, 4);
                      const float inv = 1.f / fmaxf(sqrtf(ss), 1e-12f);
#pragma unroll
                      for (int e = 0; e < 8; ++e) kk[e] *= inv;
                      WS32(F, u32x4, (unsigned)WS_KK + o * 2u) = pack8(kk); }
                    {
                        float pw0[8], pw1[8], d0[8], d1[8];
                        unpack8(*(const LAS u32x4*)(pp), pw0); unpack8(*(const LAS u32x4*)(pp + PA), pw1);
#pragma unroll
                        for (int e = 0; e < 8; ++e) {
                            d0[e] = 0.6065306597126334f * __builtin_amdgcn_rcpf(1.f + __expf(-(w00[e] + pw0[e]))); d1[e] = 0.6065306597126334f * __builtin_amdgcn_rcpf(1.f + __expf(-(w01[e] + pw1[e]))); }
                        WS32(F, u32x4, (unsigned)WS_WDEC + o * 2u) = pack8(d0); WS32(F, u32x4, (unsigned)WS_WDEC + ((unsigned)(MTOK * 1024) + o) * 2u) = pack8(d1);
                    }
                    {
                        float pa0[8], pa1[8], kd0[8], kd1[8], b0v[8], b1v[8]; float bs = 0.f;
                        unpack8(*(const LAS u32x4*)(pp + 2 * PA), pa0); unpack8(*(const LAS u32x4*)(pp + 3 * PA), pa1);
#pragma unroll
                        for (int e = 0; e < 8; ++e) {
                            const float av0 = __builtin_amdgcn_rcpf(1.f + __expf(-(a00[e] + pa0[e]))), av1 = __builtin_amdgcn_rcpf(1.f + __expf(-(a01[e] + pa1[e])));
                            kd0[e] = zkt[e] * (1.f + (av0 - 1.f) * kac[e]); kd1[e] = zkt[e] * (1.f + (av1 - 1.f) * kac[e]);
                            b0v[e] = kk[e] * av0; b1v[e] = kk[e] * av1;
                            bs += zrt[e] * (kd0[e] + kd1[e]) * rkc[e]; }
                        bs += __shfl_xor(bs, 1); bs += __shfl_xor(bs, 2); bs += __shfl_xor(bs, 4);
                        if ((chk & 7) == 0) WS32(F, float, (unsigned)WS_BONUS + ((unsigned)(m0t + tkn) * 16u + (unsigned)(4 * q + (chk >> 3))) * 4u) = bs;
                        WS32(F, u32x4, (unsigned)WS_KD + o * 2u) = pack8(kd0); WS32(F, u32x4, (unsigned)WS_KD + ((unsigned)(MTOK * 1024) + o) * 2u) = pack8(kd1);
                        WS32(F, u32x4, (unsigned)WS_BB + o * 2u) = pack8(b0v); WS32(F, u32x4, (unsigned)WS_BB + ((unsigned)(MTOK * 1024) + o) * 2u) = pack8(b1v);
                    }
                    WS32(F, u32x4, (unsigned)WS_G + o * 2u) = *(const LAS u32x4*)(pp + 4 * PA);
                }
            }
            __syncthreads();
        }
    }
}

struct P5aConst { float lam; };
__device__ __forceinline__ void p5a_init(const Frame& F, P5aConst& K) {
    const int lane = F.lane;
    const float q1 = INP(F, 6, float)[lane] * INP(F, 7, float)[lane], q2 = INP(F, 8, float)[lane] * INP(F, 9, float)[lane];
    K.lam = __expf(wave_sum(q1)) - __expf(wave_sum(q2)) + 0.2f;
}
__device__ __forceinline__ void p5a_token(const Frame& F, const P5aConst& K, int m) {
    const bf16_t* OC = WSP(F, WS_OC, bf16_t); bf16_t* MIX = WSP(F, WS_MIX, bf16_t); const float* subw = INP(F, 10, float);
    const int c0 = F.lane * 16; const float lam = K.lam;
    const u32x4* p0 = (const u32x4*)(OC + (size_t)m * 1024 + c0); const u32x4* p1 = (const u32x4*)(OC + (size_t)MTOK * 1024 + (size_t)m * 1024 + c0);
    const u32x4 a0 = p0[0], a1 = p0[1], b0 = p1[0], b1 = p1[1];
    float dv[16]; const unsigned aw[8] = {a0.x, a0.y, a0.z, a0.w, a1.x, a1.y, a1.z, a1.w}, bw[8] = {b0.x, b0.y, b0.z, b0.w, b1.x, b1.y, b1.z, b1.w};
    float ssq = 0.f;
#pragma unroll
    for (int i = 0; i < 8; ++i) { dv[2 * i] = bf_lo(aw[i]) - lam * bf_lo(bw[i]); dv[2 * i + 1] = bf_hi(aw[i]) - lam * bf_hi(bw[i]); ssq += dv[2 * i] * dv[2 * i] + dv[2 * i + 1] * dv[2 * i + 1]; }
    ssq += __shfl_xor(ssq, 1); ssq += __shfl_xor(ssq, 2); ssq += __shfl_xor(ssq, 4);
    const float rstd = 1.f / sqrtf(ssq * (1.f / 128.f) + 1e-5f);
    unsigned ow[8];
#pragma unroll
    for (int i = 0; i < 8; ++i) { const float s0 = subw[(c0 + 2 * i) & 127] * 0.8f, s1 = subw[(c0 + 2 * i + 1) & 127] * 0.8f; ow[i] = cvtpk(dv[2 * i] * rstd * s0, dv[2 * i + 1] * rstd * s1); }
    u32x4* op = (u32x4*)(MIX + (size_t)m * 2048 + c0); op[0] = (u32x4){ow[0], ow[1], ow[2], ow[3]}; op[1] = (u32x4){ow[4], ow[5], ow[6], ow[7]};
}

__device__ __forceinline__ void p4_scan(Frame& F, const int mode = 0) {
    constexpr int CH = 32, NCH = SEQ / CH;
    constexpr int VEC = CH * 64 * 4;
    constexpr int BUF = 5 * VEC + CH * 32 * 4;
    constexpr int YOFF = 2 * BUF, YB = CH * 32 * 4;
    constexpr int CVT_SCR = 2 * BUF + 2 * YB;
    const bf16_t* Wdec = WSP(F, WS_WDEC, bf16_t); const bf16_t* KDg = WSP(F, WS_KD, bf16_t); const bf16_t* BBg = WSP(F, WS_BB, bf16_t);
    const bf16_t* Rg = WSP(F, WS_R, bf16_t); const bf16_t* KKg = WSP(F, WS_KK, bf16_t); const bf16_t* Vg = WSP(F, WS_V, bf16_t); bf16_t* YS = WSP(F, WS_YS, bf16_t);
    const int tid = F.tid, lane = F.lane, wid = F.wave;
    const bool is_comp = wid < 4;
    const int ri = wid & 3;
    if (is_comp) __builtin_amdgcn_s_setprio(3);
    const int g = lane >> 3, j = lane & 7, rowl = ri * 8 + g;
    const int mt = ri * 64 + lane, mw = ri;
    int cvt_it = F.vcu * 4 + mw; f32x4 cvv[16]; int ck0 = 0, crowb = 0; unsigned char* cWT = nullptr;
    f32x4 cvvB[16]; int ck0B = 0, crowbB = 0; unsigned char* cWTB = nullptr;
    LAS unsigned* st_cnt = (LAS unsigned*)(F.lds + CVT_SCR + 4 * 4096); LAS unsigned* cons_cnt = st_cnt + 16;
    for (int item = F.vcu; item < 256; item += F.G) {
        const int chain = item >> 1, half = item & 1, d = chain >> 6, b = (chain >> 4) & 3, h = chain & 15;
        const size_t sh = (size_t)b * SEQ * 1024 + h * 64, pd = (size_t)d * MTOK * 1024 + sh;
        f32x2 S2[4] = {{0.f, 0.f}, {0.f, 0.f}, {0.f, 0.f}, {0.f, 0.f}};
        u32x2 rw[2], rkk[2], rbb[2], rkd[2], rr[2]; unsigned rv[2];
        const int cstep = d ? -CH * 1024 : CH * 1024;
        unsigned po[2], pv[2];
#pragma unroll
        for (int q_ = 0; q_ < 2; ++q_) { const int sl_ = mt + 256 * q_, ss_ = sl_ >> 4, sk_ = (sl_ & 15) * 4, tq_ = d ? (SEQ - 1 - ss_) : ss_; po[q_] = (unsigned)(tq_ * 1024 + sk_); pv[q_] = (unsigned)(tq_ * 1024 + half * 32 + 2 * (sl_ & 15)); }
        const char* bW = (const char*)(Wdec + pd); const char* bKK = (const char*)(KKg + sh); const char* bBB = (const char*)(BBg + pd); const char* bKD = (const char*)(KDg + pd); const char* bR = (const char*)(Rg + sh); const char* bV = (const char*)(Vg + sh);
#define SC_LOAD(c) do { const unsigned cu_ = (unsigned)((c) * cstep); _Pragma("unroll") for (int q_ = 0; q_ < 2; ++q_) { const unsigned e_ = po[q_] + cu_; \
        rw[q_] = *(const u32x2*)(bW + (size_t)(e_ * 2u)); rkk[q_] = *(const u32x2*)(bKK + (size_t)(e_ * 2u)); rbb[q_] = *(const u32x2*)(bBB + (size_t)(e_ * 2u)); rkd[q_] = *(const u32x2*)(bKD + (size_t)(e_ * 2u)); rr[q_] = *(const u32x2*)(bR + (size_t)(e_ * 2u)); \
        rv[q_] = *(const unsigned*)(bV + (size_t)((pv[q_] + cu_) * 2u)); } } while (0)
#define SC_STORE(bufi) do { LAS unsigned char* bp_ = F.lds + (bufi) * BUF; _Pragma("unroll") for (int q_ = 0; q_ < 2; ++q_) { const int sl_ = mt + 256 * q_, ss_ = sl_ >> 4, sk_ = (sl_ & 15) * 4; const int o_ = (ss_ * 64 + sk_) * 4; \
        *(LAS f32x4*)(bp_ + o_) = (f32x4){__expf(-bf_lo(rw[q_].x)), __expf(-bf_hi(rw[q_].x)), __expf(-bf_lo(rw[q_].y)), __expf(-bf_hi(rw[q_].y))}; \
        *(LAS f32x4*)(bp_ + VEC + o_) = (f32x4){bf_lo(rkk[q_].x), bf_hi(rkk[q_].x), bf_lo(rkk[q_].y), bf_hi(rkk[q_].y)}; \
        *(LAS f32x4*)(bp_ + 2 * VEC + o_) = (f32x4){bf_lo(rbb[q_].x), bf_hi(rbb[q_].x), bf_lo(rbb[q_].y), bf_hi(rbb[q_].y)}; \
        *(LAS f32x4*)(bp_ + 3 * VEC + o_) = (f32x4){bf_lo(rkd[q_].x), bf_hi(rkd[q_].x), bf_lo(rkd[q_].y), bf_hi(rkd[q_].y)}; \
        *(LAS f32x4*)(bp_ + 4 * VEC + o_) = (f32x4){bf_lo(rr[q_].x), bf_hi(rr[q_].x), bf_lo(rr[q_].y), bf_hi(rr[q_].y)}; \
        *(LAS f32x2*)(bp_ + 5 * VEC + (ss_ * 32 + 2 * (sl_ & 15)) * 4) = (f32x2){bf_lo(rv[q_]), bf_hi(rv[q_])}; } } while (0)
#define Y_OUT(c) do { const int ys_ = mt >> 3, yr_ = (mt & 7) * 4; const int tt_ = (c) * CH + ys_, t_ = d ? (SEQ - 1 - tt_) : tt_; \
        const f32x4 yv_ = *(const LAS f32x4*)(F.lds + YOFF + ((c) & 1) * YB + (ys_ * 32 + yr_) * 4); \
        *(u32x2*)(YS + pd + (size_t)t_ * 1024 + half * 32 + yr_) = (u32x2){cvtpk(yv_.x, yv_.y), cvtpk(yv_.z, yv_.w)}; } while (0)
#define SC_WAIT(cnt_, tgt_) do { for (;;) { const u32x4 q_ = *(volatile LAS u32x4*)(cnt_); const unsigned a_ = q_.x < q_.y ? q_.x : q_.y, b_ = q_.z < q_.w ? q_.z : q_.w; \
        if ((a_ < b_ ? a_ : b_) >= (tgt_)) break; if (is_comp) __builtin_amdgcn_s_sleep(1); else __builtin_amdgcn_s_sleep(12); } asm volatile("" ::: "memory"); } while (0)
#define SC_SIGNAL(cnt_, val_) do { asm volatile("s_waitcnt lgkmcnt(0)" ::: "memory"); if (lane == 0) *(volatile LAS unsigned*)((cnt_) + ri) = (val_); } while (0)
        __syncthreads();
        if (tid < 4) { st_cnt[tid] = 0u; cons_cnt[tid] = 0u; }
        if (!is_comp) { SC_LOAD(0); SC_STORE(0); SC_LOAD(1); }
        __syncthreads();
        if (is_comp) {
          for (int c = 0; c < NCH; ++c) {
            SC_WAIT(st_cnt, (unsigned)c);
            if (mode != 2) {
                const LAS unsigned char* bp = F.lds + (c & 1) * BUF;
                LAS float* yb = (LAS float*)(F.lds + YOFF + (c & 1) * YB);
                f32x4 cw_[2], ckk[2], cbb[2], ckd[2], cr[2]; float cv;
#define SC_RD(s_) do { const int o_ = ((s_) * 64 + j * 8) * 4; cw_[0] = *(const LAS f32x4*)(bp + o_); cw_[1] = *(const LAS f32x4*)(bp + o_ + 16); ckk[0] = *(const LAS f32x4*)(bp + VEC + o_); ckk[1] = *(const LAS f32x4*)(bp + VEC + o_ + 16); \
                cbb[0] = *(const LAS f32x4*)(bp + 2 * VEC + o_); cbb[1] = *(const LAS f32x4*)(bp + 2 * VEC + o_ + 16); ckd[0] = *(const LAS f32x4*)(bp + 3 * VEC + o_); ckd[1] = *(const LAS f32x4*)(bp + 3 * VEC + o_ + 16); \
                cr[0] = *(const LAS f32x4*)(bp + 4 * VEC + o_); cr[1] = *(const LAS f32x4*)(bp + 4 * VEC + o_ + 16); cv = *(const LAS float*)(bp + 5 * VEC + ((s_) * 32 + rowl) * 4); } while (0)
#define H2(v_, i_) ((f32x2){v_[(i_) >> 1][((i_) & 1) * 2], v_[(i_) >> 1][((i_) & 1) * 2 + 1]})
                SC_RD(0);
                float yk = 0.f;
#pragma unroll
                for (int s = 0; s < CH; ++s) {
                    f32x4 w[2] = {cw_[0], cw_[1]}, kk[2] = {ckk[0], ckk[1]}, bb[2] = {cbb[0], cbb[1]}, kd[2] = {ckd[0], ckd[1]}, r[2] = {cr[0], cr[1]}; const float v = cv;
                    if (s + 1 < CH) SC_RD(s + 1);
                    f32x2 pa = S2[0] * H2(kk, 0), pb = S2[1] * H2(kk, 1); pa = S2[2] * H2(kk, 2) + pa; pb = S2[3] * H2(kk, 3) + pb; pa = pa + pb;
                    const f32x2 vv = {v, v};
                    f32x2 u[4];
#pragma unroll
                    for (int i = 0; i < 4; ++i) u[i] = S2[i] * H2(w, i) + vv * H2(kd, i);
                    float p = pa.x + pa.y;
                    p = dpp_add<0xB1>(p); p = dpp_add<0x4E>(p); p = dpp_add<0x141>(p);
                    const f32x2 sa = {-p, -p};
#pragma unroll
                    for (int i = 0; i < 4; ++i) S2[i] = sa * H2(bb, i) + u[i];
                    f32x2 ya = S2[0] * H2(r, 0), yc = S2[1] * H2(r, 1); ya = S2[2] * H2(r, 2) + ya; yc = S2[3] * H2(r, 3) + yc; ya = ya + yc;
                    float y = ya.x + ya.y;
                    y = dpp_add<0xB1>(y); y = dpp_add<0x4E>(y); y = dpp_add<0x141>(y);
                    yk = (j == (s & 7)) ? y : yk;
                    if ((s & 7) == 7) yb[((s & 24) + j) * 32 + rowl] = yk;
                }
#undef SC_RD
#undef H2
            }
            SC_SIGNAL(cons_cnt, (unsigned)(c + 1));
          }
        } else {
#define MEM_DUTIES(c_) do { SC_WAIT(cons_cnt, (unsigned)(c_)); if ((c_) >= 1 && mode != 2) Y_OUT((c_) - 1); if ((c_) + 1 < NCH) SC_STORE(((c_) + 1) & 1); SC_SIGNAL(st_cnt, (unsigned)((c_) + 1)); if ((c_) + 2 < NCH) SC_LOAD((c_) + 2); } while (0)
#define CVT_LOAD_SET(V_, K0_, WT_, RB_) do { const int it_ = cvt_it < N_EXPERT_ITEMS ? cvt_it : N_EXPERT_ITEMS - 1; const float* cW_; int cn0_; cvt_expert_decode(F, it_, cW_, K0_, cn0_, WT_, RB_); cvt8_load(V_, cW_, K0_, cn0_, lane); cvt_it += F.G * 4; } while (0)
          if (item == F.vcu) { P5aConst p5k; p5a_init(F, p5k); for (int xm = F.vcu * 4 + mw; xm < MTOK; xm += F.G * 4) p5a_token(F, p5k, xm); }
          int ngrp = 0; { const int left = (N_EXPERT_ITEMS - cvt_it + F.G * 4 - 1) / (F.G * 4); ngrp = left > 0 ? left / 3 : 0; if (ngrp > NCH / 4) ngrp = NCH / 4; }
          int cg = 0;
#pragma unroll 1
          for (; cg < 4 * ngrp; cg += 4) {
            MEM_DUTIES(cg);
#if CVT_IN_SCAN
            if (cg > 0) cvt8_finish(cvv, ck0, cWT, crowb, lane);
            CVT_LOAD_SET(cvv, ck0, cWT, crowb);
#endif
            MEM_DUTIES(cg + 1);
#if CVT_IN_SCAN
            CVT_LOAD_SET(cvvB, ck0B, cWTB, crowbB);
#endif
            MEM_DUTIES(cg + 2);
#if CVT_IN_SCAN
            cvt8_finish(cvv, ck0, cWT, crowb, lane);
            CVT_LOAD_SET(cvv, ck0, cWT, crowb);
#endif
            MEM_DUTIES(cg + 3);
#if CVT_IN_SCAN
            cvt8_finish(cvvB, ck0B, cWTB, crowbB, lane);
#endif
          }
#if CVT_IN_SCAN
          if (ngrp > 0) cvt8_finish(cvv, ck0, cWT, crowb, lane);
#endif
#pragma unroll 1
          for (; cg < NCH; ++cg) MEM_DUTIES(cg);
#undef MEM_DUTIES
#undef CVT_LOAD_SET
          SC_WAIT(cons_cnt, (unsigned)NCH);
        }
        if (!is_comp && mode != 2) Y_OUT(NCH - 1);
#undef SC_LOAD
#undef SC_STORE
#undef Y_OUT
#undef SC_WAIT
#undef SC_SIGNAL
    }
    __builtin_amdgcn_s_setprio(0);
#if CVT_IN_SCAN
    if (!is_comp) {
        for (; cvt_it < N_EXPERT_ITEMS; cvt_it += F.G * 4) {
            const float* W; int k0, n0, rowb; unsigned char* WT;
            cvt_expert_decode(F, cvt_it, W, k0, n0, WT, rowb); cvt8_load(cvv, W, k0, n0, lane); cvt8_finish(cvv, k0, WT, rowb, lane);
        }
    }
#endif
}

__device__ __forceinline__ void p5_finalize(Frame& F) {
    const bf16_t* OC = WSP(F, WS_OC, bf16_t); const bf16_t* YS = WSP(F, WS_YS, bf16_t); const bf16_t* Vg = WSP(F, WS_V, bf16_t); const bf16_t* Gg = WSP(F, WS_G, bf16_t);
    const float* BON = WSP(F, WS_BONUS, float); bf16_t* MIX = WSP(F, WS_MIX, bf16_t);
    const float* subw = INP(F, 10, float); const float* lnw = INP(F, 19, float); const float* lnb = INP(F, 20, float);
    const int lane = F.lane, gw = F.vcu * 8 + F.wave, NGW = F.G * 8;
    float lam;
    { const float q1 = INP(F, 6, float)[lane] * INP(F, 7, float)[lane], q2 = INP(F, 8, float)[lane] * INP(F, 9, float)[lane];
      lam = __expf(wave_sum(q1)) - __expf(wave_sum(q2)) + 0.2f; }
    const int c0 = lane * 16;
    float sw[16], lw[16], lb[16];
#pragma unroll
    for (int i = 0; i < 16; ++i) { sw[i] = subw[(c0 + i) & 127] * 0.8f; lw[i] = lnw[c0 + i]; lb[i] = lnb[c0 + i]; }
    for (int m = gw; m < MTOK; m += NGW) {
        { const u32x4* y0 = (const u32x4*)(YS + (size_t)m * 1024 + c0); const u32x4* y1 = (const u32x4*)(YS + (size_t)MTOK * 1024 + (size_t)m * 1024 + c0);
          float y[16]; float s = 0.f;
          { const u32x4 a0 = y0[0], a1 = y0[1], b0 = y1[0], b1 = y1[1];
            const unsigned aw[8] = {a0.x, a0.y, a0.z, a0.w, a1.x, a1.y, a1.z, a1.w}, bw[8] = {b0.x, b0.y, b0.z, b0.w, b1.x, b1.y, b1.z, b1.w};
#pragma unroll
            for (int i = 0; i < 8; ++i) { y[2 * i] = bf_lo(aw[i]) + bf_lo(bw[i]); y[2 * i + 1] = bf_hi(aw[i]) + bf_hi(bw[i]); } }
#pragma unroll
          for (int i = 0; i < 16; ++i) s += y[i];
          s += __shfl_xor(s, 1); s += __shfl_xor(s, 2);
          const float mu = s * (1.f / 64.f); float q = 0.f;
#pragma unroll
          for (int i = 0; i < 16; ++i) { y[i] -= mu; q += y[i] * y[i]; }
          q += __shfl_xor(q, 1); q += __shfl_xor(q, 2);
          const float rstd = 1.f / sqrtf(q * (1.f / 64.f) + 64e-5f);
          const float bon = BON[(size_t)m * 16 + (lane >> 2)];
          const u32x4* vp = (const u32x4*)(Vg + (size_t)m * 1024 + c0); const u32x4* gp = (const u32x4*)(Gg + (size_t)m * 1024 + c0);
          const u32x4 v0 = vp[0], v1 = vp[1], g0 = gp[0], g1 = gp[1];
          const unsigned vw[8] = {v0.x, v0.y, v0.z, v0.w, v1.x, v1.y, v1.z, v1.w}, gq[8] = {g0.x, g0.y, g0.z, g0.w, g1.x, g1.y, g1.z, g1.w};
          unsigned ow[8];
#pragma unroll
          for (int i = 0; i < 8; ++i) {
              const float e0 = (y[2 * i] * rstd * lw[2 * i] + lb[2 * i] + bon * bf_lo(vw[i])) * bf_lo(gq[i]);
              const float e1 = (y[2 * i + 1] * rstd * lw[2 * i + 1] + lb[2 * i + 1] + bon * bf_hi(vw[i])) * bf_hi(gq[i]);
              ow[i] = cvtpk(e0, e1); }
          u32x4* op = (u32x4*)(MIX + (size_t)m * 2048 + 1024 + c0); op[0] = (u32x4){ow[0], ow[1], ow[2], ow[3]}; op[1] = (u32x4){ow[4], ow[5], ow[6], ow[7]}; }
    }
}

__device__ __forceinline__ void p7_router(Frame& F) {
    const bf16_t* X1 = WSP(F, WS_X1, bf16_t); const float* nw = INP(F, 22, float); const float* wr = INP(F, 23, float);
    unsigned char* H2 = WSP(F, WS_H2, unsigned char); float* AFF = WSP(F, WS_AFF, float);
    const int lane = F.lane, tid = F.tid, gw = F.vcu * 8 + F.wave, NGW = F.G * 8;
    volatile LAS unsigned* MISC = (volatile LAS unsigned*)(F.lds + MISC_OFF);
    const unsigned m8 = MISC[8], m9 = MISC[9];
    __syncthreads();
    for (int f = tid; f < 2048 * 4; f += 512) { const int col = f >> 2, q = f & 3; *(LAS f32x4*)(F.lds + (col >> 2) * 272 + (col & 3) * 64 + q * 16) = *(const f32x4*)(wr + (size_t)col * 16 + 4 * q); }
    __syncthreads();
    for (int pr = gw; pr < MTOK / 2; pr += NGW) {
        const int m = 2 * pr;
        const u32x2* xr0 = (const u32x2*)(X1 + (size_t)m * DM) + lane; const u32x2* xr1 = xr0 + DM / 4;
        f32x4 v0[8], v1[8]; float s0 = 0.f, s1 = 0.f;
#pragma unroll
        for (int j = 0; j < 8; ++j) { const u32x2 a_ = xr0[64 * j], b_ = xr1[64 * j]; v0[j] = (f32x4){bf_lo(a_.x), bf_hi(a_.x), bf_lo(a_.y), bf_hi(a_.y)}; v1[j] = (f32x4){bf_lo(b_.x), bf_hi(b_.x), bf_lo(b_.y), bf_hi(b_.y)}; }
#pragma unroll
        for (int j = 0; j < 8; ++j) { s0 += (v0[j].x * v0[j].x + v0[j].y * v0[j].y) + (v0[j].z * v0[j].z + v0[j].w * v0[j].w); s1 += (v1[j].x * v1[j].x + v1[j].y * v1[j].y) + (v1[j].z * v1[j].z + v1[j].w * v1[j].w); }
        const float r0 = 1.f / sqrtf(wave_sum(s0) * (1.f / DM) + 1e-6f), r1 = 1.f / sqrtf(wave_sum(s1) * (1.f / DM) + 1e-6f);
        unsigned* o0 = (unsigned*)(H2 + (size_t)m * DM) + lane; unsigned* o1 = o0 + DM / 4;
        float acc[32];
#pragma unroll
        for (int i = 0; i < 32; ++i) acc[i] = 0.f;
#pragma unroll
        for (int j = 0; j < 8; ++j) {
            const f32x4 w = ((const f32x4*)nw)[lane + 64 * j];
            const f32x4 a = v0[j] * w * r0, b = v1[j] * w * r1;
            o0[64 * j] = pg8::cvt4_fp8(a.x, a.y, a.z, a.w);
            o1[64 * j] = pg8::cvt4_fp8(b.x, b.y, b.z, b.w);
            const LAS f32x4* wp = (const LAS f32x4*)(F.lds + (lane + 64 * j) * 272);
#pragma unroll
            for (int i = 0; i < 4; ++i) {
#pragma unroll
                for (int q = 0; q < 4; ++q) { const f32x4 ww = wp[i * 4 + q];
#pragma unroll
                    for (int e = 0; e < 4; ++e) { acc[4 * q + e] += a[i] * ww[e]; acc[16 + 4 * q + e] += b[i] * ww[e]; } }
                asm volatile("" ::: "memory");
            }
        }
#define RSTAGE(N_, B_) do { const bool up_ = (lane & (B_)) != 0; _Pragma("unroll") for (int k = 0; k < (N_); ++k) { const float lo_ = acc[k], hi_ = acc[(N_) + k]; \
            const float snd_ = up_ ? lo_ : hi_, kp_ = up_ ? hi_ : lo_; acc[k] = kp_ + __shfl_xor(snd_, (B_)); } } while (0)
        RSTAGE(16, 32); RSTAGE(8, 16); RSTAGE(4, 8); RSTAGE(2, 4); RSTAGE(1, 2);
#undef RSTAGE
        float lg = acc[0] + __shfl_xor(acc[0], 1);
        float mx = lg;
        mx = fmaxf(mx, __shfl_xor(mx, 2)); mx = fmaxf(mx, __shfl_xor(mx, 4)); mx = fmaxf(mx, __shfl_xor(mx, 8)); mx = fmaxf(mx, __shfl_xor(mx, 16));
        const float p = expf(lg - mx);
        float den = p; den += __shfl_xor(den, 2); den += __shfl_xor(den, 4); den += __shfl_xor(den, 8); den += __shfl_xor(den, 16);
        if ((lane & 1) == 0) { const int row = lane >> 5, e = (lane >> 1) & 15, mm = m + row; AFF[((size_t)(mm >> 11) * 16 + e) * SEQ + (mm & (SEQ - 1))] = p / den; }
    }
    __syncthreads();
    if (tid == 0) { MISC[8] = m8; MISC[9] = m9; }
    __syncthreads();
}

__device__ __forceinline__ int wave_count4(bool f0, bool f1, bool f2, bool f3) {
    return __builtin_popcountll(__ballot(f0)) + __builtin_popcountll(__ballot(f1)) + __builtin_popcountll(__ballot(f2)) + __builtin_popcountll(__ballot(f3));
}
__device__ __forceinline__ void p8_select(Frame& F) {
    const float* AFF = WSP(F, WS_AFF, float);
    int* XEIDX = WSP(F, WS_XEIDX, int); float* GATEX = WSP(F, WS_GATEX, float); int* SLOT = WSP(F, WS_SLOT, int);
    LAS int* part = (LAS int*)F.lds;
    LAS unsigned* cnt = (LAS unsigned*)(F.lds + 256);
    LAS unsigned* list = (LAS unsigned*)(F.lds + 512);
    const int tid = F.tid, lane = F.lane, w = F.wave;
    for (int item = F.vcu; item < 256; item += F.G) {
        const int be = item >> 2, q = item & 3, b = be >> 4, e = be & 15;
        __syncthreads();
        if (tid == 0) *cnt = 0u;
        const f32x4 a4 = ((const f32x4*)(AFF + (size_t)be * SEQ))[tid];
        const unsigned u0 = __float_as_uint(a4.x), u1 = __float_as_uint(a4.y), u2 = __float_as_uint(a4.z), u3 = __float_as_uint(a4.w);
        unsigned lo = 0u, hi = 0x7f800001u;
        int itn = 0;
        while (hi - lo > 1u) {
            const unsigned mid = lo + ((hi - lo) >> 1);
            const int c = wave_count4(u0 >= mid, u1 >= mid, u2 >= mid, u3 >= mid);
            LAS int* pp = part + (itn & 1) * 8;
            if (lane == 0) pp[w] = c;
            __syncthreads();
            int tot = 0;
#pragma unroll
            for (int i = 0; i < 8; ++i) tot += pp[i];
            if (tot >= CAP) lo = mid; else hi = mid;
            ++itn;
        }
        const unsigned T = lo;
        const bool g0 = u0 > T, g1 = u1 > T, g2 = u2 > T, g3 = u3 > T, q0 = u0 == T, q1 = u1 == T, q2 = u2 == T, q3 = u3 == T;
        const unsigned long long bg0 = __ballot(g0), bg1 = __ballot(g1), bg2 = __ballot(g2), bg3 = __ballot(g3), bq0 = __ballot(q0), bq1 = __ballot(q1), bq2 = __ballot(q2), bq3 = __ballot(q3);
        const unsigned long long below = (lane == 0) ? 0ull : (~0ull >> (64 - lane));
        int pg = __builtin_popcountll(bg0 & below) + __builtin_popcountll(bg1 & below) + __builtin_popcountll(bg2 & below) + __builtin_popcountll(bg3 & below);
        int pq = __builtin_popcountll(bq0 & below) + __builtin_popcountll(bq1 & below) + __builtin_popcountll(bq2 & below) + __builtin_popcountll(bq3 & below);
        const int wg = __builtin_popcountll(bg0) + __builtin_popcountll(bg1) + __builtin_popcountll(bg2) + __builtin_popcountll(bg3);
        const int wq = __builtin_popcountll(bq0) + __builtin_popcountll(bq1) + __builtin_popcountll(bq2) + __builtin_popcountll(bq3);
        if (lane == 0) { part[16 + w] = wg; part[32 + w] = wq; }
        __syncthreads();
        int gtc = 0, baseg = 0, baseq = 0;
#pragma unroll
        for (int i = 0; i < 8; ++i) { const int x = part[16 + i], y = part[32 + i]; gtc += x; if (i < w) { baseg += x; baseq += y; } }
        const int need = CAP - gtc;
        pg += baseg; pq += baseq;
        if ((w >> 1) == q) {
            const bool gs[4] = {g0, g1, g2, g3}, qs[4] = {q0, q1, q2, q3}; const float av[4] = {a4.x, a4.y, a4.z, a4.w};
            int cg_ = pg, cq_ = pq;
#pragma unroll
            for (int i = 0; i < 4; ++i) {
                const int t = 4 * tid + i, m = b * SEQ + t; int slot = -1;
                if (gs[i]) { slot = cg_; ++cg_; } else if (qs[i]) { if (cq_ < need) slot = gtc + cq_; ++cq_; }
                SLOT[m * 16 + e] = slot;
                if (slot >= 0) { GATEX[(e * 4 + b) * CAP + slot] = av[i]; XEIDX[(e * 4 + b) * CAP + slot] = m; }
            }
        }
    }
}

__device__ __forceinline__ void p11_final(Frame& F) {
    const bf16_t* X1 = WSP(F, WS_X1, bf16_t); const bf16_t* YE = WSP(F, WS_YE, bf16_t); const int* SLOT = WSP(F, WS_SLOT, int); const float* nw = INP(F, 27, float);
    float* out = F.a->out;
    const int lane = F.lane, gw = F.vcu * 8 + F.wave, NGW = F.G * 8;
    for (int m = gw; m < MTOK; m += NGW) {
        const int b = m >> 11;
        float v[32];
        { const u32x4* xr = (const u32x4*)(X1 + (size_t)m * DM + lane * 8);
#pragma unroll
          for (int j = 0; j < 4; ++j) { const u32x4 a = xr[64 * j]; v[8 * j] = bf_lo(a.x); v[8 * j + 1] = bf_hi(a.x); v[8 * j + 2] = bf_lo(a.y); v[8 * j + 3] = bf_hi(a.y); v[8 * j + 4] = bf_lo(a.z); v[8 * j + 5] = bf_hi(a.z); v[8 * j + 6] = bf_lo(a.w); v[8 * j + 7] = bf_hi(a.w); } }
        int sl = (lane < 16) ? SLOT[m * 16 + lane] : -1;
        for (int e = 0; e < 16; ++e) {
            const int s = __shfl(sl, e);
            if (s >= 0) { const u32x4* yr = (const u32x4*)(YE + (size_t)((e * 4 + b) * CAP + s) * DM + lane * 8);
#pragma unroll
                for (int j = 0; j < 4; ++j) { const u32x4 w = yr[64 * j];
                    v[8 * j] += bf_lo(w.x); v[8 * j + 1] += bf_hi(w.x); v[8 * j + 2] += bf_lo(w.y); v[8 * j + 3] += bf_hi(w.y); v[8 * j + 4] += bf_lo(w.z); v[8 * j + 5] += bf_hi(w.z); v[8 * j + 6] += bf_lo(w.w); v[8 * j + 7] += bf_hi(w.w); } }
        }
        float s = 0.f;
#pragma unroll
        for (int i = 0; i < 32; ++i) s += v[i] * v[i];
        const float rstd = 1.f / sqrtf(wave_sum(s) * (1.f / DM) + 1e-6f);
#pragma unroll
        for (int j = 0; j < 4; ++j) { const int col = 512 * j + lane * 8; const f32x4 w0 = *(const f32x4*)(nw + col), w1 = *(const f32x4*)(nw + col + 4);
            f32x4 o0 = {v[8 * j] * rstd * w0.x, v[8 * j + 1] * rstd * w0.y, v[8 * j + 2] * rstd * w0.z, v[8 * j + 3] * rstd * w0.w};
            f32x4 o1 = {v[8 * j + 4] * rstd * w1.x, v[8 * j + 5] * rstd * w1.y, v[8 * j + 6] * rstd * w1.z, v[8 * j + 7] * rstd * w1.w};
            *(f32x4*)(out + (size_t)m * DM + col) = o0; *(f32x4*)(out + (size_t)m * DM + col + 4) = o1; }
    }
}


template <int PHM> __global__ void __launch_bounds__(512, 2) mk_fwd(Args args) {
    extern __shared__ __attribute__((aligned(16))) unsigned char lds[];
    Frame F;
    F.lds = (LAS unsigned char*)lds; F.ldsg = (char*)lds; F.a = &args;
    F.tid = threadIdx.x; F.lane = F.tid & 63; F.wave = __builtin_amdgcn_readfirstlane(F.tid >> 6);
    F.G = gridDim.x; { const int bx = blockIdx.x; F.vcu = (F.G % 8 == 0) ? (bx % 8) * (F.G / 8) + bx / 8 : bx; }
    volatile LAS unsigned* MISC = (volatile LAS unsigned*)(F.lds + MISC_OFF);
    for (int u = F.tid; u < (LDS_BYTES - 131072) / 4; u += 512) ((LAS unsigned*)(F.lds + 131072))[u] = 0u;
    __syncthreads();
    gu32* ctl = (gu32*)(args.ws + WS_CTL);
    XcdBarrier bar; bar.bar = (unsigned*)(ctl + CW_BAR); bar.x = 0; bar.st = nullptr;
    if (MK_N_LAUNCHES == 1) bar = xcd_barrier_post((unsigned*)(ctl + CW_BAR), MISC + 8);
    const int lo = args.ph_lo, hi = args.ph_hi;
#define IN(k) (((PHM >> (k)) & 1) && lo <= (k) && (k) < hi)
#ifndef DUP_MASK
#define DUP_MASK 0
#endif
#define REP(k) for (int rep_ = 0; rep_ < 1 + ((DUP_MASK >> (k)) & 1); ++rep_)
#define SEAM(k) do { if (IN(k) && IN((k) + 1)) xcd_barrier(bar); } while (0)

    if (IN(0)) REP(0) { p0_prologue(F); }
    SEAM(0);
    if (IN(1)) REP(1) {
        pg8::Gemm g{WSP(F, WS_H1, bf16_t), WSP(F, WS_WIN, bf16_t), MTOK, 6144, DM, DM}; pg8::StaticOrder S; S.init(MTOK, 6144, F.G, (int)blockIdx.x);
        pg8::EpiProj E{WSP(F, WS_PROJ, bf16_t), LDP, WSP(F, WS_ROPE, float), QSCALE};
        pg8::gemm_phase<pg8::EpiProj, pg8::StaticOrder, true, true>(F.lds, g, S, E);
        pg8::Gemm g2{WSP(F, WS_H1, bf16_t), WSP(F, WS_WIN, bf16_t), MTOK, 512, DM / 4, DM}; pg8::TailOrder S2{F.G, (int)blockIdx.x};
        pg8::EpiPart E2{WSP(F, WS_PART, bf16_t)};
        pg8::gemm_phase<pg8::EpiPart, pg8::TailOrder, true, true>(F.lds, g2, S2, E2);
    }
    SEAM(1);
    const bool prep_first = (F.vcu & 1) != 0;
    if (IN(3) && prep_first) { p3_prep(F, 0); }
    if (IN(2)) {
        const bf16_t* P = WSP(F, WS_PROJ, bf16_t); bf16_t* OC = WSP(F, WS_OC, bf16_t);
        for (int u = F.vcu * 2; u < 512; u += F.G * 2)
            for (int i = 0; i < 2; ++i) {
                const int uu = u + i, qb = uu & 7, c = (uu >> 3) & 1, h = (uu >> 4) & 7, b = uu >> 7;
                const size_t m0 = (size_t)b * SEQ;
                att::attn_unit<LDP>(P + (m0 + qb * 256) * LDP + h * 128 + c * 64, P + m0 * LDP + 1024 + h * 128 + c * 64, P + m0 * LDP + 2048 + h * 128,
                                    OC + (size_t)c * MTOK * 1024 + (m0 + qb * 256) * 1024 + h * 128, SEQ, F.ldsg);
            }
    }
    if (IN(3) && !prep_first) { p3_prep(F, 0); }
    SEAM(3);
    #ifndef SCAN_PROBE
#define SCAN_PROBE 0
#endif
    if (IN(4)) REP(4) { p4_scan(F, rep_ ? SCAN_PROBE : 0); }
    SEAM(4);
    if (IN(5)) REP(5) { p5_finalize(F); }
    SEAM(5);
    if (IN(6)) REP(6) {
        pg8::Gemm g{WSP(F, WS_MIX, bf16_t), WSP(F, WS_WOUT, bf16_t), MTOK, DM, DM, DM}; pg8::StaticOrder S; S.init(MTOK, DM, F.G, (int)blockIdx.x);
        pg8::EpiResid E{INP(F, 0, float), WSP(F, WS_X1, bf16_t), DM};
        pg8::gemm_phase<pg8::EpiResid, pg8::StaticOrder, true, true>(F.lds, g, S, E);
    }
    SEAM(6);
    if (IN(7)) REP(7) { p7_router(F); }
    SEAM(7);
    if (IN(8)) REP(8) { p8_select(F); }
    SEAM(8);
    if (IN(9)) REP(9) {
        pg8::Gemm g{WSP(F, WS_H2, bf16_t), WSP(F, WS_WGU, bf16_t), 16384, 65536, DM / 2, DM / 2}; pg8::MoeOrderT<true> S{F.G, F.vcu, 16, 1024, WSP(F, WS_XEIDX, int)};
        pg8::EpiSwiglu E{WSP(F, WS_HID, unsigned char), 16};
        pg8::gemm_phase<pg8::EpiSwiglu, pg8::MoeOrderT<true>, true, true, true>(F.lds, g, S, E);
    }
    SEAM(9);
    if (IN(10)) REP(10) {
        pg8::Gemm g{WSP(F, WS_HID, bf16_t), WSP(F, WS_WD, bf16_t), 16384, 32768, DM / 2, DM / 2}; pg8::MoeOrderT<false> S{F.G, F.vcu, 8, 512, nullptr};
        pg8::EpiDown E{WSP(F, WS_YE, bf16_t), WSP(F, WS_GATEX, float), 8};
        pg8::gemm_phase<pg8::EpiDown, pg8::MoeOrderT<false>, true, true, true>(F.lds, g, S, E);
    }
    SEAM(10);
    if (IN(11)) REP(11) { p11_final(F); }
#undef IN
#undef SEAM
}

static const void* kfn(int li) {
#if MK_N_LAUNCHES == 1
    (void)li; return (const void*)mk_fwd<0xFFF>;
#else
    switch (li) {
        case 0: return (const void*)mk_fwd<1>; case 1: return (const void*)mk_fwd<2>; case 2: return (const void*)mk_fwd<4>; case 3: return (const void*)mk_fwd<8>;
        case 4: return (const void*)mk_fwd<16>; case 5: return (const void*)mk_fwd<32>; case 6: return (const void*)mk_fwd<64>; case 7: return (const void*)mk_fwd<128>;
        case 8: return (const void*)mk_fwd<256>; case 9: return (const void*)mk_fwd<512>; case 10: return (const void*)mk_fwd<1024>; default: return (const void*)mk_fwd<2048>;
    }
#endif
}
extern "C" void kernel_launch(void* const* d_in, const int* in_sizes, int n_in, void* d_out, int out_size, void* d_ws, size_t ws_size, hipStream_t stream) {
    static int grid = 0;
    if (grid == 0) {
        if (n_in != 28 || out_size != MTOK * DM || ws_size < WS_END) { fprintf(stderr, "kernel_launch: unexpected shapes: n_in %d out %d ws %zu (need >= %zu)\n", n_in, out_size, ws_size, (size_t)WS_END); grid = -1; return; }
        int dev = 0, cus = 0, per_cu = 0;
        if (hipGetDevice(&dev) != hipSuccess || hipDeviceGetAttribute(&cus, hipDeviceAttributeMultiprocessorCount, dev) != hipSuccess) { fprintf(stderr, "kernel_launch: device query failed\n"); grid = -1; return; }
        for (int i = 0; i < MK_N_LAUNCHES; ++i) if (hipFuncSetAttribute(kfn(i), hipFuncAttributeMaxDynamicSharedMemorySize, LDS_BYTES) != hipSuccess) { fprintf(stderr, "kernel_launch: hipFuncSetAttribute failed\n"); grid = -1; return; }
        if (hipOccupancyMaxActiveBlocksPerMultiprocessor(&per_cu, kfn(0), 512, LDS_BYTES) != hipSuccess || per_cu < 1) { fprintf(stderr, "kernel_launch: occupancy query says %d blocks/CU\n", per_cu); }
        (void)hipGetLastError();
        grid = cus;
    }
    if (grid < 0) return;
    if (hipMemsetAsync((char*)d_ws + WS_CTL, 0, CTL_ZERO_BYTES, stream) != hipSuccess) { fprintf(stderr, "kernel_launch: memset failed\n"); return; }
    Args a{};
    for (int i = 0; i < 28; ++i) a.in[i] = d_in[i];
    a.out = (float*)d_out; a.ws = (unsigned char*)d_ws;
    const int nl = MK_N_LAUNCHES;
    for (int li = 0; li < nl; ++li) {
        a.ph_lo = (nl == 1) ? 0 : li; a.ph_hi = (nl == 1) ? N_PHASES : li + 1; a.li = li;
        void* kargs[] = {&a};
        (void)hipLaunchKernel(kfn(li), dim3(grid), dim3(512), kargs, LDS_BYTES, stream);
        const hipError_t le = hipPeekAtLastError();
        if (le != hipSuccess) { fprintf(stderr, "kernel_launch: launch %d failed: %s\n", li, hipGetErrorName(le)); break; }
    }
}
```

```cpp
#include <hip/hip_runtime.h>
#include <hip/hip_bf16.h>
#include <cstdio>
#include <cstdint>

#ifndef MK_N_LAUNCHES
#define MK_N_LAUNCHES 1
#endif
#ifndef CVT_IN_SCAN
#define CVT_IN_SCAN 1
#endif
constexpr int N_PHASES = 12;

constexpr int BATCH = 4, SEQ = 2048, DM = 2048, MTOK = BATCH * SEQ;
constexpr int IN_COLS = 6432, LDP = 6656;
constexpr int ZC0 = 3072;
constexpr int RW = 1024, NH_R = 16, HD_R = 64;
constexpr int NEXP = 16, CAP = 256, FF = 2048;
constexpr float QSCALE = 0.18033688011112042f;

constexpr size_t MiB = 1u << 20;
constexpr size_t WS_CTL = 0, CTL_ZERO_BYTES = 1 * MiB;
constexpr size_t WS_ROPE = 1 * MiB;
constexpr size_t WS_LORA = 2 * MiB;
constexpr size_t WS_AFF = 3 * MiB;
constexpr size_t WS_GATEX = 3 * MiB + 512 * 1024;
constexpr size_t WS_SLOT = 4 * MiB;
constexpr size_t WS_XEIDX = 6 * MiB;
constexpr size_t WS_BONUS = 5 * MiB;
constexpr size_t WS_WIN = 8 * MiB;
constexpr size_t WS_WOUT = 34 * MiB;
constexpr size_t WS_WGU = 48 * MiB;
constexpr size_t WS_WD = 304 * MiB;
constexpr size_t WS_H1 = 432 * MiB;
constexpr size_t WS_PROJ = 464 * MiB;
constexpr size_t WS_R = 568 * MiB, WS_KK = 584 * MiB, WS_V = 600 * MiB;
constexpr size_t WS_WDEC = 616 * MiB;
constexpr size_t WS_KD = 680 * MiB, WS_BB = 712 * MiB;
constexpr size_t WS_G = 744 * MiB;
constexpr size_t WS_OC = 760 * MiB;
constexpr size_t WS_YS = 792 * MiB;
constexpr size_t WS_MIX = 856 * MiB;
constexpr size_t WS_X1 = 888 * MiB;
constexpr size_t WS_H2 = 952 * MiB;
constexpr size_t WS_HID = 528 * MiB, WS_YE = 592 * MiB;
constexpr size_t WS_PART = WS_X1;
constexpr size_t WS_END = 984 * MiB;
constexpr int CW_BAR = 4096;

constexpr int LDS_BYTES = 147456;
constexpr int MISC_OFF = 131072 + 320;

#define GAS __attribute__((address_space(1)))
#define LAS __attribute__((address_space(3)))
typedef unsigned short bf16_t;
typedef float f32x4 __attribute__((ext_vector_type(4)));
typedef float f32x2 __attribute__((ext_vector_type(2)));
typedef float f32x16 __attribute__((ext_vector_type(16)));
typedef unsigned u32x4 __attribute__((ext_vector_type(4)));
typedef unsigned u32x2 __attribute__((ext_vector_type(2)));
typedef short bf16x8 __attribute__((ext_vector_type(8)));
typedef short s16x4 __attribute__((ext_vector_type(4)));
typedef __bf16 bf16x2_t __attribute__((ext_vector_type(2)));

__device__ __forceinline__ unsigned cvtpk(float lo, float hi) { f32x2 v = {lo, hi}; bf16x2_t b = __builtin_convertvector(v, bf16x2_t); return __builtin_bit_cast(unsigned, b); }
__device__ __forceinline__ float bf_lo(unsigned w) { return __uint_as_float(w << 16); }
__device__ __forceinline__ float bf_hi(unsigned w) { return __uint_as_float(w & 0xffff0000u); }
__device__ __forceinline__ float bf2f(bf16_t v) { return __uint_as_float((unsigned)v << 16); }
__device__ __forceinline__ float wave_sum(float v) {
#pragma unroll
    for (int o = 1; o < 64; o <<= 1) v += __shfl_xor(v, o);
    return v;
}
__device__ __forceinline__ float sigmoidf_(float x) { return 1.f / (1.f + __expf(-x)); }

struct Args { const void* in[28]; float* out; unsigned char* ws; int ph_lo, ph_hi, li, pad; };

namespace pg8 {
#define PG8_LAS __attribute__((address_space(3)))
typedef unsigned short bf16_t;
typedef short bf16x8 __attribute__((ext_vector_type(8)));
typedef float f32x4 __attribute__((ext_vector_type(4)));
typedef unsigned u32x4 __attribute__((ext_vector_type(4)));
typedef unsigned u32x2 __attribute__((ext_vector_type(2)));
typedef int i32x4 __attribute__((ext_vector_type(4)));
typedef int i32x8 __attribute__((ext_vector_type(8)));
typedef float f32x8 __attribute__((ext_vector_type(8)));
typedef float f32x32 __attribute__((ext_vector_type(32)));
constexpr int BM = 256, BK = 64, HALF = 128, HTB = HALF * BK * 2  , STAGE_BYTES = 8 * HTB, NXCD = 8, WGM = 8;

__host__ __device__ __forceinline__ int lds_byte(int r, int c) { const int st = (r >> 4) * 2 + (c >> 5), rr = r & 15, cc = c & 31, ob = rr * 64 + cc * 2; return st * 1024 + (ob ^ (((ob >> 9) & 1) << 5)); }
__host__ __device__ __forceinline__ void stage_rc(int b, int& R, int& C) { const int st = b / 1024, sb = b % 1024, swz = sb ^ (((sb >> 9) & 1) << 5); R = (st >> 1) * 16 + swz / 64; C = (st & 1) * 32 + (swz % 64) / 2; }
__host__ __device__ __forceinline__ int perm32(int rho) { const int n = rho >> 4, i = rho & 15; return 8 * (i >> 2) + 4 * n + (i & 3); }

struct Unit { int pm, pn, pk; };
struct Gemm { const bf16_t* A; const bf16_t* Bt; int M, N, K, Kp; };

struct StaticOrder {
    int nM, nN, nwg, G, c;
    __host__ __device__ void init(int M, int N, int G_, int c_) { nM = M / BM; nN = N / BM; nwg = nM * nN; G = G_; c = c_; }
    __host__ __device__ bool next(int i, Unit& u) const {
        const long L = (long)i * G + c; if (L >= nwg) return false;
        int wgid = (int)L; { const int q = nwg / NXCD, r = nwg % NXCD, xcd = wgid % NXCD, off = wgid / NXCD; wgid = (xcd < r ? xcd * (q + 1) : r * (q + 1) + (xcd - r) * q) + off; }
        const int nig = WGM * nN, gid = wgid / nig, fm = gid * WGM, gsz = (nM - fm) < WGM ? (nM - fm) : WGM;
        u.pm = fm + ((wgid % nig) % gsz); u.pn = (wgid % nig) / gsz; u.pk = 0; return true;
    }
    static constexpr bool GATHER = false;
    __device__ __forceinline__ int arow(const Unit&, int) const { return 0; }
    __device__ __forceinline__ void a_ready(const Unit&) const {}
    __device__ __forceinline__ void done(const Unit&) const {}
};


typedef float f32x2 __attribute__((ext_vector_type(2)));
typedef __bf16 bf16x2_t __attribute__((ext_vector_type(2)));
__device__ __forceinline__ unsigned cvt_pk_bf16(float lo, float hi) { f32x2 v = {lo, hi}; bf16x2_t b = __builtin_convertvector(v, bf16x2_t); return __builtin_bit_cast(unsigned, b); }

template <bool GATHER_> struct MoeOrderT {
    static constexpr bool GATHER = GATHER_;
    int G, vcu, npn, total; const int* idx;
    __device__ __forceinline__ int arow(const Unit& u, int r) const { return idx[u.pm * BM + r]; }
    __device__ bool next(int i, Unit& u) const {
        const int L = i * G + vcu; if (L >= total) return false;
        const int per_e = 4 * npn, e = L / per_e, r = L % per_e;
        u.pm = e * 4 + (r & 3); u.pn = e * npn + (r >> 2); u.pk = 0; return true;
    }
    __device__ __forceinline__ void a_ready(const Unit&) const {}
    __device__ __forceinline__ void done(const Unit&) const {}
};

struct TailOrder {
    int G, c; static constexpr bool GATHER = false;
    __device__ bool next(int i, Unit& u) const { const int L = i * G + c; if (L >= 256) return false; u.pk = L & 3; const int t = L >> 2; u.pm = t & 31; u.pn = 24 + (t >> 5); return true; }
    __device__ __forceinline__ int arow(const Unit&, int) const { return 0; }
    __device__ __forceinline__ void a_ready(const Unit&) const {}
    __device__ __forceinline__ void done(const Unit&) const {}
};
struct EpiPart {
    static constexpr bool PERM = true, AFTER_DRAIN = false;
    bf16_t* P;
    __device__ __forceinline__ void operator()(const f32x4 (&acc)[2][2][4][2], const Unit& u, int wr, int wc, int fr, int fq) const {
        bf16_t* base = P + ((size_t)(((u.pn - 24) * 32 + u.pm) * 4 + u.pk) << 16);
        const int row0 = wr * 64 + fr, col0 = wc * 32 + 8 * fq;
        const bool thin = (u.pn == 25);
        if (thin && wc != 0) return;
#pragma unroll
        for (int ai = 0; ai < 2; ++ai)
#pragma unroll
            for (int m = 0; m < 4; ++m) {
                bf16_t* rowp = base + (row0 + ai * HALF + m * 16) * 256 + col0;
#pragma unroll
                for (int bj = 0; bj < 2; ++bj) { if (bj == 1 && thin) break; const f32x4 v0 = acc[ai][bj][m][0], v1 = acc[ai][bj][m][1];
                    u32x4 w; w.x = cvt_pk_bf16(v0[0], v0[1]); w.y = cvt_pk_bf16(v0[2], v0[3]); w.z = cvt_pk_bf16(v1[0], v1[1]); w.w = cvt_pk_bf16(v1[2], v1[3]);
                    *(u32x4*)(rowp + bj * HALF) = w; }
            }
    }
};

struct EpiProj {
    static constexpr bool PERM = true, AFTER_DRAIN = false;
    bf16_t* P; int ldp; const float* rope; float qscale;
    __device__ __forceinline__ void operator()(const f32x4 (&acc)[2][2][4][2], const Unit& u, int wr, int wc, int fr, int fq) const {
        const int row0 = u.pm * BM + wr * 64 + fr, colt = u.pn * BM, col0 = colt + wc * 32 + 8 * fq;
        const bool ropew = (colt < 2048) && ((wc & 1) == 0);
        const float sc = (colt < 1024) ? qscale : 1.f, sgn = (fq == 0) ? -1.f : 1.f;
#pragma unroll
        for (int ai = 0; ai < 2; ++ai)
#pragma unroll
            for (int m = 0; m < 4; ++m) {
                const int row = row0 + ai * HALF + m * 16;
                f32x4 c0 = {1.f, 1.f, 1.f, 1.f}, c1 = c0, s0 = {0.f, 0.f, 0.f, 0.f}, s1 = s0;
                if (ropew) { const f32x4* rp = (const f32x4*)(rope + (size_t)row * 16); c0 = rp[0]; c1 = rp[1]; s0 = rp[2]; s1 = rp[3]; }
                bf16_t* rowp = P + (size_t)row * ldp + col0;
#pragma unroll
                for (int bj = 0; bj < 2; ++bj) {
                    f32x4 v0 = acc[ai][bj][m][0], v1 = acc[ai][bj][m][1];
                    if (ropew) {
                        f32x4 p0, p1;
#pragma unroll
                        for (int i = 0; i < 4; ++i) { p0[i] = __shfl_xor(v0[i], 16); p1[i] = __shfl_xor(v1[i], 16); }
                        if (fq < 2) { v0 = v0 * c0 + (p0 * s0) * sgn; v1 = v1 * c1 + (p1 * s1) * sgn; }
                    }
                    v0 = v0 * sc; v1 = v1 * sc;
                    u32x4 w; w.x = cvt_pk_bf16(v0[0], v0[1]); w.y = cvt_pk_bf16(v0[2], v0[3]); w.z = cvt_pk_bf16(v1[0], v1[1]); w.w = cvt_pk_bf16(v1[2], v1[3]);
                    *(u32x4*)(rowp + bj * HALF) = w;
                }
            }
    }
};

struct EpiResid {
    static constexpr bool PERM = true, AFTER_DRAIN = false;
    const float* base; bf16_t* out; int ldc;
    __device__ __forceinline__ void operator()(const f32x4 (&acc)[2][2][4][2], const Unit& u, int wr, int wc, int fr, int fq) const {
        const int row0 = u.pm * BM + wr * 64 + fr, col0 = u.pn * BM + wc * 32 + 8 * fq;
#pragma unroll
        for (int ai = 0; ai < 2; ++ai)
#pragma unroll
            for (int m = 0; m < 4; ++m) {
                const size_t off = (size_t)(row0 + ai * HALF + m * 16) * ldc + col0;
#pragma unroll
                for (int bj = 0; bj < 2; ++bj) { const f32x4 b0 = *(const f32x4*)(base + off + bj * HALF), b1 = *(const f32x4*)(base + off + bj * HALF + 4);
                    const f32x4 v0 = b0 + acc[ai][bj][m][0], v1 = b1 + acc[ai][bj][m][1];
                    u32x4 w; w.x = cvt_pk_bf16(v0[0], v0[1]); w.y = cvt_pk_bf16(v0[2], v0[3]); w.z = cvt_pk_bf16(v1[0], v1[1]); w.w = cvt_pk_bf16(v1[2], v1[3]);
                    *(u32x4*)(out + off + bj * HALF) = w; }
            }
    }
};

__device__ __forceinline__ float clamp8(float x) { return __builtin_fminf(__builtin_fmaxf(x, -448.f), 448.f); }
__device__ __forceinline__ unsigned cvt4_fp8(float a, float b, float c, float d) {
    int w = __builtin_amdgcn_cvt_pk_fp8_f32(clamp8(a), clamp8(b), 0, false); w = __builtin_amdgcn_cvt_pk_fp8_f32(clamp8(c), clamp8(d), w, true); return (unsigned)w; }
constexpr float W8_SCALE = 64.f, W8_DESCALE = 1.f / 64.f;

struct EpiSwiglu {
    static constexpr bool PERM = true, AFTER_DRAIN = false;
    unsigned char* H; int npn;
    __device__ __forceinline__ void operator()(const f32x4 (&acc)[2][2][4][2], const Unit& u, int wr, int wc, int fr, int fq) const {
        const int row0 = u.pm * BM + wr * 64 + fr, pnl = u.pn % npn, col0 = pnl * HALF + wc * 32 + 8 * fq;
#pragma unroll
        for (int ai = 0; ai < 2; ++ai)
#pragma unroll
            for (int m = 0; m < 4; ++m) {
                unsigned char* rowp = H + (size_t)(row0 + ai * HALF + m * 16) * 2048 + col0;
                float h[8];
#pragma unroll
                for (int n = 0; n < 2; ++n)
#pragma unroll
                    for (int i = 0; i < 4; ++i) { const float g = acc[ai][0][m][n][i] * W8_DESCALE, up = acc[ai][1][m][n][i] * W8_DESCALE; h[n * 4 + i] = g * up * __builtin_amdgcn_rcpf(1.f + __expf(-g)); }
                u32x2 w; w.x = cvt4_fp8(h[0], h[1], h[2], h[3]); w.y = cvt4_fp8(h[4], h[5], h[6], h[7]);
                *(u32x2*)rowp = w;
            }
    }
};

constexpr float YE_SCALE = 16.f, YE_DESCALE = 1.f / 16.f;
struct EpiDown {
    static constexpr bool PERM = true, AFTER_DRAIN = false;
    unsigned char* Y; const float* gate; int npn;
    __device__ __forceinline__ void operator()(const f32x4 (&acc)[2][2][4][2], const Unit& u, int wr, int wc, int fr, int fq) const {
        const int row0 = u.pm * BM + wr * 64 + fr, pnl = u.pn % npn, col0 = pnl * BM + wc * 32 + 8 * fq;
#pragma unroll
        for (int ai = 0; ai < 2; ++ai)
#pragma unroll
            for (int m = 0; m < 4; ++m) {
                const int row = row0 + ai * HALF + m * 16; const float gt = gate[row] * (W8_DESCALE * YE_SCALE);
                unsigned char* rowp = Y + (size_t)row * 2048 + col0;
#pragma unroll
                for (int bj = 0; bj < 2; ++bj) { const f32x4 v0 = acc[ai][bj][m][0] * gt, v1 = acc[ai][bj][m][1] * gt;
                    u32x2 w; w.x = cvt4_fp8(v0[0], v0[1], v0[2], v0[3]); w.y = cvt4_fp8(v1[0], v1[1], v1[2], v1[3]);
                    *(u32x2*)(rowp + bj * HALF) = w; }
            }
    }
};

template <class Epi, class Sched, bool ALIGN_EPI = false, bool SP2 = false, bool FP8 = false>
__device__ __forceinline__ void gemm_phase(PG8_LAS unsigned char* lds, const Gemm g, const Sched& S, const Epi& E) {
    const int tid = threadIdx.x, wid = __builtin_amdgcn_readfirstlane(tid >> 6), lane = tid & 63, wr = wid >> 2, wc = wid & 3, fr = lane & 15, fq = lane >> 4;
    const int K = g.Kp, nt = g.K / BK;
    const size_t kslice = (size_t)g.K * 2;
    unsigned voffA[2], voffB[2];
#pragma unroll
    for (int i = 0; i < 2; ++i) { int R, C; stage_rc(tid * 16 + i * 8192, R, C); const int Rb = Epi::PERM ? ((R & ~31) + perm32(R & 31)) : R;
        voffA[i] = (unsigned)(R * K + C) * 2u; voffB[i] = (unsigned)(Rb * K + C) * 2u; }
    static_assert(!Sched::GATHER || SP2, "gathered A rows: SP2 loop only");
    const size_t kstep = (size_t)(BK * 2);
    const size_t hstep = (size_t)HALF * K * 2;
    const size_t tstep = 2 * hstep;
    const unsigned ldsw = (unsigned)wid * 1024u;
    const int aoff = lds_byte(wr * 64 + fr, fq * 8), boff = lds_byte(wc * 32 + fr, fq * 8);
#define PG8_SA(b, h) (((b) * 2 + (h)) * HTB)
#define PG8_SB(b, h) ((4 + (b) * 2 + (h)) * HTB)
#define PG8_STAGE(bufoff, gbase, voff) do { _Pragma("unroll") for (int _i = 0; _i < 2; ++_i) \
        __builtin_amdgcn_global_load_lds((const unsigned*)((const char*)(gbase) + (voff)[_i]), (PG8_LAS unsigned*)(lds + (bufoff) + ldsw + _i * 8192), 16, 0, 0); } while (0)
#define PG8_LDA(dst, b, h) do { _Pragma("unroll") for (int m = 0; m < 4; ++m) _Pragma("unroll") for (int k = 0; k < 2; ++k) dst[m][k] = *(const PG8_LAS bf16x8*)(lds + PG8_SA(b, h) + aoff + m * 2048 + k * 1024); } while (0)
#define PG8_LDB(dst, b, h) do { _Pragma("unroll") for (int n = 0; n < 2; ++n) _Pragma("unroll") for (int k = 0; k < 2; ++k) dst[n][k] = *(const PG8_LAS bf16x8*)(lds + PG8_SB(b, h) + boff + n * 2048 + k * 1024); } while (0)
#define PG8_CAT8(x, y) __builtin_shufflevector(__builtin_bit_cast(i32x4, x), __builtin_bit_cast(i32x4, y), 0, 1, 2, 3, 4, 5, 6, 7)
#define PG8_W8(c) __builtin_shufflevector(c, c, 0, 1, 2, 3, -1, -1, -1, -1)
#define PG8_MMA(ai, bj, At, Bt) do { __builtin_amdgcn_s_setprio(1); \
        if constexpr (FP8) { f32x32 a_ = acc32[ai][bj]; _Pragma("unroll") for (int m = 0; m < 4; ++m) _Pragma("unroll") for (int n = 0; n < 2; ++n) { \
            f32x4 c_ = {a_[(m * 2 + n) * 4], a_[(m * 2 + n) * 4 + 1], a_[(m * 2 + n) * 4 + 2], a_[(m * 2 + n) * 4 + 3]}; \
            c_ = __builtin_amdgcn_mfma_scale_f32_16x16x128_f8f6f4(PG8_CAT8(Bt[n][0], Bt[n][1]), PG8_CAT8(At[m][0], At[m][1]), c_, 0, 0, 0, 0, 0, 0); \
            a_[(m * 2 + n) * 4] = c_[0]; a_[(m * 2 + n) * 4 + 1] = c_[1]; a_[(m * 2 + n) * 4 + 2] = c_[2]; a_[(m * 2 + n) * 4 + 3] = c_[3]; } acc32[ai][bj] = a_; } \
        else { _Pragma("unroll") for (int m = 0; m < 4; ++m) _Pragma("unroll") for (int n = 0; n < 2; ++n) _Pragma("unroll") for (int k = 0; k < 2; ++k) \
            acc[ai][bj][m][n] = __builtin_amdgcn_mfma_f32_16x16x32_bf16(Bt[n][k], At[m][k], acc[ai][bj][m][n], 0, 0, 0); } __builtin_amdgcn_s_setprio(0); } while (0)
#define PG8_WAIT_V(n) asm volatile("s_waitcnt vmcnt(" #n ")" ::: "memory")
#define PG8_WAIT_L(n) asm volatile("s_waitcnt lgkmcnt(" #n ")" ::: "memory")
#define PG8_BAR __builtin_amdgcn_s_barrier()
#define PG8_SCHED __builtin_amdgcn_sched_barrier(0)
    Unit cur, nxt; int ui = 0;
    if (!S.next(0, cur)) return;
    f32x4 acc[2][2][4][2]; f32x32 acc32[2][2];
#pragma unroll
    for (int a = 0; a < 2; ++a)
#pragma unroll
        for (int b = 0; b < 2; ++b)
#pragma unroll
            for (int m = 0; m < 4; ++m) {
#pragma unroll
                for (int n = 0; n < 2; ++n) { acc[a][b][m][n] = (f32x4){0.f, 0.f, 0.f, 0.f};
#pragma unroll
                    for (int i = 0; i < 4; ++i) acc32[a][b][(m * 2 + n) * 4 + i] = 0.f; } }
    bf16x8 At[4][2], B0[2][2], B1[2][2];
    const char* cA = (const char*)g.A + (size_t)cur.pm * tstep + (size_t)cur.pk * kslice; const char* cB = (const char*)g.Bt + (size_t)cur.pn * tstep + (size_t)cur.pk * kslice;
    unsigned cvA0[2], cvA1[2], nvA0[2], nvA1[2];
#pragma unroll
    for (int i = 0; i < 2; ++i) { int R, C; stage_rc(tid * 16 + i * 8192, R, C);
        if constexpr (Sched::GATHER) { cvA0[i] = (unsigned)(S.arow(cur, R) * K + C) * 2u; cvA1[i] = (unsigned)(S.arow(cur, HALF + R) * K + C) * 2u; }
        else { cvA0[i] = voffA[i]; cvA1[i] = voffA[i] + (unsigned)hstep; }
        nvA0[i] = cvA0[i]; nvA1[i] = cvA1[i]; }
    if constexpr (Sched::GATHER) cA = (const char*)g.A;
    S.a_ready(cur);
    if constexpr (SP2) {
        PG8_STAGE(PG8_SB(0, 0), cB, voffB); PG8_STAGE(PG8_SB(0, 1), cB + hstep, voffB); PG8_STAGE(PG8_SA(0, 0), cA, cvA0); PG8_STAGE(PG8_SA(0, 1), cA, cvA1);
        if (wr == 1) PG8_BAR;
        PG8_WAIT_V(2); PG8_BAR;
        PG8_STAGE(PG8_SB(1, 0), cB + kstep, voffB); PG8_STAGE(PG8_SA(1, 0), cA + kstep, cvA0); PG8_STAGE(PG8_SB(1, 1), cB + hstep + kstep, voffB);
        PG8_WAIT_V(6); PG8_BAR;
    } else {
        PG8_STAGE(PG8_SB(0, 0), cB, voffB); PG8_STAGE(PG8_SA(0, 0), cA, voffA); PG8_STAGE(PG8_SB(0, 1), cB + hstep, voffB); PG8_STAGE(PG8_SA(0, 1), cA + hstep, voffA);
        if (wr == 1) PG8_BAR;
        PG8_WAIT_V(4); PG8_BAR;
        PG8_STAGE(PG8_SB(1, 0), cB + kstep, voffB); PG8_STAGE(PG8_SA(1, 0), cA + kstep, voffA); PG8_STAGE(PG8_SB(1, 1), cB + hstep + kstep, voffB);
        PG8_WAIT_V(6); PG8_BAR;
    }
    for (;;) {
        const bool has_next = S.next(ui + 1, nxt);
        const char* nA = Sched::GATHER ? (const char*)g.A : (has_next ? (const char*)g.A + (size_t)nxt.pm * tstep + (size_t)nxt.pk * kslice : cA);
        if constexpr (Sched::GATHER) { if (has_next) {
#pragma unroll
            for (int i = 0; i < 2; ++i) { int R, C; stage_rc(tid * 16 + i * 8192, R, C); nvA0[i] = (unsigned)(S.arow(nxt, R) * K + C) * 2u; nvA1[i] = (unsigned)(S.arow(nxt, HALF + R) * K + C) * 2u; } } } const char* nB = has_next ? (const char*)g.Bt + (size_t)nxt.pn * tstep + (size_t)nxt.pk * kslice : cB;
        for (int t = 0; t < nt; t += 2) {
            const bool last = (t == nt - 2);
            const char* a1 = cA + (size_t)(t + 1) * kstep;
            const char* a2 = last ? nA : cA + (size_t)(t + 2) * kstep; const char* b2 = last ? nB : cB + (size_t)(t + 2) * kstep;
            const char* a3 = a2 + kstep; const char* b3 = b2 + kstep;
            if (last && has_next) S.a_ready(nxt);
            unsigned sA0[2], sA1[2];
#pragma unroll
            for (int i = 0; i < 2; ++i) { sA0[i] = last ? nvA0[i] : cvA0[i]; sA1[i] = last ? nvA1[i] : cvA1[i]; }
            if constexpr (SP2) {
            PG8_LDB(B0, 0, 0); PG8_LDB(B1, 0, 1); PG8_SCHED; PG8_LDA(At, 0, 0); PG8_STAGE(PG8_SA(1, 1), a1, cvA1);
            PG8_WAIT_V(8); PG8_WAIT_L(0); PG8_BAR; PG8_MMA(0, 0, At, B0); PG8_MMA(0, 1, At, B1); PG8_BAR; PG8_SCHED;
            PG8_LDA(At, 0, 1); PG8_STAGE(PG8_SB(0, 0), b2, voffB); PG8_STAGE(PG8_SB(0, 1), b2 + hstep, voffB); PG8_STAGE(PG8_SA(0, 0), a2, sA0);
            PG8_WAIT_V(8); PG8_WAIT_L(0); PG8_BAR; PG8_MMA(1, 0, At, B0); PG8_MMA(1, 1, At, B1); PG8_BAR; PG8_SCHED;
            PG8_LDB(B0, 1, 0); PG8_LDB(B1, 1, 1); PG8_SCHED; PG8_LDA(At, 1, 0); PG8_STAGE(PG8_SA(0, 1), a2, sA1);
            PG8_WAIT_V(8); PG8_WAIT_L(0); PG8_BAR; PG8_MMA(0, 0, At, B0); PG8_MMA(0, 1, At, B1); PG8_BAR; PG8_SCHED;
            PG8_LDA(At, 1, 1); PG8_STAGE(PG8_SB(1, 0), b3, voffB); PG8_STAGE(PG8_SB(1, 1), b3 + hstep, voffB); PG8_STAGE(PG8_SA(1, 0), a3, sA0);
            PG8_WAIT_V(8); PG8_WAIT_L(0); PG8_BAR; PG8_MMA(1, 0, At, B0); PG8_MMA(1, 1, At, B1); PG8_BAR; PG8_SCHED;
            } else {
            PG8_LDB(B0, 0, 0); PG8_SCHED; PG8_LDA(At, 0, 0); PG8_STAGE(PG8_SA(1, 1), a1 + hstep, voffA);
            PG8_WAIT_L(8); PG8_BAR; PG8_WAIT_L(0); PG8_MMA(0, 0, At, B0); PG8_BAR; PG8_SCHED;
            PG8_LDB(B1, 0, 1); PG8_STAGE(PG8_SB(0, 0), b2, voffB);
            PG8_BAR; PG8_WAIT_L(0); PG8_MMA(0, 1, At, B1); PG8_BAR;
            PG8_LDA(At, 0, 1); PG8_STAGE(PG8_SA(0, 0), a2, voffA);
            PG8_BAR; PG8_WAIT_L(0); PG8_MMA(1, 0, At, B0); PG8_BAR; PG8_SCHED;
            PG8_STAGE(PG8_SB(0, 1), b2 + hstep, voffB);
            PG8_WAIT_V(6); PG8_BAR; PG8_MMA(1, 1, At, B1); PG8_BAR;
            PG8_LDB(B0, 1, 0); PG8_SCHED; PG8_LDA(At, 1, 0); PG8_STAGE(PG8_SA(0, 1), a2 + hstep, voffA);
            PG8_WAIT_L(8); PG8_BAR; PG8_WAIT_L(0); PG8_MMA(0, 0, At, B0); PG8_BAR; PG8_SCHED;
            PG8_LDB(B1, 1, 1); PG8_STAGE(PG8_SB(1, 0), b3, voffB);
            PG8_BAR; PG8_WAIT_L(0); PG8_MMA(0, 1, At, B1); PG8_BAR;
            PG8_LDA(At, 1, 1); PG8_STAGE(PG8_SA(1, 0), a3, voffA);
            PG8_BAR; PG8_WAIT_L(0); PG8_MMA(1, 0, At, B0); PG8_BAR; PG8_SCHED;
            PG8_STAGE(PG8_SB(1, 1), b3 + hstep, voffB);
            PG8_WAIT_V(6); PG8_BAR; PG8_MMA(1, 1, At, B1); PG8_BAR;
            }
        }
        if constexpr (ALIGN_EPI) { if (wr == 0) PG8_BAR; }
        if constexpr (FP8) {
#pragma unroll
            for (int a = 0; a < 2; ++a)
#pragma unroll
                for (int b = 0; b < 2; ++b)
#pragma unroll
                    for (int m = 0; m < 4; ++m)
#pragma unroll
                        for (int n = 0; n < 2; ++n)
#pragma unroll
                            for (int i = 0; i < 4; ++i) acc[a][b][m][n][i] = acc32[a][b][(m * 2 + n) * 4 + i]; }
        if constexpr (!Epi::AFTER_DRAIN) { E(acc, cur, wr, wc, fr, fq); S.done(cur); }
        if (!has_next) break;
#pragma unroll
        for (int a = 0; a < 2; ++a)
#pragma unroll
            for (int b = 0; b < 2; ++b)
#pragma unroll
                for (int m = 0; m < 4; ++m) {
#pragma unroll
                    for (int n = 0; n < 2; ++n) { acc[a][b][m][n] = (f32x4){0.f, 0.f, 0.f, 0.f};
#pragma unroll
                        for (int i = 0; i < 4; ++i) acc32[a][b][(m * 2 + n) * 4 + i] = 0.f; } }
        cur = nxt; cA = nA; cB = nB; ++ui;
#pragma unroll
        for (int i = 0; i < 2; ++i) { cvA0[i] = nvA0[i]; cvA1[i] = nvA1[i]; }
        if constexpr (ALIGN_EPI) { if (wr == 1) PG8_BAR; }
    }
    PG8_WAIT_V(0);
    if constexpr (!ALIGN_EPI) { if (wr == 0) PG8_BAR; }
    PG8_BAR;
    if constexpr (Epi::AFTER_DRAIN) { E.fused(acc, cur, wr, wc, fr, fq, lds, wid, lane); S.done(cur); }
#undef PG8_SA
#undef PG8_SB
#undef PG8_STAGE
#undef PG8_LDA
#undef PG8_LDB
#undef PG8_MMA
#undef PG8_CAT8
#undef PG8_W8
#undef PG8_WAIT_V
#undef PG8_WAIT_L
#undef PG8_BAR
#undef PG8_SCHED
}
}

namespace att {
constexpr int NW = 8, QBLK = 32, KVBLK = 64;
constexpr float THR = 8.f;
constexpr int SHM_V = KVBLK * 128 * 2, SHM_K = KVBLK * 64 * 2;
constexpr int SHM_ATTN = 2 * SHM_V + 2 * SHM_K + NW * 64 * 4;
#define KSWZ64(row, colB) ((row) * 128 + ((colB) ^ ((((row) >> 1) & 7) << 4)))
#define SBAR() __builtin_amdgcn_sched_barrier(0)
__device__ __forceinline__ int crow(int r, int hi) { return (r & 3) + 8 * (r >> 2) + 4 * hi; }

__device__ __forceinline__ void partialSM(f32x16& p0, f32x16& p1, float& m_reg, float& mn, float& alpha) {
  float pmax = p0[0];
#pragma unroll
  for (int r = 1; r < 16; ++r) pmax = fmaxf(pmax, p0[r]);
#pragma unroll
  for (int r = 0; r < 16; ++r) pmax = fmaxf(pmax, p1[r]);
  { auto rr = __builtin_amdgcn_permlane32_swap(__float_as_uint(pmax), __float_as_uint(pmax), false, false);
    pmax = fmaxf(__uint_as_float(rr[0]), __uint_as_float(rr[1])); }
  if (__builtin_expect(__all(pmax - m_reg <= THR), 1)) { mn = m_reg; alpha = 1.f; }
  else { mn = fmaxf(m_reg, pmax); alpha = __builtin_amdgcn_exp2f(m_reg - mn); m_reg = mn; }
#pragma unroll
  for (int r = 0; r < 16; ++r) p0[r] = p0[r] - mn;
#pragma unroll
  for (int r = 0; r < 16; ++r) p1[r] = p1[r] - mn;
#pragma unroll
  for (int r = 0; r < 16; ++r) p0[r] = __builtin_amdgcn_exp2f(p0[r]);
}
__device__ __forceinline__ void finishSM(f32x16& p0, f32x16& p1, float alpha, float& l_reg, bf16x8& pa0, bf16x8& pa1, bf16x8& pa2, bf16x8& pa3) {
#pragma unroll
  for (int r = 0; r < 16; ++r) p1[r] = __builtin_amdgcn_exp2f(p1[r]);
  float ps = 0;
#pragma unroll
  for (int r = 0; r < 16; ++r) ps += p0[r];
#pragma unroll
  for (int r = 0; r < 16; ++r) ps += p1[r];
  { auto rr = __builtin_amdgcn_permlane32_swap(__float_as_uint(ps), __float_as_uint(ps), false, false);
    ps = __uint_as_float(rr[0]) + __uint_as_float(rr[1]); }
  l_reg = l_reg * alpha + ps;
#define PK4(P, BASE, OUT) do { unsigned a0 = cvtpk(P[BASE + 0], P[BASE + 1]), a1 = cvtpk(P[BASE + 2], P[BASE + 3]);   \
    unsigned b0 = cvtpk(P[BASE + 4], P[BASE + 5]), b1 = cvtpk(P[BASE + 6], P[BASE + 7]);                              \
    auto r0 = __builtin_amdgcn_permlane32_swap(a0, b0, false, false); auto r1 = __builtin_amdgcn_permlane32_swap(a1, b1, false, false); \
    u32x4 w = {r0[0], r1[0], r0[1], r1[1]}; OUT = __builtin_bit_cast(bf16x8, w); } while (0)
  PK4(p0, 0, pa0); PK4(p0, 8, pa1); PK4(p1, 0, pa2); PK4(p1, 8, pa3);
#undef PK4
}
__device__ __forceinline__ void qkt(f32x16& p0, f32x16& p1, const char* Ks, const bf16x8* qr, int r32, int hi) {
  p0 = f32x16{}; p1 = f32x16{};
#pragma unroll
  for (int d0 = 0; d0 < 4; ++d0) { const int cb = (d0 * 16 + hi * 8) * 2;
    bf16x8 b0 = *reinterpret_cast<const bf16x8*>(Ks + KSWZ64(r32, cb));
    bf16x8 b1 = *reinterpret_cast<const bf16x8*>(Ks + KSWZ64(32 + r32, cb));
    p0 = __builtin_amdgcn_mfma_f32_32x32x16_bf16(b0, qr[d0], p0, 0, 0, 0);
    p1 = __builtin_amdgcn_mfma_f32_32x32x16_bf16(b1, qr[d0], p1, 0, 0, 0); }
}
__device__ __forceinline__ int v_st(int k, int c) { const int kk = (k & ~0xC) | ((k & 4) << 1) | ((k & 8) >> 1); return ((kk >> 3) * 4 + (c >> 5)) * 512 + ((kk & 7) * 32 + (c & 31)) * 2; }
__device__ __forceinline__ int v_rd_base(int lane) { return ((lane & 3) << 3) | (((lane >> 2) & 3) << 6) | (((lane >> 4) & 1) << 5) | (((lane >> 5) & 1) << 8); }
constexpr int v_rd_off(int d0, int ks, int half) { return d0 * 512 + ks * 4096 + half * 2048; }
template <int OFF> __device__ __forceinline__ s16x4 tr_read(int vb) {
  s16x4 r; asm volatile("ds_read_b64_tr_b16 %0, %1 offset:%2" : "=&v"(r) : "v"(vb), "i"(OFF) : "memory"); return r;
}
template <int D0> __device__ __forceinline__ void pv_one(f32x16& od, int vb, bf16x8 pa0, bf16x8 pa1, bf16x8 pa2, bf16x8 pa3) {
  const s16x4 l0 = tr_read<v_rd_off(D0, 0, 0)>(vb), h0 = tr_read<v_rd_off(D0, 0, 1)>(vb), l1 = tr_read<v_rd_off(D0, 1, 0)>(vb), h1 = tr_read<v_rd_off(D0, 1, 1)>(vb);
  const s16x4 l2 = tr_read<v_rd_off(D0, 2, 0)>(vb), h2 = tr_read<v_rd_off(D0, 2, 1)>(vb), l3 = tr_read<v_rd_off(D0, 3, 0)>(vb), h3 = tr_read<v_rd_off(D0, 3, 1)>(vb);
  asm volatile("s_waitcnt lgkmcnt(0)" ::: "memory"); SBAR();
#define PK(L, H) (bf16x8){L[0], L[1], L[2], L[3], H[0], H[1], H[2], H[3]}
  od = __builtin_amdgcn_mfma_f32_32x32x16_bf16(pa0, PK(l0, h0), od, 0, 0, 0);
  od = __builtin_amdgcn_mfma_f32_32x32x16_bf16(pa1, PK(l1, h1), od, 0, 0, 0);
  od = __builtin_amdgcn_mfma_f32_32x32x16_bf16(pa2, PK(l2, h2), od, 0, 0, 0);
  od = __builtin_amdgcn_mfma_f32_32x32x16_bf16(pa3, PK(l3, h3), od, 0, 0, 0);
#undef PK
}
__device__ __forceinline__ void pv_d0(f32x16* o, int vb, bf16x8 pa0, bf16x8 pa1, bf16x8 pa2, bf16x8 pa3) {
  pv_one<0>(o[0], vb, pa0, pa1, pa2, pa3); pv_one<1>(o[1], vb, pa0, pa1, pa2, pa3); pv_one<2>(o[2], vb, pa0, pa1, pa2, pa3); pv_one<3>(o[3], vb, pa0, pa1, pa2, pa3);
}

template <int LDQ>
__device__ __forceinline__ void attn_unit(const bf16_t* __restrict__ Qb, const bf16_t* __restrict__ Kh, const bf16_t* __restrict__ Vh, bf16_t* __restrict__ Ob, int seq, char* lds) {
  const int tid = threadIdx.x, wid = tid >> 6, lane = tid & 63, r32 = lane & 31, hi = lane >> 5;
  char* V_lds = lds; char* K_lds = lds + 2 * SHM_V;
  float* ws = (float*)(lds + 2 * SHM_V + 2 * SHM_K) + wid * 64; float* li_l = ws; float* al_l = ws + 32;
  float m_reg = -1e30f, l_reg = 0; f32x16 o[4] = {}; bf16x8 qr[4];
  const bf16_t* Qw = Qb + (long)(wid * QBLK + r32) * LDQ + hi * 8;
#pragma unroll
  for (int d0 = 0; d0 < 4; ++d0) qr[d0] = *reinterpret_cast<const bf16x8*>(Qw + d0 * 16);
  const int sr = tid >> 4, sc = (tid & 15) * 8, vst0 = v_st(sr, sc), vst1 = v_st(32 + sr, sc);
  const int kr = tid >> 3, kc8 = (tid & 7) * 8, kst = KSWZ64(kr, kc8 * 2);
  const int vb0 = (int)(uintptr_t)V_lds + v_rd_base(lane);
  struct { bf16x8 vs0, vs1, ks; } sr_[2];
  const bf16_t* Vp0 = Vh + (long)sr * LDQ + sc; const bf16_t* Kp0 = Kh + (long)kr * LDQ + kc8;
#define SLOAD(i, k0) do { const long ko_ = (long)(k0) * LDQ; sr_[i].vs0 = *reinterpret_cast<const bf16x8*>(Vp0 + ko_); sr_[i].vs1 = *reinterpret_cast<const bf16x8*>(Vp0 + ko_ + 32 * LDQ); \
    sr_[i].ks = *reinterpret_cast<const bf16x8*>(Kp0 + ko_); } while (0)
#define SWRITE(b, i) do { *(bf16x8*)(V_lds + (b) * SHM_V + vst0) = sr_[i].vs0; *(bf16x8*)(V_lds + (b) * SHM_V + vst1) = sr_[i].vs1; \
    *(bf16x8*)(K_lds + (b) * SHM_K + kst) = sr_[i].ks; } while (0)
#define SWAIT() asm volatile("s_waitcnt vmcnt(3)" ::: "memory")
#define RESC(a) do { if (__any((a) < 1.f)) { if (hi == 0) al_l[r32] = (a); asm volatile("s_waitcnt lgkmcnt(0)" ::: "memory"); \
    _Pragma("unroll") for (int d = 0; d < 4; ++d) _Pragma("unroll") for (int r = 0; r < 16; ++r) o[d][r] *= al_l[crow(r, hi)]; } } while (0)
  f32x16 pA0, pA1, pB0, pB1; float mnA, mnB, alA, alB; bf16x8 pa0, pa1, pa2, pa3; const int NT = seq / KVBLK;
  constexpr int SE = 0, SO = 1;
  SLOAD(SE, 0); asm volatile("s_waitcnt vmcnt(0)" ::: "memory"); SWRITE(0, SE); __syncthreads();
  qkt(pA0, pA1, K_lds, qr, r32, hi); partialSM(pA0, pA1, m_reg, mnA, alA);
  SLOAD(SO, KVBLK); if (2 < NT) SLOAD(SE, 2 * KVBLK);
  SWAIT(); SWRITE(1, SO); __syncthreads();
  for (int j = 1; j + 1 < NT; j += 2) {
    SBAR(); qkt(pB0, pB1, K_lds + SHM_K, qr, r32, hi);
    finishSM(pA0, pA1, alA, l_reg, pa0, pa1, pa2, pa3); SBAR();
    SLOAD(SO, (j + 2) * KVBLK); SBAR();
    pv_d0(o, vb0, pa0, pa1, pa2, pa3); partialSM(pB0, pB1, m_reg, mnB, alB);
    __syncthreads(); SWAIT(); SWRITE(0, SE);
    RESC(alB); __syncthreads();
    SBAR(); qkt(pA0, pA1, K_lds, qr, r32, hi);
    finishSM(pB0, pB1, alB, l_reg, pa0, pa1, pa2, pa3); SBAR();
    if (j + 3 < NT) SLOAD(SE, (j + 3) * KVBLK); SBAR();
    pv_d0(o, vb0 + SHM_V, pa0, pa1, pa2, pa3); partialSM(pA0, pA1, m_reg, mnA, alA);
    __syncthreads(); SWAIT(); SWRITE(1, SO);
    RESC(alA); __syncthreads();
  }
  SBAR(); qkt(pB0, pB1, K_lds + SHM_K, qr, r32, hi);
  finishSM(pA0, pA1, alA, l_reg, pa0, pa1, pa2, pa3); SBAR();
  pv_d0(o, vb0, pa0, pa1, pa2, pa3); partialSM(pB0, pB1, m_reg, mnB, alB);
  __syncthreads(); RESC(alB);
  finishSM(pB0, pB1, alB, l_reg, pa0, pa1, pa2, pa3); SBAR();
  pv_d0(o, vb0 + SHM_V, pa0, pa1, pa2, pa3);
  if (hi == 0) li_l[r32] = l_reg; asm volatile("s_waitcnt lgkmcnt(0)" ::: "memory");
  float rli[16];
#pragma unroll
  for (int r = 0; r < 16; ++r) rli[r] = __builtin_amdgcn_rcpf(li_l[crow(r, hi)]);
  bf16_t* Ow = Ob + (long)(wid * QBLK) * 1024;
#pragma unroll
  for (int r = 0; r < 16; ++r) { const int orow = crow(r, hi);
#pragma unroll
    for (int d0 = 0; d0 < 4; ++d0) Ow[(long)orow * 1024 + d0 * 32 + r32] = (bf16_t)(cvtpk(o[d0][r] * rli[r], 0.f) & 0xffffu); }
  __syncthreads();
#undef SLOAD
#undef SWRITE
#undef SWAIT
#undef RESC
}
#undef SBAR
}


typedef GAS unsigned gu32;
#define RLX_AGENT __ATOMIC_RELAXED, __HIP_MEMORY_SCOPE_AGENT
#define XB_TMO      128
#define XB_XCNT(j)  (256  + 64 * (j))
#define XB_XSUB(j)  (1280 + 64 * (j))
#define XB_XGEN(j)  (2304 + 64 * (j))
#define XB_TOP      3328
#define XB_TOPGEN   3392
#define XCD_BAR_WORDS 3456
#define XB_SPIN_CAP (1u << 22)
__device__ __forceinline__ unsigned xb_ld(unsigned* p)              { return __hip_atomic_load(p, __ATOMIC_RELAXED, __HIP_MEMORY_SCOPE_AGENT); }
__device__ __forceinline__ unsigned xb_add(unsigned* p, unsigned v) { return __hip_atomic_fetch_add(p, v, __ATOMIC_RELAXED, __HIP_MEMORY_SCOPE_AGENT); }
__device__ __forceinline__ unsigned xb_xcc_id() { return (unsigned)__builtin_amdgcn_s_getreg((3 << 11) | 20) & 0xFu; }
#define XB_SPIN(cond, bar) do { unsigned _sp = 0; while (cond) { __builtin_amdgcn_s_sleep(1); \
    if ((++_sp & 255u) == 0u) { if (xb_ld(&(bar)[XB_TMO])) break; if (_sp > XB_SPIN_CAP) { atomicAdd(&(bar)[XB_TMO], 1u); break; } } } } while (0)
struct XcdBarrier { unsigned* bar; unsigned x; volatile LAS unsigned* st; };
__device__ __forceinline__ XcdBarrier xcd_barrier_post(unsigned* bar, volatile LAS unsigned* st) {
    XcdBarrier b; b.bar = bar; b.x = xb_xcc_id(); b.st = st;
    if (threadIdx.x == 0) (void)xb_add(&bar[XB_XCNT(b.x)], 1u);
    return b;
}
__device__ __forceinline__ void xcd_barrier_complete(unsigned* bar, unsigned x, unsigned& nloc, unsigned& nx) {
    const unsigned G = gridDim.x * gridDim.y * gridDim.z;
    unsigned sum, cnt, mine, sp = 0u;
    for (;;) {
        sum = 0u; cnt = 0u; mine = 0u;
#pragma unroll
        for (unsigned j = 0; j < 16; ++j) { const unsigned c = xb_ld(&bar[XB_XCNT(j)]); sum += c; cnt += (c > 0u) ? 1u : 0u; mine = (j == x) ? c : mine; }
        if (sum == G) break;
        __builtin_amdgcn_s_sleep(1);
        if ((++sp & 255u) == 0u) { if (xb_ld(&bar[XB_TMO])) break; if (sp > XB_SPIN_CAP) { atomicAdd(&bar[XB_TMO], 1u); break; } }
    }
    nloc = mine > 0u ? mine : 1u; nx = cnt > 0u ? cnt : 1u;
}
__device__ __forceinline__ void xcd_barrier(const XcdBarrier& b) {
    asm volatile("s_waitcnt vmcnt(0)" ::: "memory");
    __syncthreads();
    if (threadIdx.x == 0) {
        unsigned* bar = b.bar;
        __builtin_amdgcn_s_waitcnt(0);
        unsigned nloc = b.st[0], nx = b.st[1];
        if (nloc == 0u) { xcd_barrier_complete(bar, b.x, nloc, nx); b.st[0] = nloc; b.st[1] = nx; }
        const unsigned old = xb_add(&bar[XB_XSUB(b.x)], 1u);
        const unsigned gen = old / nloc;
        if (old + 1u == (gen + 1u) * nloc) {
            __builtin_amdgcn_fence(__ATOMIC_RELEASE, "agent");
            asm volatile("s_waitcnt vmcnt(0)" ::: "memory");
            const unsigned og = xb_add(&bar[XB_TOP], 1u);
            const unsigned tg = og / nx;
            if (og + 1u == (tg + 1u) * nx) xb_add(&bar[XB_TOPGEN], 1u);
            else XB_SPIN(xb_ld(&bar[XB_TOPGEN]) == tg, bar);
            __builtin_amdgcn_fence(__ATOMIC_ACQUIRE, "agent");
            xb_add(&bar[XB_XGEN(b.x)], 1u);
            asm volatile("s_waitcnt vmcnt(0)" ::: "memory");
        } else {
            XB_SPIN(xb_ld(&bar[XB_XGEN(b.x)]) == gen, bar);
            __builtin_amdgcn_fence(__ATOMIC_ACQUIRE, "agent");
            asm volatile("s_waitcnt vmcnt(0)" ::: "memory");
        }
    }
    __syncthreads();
}

struct Frame {
    LAS unsigned char* lds; char* ldsg;
    int tid, lane, wave, vcu, G;
    const Args* a;
};
#define INP(F, i, T) ((const T*)(F).a->in[i])
#define WSP(F, off, T) ((T*)((F).a->ws + (off)))

__device__ __forceinline__ void cvt_load(f32x4 (&v)[16], const float* __restrict__ W, int N, int nvalid, int k0, int n0, int lane) {
    const int kq = lane >> 4, nq = lane & 15;
    const unsigned voff = (unsigned)(kq * N + 4 * nq) * 4u;
#pragma unroll
    for (int i = 0; i < 16; ++i) {
        const char* Wu = (const char*)(W + (size_t)(k0 + 4 * i) * N + n0);
        if (4 * nq < nvalid) v[i] = __builtin_nontemporal_load((const f32x4*)(Wu + (size_t)voff)); else v[i] = (f32x4){0.f, 0.f, 0.f, 0.f};
    }
}
__device__ __forceinline__ void cvt_finish(const f32x4 (&v)[16], int k0, bf16_t* __restrict__ WT, int rowb, LAS unsigned char* scr, int lane) {
    const int kq = lane >> 4, nq = lane & 15;
    const int g = lane >> 4, i16 = lane & 15, q = i16 >> 2, p = i16 & 3;
    typedef short v4i16_t __attribute__((ext_vector_type(4)));
#pragma unroll
    for (int hf = 0; hf < 2; ++hf) {
#pragma unroll
        for (int i = 0; i < 8; ++i) {
            const int k = 4 * i + kq, s = ((k >> 1) & 1) | (((k >> 3) & 1) << 1);
            u32x2 w; w.x = cvtpk(v[8 * hf + i].x, v[8 * hf + i].y); w.y = cvtpk(v[8 * hf + i].z, v[8 * hf + i].w);
            *(LAS u32x2*)(scr + k * 128 + ((nq * 8) ^ (s << 5))) = w;
        }
        const int klo = 8 * g + q, s = ((klo >> 1) & 1) | (((klo >> 3) & 1) << 1);
#pragma unroll
        for (int nb = 0; nb < 4; ++nb) {
            const int a_lo = klo * 128 + (((16 * nb + 4 * p) * 2) ^ (s << 5));
            const s16x4 lo = __builtin_bit_cast(s16x4, __builtin_amdgcn_ds_read_tr16_b64_v4i16((LAS v4i16_t*)(scr + a_lo)));
            const s16x4 hi = __builtin_bit_cast(s16x4, __builtin_amdgcn_ds_read_tr16_b64_v4i16((LAS v4i16_t*)(scr + a_lo + 512)));
            bf16x8 o = {lo[0], lo[1], lo[2], lo[3], hi[0], hi[1], hi[2], hi[3]};
            char* Wu = (char*)(WT + (size_t)(rowb + 16 * nb) * 2048 + k0 + 32 * hf);
            __builtin_nontemporal_store(o, (bf16x8*)(Wu + (size_t)(unsigned)((i16 * 2048 + 8 * g) * 2)));
        }
    }
}
__device__ __forceinline__ void cvt8_load(f32x4 (&v)[16], const float* __restrict__ W, int k0, int n0, int lane) {
    const int kq = lane >> 4, nq = lane & 15;
    const unsigned voff = (unsigned)(16 * kq * 2048 + 4 * nq) * 4u;
#pragma unroll
    for (int i = 0; i < 16; ++i) {
        const char* Wu = (const char*)(W + (size_t)(k0 + i) * 2048 + n0);
        v[i] = __builtin_nontemporal_load((const f32x4*)(Wu + (size_t)voff));
    }
}
__device__ __forceinline__ void cvt8_finish(const f32x4 (&v)[16], int k0, unsigned char* __restrict__ W8, int rowb, int lane) {
    const int kq = lane >> 4, nq = lane & 15;
    char* Wu = (char*)(W8 + (size_t)rowb * 2048 + k0);
    const unsigned voff = (unsigned)(4 * nq * 2048 + 16 * kq);
#pragma unroll
    for (int j = 0; j < 4; ++j) {
        u32x4 o;
#pragma unroll
        for (int q = 0; q < 4; ++q) {
            int w = __builtin_amdgcn_cvt_pk_fp8_f32(v[4 * q][j] * pg8::W8_SCALE, v[4 * q + 1][j] * pg8::W8_SCALE, 0, false);
            w = __builtin_amdgcn_cvt_pk_fp8_f32(v[4 * q + 2][j] * pg8::W8_SCALE, v[4 * q + 3][j] * pg8::W8_SCALE, w, true);
            o[q] = (unsigned)w;
        }
        __builtin_nontemporal_store(o, (u32x4*)(Wu + (size_t)(voff + (unsigned)(j * 2048))));
    }
}
__device__ __forceinline__ void cvt_expert_decode(const Frame& F, int r, const float*& W, int& k0, int& n0, unsigned char*& WT, int& rowb) {
    constexpr int I_E = 16 * 32 * 32;
    const int mat = r / I_E; r -= mat * I_E;
    const int e = r >> 10, kt = (r >> 5) & 31, nt = r & 31;
    k0 = kt * 64; n0 = nt * 64;
    if (mat < 2) { W = INP(F, 24 + mat, float) + (size_t)e * 2048 * 2048; WT = WSP(F, WS_WGU, unsigned char); rowb = e * 4096 + (n0 >> 7) * 256 + mat * 128 + (n0 & 127); }
    else { W = INP(F, 26, float) + (size_t)e * 2048 * 2048; WT = WSP(F, WS_WD, unsigned char); rowb = e * 2048 + n0; }
}
constexpr int N_EXPERT_ITEMS = 3 * 16 * 32 * 32;
__device__ __forceinline__ void p0_prologue(Frame& F) {
    LAS unsigned char* scr = F.lds + F.wave * 4096;
    const int gw = F.vcu * 8 + F.wave, NGW = F.G * 8, lane = F.lane;
    const float* w_in = INP(F, 3, float); const float* w_out = INP(F, 21, float);
    bf16_t* WinT = WSP(F, WS_WIN, bf16_t); bf16_t* WoutT = WSP(F, WS_WOUT, bf16_t);
    constexpr int I_IN = 32 * 101, I_OUT = 32 * 32, NITEMS = I_IN + I_OUT;
    for (int it = gw; it < NITEMS; it += NGW) {
        f32x4 v[16];
        if (it < I_IN) { const int kt = it / 101, nt = it % 101; const int nv = (nt == 100) ? 32 : 64; cvt_load(v, w_in, IN_COLS, nv, kt * 64, nt * 64, lane); cvt_finish(v, kt * 64, WinT, nt * 64, scr, lane); }
        else { const int r = it - I_IN, kt = r >> 5, nt = r & 31; cvt_load(v, w_out, 2048, 64, kt * 64, nt * 64, lane); cvt_finish(v, kt * 64, WoutT, nt * 64, scr, lane); }
    }
#if !CVT_IN_SCAN
    for (int it = gw; it < N_EXPERT_ITEMS; it += NGW) {
        f32x4 v[16]; const float* W; int k0, n0, rowb; unsigned char* WT;
        cvt_expert_decode(F, it, W, k0, n0, WT, rowb); cvt8_load(v, W, k0, n0, lane); cvt8_finish(v, k0, WT, rowb, lane);
    }
#endif
    { u32x4 z = {0u, 0u, 0u, 0u}; u32x4* zp = (u32x4*)(WinT + (size_t)6464 * 2048); const int nz = 192 * 2048 * 2 / 16;
      for (int i = gw * 64 + lane; i < nz; i += NGW * 64) zp[i] = z; }
    { const float* x = INP(F, 0, float); const float* nw = INP(F, 2, float); bf16_t* H1 = WSP(F, WS_H1, bf16_t);
      for (int m = gw; m < MTOK; m += NGW) {
          const f32x4* xr = (const f32x4*)(x + (size_t)m * DM) + lane; f32x4 v[8]; float s = 0.f;
#pragma unroll
          for (int j = 0; j < 8; ++j) { v[j] = xr[64 * j]; s += (v[j].x * v[j].x + v[j].y * v[j].y) + (v[j].z * v[j].z + v[j].w * v[j].w); }
          const float rstd = 1.f / sqrtf(wave_sum(s) * (1.f / DM) + 1e-6f);
          u32x2* o8 = (u32x2*)(H1 + (size_t)m * DM) + lane;
#pragma unroll
          for (int j = 0; j < 8; ++j) { const f32x4 w = ((const f32x4*)nw)[lane + 64 * j]; u32x2 o; o.x = cvtpk(v[j].x * rstd * w.x, v[j].y * rstd * w.y); o.y = cvtpk(v[j].z * rstd * w.z, v[j].w * rstd * w.w); o8[64 * j] = o; }
      } }
    { const float* dup = INP(F, 12, float); const float* iup = INP(F, 14, float); const float* gup = INP(F, 15, float);
      bf16_t* DUt = WSP(F, WS_LORA, bf16_t); bf16_t* IUt = DUt + 2 * 1024 * 64; bf16_t* GUt = IUt + 2 * 1024 * 64;
      for (int i = gw * 64 + lane; i < 2 * 1024 * 64; i += NGW * 64) { const int j = i & 63, c = (i >> 6) & 1023, d = i >> 16;
          DUt[i] = (bf16_t)(cvtpk(dup[(size_t)(d * 64 + j) * 1024 + c], 0.f) & 0xffffu); IUt[i] = (bf16_t)(cvtpk(iup[(size_t)(d * 64 + j) * 1024 + c], 0.f) & 0xffffu); }
      for (int i = gw * 64 + lane; i < 1024 * 160; i += NGW * 64) { const int c = i / 160, j = i - c * 160; GUt[i] = (bf16_t)(cvtpk(gup[(size_t)j * 1024 + c], 0.f) & 0xffffu); } }
    { const int* pos = INP(F, 1, int); float* rope = WSP(F, WS_ROPE, float);
      const float invf[8] = {1.0f, 0.19392274474868576f, 0.03760603093086393f, 0.007292664737217109f, 0.001414213562373095f, 0.0002742481756762073f, 5.318295896944988e-05f, 1.031338537721246e-05f};
      for (int i = gw * 64 + lane; i < MTOK * 8; i += NGW * 64) { const int m = i >> 3, j = i & 7; float fj = invf[0];
#pragma unroll
          for (int q = 1; q < 8; ++q) fj = (j == q) ? invf[q] : fj;
          const float ang = (float)pos[m] * fj; rope[m * 16 + j] = cosf(ang); rope[m * 16 + 8 + j] = sinf(ang); } }
}

#define WS32(F, T, byteoff) (*(T*)((F).a->ws + (size_t)(unsigned)(byteoff)))
template <int CTRL> __device__ __forceinline__ float dpp_add(float x) {
    return x + __int_as_float(__builtin_amdgcn_update_dpp(0, __float_as_int(x), CTRL, 0xf, 0xf, false));
}
__device__ __forceinline__ float row16_allsum(float x) { x = dpp_add<0x128>(x); x = dpp_add<0x124>(x); x = dpp_add<0x122>(x); x = dpp_add<0x121>(x); return x; }
__device__ __forceinline__ bf16_t f2bf(float x) { return (bf16_t)(cvtpk(x, 0.f) & 0xffffu); }
__device__ __forceinline__ u32x4 ld_row16(const Frame& F, unsigned off, bool ok) { u32x4 r = {0u, 0u, 0u, 0u}; if (ok) r = WS32(F, const u32x4, off); return r; }
__device__ __forceinline__ void unpack8(const u32x4 w, float (&o)[8]) { o[0] = bf_lo(w.x); o[1] = bf_hi(w.x); o[2] = bf_lo(w.y); o[3] = bf_hi(w.y); o[4] = bf_lo(w.z); o[5] = bf_hi(w.z); o[6] = bf_lo(w.w); o[7] = bf_hi(w.w); }
__device__ __forceinline__ void ld8f(const float* p, float (&o)[8]) { const f32x4 a = ((const f32x4*)p)[0], b = ((const f32x4*)p)[1]; o[0] = a.x; o[1] = a.y; o[2] = a.z; o[3] = a.w; o[4] = b.x; o[5] = b.y; o[6] = b.z; o[7] = b.w; }
__device__ __forceinline__ u32x4 pack8(const float (&v)[8]) { return (u32x4){cvtpk(v[0], v[1]), cvtpk(v[2], v[3]), cvtpk(v[4], v[5]), cvtpk(v[6], v[7])}; }
__device__ __forceinline__ void p3_prep(Frame& F, const int mode = 0) {
    constexpr int AP = 296;
    constexpr int PP = 264, PA = 16 * PP, PT = 5 * PA;
    LAS bf16_t* Al = (LAS bf16_t*)F.lds;
    LAS bf16_t* Pl = (LAS bf16_t*)(F.lds + 18944);
    LAS float* Zr = (LAS float*)(F.lds + 18944);
    LAS float* Zl = (LAS float*)(F.lds + 18944 + 20736);
    const int tid = F.tid, lane = F.lane, w = F.wave;
    const bf16_t* DUt = WSP(F, WS_LORA, bf16_t); const bf16_t* IUt = DUt + 2 * 1024 * 64; const bf16_t* GUt = IUt + 2 * 1024 * 64;
    for (int item = F.vcu; item < MTOK / 32; item += F.G) {
        __syncthreads();
#pragma unroll 1
        for (int tl = 0; tl < 2; ++tl) {
            const int m0 = item * 32 + tl * 16, t0 = m0 & (SEQ - 1);
            for (int p = tid; p < 18 * 36; p += 512) {
                const int rr = p / 36, ch = p - rr * 36, t = t0 + rr - 1, m = m0 + rr - 1;
                f32x4 a0 = {0.f, 0.f, 0.f, 0.f}, a1 = a0;
                if (t >= 0 && t < SEQ) {
                    const bf16_t* pp = WSP(F, WS_PART, bf16_t) + (((size_t)((ch >> 5) * 32 + (m >> 8)) * 4) << 16) + (size_t)(m & 255) * 256 + ((8 * ch) & 255);
                    u32x4 q[4];
#pragma unroll
                    for (int k = 0; k < 4; ++k) q[k] = *(const u32x4*)(pp + ((size_t)k << 16));
#pragma unroll
                    for (int k = 0; k < 4; ++k) { a0 += (f32x4){bf_lo(q[k].x), bf_hi(q[k].x), bf_lo(q[k].y), bf_hi(q[k].y)}; a1 += (f32x4){bf_lo(q[k].z), bf_hi(q[k].z), bf_lo(q[k].w), bf_hi(q[k].w)}; }
                }
                LAS f32x4* zp = (LAS f32x4*)(Zr + rr * 288 + 8 * ch); zp[0] = a0; zp[1] = a1;
            }
            __syncthreads();
            for (int p = tid; p < 16 * 36; p += 512) {
                const int i = p / 36, ch = p - i * 36, zc = 3072 + 8 * ch;
                float c[8], pv[8], nx[8], mp[8], mn[8];
                { const LAS f32x4* q = (const LAS f32x4*)(Zr + i * 288 + 8 * ch); const f32x4 x0 = q[0], x1 = q[1], y0 = q[72], y1 = q[73], w0 = q[144], w1 = q[145];
                  pv[0] = x0.x; pv[1] = x0.y; pv[2] = x0.z; pv[3] = x0.w; pv[4] = x1.x; pv[5] = x1.y; pv[6] = x1.z; pv[7] = x1.w;
                  c[0] = y0.x; c[1] = y0.y; c[2] = y0.z; c[3] = y0.w; c[4] = y1.x; c[5] = y1.y; c[6] = y1.z; c[7] = y1.w;
                  nx[0] = w0.x; nx[1] = w0.y; nx[2] = w0.z; nx[3] = w0.w; nx[4] = w1.x; nx[5] = w1.y; nx[6] = w1.z; nx[7] = w1.w; }
                ld8f(INP(F, 4, float) + zc, mp); ld8f(INP(F, 5, float) + zc, mn);
                LAS f32x4* zp = (LAS f32x4*)(Zl + i * 288 + 8 * ch); float z[8];
#pragma unroll
                for (int e = 0; e < 8; ++e) z[e] = c[e] + mp[e] * (pv[e] - c[e]) + mn[e] * (nx[e] - c[e]);
                zp[0] = (f32x4){z[0], z[1], z[2], z[3]}; zp[1] = (f32x4){z[4], z[5], z[6], z[7]};
            }
            __syncthreads();
            for (int e = tid; e < 16 * 288; e += 512) { const int i = e / 288, j = e - i * 288; float z = Zl[e];
                if (j < 64) z = 1.f - 2.f * __builtin_amdgcn_rcpf(__expf(2.f * z) + 1.f); else if (j >= 128) z = __builtin_amdgcn_rcpf(1.f + __expf(-z));
                Al[tl * 16 * AP + i * AP + j] = f2bf(z); }
        }
        __syncthreads();
        if (mode == 1) continue;
        const int chk = tid & 31, pidx = tid >> 5, tb = pidx >> 3, tp = pidx & 7;
        const int m0t = item * 32 + tb * 16, t0t = m0t & (SEQ - 1);
#pragma unroll 1
        for (int qi = 0; qi < 4; ++qi) {
            const int q = (qi + (F.vcu >> 2)) & 3;
            u32x4 rawr[4], rawk[4], rawv[4];
            { const unsigned off = (unsigned)WS_PROJ + ((unsigned)(m0t + 2 * tp) * LDP + ZC0 + 256 * q + 8 * chk) * 2u;
#pragma unroll
              for (int rr = 0; rr < 4; ++rr) { const int t = t0t + 2 * tp + rr - 1; const bool ok = (t >= 0) && (t < SEQ); const unsigned o = off + (unsigned)((rr - 1) * LDP * 2);
                  rawr[rr] = ld_row16(F, o, ok); rawk[rr] = ld_row16(F, o + 1024u * 2u, ok); rawv[rr] = ld_row16(F, o + 2048u * 2u, ok); } }
            {
                const int n16 = lane & 15, q4 = lane >> 4;
                struct BF { bf16x8 d0[2], d1[2], i0[2], i1[2], g[5]; };
#define LD_BF(X, nb_) do { const int cl_ = 256 * q + 32 * w + 16 * (nb_) + n16; _Pragma("unroll") for (int ks = 0; ks < 2; ++ks) { \
                    X.d0[ks] = *(const bf16x8*)(DUt + (size_t)cl_ * 64 + 32 * ks + 8 * q4); X.d1[ks] = *(const bf16x8*)(DUt + (size_t)(1024 + cl_) * 64 + 32 * ks + 8 * q4); \
                    X.i0[ks] = *(const bf16x8*)(IUt + (size_t)cl_ * 64 + 32 * ks + 8 * q4); X.i1[ks] = *(const bf16x8*)(IUt + (size_t)(1024 + cl_) * 64 + 32 * ks + 8 * q4); } \
                    _Pragma("unroll") for (int ks = 0; ks < 5; ++ks) X.g[ks] = *(const bf16x8*)(GUt + (size_t)cl_ * 160 + 32 * ks + 8 * q4); } while (0)
#define DO_NB(X, nb_, tl_) do { const int ch_ = 32 * w + 16 * (nb_); \
                    f32x4 aw0 = {0.f, 0.f, 0.f, 0.f}, aw1 = aw0, aa0 = aw0, aa1 = aw0, ag = aw0; \
                    _Pragma("unroll") for (int ks = 0; ks < 2; ++ks) { \
                        aw0 = __builtin_amdgcn_mfma_f32_16x16x32_bf16(X.d0[ks], af[ks], aw0, 0, 0, 0); aw1 = __builtin_amdgcn_mfma_f32_16x16x32_bf16(X.d1[ks], af[ks], aw1, 0, 0, 0); \
                        aa0 = __builtin_amdgcn_mfma_f32_16x16x32_bf16(X.i0[ks], af[2 + ks], aa0, 0, 0, 0); aa1 = __builtin_amdgcn_mfma_f32_16x16x32_bf16(X.i1[ks], af[2 + ks], aa1, 0, 0, 0); } \
                    _Pragma("unroll") for (int ks = 0; ks < 5; ++ks) ag = __builtin_amdgcn_mfma_f32_16x16x32_bf16(X.g[ks], af[4 + ks], ag, 0, 0, 0); \
                    LAS bf16_t* pp = Pl + (tl_) * PT + n16 * PP + ch_ + 4 * q4; \
                    *(LAS u32x2*)(pp) = (u32x2){cvtpk(aw0[0], aw0[1]), cvtpk(aw0[2], aw0[3])}; *(LAS u32x2*)(pp + PA) = (u32x2){cvtpk(aw1[0], aw1[1]), cvtpk(aw1[2], aw1[3])}; \
                    *(LAS u32x2*)(pp + 2 * PA) = (u32x2){cvtpk(aa0[0], aa0[1]), cvtpk(aa0[2], aa0[3])}; *(LAS u32x2*)(pp + 3 * PA) = (u32x2){cvtpk(aa1[0], aa1[1]), cvtpk(aa1[2], aa1[3])}; \
                    *(LAS u32x2*)(pp + 4 * PA) = (u32x2){cvtpk(ag[0], ag[1]), cvtpk(ag[2], ag[3])}; } while (0)
                BF fa, fb; LD_BF(fa, 0); LD_BF(fb, 1);
#pragma unroll
                for (int tl = 0; tl < 2; ++tl) {
                    bf16x8 af[9];
#pragma unroll
                    for (int ks = 0; ks < 9; ++ks) af[ks] = *(const LAS bf16x8*)(Al + tl * 16 * AP + n16 * AP + 32 * ks + 8 * q4);
                    DO_NB(fa, 0, tl); DO_NB(fb, 1, tl);
                }
#undef LD_BF
#undef DO_NB
            }
            __syncthreads();
            if (mode != 2) {
                const int c = 256 * q + 8 * chk;
                float r4[4][8], k4[4][8], v4[4][8];
#pragma unroll
                for (int rr = 0; rr < 4; ++rr) { unpack8(rawr[rr], r4[rr]); unpack8(rawk[rr], k4[rr]); unpack8(rawv[rr], v4[rr]); }
                float zr[2][8], zk[2][8], zv[2][8];
                { float mp[8], mn[8];
                  ld8f(INP(F, 4, float) + c, mp); ld8f(INP(F, 5, float) + c, mn);
#pragma unroll
                  for (int tk = 0; tk < 2; ++tk)
#pragma unroll
                      for (int e = 0; e < 8; ++e) zr[tk][e] = r4[tk + 1][e] + mp[e] * (r4[tk][e] - r4[tk + 1][e]) + mn[e] * (r4[tk + 2][e] - r4[tk + 1][e]);
                  ld8f(INP(F, 4, float) + 1024 + c, mp); ld8f(INP(F, 5, float) + 1024 + c, mn);
#pragma unroll
                  for (int tk = 0; tk < 2; ++tk)
#pragma unroll
                      for (int e = 0; e < 8; ++e) zk[tk][e] = k4[tk + 1][e] + mp[e] * (k4[tk][e] - k4[tk + 1][e]) + mn[e] * (k4[tk + 2][e] - k4[tk + 1][e]);
                  ld8f(INP(F, 4, float) + 2048 + c, mp); ld8f(INP(F, 5, float) + 2048 + c, mn);
#pragma unroll
                  for (int tk = 0; tk < 2; ++tk)
#pragma unroll
                      for (int e = 0; e < 8; ++e) zv[tk][e] = v4[tk + 1][e] + mp[e] * (v4[tk][e] - v4[tk + 1][e]) + mn[e] * (v4[tk + 2][e] - v4[tk + 1][e]); }
                float kkw[8], w00[8], w01[8], a00[8], a01[8], kac[8], rkc[8];
                ld8f(INP(F, 16, float) + c, kkw); ld8f(INP(F, 11, float) + c, w00); ld8f(INP(F, 11, float) + 1024 + c, w01);
                ld8f(INP(F, 13, float) + c, a00); ld8f(INP(F, 13, float) + 1024 + c, a01); ld8f(INP(F, 17, float) + c, kac); ld8f(INP(F, 18, float) + c, rkc);
#pragma unroll 1
                for (int tk = 0; tk < 2; ++tk) {
                    const int tkn = 2 * tp + tk; const unsigned o = (unsigned)(m0t + tkn) * 1024u + (unsigned)c;
                    const LAS bf16_t* pp = Pl + tb * PT + tkn * PP + 8 * chk;
                    float zrt[8], zkt[8], zvt[8];
#pragma unroll
                    for (int e = 0; e < 8; ++e) { zrt[e] = tk ? zr[1][e] : zr[0][e]; zkt[e] = tk ? zk[1][e] : zk[0][e]; zvt[e] = tk ? zv[1][e] : zv[0][e]; }
                    WS32(F, u32x4, (unsigned)WS_R + o * 2u) = pack8(zrt); WS32(F, u32x4, (unsigned)WS_V + o * 2u) = pack8(zvt);
                    float kk[8];
                    { float ss = 0.f;
#pragma unroll
                      for (int e = 0; e < 8; ++e) { kk[e] = zkt[e] * kkw[e]; ss += kk[e] * kk[e]; }
                      ss += __shfl_xor(ss, 1); ss += __shfl_xor(ss, 2); ss += __shfl_xor(ss, 4);
                      const float inv = 1.f / fmaxf(sqrtf(ss), 1e-12f);
#pragma unroll
                      for (int e = 0; e < 8; ++e) kk[e] *= inv;
                      WS32(F, u32x4, (unsigned)WS_KK + o * 2u) = pack8(kk); }
                    {
                        float pw0[8], pw1[8], d0[8], d1[8];
                        unpack8(*(const LAS u32x4*)(pp), pw0); unpack8(*(const LAS u32x4*)(pp + PA), pw1);
#pragma unroll
                        for (int e = 0; e < 8; ++e) {
                            d0[e] = 0.6065306597126334f * __builtin_amdgcn_rcpf(1.f + __expf(-(w00[e] + pw0[e]))); d1[e] = 0.6065306597126334f * __builtin_amdgcn_rcpf(1.f + __expf(-(w01[e] + pw1[e]))); }
                        WS32(F, u32x4, (unsigned)WS_WDEC + o * 2u) = pack8(d0); WS32(F, u32x4, (unsigned)WS_WDEC + ((unsigned)(MTOK * 1024) + o) * 2u) = pack8(d1);
                    }
                    {
                        float pa0[8], pa1[8], kd0[8], kd1[8], b0v[8], b1v[8]; float bs = 0.f;
                        unpack8(*(const LAS u32x4*)(pp + 2 * PA), pa0); unpack8(*(const LAS u32x4*)(pp + 3 * PA), pa1);
#pragma unroll
                        for (int e = 0; e < 8; ++e) {
                            const float av0 = __builtin_amdgcn_rcpf(1.f + __expf(-(a00[e] + pa0[e]))), av1 = __builtin_amdgcn_rcpf(1.f + __expf(-(a01[e] + pa1[e])));
                            kd0[e] = zkt[e] * (1.f + (av0 - 1.f) * kac[e]); kd1[e] = zkt[e] * (1.f + (av1 - 1.f) * kac[e]);
                            b0v[e] = kk[e] * av0; b1v[e] = kk[e] * av1;
                            bs += zrt[e] * (kd0[e] + kd1[e]) * rkc[e]; }
                        bs += __shfl_xor(bs, 1); bs += __shfl_xor(bs, 2); bs += __shfl_xor(bs, 4);
                        if ((chk & 7) == 0) WS32(F, float, (unsigned)WS_BONUS + ((unsigned)(m0t + tkn) * 16u + (unsigned)(4 * q + (chk >> 3))) * 4u) = bs;
                        WS32(F, u32x4, (unsigned)WS_KD + o * 2u) = pack8(kd0); WS32(F, u32x4, (unsigned)WS_KD + ((unsigned)(MTOK * 1024) + o) * 2u) = pack8(kd1);
                        WS32(F, u32x4, (unsigned)WS_BB + o * 2u) = pack8(b0v); WS32(F, u32x4, (unsigned)WS_BB + ((unsigned)(MTOK * 1024) + o) * 2u) = pack8(b1v);
                    }
                    WS32(F, u32x4, (unsigned)WS_G + o * 2u) = *(const LAS u32x4*)(pp + 4 * PA);
                }
            }
            __syncthreads();
        }
    }
}

struct P5aConst { float lam; };
__device__ __forceinline__ void p5a_init(const Frame& F, P5aConst& K) {
    const int lane = F.lane;
    const float q1 = INP(F, 6, float)[lane] * INP(F, 7, float)[lane], q2 = INP(F, 8, float)[lane] * INP(F, 9, float)[lane];
    K.lam = __expf(wave_sum(q1)) - __expf(wave_sum(q2)) + 0.2f;
}
__device__ __forceinline__ void p5a_token(const Frame& F, const P5aConst& K, int m) {
    const bf16_t* OC = WSP(F, WS_OC, bf16_t); bf16_t* MIX = WSP(F, WS_MIX, bf16_t); const float* subw = INP(F, 10, float);
    const int c0 = F.lane * 16; const float lam = K.lam;
    const u32x4* p0 = (const u32x4*)(OC + (size_t)m * 1024 + c0); const u32x4* p1 = (const u32x4*)(OC + (size_t)MTOK * 1024 + (size_t)m * 1024 + c0);
    const u32x4 a0 = p0[0], a1 = p0[1], b0 = p1[0], b1 = p1[1];
    float dv[16]; const unsigned aw[8] = {a0.x, a0.y, a0.z, a0.w, a1.x, a1.y, a1.z, a1.w}, bw[8] = {b0.x, b0.y, b0.z, b0.w, b1.x, b1.y, b1.z, b1.w};
    float ssq = 0.f;
#pragma unroll
    for (int i = 0; i < 8; ++i) { dv[2 * i] = bf_lo(aw[i]) - lam * bf_lo(bw[i]); dv[2 * i + 1] = bf_hi(aw[i]) - lam * bf_hi(bw[i]); ssq += dv[2 * i] * dv[2 * i] + dv[2 * i + 1] * dv[2 * i + 1]; }
    ssq += __shfl_xor(ssq, 1); ssq += __shfl_xor(ssq, 2); ssq += __shfl_xor(ssq, 4);
    const float rstd = 1.f / sqrtf(ssq * (1.f / 128.f) + 1e-5f);
    unsigned ow[8];
#pragma unroll
    for (int i = 0; i < 8; ++i) { const float s0 = subw[(c0 + 2 * i) & 127] * 0.8f, s1 = subw[(c0 + 2 * i + 1) & 127] * 0.8f; ow[i] = cvtpk(dv[2 * i] * rstd * s0, dv[2 * i + 1] * rstd * s1); }
    u32x4* op = (u32x4*)(MIX + (size_t)m * 2048 + c0); op[0] = (u32x4){ow[0], ow[1], ow[2], ow[3]}; op[1] = (u32x4){ow[4], ow[5], ow[6], ow[7]};
}

__device__ __forceinline__ void p4_scan(Frame& F, const int mode = 0) {
    constexpr int CH = 32, NCH = SEQ / CH;
    constexpr int VEC = CH * 64 * 4;
    constexpr int BUF = 5 * VEC + CH * 32 * 4;
    constexpr int YOFF = 2 * BUF, YB = CH * 32 * 4;
    constexpr int CVT_SCR = 2 * BUF + 2 * YB;
    const bf16_t* Wdec = WSP(F, WS_WDEC, bf16_t); const bf16_t* KDg = WSP(F, WS_KD, bf16_t); const bf16_t* BBg = WSP(F, WS_BB, bf16_t);
    const bf16_t* Rg = WSP(F, WS_R, bf16_t); const bf16_t* KKg = WSP(F, WS_KK, bf16_t); const bf16_t* Vg = WSP(F, WS_V, bf16_t); bf16_t* YS = WSP(F, WS_YS, bf16_t);
    const int tid = F.tid, lane = F.lane, wid = F.wave;
    const bool is_comp = wid < 4;
    const int ri = wid & 3;
    if (is_comp) __builtin_amdgcn_s_setprio(3);
    const int g = lane >> 3, j = lane & 7, rowl = ri * 8 + g;
    const int mt = ri * 64 + lane, mw = ri;
    int cvt_it = F.vcu * 4 + mw; f32x4 cvv[16]; int ck0 = 0, crowb = 0; unsigned char* cWT = nullptr;
    f32x4 cvvB[16]; int ck0B = 0, crowbB = 0; unsigned char* cWTB = nullptr;
    LAS unsigned* st_cnt = (LAS unsigned*)(F.lds + CVT_SCR + 4 * 4096); LAS unsigned* cons_cnt = st_cnt + 16;
    for (int item = F.vcu; item < 256; item += F.G) {
        const int chain = item >> 1, half = item & 1, d = chain >> 6, b = (chain >> 4) & 3, h = chain & 15;
        const size_t sh = (size_t)b * SEQ * 1024 + h * 64, pd = (size_t)d * MTOK * 1024 + sh;
        f32x2 S2[4] = {{0.f, 0.f}, {0.f, 0.f}, {0.f, 0.f}, {0.f, 0.f}};
        u32x2 rw[2], rkk[2], rbb[2], rkd[2], rr[2]; unsigned rv[2];
        const int cstep = d ? -CH * 1024 : CH * 1024;
        unsigned po[2], pv[2];
#pragma unroll
        for (int q_ = 0; q_ < 2; ++q_) { const int sl_ = mt + 256 * q_, ss_ = sl_ >> 4, sk_ = (sl_ & 15) * 4, tq_ = d ? (SEQ - 1 - ss_) : ss_; po[q_] = (unsigned)(tq_ * 1024 + sk_); pv[q_] = (unsigned)(tq_ * 1024 + half * 32 + 2 * (sl_ & 15)); }
        const char* bW = (const char*)(Wdec + pd); const char* bKK = (const char*)(KKg + sh); const char* bBB = (const char*)(BBg + pd); const char* bKD = (const char*)(KDg + pd); const char* bR = (const char*)(Rg + sh); const char* bV = (const char*)(Vg + sh);
#define SC_LOAD(c) do { const unsigned cu_ = (unsigned)((c) * cstep); _Pragma("unroll") for (int q_ = 0; q_ < 2; ++q_) { const unsigned e_ = po[q_] + cu_; \
        rw[q_] = *(const u32x2*)(bW + (size_t)(e_ * 2u)); rkk[q_] = *(const u32x2*)(bKK + (size_t)(e_ * 2u)); rbb[q_] = *(const u32x2*)(bBB + (size_t)(e_ * 2u)); rkd[q_] = *(const u32x2*)(bKD + (size_t)(e_ * 2u)); rr[q_] = *(const u32x2*)(bR + (size_t)(e_ * 2u)); \
        rv[q_] = *(const unsigned*)(bV + (size_t)((pv[q_] + cu_) * 2u)); } } while (0)
#define SC_STORE(bufi) do { LAS unsigned char* bp_ = F.lds + (bufi) * BUF; _Pragma("unroll") for (int q_ = 0; q_ < 2; ++q_) { const int sl_ = mt + 256 * q_, ss_ = sl_ >> 4, sk_ = (sl_ & 15) * 4; const int o_ = (ss_ * 64 + sk_) * 4; \
        *(LAS f32x4*)(bp_ + o_) = (f32x4){__expf(-bf_lo(rw[q_].x)), __expf(-bf_hi(rw[q_].x)), __expf(-bf_lo(rw[q_].y)), __expf(-bf_hi(rw[q_].y))}; \
        *(LAS f32x4*)(bp_ + VEC + o_) = (f32x4){bf_lo(rkk[q_].x), bf_hi(rkk[q_].x), bf_lo(rkk[q_].y), bf_hi(rkk[q_].y)}; \
        *(LAS f32x4*)(bp_ + 2 * VEC + o_) = (f32x4){bf_lo(rbb[q_].x), bf_hi(rbb[q_].x), bf_lo(rbb[q_].y), bf_hi(rbb[q_].y)}; \
        *(LAS f32x4*)(bp_ + 3 * VEC + o_) = (f32x4){bf_lo(rkd[q_].x), bf_hi(rkd[q_].x), bf_lo(rkd[q_].y), bf_hi(rkd[q_].y)}; \
        *(LAS f32x4*)(bp_ + 4 * VEC + o_) = (f32x4){bf_lo(rr[q_].x), bf_hi(rr[q_].x), bf_lo(rr[q_].y), bf_hi(rr[q_].y)}; \
        *(LAS f32x2*)(bp_ + 5 * VEC + (ss_ * 32 + 2 * (sl_ & 15)) * 4) = (f32x2){bf_lo(rv[q_]), bf_hi(rv[q_])}; } } while (0)
#define Y_OUT(c) do { const int ys_ = mt >> 3, yr_ = (mt & 7) * 4; const int tt_ = (c) * CH + ys_, t_ = d ? (SEQ - 1 - tt_) : tt_; \
        const f32x4 yv_ = *(const LAS f32x4*)(F.lds + YOFF + ((c) & 1) * YB + (ys_ * 32 + yr_) * 4); \
        *(u32x2*)(YS + pd + (size_t)t_ * 1024 + half * 32 + yr_) = (u32x2){cvtpk(yv_.x, yv_.y), cvtpk(yv_.z, yv_.w)}; } while (0)
#define SC_WAIT(cnt_, tgt_) do { for (;;) { const u32x4 q_ = *(volatile LAS u32x4*)(cnt_); const unsigned a_ = q_.x < q_.y ? q_.x : q_.y, b_ = q_.z < q_.w ? q_.z : q_.w; \
        if ((a_ < b_ ? a_ : b_) >= (tgt_)) break; if (is_comp) __builtin_amdgcn_s_sleep(1); else __builtin_amdgcn_s_sleep(12); } asm volatile("" ::: "memory"); } while (0)
#define SC_SIGNAL(cnt_, val_) do { asm volatile("s_waitcnt lgkmcnt(0)" ::: "memory"); if (lane == 0) *(volatile LAS unsigned*)((cnt_) + ri) = (val_); } while (0)
        __syncthreads();
        if (tid < 4) { st_cnt[tid] = 0u; cons_cnt[tid] = 0u; }
        if (!is_comp) { SC_LOAD(0); SC_STORE(0); SC_LOAD(1); }
        __syncthreads();
        if (is_comp) {
          for (int c = 0; c < NCH; ++c) {
            SC_WAIT(st_cnt, (unsigned)c);
            if (mode != 2) {
                const LAS unsigned char* bp = F.lds + (c & 1) * BUF;
                LAS float* yb = (LAS float*)(F.lds + YOFF + (c & 1) * YB);
                f32x4 cw_[2], ckk[2], cbb[2], ckd[2], cr[2]; float cv;
#define SC_RD(s_) do { const int o_ = ((s_) * 64 + j * 8) * 4; cw_[0] = *(const LAS f32x4*)(bp + o_); cw_[1] = *(const LAS f32x4*)(bp + o_ + 16); ckk[0] = *(const LAS f32x4*)(bp + VEC + o_); ckk[1] = *(const LAS f32x4*)(bp + VEC + o_ + 16); \
                cbb[0] = *(const LAS f32x4*)(bp + 2 * VEC + o_); cbb[1] = *(const LAS f32x4*)(bp + 2 * VEC + o_ + 16); ckd[0] = *(const LAS f32x4*)(bp + 3 * VEC + o_); ckd[1] = *(const LAS f32x4*)(bp + 3 * VEC + o_ + 16); \
                cr[0] = *(const LAS f32x4*)(bp + 4 * VEC + o_); cr[1] = *(const LAS f32x4*)(bp + 4 * VEC + o_ + 16); cv = *(const LAS float*)(bp + 5 * VEC + ((s_) * 32 + rowl) * 4); } while (0)
#define H2(v_, i_) ((f32x2){v_[(i_) >> 1][((i_) & 1) * 2], v_[(i_) >> 1][((i_) & 1) * 2 + 1]})
                SC_RD(0);
                float yk = 0.f;
#pragma unroll
                for (int s = 0; s < CH; ++s) {
                    f32x4 w[2] = {cw_[0], cw_[1]}, kk[2] = {ckk[0], ckk[1]}, bb[2] = {cbb[0], cbb[1]}, kd[2] = {ckd[0], ckd[1]}, r[2] = {cr[0], cr[1]}; const float v = cv;
                    if (s + 1 < CH) SC_RD(s + 1);
                    f32x2 pa = S2[0] * H2(kk, 0), pb = S2[1] * H2(kk, 1); pa = S2[2] * H2(kk, 2) + pa; pb = S2[3] * H2(kk, 3) + pb; pa = pa + pb;
                    const f32x2 vv = {v, v};
                    f32x2 u[4];
#pragma unroll
                    for (int i = 0; i < 4; ++i) u[i] = S2[i] * H2(w, i) + vv * H2(kd, i);
                    float p = pa.x + pa.y;
                    p = dpp_add<0xB1>(p); p = dpp_add<0x4E>(p); p = dpp_add<0x141>(p);
                    const f32x2 sa = {-p, -p};
#pragma unroll
                    for (int i = 0; i < 4; ++i) S2[i] = sa * H2(bb, i) + u[i];
                    f32x2 ya = S2[0] * H2(r, 0), yc = S2[1] * H2(r, 1); ya = S2[2] * H2(r, 2) + ya; yc = S2[3] * H2(r, 3) + yc; ya = ya + yc;
                    float y = ya.x + ya.y;
                    y = dpp_add<0xB1>(y); y = dpp_add<0x4E>(y); y = dpp_add<0x141>(y);
                    yk = (j == (s & 7)) ? y : yk;
                    if ((s & 7) == 7) yb[((s & 24) + j) * 32 + rowl] = yk;
                }
#undef SC_RD
#undef H2
            }
            SC_SIGNAL(cons_cnt, (unsigned)(c + 1));
          }
        } else {
#define MEM_DUTIES(c_) do { SC_WAIT(cons_cnt, (unsigned)(c_)); if ((c_) >= 1 && mode != 2) Y_OUT((c_) - 1); if ((c_) + 1 < NCH) SC_STORE(((c_) + 1) & 1); SC_SIGNAL(st_cnt, (unsigned)((c_) + 1)); if ((c_) + 2 < NCH) SC_LOAD((c_) + 2); } while (0)
#define CVT_LOAD_SET(V_, K0_, WT_, RB_) do { const int it_ = cvt_it < N_EXPERT_ITEMS ? cvt_it : N_EXPERT_ITEMS - 1; const float* cW_; int cn0_; cvt_expert_decode(F, it_, cW_, K0_, cn0_, WT_, RB_); cvt8_load(V_, cW_, K0_, cn0_, lane); cvt_it += F.G * 4; } while (0)
          if (item == F.vcu) { P5aConst p5k; p5a_init(F, p5k); for (int xm = F.vcu * 4 + mw; xm < MTOK; xm += F.G * 4) p5a_token(F, p5k, xm); }
          int ngrp = 0; { const int left = (N_EXPERT_ITEMS - cvt_it + F.G * 4 - 1) / (F.G * 4); ngrp = left > 0 ? left / 3 : 0; if (ngrp > NCH / 4) ngrp = NCH / 4; }
          int cg = 0;
#pragma unroll 1
          for (; cg < 4 * ngrp; cg += 4) {
            MEM_DUTIES(cg);
#if CVT_IN_SCAN
            if (cg > 0) cvt8_finish(cvv, ck0, cWT, crowb, lane);
            CVT_LOAD_SET(cvv, ck0, cWT, crowb);
#endif
            MEM_DUTIES(cg + 1);
#if CVT_IN_SCAN
            CVT_LOAD_SET(cvvB, ck0B, cWTB, crowbB);
#endif
            MEM_DUTIES(cg + 2);
#if CVT_IN_SCAN
            cvt8_finish(cvv, ck0, cWT, crowb, lane);
            CVT_LOAD_SET(cvv, ck0, cWT, crowb);
#endif
            MEM_DUTIES(cg + 3);
#if CVT_IN_SCAN
            cvt8_finish(cvvB, ck0B, cWTB, crowbB, lane);
#endif
          }
#if CVT_IN_SCAN
          if (ngrp > 0) cvt8_finish(cvv, ck0, cWT, crowb, lane);
#endif
#pragma unroll 1
          for (; cg < NCH; ++cg) MEM_DUTIES(cg);
#undef MEM_DUTIES
#undef CVT_LOAD_SET
          SC_WAIT(cons_cnt, (unsigned)NCH);
        }
        if (!is_comp && mode != 2) Y_OUT(NCH - 1);
#undef SC_LOAD
#undef SC_STORE
#undef Y_OUT
#undef SC_WAIT
#undef SC_SIGNAL
    }
    __builtin_amdgcn_s_setprio(0);
#if CVT_IN_SCAN
    if (!is_comp) {
        for (; cvt_it < N_EXPERT_ITEMS; cvt_it += F.G * 4) {
            const float* W; int k0, n0, rowb; unsigned char* WT;
            cvt_expert_decode(F, cvt_it, W, k0, n0, WT, rowb); cvt8_load(cvv, W, k0, n0, lane); cvt8_finish(cvv, k0, WT, rowb, lane);
        }
    }
#endif
}

__device__ __forceinline__ void p5_finalize(Frame& F) {
    const bf16_t* OC = WSP(F, WS_OC, bf16_t); const bf16_t* YS = WSP(F, WS_YS, bf16_t); const bf16_t* Vg = WSP(F, WS_V, bf16_t); const bf16_t* Gg = WSP(F, WS_G, bf16_t);
    const float* BON = WSP(F, WS_BONUS, float); bf16_t* MIX = WSP(F, WS_MIX, bf16_t);
    const float* subw = INP(F, 10, float); const float* lnw = INP(F, 19, float); const float* lnb = INP(F, 20, float);
    const int lane = F.lane, gw = F.vcu * 8 + F.wave, NGW = F.G * 8;
    float lam;
    { const float q1 = INP(F, 6, float)[lane] * INP(F, 7, float)[lane], q2 = INP(F, 8, float)[lane] * INP(F, 9, float)[lane];
      lam = __expf(wave_sum(q1)) - __expf(wave_sum(q2)) + 0.2f; }
    const int c0 = lane * 16;
    float sw[16], lw[16], lb[16];
#pragma unroll
    for (int i = 0; i < 16; ++i) { sw[i] = subw[(c0 + i) & 127] * 0.8f; lw[i] = lnw[c0 + i]; lb[i] = lnb[c0 + i]; }
    for (int m = gw; m < MTOK; m += NGW) {
        { const u32x4* y0 = (const u32x4*)(YS + (size_t)m * 1024 + c0); const u32x4* y1 = (const u32x4*)(YS + (size_t)MTOK * 1024 + (size_t)m * 1024 + c0);
          float y[16]; float s = 0.f;
          { const u32x4 a0 = y0[0], a1 = y0[1], b0 = y1[0], b1 = y1[1];
            const unsigned aw[8] = {a0.x, a0.y, a0.z, a0.w, a1.x, a1.y, a1.z, a1.w}, bw[8] = {b0.x, b0.y, b0.z, b0.w, b1.x, b1.y, b1.z, b1.w};
#pragma unroll
            for (int i = 0; i < 8; ++i) { y[2 * i] = bf_lo(aw[i]) + bf_lo(bw[i]); y[2 * i + 1] = bf_hi(aw[i]) + bf_hi(bw[i]); } }
#pragma unroll
          for (int i = 0; i < 16; ++i) s += y[i];
          s += __shfl_xor(s, 1); s += __shfl_xor(s, 2);
          const float mu = s * (1.f / 64.f); float q = 0.f;
#pragma unroll
          for (int i = 0; i < 16; ++i) { y[i] -= mu; q += y[i] * y[i]; }
          q += __shfl_xor(q, 1); q += __shfl_xor(q, 2);
          const float rstd = 1.f / sqrtf(q * (1.f / 64.f) + 64e-5f);
          const float bon = BON[(size_t)m * 16 + (lane >> 2)];
          const u32x4* vp = (const u32x4*)(Vg + (size_t)m * 1024 + c0); const u32x4* gp = (const u32x4*)(Gg + (size_t)m * 1024 + c0);
          const u32x4 v0 = vp[0], v1 = vp[1], g0 = gp[0], g1 = gp[1];
          const unsigned vw[8] = {v0.x, v0.y, v0.z, v0.w, v1.x, v1.y, v1.z, v1.w}, gq[8] = {g0.x, g0.y, g0.z, g0.w, g1.x, g1.y, g1.z, g1.w};
          unsigned ow[8];
#pragma unroll
          for (int i = 0; i < 8; ++i) {
              const float e0 = (y[2 * i] * rstd * lw[2 * i] + lb[2 * i] + bon * bf_lo(vw[i])) * bf_lo(gq[i]);
              const float e1 = (y[2 * i + 1] * rstd * lw[2 * i + 1] + lb[2 * i + 1] + bon * bf_hi(vw[i])) * bf_hi(gq[i]);
              ow[i] = cvtpk(e0, e1); }
          u32x4* op = (u32x4*)(MIX + (size_t)m * 2048 + 1024 + c0); op[0] = (u32x4){ow[0], ow[1], ow[2], ow[3]}; op[1] = (u32x4){ow[4], ow[5], ow[6], ow[7]}; }
    }
}

__device__ __forceinline__ void p7_router(Frame& F) {
    const bf16_t* X1 = WSP(F, WS_X1, bf16_t); const float* nw = INP(F, 22, float); const float* wr = INP(F, 23, float);
    unsigned char* H2 = WSP(F, WS_H2, unsigned char); float* AFF = WSP(F, WS_AFF, float);
    const int lane = F.lane, tid = F.tid, gw = F.vcu * 8 + F.wave, NGW = F.G * 8;
    volatile LAS unsigned* MISC = (volatile LAS unsigned*)(F.lds + MISC_OFF);
    const unsigned m8 = MISC[8], m9 = MISC[9];
    __syncthreads();
    for (int f = tid; f < 2048 * 4; f += 512) { const int col = f >> 2, q = f & 3; *(LAS f32x4*)(F.lds + (col >> 2) * 272 + (col & 3) * 64 + q * 16) = *(const f32x4*)(wr + (size_t)col * 16 + 4 * q); }
    __syncthreads();
    for (int pr = gw; pr < MTOK / 2; pr += NGW) {
        const int m = 2 * pr;
        const u32x2* xr0 = (const u32x2*)(X1 + (size_t)m * DM) + lane; const u32x2* xr1 = xr0 + DM / 4;
        f32x4 v0[8], v1[8]; float s0 = 0.f, s1 = 0.f;
#pragma unroll
        for (int j = 0; j < 8; ++j) { const u32x2 a_ = xr0[64 * j], b_ = xr1[64 * j]; v0[j] = (f32x4){bf_lo(a_.x), bf_hi(a_.x), bf_lo(a_.y), bf_hi(a_.y)}; v1[j] = (f32x4){bf_lo(b_.x), bf_hi(b_.x), bf_lo(b_.y), bf_hi(b_.y)}; }
#pragma unroll
        for (int j = 0; j < 8; ++j) { s0 += (v0[j].x * v0[j].x + v0[j].y * v0[j].y) + (v0[j].z * v0[j].z + v0[j].w * v0[j].w); s1 += (v1[j].x * v1[j].x + v1[j].y * v1[j].y) + (v1[j].z * v1[j].z + v1[j].w * v1[j].w); }
        const float r0 = 1.f / sqrtf(wave_sum(s0) * (1.f / DM) + 1e-6f), r1 = 1.f / sqrtf(wave_sum(s1) * (1.f / DM) + 1e-6f);
        unsigned* o0 = (unsigned*)(H2 + (size_t)m * DM) + lane; unsigned* o1 = o0 + DM / 4;
        float acc[32];
#pragma unroll
        for (int i = 0; i < 32; ++i) acc[i] = 0.f;
#pragma unroll
        for (int j = 0; j < 8; ++j) {
            const f32x4 w = ((const f32x4*)nw)[lane + 64 * j];
            const f32x4 a = v0[j] * w * r0, b = v1[j] * w * r1;
            o0[64 * j] = pg8::cvt4_fp8(a.x, a.y, a.z, a.w);
            o1[64 * j] = pg8::cvt4_fp8(b.x, b.y, b.z, b.w);
            const LAS f32x4* wp = (const LAS f32x4*)(F.lds + (lane + 64 * j) * 272);
#pragma unroll
            for (int i = 0; i < 4; ++i) {
#pragma unroll
                for (int q = 0; q < 4; ++q) { const f32x4 ww = wp[i * 4 + q];
#pragma unroll
                    for (int e = 0; e < 4; ++e) { acc[4 * q + e] += a[i] * ww[e]; acc[16 + 4 * q + e] += b[i] * ww[e]; } }
                asm volatile("" ::: "memory");
            }
        }
#define RSTAGE(N_, B_) do { const bool up_ = (lane & (B_)) != 0; _Pragma("unroll") for (int k = 0; k < (N_); ++k) { const float lo_ = acc[k], hi_ = acc[(N_) + k]; \
            const float snd_ = up_ ? lo_ : hi_, kp_ = up_ ? hi_ : lo_; acc[k] = kp_ + __shfl_xor(snd_, (B_)); } } while (0)
        RSTAGE(16, 32); RSTAGE(8, 16); RSTAGE(4, 8); RSTAGE(2, 4); RSTAGE(1, 2);
#undef RSTAGE
        float lg = acc[0] + __shfl_xor(acc[0], 1);
        float mx = lg;
        mx = fmaxf(mx, __shfl_xor(mx, 2)); mx = fmaxf(mx, __shfl_xor(mx, 4)); mx = fmaxf(mx, __shfl_xor(mx, 8)); mx = fmaxf(mx, __shfl_xor(mx, 16));
        const float p = expf(lg - mx);
        float den = p; den += __shfl_xor(den, 2); den += __shfl_xor(den, 4); den += __shfl_xor(den, 8); den += __shfl_xor(den, 16);
        if ((lane & 1) == 0) { const int row = lane >> 5, e = (lane >> 1) & 15, mm = m + row; AFF[((size_t)(mm >> 11) * 16 + e) * SEQ + (mm & (SEQ - 1))] = p / den; }
    }
    __syncthreads();
    if (tid == 0) { MISC[8] = m8; MISC[9] = m9; }
    __syncthreads();
}

__device__ __forceinline__ int wave_count4(bool f0, bool f1, bool f2, bool f3) {
    return __builtin_popcountll(__ballot(f0)) + __builtin_popcountll(__ballot(f1)) + __builtin_popcountll(__ballot(f2)) + __builtin_popcountll(__ballot(f3));
}
__device__ __forceinline__ void p8_select(Frame& F) {
    const float* AFF = WSP(F, WS_AFF, float);
    int* XEIDX = WSP(F, WS_XEIDX, int); float* GATEX = WSP(F, WS_GATEX, float); int* SLOT = WSP(F, WS_SLOT, int);
    LAS int* part = (LAS int*)F.lds;
    LAS unsigned* cnt = (LAS unsigned*)(F.lds + 256);
    LAS unsigned* list = (LAS unsigned*)(F.lds + 512);
    const int tid = F.tid, lane = F.lane, w = F.wave;
    for (int item = F.vcu; item < 256; item += F.G) {
        const int be = item >> 2, q = item & 3, b = be >> 4, e = be & 15;
        __syncthreads();
        if (tid == 0) *cnt = 0u;
        const f32x4 a4 = ((const f32x4*)(AFF + (size_t)be * SEQ))[tid];
        const unsigned u0 = __float_as_uint(a4.x), u1 = __float_as_uint(a4.y), u2 = __float_as_uint(a4.z), u3 = __float_as_uint(a4.w);
        unsigned lo = 0u, hi = 0x7f800001u;
        int itn = 0;
        while (hi - lo > 1u) {
            const unsigned mid = lo + ((hi - lo) >> 1);
            const int c = wave_count4(u0 >= mid, u1 >= mid, u2 >= mid, u3 >= mid);
            LAS int* pp = part + (itn & 1) * 8;
            if (lane == 0) pp[w] = c;
            __syncthreads();
            int tot = 0;
#pragma unroll
            for (int i = 0; i < 8; ++i) tot += pp[i];
            if (tot >= CAP) lo = mid; else hi = mid;
            ++itn;
        }
        const unsigned T = lo;
        const bool g0 = u0 > T, g1 = u1 > T, g2 = u2 > T, g3 = u3 > T, q0 = u0 == T, q1 = u1 == T, q2 = u2 == T, q3 = u3 == T;
        const unsigned long long bg0 = __ballot(g0), bg1 = __ballot(g1), bg2 = __ballot(g2), bg3 = __ballot(g3), bq0 = __ballot(q0), bq1 = __ballot(q1), bq2 = __ballot(q2), bq3 = __ballot(q3);
        const unsigned long long below = (lane == 0) ? 0ull : (~0ull >> (64 - lane));
        int pg = __builtin_popcountll(bg0 & below) + __builtin_popcountll(bg1 & below) + __builtin_popcountll(bg2 & below) + __builtin_popcountll(bg3 & below);
        int pq = __builtin_popcountll(bq0 & below) + __builtin_popcountll(bq1 & below) + __builtin_popcountll(bq2 & below) + __builtin_popcountll(bq3 & below);
        const int wg = __builtin_popcountll(bg0) + __builtin_popcountll(bg1) + __builtin_popcountll(bg2) + __builtin_popcountll(bg3);
        const int wq = __builtin_popcountll(bq0) + __builtin_popcountll(bq1) + __builtin_popcountll(bq2) + __builtin_popcountll(bq3);
        if (lane == 0) { part[16 + w] = wg; part[32 + w] = wq; }
        __syncthreads();
        int gtc = 0, baseg = 0, baseq = 0;
#pragma unroll
        for (int i = 0; i < 8; ++i) { const int x = part[16 + i], y = part[32 + i]; gtc += x; if (i < w) { baseg += x; baseq += y; } }
        const int need = CAP - gtc;
        pg += baseg; pq += baseq;
        if ((w >> 1) == q) {
            const bool gs[4] = {g0, g1, g2, g3}, qs[4] = {q0, q1, q2, q3}; const float av[4] = {a4.x, a4.y, a4.z, a4.w};
            int cg_ = pg, cq_ = pq;
#pragma unroll
            for (int i = 0; i < 4; ++i) {
                const int t = 4 * tid + i, m = b * SEQ + t; int slot = -1;
                if (gs[i]) { slot = cg_; ++cg_; } else if (qs[i]) { if (cq_ < need) slot = gtc + cq_; ++cq_; }
                SLOT[m * 16 + e] = slot;
                if (slot >= 0) { GATEX[(e * 4 + b) * CAP + slot] = av[i]; XEIDX[(e * 4 + b) * CAP + slot] = m; }
            }
        }
    }
}

__device__ __forceinline__ void p11_final(Frame& F) {
    const bf16_t* X1 = WSP(F, WS_X1, bf16_t); const unsigned char* YE = WSP(F, WS_YE, unsigned char); const int* SLOT = WSP(F, WS_SLOT, int); const float* nw = INP(F, 27, float);
    float* out = F.a->out;
    const int lane = F.lane, gw = F.vcu * 8 + F.wave, NGW = F.G * 8;
    for (int m = gw; m < MTOK; m += NGW) {
        const int b = m >> 11;
        float v[32];
        { const u32x4* xr = (const u32x4*)(X1 + (size_t)m * DM + lane * 8);
#pragma unroll
          for (int j = 0; j < 4; ++j) { const u32x4 a = xr[64 * j]; v[8 * j] = bf_lo(a.x); v[8 * j + 1] = bf_hi(a.x); v[8 * j + 2] = bf_lo(a.y); v[8 * j + 3] = bf_hi(a.y); v[8 * j + 4] = bf_lo(a.z); v[8 * j + 5] = bf_hi(a.z); v[8 * j + 6] = bf_lo(a.w); v[8 * j + 7] = bf_hi(a.w); } }
        int sl = (lane < 16) ? SLOT[m * 16 + lane] : -1;
        for (int e = 0; e < 16; ++e) {
            const int s = __shfl(sl, e);
            if (s >= 0) { const u32x2* yr = (const u32x2*)(YE + (size_t)((e * 4 + b) * CAP + s) * DM + lane * 8);
#pragma unroll
                for (int j = 0; j < 4; ++j) { const u32x2 w = yr[64 * j];
#define P11_ACC(q_) do { v[8 * j + (q_)] += __builtin_amdgcn_cvt_f32_fp8(w.x, q_) * pg8::YE_DESCALE; v[8 * j + 4 + (q_)] += __builtin_amdgcn_cvt_f32_fp8(w.y, q_) * pg8::YE_DESCALE; } while (0)
                    P11_ACC(0); P11_ACC(1); P11_ACC(2); P11_ACC(3);
#undef P11_ACC
                } }
        }
        float s = 0.f;
#pragma unroll
        for (int i = 0; i < 32; ++i) s += v[i] * v[i];
        const float rstd = 1.f / sqrtf(wave_sum(s) * (1.f / DM) + 1e-6f);
#pragma unroll
        for (int j = 0; j < 4; ++j) { const int col = 512 * j + lane * 8; const f32x4 w0 = *(const f32x4*)(nw + col), w1 = *(const f32x4*)(nw + col + 4);
            f32x4 o0 = {v[8 * j] * rstd * w0.x, v[8 * j + 1] * rstd * w0.y, v[8 * j + 2] * rstd * w0.z, v[8 * j + 3] * rstd * w0.w};
            f32x4 o1 = {v[8 * j + 4] * rstd * w1.x, v[8 * j + 5] * rstd * w1.y, v[8 * j + 6] * rstd * w1.z, v[8 * j + 7] * rstd * w1.w};
            *(f32x4*)(out + (size_t)m * DM + col) = o0; *(f32x4*)(out + (size_t)m * DM + col + 4) = o1; }
    }
}


template <int PHM> __global__ void __launch_bounds__(512, 2) mk_fwd(Args args) {
    extern __shared__ __attribute__((aligned(16))) unsigned char lds[];
    Frame F;
    F.lds = (LAS unsigned char*)lds; F.ldsg = (char*)lds; F.a = &args;
    F.tid = threadIdx.x; F.lane = F.tid & 63; F.wave = __builtin_amdgcn_readfirstlane(F.tid >> 6);
    F.G = gridDim.x; { const int bx = blockIdx.x; F.vcu = (F.G % 8 == 0) ? (bx % 8) * (F.G / 8) + bx / 8 : bx; }
    volatile LAS unsigned* MISC = (volatile LAS unsigned*)(F.lds + MISC_OFF);
    for (int u = F.tid; u < (LDS_BYTES - 131072) / 4; u += 512) ((LAS unsigned*)(F.lds + 131072))[u] = 0u;
    __syncthreads();
    gu32* ctl = (gu32*)(args.ws + WS_CTL);
    XcdBarrier bar; bar.bar = (unsigned*)(ctl + CW_BAR); bar.x = 0; bar.st = nullptr;
    if (MK_N_LAUNCHES == 1) bar = xcd_barrier_post((unsigned*)(ctl + CW_BAR), MISC + 8);
    const int lo = args.ph_lo, hi = args.ph_hi;
#define IN(k) (((PHM >> (k)) & 1) && lo <= (k) && (k) < hi)
#ifndef DUP_MASK
#define DUP_MASK 0
#endif
#define REP(k) for (int rep_ = 0; rep_ < 1 + ((DUP_MASK >> (k)) & 1); ++rep_)
#define SEAM(k) do { if (IN(k) && IN((k) + 1)) xcd_barrier(bar); } while (0)

    if (IN(0)) REP(0) { p0_prologue(F); }
    SEAM(0);
    if (IN(1)) REP(1) {
        pg8::Gemm g{WSP(F, WS_H1, bf16_t), WSP(F, WS_WIN, bf16_t), MTOK, 6144, DM, DM}; pg8::StaticOrder S; S.init(MTOK, 6144, F.G, (int)blockIdx.x);
        pg8::EpiProj E{WSP(F, WS_PROJ, bf16_t), LDP, WSP(F, WS_ROPE, float), QSCALE};
        pg8::gemm_phase<pg8::EpiProj, pg8::StaticOrder, true, true>(F.lds, g, S, E);
        pg8::Gemm g2{WSP(F, WS_H1, bf16_t), WSP(F, WS_WIN, bf16_t), MTOK, 512, DM / 4, DM}; pg8::TailOrder S2{F.G, (int)blockIdx.x};
        pg8::EpiPart E2{WSP(F, WS_PART, bf16_t)};
        pg8::gemm_phase<pg8::EpiPart, pg8::TailOrder, true, true>(F.lds, g2, S2, E2);
    }
    SEAM(1);
    const bool prep_first = (F.vcu & 1) != 0;
    if (IN(3) && prep_first) { p3_prep(F, 0); }
    if (IN(2)) {
        const bf16_t* P = WSP(F, WS_PROJ, bf16_t); bf16_t* OC = WSP(F, WS_OC, bf16_t);
        for (int u = F.vcu * 2; u < 512; u += F.G * 2)
            for (int i = 0; i < 2; ++i) {
                const int uu = u + i, qb = uu & 7, c = (uu >> 3) & 1, h = (uu >> 4) & 7, b = uu >> 7;
                const size_t m0 = (size_t)b * SEQ;
                att::attn_unit<LDP>(P + (m0 + qb * 256) * LDP + h * 128 + c * 64, P + m0 * LDP + 1024 + h * 128 + c * 64, P + m0 * LDP + 2048 + h * 128,
                                    OC + (size_t)c * MTOK * 1024 + (m0 + qb * 256) * 1024 + h * 128, SEQ, F.ldsg);
            }
    }
    if (IN(3) && !prep_first) { p3_prep(F, 0); }
    SEAM(3);
    #ifndef SCAN_PROBE
#define SCAN_PROBE 0
#endif
    if (IN(4)) REP(4) { p4_scan(F, rep_ ? SCAN_PROBE : 0); }
    SEAM(4);
    if (IN(5)) REP(5) { p5_finalize(F); }
    SEAM(5);
    if (IN(6)) REP(6) {
        pg8::Gemm g{WSP(F, WS_MIX, bf16_t), WSP(F, WS_WOUT, bf16_t), MTOK, DM, DM, DM}; pg8::StaticOrder S; S.init(MTOK, DM, F.G, (int)blockIdx.x);
        pg8::EpiResid E{INP(F, 0, float), WSP(F, WS_X1, bf16_t), DM};
        pg8::gemm_phase<pg8::EpiResid, pg8::StaticOrder, true, true>(F.lds, g, S, E);
    }
    SEAM(6);
    if (IN(7)) REP(7) { p7_router(F); }
    SEAM(7);
    if (IN(8)) REP(8) { p8_select(F); }
    SEAM(8);
    if (IN(9)) REP(9) {
        pg8::Gemm g{WSP(F, WS_H2, bf16_t), WSP(F, WS_WGU, bf16_t), 16384, 65536, DM / 2, DM / 2}; pg8::MoeOrderT<true> S{F.G, F.vcu, 16, 1024, WSP(F, WS_XEIDX, int)};
        pg8::EpiSwiglu E{WSP(F, WS_HID, unsigned char), 16};
        pg8::gemm_phase<pg8::EpiSwiglu, pg8::MoeOrderT<true>, true, true, true>(F.lds, g, S, E);
    }
    SEAM(9);
    if (IN(10)) REP(10) {
        pg8::Gemm g{WSP(F, WS_HID, bf16_t), WSP(F, WS_WD, bf16_t), 16384, 32768, DM / 2, DM / 2}; pg8::MoeOrderT<false> S{F.G, F.vcu, 8, 512, nullptr};
        pg8::EpiDown E{WSP(F, WS_YE, unsigned char), WSP(F, WS_GATEX, float), 8};
        pg8::gemm_phase<pg8::EpiDown, pg8::MoeOrderT<false>, true, true, true>(F.lds, g, S, E);
    }
    SEAM(10);
    if (IN(11)) REP(11) { p11_final(F); }
#undef IN
#undef SEAM
}

static const void* kfn(int li) {
#if MK_N_LAUNCHES == 1
    (void)li; return (const void*)mk_fwd<0xFFF>;
#else
    switch (li) {
        case 0: return (const void*)mk_fwd<1>; case 1: return (const void*)mk_fwd<2>; case 2: return (const void*)mk_fwd<4>; case 3: return (const void*)mk_fwd<8>;
        case 4: return (const void*)mk_fwd<16>; case 5: return (const void*)mk_fwd<32>; case 6: return (const void*)mk_fwd<64>; case 7: return (const void*)mk_fwd<128>;
        case 8: return (const void*)mk_fwd<256>; case 9: return (const void*)mk_fwd<512>; case 10: return (const void*)mk_fwd<1024>; default: return (const void*)mk_fwd<2048>;
    }
#endif
}
extern "C" void kernel_launch(void* const* d_in, const int* in_sizes, int n_in, void* d_out, int out_size, void* d_ws, size_t ws_size, hipStream_t stream) {
    static int grid = 0;
    if (grid == 0) {
        if (n_in != 28 || out_size != MTOK * DM || ws_size < WS_END) { fprintf(stderr, "kernel_launch: unexpected shapes: n_in %d out %d ws %zu (need >= %zu)\n", n_in, out_size, ws_size, (size_t)WS_END); grid = -1; return; }
        int dev = 0, cus = 0, per_cu = 0;
        if (hipGetDevice(&dev) != hipSuccess || hipDeviceGetAttribute(&cus, hipDeviceAttributeMultiprocessorCount, dev) != hipSuccess) { fprintf(stderr, "kernel_launch: device query failed\n"); grid = -1; return; }
        for (int i = 0; i < MK_N_LAUNCHES; ++i) if (hipFuncSetAttribute(kfn(i), hipFuncAttributeMaxDynamicSharedMemorySize, LDS_BYTES) != hipSuccess) { fprintf(stderr, "kernel_launch: hipFuncSetAttribute failed\n"); grid = -1; return; }
        if (hipOccupancyMaxActiveBlocksPerMultiprocessor(&per_cu, kfn(0), 512, LDS_BYTES) != hipSuccess || per_cu < 1) { fprintf(stderr, "kernel_launch: occupancy query says %d blocks/CU\n", per_cu); }
        (void)hipGetLastError();
        grid = cus;
    }
    if (grid < 0) return;
    if (hipMemsetAsync((char*)d_ws + WS_CTL, 0, CTL_ZERO_BYTES, stream) != hipSuccess) { fprintf(stderr, "kernel_launch: memset failed\n"); return; }
    Args a{};
    for (int i = 0; i < 28; ++i) a.in[i] = d_in[i];
    a.out = (float*)d_out; a.ws = (unsigned char*)d_ws;
    const int nl = MK_N_LAUNCHES;
    for (int li = 0; li < nl; ++li) {
        a.ph_lo = (nl == 1) ? 0 : li; a.ph_hi = (nl == 1) ? N_PHASES : li + 1; a.li = li;
        void* kargs[] = {&a};
        (void)hipLaunchKernel(kfn(li), dim3(grid), dim3(512), kargs, LDS_BYTES, stream);
        const hipError_t le = hipPeekAtLastError();
        if (le != hipSuccess) { fprintf(stderr, "kernel_launch: launch %d failed: %s\n", li, hipGetErrorName(le)); break; }
    }
}
```

```cpp
#include <hip/hip_runtime.h>
#include <hip/hip_bf16.h>
#include <cstdio>
#include <cstdint>

#ifndef MK_N_LAUNCHES
#define MK_N_LAUNCHES 1
#endif
#ifndef CVT_IN_SCAN
#define CVT_IN_SCAN 1
#endif
constexpr int N_PHASES = 12;

constexpr int BATCH = 4, SEQ = 2048, DM = 2048, MTOK = BATCH * SEQ;
constexpr int IN_COLS = 6432, LDP = 6656;
constexpr int ZC0 = 3072;
constexpr int RW = 1024, NH_R = 16, HD_R = 64;
constexpr int NEXP = 16, CAP = 256, FF = 2048;
constexpr float QSCALE = 0.18033688011112042f;

constexpr size_t MiB = 1u << 20;
constexpr size_t WS_CTL = 0, CTL_ZERO_BYTES = 1 * MiB;
constexpr size_t WS_ROPE = 1 * MiB;
constexpr size_t WS_LORA = 2 * MiB;
constexpr size_t WS_AFF = 3 * MiB;
constexpr size_t WS_GATEX = 3 * MiB + 512 * 1024;
constexpr size_t WS_SLOT = 4 * MiB;
constexpr size_t WS_XEIDX = 6 * MiB;
constexpr size_t WS_BONUS = 5 * MiB;
constexpr size_t WS_WIN = 8 * MiB;
constexpr size_t WS_WOUT = 34 * MiB;
constexpr size_t WS_WGU = 48 * MiB;
constexpr size_t WS_WD = 304 * MiB;
constexpr size_t WS_H1 = 432 * MiB;
constexpr size_t WS_PROJ = 464 * MiB;
constexpr size_t WS_R = 568 * MiB, WS_KK = 584 * MiB, WS_V = 600 * MiB;
constexpr size_t WS_WDEC = 616 * MiB;
constexpr size_t WS_KD = 680 * MiB, WS_BB = 712 * MiB;
constexpr size_t WS_G = 744 * MiB;
constexpr size_t WS_OC = 760 * MiB;
constexpr size_t WS_YS = 792 * MiB;
constexpr size_t WS_MIX = 856 * MiB;
constexpr size_t WS_X1 = 888 * MiB;
constexpr size_t WS_H2 = 952 * MiB;
constexpr size_t WS_HID = 528 * MiB, WS_YE = 592 * MiB;
constexpr size_t WS_PART = WS_X1;
constexpr size_t WS_END = 984 * MiB;
constexpr int CW_BAR = 4096;

constexpr int LDS_BYTES = 147456;
constexpr int MISC_OFF = 131072 + 320;

#define GAS __attribute__((address_space(1)))
#define LAS __attribute__((address_space(3)))
typedef unsigned short bf16_t;
typedef float f32x4 __attribute__((ext_vector_type(4)));
typedef float f32x2 __attribute__((ext_vector_type(2)));
typedef float f32x16 __attribute__((ext_vector_type(16)));
typedef unsigned u32x4 __attribute__((ext_vector_type(4)));
typedef unsigned u32x2 __attribute__((ext_vector_type(2)));
typedef short bf16x8 __attribute__((ext_vector_type(8)));
typedef short s16x4 __attribute__((ext_vector_type(4)));
typedef __bf16 bf16x2_t __attribute__((ext_vector_type(2)));

__device__ __forceinline__ unsigned cvtpk(float lo, float hi) { f32x2 v = {lo, hi}; bf16x2_t b = __builtin_convertvector(v, bf16x2_t); return __builtin_bit_cast(unsigned, b); }
__device__ __forceinline__ float bf_lo(unsigned w) { return __uint_as_float(w << 16); }
__device__ __forceinline__ float bf_hi(unsigned w) { return __uint_as_float(w & 0xffff0000u); }
__device__ __forceinline__ float bf2f(bf16_t v) { return __uint_as_float((unsigned)v << 16); }
__device__ __forceinline__ float wave_sum(float v) {
#pragma unroll
    for (int o = 1; o < 64; o <<= 1) v += __shfl_xor(v, o);
    return v;
}
__device__ __forceinline__ float sigmoidf_(float x) { return 1.f / (1.f + __expf(-x)); }

struct Args { const void* in[28]; float* out; unsigned char* ws; int ph_lo, ph_hi, li, pad; };

namespace pg8 {
#define PG8_LAS __attribute__((address_space(3)))
typedef unsigned short bf16_t;
typedef short bf16x8 __attribute__((ext_vector_type(8)));
typedef float f32x4 __attribute__((ext_vector_type(4)));
typedef unsigned u32x4 __attribute__((ext_vector_type(4)));
typedef unsigned u32x2 __attribute__((ext_vector_type(2)));
typedef int i32x4 __attribute__((ext_vector_type(4)));
typedef int i32x8 __attribute__((ext_vector_type(8)));
typedef float f32x8 __attribute__((ext_vector_type(8)));
typedef float f32x32 __attribute__((ext_vector_type(32)));
constexpr int BM = 256, BK = 64, HALF = 128, HTB = HALF * BK * 2  , STAGE_BYTES = 8 * HTB, NXCD = 8, WGM = 8;

__host__ __device__ __forceinline__ int lds_byte(int r, int c) { const int st = (r >> 4) * 2 + (c >> 5), rr = r & 15, cc = c & 31, ob = rr * 64 + cc * 2; return st * 1024 + (ob ^ (((ob >> 9) & 1) << 5)); }
__host__ __device__ __forceinline__ void stage_rc(int b, int& R, int& C) { const int st = b / 1024, sb = b % 1024, swz = sb ^ (((sb >> 9) & 1) << 5); R = (st >> 1) * 16 + swz / 64; C = (st & 1) * 32 + (swz % 64) / 2; }
__host__ __device__ __forceinline__ int perm32(int rho) { const int n = rho >> 4, i = rho & 15; return 8 * (i >> 2) + 4 * n + (i & 3); }

struct Unit { int pm, pn, pk; };
struct Gemm { const bf16_t* A; const bf16_t* Bt; int M, N, K, Kp; };

struct StaticOrder {
    int nM, nN, nwg, G, c;
    __host__ __device__ void init(int M, int N, int G_, int c_) { nM = M / BM; nN = N / BM; nwg = nM * nN; G = G_; c = c_; }
    __host__ __device__ bool next(int i, Unit& u) const {
        const long L = (long)i * G + c; if (L >= nwg) return false;
        int wgid = (int)L; { const int q = nwg / NXCD, r = nwg % NXCD, xcd = wgid % NXCD, off = wgid / NXCD; wgid = (xcd < r ? xcd * (q + 1) : r * (q + 1) + (xcd - r) * q) + off; }
        const int nig = WGM * nN, gid = wgid / nig, fm = gid * WGM, gsz = (nM - fm) < WGM ? (nM - fm) : WGM;
        u.pm = fm + ((wgid % nig) % gsz); u.pn = (wgid % nig) / gsz; u.pk = 0; return true;
    }
    static constexpr bool GATHER = false;
    __device__ __forceinline__ int arow(const Unit&, int) const { return 0; }
    __device__ __forceinline__ void a_ready(const Unit&) const {}
    __device__ __forceinline__ void done(const Unit&) const {}
};


typedef float f32x2 __attribute__((ext_vector_type(2)));
typedef __bf16 bf16x2_t __attribute__((ext_vector_type(2)));
__device__ __forceinline__ unsigned cvt_pk_bf16(float lo, float hi) { f32x2 v = {lo, hi}; bf16x2_t b = __builtin_convertvector(v, bf16x2_t); return __builtin_bit_cast(unsigned, b); }

template <bool GATHER_> struct MoeOrderT {
    static constexpr bool GATHER = GATHER_;
    int G, vcu, npn, total; const int* idx;
    __device__ __forceinline__ int arow(const Unit& u, int r) const { return idx[u.pm * BM + r]; }
    __device__ bool next(int i, Unit& u) const {
        const int L = i * G + vcu; if (L >= total) return false;
        const int per_e = 4 * npn, e = L / per_e, r = L % per_e;
        u.pm = e * 4 + (r & 3); u.pn = e * npn + (r >> 2); u.pk = 0; return true;
    }
    __device__ __forceinline__ void a_ready(const Unit&) const {}
    __device__ __forceinline__ void done(const Unit&) const {}
};

struct TailOrder {
    int G, c; static constexpr bool GATHER = false;
    __device__ bool next(int i, Unit& u) const { const int L = i * G + c; if (L >= 256) return false; u.pk = L & 3; const int t = L >> 2; u.pm = t & 31; u.pn = 24 + (t >> 5); return true; }
    __device__ __forceinline__ int arow(const Unit&, int) const { return 0; }
    __device__ __forceinline__ void a_ready(const Unit&) const {}
    __device__ __forceinline__ void done(const Unit&) const {}
};
struct EpiPart {
    static constexpr bool PERM = true, AFTER_DRAIN = false;
    bf16_t* P;
    __device__ __forceinline__ void operator()(const f32x4 (&acc)[2][2][4][2], const Unit& u, int wr, int wc, int fr, int fq) const {
        bf16_t* base = P + ((size_t)(((u.pn - 24) * 32 + u.pm) * 4 + u.pk) << 16);
        const int row0 = wr * 64 + fr, col0 = wc * 32 + 8 * fq;
        const bool thin = (u.pn == 25);
        if (thin && wc != 0) return;
#pragma unroll
        for (int ai = 0; ai < 2; ++ai)
#pragma unroll
            for (int m = 0; m < 4; ++m) {
                bf16_t* rowp = base + (row0 + ai * HALF + m * 16) * 256 + col0;
#pragma unroll
                for (int bj = 0; bj < 2; ++bj) { if (bj == 1 && thin) break; const f32x4 v0 = acc[ai][bj][m][0], v1 = acc[ai][bj][m][1];
                    u32x4 w; w.x = cvt_pk_bf16(v0[0], v0[1]); w.y = cvt_pk_bf16(v0[2], v0[3]); w.z = cvt_pk_bf16(v1[0], v1[1]); w.w = cvt_pk_bf16(v1[2], v1[3]);
                    *(u32x4*)(rowp + bj * HALF) = w; }
            }
    }
};

struct EpiProj {
    static constexpr bool PERM = true, AFTER_DRAIN = false;
    bf16_t* P; int ldp; const float* rope; float qscale;
    __device__ __forceinline__ void operator()(const f32x4 (&acc)[2][2][4][2], const Unit& u, int wr, int wc, int fr, int fq) const {
        const int row0 = u.pm * BM + wr * 64 + fr, colt = u.pn * BM, col0 = colt + wc * 32 + 8 * fq;
        const bool ropew = (colt < 2048) && ((wc & 1) == 0);
        const float sc = (colt < 1024) ? qscale : 1.f, sgn = (fq == 0) ? -1.f : 1.f;
#pragma unroll
        for (int ai = 0; ai < 2; ++ai)
#pragma unroll
            for (int m = 0; m < 4; ++m) {
                const int row = row0 + ai * HALF + m * 16;
                f32x4 c0 = {1.f, 1.f, 1.f, 1.f}, c1 = c0, s0 = {0.f, 0.f, 0.f, 0.f}, s1 = s0;
                if (ropew) { const f32x4* rp = (const f32x4*)(rope + (size_t)row * 16); c0 = rp[0]; c1 = rp[1]; s0 = rp[2]; s1 = rp[3]; }
                bf16_t* rowp = P + (size_t)row * ldp + col0;
#pragma unroll
                for (int bj = 0; bj < 2; ++bj) {
                    f32x4 v0 = acc[ai][bj][m][0], v1 = acc[ai][bj][m][1];
                    if (ropew) {
                        f32x4 p0, p1;
#pragma unroll
                        for (int i = 0; i < 4; ++i) { p0[i] = __shfl_xor(v0[i], 16); p1[i] = __shfl_xor(v1[i], 16); }
                        if (fq < 2) { v0 = v0 * c0 + (p0 * s0) * sgn; v1 = v1 * c1 + (p1 * s1) * sgn; }
                    }
                    v0 = v0 * sc; v1 = v1 * sc;
                    u32x4 w; w.x = cvt_pk_bf16(v0[0], v0[1]); w.y = cvt_pk_bf16(v0[2], v0[3]); w.z = cvt_pk_bf16(v1[0], v1[1]); w.w = cvt_pk_bf16(v1[2], v1[3]);
                    *(u32x4*)(rowp + bj * HALF) = w;
                }
            }
    }
};

struct EpiResid {
    static constexpr bool PERM = true, AFTER_DRAIN = false;
    const float* base; bf16_t* out; int ldc;
    __device__ __forceinline__ void operator()(const f32x4 (&acc)[2][2][4][2], const Unit& u, int wr, int wc, int fr, int fq) const {
        const int row0 = u.pm * BM + wr * 64 + fr, col0 = u.pn * BM + wc * 32 + 8 * fq;
#pragma unroll
        for (int ai = 0; ai < 2; ++ai)
#pragma unroll
            for (int m = 0; m < 4; ++m) {
                const size_t off = (size_t)(row0 + ai * HALF + m * 16) * ldc + col0;
#pragma unroll
                for (int bj = 0; bj < 2; ++bj) { const f32x4 b0 = *(const f32x4*)(base + off + bj * HALF), b1 = *(const f32x4*)(base + off + bj * HALF + 4);
                    const f32x4 v0 = b0 + acc[ai][bj][m][0], v1 = b1 + acc[ai][bj][m][1];
                    u32x4 w; w.x = cvt_pk_bf16(v0[0], v0[1]); w.y = cvt_pk_bf16(v0[2], v0[3]); w.z = cvt_pk_bf16(v1[0], v1[1]); w.w = cvt_pk_bf16(v1[2], v1[3]);
                    *(u32x4*)(out + off + bj * HALF) = w; }
            }
    }
};

__device__ __forceinline__ float clamp8(float x) { return __builtin_fminf(__builtin_fmaxf(x, -448.f), 448.f); }
__device__ __forceinline__ unsigned cvt4_fp8(float a, float b, float c, float d) {
    int w = __builtin_amdgcn_cvt_pk_fp8_f32(clamp8(a), clamp8(b), 0, false); w = __builtin_amdgcn_cvt_pk_fp8_f32(clamp8(c), clamp8(d), w, true); return (unsigned)w; }
constexpr float W8_SCALE = 64.f, W8_DESCALE = 1.f / 64.f;

struct EpiSwiglu {
    static constexpr bool PERM = true, AFTER_DRAIN = false;
    unsigned char* H; int npn;
    __device__ __forceinline__ void operator()(const f32x4 (&acc)[2][2][4][2], const Unit& u, int wr, int wc, int fr, int fq) const {
        const int row0 = u.pm * BM + wr * 64 + fr, pnl = u.pn % npn, col0 = pnl * HALF + wc * 32 + 8 * fq;
#pragma unroll
        for (int ai = 0; ai < 2; ++ai)
#pragma unroll
            for (int m = 0; m < 4; ++m) {
                unsigned char* rowp = H + (size_t)(row0 + ai * HALF + m * 16) * 2048 + col0;
                float h[8];
#pragma unroll
                for (int n = 0; n < 2; ++n)
#pragma unroll
                    for (int i = 0; i < 4; ++i) { const float g = acc[ai][0][m][n][i] * W8_DESCALE, up = acc[ai][1][m][n][i] * W8_DESCALE; h[n * 4 + i] = g * up * __builtin_amdgcn_rcpf(1.f + __expf(-g)); }
                u32x2 w; w.x = cvt4_fp8(h[0], h[1], h[2], h[3]); w.y = cvt4_fp8(h[4], h[5], h[6], h[7]);
                *(u32x2*)rowp = w;
            }
    }
};

constexpr float YE_SCALE = 16.f, YE_DESCALE = 1.f / 16.f;
struct EpiDown {
    static constexpr bool PERM = true, AFTER_DRAIN = false;
    unsigned char* Y; const float* gate; int npn;
    __device__ __forceinline__ void operator()(const f32x4 (&acc)[2][2][4][2], const Unit& u, int wr, int wc, int fr, int fq) const {
        const int row0 = u.pm * BM + wr * 64 + fr, pnl = u.pn % npn, col0 = pnl * BM + wc * 32 + 8 * fq;
#pragma unroll
        for (int ai = 0; ai < 2; ++ai)
#pragma unroll
            for (int m = 0; m < 4; ++m) {
                const int row = row0 + ai * HALF + m * 16; const float gt = gate[row] * (W8_DESCALE * YE_SCALE);
                unsigned char* rowp = Y + (size_t)row * 2048 + col0;
#pragma unroll
                for (int bj = 0; bj < 2; ++bj) { const f32x4 v0 = acc[ai][bj][m][0] * gt, v1 = acc[ai][bj][m][1] * gt;
                    u32x2 w; w.x = cvt4_fp8(v0[0], v0[1], v0[2], v0[3]); w.y = cvt4_fp8(v1[0], v1[1], v1[2], v1[3]);
                    *(u32x2*)(rowp + bj * HALF) = w; }
            }
    }
};

template <class Epi, class Sched, bool ALIGN_EPI = false, bool SP2 = false, bool FP8 = false>
__device__ __forceinline__ void gemm_phase(PG8_LAS unsigned char* lds, const Gemm g, const Sched& S, const Epi& E) {
    const int tid = threadIdx.x, wid = __builtin_amdgcn_readfirstlane(tid >> 6), lane = tid & 63, wr = wid >> 2, wc = wid & 3, fr = lane & 15, fq = lane >> 4;
    const int K = g.Kp, nt = g.K / BK;
    const size_t kslice = (size_t)g.K * 2;
    unsigned voffA[2], voffB[2];
#pragma unroll
    for (int i = 0; i < 2; ++i) { int R, C; stage_rc(tid * 16 + i * 8192, R, C); const int Rb = Epi::PERM ? ((R & ~31) + perm32(R & 31)) : R;
        voffA[i] = (unsigned)(R * K + C) * 2u; voffB[i] = (unsigned)(Rb * K + C) * 2u; }
    static_assert(!Sched::GATHER || SP2, "gathered A rows: SP2 loop only");
    const size_t kstep = (size_t)(BK * 2);
    const size_t hstep = (size_t)HALF * K * 2;
    const size_t tstep = 2 * hstep;
    const unsigned ldsw = (unsigned)wid * 1024u;
    const int aoff = lds_byte(wr * 64 + fr, fq * 8), boff = lds_byte(wc * 32 + fr, fq * 8);
#define PG8_SA(b, h) (((b) * 2 + (h)) * HTB)
#define PG8_SB(b, h) ((4 + (b) * 2 + (h)) * HTB)
#define PG8_STAGE(bufoff, gbase, voff) do { _Pragma("unroll") for (int _i = 0; _i < 2; ++_i) \
        __builtin_amdgcn_global_load_lds((const unsigned*)((const char*)(gbase) + (voff)[_i]), (PG8_LAS unsigned*)(lds + (bufoff) + ldsw + _i * 8192), 16, 0, 0); } while (0)
#define PG8_LDA(dst, b, h) do { _Pragma("unroll") for (int m = 0; m < 4; ++m) _Pragma("unroll") for (int k = 0; k < 2; ++k) dst[m][k] = *(const PG8_LAS bf16x8*)(lds + PG8_SA(b, h) + aoff + m * 2048 + k * 1024); } while (0)
#define PG8_LDB(dst, b, h) do { _Pragma("unroll") for (int n = 0; n < 2; ++n) _Pragma("unroll") for (int k = 0; k < 2; ++k) dst[n][k] = *(const PG8_LAS bf16x8*)(lds + PG8_SB(b, h) + boff + n * 2048 + k * 1024); } while (0)
#define PG8_CAT8(x, y) __builtin_shufflevector(__builtin_bit_cast(i32x4, x), __builtin_bit_cast(i32x4, y), 0, 1, 2, 3, 4, 5, 6, 7)
#define PG8_W8(c) __builtin_shufflevector(c, c, 0, 1, 2, 3, -1, -1, -1, -1)
#define PG8_MMA(ai, bj, At, Bt) do { __builtin_amdgcn_s_setprio(1); \
        if constexpr (FP8) { f32x32 a_ = acc32[ai][bj]; _Pragma("unroll") for (int m = 0; m < 4; ++m) _Pragma("unroll") for (int n = 0; n < 2; ++n) { \
            f32x4 c_ = {a_[(m * 2 + n) * 4], a_[(m * 2 + n) * 4 + 1], a_[(m * 2 + n) * 4 + 2], a_[(m * 2 + n) * 4 + 3]}; \
            c_ = __builtin_amdgcn_mfma_scale_f32_16x16x128_f8f6f4(PG8_CAT8(Bt[n][0], Bt[n][1]), PG8_CAT8(At[m][0], At[m][1]), c_, 0, 0, 0, 0, 0, 0); \
            a_[(m * 2 + n) * 4] = c_[0]; a_[(m * 2 + n) * 4 + 1] = c_[1]; a_[(m * 2 + n) * 4 + 2] = c_[2]; a_[(m * 2 + n) * 4 + 3] = c_[3]; } acc32[ai][bj] = a_; } \
        else { _Pragma("unroll") for (int m = 0; m < 4; ++m) _Pragma("unroll") for (int n = 0; n < 2; ++n) _Pragma("unroll") for (int k = 0; k < 2; ++k) \
            acc[ai][bj][m][n] = __builtin_amdgcn_mfma_f32_16x16x32_bf16(Bt[n][k], At[m][k], acc[ai][bj][m][n], 0, 0, 0); } __builtin_amdgcn_s_setprio(0); } while (0)
#define PG8_WAIT_V(n) asm volatile("s_waitcnt vmcnt(" #n ")" ::: "memory")
#define PG8_WAIT_L(n) asm volatile("s_waitcnt lgkmcnt(" #n ")" ::: "memory")
#define PG8_BAR __builtin_amdgcn_s_barrier()
#define PG8_SCHED __builtin_amdgcn_sched_barrier(0)
    Unit cur, nxt; int ui = 0;
    if (!S.next(0, cur)) return;
    f32x4 acc[2][2][4][2]; f32x32 acc32[2][2];
#pragma unroll
    for (int a = 0; a < 2; ++a)
#pragma unroll
        for (int b = 0; b < 2; ++b)
#pragma unroll
            for (int m = 0; m < 4; ++m) {
#pragma unroll
                for (int n = 0; n < 2; ++n) { acc[a][b][m][n] = (f32x4){0.f, 0.f, 0.f, 0.f};
#pragma unroll
                    for (int i = 0; i < 4; ++i) acc32[a][b][(m * 2 + n) * 4 + i] = 0.f; } }
    bf16x8 At[4][2], B0[2][2], B1[2][2];
    const char* cA = (const char*)g.A + (size_t)cur.pm * tstep + (size_t)cur.pk * kslice; const char* cB = (const char*)g.Bt + (size_t)cur.pn * tstep + (size_t)cur.pk * kslice;
    unsigned cvA0[2], cvA1[2], nvA0[2], nvA1[2];
#pragma unroll
    for (int i = 0; i < 2; ++i) { int R, C; stage_rc(tid * 16 + i * 8192, R, C);
        if constexpr (Sched::GATHER) { cvA0[i] = (unsigned)(S.arow(cur, R) * K + C) * 2u; cvA1[i] = (unsigned)(S.arow(cur, HALF + R) * K + C) * 2u; }
        else { cvA0[i] = voffA[i]; cvA1[i] = voffA[i] + (unsigned)hstep; }
        nvA0[i] = cvA0[i]; nvA1[i] = cvA1[i]; }
    if constexpr (Sched::GATHER) cA = (const char*)g.A;
    S.a_ready(cur);
    if constexpr (SP2) {
        PG8_STAGE(PG8_SB(0, 0), cB, voffB); PG8_STAGE(PG8_SB(0, 1), cB + hstep, voffB); PG8_STAGE(PG8_SA(0, 0), cA, cvA0); PG8_STAGE(PG8_SA(0, 1), cA, cvA1);
        if (wr == 1) PG8_BAR;
        PG8_WAIT_V(2); PG8_BAR;
        PG8_STAGE(PG8_SB(1, 0), cB + kstep, voffB); PG8_STAGE(PG8_SA(1, 0), cA + kstep, cvA0); PG8_STAGE(PG8_SB(1, 1), cB + hstep + kstep, voffB);
        PG8_WAIT_V(6); PG8_BAR;
    } else {
        PG8_STAGE(PG8_SB(0, 0), cB, voffB); PG8_STAGE(PG8_SA(0, 0), cA, voffA); PG8_STAGE(PG8_SB(0, 1), cB + hstep, voffB); PG8_STAGE(PG8_SA(0, 1), cA + hstep, voffA);
        if (wr == 1) PG8_BAR;
        PG8_WAIT_V(4); PG8_BAR;
        PG8_STAGE(PG8_SB(1, 0), cB + kstep, voffB); PG8_STAGE(PG8_SA(1, 0), cA + kstep, voffA); PG8_STAGE(PG8_SB(1, 1), cB + hstep + kstep, voffB);
        PG8_WAIT_V(6); PG8_BAR;
    }
    for (;;) {
        const bool has_next = S.next(ui + 1, nxt);
        const char* nA = Sched::GATHER ? (const char*)g.A : (has_next ? (const char*)g.A + (size_t)nxt.pm * tstep + (size_t)nxt.pk * kslice : cA);
        if constexpr (Sched::GATHER) { if (has_next) {
#pragma unroll
            for (int i = 0; i < 2; ++i) { int R, C; stage_rc(tid * 16 + i * 8192, R, C); nvA0[i] = (unsigned)(S.arow(nxt, R) * K + C) * 2u; nvA1[i] = (unsigned)(S.arow(nxt, HALF + R) * K + C) * 2u; } } } const char* nB = has_next ? (const char*)g.Bt + (size_t)nxt.pn * tstep + (size_t)nxt.pk * kslice : cB;
        for (int t = 0; t < nt; t += 2) {
            const bool last = (t == nt - 2);
            const char* a1 = cA + (size_t)(t + 1) * kstep;
            const char* a2 = last ? nA : cA + (size_t)(t + 2) * kstep; const char* b2 = last ? nB : cB + (size_t)(t + 2) * kstep;
            const char* a3 = a2 + kstep; const char* b3 = b2 + kstep;
            if (last && has_next) S.a_ready(nxt);
            unsigned sA0[2], sA1[2];
#pragma unroll
            for (int i = 0; i < 2; ++i) { sA0[i] = last ? nvA0[i] : cvA0[i]; sA1[i] = last ? nvA1[i] : cvA1[i]; }
            if constexpr (SP2) {
            PG8_LDB(B0, 0, 0); PG8_LDB(B1, 0, 1); PG8_SCHED; PG8_LDA(At, 0, 0); PG8_STAGE(PG8_SA(1, 1), a1, cvA1);
            PG8_WAIT_V(8); PG8_WAIT_L(0); PG8_BAR; PG8_MMA(0, 0, At, B0); PG8_MMA(0, 1, At, B1); PG8_BAR; PG8_SCHED;
            PG8_LDA(At, 0, 1); PG8_STAGE(PG8_SB(0, 0), b2, voffB); PG8_STAGE(PG8_SB(0, 1), b2 + hstep, voffB); PG8_STAGE(PG8_SA(0, 0), a2, sA0);
            PG8_WAIT_V(8); PG8_WAIT_L(0); PG8_BAR; PG8_MMA(1, 0, At, B0); PG8_MMA(1, 1, At, B1); PG8_BAR; PG8_SCHED;
            PG8_LDB(B0, 1, 0); PG8_LDB(B1, 1, 1); PG8_SCHED; PG8_LDA(At, 1, 0); PG8_STAGE(PG8_SA(0, 1), a2, sA1);
            PG8_WAIT_V(8); PG8_WAIT_L(0); PG8_BAR; PG8_MMA(0, 0, At, B0); PG8_MMA(0, 1, At, B1); PG8_BAR; PG8_SCHED;
            PG8_LDA(At, 1, 1); PG8_STAGE(PG8_SB(1, 0), b3, voffB); PG8_STAGE(PG8_SB(1, 1), b3 + hstep, voffB); PG8_STAGE(PG8_SA(1, 0), a3, sA0);
            PG8_WAIT_V(8); PG8_WAIT_L(0); PG8_BAR; PG8_MMA(1, 0, At, B0); PG8_MMA(1, 1, At, B1); PG8_BAR; PG8_SCHED;
            } else {
            PG8_LDB(B0, 0, 0); PG8_SCHED; PG8_LDA(At, 0, 0); PG8_STAGE(PG8_SA(1, 1), a1 + hstep, voffA);
            PG8_WAIT_L(8); PG8_BAR; PG8_WAIT_L(0); PG8_MMA(0, 0, At, B0); PG8_BAR; PG8_SCHED;
            PG8_LDB(B1, 0, 1); PG8_STAGE(PG8_SB(0, 0), b2, voffB);
            PG8_BAR; PG8_WAIT_L(0); PG8_MMA(0, 1, At, B1); PG8_BAR;
            PG8_LDA(At, 0, 1); PG8_STAGE(PG8_SA(0, 0), a2, voffA);
            PG8_BAR; PG8_WAIT_L(0); PG8_MMA(1, 0, At, B0); PG8_BAR; PG8_SCHED;
            PG8_STAGE(PG8_SB(0, 1), b2 + hstep, voffB);
            PG8_WAIT_V(6); PG8_BAR; PG8_MMA(1, 1, At, B1); PG8_BAR;
            PG8_LDB(B0, 1, 0); PG8_SCHED; PG8_LDA(At, 1, 0); PG8_STAGE(PG8_SA(0, 1), a2 + hstep, voffA);
            PG8_WAIT_L(8); PG8_BAR; PG8_WAIT_L(0); PG8_MMA(0, 0, At, B0); PG8_BAR; PG8_SCHED;
            PG8_LDB(B1, 1, 1); PG8_STAGE(PG8_SB(1, 0), b3, voffB);
            PG8_BAR; PG8_WAIT_L(0); PG8_MMA(0, 1, At, B1); PG8_BAR;
            PG8_LDA(At, 1, 1); PG8_STAGE(PG8_SA(1, 0), a3, voffA);
            PG8_BAR; PG8_WAIT_L(0); PG8_MMA(1, 0, At, B0); PG8_BAR; PG8_SCHED;
            PG8_STAGE(PG8_SB(1, 1), b3 + hstep, voffB);
            PG8_WAIT_V(6); PG8_BAR; PG8_MMA(1, 1, At, B1); PG8_BAR;
            }
        }
        if constexpr (ALIGN_EPI) { if (wr == 0) PG8_BAR; }
        if constexpr (FP8) {
#pragma unroll
            for (int a = 0; a < 2; ++a)
#pragma unroll
                for (int b = 0; b < 2; ++b)
#pragma unroll
                    for (int m = 0; m < 4; ++m)
#pragma unroll
                        for (int n = 0; n < 2; ++n)
#pragma unroll
                            for (int i = 0; i < 4; ++i) acc[a][b][m][n][i] = acc32[a][b][(m * 2 + n) * 4 + i]; }
        if constexpr (!Epi::AFTER_DRAIN) { E(acc, cur, wr, wc, fr, fq); S.done(cur); }
        if (!has_next) break;
#pragma unroll
        for (int a = 0; a < 2; ++a)
#pragma unroll
            for (int b = 0; b < 2; ++b)
#pragma unroll
                for (int m = 0; m < 4; ++m) {
#pragma unroll
                    for (int n = 0; n < 2; ++n) { acc[a][b][m][n] = (f32x4){0.f, 0.f, 0.f, 0.f};
#pragma unroll
                        for (int i = 0; i < 4; ++i) acc32[a][b][(m * 2 + n) * 4 + i] = 0.f; } }
        cur = nxt; cA = nA; cB = nB; ++ui;
#pragma unroll
        for (int i = 0; i < 2; ++i) { cvA0[i] = nvA0[i]; cvA1[i] = nvA1[i]; }
        if constexpr (ALIGN_EPI) { if (wr == 1) PG8_BAR; }
    }
    PG8_WAIT_V(0);
    if constexpr (!ALIGN_EPI) { if (wr == 0) PG8_BAR; }
    PG8_BAR;
    if constexpr (Epi::AFTER_DRAIN) { E.fused(acc, cur, wr, wc, fr, fq, lds, wid, lane); S.done(cur); }
#undef PG8_SA
#undef PG8_SB
#undef PG8_STAGE
#undef PG8_LDA
#undef PG8_LDB
#undef PG8_MMA
#undef PG8_CAT8
#undef PG8_W8
#undef PG8_WAIT_V
#undef PG8_WAIT_L
#undef PG8_BAR
#undef PG8_SCHED
}
}

namespace att {
constexpr int NW = 8, QBLK = 32, KVBLK = 64;
constexpr float THR = 8.f;
constexpr int SHM_V = KVBLK * 128 * 2, SHM_K = KVBLK * 64 * 2;
constexpr int SHM_ATTN = 2 * SHM_V + 2 * SHM_K + NW * 64 * 4;
#define KSWZ64(row, colB) ((row) * 128 + ((colB) ^ ((((row) >> 1) & 7) << 4)))
#define SBAR() __builtin_amdgcn_sched_barrier(0)
__device__ __forceinline__ int crow(int r, int hi) { return (r & 3) + 8 * (r >> 2) + 4 * hi; }

__device__ __forceinline__ void partialSM(f32x16& p0, f32x16& p1, float& m_reg, float& mn, float& alpha) {
  float pmax = p0[0];
#pragma unroll
  for (int r = 1; r < 16; ++r) pmax = fmaxf(pmax, p0[r]);
#pragma unroll
  for (int r = 0; r < 16; ++r) pmax = fmaxf(pmax, p1[r]);
  { auto rr = __builtin_amdgcn_permlane32_swap(__float_as_uint(pmax), __float_as_uint(pmax), false, false);
    pmax = fmaxf(__uint_as_float(rr[0]), __uint_as_float(rr[1])); }
  if (__builtin_expect(__all(pmax - m_reg <= THR), 1)) { mn = m_reg; alpha = 1.f; }
  else { mn = fmaxf(m_reg, pmax); alpha = __builtin_amdgcn_exp2f(m_reg - mn); m_reg = mn; }
#pragma unroll
  for (int r = 0; r < 16; ++r) p0[r] = p0[r] - mn;
#pragma unroll
  for (int r = 0; r < 16; ++r) p1[r] = p1[r] - mn;
#pragma unroll
  for (int r = 0; r < 16; ++r) p0[r] = __builtin_amdgcn_exp2f(p0[r]);
}
__device__ __forceinline__ void finishSM(f32x16& p0, f32x16& p1, float alpha, float& l_reg, bf16x8& pa0, bf16x8& pa1, bf16x8& pa2, bf16x8& pa3) {
#pragma unroll
  for (int r = 0; r < 16; ++r) p1[r] = __builtin_amdgcn_exp2f(p1[r]);
  float ps = 0;
#pragma unroll
  for (int r = 0; r < 16; ++r) ps += p0[r];
#pragma unroll
  for (int r = 0; r < 16; ++r) ps += p1[r];
  { auto rr = __builtin_amdgcn_permlane32_swap(__float_as_uint(ps), __float_as_uint(ps), false, false);
    ps = __uint_as_float(rr[0]) + __uint_as_float(rr[1]); }
  l_reg = l_reg * alpha + ps;
#define PK4(P, BASE, OUT) do { unsigned a0 = cvtpk(P[BASE + 0], P[BASE + 1]), a1 = cvtpk(P[BASE + 2], P[BASE + 3]);   \
    unsigned b0 = cvtpk(P[BASE + 4], P[BASE + 5]), b1 = cvtpk(P[BASE + 6], P[BASE + 7]);                              \
    auto r0 = __builtin_amdgcn_permlane32_swap(a0, b0, false, false); auto r1 = __builtin_amdgcn_permlane32_swap(a1, b1, false, false); \
    u32x4 w = {r0[0], r1[0], r0[1], r1[1]}; OUT = __builtin_bit_cast(bf16x8, w); } while (0)
  PK4(p0, 0, pa0); PK4(p0, 8, pa1); PK4(p1, 0, pa2); PK4(p1, 8, pa3);
#undef PK4
}
__device__ __forceinline__ void qkt(f32x16& p0, f32x16& p1, const char* Ks, const bf16x8* qr, int r32, int hi) {
  p0 = f32x16{}; p1 = f32x16{};
#pragma unroll
  for (int d0 = 0; d0 < 4; ++d0) { const int cb = (d0 * 16 + hi * 8) * 2;
    bf16x8 b0 = *reinterpret_cast<const bf16x8*>(Ks + KSWZ64(r32, cb));
    bf16x8 b1 = *reinterpret_cast<const bf16x8*>(Ks + KSWZ64(32 + r32, cb));
    p0 = __builtin_amdgcn_mfma_f32_32x32x16_bf16(b0, qr[d0], p0, 0, 0, 0);
    p1 = __builtin_amdgcn_mfma_f32_32x32x16_bf16(b1, qr[d0], p1, 0, 0, 0); }
}
__device__ __forceinline__ int v_st(int k, int c) { const int kk = (k & ~0xC) | ((k & 4) << 1) | ((k & 8) >> 1); return ((kk >> 3) * 4 + (c >> 5)) * 512 + ((kk & 7) * 32 + (c & 31)) * 2; }
__device__ __forceinline__ int v_rd_base(int lane) { return ((lane & 3) << 3) | (((lane >> 2) & 3) << 6) | (((lane >> 4) & 1) << 5) | (((lane >> 5) & 1) << 8); }
constexpr int v_rd_off(int d0, int ks, int half) { return d0 * 512 + ks * 4096 + half * 2048; }
template <int OFF> __device__ __forceinline__ s16x4 tr_read(int vb) {
  s16x4 r; asm volatile("ds_read_b64_tr_b16 %0, %1 offset:%2" : "=&v"(r) : "v"(vb), "i"(OFF) : "memory"); return r;
}
template <int D0> __device__ __forceinline__ void pv_one(f32x16& od, int vb, bf16x8 pa0, bf16x8 pa1, bf16x8 pa2, bf16x8 pa3) {
  const s16x4 l0 = tr_read<v_rd_off(D0, 0, 0)>(vb), h0 = tr_read<v_rd_off(D0, 0, 1)>(vb), l1 = tr_read<v_rd_off(D0, 1, 0)>(vb), h1 = tr_read<v_rd_off(D0, 1, 1)>(vb);
  const s16x4 l2 = tr_read<v_rd_off(D0, 2, 0)>(vb), h2 = tr_read<v_rd_off(D0, 2, 1)>(vb), l3 = tr_read<v_rd_off(D0, 3, 0)>(vb), h3 = tr_read<v_rd_off(D0, 3, 1)>(vb);
  asm volatile("s_waitcnt lgkmcnt(0)" ::: "memory"); SBAR();
#define PK(L, H) (bf16x8){L[0], L[1], L[2], L[3], H[0], H[1], H[2], H[3]}
  od = __builtin_amdgcn_mfma_f32_32x32x16_bf16(pa0, PK(l0, h0), od, 0, 0, 0);
  od = __builtin_amdgcn_mfma_f32_32x32x16_bf16(pa1, PK(l1, h1), od, 0, 0, 0);
  od = __builtin_amdgcn_mfma_f32_32x32x16_bf16(pa2, PK(l2, h2), od, 0, 0, 0);
  od = __builtin_amdgcn_mfma_f32_32x32x16_bf16(pa3, PK(l3, h3), od, 0, 0, 0);
#undef PK
}
__device__ __forceinline__ void pv_d0(f32x16* o, int vb, bf16x8 pa0, bf16x8 pa1, bf16x8 pa2, bf16x8 pa3) {
  pv_one<0>(o[0], vb, pa0, pa1, pa2, pa3); pv_one<1>(o[1], vb, pa0, pa1, pa2, pa3); pv_one<2>(o[2], vb, pa0, pa1, pa2, pa3); pv_one<3>(o[3], vb, pa0, pa1, pa2, pa3);
}

template <int LDQ>
__device__ __forceinline__ void attn_unit(const bf16_t* __restrict__ Qb, const bf16_t* __restrict__ Kh, const bf16_t* __restrict__ Vh, bf16_t* __restrict__ Ob, int seq, char* lds) {
  const int tid = threadIdx.x, wid = tid >> 6, lane = tid & 63, r32 = lane & 31, hi = lane >> 5;
  char* V_lds = lds; char* K_lds = lds + 2 * SHM_V;
  float* ws = (float*)(lds + 2 * SHM_V + 2 * SHM_K) + wid * 64; float* li_l = ws; float* al_l = ws + 32;
  float m_reg = -1e30f, l_reg = 0; f32x16 o[4] = {}; bf16x8 qr[4];
  const bf16_t* Qw = Qb + (long)(wid * QBLK + r32) * LDQ + hi * 8;
#pragma unroll
  for (int d0 = 0; d0 < 4; ++d0) qr[d0] = *reinterpret_cast<const bf16x8*>(Qw + d0 * 16);
  const int sr = tid >> 4, sc = (tid & 15) * 8, vst0 = v_st(sr, sc), vst1 = v_st(32 + sr, sc);
  const int kr = tid >> 3, kc8 = (tid & 7) * 8, kst = KSWZ64(kr, kc8 * 2);
  const int vb0 = (int)(uintptr_t)V_lds + v_rd_base(lane);
  struct { bf16x8 vs0, vs1, ks; } sr_[2];
  const bf16_t* Vp0 = Vh + (long)sr * LDQ + sc; const bf16_t* Kp0 = Kh + (long)kr * LDQ + kc8;
#define SLOAD(i, k0) do { const long ko_ = (long)(k0) * LDQ; sr_[i].vs0 = *reinterpret_cast<const bf16x8*>(Vp0 + ko_); sr_[i].vs1 = *reinterpret_cast<const bf16x8*>(Vp0 + ko_ + 32 * LDQ); \
    sr_[i].ks = *reinterpret_cast<const bf16x8*>(Kp0 + ko_); } while (0)
#define SWRITE(b, i) do { *(bf16x8*)(V_lds + (b) * SHM_V + vst0) = sr_[i].vs0; *(bf16x8*)(V_lds + (b) * SHM_V + vst1) = sr_[i].vs1; \
    *(bf16x8*)(K_lds + (b) * SHM_K + kst) = sr_[i].ks; } while (0)
#define SWAIT() asm volatile("s_waitcnt vmcnt(3)" ::: "memory")
#define RESC(a) do { if (__any((a) < 1.f)) { if (hi == 0) al_l[r32] = (a); asm volatile("s_waitcnt lgkmcnt(0)" ::: "memory"); \
    _Pragma("unroll") for (int d = 0; d < 4; ++d) _Pragma("unroll") for (int r = 0; r < 16; ++r) o[d][r] *= al_l[crow(r, hi)]; } } while (0)
  f32x16 pA0, pA1, pB0, pB1; float mnA, mnB, alA, alB; bf16x8 pa0, pa1, pa2, pa3; const int NT = seq / KVBLK;
  constexpr int SE = 0, SO = 1;
  SLOAD(SE, 0); asm volatile("s_waitcnt vmcnt(0)" ::: "memory"); SWRITE(0, SE); __syncthreads();
  qkt(pA0, pA1, K_lds, qr, r32, hi); partialSM(pA0, pA1, m_reg, mnA, alA);
  SLOAD(SO, KVBLK); if (2 < NT) SLOAD(SE, 2 * KVBLK);
  SWAIT(); SWRITE(1, SO); __syncthreads();
  for (int j = 1; j + 1 < NT; j += 2) {
    SBAR(); qkt(pB0, pB1, K_lds + SHM_K, qr, r32, hi);
    finishSM(pA0, pA1, alA, l_reg, pa0, pa1, pa2, pa3); SBAR();
    SLOAD(SO, (j + 2) * KVBLK); SBAR();
    pv_d0(o, vb0, pa0, pa1, pa2, pa3); partialSM(pB0, pB1, m_reg, mnB, alB);
    __syncthreads(); SWAIT(); SWRITE(0, SE);
    RESC(alB); __syncthreads();
    SBAR(); qkt(pA0, pA1, K_lds, qr, r32, hi);
    finishSM(pB0, pB1, alB, l_reg, pa0, pa1, pa2, pa3); SBAR();
    if (j + 3 < NT) SLOAD(SE, (j + 3) * KVBLK); SBAR();
    pv_d0(o, vb0 + SHM_V, pa0, pa1, pa2, pa3); partialSM(pA0, pA1, m_reg, mnA, alA);
    __syncthreads(); SWAIT(); SWRITE(1, SO);
    RESC(alA); __syncthreads();
  }
  SBAR(); qkt(pB0, pB1, K_lds + SHM_K, qr, r32, hi);
  finishSM(pA0, pA1, alA, l_reg, pa0, pa1, pa2, pa3); SBAR();
  pv_d0(o, vb0, pa0, pa1, pa2, pa3); partialSM(pB0, pB1, m_reg, mnB, alB);
  __syncthreads(); RESC(alB);
  finishSM(pB0, pB1, alB, l_reg, pa0, pa1, pa2, pa3); SBAR();
  pv_d0(o, vb0 + SHM_V, pa0, pa1, pa2, pa3);
  if (hi == 0) li_l[r32] = l_reg; asm volatile("s_waitcnt lgkmcnt(0)" ::: "memory");
  float rli[16];
#pragma unroll
  for (int r = 0; r < 16; ++r) rli[r] = __builtin_amdgcn_rcpf(li_l[crow(r, hi)]);
  bf16_t* Ow = Ob + (long)(wid * QBLK) * 1024;
#pragma unroll
  for (int r = 0; r < 16; ++r) { const int orow = crow(r, hi);
#pragma unroll
    for (int d0 = 0; d0 < 4; ++d0) Ow[(long)orow * 1024 + d0 * 32 + r32] = (bf16_t)(cvtpk(o[d0][r] * rli[r], 0.f) & 0xffffu); }
  __syncthreads();
#undef SLOAD
#undef SWRITE
#undef SWAIT
#undef RESC
}
#undef SBAR
}


typedef GAS unsigned gu32;
#define RLX_AGENT __ATOMIC_RELAXED, __HIP_MEMORY_SCOPE_AGENT
#define XB_TMO      128
#define XB_XCNT(j)  (256  + 64 * (j))
#define XB_XSUB(j)  (1280 + 64 * (j))
#define XB_XGEN(j)  (2304 + 64 * (j))
#define XB_TOP      3328
#define XB_TOPGEN   3392
#define XCD_BAR_WORDS 3456
#define XB_SPIN_CAP (1u << 22)
__device__ __forceinline__ unsigned xb_ld(unsigned* p)              { return __hip_atomic_load(p, __ATOMIC_RELAXED, __HIP_MEMORY_SCOPE_AGENT); }
__device__ __forceinline__ unsigned xb_add(unsigned* p, unsigned v) { return __hip_atomic_fetch_add(p, v, __ATOMIC_RELAXED, __HIP_MEMORY_SCOPE_AGENT); }
__device__ __forceinline__ unsigned xb_xcc_id() { return (unsigned)__builtin_amdgcn_s_getreg((3 << 11) | 20) & 0xFu; }
#define XB_SPIN(cond, bar) do { unsigned _sp = 0; while (cond) { __builtin_amdgcn_s_sleep(1); \
    if ((++_sp & 255u) == 0u) { if (xb_ld(&(bar)[XB_TMO])) break; if (_sp > XB_SPIN_CAP) { atomicAdd(&(bar)[XB_TMO], 1u); break; } } } } while (0)
struct XcdBarrier { unsigned* bar; unsigned x; volatile LAS unsigned* st; };
__device__ __forceinline__ XcdBarrier xcd_barrier_post(unsigned* bar, volatile LAS unsigned* st) {
    XcdBarrier b; b.bar = bar; b.x = xb_xcc_id(); b.st = st;
    if (threadIdx.x == 0) (void)xb_add(&bar[XB_XCNT(b.x)], 1u);
    return b;
}
__device__ __forceinline__ void xcd_barrier_complete(unsigned* bar, unsigned x, unsigned& nloc, unsigned& nx) {
    const unsigned G = gridDim.x * gridDim.y * gridDim.z;
    unsigned sum, cnt, mine, sp = 0u;
    for (;;) {
        sum = 0u; cnt = 0u; mine = 0u;
#pragma unroll
        for (unsigned j = 0; j < 16; ++j) { const unsigned c = xb_ld(&bar[XB_XCNT(j)]); sum += c; cnt += (c > 0u) ? 1u : 0u; mine = (j == x) ? c : mine; }
        if (sum == G) break;
        __builtin_amdgcn_s_sleep(1);
        if ((++sp & 255u) == 0u) { if (xb_ld(&bar[XB_TMO])) break; if (sp > XB_SPIN_CAP) { atomicAdd(&bar[XB_TMO], 1u); break; } }
    }
    nloc = mine > 0u ? mine : 1u; nx = cnt > 0u ? cnt : 1u;
}
__device__ __forceinline__ void xcd_barrier(const XcdBarrier& b) {
    asm volatile("s_waitcnt vmcnt(0)" ::: "memory");
    __syncthreads();
    if (threadIdx.x == 0) {
        unsigned* bar = b.bar;
        __builtin_amdgcn_s_waitcnt(0);
        unsigned nloc = b.st[0], nx = b.st[1];
        if (nloc == 0u) { xcd_barrier_complete(bar, b.x, nloc, nx); b.st[0] = nloc; b.st[1] = nx; }
        const unsigned old = xb_add(&bar[XB_XSUB(b.x)], 1u);
        const unsigned gen = old / nloc;
        if (old + 1u == (gen + 1u) * nloc) {
            __builtin_amdgcn_fence(__ATOMIC_RELEASE, "agent");
            asm volatile("s_waitcnt vmcnt(0)" ::: "memory");
            const unsigned og = xb_add(&bar[XB_TOP], 1u);
            const unsigned tg = og / nx;
            if (og + 1u == (tg + 1u) * nx) xb_add(&bar[XB_TOPGEN], 1u);
            else XB_SPIN(xb_ld(&bar[XB_TOPGEN]) == tg, bar);
            __builtin_amdgcn_fence(__ATOMIC_ACQUIRE, "agent");
            xb_add(&bar[XB_XGEN(b.x)], 1u);
            asm volatile("s_waitcnt vmcnt(0)" ::: "memory");
        } else {
            XB_SPIN(xb_ld(&bar[XB_XGEN(b.x)]) == gen, bar);
            __builtin_amdgcn_fence(__ATOMIC_ACQUIRE, "agent");
            asm volatile("s_waitcnt vmcnt(0)" ::: "memory");
        }
    }
    __syncthreads();
}

struct Frame {
    LAS unsigned char* lds; char* ldsg;
    int tid, lane, wave, vcu, G;
    const Args* a;
};
#define INP(F, i, T) ((const T*)(F).a->in[i])
#define WSP(F, off, T) ((T*)((F).a->ws + (off)))

__device__ __forceinline__ void cvt_load(f32x4 (&v)[16], const float* __restrict__ W, int N, int nvalid, int k0, int n0, int lane) {
    const int kq = lane >> 4, nq = lane & 15;
    const unsigned voff = (unsigned)(kq * N + 4 * nq) * 4u;
#pragma unroll
    for (int i = 0; i < 16; ++i) {
        const char* Wu = (const char*)(W + (size_t)(k0 + 4 * i) * N + n0);
        if (4 * nq < nvalid) v[i] = __builtin_nontemporal_load((const f32x4*)(Wu + (size_t)voff)); else v[i] = (f32x4){0.f, 0.f, 0.f, 0.f};
    }
}
__device__ __forceinline__ void cvt_finish(const f32x4 (&v)[16], int k0, bf16_t* __restrict__ WT, int rowb, LAS unsigned char* scr, int lane) {
    const int kq = lane >> 4, nq = lane & 15;
    const int g = lane >> 4, i16 = lane & 15, q = i16 >> 2, p = i16 & 3;
    typedef short v4i16_t __attribute__((ext_vector_type(4)));
#pragma unroll
    for (int hf = 0; hf < 2; ++hf) {
#pragma unroll
        for (int i = 0; i < 8; ++i) {
            const int k = 4 * i + kq, s = ((k >> 1) & 1) | (((k >> 3) & 1) << 1);
            u32x2 w; w.x = cvtpk(v[8 * hf + i].x, v[8 * hf + i].y); w.y = cvtpk(v[8 * hf + i].z, v[8 * hf + i].w);
            *(LAS u32x2*)(scr + k * 128 + ((nq * 8) ^ (s << 5))) = w;
        }
        const int klo = 8 * g + q, s = ((klo >> 1) & 1) | (((klo >> 3) & 1) << 1);
#pragma unroll
        for (int nb = 0; nb < 4; ++nb) {
            const int a_lo = klo * 128 + (((16 * nb + 4 * p) * 2) ^ (s << 5));
            const s16x4 lo = __builtin_bit_cast(s16x4, __builtin_amdgcn_ds_read_tr16_b64_v4i16((LAS v4i16_t*)(scr + a_lo)));
            const s16x4 hi = __builtin_bit_cast(s16x4, __builtin_amdgcn_ds_read_tr16_b64_v4i16((LAS v4i16_t*)(scr + a_lo + 512)));
            bf16x8 o = {lo[0], lo[1], lo[2], lo[3], hi[0], hi[1], hi[2], hi[3]};
            char* Wu = (char*)(WT + (size_t)(rowb + 16 * nb) * 2048 + k0 + 32 * hf);
            __builtin_nontemporal_store(o, (bf16x8*)(Wu + (size_t)(unsigned)((i16 * 2048 + 8 * g) * 2)));
        }
    }
}
__device__ __forceinline__ void cvt8_load(f32x4 (&v)[16], const float* __restrict__ W, int k0, int n0, int lane) {
    const int kq = lane >> 4, nq = lane & 15;
    const unsigned voff = (unsigned)(16 * kq * 2048 + 4 * nq) * 4u;
#pragma unroll
    for (int i = 0; i < 16; ++i) {
        const char* Wu = (const char*)(W + (size_t)(k0 + i) * 2048 + n0);
        v[i] = __builtin_nontemporal_load((const f32x4*)(Wu + (size_t)voff));
    }
}
__device__ __forceinline__ void cvt8_finish(const f32x4 (&v)[16], int k0, unsigned char* __restrict__ W8, int rowb, int lane) {
    const int kq = lane >> 4, nq = lane & 15;
    char* Wu = (char*)(W8 + (size_t)rowb * 2048 + k0);
    const unsigned voff = (unsigned)(4 * nq * 2048 + 16 * kq);
#pragma unroll
    for (int j = 0; j < 4; ++j) {
        u32x4 o;
#pragma unroll
        for (int q = 0; q < 4; ++q) {
            int w = __builtin_amdgcn_cvt_pk_fp8_f32(v[4 * q][j] * pg8::W8_SCALE, v[4 * q + 1][j] * pg8::W8_SCALE, 0, false);
            w = __builtin_amdgcn_cvt_pk_fp8_f32(v[4 * q + 2][j] * pg8::W8_SCALE, v[4 * q + 3][j] * pg8::W8_SCALE, w, true);
            o[q] = (unsigned)w;
        }
        __builtin_nontemporal_store(o, (u32x4*)(Wu + (size_t)(voff + (unsigned)(j * 2048))));
    }
}
__device__ __forceinline__ void cvt_expert_decode(const Frame& F, int r, const float*& W, int& k0, int& n0, unsigned char*& WT, int& rowb) {
    constexpr int I_E = 16 * 32 * 32;
    const int mat = r / I_E; r -= mat * I_E;
    const int e = r >> 10, kt = (r >> 5) & 31, nt = r & 31;
    k0 = kt * 64; n0 = nt * 64;
    if (mat < 2) { W = INP(F, 24 + mat, float) + (size_t)e * 2048 * 2048; WT = WSP(F, WS_WGU, unsigned char); rowb = e * 4096 + (n0 >> 7) * 256 + mat * 128 + (n0 & 127); }
    else { W = INP(F, 26, float) + (size_t)e * 2048 * 2048; WT = WSP(F, WS_WD, unsigned char); rowb = e * 2048 + n0; }
}
constexpr int N_EXPERT_ITEMS = 3 * 16 * 32 * 32;
__device__ __forceinline__ void p0_prologue(Frame& F) {
    LAS unsigned char* scr = F.lds + F.wave * 4096;
    const int gw = F.vcu * 8 + F.wave, NGW = F.G * 8, lane = F.lane;
    const float* w_in = INP(F, 3, float); const float* w_out = INP(F, 21, float);
    bf16_t* WinT = WSP(F, WS_WIN, bf16_t); bf16_t* WoutT = WSP(F, WS_WOUT, bf16_t);
    constexpr int I_IN = 32 * 101, I_OUT = 32 * 32, NITEMS = I_IN + I_OUT;
    for (int it = gw; it < NITEMS; it += NGW) {
        f32x4 v[16];
        if (it < I_IN) { const int kt = it / 101, nt = it % 101; const int nv = (nt == 100) ? 32 : 64; cvt_load(v, w_in, IN_COLS, nv, kt * 64, nt * 64, lane); cvt_finish(v, kt * 64, WinT, nt * 64, scr, lane); }
        else { const int r = it - I_IN, kt = r >> 5, nt = r & 31; cvt_load(v, w_out, 2048, 64, kt * 64, nt * 64, lane); cvt_finish(v, kt * 64, WoutT, nt * 64, scr, lane); }
    }
#if !CVT_IN_SCAN
    for (int it = gw; it < N_EXPERT_ITEMS; it += NGW) {
        f32x4 v[16]; const float* W; int k0, n0, rowb; unsigned char* WT;
        cvt_expert_decode(F, it, W, k0, n0, WT, rowb); cvt8_load(v, W, k0, n0, lane); cvt8_finish(v, k0, WT, rowb, lane);
    }
#endif
    { u32x4 z = {0u, 0u, 0u, 0u}; u32x4* zp = (u32x4*)(WinT + (size_t)6464 * 2048); const int nz = 192 * 2048 * 2 / 16;
      for (int i = gw * 64 + lane; i < nz; i += NGW * 64) zp[i] = z; }
    { const float* x = INP(F, 0, float); const float* nw = INP(F, 2, float); bf16_t* H1 = WSP(F, WS_H1, bf16_t);
      for (int m = gw; m < MTOK; m += NGW) {
          const f32x4* xr = (const f32x4*)(x + (size_t)m * DM) + lane; f32x4 v[8]; float s = 0.f;
#pragma unroll
          for (int j = 0; j < 8; ++j) { v[j] = xr[64 * j]; s += (v[j].x * v[j].x + v[j].y * v[j].y) + (v[j].z * v[j].z + v[j].w * v[j].w); }
          const float rstd = 1.f / sqrtf(wave_sum(s) * (1.f / DM) + 1e-6f);
          u32x2* o8 = (u32x2*)(H1 + (size_t)m * DM) + lane;
#pragma unroll
          for (int j = 0; j < 8; ++j) { const f32x4 w = ((const f32x4*)nw)[lane + 64 * j]; u32x2 o; o.x = cvtpk(v[j].x * rstd * w.x, v[j].y * rstd * w.y); o.y = cvtpk(v[j].z * rstd * w.z, v[j].w * rstd * w.w); o8[64 * j] = o; }
      } }
    { const float* dup = INP(F, 12, float); const float* iup = INP(F, 14, float); const float* gup = INP(F, 15, float);
      bf16_t* DUt = WSP(F, WS_LORA, bf16_t); bf16_t* IUt = DUt + 2 * 1024 * 64; bf16_t* GUt = IUt + 2 * 1024 * 64;
      for (int i = gw * 64 + lane; i < 2 * 1024 * 64; i += NGW * 64) { const int j = i & 63, c = (i >> 6) & 1023, d = i >> 16;
          DUt[i] = (bf16_t)(cvtpk(dup[(size_t)(d * 64 + j) * 1024 + c], 0.f) & 0xffffu); IUt[i] = (bf16_t)(cvtpk(iup[(size_t)(d * 64 + j) * 1024 + c], 0.f) & 0xffffu); }
      for (int i = gw * 64 + lane; i < 1024 * 160; i += NGW * 64) { const int c = i / 160, j = i - c * 160; GUt[i] = (bf16_t)(cvtpk(gup[(size_t)j * 1024 + c], 0.f) & 0xffffu); } }
    { const int* pos = INP(F, 1, int); float* rope = WSP(F, WS_ROPE, float);
      const float invf[8] = {1.0f, 0.19392274474868576f, 0.03760603093086393f, 0.007292664737217109f, 0.001414213562373095f, 0.0002742481756762073f, 5.318295896944988e-05f, 1.031338537721246e-05f};
      for (int i = gw * 64 + lane; i < MTOK * 8; i += NGW * 64) { const int m = i >> 3, j = i & 7; float fj = invf[0];
#pragma unroll
          for (int q = 1; q < 8; ++q) fj = (j == q) ? invf[q] : fj;
          const float ang = (float)pos[m] * fj; rope[m * 16 + j] = cosf(ang); rope[m * 16 + 8 + j] = sinf(ang); } }
}

#define WS32(F, T, byteoff) (*(T*)((F).a->ws + (size_t)(unsigned)(byteoff)))
template <int CTRL> __device__ __forceinline__ float dpp_add(float x) {
    return x + __int_as_float(__builtin_amdgcn_update_dpp(0, __float_as_int(x), CTRL, 0xf, 0xf, false));
}
__device__ __forceinline__ float row16_allsum(float x) { x = dpp_add<0x128>(x); x = dpp_add<0x124>(x); x = dpp_add<0x122>(x); x = dpp_add<0x121>(x); return x; }
__device__ __forceinline__ bf16_t f2bf(float x) { return (bf16_t)(cvtpk(x, 0.f) & 0xffffu); }
__device__ __forceinline__ u32x4 ld_row16(const Frame& F, unsigned off, bool ok) { u32x4 r = {0u, 0u, 0u, 0u}; if (ok) r = WS32(F, const u32x4, off); return r; }
__device__ __forceinline__ void unpack8(const u32x4 w, float (&o)[8]) { o[0] = bf_lo(w.x); o[1] = bf_hi(w.x); o[2] = bf_lo(w.y); o[3] = bf_hi(w.y); o[4] = bf_lo(w.z); o[5] = bf_hi(w.z); o[6] = bf_lo(w.w); o[7] = bf_hi(w.w); }
__device__ __forceinline__ void ld8f(const float* p, float (&o)[8]) { const f32x4 a = ((const f32x4*)p)[0], b = ((const f32x4*)p)[1]; o[0] = a.x; o[1] = a.y; o[2] = a.z; o[3] = a.w; o[4] = b.x; o[5] = b.y; o[6] = b.z; o[7] = b.w; }
__device__ __forceinline__ u32x4 pack8(const float (&v)[8]) { return (u32x4){cvtpk(v[0], v[1]), cvtpk(v[2], v[3]), cvtpk(v[4], v[5]), cvtpk(v[6], v[7])}; }
__device__ __forceinline__ void p3_prep(Frame& F, const int mode = 0) {
    constexpr int AP = 296;
    constexpr int PP = 264, PA = 16 * PP, PT = 5 * PA;
    LAS bf16_t* Al = (LAS bf16_t*)F.lds;
    LAS bf16_t* Pl = (LAS bf16_t*)(F.lds + 18944);
    LAS float* Zr = (LAS float*)(F.lds + 18944);
    LAS float* Zl = (LAS float*)(F.lds + 18944 + 20736);
    const int tid = F.tid, lane = F.lane, w = F.wave;
    const bf16_t* DUt = WSP(F, WS_LORA, bf16_t); const bf16_t* IUt = DUt + 2 * 1024 * 64; const bf16_t* GUt = IUt + 2 * 1024 * 64;
    for (int item = F.vcu; item < MTOK / 32; item += F.G) {
        __syncthreads();
#pragma unroll 1
        for (int tl = 0; tl < 2; ++tl) {
            const int m0 = item * 32 + tl * 16, t0 = m0 & (SEQ - 1);
            for (int p = tid; p < 18 * 36; p += 512) {
                const int rr = p / 36, ch = p - rr * 36, t = t0 + rr - 1, m = m0 + rr - 1;
                f32x4 a0 = {0.f, 0.f, 0.f, 0.f}, a1 = a0;
                if (t >= 0 && t < SEQ) {
                    const bf16_t* pp = WSP(F, WS_PART, bf16_t) + (((size_t)((ch >> 5) * 32 + (m >> 8)) * 4) << 16) + (size_t)(m & 255) * 256 + ((8 * ch) & 255);
                    u32x4 q[4];
#pragma unroll
                    for (int k = 0; k < 4; ++k) q[k] = *(const u32x4*)(pp + ((size_t)k << 16));
#pragma unroll
                    for (int k = 0; k < 4; ++k) { a0 += (f32x4){bf_lo(q[k].x), bf_hi(q[k].x), bf_lo(q[k].y), bf_hi(q[k].y)}; a1 += (f32x4){bf_lo(q[k].z), bf_hi(q[k].z), bf_lo(q[k].w), bf_hi(q[k].w)}; }
                }
                LAS f32x4* zp = (LAS f32x4*)(Zr + rr * 288 + 8 * ch); zp[0] = a0; zp[1] = a1;
            }
            __syncthreads();
            for (int p = tid; p < 16 * 36; p += 512) {
                const int i = p / 36, ch = p - i * 36, zc = 3072 + 8 * ch;
                float c[8], pv[8], nx[8], mp[8], mn[8];
                { const LAS f32x4* q = (const LAS f32x4*)(Zr + i * 288 + 8 * ch); const f32x4 x0 = q[0], x1 = q[1], y0 = q[72], y1 = q[73], w0 = q[144], w1 = q[145];
                  pv[0] = x0.x; pv[1] = x0.y; pv[2] = x0.z; pv[3] = x0.w; pv[4] = x1.x; pv[5] = x1.y; pv[6] = x1.z; pv[7] = x1.w;
                  c[0] = y0.x; c[1] = y0.y; c[2] = y0.z; c[3] = y0.w; c[4] = y1.x; c[5] = y1.y; c[6] = y1.z; c[7] = y1.w;
                  nx[0] = w0.x; nx[1] = w0.y; nx[2] = w0.z; nx[3] = w0.w; nx[4] = w1.x; nx[5] = w1.y; nx[6] = w1.z; nx[7] = w1.w; }
                ld8f(INP(F, 4, float) + zc, mp); ld8f(INP(F, 5, float) + zc, mn);
                LAS f32x4* zp = (LAS f32x4*)(Zl + i * 288 + 8 * ch); float z[8];
#pragma unroll
                for (int e = 0; e < 8; ++e) z[e] = c[e] + mp[e] * (pv[e] - c[e]) + mn[e] * (nx[e] - c[e]);
                zp[0] = (f32x4){z[0], z[1], z[2], z[3]}; zp[1] = (f32x4){z[4], z[5], z[6], z[7]};
            }
            __syncthreads();
            for (int e = tid; e < 16 * 288; e += 512) { const int i = e / 288, j = e - i * 288; float z = Zl[e];
                if (j < 64) z = 1.f - 2.f * __builtin_amdgcn_rcpf(__expf(2.f * z) + 1.f); else if (j >= 128) z = __builtin_amdgcn_rcpf(1.f + __expf(-z));
                Al[tl * 16 * AP + i * AP + j] = f2bf(z); }
        }
        __syncthreads();
        if (mode == 1) continue;
        const int chk = tid & 31, pidx = tid >> 5, tb = pidx >> 3, tp = pidx & 7;
        const int m0t = item * 32 + tb * 16, t0t = m0t & (SEQ - 1);
#pragma unroll 1
        for (int qi = 0; qi < 4; ++qi) {
            const int q = (qi + (F.vcu >> 2)) & 3;
            u32x4 rawr[4], rawk[4], rawv[4];
            { const unsigned off = (unsigned)WS_PROJ + ((unsigned)(m0t + 2 * tp) * LDP + ZC0 + 256 * q + 8 * chk) * 2u;
#pragma unroll
              for (int rr = 0; rr < 4; ++rr) { const int t = t0t + 2 * tp + rr - 1; const bool ok = (t >= 0) && (t < SEQ); const unsigned o = off + (unsigned)((rr - 1) * LDP * 2);
                  rawr[rr] = ld_row16(F, o, ok); rawk[rr] = ld_row16(F, o + 1024u * 2u, ok); rawv[rr] = ld_row16(F, o + 2048u * 2u, ok); } }
            {
                const int n16 = lane & 15, q4 = lane >> 4;
                struct BF { bf16x8 d0[2], d1[2], i0[2], i1[2], g[5]; };
#define LD_BF(X, nb_) do { const int cl_ = 256 * q + 32 * w + 16 * (nb_) + n16; _Pragma("unroll") for (int ks = 0; ks < 2; ++ks) { \
                    X.d0[ks] = *(const bf16x8*)(DUt + (size_t)cl_ * 64 + 32 * ks + 8 * q4); X.d1[ks] = *(const bf16x8*)(DUt + (size_t)(1024 + cl_) * 64 + 32 * ks + 8 * q4); \
                    X.i0[ks] = *(const bf16x8*)(IUt + (size_t)cl_ * 64 + 32 * ks + 8 * q4); X.i1[ks] = *(const bf16x8*)(IUt + (size_t)(1024 + cl_) * 64 + 32 * ks + 8 * q4); } \
                    _Pragma("unroll") for (int ks = 0; ks < 5; ++ks) X.g[ks] = *(const bf16x8*)(GUt + (size_t)cl_ * 160 + 32 * ks + 8 * q4); } while (0)
#define DO_NB(X, nb_, tl_) do { const int ch_ = 32 * w + 16 * (nb_); \
                    f32x4 aw0 = {0.f, 0.f, 0.f, 0.f}, aw1 = aw0, aa0 = aw0, aa1 = aw0, ag = aw0; \
                    _Pragma("unroll") for (int ks = 0; ks < 2; ++ks) { \
                        aw0 = __builtin_amdgcn_mfma_f32_16x16x32_bf16(X.d0[ks], af[ks], aw0, 0, 0, 0); aw1 = __builtin_amdgcn_mfma_f32_16x16x32_bf16(X.d1[ks], af[ks], aw1, 0, 0, 0); \
                        aa0 = __builtin_amdgcn_mfma_f32_16x16x32_bf16(X.i0[ks], af[2 + ks], aa0, 0, 0, 0); aa1 = __builtin_amdgcn_mfma_f32_16x16x32_bf16(X.i1[ks], af[2 + ks], aa1, 0, 0, 0); } \
                    _Pragma("unroll") for (int ks = 0; ks < 5; ++ks) ag = __builtin_amdgcn_mfma_f32_16x16x32_bf16(X.g[ks], af[4 + ks], ag, 0, 0, 0); \
                    LAS bf16_t* pp = Pl + (tl_) * PT + n16 * PP + ch_ + 4 * q4; \
                    *(LAS u32x2*)(pp) = (u32x2){cvtpk(aw0[0], aw0[1]), cvtpk(aw0[2], aw0[3])}; *(LAS u32x2*)(pp + PA) = (u32x2){cvtpk(aw1[0], aw1[1]), cvtpk(aw1[2], aw1[3])}; \
                    *(LAS u32x2*)(pp + 2 * PA) = (u32x2){cvtpk(aa0[0], aa0[1]), cvtpk(aa0[2], aa0[3])}; *(LAS u32x2*)(pp + 3 * PA) = (u32x2){cvtpk(aa1[0], aa1[1]), cvtpk(aa1[2], aa1[3])}; \
                    *(LAS u32x2*)(pp + 4 * PA) = (u32x2){cvtpk(ag[0], ag[1]), cvtpk(ag[2], ag[3])}; } while (0)
                BF fa, fb; LD_BF(fa, 0); LD_BF(fb, 1);
#pragma unroll
                for (int tl = 0; tl < 2; ++tl) {
                    bf16x8 af[9];
#pragma unroll
                    for (int ks = 0; ks < 9; ++ks) af[ks] = *(const LAS bf16x8*)(Al + tl * 16 * AP + n16 * AP + 32 * ks + 8 * q4);
                    DO_NB(fa, 0, tl); DO_NB(fb, 1, tl);
                }
#undef LD_BF
#undef DO_NB
            }
            __syncthreads();
            if (mode != 2) {
                const int c = 256 * q + 8 * chk;
                float r4[4][8], k4[4][8], v4[4][8];
#pragma unroll
                for (int rr = 0; rr < 4; ++rr) { unpack8(rawr[rr], r4[rr]); unpack8(rawk[rr], k4[rr]); unpack8(rawv[rr], v4[rr]); }
                float zr[2][8], zk[2][8], zv[2][8];
                { float mp[8], mn[8];
                  ld8f(INP(F, 4, float) + c, mp); ld8f(INP(F, 5, float) + c, mn);
#pragma unroll
                  for (int tk = 0; tk < 2; ++tk)
#pragma unroll
                      for (int e = 0; e < 8; ++e) zr[tk][e] = r4[tk + 1][e] + mp[e] * (r4[tk][e] - r4[tk + 1][e]) + mn[e] * (r4[tk + 2][e] - r4[tk + 1][e]);
                  ld8f(INP(F, 4, float) + 1024 + c, mp); ld8f(INP(F, 5, float) + 1024 + c, mn);
#pragma unroll
                  for (int tk = 0; tk < 2; ++tk)
#pragma unroll
                      for (int e = 0; e < 8; ++e) zk[tk][e] = k4[tk + 1][e] + mp[e] * (k4[tk][e] - k4[tk + 1][e]) + mn[e] * (k4[tk + 2][e] - k4[tk + 1][e]);
                  ld8f(INP(F, 4, float) + 2048 + c, mp); ld8f(INP(F, 5, float) + 2048 + c, mn);
#pragma unroll
                  for (int tk = 0; tk < 2; ++tk)
#pragma unroll
                      for (int e = 0; e < 8; ++e) zv[tk][e] = v4[tk + 1][e] + mp[e] * (v4[tk][e] - v4[tk + 1][e]) + mn[e] * (v4[tk + 2][e] - v4[tk + 1][e]); }
                float kkw[8], w00[8], w01[8], a00[8], a01[8], kac[8], rkc[8];
                ld8f(INP(F, 16, float) + c, kkw); ld8f(INP(F, 11, float) + c, w00); ld8f(INP(F, 11, float) + 1024 + c, w01);
                ld8f(INP(F, 13, float) + c, a00); ld8f(INP(F, 13, float) + 1024 + c, a01); ld8f(INP(F, 17, float) + c, kac); ld8f(INP(F, 18, float) + c, rkc);
#pragma unroll 1
                for (int tk = 0; tk < 2; ++tk) {
                    const int tkn = 2 * tp + tk; const unsigned o = (unsigned)(m0t + tkn) * 1024u + (unsigned)c;
                    const LAS bf16_t* pp = Pl + tb * PT + tkn * PP + 8 * chk;
                    float zrt[8], zkt[8], zvt[8];
#pragma unroll
                    for (int e = 0; e < 8; ++e) { zrt[e] = tk ? zr[1][e] : zr[0][e]; zkt[e] = tk ? zk[1][e] : zk[0][e]; zvt[e] = tk ? zv[1][e] : zv[0][e]; }
                    WS32(F, u32x4, (unsigned)WS_R + o * 2u) = pack8(zrt); WS32(F, u32x4, (unsigned)WS_V + o * 2u) = pack8(zvt);
                    float kk[8];
                    { float ss = 0.f;
#pragma unroll
                      for (int e = 0; e < 8; ++e) { kk[e] = zkt[e] * kkw[e]; ss += kk[e] * kk[e]; }
                      ss += __shfl_xor(ss, 1); ss += __shfl_xor(ss, 2); ss += __shfl_xor(ss, 4);
                      const float inv = 1.f / fmaxf(sqrtf(ss), 1e-12f);
#pragma unroll
                      for (int e = 0; e < 8; ++e) kk[e] *= inv;
                      WS32(F, u32x4, (unsigned)WS_KK + o * 2u) = pack8(kk); }
                    {
                        float pw0[8], pw1[8], d0[8], d1[8];
                        unpack8(*(const LAS u32x4*)(pp), pw0); unpack8(*(const LAS u32x4*)(pp + PA), pw1);
#pragma unroll
                        for (int e = 0; e < 8; ++e) {
                            d0[e] = 0.6065306597126334f * __builtin_amdgcn_rcpf(1.f + __expf(-(w00[e] + pw0[e]))); d1[e] = 0.6065306597126334f * __builtin_amdgcn_rcpf(1.f + __expf(-(w01[e] + pw1[e]))); }
                        WS32(F, u32x4, (unsigned)WS_WDEC + o * 2u) = pack8(d0); WS32(F, u32x4, (unsigned)WS_WDEC + ((unsigned)(MTOK * 1024) + o) * 2u) = pack8(d1);
                    }
                    {
                        float pa0[8], pa1[8], kd0[8], kd1[8], b0v[8], b1v[8]; float bs = 0.f;
                        unpack8(*(const LAS u32x4*)(pp + 2 * PA), pa0); unpack8(*(const LAS u32x4*)(pp + 3 * PA), pa1);
#pragma unroll
                        for (int e = 0; e < 8; ++e) {
                            const float av0 = __builtin_amdgcn_rcpf(1.f + __expf(-(a00[e] + pa0[e]))), av1 = __builtin_amdgcn_rcpf(1.f + __expf(-(a01[e] + pa1[e])));
                            kd0[e] = zkt[e] * (1.f + (av0 - 1.f) * kac[e]); kd1[e] = zkt[e] * (1.f + (av1 - 1.f) * kac[e]);
                            b0v[e] = kk[e] * av0; b1v[e] = kk[e] * av1;
                            bs += zrt[e] * (kd0[e] + kd1[e]) * rkc[e]; }
                        bs += __shfl_xor(bs, 1); bs += __shfl_xor(bs, 2); bs += __shfl_xor(bs, 4);
                        if ((chk & 7) == 0) WS32(F, float, (unsigned)WS_BONUS + ((unsigned)(m0t + tkn) * 16u + (unsigned)(4 * q + (chk >> 3))) * 4u) = bs;
                        WS32(F, u32x4, (unsigned)WS_KD + o * 2u) = pack8(kd0); WS32(F, u32x4, (unsigned)WS_KD + ((unsigned)(MTOK * 1024) + o) * 2u) = pack8(kd1);
                        WS32(F, u32x4, (unsigned)WS_BB + o * 2u) = pack8(b0v); WS32(F, u32x4, (unsigned)WS_BB + ((unsigned)(MTOK * 1024) + o) * 2u) = pack8(b1v);
                    }
                    WS32(F, u32x4, (unsigned)WS_G + o * 2u) = *(const LAS u32x4*)(pp + 4 * PA);
                }
            }
            __syncthreads();
        }
    }
}

struct P5aConst { float lam; };
__device__ __forceinline__ void p5a_init(const Frame& F, P5aConst& K) {
    const int lane = F.lane;
    const float q1 = INP(F, 6, float)[lane] * INP(F, 7, float)[lane], q2 = INP(F, 8, float)[lane] * INP(F, 9, float)[lane];
    K.lam = __expf(wave_sum(q1)) - __expf(wave_sum(q2)) + 0.2f;
}
__device__ __forceinline__ void p5a_token(const Frame& F, const P5aConst& K, int m) {
    const bf16_t* OC = WSP(F, WS_OC, bf16_t); bf16_t* MIX = WSP(F, WS_MIX, bf16_t); const float* subw = INP(F, 10, float);
    const int c0 = F.lane * 16; const float lam = K.lam;
    const u32x4* p0 = (const u32x4*)(OC + (size_t)m * 1024 + c0); const u32x4* p1 = (const u32x4*)(OC + (size_t)MTOK * 1024 + (size_t)m * 1024 + c0);
    const u32x4 a0 = p0[0], a1 = p0[1], b0 = p1[0], b1 = p1[1];
    float dv[16]; const unsigned aw[8] = {a0.x, a0.y, a0.z, a0.w, a1.x, a1.y, a1.z, a1.w}, bw[8] = {b0.x, b0.y, b0.z, b0.w, b1.x, b1.y, b1.z, b1.w};
    float ssq = 0.f;
#pragma unroll
    for (int i = 0; i < 8; ++i) { dv[2 * i] = bf_lo(aw[i]) - lam * bf_lo(bw[i]); dv[2 * i + 1] = bf_hi(aw[i]) - lam * bf_hi(bw[i]); ssq += dv[2 * i] * dv[2 * i] + dv[2 * i + 1] * dv[2 * i + 1]; }
    ssq += __shfl_xor(ssq, 1); ssq += __shfl_xor(ssq, 2); ssq += __shfl_xor(ssq, 4);
    const float rstd = 1.f / sqrtf(ssq * (1.f / 128.f) + 1e-5f);
    unsigned ow[8];
#pragma unroll
    for (int i = 0; i < 8; ++i) { const float s0 = subw[(c0 + 2 * i) & 127] * 0.8f, s1 = subw[(c0 + 2 * i + 1) & 127] * 0.8f; ow[i] = cvtpk(dv[2 * i] * rstd * s0, dv[2 * i + 1] * rstd * s1); }
    u32x4* op = (u32x4*)(MIX + (size_t)m * 2048 + c0); op[0] = (u32x4){ow[0], ow[1], ow[2], ow[3]}; op[1] = (u32x4){ow[4], ow[5], ow[6], ow[7]};
}

__device__ __forceinline__ void p4_scan(Frame& F, const int mode = 0) {
    constexpr int CH = 32, NCH = SEQ / CH;
    constexpr int VEC = CH * 64 * 4;
    constexpr int BUF = 5 * VEC + CH * 32 * 4;
    constexpr int YOFF = 2 * BUF, YB = CH * 32 * 4;
    constexpr int CVT_SCR = 2 * BUF + 2 * YB;
    const bf16_t* Wdec = WSP(F, WS_WDEC, bf16_t); const bf16_t* KDg = WSP(F, WS_KD, bf16_t); const bf16_t* BBg = WSP(F, WS_BB, bf16_t);
    const bf16_t* Rg = WSP(F, WS_R, bf16_t); const bf16_t* KKg = WSP(F, WS_KK, bf16_t); const bf16_t* Vg = WSP(F, WS_V, bf16_t); bf16_t* YS = WSP(F, WS_YS, bf16_t);
    const int tid = F.tid, lane = F.lane, wid = F.wave;
    const bool is_comp = wid < 4;
    const int ri = wid & 3;
    if (is_comp) __builtin_amdgcn_s_setprio(3);
    const int g = lane >> 3, j = lane & 7, rowl = ri * 8 + g;
    const int mt = ri * 64 + lane, mw = ri;
    int cvt_it = F.vcu * 4 + mw; f32x4 cvv[16]; int ck0 = 0, crowb = 0; unsigned char* cWT = nullptr;
    f32x4 cvvB[16]; int ck0B = 0, crowbB = 0; unsigned char* cWTB = nullptr;
    LAS unsigned* st_cnt = (LAS unsigned*)(F.lds + CVT_SCR + 4 * 4096); LAS unsigned* cons_cnt = st_cnt + 16;
    for (int item = F.vcu; item < 256; item += F.G) {
        const int chain = item >> 1, half = item & 1, d = chain >> 6, b = (chain >> 4) & 3, h = chain & 15;
        const size_t sh = (size_t)b * SEQ * 1024 + h * 64, pd = (size_t)d * MTOK * 1024 + sh;
        f32x2 S2[4] = {{0.f, 0.f}, {0.f, 0.f}, {0.f, 0.f}, {0.f, 0.f}};
        u32x2 rw[2], rkk[2], rbb[2], rkd[2], rr[2]; unsigned rv[2];
        const int cstep = d ? -CH * 1024 : CH * 1024;
        unsigned po[2], pv[2];
#pragma unroll
        for (int q_ = 0; q_ < 2; ++q_) { const int sl_ = mt + 256 * q_, ss_ = sl_ >> 4, sk_ = (sl_ & 15) * 4, tq_ = d ? (SEQ - 1 - ss_) : ss_; po[q_] = (unsigned)(tq_ * 1024 + sk_); pv[q_] = (unsigned)(tq_ * 1024 + half * 32 + 2 * (sl_ & 15)); }
        const char* bW = (const char*)(Wdec + pd); const char* bKK = (const char*)(KKg + sh); const char* bBB = (const char*)(BBg + pd); const char* bKD = (const char*)(KDg + pd); const char* bR = (const char*)(Rg + sh); const char* bV = (const char*)(Vg + sh);
#define SC_LOAD(c) do { const unsigned cu_ = (unsigned)((c) * cstep); _Pragma("unroll") for (int q_ = 0; q_ < 2; ++q_) { const unsigned e_ = po[q_] + cu_; \
        rw[q_] = *(const u32x2*)(bW + (size_t)(e_ * 2u)); rkk[q_] = *(const u32x2*)(bKK + (size_t)(e_ * 2u)); rbb[q_] = *(const u32x2*)(bBB + (size_t)(e_ * 2u)); rkd[q_] = *(const u32x2*)(bKD + (size_t)(e_ * 2u)); rr[q_] = *(const u32x2*)(bR + (size_t)(e_ * 2u)); \
        rv[q_] = *(const unsigned*)(bV + (size_t)((pv[q_] + cu_) * 2u)); } } while (0)
#define SC_STORE(bufi) do { LAS unsigned char* bp_ = F.lds + (bufi) * BUF; _Pragma("unroll") for (int q_ = 0; q_ < 2; ++q_) { const int sl_ = mt + 256 * q_, ss_ = sl_ >> 4, sk_ = (sl_ & 15) * 4; const int o_ = (ss_ * 64 + sk_) * 4; \
        *(LAS f32x4*)(bp_ + o_) = (f32x4){__expf(-bf_lo(rw[q_].x)), __expf(-bf_hi(rw[q_].x)), __expf(-bf_lo(rw[q_].y)), __expf(-bf_hi(rw[q_].y))}; \
        *(LAS f32x4*)(bp_ + VEC + o_) = (f32x4){bf_lo(rkk[q_].x), bf_hi(rkk[q_].x), bf_lo(rkk[q_].y), bf_hi(rkk[q_].y)}; \
        *(LAS f32x4*)(bp_ + 2 * VEC + o_) = (f32x4){bf_lo(rbb[q_].x), bf_hi(rbb[q_].x), bf_lo(rbb[q_].y), bf_hi(rbb[q_].y)}; \
        *(LAS f32x4*)(bp_ + 3 * VEC + o_) = (f32x4){bf_lo(rkd[q_].x), bf_hi(rkd[q_].x), bf_lo(rkd[q_].y), bf_hi(rkd[q_].y)}; \
        *(LAS f32x4*)(bp_ + 4 * VEC + o_) = (f32x4){bf_lo(rr[q_].x), bf_hi(rr[q_].x), bf_lo(rr[q_].y), bf_hi(rr[q_].y)}; \
        *(LAS f32x2*)(bp_ + 5 * VEC + (ss_ * 32 + 2 * (sl_ & 15)) * 4) = (f32x2){bf_lo(rv[q_]), bf_hi(rv[q_])}; } } while (0)
#define Y_OUT(c) do { const int ys_ = mt >> 3, yr_ = (mt & 7) * 4; const int tt_ = (c) * CH + ys_, t_ = d ? (SEQ - 1 - tt_) : tt_; \
        const f32x4 yv_ = *(const LAS f32x4*)(F.lds + YOFF + ((c) & 1) * YB + (ys_ * 32 + yr_) * 4); \
        *(u32x2*)(YS + pd + (size_t)t_ * 1024 + half * 32 + yr_) = (u32x2){cvtpk(yv_.x, yv_.y), cvtpk(yv_.z, yv_.w)}; } while (0)
#define SC_WAIT(cnt_, tgt_) do { for (;;) { const u32x4 q_ = *(volatile LAS u32x4*)(cnt_); const unsigned a_ = q_.x < q_.y ? q_.x : q_.y, b_ = q_.z < q_.w ? q_.z : q_.w; \
        if ((a_ < b_ ? a_ : b_) >= (tgt_)) break; if (is_comp) __builtin_amdgcn_s_sleep(1); else __builtin_amdgcn_s_sleep(12); } asm volatile("" ::: "memory"); } while (0)
#define SC_SIGNAL(cnt_, val_) do { asm volatile("s_waitcnt lgkmcnt(0)" ::: "memory"); if (lane == 0) *(volatile LAS unsigned*)((cnt_) + ri) = (val_); } while (0)
        __syncthreads();
        if (tid < 4) { st_cnt[tid] = 0u; cons_cnt[tid] = 0u; }
        if (!is_comp) { SC_LOAD(0); SC_STORE(0); SC_LOAD(1); }
        __syncthreads();
        if (is_comp) {
          for (int c = 0; c < NCH; ++c) {
            SC_WAIT(st_cnt, (unsigned)c);
            if (mode != 2) {
                const LAS unsigned char* bp = F.lds + (c & 1) * BUF;
                LAS float* yb = (LAS float*)(F.lds + YOFF + (c & 1) * YB);
                f32x4 cw_[2], ckk[2], cbb[2], ckd[2], cr[2]; float cv;
#define SC_RD(s_) do { const int o_ = ((s_) * 64 + j * 8) * 4; cw_[0] = *(const LAS f32x4*)(bp + o_); cw_[1] = *(const LAS f32x4*)(bp + o_ + 16); ckk[0] = *(const LAS f32x4*)(bp + VEC + o_); ckk[1] = *(const LAS f32x4*)(bp + VEC + o_ + 16); \
                cbb[0] = *(const LAS f32x4*)(bp + 2 * VEC + o_); cbb[1] = *(const LAS f32x4*)(bp + 2 * VEC + o_ + 16); ckd[0] = *(const LAS f32x4*)(bp + 3 * VEC + o_); ckd[1] = *(const LAS f32x4*)(bp + 3 * VEC + o_ + 16); \
                cr[0] = *(const LAS f32x4*)(bp + 4 * VEC + o_); cr[1] = *(const LAS f32x4*)(bp + 4 * VEC + o_ + 16); cv = *(const LAS float*)(bp + 5 * VEC + ((s_) * 32 + rowl) * 4); } while (0)
#define H2(v_, i_) ((f32x2){v_[(i_) >> 1][((i_) & 1) * 2], v_[(i_) >> 1][((i_) & 1) * 2 + 1]})
                SC_RD(0);
                float yk = 0.f;
#pragma unroll
                for (int s = 0; s < CH; ++s) {
                    f32x4 w[2] = {cw_[0], cw_[1]}, kk[2] = {ckk[0], ckk[1]}, bb[2] = {cbb[0], cbb[1]}, kd[2] = {ckd[0], ckd[1]}, r[2] = {cr[0], cr[1]}; const float v = cv;
                    if (s + 1 < CH) SC_RD(s + 1);
                    f32x2 pa = S2[0] * H2(kk, 0), pb = S2[1] * H2(kk, 1); pa = S2[2] * H2(kk, 2) + pa; pb = S2[3] * H2(kk, 3) + pb; pa = pa + pb;
                    const f32x2 vv = {v, v};
                    f32x2 u[4];
#pragma unroll
                    for (int i = 0; i < 4; ++i) u[i] = S2[i] * H2(w, i) + vv * H2(kd, i);
                    float p = pa.x + pa.y;
                    p = dpp_add<0xB1>(p); p = dpp_add<0x4E>(p); p = dpp_add<0x141>(p);
                    const f32x2 sa = {-p, -p};
#pragma unroll
                    for (int i = 0; i < 4; ++i) S2[i] = sa * H2(bb, i) + u[i];
                    f32x2 ya = S2[0] * H2(r, 0), yc = S2[1] * H2(r, 1); ya = S2[2] * H2(r, 2) + ya; yc = S2[3] * H2(r, 3) + yc; ya = ya + yc;
                    float y = ya.x + ya.y;
                    y = dpp_add<0xB1>(y); y = dpp_add<0x4E>(y); y = dpp_add<0x141>(y);
                    yk = (j == (s & 7)) ? y : yk;
                    if ((s & 7) == 7) yb[((s & 24) + j) * 32 + rowl] = yk;
                }
#undef SC_RD
#undef H2
            }
            SC_SIGNAL(cons_cnt, (unsigned)(c + 1));
          }
        } else {
#define MEM_DUTIES(c_) do { SC_WAIT(cons_cnt, (unsigned)(c_)); if ((c_) >= 1 && mode != 2) Y_OUT((c_) - 1); if ((c_) + 1 < NCH) SC_STORE(((c_) + 1) & 1); SC_SIGNAL(st_cnt, (unsigned)((c_) + 1)); if ((c_) + 2 < NCH) SC_LOAD((c_) + 2); } while (0)
#define CVT_LOAD_SET(V_, K0_, WT_, RB_) do { const int it_ = cvt_it < N_EXPERT_ITEMS ? cvt_it : N_EXPERT_ITEMS - 1; const float* cW_; int cn0_; cvt_expert_decode(F, it_, cW_, K0_, cn0_, WT_, RB_); cvt8_load(V_, cW_, K0_, cn0_, lane); cvt_it += F.G * 4; } while (0)
          if (item == F.vcu) { P5aConst p5k; p5a_init(F, p5k); for (int xm = F.vcu * 4 + mw; xm < MTOK; xm += F.G * 4) p5a_token(F, p5k, xm); }
          int ngrp = 0; { const int left = (N_EXPERT_ITEMS - cvt_it + F.G * 4 - 1) / (F.G * 4); ngrp = left > 0 ? left / 3 : 0; if (ngrp > NCH / 4) ngrp = NCH / 4; }
          int cg = 0;
#pragma unroll 1
          for (; cg < 4 * ngrp; cg += 4) {
            MEM_DUTIES(cg);
#if CVT_IN_SCAN
            if (cg > 0) cvt8_finish(cvv, ck0, cWT, crowb, lane);
            CVT_LOAD_SET(cvv, ck0, cWT, crowb);
#endif
            MEM_DUTIES(cg + 1);
#if CVT_IN_SCAN
            CVT_LOAD_SET(cvvB, ck0B, cWTB, crowbB);
#endif
            MEM_DUTIES(cg + 2);
#if CVT_IN_SCAN
            cvt8_finish(cvv, ck0, cWT, crowb, lane);
            CVT_LOAD_SET(cvv, ck0, cWT, crowb);
#endif
            MEM_DUTIES(cg + 3);
#if CVT_IN_SCAN
            cvt8_finish(cvvB, ck0B, cWTB, crowbB, lane);
#endif
          }
#if CVT_IN_SCAN
          if (ngrp > 0) cvt8_finish(cvv, ck0, cWT, crowb, lane);
#endif
#pragma unroll 1
          for (; cg < NCH; ++cg) MEM_DUTIES(cg);
#undef MEM_DUTIES
#undef CVT_LOAD_SET
          SC_WAIT(cons_cnt, (unsigned)NCH);
        }
        if (!is_comp && mode != 2) Y_OUT(NCH - 1);
#undef SC_LOAD
#undef SC_STORE
#undef Y_OUT
#undef SC_WAIT
#undef SC_SIGNAL
    }
    __builtin_amdgcn_s_setprio(0);
#if CVT_IN_SCAN
    if (!is_comp) {
        for (; cvt_it < N_EXPERT_ITEMS; cvt_it += F.G * 4) {
            const float* W; int k0, n0, rowb; unsigned char* WT;
            cvt_expert_decode(F, cvt_it, W, k0, n0, WT, rowb); cvt8_load(cvv, W, k0, n0, lane); cvt8_finish(cvv, k0, WT, rowb, lane);
        }
    }
#endif
}

__device__ __forceinline__ void p5_finalize(Frame& F) {
    const bf16_t* OC = WSP(F, WS_OC, bf16_t); const bf16_t* YS = WSP(F, WS_YS, bf16_t); const bf16_t* Vg = WSP(F, WS_V, bf16_t); const bf16_t* Gg = WSP(F, WS_G, bf16_t);
    const float* BON = WSP(F, WS_BONUS, float); bf16_t* MIX = WSP(F, WS_MIX, bf16_t);
    const float* subw = INP(F, 10, float); const float* lnw = INP(F, 19, float); const float* lnb = INP(F, 20, float);
    const int lane = F.lane, gw = F.vcu * 8 + F.wave, NGW = F.G * 8;
    float lam;
    { const float q1 = INP(F, 6, float)[lane] * INP(F, 7, float)[lane], q2 = INP(F, 8, float)[lane] * INP(F, 9, float)[lane];
      lam = __expf(wave_sum(q1)) - __expf(wave_sum(q2)) + 0.2f; }
    const int c0 = lane * 16;
    float sw[16], lw[16], lb[16];
#pragma unroll
    for (int i = 0; i < 16; ++i) { sw[i] = subw[(c0 + i) & 127] * 0.8f; lw[i] = lnw[c0 + i]; lb[i] = lnb[c0 + i]; }
    for (int m = gw; m < MTOK; m += NGW) {
        { const u32x4* y0 = (const u32x4*)(YS + (size_t)m * 1024 + c0); const u32x4* y1 = (const u32x4*)(YS + (size_t)MTOK * 1024 + (size_t)m * 1024 + c0);
          float y[16]; float s = 0.f;
          { const u32x4 a0 = y0[0], a1 = y0[1], b0 = y1[0], b1 = y1[1];
            const unsigned aw[8] = {a0.x, a0.y, a0.z, a0.w, a1.x, a1.y, a1.z, a1.w}, bw[8] = {b0.x, b0.y, b0.z, b0.w, b1.x, b1.y, b1.z, b1.w};
#pragma unroll
            for (int i = 0; i < 8; ++i) { y[2 * i] = bf_lo(aw[i]) + bf_lo(bw[i]); y[2 * i + 1] = bf_hi(aw[i]) + bf_hi(bw[i]); } }
#pragma unroll
          for (int i = 0; i < 16; ++i) s += y[i];
          s += __shfl_xor(s, 1); s += __shfl_xor(s, 2);
          const float mu = s * (1.f / 64.f); float q = 0.f;
#pragma unroll
          for (int i = 0; i < 16; ++i) { y[i] -= mu; q += y[i] * y[i]; }
          q += __shfl_xor(q, 1); q += __shfl_xor(q, 2);
          const float rstd = 1.f / sqrtf(q * (1.f / 64.f) + 64e-5f);
          const float bon = BON[(size_t)m * 16 + (lane >> 2)];
          const u32x4* vp = (const u32x4*)(Vg + (size_t)m * 1024 + c0); const u32x4* gp = (const u32x4*)(Gg + (size_t)m * 1024 + c0);
          const u32x4 v0 = vp[0], v1 = vp[1], g0 = gp[0], g1 = gp[1];
          const unsigned vw[8] = {v0.x, v0.y, v0.z, v0.w, v1.x, v1.y, v1.z, v1.w}, gq[8] = {g0.x, g0.y, g0.z, g0.w, g1.x, g1.y, g1.z, g1.w};
          unsigned ow[8];
#pragma unroll
          for (int i = 0; i < 8; ++i) {
              const float e0 = (y[2 * i] * rstd * lw[2 * i] + lb[2 * i] + bon * bf_lo(vw[i])) * bf_lo(gq[i]);
              const float e1 = (y[2 * i + 1] * rstd * lw[2 * i + 1] + lb[2 * i + 1] + bon * bf_hi(vw[i])) * bf_hi(gq[i]);
              ow[i] = cvtpk(e0, e1); }
          u32x4* op = (u32x4*)(MIX + (size_t)m * 2048 + 1024 + c0); op[0] = (u32x4){ow[0], ow[1], ow[2], ow[3]}; op[1] = (u32x4){ow[4], ow[5], ow[6], ow[7]}; }
    }
}

__device__ __forceinline__ void p7_router(Frame& F) {
    const bf16_t* X1 = WSP(F, WS_X1, bf16_t); const float* nw = INP(F, 22, float); const float* wr = INP(F, 23, float);
    unsigned char* H2 = WSP(F, WS_H2, unsigned char); float* AFF = WSP(F, WS_AFF, float);
    const int lane = F.lane, w = F.wave, tok = lane & 15, kq = lane >> 4;
    LAS float* part = (LAS float*)F.lds;
    LAS float* ssqp = (LAS float*)(F.lds + 8192);
    const int kb = 256 * w + 8 * kq;
    float Bw[8][8];
#pragma unroll
    for (int g = 0; g < 8; ++g)
#pragma unroll
        for (int e = 0; e < 8; ++e) { const int k = kb + 32 * g + e; Bw[g][e] = nw[k] * wr[(size_t)k * 16 + tok]; }
    for (int item = F.vcu; item < MTOK / 16; item += F.G) {
        const int m0 = item * 16;
        u32x4 xr[8];
        const bf16_t* xp = X1 + (size_t)(m0 + tok) * DM + kb;
#pragma unroll
        for (int g = 0; g < 8; ++g) xr[g] = *(const u32x4*)(xp + 32 * g);
        f32x4 acc = {0.f, 0.f, 0.f, 0.f}; float ss = 0.f;
#pragma unroll
        for (int g = 0; g < 8; ++g) {
            float x[8]; unpack8(xr[g], x);
#pragma unroll
            for (int e = 0; e < 8; ++e) { ss += x[e] * x[e]; acc = __builtin_amdgcn_mfma_f32_16x16x4f32(x[e], Bw[g][e], acc, 0, 0, 0); }
        }
        __syncthreads();
        *(LAS f32x4*)(part + w * 256 + tok * 16 + 4 * kq) = acc;
        ss += __shfl_xor(ss, 16); ss += __shfl_xor(ss, 32);
        if (kq == 0) ssqp[w * 16 + tok] = ss;
        __syncthreads();
        float tot = 0.f;
#pragma unroll
        for (int i = 0; i < 8; ++i) tot += ssqp[i * 16 + tok];
        const float rstd = 1.f / sqrtf(tot * (1.f / DM) + 1e-6f);
        { unsigned char* hp = H2 + (size_t)(m0 + tok) * DM + kb;
#pragma unroll
          for (int g = 0; g < 8; ++g) { float x[8]; unpack8(xr[g], x); const f32x4 n0 = *(const f32x4*)(nw + kb + 32 * g), n1 = *(const f32x4*)(nw + kb + 32 * g + 4);
              u32x2 o; o.x = pg8::cvt4_fp8(x[0] * rstd * n0.x, x[1] * rstd * n0.y, x[2] * rstd * n0.z, x[3] * rstd * n0.w); o.y = pg8::cvt4_fp8(x[4] * rstd * n1.x, x[5] * rstd * n1.y, x[6] * rstd * n1.z, x[7] * rstd * n1.w);
              *(u32x2*)(hp + 32 * g) = o; } }
        if (lane < 32) {
            const int tt = 2 * w + (lane >> 4), ex = lane & 15;
            float lg = 0.f, t2 = 0.f;
#pragma unroll
            for (int i = 0; i < 8; ++i) { lg += part[i * 256 + ex * 16 + tt]; t2 += ssqp[i * 16 + tt]; }
            lg *= 1.f / sqrtf(t2 * (1.f / DM) + 1e-6f);
            float mx = lg;
            mx = fmaxf(mx, __shfl_xor(mx, 1)); mx = fmaxf(mx, __shfl_xor(mx, 2)); mx = fmaxf(mx, __shfl_xor(mx, 4)); mx = fmaxf(mx, __shfl_xor(mx, 8));
            const float pe = expf(lg - mx);
            float den = pe; den += __shfl_xor(den, 1); den += __shfl_xor(den, 2); den += __shfl_xor(den, 4); den += __shfl_xor(den, 8);
            const int mm = m0 + tt;
            AFF[((size_t)(mm >> 11) * 16 + ex) * SEQ + (mm & (SEQ - 1))] = pe / den;
        }
    }
    __syncthreads();
}

__device__ __forceinline__ int wave_count4(bool f0, bool f1, bool f2, bool f3) {
    return __builtin_popcountll(__ballot(f0)) + __builtin_popcountll(__ballot(f1)) + __builtin_popcountll(__ballot(f2)) + __builtin_popcountll(__ballot(f3));
}
__device__ __forceinline__ void p8_select(Frame& F) {
    const float* AFF = WSP(F, WS_AFF, float);
    int* XEIDX = WSP(F, WS_XEIDX, int); float* GATEX = WSP(F, WS_GATEX, float); int* SLOT = WSP(F, WS_SLOT, int);
    LAS int* part = (LAS int*)F.lds;
    LAS unsigned* cnt = (LAS unsigned*)(F.lds + 256);
    LAS unsigned* list = (LAS unsigned*)(F.lds + 512);
    const int tid = F.tid, lane = F.lane, w = F.wave;
    for (int item = F.vcu; item < 256; item += F.G) {
        const int be = item >> 2, q = item & 3, b = be >> 4, e = be & 15;
        __syncthreads();
        if (tid == 0) *cnt = 0u;
        const f32x4 a4 = ((const f32x4*)(AFF + (size_t)be * SEQ))[tid];
        const unsigned u0 = __float_as_uint(a4.x), u1 = __float_as_uint(a4.y), u2 = __float_as_uint(a4.z), u3 = __float_as_uint(a4.w);
        unsigned lo = 0u, hi = 0x7f800001u;
        int itn = 0;
        while (hi - lo > 1u) {
            const unsigned mid = lo + ((hi - lo) >> 1);
            const int c = wave_count4(u0 >= mid, u1 >= mid, u2 >= mid, u3 >= mid);
            LAS int* pp = part + (itn & 1) * 8;
            if (lane == 0) pp[w] = c;
            __syncthreads();
            int tot = 0;
#pragma unroll
            for (int i = 0; i < 8; ++i) tot += pp[i];
            if (tot >= CAP) lo = mid; else hi = mid;
            ++itn;
        }
        const unsigned T = lo;
        const bool g0 = u0 > T, g1 = u1 > T, g2 = u2 > T, g3 = u3 > T, q0 = u0 == T, q1 = u1 == T, q2 = u2 == T, q3 = u3 == T;
        const unsigned long long bg0 = __ballot(g0), bg1 = __ballot(g1), bg2 = __ballot(g2), bg3 = __ballot(g3), bq0 = __ballot(q0), bq1 = __ballot(q1), bq2 = __ballot(q2), bq3 = __ballot(q3);
        const unsigned long long below = (lane == 0) ? 0ull : (~0ull >> (64 - lane));
        int pg = __builtin_popcountll(bg0 & below) + __builtin_popcountll(bg1 & below) + __builtin_popcountll(bg2 & below) + __builtin_popcountll(bg3 & below);
        int pq = __builtin_popcountll(bq0 & below) + __builtin_popcountll(bq1 & below) + __builtin_popcountll(bq2 & below) + __builtin_popcountll(bq3 & below);
        const int wg = __builtin_popcountll(bg0) + __builtin_popcountll(bg1) + __builtin_popcountll(bg2) + __builtin_popcountll(bg3);
        const int wq = __builtin_popcountll(bq0) + __builtin_popcountll(bq1) + __builtin_popcountll(bq2) + __builtin_popcountll(bq3);
        if (lane == 0) { part[16 + w] = wg; part[32 + w] = wq; }
        __syncthreads();
        int gtc = 0, baseg = 0, baseq = 0;
#pragma unroll
        for (int i = 0; i < 8; ++i) { const int x = part[16 + i], y = part[32 + i]; gtc += x; if (i < w) { baseg += x; baseq += y; } }
        const int need = CAP - gtc;
        pg += baseg; pq += baseq;
        if ((w >> 1) == q) {
            const bool gs[4] = {g0, g1, g2, g3}, qs[4] = {q0, q1, q2, q3}; const float av[4] = {a4.x, a4.y, a4.z, a4.w};
            int cg_ = pg, cq_ = pq;
#pragma unroll
            for (int i = 0; i < 4; ++i) {
                const int t = 4 * tid + i, m = b * SEQ + t; int slot = -1;
                if (gs[i]) { slot = cg_; ++cg_; } else if (qs[i]) { if (cq_ < need) slot = gtc + cq_; ++cq_; }
                SLOT[m * 16 + e] = slot;
                if (slot >= 0) { GATEX[(e * 4 + b) * CAP + slot] = av[i]; XEIDX[(e * 4 + b) * CAP + slot] = m; }
            }
        }
    }
}

__device__ __forceinline__ void p11_final(Frame& F) {
    const bf16_t* X1 = WSP(F, WS_X1, bf16_t); const unsigned char* YE = WSP(F, WS_YE, unsigned char); const int* SLOT = WSP(F, WS_SLOT, int); const float* nw = INP(F, 27, float);
    float* out = F.a->out;
    const int lane = F.lane, gw = F.vcu * 8 + F.wave, NGW = F.G * 8;
    for (int m = gw; m < MTOK; m += NGW) {
        const int b = m >> 11;
        float v[32];
        { const u32x4* xr = (const u32x4*)(X1 + (size_t)m * DM + lane * 8);
#pragma unroll
          for (int j = 0; j < 4; ++j) { const u32x4 a = xr[64 * j]; v[8 * j] = bf_lo(a.x); v[8 * j + 1] = bf_hi(a.x); v[8 * j + 2] = bf_lo(a.y); v[8 * j + 3] = bf_hi(a.y); v[8 * j + 4] = bf_lo(a.z); v[8 * j + 5] = bf_hi(a.z); v[8 * j + 6] = bf_lo(a.w); v[8 * j + 7] = bf_hi(a.w); } }
        int sl = (lane < 16) ? SLOT[m * 16 + lane] : -1;
        for (int e = 0; e < 16; ++e) {
            const int s = __shfl(sl, e);
            if (s >= 0) { const u32x2* yr = (const u32x2*)(YE + (size_t)((e * 4 + b) * CAP + s) * DM + lane * 8);
#pragma unroll
                for (int j = 0; j < 4; ++j) { const u32x2 w = yr[64 * j];
#define P11_ACC(q_) do { v[8 * j + (q_)] += __builtin_amdgcn_cvt_f32_fp8(w.x, q_) * pg8::YE_DESCALE; v[8 * j + 4 + (q_)] += __builtin_amdgcn_cvt_f32_fp8(w.y, q_) * pg8::YE_DESCALE; } while (0)
                    P11_ACC(0); P11_ACC(1); P11_ACC(2); P11_ACC(3);
#undef P11_ACC
                } }
        }
        float s = 0.f;
#pragma unroll
        for (int i = 0; i < 32; ++i) s += v[i] * v[i];
        const float rstd = 1.f / sqrtf(wave_sum(s) * (1.f / DM) + 1e-6f);
#pragma unroll
        for (int j = 0; j < 4; ++j) { const int col = 512 * j + lane * 8; const f32x4 w0 = *(const f32x4*)(nw + col), w1 = *(const f32x4*)(nw + col + 4);
            f32x4 o0 = {v[8 * j] * rstd * w0.x, v[8 * j + 1] * rstd * w0.y, v[8 * j + 2] * rstd * w0.z, v[8 * j + 3] * rstd * w0.w};
            f32x4 o1 = {v[8 * j + 4] * rstd * w1.x, v[8 * j + 5] * rstd * w1.y, v[8 * j + 6] * rstd * w1.z, v[8 * j + 7] * rstd * w1.w};
            *(f32x4*)(out + (size_t)m * DM + col) = o0; *(f32x4*)(out + (size_t)m * DM + col + 4) = o1; }
    }
}


template <int PHM> __global__ void __launch_bounds__(512, 2) mk_fwd(Args args) {
    extern __shared__ __attribute__((aligned(16))) unsigned char lds[];
    Frame F;
    F.lds = (LAS unsigned char*)lds; F.ldsg = (char*)lds; F.a = &args;
    F.tid = threadIdx.x; F.lane = F.tid & 63; F.wave = __builtin_amdgcn_readfirstlane(F.tid >> 6);
    F.G = gridDim.x; { const int bx = blockIdx.x; F.vcu = (F.G % 8 == 0) ? (bx % 8) * (F.G / 8) + bx / 8 : bx; }
    volatile LAS unsigned* MISC = (volatile LAS unsigned*)(F.lds + MISC_OFF);
    for (int u = F.tid; u < (LDS_BYTES - 131072) / 4; u += 512) ((LAS unsigned*)(F.lds + 131072))[u] = 0u;
    __syncthreads();
    gu32* ctl = (gu32*)(args.ws + WS_CTL);
    XcdBarrier bar; bar.bar = (unsigned*)(ctl + CW_BAR); bar.x = 0; bar.st = nullptr;
    if (MK_N_LAUNCHES == 1) bar = xcd_barrier_post((unsigned*)(ctl + CW_BAR), MISC + 8);
    const int lo = args.ph_lo, hi = args.ph_hi;
#define IN(k) (((PHM >> (k)) & 1) && lo <= (k) && (k) < hi)
#ifndef DUP_MASK
#define DUP_MASK 0
#endif
#define REP(k) for (int rep_ = 0; rep_ < 1 + ((DUP_MASK >> (k)) & 1); ++rep_)
#define SEAM(k) do { if (IN(k) && IN((k) + 1)) xcd_barrier(bar); } while (0)

    if (IN(0)) REP(0) { p0_prologue(F); }
    SEAM(0);
    if (IN(1)) REP(1) {
        pg8::Gemm g{WSP(F, WS_H1, bf16_t), WSP(F, WS_WIN, bf16_t), MTOK, 6144, DM, DM}; pg8::StaticOrder S; S.init(MTOK, 6144, F.G, (int)blockIdx.x);
        pg8::EpiProj E{WSP(F, WS_PROJ, bf16_t), LDP, WSP(F, WS_ROPE, float), QSCALE};
        pg8::gemm_phase<pg8::EpiProj, pg8::StaticOrder, true, true>(F.lds, g, S, E);
        pg8::Gemm g2{WSP(F, WS_H1, bf16_t), WSP(F, WS_WIN, bf16_t), MTOK, 512, DM / 4, DM}; pg8::TailOrder S2{F.G, (int)blockIdx.x};
        pg8::EpiPart E2{WSP(F, WS_PART, bf16_t)};
        pg8::gemm_phase<pg8::EpiPart, pg8::TailOrder, true, true>(F.lds, g2, S2, E2);
    }
    SEAM(1);
    const bool prep_first = (F.vcu & 1) != 0;
    if (IN(3) && prep_first) { p3_prep(F, 0); }
    if (IN(2)) {
        const bf16_t* P = WSP(F, WS_PROJ, bf16_t); bf16_t* OC = WSP(F, WS_OC, bf16_t);
        for (int u = F.vcu * 2; u < 512; u += F.G * 2)
            for (int i = 0; i < 2; ++i) {
                const int uu = u + i, qb = uu & 7, c = (uu >> 3) & 1, h = (uu >> 4) & 7, b = uu >> 7;
                const size_t m0 = (size_t)b * SEQ;
                att::attn_unit<LDP>(P + (m0 + qb * 256) * LDP + h * 128 + c * 64, P + m0 * LDP + 1024 + h * 128 + c * 64, P + m0 * LDP + 2048 + h * 128,
                                    OC + (size_t)c * MTOK * 1024 + (m0 + qb * 256) * 1024 + h * 128, SEQ, F.ldsg);
            }
    }
    if (IN(3) && !prep_first) { p3_prep(F, 0); }
    SEAM(3);
    #ifndef SCAN_PROBE
#define SCAN_PROBE 0
#endif
    if (IN(4)) REP(4) { p4_scan(F, rep_ ? SCAN_PROBE : 0); }
    SEAM(4);
    if (IN(5)) REP(5) { p5_finalize(F); }
    SEAM(5);
    if (IN(6)) REP(6) {
        pg8::Gemm g{WSP(F, WS_MIX, bf16_t), WSP(F, WS_WOUT, bf16_t), MTOK, DM, DM, DM}; pg8::StaticOrder S; S.init(MTOK, DM, F.G, (int)blockIdx.x);
        pg8::EpiResid E{INP(F, 0, float), WSP(F, WS_X1, bf16_t), DM};
        pg8::gemm_phase<pg8::EpiResid, pg8::StaticOrder, true, true>(F.lds, g, S, E);
    }
    SEAM(6);
    if (IN(7)) REP(7) { p7_router(F); }
    SEAM(7);
    if (IN(8)) REP(8) { p8_select(F); }
    SEAM(8);
    if (IN(9)) REP(9) {
        pg8::Gemm g{WSP(F, WS_H2, bf16_t), WSP(F, WS_WGU, bf16_t), 16384, 65536, DM / 2, DM / 2}; pg8::MoeOrderT<true> S{F.G, F.vcu, 16, 1024, WSP(F, WS_XEIDX, int)};
        pg8::EpiSwiglu E{WSP(F, WS_HID, unsigned char), 16};
        pg8::gemm_phase<pg8::EpiSwiglu, pg8::MoeOrderT<true>, true, true, true>(F.lds, g, S, E);
    }
    SEAM(9);
    if (IN(10)) REP(10) {
        pg8::Gemm g{WSP(F, WS_HID, bf16_t), WSP(F, WS_WD, bf16_t), 16384, 32768, DM / 2, DM / 2}; pg8::MoeOrderT<false> S{F.G, F.vcu, 8, 512, nullptr};
        pg8::EpiDown E{WSP(F, WS_YE, unsigned char), WSP(F, WS_GATEX, float), 8};
        pg8::gemm_phase<pg8::EpiDown, pg8::MoeOrderT<false>, true, true, true>(F.lds, g, S, E);
    }
    SEAM(10);
    if (IN(11)) REP(11) { p11_final(F); }
#undef IN
#undef SEAM
}

static const void* kfn(int li) {
#if MK_N_LAUNCHES == 1
    (void)li; return (const void*)mk_fwd<0xFFF>;
#else
    switch (li) {
        case 0: return (const void*)mk_fwd<1>; case 1: return (const void*)mk_fwd<2>; case 2: return (const void*)mk_fwd<4>; case 3: return (const void*)mk_fwd<8>;
        case 4: return (const void*)mk_fwd<16>; case 5: return (const void*)mk_fwd<32>; case 6: return (const void*)mk_fwd<64>; case 7: return (const void*)mk_fwd<128>;
        case 8: return (const void*)mk_fwd<256>; case 9: return (const void*)mk_fwd<512>; case 10: return (const void*)mk_fwd<1024>; default: return (const void*)mk_fwd<2048>;
    }
#endif
}
extern "C" void kernel_launch(void* const* d_in, const int* in_sizes, int n_in, void* d_out, int out_size, void* d_ws, size_t ws_size, hipStream_t stream) {
    static int grid = 0;
    if (grid == 0) {
        if (n_in != 28 || out_size != MTOK * DM || ws_size < WS_END) { fprintf(stderr, "kernel_launch: unexpected shapes: n_in %d out %d ws %zu (need >= %zu)\n", n_in, out_size, ws_size, (size_t)WS_END); grid = -1; return; }
        int dev = 0, cus = 0, per_cu = 0;
        if (hipGetDevice(&dev) != hipSuccess || hipDeviceGetAttribute(&cus, hipDeviceAttributeMultiprocessorCount, dev) != hipSuccess) { fprintf(stderr, "kernel_launch: device query failed\n"); grid = -1; return; }
        for (int i = 0; i < MK_N_LAUNCHES; ++i) if (hipFuncSetAttribute(kfn(i), hipFuncAttributeMaxDynamicSharedMemorySize, LDS_BYTES) != hipSuccess) { fprintf(stderr, "kernel_launch: hipFuncSetAttribute failed\n"); grid = -1; return; }
        if (hipOccupancyMaxActiveBlocksPerMultiprocessor(&per_cu, kfn(0), 512, LDS_BYTES) != hipSuccess || per_cu < 1) { fprintf(stderr, "kernel_launch: occupancy query says %d blocks/CU\n", per_cu); }
        (void)hipGetLastError();
        grid = cus;
    }
    if (grid < 0) return;
    if (hipMemsetAsync((char*)d_ws + WS_CTL, 0, CTL_ZERO_BYTES, stream) != hipSuccess) { fprintf(stderr, "kernel_launch: memset failed\n"); return; }
    Args a{};
    for (int i = 0; i < 28; ++i) a.in[i] = d_in[i];
    a.out = (float*)d_out; a.ws = (unsigned char*)d_ws;
    const int nl = MK_N_LAUNCHES;
    for (int li = 0; li < nl; ++li) {
        a.ph_lo = (nl == 1) ? 0 : li; a.ph_hi = (nl == 1) ? N_PHASES : li + 1; a.li = li;
        void* kargs[] = {&a};
        (void)hipLaunchKernel(kfn(li), dim3(grid), dim3(512), kargs, LDS_BYTES, stream);
        const hipError_t le = hipPeekAtLastError();
        if (le != hipSuccess) { fprintf(stderr, "kernel_launch: launch %d failed: %s\n", li, hipGetErrorName(le)); break; }
    }
}
```

```cpp
#include <hip/hip_runtime.h>
#include <hip/hip_bf16.h>
#include <cstdio>
#include <cstdint>

#ifndef MK_N_LAUNCHES
#define MK_N_LAUNCHES 1
#endif
#ifndef CVT_IN_SCAN
#define CVT_IN_SCAN 1
#endif
constexpr int N_PHASES = 12;

constexpr int BATCH = 4, SEQ = 2048, DM = 2048, MTOK = BATCH * SEQ;
constexpr int IN_COLS = 6432, LDP = 6656;
constexpr int ZC0 = 3072;
constexpr int RW = 1024, NH_R = 16, HD_R = 64;
constexpr int NEXP = 16, CAP = 256, FF = 2048;
constexpr float QSCALE = 0.18033688011112042f;

constexpr size_t MiB = 1u << 20;
constexpr size_t WS_CTL = 0, CTL_ZERO_BYTES = 1 * MiB;
constexpr size_t WS_ROPE = 1 * MiB;
constexpr size_t WS_LORA = 2 * MiB;
constexpr size_t WS_AFF = 3 * MiB;
constexpr size_t WS_GATEX = 3 * MiB + 512 * 1024;
constexpr size_t WS_SLOT = 4 * MiB;
constexpr size_t WS_XEIDX = 6 * MiB;
constexpr size_t WS_BONUS = 5 * MiB;
constexpr size_t WS_WIN = 8 * MiB;
constexpr size_t WS_WOUT = 34 * MiB;
constexpr size_t WS_WGU = 48 * MiB;
constexpr size_t WS_WD = 304 * MiB;
constexpr size_t WS_H1 = 432 * MiB;
constexpr size_t WS_PROJ = 464 * MiB;
constexpr size_t WS_R = 568 * MiB, WS_KK = 584 * MiB, WS_V = 600 * MiB;
constexpr size_t WS_WDEC = 616 * MiB;
constexpr size_t WS_KD = 680 * MiB, WS_BB = 712 * MiB;
constexpr size_t WS_G = 744 * MiB;
constexpr size_t WS_OC = 760 * MiB;
constexpr size_t WS_YS = 792 * MiB;
constexpr size_t WS_MIX = 856 * MiB;
constexpr size_t WS_X1 = 888 * MiB;
constexpr size_t WS_H2 = 952 * MiB;
constexpr size_t WS_HID = 528 * MiB, WS_YE = 592 * MiB;
constexpr size_t WS_PART = WS_X1;
constexpr size_t WS_END = 984 * MiB;
constexpr int CW_BAR = 4096;

constexpr int LDS_BYTES = 147456;
constexpr int MISC_OFF = 131072 + 320;

#define GAS __attribute__((address_space(1)))
#define LAS __attribute__((address_space(3)))
typedef unsigned short bf16_t;
typedef float f32x4 __attribute__((ext_vector_type(4)));
typedef float f32x2 __attribute__((ext_vector_type(2)));
typedef float f32x16 __attribute__((ext_vector_type(16)));
typedef unsigned u32x4 __attribute__((ext_vector_type(4)));
typedef unsigned u32x2 __attribute__((ext_vector_type(2)));
typedef short bf16x8 __attribute__((ext_vector_type(8)));
typedef short s16x4 __attribute__((ext_vector_type(4)));
typedef __bf16 bf16x2_t __attribute__((ext_vector_type(2)));

__device__ __forceinline__ unsigned cvtpk(float lo, float hi) { f32x2 v = {lo, hi}; bf16x2_t b = __builtin_convertvector(v, bf16x2_t); return __builtin_bit_cast(unsigned, b); }
__device__ __forceinline__ float bf_lo(unsigned w) { return __uint_as_float(w << 16); }
__device__ __forceinline__ float bf_hi(unsigned w) { return __uint_as_float(w & 0xffff0000u); }
__device__ __forceinline__ float bf2f(bf16_t v) { return __uint_as_float((unsigned)v << 16); }
__device__ __forceinline__ float wave_sum(float v) {
#pragma unroll
    for (int o = 1; o < 64; o <<= 1) v += __shfl_xor(v, o);
    return v;
}
__device__ __forceinline__ float sigmoidf_(float x) { return 1.f / (1.f + __expf(-x)); }

struct Args { const void* in[28]; float* out; unsigned char* ws; int ph_lo, ph_hi, li, pad; };

namespace pg8 {
#define PG8_LAS __attribute__((address_space(3)))
typedef unsigned short bf16_t;
typedef short bf16x8 __attribute__((ext_vector_type(8)));
typedef float f32x4 __attribute__((ext_vector_type(4)));
typedef unsigned u32x4 __attribute__((ext_vector_type(4)));
typedef unsigned u32x2 __attribute__((ext_vector_type(2)));
typedef int i32x4 __attribute__((ext_vector_type(4)));
typedef int i32x8 __attribute__((ext_vector_type(8)));
typedef float f32x8 __attribute__((ext_vector_type(8)));
typedef float f32x32 __attribute__((ext_vector_type(32)));
constexpr int BM = 256, BK = 64, HALF = 128, HTB = HALF * BK * 2  , STAGE_BYTES = 8 * HTB, NXCD = 8, WGM = 8;

__host__ __device__ __forceinline__ int lds_byte(int r, int c) { const int st = (r >> 4) * 2 + (c >> 5), rr = r & 15, cc = c & 31, ob = rr * 64 + cc * 2; return st * 1024 + (ob ^ (((ob >> 9) & 1) << 5)); }
__host__ __device__ __forceinline__ void stage_rc(int b, int& R, int& C) { const int st = b / 1024, sb = b % 1024, swz = sb ^ (((sb >> 9) & 1) << 5); R = (st >> 1) * 16 + swz / 64; C = (st & 1) * 32 + (swz % 64) / 2; }
__host__ __device__ __forceinline__ int perm32(int rho) { const int n = rho >> 4, i = rho & 15; return 8 * (i >> 2) + 4 * n + (i & 3); }

struct Unit { int pm, pn, pk; };
struct Gemm { const bf16_t* A; const bf16_t* Bt; int M, N, K, Kp; };

struct StaticOrder {
    int nM, nN, nwg, G, c;
    __host__ __device__ void init(int M, int N, int G_, int c_) { nM = M / BM; nN = N / BM; nwg = nM * nN; G = G_; c = c_; }
    __host__ __device__ bool next(int i, Unit& u) const {
        const long L = (long)i * G + c; if (L >= nwg) return false;
        int wgid = (int)L; { const int q = nwg / NXCD, r = nwg % NXCD, xcd = wgid % NXCD, off = wgid / NXCD; wgid = (xcd < r ? xcd * (q + 1) : r * (q + 1) + (xcd - r) * q) + off; }
        const int nig = WGM * nN, gid = wgid / nig, fm = gid * WGM, gsz = (nM - fm) < WGM ? (nM - fm) : WGM;
        u.pm = fm + ((wgid % nig) % gsz); u.pn = (wgid % nig) / gsz; u.pk = 0; return true;
    }
    static constexpr bool GATHER = false;
    __device__ __forceinline__ int arow(const Unit&, int) const { return 0; }
    __device__ __forceinline__ void a_ready(const Unit&) const {}
    __device__ __forceinline__ void done(const Unit&) const {}
};


typedef float f32x2 __attribute__((ext_vector_type(2)));
typedef __bf16 bf16x2_t __attribute__((ext_vector_type(2)));
__device__ __forceinline__ unsigned cvt_pk_bf16(float lo, float hi) { f32x2 v = {lo, hi}; bf16x2_t b = __builtin_convertvector(v, bf16x2_t); return __builtin_bit_cast(unsigned, b); }

template <bool GATHER_> struct MoeOrderT {
    static constexpr bool GATHER = GATHER_;
    int G, vcu, npn, total; const int* idx;
    __device__ __forceinline__ int arow(const Unit& u, int r) const { return idx[u.pm * BM + r]; }
    __device__ bool next(int i, Unit& u) const {
        const int L = i * G + vcu; if (L >= total) return false;
        const int per_e = 4 * npn, e = L / per_e, r = L % per_e;
        u.pm = e * 4 + (r & 3); u.pn = e * npn + (r >> 2); u.pk = 0; return true;
    }
    __device__ __forceinline__ void a_ready(const Unit&) const {}
    __device__ __forceinline__ void done(const Unit&) const {}
};

struct TailOrder {
    int G, c; static constexpr bool GATHER = false;
    __device__ bool next(int i, Unit& u) const { const int L = i * G + c; if (L >= 256) return false; u.pk = L & 3; const int t = L >> 2; u.pm = t & 31; u.pn = 24 + (t >> 5); return true; }
    __device__ __forceinline__ int arow(const Unit&, int) const { return 0; }
    __device__ __forceinline__ void a_ready(const Unit&) const {}
    __device__ __forceinline__ void done(const Unit&) const {}
};
struct EpiPart {
    static constexpr bool PERM = true, AFTER_DRAIN = false;
    bf16_t* P;
    __device__ __forceinline__ void operator()(const f32x4 (&acc)[2][2][4][2], const Unit& u, int wr, int wc, int fr, int fq) const {
        bf16_t* base = P + ((size_t)(((u.pn - 24) * 32 + u.pm) * 4 + u.pk) << 16);
        const int row0 = wr * 64 + fr, col0 = wc * 32 + 8 * fq;
        const bool thin = (u.pn == 25);
        if (thin && wc != 0) return;
#pragma unroll
        for (int ai = 0; ai < 2; ++ai)
#pragma unroll
            for (int m = 0; m < 4; ++m) {
                bf16_t* rowp = base + (row0 + ai * HALF + m * 16) * 256 + col0;
#pragma unroll
                for (int bj = 0; bj < 2; ++bj) { if (bj == 1 && thin) break; const f32x4 v0 = acc[ai][bj][m][0], v1 = acc[ai][bj][m][1];
                    u32x4 w; w.x = cvt_pk_bf16(v0[0], v0[1]); w.y = cvt_pk_bf16(v0[2], v0[3]); w.z = cvt_pk_bf16(v1[0], v1[1]); w.w = cvt_pk_bf16(v1[2], v1[3]);
                    *(u32x4*)(rowp + bj * HALF) = w; }
            }
    }
};

struct EpiProj {
    static constexpr bool PERM = true, AFTER_DRAIN = false;
    bf16_t* P; int ldp; const float* rope; float qscale;
    __device__ __forceinline__ void operator()(const f32x4 (&acc)[2][2][4][2], const Unit& u, int wr, int wc, int fr, int fq) const {
        const int row0 = u.pm * BM + wr * 64 + fr, colt = u.pn * BM, col0 = colt + wc * 32 + 8 * fq;
        const bool ropew = (colt < 2048) && ((wc & 1) == 0);
        const float sc = (colt < 1024) ? qscale : 1.f, sgn = (fq == 0) ? -1.f : 1.f;
#pragma unroll
        for (int ai = 0; ai < 2; ++ai)
#pragma unroll
            for (int m = 0; m < 4; ++m) {
                const int row = row0 + ai * HALF + m * 16;
                f32x4 c0 = {1.f, 1.f, 1.f, 1.f}, c1 = c0, s0 = {0.f, 0.f, 0.f, 0.f}, s1 = s0;
                if (ropew) { const f32x4* rp = (const f32x4*)(rope + (size_t)row * 16); c0 = rp[0]; c1 = rp[1]; s0 = rp[2]; s1 = rp[3]; }
                bf16_t* rowp = P + (size_t)row * ldp + col0;
#pragma unroll
                for (int bj = 0; bj < 2; ++bj) {
                    f32x4 v0 = acc[ai][bj][m][0], v1 = acc[ai][bj][m][1];
                    if (ropew) {
                        f32x4 p0, p1;
#pragma unroll
                        for (int i = 0; i < 4; ++i) { p0[i] = __shfl_xor(v0[i], 16); p1[i] = __shfl_xor(v1[i], 16); }
                        if (fq < 2) { v0 = v0 * c0 + (p0 * s0) * sgn; v1 = v1 * c1 + (p1 * s1) * sgn; }
                    }
                    v0 = v0 * sc; v1 = v1 * sc;
                    u32x4 w; w.x = cvt_pk_bf16(v0[0], v0[1]); w.y = cvt_pk_bf16(v0[2], v0[3]); w.z = cvt_pk_bf16(v1[0], v1[1]); w.w = cvt_pk_bf16(v1[2], v1[3]);
                    *(u32x4*)(rowp + bj * HALF) = w;
                }
            }
    }
};

struct EpiResid {
    static constexpr bool PERM = true, AFTER_DRAIN = false;
    const float* base; bf16_t* out; int ldc;
    __device__ __forceinline__ void operator()(const f32x4 (&acc)[2][2][4][2], const Unit& u, int wr, int wc, int fr, int fq) const {
        const int row0 = u.pm * BM + wr * 64 + fr, col0 = u.pn * BM + wc * 32 + 8 * fq;
#pragma unroll
        for (int ai = 0; ai < 2; ++ai)
#pragma unroll
            for (int m = 0; m < 4; ++m) {
                const size_t off = (size_t)(row0 + ai * HALF + m * 16) * ldc + col0;
#pragma unroll
                for (int bj = 0; bj < 2; ++bj) { const f32x4 b0 = *(const f32x4*)(base + off + bj * HALF), b1 = *(const f32x4*)(base + off + bj * HALF + 4);
                    const f32x4 v0 = b0 + acc[ai][bj][m][0], v1 = b1 + acc[ai][bj][m][1];
                    u32x4 w; w.x = cvt_pk_bf16(v0[0], v0[1]); w.y = cvt_pk_bf16(v0[2], v0[3]); w.z = cvt_pk_bf16(v1[0], v1[1]); w.w = cvt_pk_bf16(v1[2], v1[3]);
                    *(u32x4*)(out + off + bj * HALF) = w; }
            }
    }
};

__device__ __forceinline__ float clamp8(float x) { return __builtin_fminf(__builtin_fmaxf(x, -448.f), 448.f); }
__device__ __forceinline__ unsigned cvt4_fp8(float a, float b, float c, float d) {
    int w = __builtin_amdgcn_cvt_pk_fp8_f32(clamp8(a), clamp8(b), 0, false); w = __builtin_amdgcn_cvt_pk_fp8_f32(clamp8(c), clamp8(d), w, true); return (unsigned)w; }
constexpr float W8_SCALE = 64.f, W8_DESCALE = 1.f / 64.f;

struct EpiSwiglu {
    static constexpr bool PERM = true, AFTER_DRAIN = false;
    unsigned char* H; int npn;
    __device__ __forceinline__ void operator()(const f32x4 (&acc)[2][2][4][2], const Unit& u, int wr, int wc, int fr, int fq) const {
        const int row0 = u.pm * BM + wr * 64 + fr, pnl = u.pn % npn, col0 = pnl * HALF + wc * 32 + 8 * fq;
#pragma unroll
        for (int ai = 0; ai < 2; ++ai)
#pragma unroll
            for (int m = 0; m < 4; ++m) {
                unsigned char* rowp = H + (size_t)(row0 + ai * HALF + m * 16) * 2048 + col0;
                float h[8];
#pragma unroll
                for (int n = 0; n < 2; ++n)
#pragma unroll
                    for (int i = 0; i < 4; ++i) { const float g = acc[ai][0][m][n][i] * W8_DESCALE, up = acc[ai][1][m][n][i] * W8_DESCALE; h[n * 4 + i] = g * up * __builtin_amdgcn_rcpf(1.f + __expf(-g)); }
                u32x2 w; w.x = cvt4_fp8(h[0], h[1], h[2], h[3]); w.y = cvt4_fp8(h[4], h[5], h[6], h[7]);
                *(u32x2*)rowp = w;
            }
    }
};

constexpr float YE_SCALE = 16.f, YE_DESCALE = 1.f / 16.f;
struct EpiDown {
    static constexpr bool PERM = true, AFTER_DRAIN = false;
    unsigned char* Y; const float* gate; int npn;
    __device__ __forceinline__ void operator()(const f32x4 (&acc)[2][2][4][2], const Unit& u, int wr, int wc, int fr, int fq) const {
        const int row0 = u.pm * BM + wr * 64 + fr, pnl = u.pn % npn, col0 = pnl * BM + wc * 32 + 8 * fq;
#pragma unroll
        for (int ai = 0; ai < 2; ++ai)
#pragma unroll
            for (int m = 0; m < 4; ++m) {
                const int row = row0 + ai * HALF + m * 16; const float gt = gate[row] * (W8_DESCALE * YE_SCALE);
                unsigned char* rowp = Y + (size_t)row * 2048 + col0;
#pragma unroll
                for (int bj = 0; bj < 2; ++bj) { const f32x4 v0 = acc[ai][bj][m][0] * gt, v1 = acc[ai][bj][m][1] * gt;
                    u32x2 w; w.x = cvt4_fp8(v0[0], v0[1], v0[2], v0[3]); w.y = cvt4_fp8(v1[0], v1[1], v1[2], v1[3]);
                    *(u32x2*)(rowp + bj * HALF) = w; }
            }
    }
};

template <class Epi, class Sched, bool ALIGN_EPI = false, bool SP2 = false, bool FP8 = false>
__device__ __forceinline__ void gemm_phase(PG8_LAS unsigned char* lds, const Gemm g, const Sched& S, const Epi& E) {
    const int tid = threadIdx.x, wid = __builtin_amdgcn_readfirstlane(tid >> 6), lane = tid & 63, wr = wid >> 2, wc = wid & 3, fr = lane & 15, fq = lane >> 4;
    const int K = g.Kp, nt = g.K / BK;
    const size_t kslice = (size_t)g.K * 2;
    unsigned voffA[2], voffB[2];
#pragma unroll
    for (int i = 0; i < 2; ++i) { int R, C; stage_rc(tid * 16 + i * 8192, R, C); const int Rb = Epi::PERM ? ((R & ~31) + perm32(R & 31)) : R;
        voffA[i] = (unsigned)(R * K + C) * 2u; voffB[i] = (unsigned)(Rb * K + C) * 2u; }
    static_assert(!Sched::GATHER || SP2, "gathered A rows: SP2 loop only");
    const size_t kstep = (size_t)(BK * 2);
    const size_t hstep = (size_t)HALF * K * 2;
    const size_t tstep = 2 * hstep;
    const unsigned ldsw = (unsigned)wid * 1024u;
    const int aoff = lds_byte(wr * 64 + fr, fq * 8), boff = lds_byte(wc * 32 + fr, fq * 8);
#define PG8_SA(b, h) (((b) * 2 + (h)) * HTB)
#define PG8_SB(b, h) ((4 + (b) * 2 + (h)) * HTB)
#define PG8_STAGE(bufoff, gbase, voff) do { _Pragma("unroll") for (int _i = 0; _i < 2; ++_i) \
        __builtin_amdgcn_global_load_lds((const unsigned*)((const char*)(gbase) + (voff)[_i]), (PG8_LAS unsigned*)(lds + (bufoff) + ldsw + _i * 8192), 16, 0, 0); } while (0)
#define PG8_LDA(dst, b, h) do { _Pragma("unroll") for (int m = 0; m < 4; ++m) _Pragma("unroll") for (int k = 0; k < 2; ++k) dst[m][k] = *(const PG8_LAS bf16x8*)(lds + PG8_SA(b, h) + aoff + m * 2048 + k * 1024); } while (0)
#define PG8_LDB(dst, b, h) do { _Pragma("unroll") for (int n = 0; n < 2; ++n) _Pragma("unroll") for (int k = 0; k < 2; ++k) dst[n][k] = *(const PG8_LAS bf16x8*)(lds + PG8_SB(b, h) + boff + n * 2048 + k * 1024); } while (0)
#define PG8_CAT8(x, y) __builtin_shufflevector(__builtin_bit_cast(i32x4, x), __builtin_bit_cast(i32x4, y), 0, 1, 2, 3, 4, 5, 6, 7)
#define PG8_W8(c) __builtin_shufflevector(c, c, 0, 1, 2, 3, -1, -1, -1, -1)
#define PG8_MMA(ai, bj, At, Bt) do { __builtin_amdgcn_s_setprio(1); \
        if constexpr (FP8) { f32x32 a_ = acc32[ai][bj]; _Pragma("unroll") for (int m = 0; m < 4; ++m) _Pragma("unroll") for (int n = 0; n < 2; ++n) { \
            f32x4 c_ = {a_[(m * 2 + n) * 4], a_[(m * 2 + n) * 4 + 1], a_[(m * 2 + n) * 4 + 2], a_[(m * 2 + n) * 4 + 3]}; \
            c_ = __builtin_amdgcn_mfma_scale_f32_16x16x128_f8f6f4(PG8_CAT8(Bt[n][0], Bt[n][1]), PG8_CAT8(At[m][0], At[m][1]), c_, 0, 0, 0, 0, 0, 0); \
            a_[(m * 2 + n) * 4] = c_[0]; a_[(m * 2 + n) * 4 + 1] = c_[1]; a_[(m * 2 + n) * 4 + 2] = c_[2]; a_[(m * 2 + n) * 4 + 3] = c_[3]; } acc32[ai][bj] = a_; } \
        else { _Pragma("unroll") for (int m = 0; m < 4; ++m) _Pragma("unroll") for (int n = 0; n < 2; ++n) _Pragma("unroll") for (int k = 0; k < 2; ++k) \
            acc[ai][bj][m][n] = __builtin_amdgcn_mfma_f32_16x16x32_bf16(Bt[n][k], At[m][k], acc[ai][bj][m][n], 0, 0, 0); } __builtin_amdgcn_s_setprio(0); } while (0)
#define PG8_WAIT_V(n) asm volatile("s_waitcnt vmcnt(" #n ")" ::: "memory")
#define PG8_WAIT_L(n) asm volatile("s_waitcnt lgkmcnt(" #n ")" ::: "memory")
#define PG8_BAR __builtin_amdgcn_s_barrier()
#define PG8_SCHED __builtin_amdgcn_sched_barrier(0)
    Unit cur, nxt; int ui = 0;
    if (!S.next(0, cur)) return;
    f32x4 acc[2][2][4][2]; f32x32 acc32[2][2];
#pragma unroll
    for (int a = 0; a < 2; ++a)
#pragma unroll
        for (int b = 0; b < 2; ++b)
#pragma unroll
            for (int m = 0; m < 4; ++m) {
#pragma unroll
                for (int n = 0; n < 2; ++n) { acc[a][b][m][n] = (f32x4){0.f, 0.f, 0.f, 0.f};
#pragma unroll
                    for (int i = 0; i < 4; ++i) acc32[a][b][(m * 2 + n) * 4 + i] = 0.f; } }
    bf16x8 At[4][2], B0[2][2], B1[2][2];
    const char* cA = (const char*)g.A + (size_t)cur.pm * tstep + (size_t)cur.pk * kslice; const char* cB = (const char*)g.Bt + (size_t)cur.pn * tstep + (size_t)cur.pk * kslice;
    unsigned cvA0[2], cvA1[2], nvA0[2], nvA1[2];
#pragma unroll
    for (int i = 0; i < 2; ++i) { int R, C; stage_rc(tid * 16 + i * 8192, R, C);
        if constexpr (Sched::GATHER) { cvA0[i] = (unsigned)(S.arow(cur, R) * K + C) * 2u; cvA1[i] = (unsigned)(S.arow(cur, HALF + R) * K + C) * 2u; }
        else { cvA0[i] = voffA[i]; cvA1[i] = voffA[i] + (unsigned)hstep; }
        nvA0[i] = cvA0[i]; nvA1[i] = cvA1[i]; }
    if constexpr (Sched::GATHER) cA = (const char*)g.A;
    S.a_ready(cur);
    if constexpr (SP2) {
        PG8_STAGE(PG8_SB(0, 0), cB, voffB); PG8_STAGE(PG8_SB(0, 1), cB + hstep, voffB); PG8_STAGE(PG8_SA(0, 0), cA, cvA0); PG8_STAGE(PG8_SA(0, 1), cA, cvA1);
        if (wr == 1) PG8_BAR;
        PG8_WAIT_V(2); PG8_BAR;
        PG8_STAGE(PG8_SB(1, 0), cB + kstep, voffB); PG8_STAGE(PG8_SA(1, 0), cA + kstep, cvA0); PG8_STAGE(PG8_SB(1, 1), cB + hstep + kstep, voffB);
        PG8_WAIT_V(6); PG8_BAR;
    } else {
        PG8_STAGE(PG8_SB(0, 0), cB, voffB); PG8_STAGE(PG8_SA(0, 0), cA, voffA); PG8_STAGE(PG8_SB(0, 1), cB + hstep, voffB); PG8_STAGE(PG8_SA(0, 1), cA + hstep, voffA);
        if (wr == 1) PG8_BAR;
        PG8_WAIT_V(4); PG8_BAR;
        PG8_STAGE(PG8_SB(1, 0), cB + kstep, voffB); PG8_STAGE(PG8_SA(1, 0), cA + kstep, voffA); PG8_STAGE(PG8_SB(1, 1), cB + hstep + kstep, voffB);
        PG8_WAIT_V(6); PG8_BAR;
    }
    for (;;) {
        const bool has_next = S.next(ui + 1, nxt);
        const char* nA = Sched::GATHER ? (const char*)g.A : (has_next ? (const char*)g.A + (size_t)nxt.pm * tstep + (size_t)nxt.pk * kslice : cA);
        if constexpr (Sched::GATHER) { if (has_next) {
#pragma unroll
            for (int i = 0; i < 2; ++i) { int R, C; stage_rc(tid * 16 + i * 8192, R, C); nvA0[i] = (unsigned)(S.arow(nxt, R) * K + C) * 2u; nvA1[i] = (unsigned)(S.arow(nxt, HALF + R) * K + C) * 2u; } } } const char* nB = has_next ? (const char*)g.Bt + (size_t)nxt.pn * tstep + (size_t)nxt.pk * kslice : cB;
        for (int t = 0; t < nt; t += 2) {
            const bool last = (t == nt - 2);
            const char* a1 = cA + (size_t)(t + 1) * kstep;
            const char* a2 = last ? nA : cA + (size_t)(t + 2) * kstep; const char* b2 = last ? nB : cB + (size_t)(t + 2) * kstep;
            const char* a3 = a2 + kstep; const char* b3 = b2 + kstep;
            if (last && has_next) S.a_ready(nxt);
            unsigned sA0[2], sA1[2];
#pragma unroll
            for (int i = 0; i < 2; ++i) { sA0[i] = last ? nvA0[i] : cvA0[i]; sA1[i] = last ? nvA1[i] : cvA1[i]; }
            if constexpr (SP2) {
            PG8_LDB(B0, 0, 0); PG8_LDB(B1, 0, 1); PG8_SCHED; PG8_LDA(At, 0, 0); PG8_STAGE(PG8_SA(1, 1), a1, cvA1);
            PG8_WAIT_V(8); PG8_WAIT_L(0); PG8_BAR; PG8_MMA(0, 0, At, B0); PG8_MMA(0, 1, At, B1); PG8_BAR; PG8_SCHED;
            PG8_LDA(At, 0, 1); PG8_STAGE(PG8_SB(0, 0), b2, voffB); PG8_STAGE(PG8_SB(0, 1), b2 + hstep, voffB); PG8_STAGE(PG8_SA(0, 0), a2, sA0);
            PG8_WAIT_V(8); PG8_WAIT_L(0); PG8_BAR; PG8_MMA(1, 0, At, B0); PG8_MMA(1, 1, At, B1); PG8_BAR; PG8_SCHED;
            PG8_LDB(B0, 1, 0); PG8_LDB(B1, 1, 1); PG8_SCHED; PG8_LDA(At, 1, 0); PG8_STAGE(PG8_SA(0, 1), a2, sA1);
            PG8_WAIT_V(8); PG8_WAIT_L(0); PG8_BAR; PG8_MMA(0, 0, At, B0); PG8_MMA(0, 1, At, B1); PG8_BAR; PG8_SCHED;
            PG8_LDA(At, 1, 1); PG8_STAGE(PG8_SB(1, 0), b3, voffB); PG8_STAGE(PG8_SB(1, 1), b3 + hstep, voffB); PG8_STAGE(PG8_SA(1, 0), a3, sA0);
            PG8_WAIT_V(8); PG8_WAIT_L(0); PG8_BAR; PG8_MMA(1, 0, At, B0); PG8_MMA(1, 1, At, B1); PG8_BAR; PG8_SCHED;
            } else {
            PG8_LDB(B0, 0, 0); PG8_SCHED; PG8_LDA(At, 0, 0); PG8_STAGE(PG8_SA(1, 1), a1 + hstep, voffA);
            PG8_WAIT_L(8); PG8_BAR; PG8_WAIT_L(0); PG8_MMA(0, 0, At, B0); PG8_BAR; PG8_SCHED;
            PG8_LDB(B1, 0, 1); PG8_STAGE(PG8_SB(0, 0), b2, voffB);
            PG8_BAR; PG8_WAIT_L(0); PG8_MMA(0, 1, At, B1); PG8_BAR;
            PG8_LDA(At, 0, 1); PG8_STAGE(PG8_SA(0, 0), a2, voffA);
            PG8_BAR; PG8_WAIT_L(0); PG8_MMA(1, 0, At, B0); PG8_BAR; PG8_SCHED;
            PG8_STAGE(PG8_SB(0, 1), b2 + hstep, voffB);
            PG8_WAIT_V(6); PG8_BAR; PG8_MMA(1, 1, At, B1); PG8_BAR;
            PG8_LDB(B0, 1, 0); PG8_SCHED; PG8_LDA(At, 1, 0); PG8_STAGE(PG8_SA(0, 1), a2 + hstep, voffA);
            PG8_WAIT_L(8); PG8_BAR; PG8_WAIT_L(0); PG8_MMA(0, 0, At, B0); PG8_BAR; PG8_SCHED;
            PG8_LDB(B1, 1, 1); PG8_STAGE(PG8_SB(1, 0), b3, voffB);
            PG8_BAR; PG8_WAIT_L(0); PG8_MMA(0, 1, At, B1); PG8_BAR;
            PG8_LDA(At, 1, 1); PG8_STAGE(PG8_SA(1, 0), a3, voffA);
            PG8_BAR; PG8_WAIT_L(0); PG8_MMA(1, 0, At, B0); PG8_BAR; PG8_SCHED;
            PG8_STAGE(PG8_SB(1, 1), b3 + hstep, voffB);
            PG8_WAIT_V(6); PG8_BAR; PG8_MMA(1, 1, At, B1); PG8_BAR;
            }
        }
        if constexpr (ALIGN_EPI) { if (wr == 0) PG8_BAR; }
        if constexpr (FP8) {
#pragma unroll
            for (int a = 0; a < 2; ++a)
#pragma unroll
                for (int b = 0; b < 2; ++b)
#pragma unroll
                    for (int m = 0; m < 4; ++m)
#pragma unroll
                        for (int n = 0; n < 2; ++n)
#pragma unroll
                            for (int i = 0; i < 4; ++i) acc[a][b][m][n][i] = acc32[a][b][(m * 2 + n) * 4 + i]; }
        if constexpr (!Epi::AFTER_DRAIN) { E(acc, cur, wr, wc, fr, fq); S.done(cur); }
        if (!has_next) break;
#pragma unroll
        for (int a = 0; a < 2; ++a)
#pragma unroll
            for (int b = 0; b < 2; ++b)
#pragma unroll
                for (int m = 0; m < 4; ++m) {
#pragma unroll
                    for (int n = 0; n < 2; ++n) { acc[a][b][m][n] = (f32x4){0.f, 0.f, 0.f, 0.f};
#pragma unroll
                        for (int i = 0; i < 4; ++i) acc32[a][b][(m * 2 + n) * 4 + i] = 0.f; } }
        cur = nxt; cA = nA; cB = nB; ++ui;
#pragma unroll
        for (int i = 0; i < 2; ++i) { cvA0[i] = nvA0[i]; cvA1[i] = nvA1[i]; }
        if constexpr (ALIGN_EPI) { if (wr == 1) PG8_BAR; }
    }
    PG8_WAIT_V(0);
    if constexpr (!ALIGN_EPI) { if (wr == 0) PG8_BAR; }
    PG8_BAR;
    if constexpr (Epi::AFTER_DRAIN) { E.fused(acc, cur, wr, wc, fr, fq, lds, wid, lane); S.done(cur); }
#undef PG8_SA
#undef PG8_SB
#undef PG8_STAGE
#undef PG8_LDA
#undef PG8_LDB
#undef PG8_MMA
#undef PG8_CAT8
#undef PG8_W8
#undef PG8_WAIT_V
#undef PG8_WAIT_L
#undef PG8_BAR
#undef PG8_SCHED
}
}

namespace att {
constexpr int NW = 8, QBLK = 32, KVBLK = 64;
constexpr float THR = 8.f;
constexpr int SHM_V = KVBLK * 128 * 2, SHM_K = KVBLK * 64 * 2;
constexpr int SHM_ATTN = 2 * SHM_V + 2 * SHM_K + NW * 64 * 4;
#define KSWZ64(row, colB) ((row) * 128 + ((colB) ^ ((((row) >> 1) & 7) << 4)))
#define SBAR() __builtin_amdgcn_sched_barrier(0)
__device__ __forceinline__ int crow(int r, int hi) { return (r & 3) + 8 * (r >> 2) + 4 * hi; }

__device__ __forceinline__ void partialSM(f32x16& p0, f32x16& p1, float& m_reg, float& mn, float& alpha) {
  float pmax = p0[0];
#pragma unroll
  for (int r = 1; r < 16; ++r) pmax = fmaxf(pmax, p0[r]);
#pragma unroll
  for (int r = 0; r < 16; ++r) pmax = fmaxf(pmax, p1[r]);
  { auto rr = __builtin_amdgcn_permlane32_swap(__float_as_uint(pmax), __float_as_uint(pmax), false, false);
    pmax = fmaxf(__uint_as_float(rr[0]), __uint_as_float(rr[1])); }
  if (__builtin_expect(__all(pmax - m_reg <= THR), 1)) { mn = m_reg; alpha = 1.f; }
  else { mn = fmaxf(m_reg, pmax); alpha = __builtin_amdgcn_exp2f(m_reg - mn); m_reg = mn; }
#pragma unroll
  for (int r = 0; r < 16; ++r) p0[r] = p0[r] - mn;
#pragma unroll
  for (int r = 0; r < 16; ++r) p1[r] = p1[r] - mn;
#pragma unroll
  for (int r = 0; r < 16; ++r) p0[r] = __builtin_amdgcn_exp2f(p0[r]);
}
__device__ __forceinline__ void finishSM(f32x16& p0, f32x16& p1, float alpha, float& l_reg, bf16x8& pa0, bf16x8& pa1, bf16x8& pa2, bf16x8& pa3) {
#pragma unroll
  for (int r = 0; r < 16; ++r) p1[r] = __builtin_amdgcn_exp2f(p1[r]);
  float ps = 0;
#pragma unroll
  for (int r = 0; r < 16; ++r) ps += p0[r];
#pragma unroll
  for (int r = 0; r < 16; ++r) ps += p1[r];
  { auto rr = __builtin_amdgcn_permlane32_swap(__float_as_uint(ps), __float_as_uint(ps), false, false);
    ps = __uint_as_float(rr[0]) + __uint_as_float(rr[1]); }
  l_reg = l_reg * alpha + ps;
#define PK4(P, BASE, OUT) do { unsigned a0 = cvtpk(P[BASE + 0], P[BASE + 1]), a1 = cvtpk(P[BASE + 2], P[BASE + 3]);   \
    unsigned b0 = cvtpk(P[BASE + 4], P[BASE + 5]), b1 = cvtpk(P[BASE + 6], P[BASE + 7]);                              \
    auto r0 = __builtin_amdgcn_permlane32_swap(a0, b0, false, false); auto r1 = __builtin_amdgcn_permlane32_swap(a1, b1, false, false); \
    u32x4 w = {r0[0], r1[0], r0[1], r1[1]}; OUT = __builtin_bit_cast(bf16x8, w); } while (0)
  PK4(p0, 0, pa0); PK4(p0, 8, pa1); PK4(p1, 0, pa2); PK4(p1, 8, pa3);
#undef PK4
}
__device__ __forceinline__ void qkt(f32x16& p0, f32x16& p1, const char* Ks, const bf16x8* qr, int r32, int hi) {
  p0 = f32x16{}; p1 = f32x16{};
#pragma unroll
  for (int d0 = 0; d0 < 4; ++d0) { const int cb = (d0 * 16 + hi * 8) * 2;
    bf16x8 b0 = *reinterpret_cast<const bf16x8*>(Ks + KSWZ64(r32, cb));
    bf16x8 b1 = *reinterpret_cast<const bf16x8*>(Ks + KSWZ64(32 + r32, cb));
    p0 = __builtin_amdgcn_mfma_f32_32x32x16_bf16(b0, qr[d0], p0, 0, 0, 0);
    p1 = __builtin_amdgcn_mfma_f32_32x32x16_bf16(b1, qr[d0], p1, 0, 0, 0); }
}
__device__ __forceinline__ int v_st(int k, int c) { const int kk = (k & ~0xC) | ((k & 4) << 1) | ((k & 8) >> 1); return ((kk >> 3) * 4 + (c >> 5)) * 512 + ((kk & 7) * 32 + (c & 31)) * 2; }
__device__ __forceinline__ int v_rd_base(int lane) { return ((lane & 3) << 3) | (((lane >> 2) & 3) << 6) | (((lane >> 4) & 1) << 5) | (((lane >> 5) & 1) << 8); }
constexpr int v_rd_off(int d0, int ks, int half) { return d0 * 512 + ks * 4096 + half * 2048; }
template <int OFF> __device__ __forceinline__ s16x4 tr_read(int vb) {
  s16x4 r; asm volatile("ds_read_b64_tr_b16 %0, %1 offset:%2" : "=&v"(r) : "v"(vb), "i"(OFF) : "memory"); return r;
}
template <int D0> __device__ __forceinline__ void pv_one(f32x16& od, int vb, bf16x8 pa0, bf16x8 pa1, bf16x8 pa2, bf16x8 pa3) {
  const s16x4 l0 = tr_read<v_rd_off(D0, 0, 0)>(vb), h0 = tr_read<v_rd_off(D0, 0, 1)>(vb), l1 = tr_read<v_rd_off(D0, 1, 0)>(vb), h1 = tr_read<v_rd_off(D0, 1, 1)>(vb);
  const s16x4 l2 = tr_read<v_rd_off(D0, 2, 0)>(vb), h2 = tr_read<v_rd_off(D0, 2, 1)>(vb), l3 = tr_read<v_rd_off(D0, 3, 0)>(vb), h3 = tr_read<v_rd_off(D0, 3, 1)>(vb);
  asm volatile("s_waitcnt lgkmcnt(0)" ::: "memory"); SBAR();
#define PK(L, H) (bf16x8){L[0], L[1], L[2], L[3], H[0], H[1], H[2], H[3]}
  od = __builtin_amdgcn_mfma_f32_32x32x16_bf16(pa0, PK(l0, h0), od, 0, 0, 0);
  od = __builtin_amdgcn_mfma_f32_32x32x16_bf16(pa1, PK(l1, h1), od, 0, 0, 0);
  od = __builtin_amdgcn_mfma_f32_32x32x16_bf16(pa2, PK(l2, h2), od, 0, 0, 0);
  od = __builtin_amdgcn_mfma_f32_32x32x16_bf16(pa3, PK(l3, h3), od, 0, 0, 0);
#undef PK
}
__device__ __forceinline__ void pv_d0(f32x16* o, int vb, bf16x8 pa0, bf16x8 pa1, bf16x8 pa2, bf16x8 pa3) {
  pv_one<0>(o[0], vb, pa0, pa1, pa2, pa3); pv_one<1>(o[1], vb, pa0, pa1, pa2, pa3); pv_one<2>(o[2], vb, pa0, pa1, pa2, pa3); pv_one<3>(o[3], vb, pa0, pa1, pa2, pa3);
}

template <int LDQ>
__device__ __forceinline__ void attn_unit(const bf16_t* __restrict__ Qb, const bf16_t* __restrict__ Kh, const bf16_t* __restrict__ Vh, bf16_t* __restrict__ Ob, int seq, char* lds) {
  const int tid = threadIdx.x, wid = tid >> 6, lane = tid & 63, r32 = lane & 31, hi = lane >> 5;
  char* V_lds = lds; char* K_lds = lds + 2 * SHM_V;
  float* ws = (float*)(lds + 2 * SHM_V + 2 * SHM_K) + wid * 64; float* li_l = ws; float* al_l = ws + 32;
  float m_reg = -1e30f, l_reg = 0; f32x16 o[4] = {}; bf16x8 qr[4];
  const bf16_t* Qw = Qb + (long)(wid * QBLK + r32) * LDQ + hi * 8;
#pragma unroll
  for (int d0 = 0; d0 < 4; ++d0) qr[d0] = *reinterpret_cast<const bf16x8*>(Qw + d0 * 16);
  const int sr = tid >> 4, sc = (tid & 15) * 8, vst0 = v_st(sr, sc), vst1 = v_st(32 + sr, sc);
  const int kr = tid >> 3, kc8 = (tid & 7) * 8, kst = KSWZ64(kr, kc8 * 2);
  const int vb0 = (int)(uintptr_t)V_lds + v_rd_base(lane);
  struct { bf16x8 vs0, vs1, ks; } sr_[2];
  const bf16_t* Vp0 = Vh + (long)sr * LDQ + sc; const bf16_t* Kp0 = Kh + (long)kr * LDQ + kc8;
#define SLOAD(i, k0) do { const long ko_ = (long)(k0) * LDQ; sr_[i].vs0 = *reinterpret_cast<const bf16x8*>(Vp0 + ko_); sr_[i].vs1 = *reinterpret_cast<const bf16x8*>(Vp0 + ko_ + 32 * LDQ); \
    sr_[i].ks = *reinterpret_cast<const bf16x8*>(Kp0 + ko_); } while (0)
#define SWRITE(b, i) do { *(bf16x8*)(V_lds + (b) * SHM_V + vst0) = sr_[i].vs0; *(bf16x8*)(V_lds + (b) * SHM_V + vst1) = sr_[i].vs1; \
    *(bf16x8*)(K_lds + (b) * SHM_K + kst) = sr_[i].ks; } while (0)
#define SWAIT() asm volatile("s_waitcnt vmcnt(3)" ::: "memory")
#define RESC(a) do { if (__any((a) < 1.f)) { if (hi == 0) al_l[r32] = (a); asm volatile("s_waitcnt lgkmcnt(0)" ::: "memory"); \
    _Pragma("unroll") for (int d = 0; d < 4; ++d) _Pragma("unroll") for (int r = 0; r < 16; ++r) o[d][r] *= al_l[crow(r, hi)]; } } while (0)
  f32x16 pA0, pA1, pB0, pB1; float mnA, mnB, alA, alB; bf16x8 pa0, pa1, pa2, pa3; const int NT = seq / KVBLK;
  constexpr int SE = 0, SO = 1;
  SLOAD(SE, 0); asm volatile("s_waitcnt vmcnt(0)" ::: "memory"); SWRITE(0, SE); __syncthreads();
  qkt(pA0, pA1, K_lds, qr, r32, hi); partialSM(pA0, pA1, m_reg, mnA, alA);
  SLOAD(SO, KVBLK); if (2 < NT) SLOAD(SE, 2 * KVBLK);
  SWAIT(); SWRITE(1, SO); __syncthreads();
  for (int j = 1; j + 1 < NT; j += 2) {
    SBAR(); qkt(pB0, pB1, K_lds + SHM_K, qr, r32, hi);
    finishSM(pA0, pA1, alA, l_reg, pa0, pa1, pa2, pa3); SBAR();
    SLOAD(SO, (j + 2) * KVBLK); SBAR();
    pv_d0(o, vb0, pa0, pa1, pa2, pa3); partialSM(pB0, pB1, m_reg, mnB, alB);
    __syncthreads(); SWAIT(); SWRITE(0, SE);
    RESC(alB); __syncthreads();
    SBAR(); qkt(pA0, pA1, K_lds, qr, r32, hi);
    finishSM(pB0, pB1, alB, l_reg, pa0, pa1, pa2, pa3); SBAR();
    if (j + 3 < NT) SLOAD(SE, (j + 3) * KVBLK); SBAR();
    pv_d0(o, vb0 + SHM_V, pa0, pa1, pa2, pa3); partialSM(pA0, pA1, m_reg, mnA, alA);
    __syncthreads(); SWAIT(); SWRITE(1, SO);
    RESC(alA); __syncthreads();
  }
  SBAR(); qkt(pB0, pB1, K_lds + SHM_K, qr, r32, hi);
  finishSM(pA0, pA1, alA, l_reg, pa0, pa1, pa2, pa3); SBAR();
  pv_d0(o, vb0, pa0, pa1, pa2, pa3); partialSM(pB0, pB1, m_reg, mnB, alB);
  __syncthreads(); RESC(alB);
  finishSM(pB0, pB1, alB, l_reg, pa0, pa1, pa2, pa3); SBAR();
  pv_d0(o, vb0 + SHM_V, pa0, pa1, pa2, pa3);
  if (hi == 0) li_l[r32] = l_reg; asm volatile("s_waitcnt lgkmcnt(0)" ::: "memory");
  float rli[16];
#pragma unroll
  for (int r = 0; r < 16; ++r) rli[r] = __builtin_amdgcn_rcpf(li_l[crow(r, hi)]);
  bf16_t* Ow = Ob + (long)(wid * QBLK) * 1024;
#pragma unroll
  for (int r = 0; r < 16; ++r) { const int orow = crow(r, hi);
#pragma unroll
    for (int d0 = 0; d0 < 4; ++d0) Ow[(long)orow * 1024 + d0 * 32 + r32] = (bf16_t)(cvtpk(o[d0][r] * rli[r], 0.f) & 0xffffu); }
  __syncthreads();
#undef SLOAD
#undef SWRITE
#undef SWAIT
#undef RESC
}
#undef SBAR
}


typedef GAS unsigned gu32;
#define RLX_AGENT __ATOMIC_RELAXED, __HIP_MEMORY_SCOPE_AGENT
#define XB_TMO      128
#define XB_XCNT(j)  (256  + 64 * (j))
#define XB_XSUB(j)  (1280 + 64 * (j))
#define XB_XGEN(j)  (2304 + 64 * (j))
#define XB_TOP      3328
#define XB_TOPGEN   3392
#define XCD_BAR_WORDS 3456
#define XB_SPIN_CAP (1u << 22)
__device__ __forceinline__ unsigned xb_ld(unsigned* p)              { return __hip_atomic_load(p, __ATOMIC_RELAXED, __HIP_MEMORY_SCOPE_AGENT); }
__device__ __forceinline__ unsigned xb_add(unsigned* p, unsigned v) { return __hip_atomic_fetch_add(p, v, __ATOMIC_RELAXED, __HIP_MEMORY_SCOPE_AGENT); }
__device__ __forceinline__ unsigned xb_xcc_id() { return (unsigned)__builtin_amdgcn_s_getreg((3 << 11) | 20) & 0xFu; }
#define XB_SPIN(cond, bar) do { unsigned _sp = 0; while (cond) { __builtin_amdgcn_s_sleep(1); \
    if ((++_sp & 255u) == 0u) { if (xb_ld(&(bar)[XB_TMO])) break; if (_sp > XB_SPIN_CAP) { atomicAdd(&(bar)[XB_TMO], 1u); break; } } } } while (0)
struct XcdBarrier { unsigned* bar; unsigned x; volatile LAS unsigned* st; };
__device__ __forceinline__ XcdBarrier xcd_barrier_post(unsigned* bar, volatile LAS unsigned* st) {
    XcdBarrier b; b.bar = bar; b.x = xb_xcc_id(); b.st = st;
    if (threadIdx.x == 0) (void)xb_add(&bar[XB_XCNT(b.x)], 1u);
    return b;
}
__device__ __forceinline__ void xcd_barrier_complete(unsigned* bar, unsigned x, unsigned& nloc, unsigned& nx) {
    const unsigned G = gridDim.x * gridDim.y * gridDim.z;
    unsigned sum, cnt, mine, sp = 0u;
    for (;;) {
        sum = 0u; cnt = 0u; mine = 0u;
#pragma unroll
        for (unsigned j = 0; j < 16; ++j) { const unsigned c = xb_ld(&bar[XB_XCNT(j)]); sum += c; cnt += (c > 0u) ? 1u : 0u; mine = (j == x) ? c : mine; }
        if (sum == G) break;
        __builtin_amdgcn_s_sleep(1);
        if ((++sp & 255u) == 0u) { if (xb_ld(&bar[XB_TMO])) break; if (sp > XB_SPIN_CAP) { atomicAdd(&bar[XB_TMO], 1u); break; } }
    }
    nloc = mine > 0u ? mine : 1u; nx = cnt > 0u ? cnt : 1u;
}
__device__ __forceinline__ void xcd_barrier(const XcdBarrier& b) {
    asm volatile("s_waitcnt vmcnt(0)" ::: "memory");
    __syncthreads();
    if (threadIdx.x == 0) {
        unsigned* bar = b.bar;
        __builtin_amdgcn_s_waitcnt(0);
        unsigned nloc = b.st[0], nx = b.st[1];
        if (nloc == 0u) { xcd_barrier_complete(bar, b.x, nloc, nx); b.st[0] = nloc; b.st[1] = nx; }
        const unsigned old = xb_add(&bar[XB_XSUB(b.x)], 1u);
        const unsigned gen = old / nloc;
        if (old + 1u == (gen + 1u) * nloc) {
            __builtin_amdgcn_fence(__ATOMIC_RELEASE, "agent");
            asm volatile("s_waitcnt vmcnt(0)" ::: "memory");
            const unsigned og = xb_add(&bar[XB_TOP], 1u);
            const unsigned tg = og / nx;
            if (og + 1u == (tg + 1u) * nx) xb_add(&bar[XB_TOPGEN], 1u);
            else XB_SPIN(xb_ld(&bar[XB_TOPGEN]) == tg, bar);
            __builtin_amdgcn_fence(__ATOMIC_ACQUIRE, "agent");
            xb_add(&bar[XB_XGEN(b.x)], 1u);
            asm volatile("s_waitcnt vmcnt(0)" ::: "memory");
        } else {
            XB_SPIN(xb_ld(&bar[XB_XGEN(b.x)]) == gen, bar);
            __builtin_amdgcn_fence(__ATOMIC_ACQUIRE, "agent");
            asm volatile("s_waitcnt vmcnt(0)" ::: "memory");
        }
    }
    __syncthreads();
}

struct Frame {
    LAS unsigned char* lds; char* ldsg;
    int tid, lane, wave, vcu, G;
    const Args* a;
};
#define INP(F, i, T) ((const T*)(F).a->in[i])
#define WSP(F, off, T) ((T*)((F).a->ws + (off)))

__device__ __forceinline__ void cvt_load(f32x4 (&v)[16], const float* __restrict__ W, int N, int nvalid, int k0, int n0, int lane) {
    const int kq = lane >> 4, nq = lane & 15;
    const unsigned voff = (unsigned)(kq * N + 4 * nq) * 4u;
#pragma unroll
    for (int i = 0; i < 16; ++i) {
        const char* Wu = (const char*)(W + (size_t)(k0 + 4 * i) * N + n0);
        if (4 * nq < nvalid) v[i] = __builtin_nontemporal_load((const f32x4*)(Wu + (size_t)voff)); else v[i] = (f32x4){0.f, 0.f, 0.f, 0.f};
    }
}
__device__ __forceinline__ void cvt_finish(const f32x4 (&v)[16], int k0, bf16_t* __restrict__ WT, int rowb, LAS unsigned char* scr, int lane) {
    const int kq = lane >> 4, nq = lane & 15;
    const int g = lane >> 4, i16 = lane & 15, q = i16 >> 2, p = i16 & 3;
    typedef short v4i16_t __attribute__((ext_vector_type(4)));
#pragma unroll
    for (int hf = 0; hf < 2; ++hf) {
#pragma unroll
        for (int i = 0; i < 8; ++i) {
            const int k = 4 * i + kq, s = ((k >> 1) & 1) | (((k >> 3) & 1) << 1);
            u32x2 w; w.x = cvtpk(v[8 * hf + i].x, v[8 * hf + i].y); w.y = cvtpk(v[8 * hf + i].z, v[8 * hf + i].w);
            *(LAS u32x2*)(scr + k * 128 + ((nq * 8) ^ (s << 5))) = w;
        }
        const int klo = 8 * g + q, s = ((klo >> 1) & 1) | (((klo >> 3) & 1) << 1);
#pragma unroll
        for (int nb = 0; nb < 4; ++nb) {
            const int a_lo = klo * 128 + (((16 * nb + 4 * p) * 2) ^ (s << 5));
            const s16x4 lo = __builtin_bit_cast(s16x4, __builtin_amdgcn_ds_read_tr16_b64_v4i16((LAS v4i16_t*)(scr + a_lo)));
            const s16x4 hi = __builtin_bit_cast(s16x4, __builtin_amdgcn_ds_read_tr16_b64_v4i16((LAS v4i16_t*)(scr + a_lo + 512)));
            bf16x8 o = {lo[0], lo[1], lo[2], lo[3], hi[0], hi[1], hi[2], hi[3]};
            char* Wu = (char*)(WT + (size_t)(rowb + 16 * nb) * 2048 + k0 + 32 * hf);
            __builtin_nontemporal_store(o, (bf16x8*)(Wu + (size_t)(unsigned)((i16 * 2048 + 8 * g) * 2)));
        }
    }
}
__device__ __forceinline__ void cvt8_load(f32x4 (&v)[16], const float* __restrict__ W, int k0, int n0, int lane) {
    const int kq = lane >> 4, nq = lane & 15;
    const unsigned voff = (unsigned)(16 * kq * 2048 + 4 * nq) * 4u;
#pragma unroll
    for (int i = 0; i < 16; ++i) {
        const char* Wu = (const char*)(W + (size_t)(k0 + i) * 2048 + n0);
        v[i] = __builtin_nontemporal_load((const f32x4*)(Wu + (size_t)voff));
    }
}
__device__ __forceinline__ void cvt8_finish(const f32x4 (&v)[16], int k0, unsigned char* __restrict__ W8, int rowb, int lane) {
    const int kq = lane >> 4, nq = lane & 15;
    char* Wu = (char*)(W8 + (size_t)rowb * 2048 + k0);
    const unsigned voff = (unsigned)(4 * nq * 2048 + 16 * kq);
#pragma unroll
    for (int j = 0; j < 4; ++j) {
        u32x4 o;
#pragma unroll
        for (int q = 0; q < 4; ++q) {
            int w = __builtin_amdgcn_cvt_pk_fp8_f32(v[4 * q][j] * pg8::W8_SCALE, v[4 * q + 1][j] * pg8::W8_SCALE, 0, false);
            w = __builtin_amdgcn_cvt_pk_fp8_f32(v[4 * q + 2][j] * pg8::W8_SCALE, v[4 * q + 3][j] * pg8::W8_SCALE, w, true);
            o[q] = (unsigned)w;
        }
        __builtin_nontemporal_store(o, (u32x4*)(Wu + (size_t)(voff + (unsigned)(j * 2048))));
    }
}
__device__ __forceinline__ void cvt_expert_decode(const Frame& F, int r, const float*& W, int& k0, int& n0, unsigned char*& WT, int& rowb) {
    constexpr int I_E = 16 * 32 * 32;
    const int mat = r / I_E; r -= mat * I_E;
    const int e = r >> 10, kt = (r >> 5) & 31, nt = r & 31;
    k0 = kt * 64; n0 = nt * 64;
    if (mat < 2) { W = INP(F, 24 + mat, float) + (size_t)e * 2048 * 2048; WT = WSP(F, WS_WGU, unsigned char); rowb = e * 4096 + (n0 >> 7) * 256 + mat * 128 + (n0 & 127); }
    else { W = INP(F, 26, float) + (size_t)e * 2048 * 2048; WT = WSP(F, WS_WD, unsigned char); rowb = e * 2048 + n0; }
}
constexpr int N_EXPERT_ITEMS = 3 * 16 * 32 * 32;
__device__ __forceinline__ void p0_prologue(Frame& F) {
    LAS unsigned char* scr = F.lds + F.wave * 4096;
    const int gw = F.vcu * 8 + F.wave, NGW = F.G * 8, lane = F.lane;
    const float* w_in = INP(F, 3, float); const float* w_out = INP(F, 21, float);
    bf16_t* WinT = WSP(F, WS_WIN, bf16_t); bf16_t* WoutT = WSP(F, WS_WOUT, bf16_t);
    constexpr int I_IN = 32 * 101, I_OUT = 32 * 32, NITEMS = I_IN + I_OUT;
    for (int it = gw; it < NITEMS; it += NGW) {
        f32x4 v[16];
        if (it < I_IN) { const int kt = it / 101, nt = it % 101; const int nv = (nt == 100) ? 32 : 64; cvt_load(v, w_in, IN_COLS, nv, kt * 64, nt * 64, lane); cvt_finish(v, kt * 64, WinT, nt * 64, scr, lane); }
        else { const int r = it - I_IN, kt = r >> 5, nt = r & 31; cvt_load(v, w_out, 2048, 64, kt * 64, nt * 64, lane); cvt_finish(v, kt * 64, WoutT, nt * 64, scr, lane); }
    }
#if !CVT_IN_SCAN
    for (int it = gw; it < N_EXPERT_ITEMS; it += NGW) {
        f32x4 v[16]; const float* W; int k0, n0, rowb; unsigned char* WT;
        cvt_expert_decode(F, it, W, k0, n0, WT, rowb); cvt8_load(v, W, k0, n0, lane); cvt8_finish(v, k0, WT, rowb, lane);
    }
#endif
    { u32x4 z = {0u, 0u, 0u, 0u}; u32x4* zp = (u32x4*)(WinT + (size_t)6464 * 2048); const int nz = 192 * 2048 * 2 / 16;
      for (int i = gw * 64 + lane; i < nz; i += NGW * 64) zp[i] = z; }
    { const float* x = INP(F, 0, float); const float* nw = INP(F, 2, float); bf16_t* H1 = WSP(F, WS_H1, bf16_t);
      for (int m = gw; m < MTOK; m += NGW) {
          const f32x4* xr = (const f32x4*)(x + (size_t)m * DM) + lane; f32x4 v[8]; float s = 0.f;
#pragma unroll
          for (int j = 0; j < 8; ++j) { v[j] = xr[64 * j]; s += (v[j].x * v[j].x + v[j].y * v[j].y) + (v[j].z * v[j].z + v[j].w * v[j].w); }
          const float rstd = 1.f / sqrtf(wave_sum(s) * (1.f / DM) + 1e-6f);
          u32x2* o8 = (u32x2*)(H1 + (size_t)m * DM) + lane;
#pragma unroll
          for (int j = 0; j < 8; ++j) { const f32x4 w = ((const f32x4*)nw)[lane + 64 * j]; u32x2 o; o.x = cvtpk(v[j].x * rstd * w.x, v[j].y * rstd * w.y); o.y = cvtpk(v[j].z * rstd * w.z, v[j].w * rstd * w.w); o8[64 * j] = o; }
      } }
    { const float* dup = INP(F, 12, float); const float* iup = INP(F, 14, float); const float* gup = INP(F, 15, float);
      bf16_t* DUt = WSP(F, WS_LORA, bf16_t); bf16_t* IUt = DUt + 2 * 1024 * 64; bf16_t* GUt = IUt + 2 * 1024 * 64;
      for (int i = gw * 64 + lane; i < 2 * 1024 * 64; i += NGW * 64) { const int j = i & 63, c = (i >> 6) & 1023, d = i >> 16;
          DUt[i] = (bf16_t)(cvtpk(dup[(size_t)(d * 64 + j) * 1024 + c], 0.f) & 0xffffu); IUt[i] = (bf16_t)(cvtpk(iup[(size_t)(d * 64 + j) * 1024 + c], 0.f) & 0xffffu); }
      for (int i = gw * 64 + lane; i < 1024 * 160; i += NGW * 64) { const int c = i / 160, j = i - c * 160; GUt[i] = (bf16_t)(cvtpk(gup[(size_t)j * 1024 + c], 0.f) & 0xffffu); } }
    { const int* pos = INP(F, 1, int); float* rope = WSP(F, WS_ROPE, float);
      const float invf[8] = {1.0f, 0.19392274474868576f, 0.03760603093086393f, 0.007292664737217109f, 0.001414213562373095f, 0.0002742481756762073f, 5.318295896944988e-05f, 1.031338537721246e-05f};
      for (int i = gw * 64 + lane; i < MTOK * 8; i += NGW * 64) { const int m = i >> 3, j = i & 7; float fj = invf[0];
#pragma unroll
          for (int q = 1; q < 8; ++q) fj = (j == q) ? invf[q] : fj;
          const float ang = (float)pos[m] * fj; rope[m * 16 + j] = cosf(ang); rope[m * 16 + 8 + j] = sinf(ang); } }
}

#define WS32(F, T, byteoff) (*(T*)((F).a->ws + (size_t)(unsigned)(byteoff)))
template <int CTRL> __device__ __forceinline__ float dpp_add(float x) {
    return x + __int_as_float(__builtin_amdgcn_update_dpp(0, __float_as_int(x), CTRL, 0xf, 0xf, false));
}
__device__ __forceinline__ float row16_allsum(float x) { x = dpp_add<0x128>(x); x = dpp_add<0x124>(x); x = dpp_add<0x122>(x); x = dpp_add<0x121>(x); return x; }
__device__ __forceinline__ bf16_t f2bf(float x) { return (bf16_t)(cvtpk(x, 0.f) & 0xffffu); }
__device__ __forceinline__ u32x4 ld_row16(const Frame& F, unsigned off, bool ok) { u32x4 r = {0u, 0u, 0u, 0u}; if (ok) r = WS32(F, const u32x4, off); return r; }
__device__ __forceinline__ void unpack8(const u32x4 w, float (&o)[8]) { o[0] = bf_lo(w.x); o[1] = bf_hi(w.x); o[2] = bf_lo(w.y); o[3] = bf_hi(w.y); o[4] = bf_lo(w.z); o[5] = bf_hi(w.z); o[6] = bf_lo(w.w); o[7] = bf_hi(w.w); }
__device__ __forceinline__ void ld8f(const float* p, float (&o)[8]) { const f32x4 a = ((const f32x4*)p)[0], b = ((const f32x4*)p)[1]; o[0] = a.x; o[1] = a.y; o[2] = a.z; o[3] = a.w; o[4] = b.x; o[5] = b.y; o[6] = b.z; o[7] = b.w; }
__device__ __forceinline__ u32x4 pack8(const float (&v)[8]) { return (u32x4){cvtpk(v[0], v[1]), cvtpk(v[2], v[3]), cvtpk(v[4], v[5]), cvtpk(v[6], v[7])}; }
__device__ __forceinline__ void p3_prep(Frame& F, const int mode = 0) {
    constexpr int AP = 296;
    constexpr int PP = 264, PA = 16 * PP, PT = 5 * PA;
    LAS bf16_t* Al = (LAS bf16_t*)F.lds;
    LAS bf16_t* Pl = (LAS bf16_t*)(F.lds + 18944);
    LAS float* Zr = (LAS float*)(F.lds + 18944);
    LAS float* Zl = (LAS float*)(F.lds + 18944 + 20736);
    const int tid = F.tid, lane = F.lane, w = F.wave;
    const bf16_t* DUt = WSP(F, WS_LORA, bf16_t); const bf16_t* IUt = DUt + 2 * 1024 * 64; const bf16_t* GUt = IUt + 2 * 1024 * 64;
    for (int item = F.vcu; item < MTOK / 32; item += F.G) {
        __syncthreads();
#pragma unroll 1
        for (int tl = 0; tl < 2; ++tl) {
            const int m0 = item * 32 + tl * 16, t0 = m0 & (SEQ - 1);
            for (int p = tid; p < 18 * 36; p += 512) {
                const int rr = p / 36, ch = p - rr * 36, t = t0 + rr - 1, m = m0 + rr - 1;
                f32x4 a0 = {0.f, 0.f, 0.f, 0.f}, a1 = a0;
                if (t >= 0 && t < SEQ) {
                    const bf16_t* pp = WSP(F, WS_PART, bf16_t) + (((size_t)((ch >> 5) * 32 + (m >> 8)) * 4) << 16) + (size_t)(m & 255) * 256 + ((8 * ch) & 255);
                    u32x4 q[4];
#pragma unroll
                    for (int k = 0; k < 4; ++k) q[k] = *(const u32x4*)(pp + ((size_t)k << 16));
#pragma unroll
                    for (int k = 0; k < 4; ++k) { a0 += (f32x4){bf_lo(q[k].x), bf_hi(q[k].x), bf_lo(q[k].y), bf_hi(q[k].y)}; a1 += (f32x4){bf_lo(q[k].z), bf_hi(q[k].z), bf_lo(q[k].w), bf_hi(q[k].w)}; }
                }
                LAS f32x4* zp = (LAS f32x4*)(Zr + rr * 288 + 8 * ch); zp[0] = a0; zp[1] = a1;
            }
            __syncthreads();
            for (int p = tid; p < 16 * 36; p += 512) {
                const int i = p / 36, ch = p - i * 36, zc = 3072 + 8 * ch;
                float c[8], pv[8], nx[8], mp[8], mn[8];
                { const LAS f32x4* q = (const LAS f32x4*)(Zr + i * 288 + 8 * ch); const f32x4 x0 = q[0], x1 = q[1], y0 = q[72], y1 = q[73], w0 = q[144], w1 = q[145];
                  pv[0] = x0.x; pv[1] = x0.y; pv[2] = x0.z; pv[3] = x0.w; pv[4] = x1.x; pv[5] = x1.y; pv[6] = x1.z; pv[7] = x1.w;
                  c[0] = y0.x; c[1] = y0.y; c[2] = y0.z; c[3] = y0.w; c[4] = y1.x; c[5] = y1.y; c[6] = y1.z; c[7] = y1.w;
                  nx[0] = w0.x; nx[1] = w0.y; nx[2] = w0.z; nx[3] = w0.w; nx[4] = w1.x; nx[5] = w1.y; nx[6] = w1.z; nx[7] = w1.w; }
                ld8f(INP(F, 4, float) + zc, mp); ld8f(INP(F, 5, float) + zc, mn);
                LAS f32x4* zp = (LAS f32x4*)(Zl + i * 288 + 8 * ch); float z[8];
#pragma unroll
                for (int e = 0; e < 8; ++e) z[e] = c[e] + mp[e] * (pv[e] - c[e]) + mn[e] * (nx[e] - c[e]);
                zp[0] = (f32x4){z[0], z[1], z[2], z[3]}; zp[1] = (f32x4){z[4], z[5], z[6], z[7]};
            }
            __syncthreads();
            for (int e = tid; e < 16 * 288; e += 512) { const int i = e / 288, j = e - i * 288; float z = Zl[e];
                if (j < 64) z = 1.f - 2.f * __builtin_amdgcn_rcpf(__expf(2.f * z) + 1.f); else if (j >= 128) z = __builtin_amdgcn_rcpf(1.f + __expf(-z));
                Al[tl * 16 * AP + i * AP + j] = f2bf(z); }
        }
        __syncthreads();
        if (mode == 1) continue;
        const int chk = tid & 31, pidx = tid >> 5, tb = pidx >> 3, tp = pidx & 7;
        const int m0t = item * 32 + tb * 16, t0t = m0t & (SEQ - 1);
#pragma unroll 1
        for (int qi = 0; qi < 4; ++qi) {
            const int q = (qi + (F.vcu >> 2)) & 3;
            u32x4 rawr[4], rawk[4], rawv[4];
            { const unsigned off = (unsigned)WS_PROJ + ((unsigned)(m0t + 2 * tp) * LDP + ZC0 + 256 * q + 8 * chk) * 2u;
#pragma unroll
              for (int rr = 0; rr < 4; ++rr) { const int t = t0t + 2 * tp + rr - 1; const bool ok = (t >= 0) && (t < SEQ); const unsigned o = off + (unsigned)((rr - 1) * LDP * 2);
                  rawr[rr] = ld_row16(F, o, ok); rawk[rr] = ld_row16(F, o + 1024u * 2u, ok); rawv[rr] = ld_row16(F, o + 2048u * 2u, ok); } }
            {
                const int n16 = lane & 15, q4 = lane >> 4;
                struct BF { bf16x8 d0[2], d1[2], i0[2], i1[2], g[5]; };
#define LD_BF(X, nb_) do { const int cl_ = 256 * q + 32 * w + 16 * (nb_) + n16; _Pragma("unroll") for (int ks = 0; ks < 2; ++ks) { \
                    X.d0[ks] = *(const bf16x8*)(DUt + (size_t)cl_ * 64 + 32 * ks + 8 * q4); X.d1[ks] = *(const bf16x8*)(DUt + (size_t)(1024 + cl_) * 64 + 32 * ks + 8 * q4); \
                    X.i0[ks] = *(const bf16x8*)(IUt + (size_t)cl_ * 64 + 32 * ks + 8 * q4); X.i1[ks] = *(const bf16x8*)(IUt + (size_t)(1024 + cl_) * 64 + 32 * ks + 8 * q4); } \
                    _Pragma("unroll") for (int ks = 0; ks < 5; ++ks) X.g[ks] = *(const bf16x8*)(GUt + (size_t)cl_ * 160 + 32 * ks + 8 * q4); } while (0)
#define DO_NB(X, nb_, tl_) do { const int ch_ = 32 * w + 16 * (nb_); \
                    f32x4 aw0 = {0.f, 0.f, 0.f, 0.f}, aw1 = aw0, aa0 = aw0, aa1 = aw0, ag = aw0; \
                    _Pragma("unroll") for (int ks = 0; ks < 2; ++ks) { \
                        aw0 = __builtin_amdgcn_mfma_f32_16x16x32_bf16(X.d0[ks], af[ks], aw0, 0, 0, 0); aw1 = __builtin_amdgcn_mfma_f32_16x16x32_bf16(X.d1[ks], af[ks], aw1, 0, 0, 0); \
                        aa0 = __builtin_amdgcn_mfma_f32_16x16x32_bf16(X.i0[ks], af[2 + ks], aa0, 0, 0, 0); aa1 = __builtin_amdgcn_mfma_f32_16x16x32_bf16(X.i1[ks], af[2 + ks], aa1, 0, 0, 0); } \
                    _Pragma("unroll") for (int ks = 0; ks < 5; ++ks) ag = __builtin_amdgcn_mfma_f32_16x16x32_bf16(X.g[ks], af[4 + ks], ag, 0, 0, 0); \
                    LAS bf16_t* pp = Pl + (tl_) * PT + n16 * PP + ch_ + 4 * q4; \
                    *(LAS u32x2*)(pp) = (u32x2){cvtpk(aw0[0], aw0[1]), cvtpk(aw0[2], aw0[3])}; *(LAS u32x2*)(pp + PA) = (u32x2){cvtpk(aw1[0], aw1[1]), cvtpk(aw1[2], aw1[3])}; \
                    *(LAS u32x2*)(pp + 2 * PA) = (u32x2){cvtpk(aa0[0], aa0[1]), cvtpk(aa0[2], aa0[3])}; *(LAS u32x2*)(pp + 3 * PA) = (u32x2){cvtpk(aa1[0], aa1[1]), cvtpk(aa1[2], aa1[3])}; \
                    *(LAS u32x2*)(pp + 4 * PA) = (u32x2){cvtpk(ag[0], ag[1]), cvtpk(ag[2], ag[3])}; } while (0)
                BF fa, fb; LD_BF(fa, 0); LD_BF(fb, 1);
#pragma unroll
                for (int tl = 0; tl < 2; ++tl) {
                    bf16x8 af[9];
#pragma unroll
                    for (int ks = 0; ks < 9; ++ks) af[ks] = *(const LAS bf16x8*)(Al + tl * 16 * AP + n16 * AP + 32 * ks + 8 * q4);
                    DO_NB(fa, 0, tl); DO_NB(fb, 1, tl);
                }
#undef LD_BF
#undef DO_NB
            }
            __syncthreads();
            if (mode != 2) {
                const int c = 256 * q + 8 * chk;
                float r4[4][8], k4[4][8], v4[4][8];
#pragma unroll
                for (int rr = 0; rr < 4; ++rr) { unpack8(rawr[rr], r4[rr]); unpack8(rawk[rr], k4[rr]); unpack8(rawv[rr], v4[rr]); }
                float zr[2][8], zk[2][8], zv[2][8];
                { float mp[8], mn[8];
                  ld8f(INP(F, 4, float) + c, mp); ld8f(INP(F, 5, float) + c, mn);
#pragma unroll
                  for (int tk = 0; tk < 2; ++tk)
#pragma unroll
                      for (int e = 0; e < 8; ++e) zr[tk][e] = r4[tk + 1][e] + mp[e] * (r4[tk][e] - r4[tk + 1][e]) + mn[e] * (r4[tk + 2][e] - r4[tk + 1][e]);
                  ld8f(INP(F, 4, float) + 1024 + c, mp); ld8f(INP(F, 5, float) + 1024 + c, mn);
#pragma unroll
                  for (int tk = 0; tk < 2; ++tk)
#pragma unroll
                      for (int e = 0; e < 8; ++e) zk[tk][e] = k4[tk + 1][e] + mp[e] * (k4[tk][e] - k4[tk + 1][e]) + mn[e] * (k4[tk + 2][e] - k4[tk + 1][e]);
                  ld8f(INP(F, 4, float) + 2048 + c, mp); ld8f(INP(F, 5, float) + 2048 + c, mn);
#pragma unroll
                  for (int tk = 0; tk < 2; ++tk)
#pragma unroll
                      for (int e = 0; e < 8; ++e) zv[tk][e] = v4[tk + 1][e] + mp[e] * (v4[tk][e] - v4[tk + 1][e]) + mn[e] * (v4[tk + 2][e] - v4[tk + 1][e]); }
                float kkw[8], w00[8], w01[8], a00[8], a01[8], kac[8], rkc[8];
                ld8f(INP(F, 16, float) + c, kkw); ld8f(INP(F, 11, float) + c, w00); ld8f(INP(F, 11, float) + 1024 + c, w01);
                ld8f(INP(F, 13, float) + c, a00); ld8f(INP(F, 13, float) + 1024 + c, a01); ld8f(INP(F, 17, float) + c, kac); ld8f(INP(F, 18, float) + c, rkc);
#pragma unroll 1
                for (int tk = 0; tk < 2; ++tk) {
                    const int tkn = 2 * tp + tk; const unsigned o = (unsigned)(m0t + tkn) * 1024u + (unsigned)c;
                    const LAS bf16_t* pp = Pl + tb * PT + tkn * PP + 8 * chk;
                    float zrt[8], zkt[8], zvt[8];
#pragma unroll
                    for (int e = 0; e < 8; ++e) { zrt[e] = tk ? zr[1][e] : zr[0][e]; zkt[e] = tk ? zk[1][e] : zk[0][e]; zvt[e] = tk ? zv[1][e] : zv[0][e]; }
                    WS32(F, u32x4, (unsigned)WS_R + o * 2u) = pack8(zrt); WS32(F, u32x4, (unsigned)WS_V + o * 2u) = pack8(zvt);
                    float kk[8];
                    { float ss = 0.f;
#pragma unroll
                      for (int e = 0; e < 8; ++e) { kk[e] = zkt[e] * kkw[e]; ss += kk[e] * kk[e]; }
                      ss += __shfl_xor(ss, 1); ss += __shfl_xor(ss, 2); ss += __shfl_xor(ss, 4);
                      const float inv = 1.f / fmaxf(sqrtf(ss), 1e-12f);
#pragma unroll
                      for (int e = 0; e < 8; ++e) kk[e] *= inv;
                      WS32(F, u32x4, (unsigned)WS_KK + o * 2u) = pack8(kk); }
                    {
                        float pw0[8], pw1[8], d0[8], d1[8];
                        unpack8(*(const LAS u32x4*)(pp), pw0); unpack8(*(const LAS u32x4*)(pp + PA), pw1);
#pragma unroll
                        for (int e = 0; e < 8; ++e) {
                            d0[e] = 0.6065306597126334f * __builtin_amdgcn_rcpf(1.f + __expf(-(w00[e] + pw0[e]))); d1[e] = 0.6065306597126334f * __builtin_amdgcn_rcpf(1.f + __expf(-(w01[e] + pw1[e]))); }
                        WS32(F, u32x4, (unsigned)WS_WDEC + o * 2u) = pack8(d0); WS32(F, u32x4, (unsigned)WS_WDEC + ((unsigned)(MTOK * 1024) + o) * 2u) = pack8(d1);
                    }
                    {
                        float pa0[8], pa1[8], kd0[8], kd1[8], b0v[8], b1v[8]; float bs = 0.f;
                        unpack8(*(const LAS u32x4*)(pp + 2 * PA), pa0); unpack8(*(const LAS u32x4*)(pp + 3 * PA), pa1);
#pragma unroll
                        for (int e = 0; e < 8; ++e) {
                            const float av0 = __builtin_amdgcn_rcpf(1.f + __expf(-(a00[e] + pa0[e]))), av1 = __builtin_amdgcn_rcpf(1.f + __expf(-(a01[e] + pa1[e])));
                            kd0[e] = zkt[e] * (1.f + (av0 - 1.f) * kac[e]); kd1[e] = zkt[e] * (1.f + (av1 - 1.f) * kac[e]);
                            b0v[e] = kk[e] * av0; b1v[e] = kk[e] * av1;
                            bs += zrt[e] * (kd0[e] + kd1[e]) * rkc[e]; }
                        bs += __shfl_xor(bs, 1); bs += __shfl_xor(bs, 2); bs += __shfl_xor(bs, 4);
                        if ((chk & 7) == 0) WS32(F, float, (unsigned)WS_BONUS + ((unsigned)(m0t + tkn) * 16u + (unsigned)(4 * q + (chk >> 3))) * 4u) = bs;
                        WS32(F, u32x4, (unsigned)WS_KD + o * 2u) = pack8(kd0); WS32(F, u32x4, (unsigned)WS_KD + ((unsigned)(MTOK * 1024) + o) * 2u) = pack8(kd1);
                        WS32(F, u32x4, (unsigned)WS_BB + o * 2u) = pack8(b0v); WS32(F, u32x4, (unsigned)WS_BB + ((unsigned)(MTOK * 1024) + o) * 2u) = pack8(b1v);
                    }
                    WS32(F, u32x4, (unsigned)WS_G + o * 2u) = *(const LAS u32x4*)(pp + 4 * PA);
                }
            }
            __syncthreads();
        }
    }
}

struct P5aConst { float lam; };
__device__ __forceinline__ void p5a_init(const Frame& F, P5aConst& K) {
    const int lane = F.lane;
    const float q1 = INP(F, 6, float)[lane] * INP(F, 7, float)[lane], q2 = INP(F, 8, float)[lane] * INP(F, 9, float)[lane];
    K.lam = __expf(wave_sum(q1)) - __expf(wave_sum(q2)) + 0.2f;
}
__device__ __forceinline__ void p5a_token(const Frame& F, const P5aConst& K, int m) {
    const bf16_t* OC = WSP(F, WS_OC, bf16_t); bf16_t* MIX = WSP(F, WS_MIX, bf16_t); const float* subw = INP(F, 10, float);
    const int c0 = F.lane * 16; const float lam = K.lam;
    const u32x4* p0 = (const u32x4*)(OC + (size_t)m * 1024 + c0); const u32x4* p1 = (const u32x4*)(OC + (size_t)MTOK * 1024 + (size_t)m * 1024 + c0);
    const u32x4 a0 = p0[0], a1 = p0[1], b0 = p1[0], b1 = p1[1];
    float dv[16]; const unsigned aw[8] = {a0.x, a0.y, a0.z, a0.w, a1.x, a1.y, a1.z, a1.w}, bw[8] = {b0.x, b0.y, b0.z, b0.w, b1.x, b1.y, b1.z, b1.w};
    float ssq = 0.f;
#pragma unroll
    for (int i = 0; i < 8; ++i) { dv[2 * i] = bf_lo(aw[i]) - lam * bf_lo(bw[i]); dv[2 * i + 1] = bf_hi(aw[i]) - lam * bf_hi(bw[i]); ssq += dv[2 * i] * dv[2 * i] + dv[2 * i + 1] * dv[2 * i + 1]; }
    ssq += __shfl_xor(ssq, 1); ssq += __shfl_xor(ssq, 2); ssq += __shfl_xor(ssq, 4);
    const float rstd = 1.f / sqrtf(ssq * (1.f / 128.f) + 1e-5f);
    unsigned ow[8];
#pragma unroll
    for (int i = 0; i < 8; ++i) { const float s0 = subw[(c0 + 2 * i) & 127] * 0.8f, s1 = subw[(c0 + 2 * i + 1) & 127] * 0.8f; ow[i] = cvtpk(dv[2 * i] * rstd * s0, dv[2 * i + 1] * rstd * s1); }
    u32x4* op = (u32x4*)(MIX + (size_t)m * 2048 + c0); op[0] = (u32x4){ow[0], ow[1], ow[2], ow[3]}; op[1] = (u32x4){ow[4], ow[5], ow[6], ow[7]};
}

__device__ __forceinline__ void p4_scan(Frame& F, const int mode = 0) {
    constexpr int CH = 32, NCH = SEQ / CH;
    constexpr int VEC = CH * 64 * 4;
    constexpr int BUF = 5 * VEC + CH * 32 * 4;
    constexpr int YOFF = 2 * BUF, YB = CH * 32 * 4;
    constexpr int CVT_SCR = 2 * BUF + 2 * YB;
    const bf16_t* Wdec = WSP(F, WS_WDEC, bf16_t); const bf16_t* KDg = WSP(F, WS_KD, bf16_t); const bf16_t* BBg = WSP(F, WS_BB, bf16_t);
    const bf16_t* Rg = WSP(F, WS_R, bf16_t); const bf16_t* KKg = WSP(F, WS_KK, bf16_t); const bf16_t* Vg = WSP(F, WS_V, bf16_t); bf16_t* YS = WSP(F, WS_YS, bf16_t);
    const int tid = F.tid, lane = F.lane, wid = F.wave;
    const bool is_comp = wid < 4;
    const int ri = wid & 3;
    if (is_comp) __builtin_amdgcn_s_setprio(3);
    const int g = lane >> 3, j = lane & 7, rowl = ri * 8 + g;
    const int mt = ri * 64 + lane, mw = ri;
    int cvt_it = F.vcu * 4 + mw; f32x4 cvv[16]; int ck0 = 0, crowb = 0; unsigned char* cWT = nullptr;
    f32x4 cvvB[16]; int ck0B = 0, crowbB = 0; unsigned char* cWTB = nullptr;
    LAS unsigned* st_cnt = (LAS unsigned*)(F.lds + CVT_SCR + 4 * 4096); LAS unsigned* cons_cnt = st_cnt + 16;
    for (int item = F.vcu; item < 256; item += F.G) {
        const int chain = item >> 1, half = item & 1, d = chain >> 6, b = (chain >> 4) & 3, h = chain & 15;
        const size_t sh = (size_t)b * SEQ * 1024 + h * 64, pd = (size_t)d * MTOK * 1024 + sh;
        f32x2 S2[4] = {{0.f, 0.f}, {0.f, 0.f}, {0.f, 0.f}, {0.f, 0.f}};
        u32x2 rw[2], rkk[2], rbb[2], rkd[2], rr[2]; unsigned rv[2];
        const int cstep = d ? -CH * 1024 : CH * 1024;
        unsigned po[2], pv[2];
#pragma unroll
        for (int q_ = 0; q_ < 2; ++q_) { const int sl_ = mt + 256 * q_, ss_ = sl_ >> 4, sk_ = (sl_ & 15) * 4, tq_ = d ? (SEQ - 1 - ss_) : ss_; po[q_] = (unsigned)(tq_ * 1024 + sk_); pv[q_] = (unsigned)(tq_ * 1024 + half * 32 + 2 * (sl_ & 15)); }
        const char* bW = (const char*)(Wdec + pd); const char* bKK = (const char*)(KKg + sh); const char* bBB = (const char*)(BBg + pd); const char* bKD = (const char*)(KDg + pd); const char* bR = (const char*)(Rg + sh); const char* bV = (const char*)(Vg + sh);
#define SC_LOAD(c) do { const unsigned cu_ = (unsigned)((c) * cstep); _Pragma("unroll") for (int q_ = 0; q_ < 2; ++q_) { const unsigned e_ = po[q_] + cu_; \
        rw[q_] = *(const u32x2*)(bW + (size_t)(e_ * 2u)); rkk[q_] = *(const u32x2*)(bKK + (size_t)(e_ * 2u)); rbb[q_] = *(const u32x2*)(bBB + (size_t)(e_ * 2u)); rkd[q_] = *(const u32x2*)(bKD + (size_t)(e_ * 2u)); rr[q_] = *(const u32x2*)(bR + (size_t)(e_ * 2u)); \
        rv[q_] = *(const unsigned*)(bV + (size_t)((pv[q_] + cu_) * 2u)); } } while (0)
#define SC_STORE(bufi) do { LAS unsigned char* bp_ = F.lds + (bufi) * BUF; _Pragma("unroll") for (int q_ = 0; q_ < 2; ++q_) { const int sl_ = mt + 256 * q_, ss_ = sl_ >> 4, sk_ = (sl_ & 15) * 4; const int o_ = (ss_ * 64 + sk_) * 4; \
        *(LAS f32x4*)(bp_ + o_) = (f32x4){__expf(-bf_lo(rw[q_].x)), __expf(-bf_hi(rw[q_].x)), __expf(-bf_lo(rw[q_].y)), __expf(-bf_hi(rw[q_].y))}; \
        *(LAS f32x4*)(bp_ + VEC + o_) = (f32x4){bf_lo(rkk[q_].x), bf_hi(rkk[q_].x), bf_lo(rkk[q_].y), bf_hi(rkk[q_].y)}; \
        *(LAS f32x4*)(bp_ + 2 * VEC + o_) = (f32x4){bf_lo(rbb[q_].x), bf_hi(rbb[q_].x), bf_lo(rbb[q_].y), bf_hi(rbb[q_].y)}; \
        *(LAS f32x4*)(bp_ + 3 * VEC + o_) = (f32x4){bf_lo(rkd[q_].x), bf_hi(rkd[q_].x), bf_lo(rkd[q_].y), bf_hi(rkd[q_].y)}; \
        *(LAS f32x4*)(bp_ + 4 * VEC + o_) = (f32x4){bf_lo(rr[q_].x), bf_hi(rr[q_].x), bf_lo(rr[q_].y), bf_hi(rr[q_].y)}; \
        *(LAS f32x2*)(bp_ + 5 * VEC + (ss_ * 32 + 2 * (sl_ & 15)) * 4) = (f32x2){bf_lo(rv[q_]), bf_hi(rv[q_])}; } } while (0)
#define Y_OUT(c) do { const int ys_ = mt >> 3, yr_ = (mt & 7) * 4; const int tt_ = (c) * CH + ys_, t_ = d ? (SEQ - 1 - tt_) : tt_; \
        const f32x4 yv_ = *(const LAS f32x4*)(F.lds + YOFF + ((c) & 1) * YB + (ys_ * 32 + yr_) * 4); \
        *(u32x2*)(YS + pd + (size_t)t_ * 1024 + half * 32 + yr_) = (u32x2){cvtpk(yv_.x, yv_.y), cvtpk(yv_.z, yv_.w)}; } while (0)
#define SC_WAIT(cnt_, tgt_) do { for (;;) { const u32x4 q_ = *(volatile LAS u32x4*)(cnt_); const unsigned a_ = q_.x < q_.y ? q_.x : q_.y, b_ = q_.z < q_.w ? q_.z : q_.w; \
        if ((a_ < b_ ? a_ : b_) >= (tgt_)) break; if (is_comp) __builtin_amdgcn_s_sleep(1); else __builtin_amdgcn_s_sleep(12); } asm volatile("" ::: "memory"); } while (0)
#define SC_SIGNAL(cnt_, val_) do { asm volatile("s_waitcnt lgkmcnt(0)" ::: "memory"); if (lane == 0) *(volatile LAS unsigned*)((cnt_) + ri) = (val_); } while (0)
        __syncthreads();
        if (tid < 4) { st_cnt[tid] = 0u; cons_cnt[tid] = 0u; }
        if (!is_comp) { SC_LOAD(0); SC_STORE(0); SC_LOAD(1); }
        __syncthreads();
        if (is_comp) {
          for (int c = 0; c < NCH; ++c) {
            SC_WAIT(st_cnt, (unsigned)c);
            if (mode != 2) {
                const LAS unsigned char* bp = F.lds + (c & 1) * BUF;
                LAS float* yb = (LAS float*)(F.lds + YOFF + (c & 1) * YB);
                f32x4 cw_[2], ckk[2], cbb[2], ckd[2], cr[2]; float cv;
#define SC_RD(s_) do { const int o_ = ((s_) * 64 + j * 8) * 4; cw_[0] = *(const LAS f32x4*)(bp + o_); cw_[1] = *(const LAS f32x4*)(bp + o_ + 16); ckk[0] = *(const LAS f32x4*)(bp + VEC + o_); ckk[1] = *(const LAS f32x4*)(bp + VEC + o_ + 16); \
                cbb[0] = *(const LAS f32x4*)(bp + 2 * VEC + o_); cbb[1] = *(const LAS f32x4*)(bp + 2 * VEC + o_ + 16); ckd[0] = *(const LAS f32x4*)(bp + 3 * VEC + o_); ckd[1] = *(const LAS f32x4*)(bp + 3 * VEC + o_ + 16); \
                cr[0] = *(const LAS f32x4*)(bp + 4 * VEC + o_); cr[1] = *(const LAS f32x4*)(bp + 4 * VEC + o_ + 16); cv = *(const LAS float*)(bp + 5 * VEC + ((s_) * 32 + rowl) * 4); } while (0)
#define H2(v_, i_) ((f32x2){v_[(i_) >> 1][((i_) & 1) * 2], v_[(i_) >> 1][((i_) & 1) * 2 + 1]})
                SC_RD(0);
                float yk = 0.f;
#pragma unroll
                for (int s = 0; s < CH; ++s) {
                    f32x4 w[2] = {cw_[0], cw_[1]}, kk[2] = {ckk[0], ckk[1]}, bb[2] = {cbb[0], cbb[1]}, kd[2] = {ckd[0], ckd[1]}, r[2] = {cr[0], cr[1]}; const float v = cv;
                    if (s + 1 < CH) SC_RD(s + 1);
                    f32x2 pa = S2[0] * H2(kk, 0), pb = S2[1] * H2(kk, 1); pa = S2[2] * H2(kk, 2) + pa; pb = S2[3] * H2(kk, 3) + pb; pa = pa + pb;
                    const f32x2 vv = {v, v};
                    f32x2 u[4];
#pragma unroll
                    for (int i = 0; i < 4; ++i) u[i] = S2[i] * H2(w, i) + vv * H2(kd, i);
                    float p = pa.x + pa.y;
                    p = dpp_add<0xB1>(p); p = dpp_add<0x4E>(p); p = dpp_add<0x141>(p);
                    const f32x2 sa = {-p, -p};
#pragma unroll
                    for (int i = 0; i < 4; ++i) S2[i] = sa * H2(bb, i) + u[i];
                    f32x2 ya = S2[0] * H2(r, 0), yc = S2[1] * H2(r, 1); ya = S2[2] * H2(r, 2) + ya; yc = S2[3] * H2(r, 3) + yc; ya = ya + yc;
                    float y = ya.x + ya.y;
                    y = dpp_add<0xB1>(y); y = dpp_add<0x4E>(y); y = dpp_add<0x141>(y);
                    yk = (j == (s & 7)) ? y : yk;
                    if ((s & 7) == 7) yb[((s & 24) + j) * 32 + rowl] = yk;
                }
#undef SC_RD
#undef H2
            }
            SC_SIGNAL(cons_cnt, (unsigned)(c + 1));
          }
        } else {
#define MEM_DUTIES(c_) do { SC_WAIT(cons_cnt, (unsigned)(c_)); if ((c_) >= 1 && mode != 2) Y_OUT((c_) - 1); if ((c_) + 1 < NCH) SC_STORE(((c_) + 1) & 1); SC_SIGNAL(st_cnt, (unsigned)((c_) + 1)); if ((c_) + 2 < NCH) SC_LOAD((c_) + 2); } while (0)
#define CVT_LOAD_SET(V_, K0_, WT_, RB_) do { const int it_ = cvt_it < N_EXPERT_ITEMS ? cvt_it : N_EXPERT_ITEMS - 1; const float* cW_; int cn0_; cvt_expert_decode(F, it_, cW_, K0_, cn0_, WT_, RB_); cvt8_load(V_, cW_, K0_, cn0_, lane); cvt_it += F.G * 4; } while (0)
          if (item == F.vcu) { P5aConst p5k; p5a_init(F, p5k); for (int xm = F.vcu * 4 + mw; xm < MTOK; xm += F.G * 4) p5a_token(F, p5k, xm); }
          int ngrp = 0; { const int left = (N_EXPERT_ITEMS - cvt_it + F.G * 4 - 1) / (F.G * 4); ngrp = left > 0 ? left / 3 : 0; if (ngrp > NCH / 4) ngrp = NCH / 4; }
          int cg = 0;
#pragma unroll 1
          for (; cg < 4 * ngrp; cg += 4) {
            MEM_DUTIES(cg);
#if CVT_IN_SCAN
            if (cg > 0) cvt8_finish(cvv, ck0, cWT, crowb, lane);
            CVT_LOAD_SET(cvv, ck0, cWT, crowb);
#endif
            MEM_DUTIES(cg + 1);
#if CVT_IN_SCAN
            CVT_LOAD_SET(cvvB, ck0B, cWTB, crowbB);
#endif
            MEM_DUTIES(cg + 2);
#if CVT_IN_SCAN
            cvt8_finish(cvv, ck0, cWT, crowb, lane);
            CVT_LOAD_SET(cvv, ck0, cWT, crowb);
#endif
            MEM_DUTIES(cg + 3);
#if CVT_IN_SCAN
            cvt8_finish(cvvB, ck0B, cWTB, crowbB, lane);
#endif
          }
#if CVT_IN_SCAN
          if (ngrp > 0) cvt8_finish(cvv, ck0, cWT, crowb, lane);
#endif
#pragma unroll 1
          for (; cg < NCH; ++cg) MEM_DUTIES(cg);
#undef MEM_DUTIES
#undef CVT_LOAD_SET
          SC_WAIT(cons_cnt, (unsigned)NCH);
        }
        if (!is_comp && mode != 2) Y_OUT(NCH - 1);
#undef SC_LOAD
#undef SC_STORE
#undef Y_OUT
#undef SC_WAIT
#undef SC_SIGNAL
    }
    __builtin_amdgcn_s_setprio(0);
#if CVT_IN_SCAN
    if (!is_comp) {
        for (; cvt_it < N_EXPERT_ITEMS; cvt_it += F.G * 4) {
            const float* W; int k0, n0, rowb; unsigned char* WT;
            cvt_expert_decode(F, cvt_it, W, k0, n0, WT, rowb); cvt8_load(cvv, W, k0, n0, lane); cvt8_finish(cvv, k0, WT, rowb, lane);
        }
    }
#endif
}

__device__ __forceinline__ void p5_finalize(Frame& F) {
    const bf16_t* YS = WSP(F, WS_YS, bf16_t); const bf16_t* Vg = WSP(F, WS_V, bf16_t); const bf16_t* Gg = WSP(F, WS_G, bf16_t);
    const float* BON = WSP(F, WS_BONUS, float); bf16_t* MIX = WSP(F, WS_MIX, bf16_t);
    const float* lnw = INP(F, 19, float); const float* lnb = INP(F, 20, float);
    const int lane = F.lane, gw = F.vcu * 8 + F.wave, NGW = F.G * 8;
    const int c0 = lane * 16;
    float lw[16], lb[16];
#pragma unroll
    for (int i = 0; i < 16; ++i) { lw[i] = lnw[c0 + i]; lb[i] = lnb[c0 + i]; }
    struct Raw { u32x4 a0, a1, b0, b1, v0, v1, g0, g1; float bon; };
#define P5_LOAD(R_, m_) do { const u32x4* y0_ = (const u32x4*)(YS + (size_t)(m_) * 1024 + c0); const u32x4* y1_ = (const u32x4*)(YS + (size_t)MTOK * 1024 + (size_t)(m_) * 1024 + c0); \
        const u32x4* vp_ = (const u32x4*)(Vg + (size_t)(m_) * 1024 + c0); const u32x4* gp_ = (const u32x4*)(Gg + (size_t)(m_) * 1024 + c0); \
        R_.a0 = y0_[0]; R_.a1 = y0_[1]; R_.b0 = y1_[0]; R_.b1 = y1_[1]; R_.v0 = vp_[0]; R_.v1 = vp_[1]; R_.g0 = gp_[0]; R_.g1 = gp_[1]; R_.bon = BON[(size_t)(m_) * 16 + (lane >> 2)]; } while (0)
#define P5_FINISH(R_, m_) do { float y[16]; float s_ = 0.f; \
        { const unsigned aw[8] = {R_.a0.x, R_.a0.y, R_.a0.z, R_.a0.w, R_.a1.x, R_.a1.y, R_.a1.z, R_.a1.w}, bw[8] = {R_.b0.x, R_.b0.y, R_.b0.z, R_.b0.w, R_.b1.x, R_.b1.y, R_.b1.z, R_.b1.w}; \
          _Pragma("unroll") for (int i = 0; i < 8; ++i) { y[2 * i] = bf_lo(aw[i]) + bf_lo(bw[i]); y[2 * i + 1] = bf_hi(aw[i]) + bf_hi(bw[i]); } } \
        _Pragma("unroll") for (int i = 0; i < 16; ++i) s_ += y[i]; \
        s_ += __shfl_xor(s_, 1); s_ += __shfl_xor(s_, 2);                                              \
        const float mu_ = s_ * (1.f / 64.f); float q_ = 0.f; \
        _Pragma("unroll") for (int i = 0; i < 16; ++i) { y[i] -= mu_; q_ += y[i] * y[i]; } \
        q_ += __shfl_xor(q_, 1); q_ += __shfl_xor(q_, 2); \
        const float rstd_ = 1.f / sqrtf(q_ * (1.f / 64.f) + 64e-5f); \
        const unsigned vw[8] = {R_.v0.x, R_.v0.y, R_.v0.z, R_.v0.w, R_.v1.x, R_.v1.y, R_.v1.z, R_.v1.w}, gq[8] = {R_.g0.x, R_.g0.y, R_.g0.z, R_.g0.w, R_.g1.x, R_.g1.y, R_.g1.z, R_.g1.w}; \
        unsigned ow[8]; \
        _Pragma("unroll") for (int i = 0; i < 8; ++i) { \
            const float e0 = (y[2 * i] * rstd_ * lw[2 * i] + lb[2 * i] + R_.bon * bf_lo(vw[i])) * bf_lo(gq[i]); \
            const float e1 = (y[2 * i + 1] * rstd_ * lw[2 * i + 1] + lb[2 * i + 1] + R_.bon * bf_hi(vw[i])) * bf_hi(gq[i]); \
            ow[i] = cvtpk(e0, e1); } \
        u32x4* op = (u32x4*)(MIX + (size_t)(m_) * 2048 + 1024 + c0); op[0] = (u32x4){ow[0], ow[1], ow[2], ow[3]}; op[1] = (u32x4){ow[4], ow[5], ow[6], ow[7]}; } while (0)
    for (int m = gw; m < MTOK; m += 2 * NGW) {
        const int m2 = m + NGW; const bool has2 = m2 < MTOK;
        Raw ra, rb; P5_LOAD(ra, m); if (has2) P5_LOAD(rb, m2);
        P5_FINISH(ra, m); if (has2) P5_FINISH(rb, m2);
    }
#undef P5_LOAD
#undef P5_FINISH
}

__device__ __forceinline__ void p7_router(Frame& F) {
    const bf16_t* X1 = WSP(F, WS_X1, bf16_t); const float* nw = INP(F, 22, float); const float* wr = INP(F, 23, float);
    unsigned char* H2 = WSP(F, WS_H2, unsigned char); float* AFF = WSP(F, WS_AFF, float);
    const int lane = F.lane, w = F.wave, tok = lane & 15, kq = lane >> 4;
    LAS float* part = (LAS float*)F.lds;
    LAS float* ssqp = (LAS float*)(F.lds + 8192);
    const int kb = 256 * w + 8 * kq;
    float Bw[8][8];
#pragma unroll
    for (int g = 0; g < 8; ++g)
#pragma unroll
        for (int e = 0; e < 8; ++e) { const int k = kb + 32 * g + e; Bw[g][e] = nw[k] * wr[(size_t)k * 16 + tok]; }
    for (int item = F.vcu; item < MTOK / 16; item += F.G) {
        const int m0 = item * 16;
        u32x4 xr[8];
        const bf16_t* xp = X1 + (size_t)(m0 + tok) * DM + kb;
#pragma unroll
        for (int g = 0; g < 8; ++g) xr[g] = *(const u32x4*)(xp + 32 * g);
        f32x4 acc = {0.f, 0.f, 0.f, 0.f}; float ss = 0.f;
#pragma unroll
        for (int g = 0; g < 8; ++g) {
            float x[8]; unpack8(xr[g], x);
#pragma unroll
            for (int e = 0; e < 8; ++e) { ss += x[e] * x[e]; acc = __builtin_amdgcn_mfma_f32_16x16x4f32(x[e], Bw[g][e], acc, 0, 0, 0); }
        }
        __syncthreads();
        *(LAS f32x4*)(part + w * 256 + tok * 16 + 4 * kq) = acc;
        ss += __shfl_xor(ss, 16); ss += __shfl_xor(ss, 32);
        if (kq == 0) ssqp[w * 16 + tok] = ss;
        __syncthreads();
        float tot = 0.f;
#pragma unroll
        for (int i = 0; i < 8; ++i) tot += ssqp[i * 16 + tok];
        const float rstd = 1.f / sqrtf(tot * (1.f / DM) + 1e-6f);
        { unsigned char* hp = H2 + (size_t)(m0 + tok) * DM + kb;
#pragma unroll
          for (int g = 0; g < 8; ++g) { float x[8]; unpack8(xr[g], x); const f32x4 n0 = *(const f32x4*)(nw + kb + 32 * g), n1 = *(const f32x4*)(nw + kb + 32 * g + 4);
              u32x2 o; o.x = pg8::cvt4_fp8(x[0] * rstd * n0.x, x[1] * rstd * n0.y, x[2] * rstd * n0.z, x[3] * rstd * n0.w); o.y = pg8::cvt4_fp8(x[4] * rstd * n1.x, x[5] * rstd * n1.y, x[6] * rstd * n1.z, x[7] * rstd * n1.w);
              *(u32x2*)(hp + 32 * g) = o; } }
        if (lane < 32) {
            const int tt = 2 * w + (lane >> 4), ex = lane & 15;
            float lg = 0.f, t2 = 0.f;
#pragma unroll
            for (int i = 0; i < 8; ++i) { lg += part[i * 256 + ex * 16 + tt]; t2 += ssqp[i * 16 + tt]; }
            lg *= 1.f / sqrtf(t2 * (1.f / DM) + 1e-6f);
            float mx = lg;
            mx = fmaxf(mx, __shfl_xor(mx, 1)); mx = fmaxf(mx, __shfl_xor(mx, 2)); mx = fmaxf(mx, __shfl_xor(mx, 4)); mx = fmaxf(mx, __shfl_xor(mx, 8));
            const float pe = expf(lg - mx);
            float den = pe; den += __shfl_xor(den, 1); den += __shfl_xor(den, 2); den += __shfl_xor(den, 4); den += __shfl_xor(den, 8);
            const int mm = m0 + tt;
            AFF[((size_t)(mm >> 11) * 16 + ex) * SEQ + (mm & (SEQ - 1))] = pe / den;
        }
    }
    __syncthreads();
}

__device__ __forceinline__ int wave_count4(bool f0, bool f1, bool f2, bool f3) {
    return __builtin_popcountll(__ballot(f0)) + __builtin_popcountll(__ballot(f1)) + __builtin_popcountll(__ballot(f2)) + __builtin_popcountll(__ballot(f3));
}
__device__ __forceinline__ void p8_select(Frame& F) {
    const float* AFF = WSP(F, WS_AFF, float);
    int* XEIDX = WSP(F, WS_XEIDX, int); float* GATEX = WSP(F, WS_GATEX, float); int* SLOT = WSP(F, WS_SLOT, int);
    LAS int* part = (LAS int*)F.lds;
    LAS unsigned* cnt = (LAS unsigned*)(F.lds + 256);
    LAS unsigned* list = (LAS unsigned*)(F.lds + 512);
    const int tid = F.tid, lane = F.lane, w = F.wave;
    for (int item = F.vcu; item < 256; item += F.G) {
        const int be = item >> 2, q = item & 3, b = be >> 4, e = be & 15;
        __syncthreads();
        if (tid == 0) *cnt = 0u;
        const f32x4 a4 = ((const f32x4*)(AFF + (size_t)be * SEQ))[tid];
        const unsigned u0 = __float_as_uint(a4.x), u1 = __float_as_uint(a4.y), u2 = __float_as_uint(a4.z), u3 = __float_as_uint(a4.w);
        unsigned lo = 0u, hi = 0x7f800001u;
        int itn = 0;
        while (hi - lo > 1u) {
            const unsigned mid = lo + ((hi - lo) >> 1);
            const int c = wave_count4(u0 >= mid, u1 >= mid, u2 >= mid, u3 >= mid);
            LAS int* pp = part + (itn & 1) * 8;
            if (lane == 0) pp[w] = c;
            __syncthreads();
            int tot = 0;
#pragma unroll
            for (int i = 0; i < 8; ++i) tot += pp[i];
            if (tot >= CAP) lo = mid; else hi = mid;
            ++itn;
        }
        const unsigned T = lo;
        const bool g0 = u0 > T, g1 = u1 > T, g2 = u2 > T, g3 = u3 > T, q0 = u0 == T, q1 = u1 == T, q2 = u2 == T, q3 = u3 == T;
        const unsigned long long bg0 = __ballot(g0), bg1 = __ballot(g1), bg2 = __ballot(g2), bg3 = __ballot(g3), bq0 = __ballot(q0), bq1 = __ballot(q1), bq2 = __ballot(q2), bq3 = __ballot(q3);
        const unsigned long long below = (lane == 0) ? 0ull : (~0ull >> (64 - lane));
        int pg = __builtin_popcountll(bg0 & below) + __builtin_popcountll(bg1 & below) + __builtin_popcountll(bg2 & below) + __builtin_popcountll(bg3 & below);
        int pq = __builtin_popcountll(bq0 & below) + __builtin_popcountll(bq1 & below) + __builtin_popcountll(bq2 & below) + __builtin_popcountll(bq3 & below);
        const int wg = __builtin_popcountll(bg0) + __builtin_popcountll(bg1) + __builtin_popcountll(bg2) + __builtin_popcountll(bg3);
        const int wq = __builtin_popcountll(bq0) + __builtin_popcountll(bq1) + __builtin_popcountll(bq2) + __builtin_popcountll(bq3);
        if (lane == 0) { part[16 + w] = wg; part[32 + w] = wq; }
        __syncthreads();
        int gtc = 0, baseg = 0, baseq = 0;
#pragma unroll
        for (int i = 0; i < 8; ++i) { const int x = part[16 + i], y = part[32 + i]; gtc += x; if (i < w) { baseg += x; baseq += y; } }
        const int need = CAP - gtc;
        pg += baseg; pq += baseq;
        if ((w >> 1) == q) {
            const bool gs[4] = {g0, g1, g2, g3}, qs[4] = {q0, q1, q2, q3}; const float av[4] = {a4.x, a4.y, a4.z, a4.w};
            int cg_ = pg, cq_ = pq;
#pragma unroll
            for (int i = 0; i < 4; ++i) {
                const int t = 4 * tid + i, m = b * SEQ + t; int slot = -1;
                if (gs[i]) { slot = cg_; ++cg_; } else if (qs[i]) { if (cq_ < need) slot = gtc + cq_; ++cq_; }
                SLOT[m * 16 + e] = slot;
                if (slot >= 0) { GATEX[(e * 4 + b) * CAP + slot] = av[i]; XEIDX[(e * 4 + b) * CAP + slot] = m; }
            }
        }
    }
}

__device__ __forceinline__ void p11_final(Frame& F) {
    const bf16_t* X1 = WSP(F, WS_X1, bf16_t); const unsigned char* YE = WSP(F, WS_YE, unsigned char); const int* SLOT = WSP(F, WS_SLOT, int); const float* nw = INP(F, 27, float);
    float* out = F.a->out;
    const int lane = F.lane, gw = F.vcu * 8 + F.wave, NGW = F.G * 8;
    for (int mA = gw; mA < MTOK; mA += 2 * NGW) {
        const int mB = mA + NGW; const bool hasB = mB < MTOK; const int mBc = hasB ? mB : mA;
        int slA = (lane < 16) ? SLOT[mA * 16 + lane] : -1, slB = (lane < 16 && hasB) ? SLOT[mBc * 16 + lane] : -1;
        u32x4 xa[4], xb[4];
        { const u32x4* xr = (const u32x4*)(X1 + (size_t)mA * DM + lane * 8); const u32x4* xs = (const u32x4*)(X1 + (size_t)mBc * DM + lane * 8);
#pragma unroll
          for (int j = 0; j < 4; ++j) { xa[j] = xr[64 * j]; xb[j] = xs[64 * j]; } }
        unsigned mkA = (unsigned)(__ballot(slA >= 0) & 0xFFFFull), mkB = (unsigned)(__ballot(slB >= 0) & 0xFFFFull);
        float va[32], vb[32];
#pragma unroll
        for (int j = 0; j < 4; ++j) { const u32x4 a = xa[j], c = xb[j];
            va[8 * j] = bf_lo(a.x); va[8 * j + 1] = bf_hi(a.x); va[8 * j + 2] = bf_lo(a.y); va[8 * j + 3] = bf_hi(a.y); va[8 * j + 4] = bf_lo(a.z); va[8 * j + 5] = bf_hi(a.z); va[8 * j + 6] = bf_lo(a.w); va[8 * j + 7] = bf_hi(a.w);
            vb[8 * j] = bf_lo(c.x); vb[8 * j + 1] = bf_hi(c.x); vb[8 * j + 2] = bf_lo(c.y); vb[8 * j + 3] = bf_hi(c.y); vb[8 * j + 4] = bf_lo(c.z); vb[8 * j + 5] = bf_hi(c.z); vb[8 * j + 6] = bf_lo(c.w); vb[8 * j + 7] = bf_hi(c.w); }
        const int bA = mA >> 11, bB = mBc >> 11;
        while (mkA | mkB) {
            u32x2 ra[2][4], rb[2][4];
#pragma unroll
            for (int q = 0; q < 2; ++q) {
                if (mkA) { const int e = __builtin_ctz(mkA); mkA &= mkA - 1u; const int sl = __builtin_amdgcn_readlane(slA, e);
                    const u32x2* yr = (const u32x2*)(YE + (size_t)((e * 4 + bA) * CAP + sl) * DM + lane * 8);
#pragma unroll
                    for (int j = 0; j < 4; ++j) ra[q][j] = yr[64 * j]; }
                else {
#pragma unroll
                    for (int j = 0; j < 4; ++j) ra[q][j] = (u32x2){0u, 0u}; }
                if (mkB) { const int e = __builtin_ctz(mkB); mkB &= mkB - 1u; const int sl = __builtin_amdgcn_readlane(slB, e);
                    const u32x2* yr = (const u32x2*)(YE + (size_t)((e * 4 + bB) * CAP + sl) * DM + lane * 8);
#pragma unroll
                    for (int j = 0; j < 4; ++j) rb[q][j] = yr[64 * j]; }
                else {
#pragma unroll
                    for (int j = 0; j < 4; ++j) rb[q][j] = (u32x2){0u, 0u}; }
            }
#define P11_ACC(V_, W_, q_) do { V_[8 * j + (q_)] += __builtin_amdgcn_cvt_f32_fp8(W_.x, q_) * pg8::YE_DESCALE; V_[8 * j + 4 + (q_)] += __builtin_amdgcn_cvt_f32_fp8(W_.y, q_) * pg8::YE_DESCALE; } while (0)
#pragma unroll
            for (int q = 0; q < 2; ++q)
#pragma unroll
                for (int j = 0; j < 4; ++j) { const u32x2 wa = ra[q][j], wb = rb[q][j];
                    P11_ACC(va, wa, 0); P11_ACC(va, wa, 1); P11_ACC(va, wa, 2); P11_ACC(va, wa, 3); P11_ACC(vb, wb, 0); P11_ACC(vb, wb, 1); P11_ACC(vb, wb, 2); P11_ACC(vb, wb, 3); }
#undef P11_ACC
        }
        float sa = 0.f, sb = 0.f;
#pragma unroll
        for (int i = 0; i < 32; ++i) { sa += va[i] * va[i]; sb += vb[i] * vb[i]; }
        const float rsa = 1.f / sqrtf(wave_sum(sa) * (1.f / DM) + 1e-6f), rsb = 1.f / sqrtf(wave_sum(sb) * (1.f / DM) + 1e-6f);
#pragma unroll
        for (int j = 0; j < 4; ++j) { const int col = 512 * j + lane * 8; const f32x4 w0 = *(const f32x4*)(nw + col), w1 = *(const f32x4*)(nw + col + 4);
            { f32x4 o0 = {va[8 * j] * rsa * w0.x, va[8 * j + 1] * rsa * w0.y, va[8 * j + 2] * rsa * w0.z, va[8 * j + 3] * rsa * w0.w};
              f32x4 o1 = {va[8 * j + 4] * rsa * w1.x, va[8 * j + 5] * rsa * w1.y, va[8 * j + 6] * rsa * w1.z, va[8 * j + 7] * rsa * w1.w};
              *(f32x4*)(out + (size_t)mA * DM + col) = o0; *(f32x4*)(out + (size_t)mA * DM + col + 4) = o1; }
            if (hasB) { f32x4 o0 = {vb[8 * j] * rsb * w0.x, vb[8 * j + 1] * rsb * w0.y, vb[8 * j + 2] * rsb * w0.z, vb[8 * j + 3] * rsb * w0.w};
              f32x4 o1 = {vb[8 * j + 4] * rsb * w1.x, vb[8 * j + 5] * rsb * w1.y, vb[8 * j + 6] * rsb * w1.z, vb[8 * j + 7] * rsb * w1.w};
              *(f32x4*)(out + (size_t)mB * DM + col) = o0; *(f32x4*)(out + (size_t)mB * DM + col + 4) = o1; } }
    }
}


template <int PHM> __global__ void __launch_bounds__(512, 2) mk_fwd(Args args) {
    extern __shared__ __attribute__((aligned(16))) unsigned char lds[];
    Frame F;
    F.lds = (LAS unsigned char*)lds; F.ldsg = (char*)lds; F.a = &args;
    F.tid = threadIdx.x; F.lane = F.tid & 63; F.wave = __builtin_amdgcn_readfirstlane(F.tid >> 6);
    F.G = gridDim.x; { const int bx = blockIdx.x; F.vcu = (F.G % 8 == 0) ? (bx % 8) * (F.G / 8) + bx / 8 : bx; }
    volatile LAS unsigned* MISC = (volatile LAS unsigned*)(F.lds + MISC_OFF);
    for (int u = F.tid; u < (LDS_BYTES - 131072) / 4; u += 512) ((LAS unsigned*)(F.lds + 131072))[u] = 0u;
    __syncthreads();
    gu32* ctl = (gu32*)(args.ws + WS_CTL);
    XcdBarrier bar; bar.bar = (unsigned*)(ctl + CW_BAR); bar.x = 0; bar.st = nullptr;
    if (MK_N_LAUNCHES == 1) bar = xcd_barrier_post((unsigned*)(ctl + CW_BAR), MISC + 8);
    const int lo = args.ph_lo, hi = args.ph_hi;
#define IN(k) (((PHM >> (k)) & 1) && lo <= (k) && (k) < hi)
#ifndef DUP_MASK
#define DUP_MASK 0
#endif
#define REP(k) for (int rep_ = 0; rep_ < 1 + ((DUP_MASK >> (k)) & 1); ++rep_)
#define SEAM(k) do { if (IN(k) && IN((k) + 1)) xcd_barrier(bar); } while (0)

    if (IN(0)) REP(0) { p0_prologue(F); }
    SEAM(0);
    if (IN(1)) REP(1) {
        pg8::Gemm g{WSP(F, WS_H1, bf16_t), WSP(F, WS_WIN, bf16_t), MTOK, 6144, DM, DM}; pg8::StaticOrder S; S.init(MTOK, 6144, F.G, (int)blockIdx.x);
        pg8::EpiProj E{WSP(F, WS_PROJ, bf16_t), LDP, WSP(F, WS_ROPE, float), QSCALE};
        pg8::gemm_phase<pg8::EpiProj, pg8::StaticOrder, true, true>(F.lds, g, S, E);
        pg8::Gemm g2{WSP(F, WS_H1, bf16_t), WSP(F, WS_WIN, bf16_t), MTOK, 512, DM / 4, DM}; pg8::TailOrder S2{F.G, (int)blockIdx.x};
        pg8::EpiPart E2{WSP(F, WS_PART, bf16_t)};
        pg8::gemm_phase<pg8::EpiPart, pg8::TailOrder, true, true>(F.lds, g2, S2, E2);
    }
    SEAM(1);
    const bool prep_first = (F.vcu & 1) != 0;
    if (IN(3) && prep_first) { p3_prep(F, 0); }
    if (IN(2)) {
        const bf16_t* P = WSP(F, WS_PROJ, bf16_t); bf16_t* OC = WSP(F, WS_OC, bf16_t);
        for (int u = F.vcu * 2; u < 512; u += F.G * 2)
            for (int i = 0; i < 2; ++i) {
                const int uu = u + i, qb = uu & 7, c = (uu >> 3) & 1, h = (uu >> 4) & 7, b = uu >> 7;
                const size_t m0 = (size_t)b * SEQ;
                att::attn_unit<LDP>(P + (m0 + qb * 256) * LDP + h * 128 + c * 64, P + m0 * LDP + 1024 + h * 128 + c * 64, P + m0 * LDP + 2048 + h * 128,
                                    OC + (size_t)c * MTOK * 1024 + (m0 + qb * 256) * 1024 + h * 128, SEQ, F.ldsg);
            }
    }
    if (IN(3) && !prep_first) { p3_prep(F, 0); }
    SEAM(3);
    #ifndef SCAN_PROBE
#define SCAN_PROBE 0
#endif
    if (IN(4)) REP(4) { p4_scan(F, rep_ ? SCAN_PROBE : 0); }
    SEAM(4);
    if (IN(5)) REP(5) { p5_finalize(F); }
    SEAM(5);
    if (IN(6)) REP(6) {
        pg8::Gemm g{WSP(F, WS_MIX, bf16_t), WSP(F, WS_WOUT, bf16_t), MTOK, DM, DM, DM}; pg8::StaticOrder S; S.init(MTOK, DM, F.G, (int)blockIdx.x);
        pg8::EpiResid E{INP(F, 0, float), WSP(F, WS_X1, bf16_t), DM};
        pg8::gemm_phase<pg8::EpiResid, pg8::StaticOrder, true, true>(F.lds, g, S, E);
    }
    SEAM(6);
    if (IN(7)) REP(7) { p7_router(F); }
    SEAM(7);
    if (IN(8)) REP(8) { p8_select(F); }
    SEAM(8);
    if (IN(9)) REP(9) {
        pg8::Gemm g{WSP(F, WS_H2, bf16_t), WSP(F, WS_WGU, bf16_t), 16384, 65536, DM / 2, DM / 2}; pg8::MoeOrderT<true> S{F.G, F.vcu, 16, 1024, WSP(F, WS_XEIDX, int)};
        pg8::EpiSwiglu E{WSP(F, WS_HID, unsigned char), 16};
        pg8::gemm_phase<pg8::EpiSwiglu, pg8::MoeOrderT<true>, true, true, true>(F.lds, g, S, E);
    }
    SEAM(9);
    if (IN(10)) REP(10) {
        pg8::Gemm g{WSP(F, WS_HID, bf16_t), WSP(F, WS_WD, bf16_t), 16384, 32768, DM / 2, DM / 2}; pg8::MoeOrderT<false> S{F.G, F.vcu, 8, 512, nullptr};
        pg8::EpiDown E{WSP(F, WS_YE, unsigned char), WSP(F, WS_GATEX, float), 8};
        pg8::gemm_phase<pg8::EpiDown, pg8::MoeOrderT<false>, true, true, true>(F.lds, g, S, E);
    }
    SEAM(10);
    if (IN(11)) REP(11) { p11_final(F); }
#undef IN
#undef SEAM
}

static const void* kfn(int li) {
#if MK_N_LAUNCHES == 1
    (void)li; return (const void*)mk_fwd<0xFFF>;
#else
    switch (li) {
        case 0: return (const void*)mk_fwd<1>; case 1: return (const void*)mk_fwd<2>; case 2: return (const void*)mk_fwd<4>; case 3: return (const void*)mk_fwd<8>;
        case 4: return (const void*)mk_fwd<16>; case 5: return (const void*)mk_fwd<32>; case 6: return (const void*)mk_fwd<64>; case 7: return (const void*)mk_fwd<128>;
        case 8: return (const void*)mk_fwd<256>; case 9: return (const void*)mk_fwd<512>; case 10: return (const void*)mk_fwd<1024>; default: return (const void*)mk_fwd<2048>;
    }
#endif
}
extern "C" void kernel_launch(void* const* d_in, const int* in_sizes, int n_in, void* d_out, int out_size, void* d_ws, size_t ws_size, hipStream_t stream) {
    static int grid = 0;
    if (grid == 0) {
        if (n_in != 28 || out_size != MTOK * DM || ws_size < WS_END) { fprintf(stderr, "kernel_launch: unexpected shapes: n_in %d out %d ws %zu (need >= %zu)\n", n_in, out_size, ws_size, (size_t)WS_END); grid = -1; return; }
        int dev = 0, cus = 0, per_cu = 0;
        if (hipGetDevice(&dev) != hipSuccess || hipDeviceGetAttribute(&cus, hipDeviceAttributeMultiprocessorCount, dev) != hipSuccess) { fprintf(stderr, "kernel_launch: device query failed\n"); grid = -1; return; }
        for (int i = 0; i < MK_N_LAUNCHES; ++i) if (hipFuncSetAttribute(kfn(i), hipFuncAttributeMaxDynamicSharedMemorySize, LDS_BYTES) != hipSuccess) { fprintf(stderr, "kernel_launch: hipFuncSetAttribute failed\n"); grid = -1; return; }
        if (hipOccupancyMaxActiveBlocksPerMultiprocessor(&per_cu, kfn(0), 512, LDS_BYTES) != hipSuccess || per_cu < 1) { fprintf(stderr, "kernel_launch: occupancy query says %d blocks/CU\n", per_cu); }
        (void)hipGetLastError();
        grid = cus;
    }
    if (grid < 0) return;
    if (hipMemsetAsync((char*)d_ws + WS_CTL, 0, CTL_ZERO_BYTES, stream) != hipSuccess) { fprintf(stderr, "kernel_launch: memset failed\n"); return; }
    Args a{};
    for (int i = 0; i < 28; ++i) a.in[i] = d_in[i];
    a.out = (float*)d_out; a.ws = (unsigned char*)d_ws;
    const int nl = MK_N_LAUNCHES;
    for (int li = 0; li < nl; ++li) {
        a.ph_lo = (nl == 1) ? 0 : li; a.ph_hi = (nl == 1) ? N_PHASES : li + 1; a.li = li;
        void* kargs[] = {&a};
        (void)hipLaunchKernel(kfn(li), dim3(grid), dim3(512), kargs, LDS_BYTES, stream);
        const hipError_t le = hipPeekAtLastError();
        if (le != hipSuccess) { fprintf(stderr, "kernel_launch: launch %d failed: %s\n", li, hipGetErrorName(le)); break; }
    }
}
```

```cpp
#include <hip/hip_runtime.h>
#include <hip/hip_bf16.h>
#include <cstdio>
#include <cstdint>

#ifndef MK_N_LAUNCHES
#define MK_N_LAUNCHES 1
#endif
#ifndef CVT_IN_SCAN
#define CVT_IN_SCAN 1
#endif
constexpr int N_PHASES = 12;

constexpr int BATCH = 4, SEQ = 2048, DM = 2048, MTOK = BATCH * SEQ;
constexpr int IN_COLS = 6432, LDP = 6656;
constexpr int ZC0 = 3072;
constexpr int RW = 1024, NH_R = 16, HD_R = 64;
constexpr int NEXP = 16, CAP = 256, FF = 2048;
constexpr float QSCALE = 0.18033688011112042f;

constexpr size_t MiB = 1u << 20;
constexpr size_t WS_CTL = 0, CTL_ZERO_BYTES = 1 * MiB;
constexpr size_t WS_ROPE = 1 * MiB;
constexpr size_t WS_LORA = 2 * MiB;
constexpr size_t WS_AFF = 3 * MiB;
constexpr size_t WS_GATEX = 3 * MiB + 512 * 1024;
constexpr size_t WS_SLOT = 4 * MiB;
constexpr size_t WS_XEIDX = 6 * MiB;
constexpr size_t WS_BONUS = 5 * MiB;
constexpr size_t WS_WIN = 8 * MiB;
constexpr size_t WS_WOUT = 34 * MiB;
constexpr size_t WS_WGU = 48 * MiB;
constexpr size_t WS_WD = 304 * MiB;
constexpr size_t WS_H1 = 432 * MiB;
constexpr size_t WS_PROJ = 464 * MiB;
constexpr size_t WS_R = 568 * MiB, WS_KK = 584 * MiB, WS_V = 600 * MiB;
constexpr size_t WS_WDEC = 616 * MiB;
constexpr size_t WS_KD = 680 * MiB, WS_BB = 712 * MiB;
constexpr size_t WS_G = 744 * MiB;
constexpr size_t WS_OC = 760 * MiB;
constexpr size_t WS_YS = 792 * MiB;
constexpr size_t WS_MIX = 856 * MiB;
constexpr size_t WS_X1 = 888 * MiB;
constexpr size_t WS_H2 = 952 * MiB;
constexpr size_t WS_HID = 528 * MiB, WS_YE = 592 * MiB;
constexpr size_t WS_PART = WS_X1;
constexpr size_t WS_END = 984 * MiB;
constexpr int CW_BAR = 4096;

constexpr int LDS_BYTES = 147456;
constexpr int MISC_OFF = 131072 + 320;

#define GAS __attribute__((address_space(1)))
#define LAS __attribute__((address_space(3)))
typedef unsigned short bf16_t;
typedef float f32x4 __attribute__((ext_vector_type(4)));
typedef float f32x2 __attribute__((ext_vector_type(2)));
typedef float f32x16 __attribute__((ext_vector_type(16)));
typedef unsigned u32x4 __attribute__((ext_vector_type(4)));
typedef unsigned u32x2 __attribute__((ext_vector_type(2)));
typedef short bf16x8 __attribute__((ext_vector_type(8)));
typedef short s16x4 __attribute__((ext_vector_type(4)));
typedef __bf16 bf16x2_t __attribute__((ext_vector_type(2)));

__device__ __forceinline__ unsigned cvtpk(float lo, float hi) { f32x2 v = {lo, hi}; bf16x2_t b = __builtin_convertvector(v, bf16x2_t); return __builtin_bit_cast(unsigned, b); }
__device__ __forceinline__ float bf_lo(unsigned w) { return __uint_as_float(w << 16); }
__device__ __forceinline__ float bf_hi(unsigned w) { return __uint_as_float(w & 0xffff0000u); }
__device__ __forceinline__ float bf2f(bf16_t v) { return __uint_as_float((unsigned)v << 16); }
__device__ __forceinline__ float wave_sum(float v) {
#pragma unroll
    for (int o = 1; o < 64; o <<= 1) v += __shfl_xor(v, o);
    return v;
}
__device__ __forceinline__ float sigmoidf_(float x) { return 1.f / (1.f + __expf(-x)); }

struct Args { const void* in[28]; float* out; unsigned char* ws; int ph_lo, ph_hi, li, pad; };

namespace pg8 {
#define PG8_LAS __attribute__((address_space(3)))
typedef unsigned short bf16_t;
typedef short bf16x8 __attribute__((ext_vector_type(8)));
typedef float f32x4 __attribute__((ext_vector_type(4)));
typedef unsigned u32x4 __attribute__((ext_vector_type(4)));
typedef unsigned u32x2 __attribute__((ext_vector_type(2)));
typedef int i32x4 __attribute__((ext_vector_type(4)));
typedef int i32x8 __attribute__((ext_vector_type(8)));
typedef float f32x8 __attribute__((ext_vector_type(8)));
typedef float f32x32 __attribute__((ext_vector_type(32)));
constexpr int BM = 256, BK = 64, HALF = 128, HTB = HALF * BK * 2  , STAGE_BYTES = 8 * HTB, NXCD = 8, WGM = 8;

__host__ __device__ __forceinline__ int lds_byte(int r, int c) { const int st = (r >> 4) * 2 + (c >> 5), rr = r & 15, cc = c & 31, ob = rr * 64 + cc * 2; return st * 1024 + (ob ^ (((ob >> 9) & 1) << 5)); }
__host__ __device__ __forceinline__ void stage_rc(int b, int& R, int& C) { const int st = b / 1024, sb = b % 1024, swz = sb ^ (((sb >> 9) & 1) << 5); R = (st >> 1) * 16 + swz / 64; C = (st & 1) * 32 + (swz % 64) / 2; }
__host__ __device__ __forceinline__ int perm32(int rho) { const int n = rho >> 4, i = rho & 15; return 8 * (i >> 2) + 4 * n + (i & 3); }

struct Unit { int pm, pn, pk; };
struct Gemm { const bf16_t* A; const bf16_t* Bt; int M, N, K, Kp; };

struct StaticOrder {
    int nM, nN, nwg, G, c;
    __host__ __device__ void init(int M, int N, int G_, int c_) { nM = M / BM; nN = N / BM; nwg = nM * nN; G = G_; c = c_; }
    __host__ __device__ bool next(int i, Unit& u) const {
        const long L = (long)i * G + c; if (L >= nwg) return false;
        int wgid = (int)L; { const int q = nwg / NXCD, r = nwg % NXCD, xcd = wgid % NXCD, off = wgid / NXCD; wgid = (xcd < r ? xcd * (q + 1) : r * (q + 1) + (xcd - r) * q) + off; }
        const int nig = WGM * nN, gid = wgid / nig, fm = gid * WGM, gsz = (nM - fm) < WGM ? (nM - fm) : WGM;
        u.pm = fm + ((wgid % nig) % gsz); u.pn = (wgid % nig) / gsz; u.pk = 0; return true;
    }
    static constexpr bool GATHER = false;
    __device__ __forceinline__ int arow(const Unit&, int) const { return 0; }
    __device__ __forceinline__ void a_ready(const Unit&) const {}
    __device__ __forceinline__ void done(const Unit&) const {}
};


typedef float f32x2 __attribute__((ext_vector_type(2)));
typedef __bf16 bf16x2_t __attribute__((ext_vector_type(2)));
__device__ __forceinline__ unsigned cvt_pk_bf16(float lo, float hi) { f32x2 v = {lo, hi}; bf16x2_t b = __builtin_convertvector(v, bf16x2_t); return __builtin_bit_cast(unsigned, b); }

template <bool GATHER_> struct MoeOrderT {
    static constexpr bool GATHER = GATHER_;
    int G, vcu, npn, total; const int* idx;
    __device__ __forceinline__ int arow(const Unit& u, int r) const { return idx[u.pm * BM + r]; }
    __device__ bool next(int i, Unit& u) const {
        const int L = i * G + vcu; if (L >= total) return false;
        const int per_e = 4 * npn, e = L / per_e, r = L % per_e;
        u.pm = e * 4 + (r & 3); u.pn = e * npn + (r >> 2); u.pk = 0; return true;
    }
    __device__ __forceinline__ void a_ready(const Unit&) const {}
    __device__ __forceinline__ void done(const Unit&) const {}
};

struct TailOrder {
    int G, c; static constexpr bool GATHER = false;
    __device__ bool next(int i, Unit& u) const { const int L = i * G + c; if (L >= 256) return false; u.pk = L & 3; const int t = L >> 2; u.pm = t & 31; u.pn = 24 + (t >> 5); return true; }
    __device__ __forceinline__ int arow(const Unit&, int) const { return 0; }
    __device__ __forceinline__ void a_ready(const Unit&) const {}
    __device__ __forceinline__ void done(const Unit&) const {}
};
struct EpiPart {
    static constexpr bool PERM = true, AFTER_DRAIN = false;
    bf16_t* P;
    __device__ __forceinline__ void operator()(const f32x4 (&acc)[2][2][4][2], const Unit& u, int wr, int wc, int fr, int fq) const {
        bf16_t* base = P + ((size_t)(((u.pn - 24) * 32 + u.pm) * 4 + u.pk) << 16);
        const int row0 = wr * 64 + fr, col0 = wc * 32 + 8 * fq;
        const bool thin = (u.pn == 25);
        if (thin && wc != 0) return;
#pragma unroll
        for (int ai = 0; ai < 2; ++ai)
#pragma unroll
            for (int m = 0; m < 4; ++m) {
                bf16_t* rowp = base + (row0 + ai * HALF + m * 16) * 256 + col0;
#pragma unroll
                for (int bj = 0; bj < 2; ++bj) { if (bj == 1 && thin) break; const f32x4 v0 = acc[ai][bj][m][0], v1 = acc[ai][bj][m][1];
                    u32x4 w; w.x = cvt_pk_bf16(v0[0], v0[1]); w.y = cvt_pk_bf16(v0[2], v0[3]); w.z = cvt_pk_bf16(v1[0], v1[1]); w.w = cvt_pk_bf16(v1[2], v1[3]);
                    *(u32x4*)(rowp + bj * HALF) = w; }
            }
    }
};

struct EpiProj {
    static constexpr bool PERM = true, AFTER_DRAIN = false;
    bf16_t* P; int ldp; const float* rope; float qscale;
    __device__ __forceinline__ void operator()(const f32x4 (&acc)[2][2][4][2], const Unit& u, int wr, int wc, int fr, int fq) const {
        const int row0 = u.pm * BM + wr * 64 + fr, colt = u.pn * BM, col0 = colt + wc * 32 + 8 * fq;
        const bool ropew = (colt < 2048) && ((wc & 1) == 0);
        const float sc = (colt < 1024) ? qscale : 1.f, sgn = (fq == 0) ? -1.f : 1.f;
#pragma unroll
        for (int ai = 0; ai < 2; ++ai)
#pragma unroll
            for (int m = 0; m < 4; ++m) {
                const int row = row0 + ai * HALF + m * 16;
                f32x4 c0 = {1.f, 1.f, 1.f, 1.f}, c1 = c0, s0 = {0.f, 0.f, 0.f, 0.f}, s1 = s0;
                if (ropew) { const f32x4* rp = (const f32x4*)(rope + (size_t)row * 16); c0 = rp[0]; c1 = rp[1]; s0 = rp[2]; s1 = rp[3]; }
                bf16_t* rowp = P + (size_t)row * ldp + col0;
#pragma unroll
                for (int bj = 0; bj < 2; ++bj) {
                    f32x4 v0 = acc[ai][bj][m][0], v1 = acc[ai][bj][m][1];
                    if (ropew) {
                        f32x4 p0, p1;
#pragma unroll
                        for (int i = 0; i < 4; ++i) { p0[i] = __shfl_xor(v0[i], 16); p1[i] = __shfl_xor(v1[i], 16); }
                        if (fq < 2) { v0 = v0 * c0 + (p0 * s0) * sgn; v1 = v1 * c1 + (p1 * s1) * sgn; }
                    }
                    v0 = v0 * sc; v1 = v1 * sc;
                    u32x4 w; w.x = cvt_pk_bf16(v0[0], v0[1]); w.y = cvt_pk_bf16(v0[2], v0[3]); w.z = cvt_pk_bf16(v1[0], v1[1]); w.w = cvt_pk_bf16(v1[2], v1[3]);
                    *(u32x4*)(rowp + bj * HALF) = w;
                }
            }
    }
};

struct EpiResid {
    static constexpr bool PERM = true, AFTER_DRAIN = false;
    const float* base; bf16_t* out; int ldc;
    __device__ __forceinline__ void operator()(const f32x4 (&acc)[2][2][4][2], const Unit& u, int wr, int wc, int fr, int fq) const {
        const int row0 = u.pm * BM + wr * 64 + fr, col0 = u.pn * BM + wc * 32 + 8 * fq;
#pragma unroll
        for (int ai = 0; ai < 2; ++ai)
#pragma unroll
            for (int m = 0; m < 4; ++m) {
                const size_t off = (size_t)(row0 + ai * HALF + m * 16) * ldc + col0;
#pragma unroll
                for (int bj = 0; bj < 2; ++bj) { const f32x4 b0 = *(const f32x4*)(base + off + bj * HALF), b1 = *(const f32x4*)(base + off + bj * HALF + 4);
                    const f32x4 v0 = b0 + acc[ai][bj][m][0], v1 = b1 + acc[ai][bj][m][1];
                    u32x4 w; w.x = cvt_pk_bf16(v0[0], v0[1]); w.y = cvt_pk_bf16(v0[2], v0[3]); w.z = cvt_pk_bf16(v1[0], v1[1]); w.w = cvt_pk_bf16(v1[2], v1[3]);
                    *(u32x4*)(out + off + bj * HALF) = w; }
            }
    }
};

__device__ __forceinline__ float clamp8(float x) { return __builtin_fminf(__builtin_fmaxf(x, -448.f), 448.f); }
__device__ __forceinline__ unsigned cvt4_fp8(float a, float b, float c, float d) {
    int w = __builtin_amdgcn_cvt_pk_fp8_f32(clamp8(a), clamp8(b), 0, false); w = __builtin_amdgcn_cvt_pk_fp8_f32(clamp8(c), clamp8(d), w, true); return (unsigned)w; }
constexpr float W8_SCALE = 64.f, W8_DESCALE = 1.f / 64.f;

struct EpiSwiglu {
    static constexpr bool PERM = true, AFTER_DRAIN = false;
    unsigned char* H; int npn;
    __device__ __forceinline__ void operator()(const f32x4 (&acc)[2][2][4][2], const Unit& u, int wr, int wc, int fr, int fq) const {
        const int row0 = u.pm * BM + wr * 64 + fr, pnl = u.pn % npn, col0 = pnl * HALF + wc * 32 + 8 * fq;
#pragma unroll
        for (int ai = 0; ai < 2; ++ai)
#pragma unroll
            for (int m = 0; m < 4; ++m) {
                unsigned char* rowp = H + (size_t)(row0 + ai * HALF + m * 16) * 2048 + col0;
                float h[8];
#pragma unroll
                for (int n = 0; n < 2; ++n)
#pragma unroll
                    for (int i = 0; i < 4; ++i) { const float g = acc[ai][0][m][n][i] * W8_DESCALE, up = acc[ai][1][m][n][i] * W8_DESCALE; h[n * 4 + i] = g * up * __builtin_amdgcn_rcpf(1.f + __expf(-g)); }
                u32x2 w; w.x = cvt4_fp8(h[0], h[1], h[2], h[3]); w.y = cvt4_fp8(h[4], h[5], h[6], h[7]);
                *(u32x2*)rowp = w;
            }
    }
};

constexpr float YE_SCALE = 16.f, YE_DESCALE = 1.f / 16.f;
struct EpiDown {
    static constexpr bool PERM = true, AFTER_DRAIN = false;
    unsigned char* Y; const float* gate; int npn;
    __device__ __forceinline__ void operator()(const f32x4 (&acc)[2][2][4][2], const Unit& u, int wr, int wc, int fr, int fq) const {
        const int row0 = u.pm * BM + wr * 64 + fr, pnl = u.pn % npn, col0 = pnl * BM + wc * 32 + 8 * fq;
#pragma unroll
        for (int ai = 0; ai < 2; ++ai)
#pragma unroll
            for (int m = 0; m < 4; ++m) {
                const int row = row0 + ai * HALF + m * 16; const float gt = gate[row] * (W8_DESCALE * YE_SCALE);
                unsigned char* rowp = Y + (size_t)row * 2048 + col0;
#pragma unroll
                for (int bj = 0; bj < 2; ++bj) { const f32x4 v0 = acc[ai][bj][m][0] * gt, v1 = acc[ai][bj][m][1] * gt;
                    u32x2 w; w.x = cvt4_fp8(v0[0], v0[1], v0[2], v0[3]); w.y = cvt4_fp8(v1[0], v1[1], v1[2], v1[3]);
                    *(u32x2*)(rowp + bj * HALF) = w; }
            }
    }
};

template <class Epi, class Sched, bool ALIGN_EPI = false, bool SP2 = false, bool FP8 = false>
__device__ __forceinline__ void gemm_phase(PG8_LAS unsigned char* lds, const Gemm g, const Sched& S, const Epi& E) {
    const int tid = threadIdx.x, wid = __builtin_amdgcn_readfirstlane(tid >> 6), lane = tid & 63, wr = wid >> 2, wc = wid & 3, fr = lane & 15, fq = lane >> 4;
    const int K = g.Kp, nt = g.K / BK;
    const size_t kslice = (size_t)g.K * 2;
    unsigned voffA[2], voffB[2];
#pragma unroll
    for (int i = 0; i < 2; ++i) { int R, C; stage_rc(tid * 16 + i * 8192, R, C); const int Rb = Epi::PERM ? ((R & ~31) + perm32(R & 31)) : R;
        voffA[i] = (unsigned)(R * K + C) * 2u; voffB[i] = (unsigned)(Rb * K + C) * 2u; }
    static_assert(!Sched::GATHER || SP2, "gathered A rows: SP2 loop only");
    const size_t kstep = (size_t)(BK * 2);
    const size_t hstep = (size_t)HALF * K * 2;
    const size_t tstep = 2 * hstep;
    const unsigned ldsw = (unsigned)wid * 1024u;
    const int aoff = lds_byte(wr * 64 + fr, fq * 8), boff = lds_byte(wc * 32 + fr, fq * 8);
#define PG8_SA(b, h) (((b) * 2 + (h)) * HTB)
#define PG8_SB(b, h) ((4 + (b) * 2 + (h)) * HTB)
#define PG8_STAGE(bufoff, gbase, voff) do { _Pragma("unroll") for (int _i = 0; _i < 2; ++_i) \
        __builtin_amdgcn_global_load_lds((const unsigned*)((const char*)(gbase) + (voff)[_i]), (PG8_LAS unsigned*)(lds + (bufoff) + ldsw + _i * 8192), 16, 0, 0); } while (0)
#define PG8_LDA(dst, b, h) do { _Pragma("unroll") for (int m = 0; m < 4; ++m) _Pragma("unroll") for (int k = 0; k < 2; ++k) dst[m][k] = *(const PG8_LAS bf16x8*)(lds + PG8_SA(b, h) + aoff + m * 2048 + k * 1024); } while (0)
#define PG8_LDB(dst, b, h) do { _Pragma("unroll") for (int n = 0; n < 2; ++n) _Pragma("unroll") for (int k = 0; k < 2; ++k) dst[n][k] = *(const PG8_LAS bf16x8*)(lds + PG8_SB(b, h) + boff + n * 2048 + k * 1024); } while (0)
#define PG8_CAT8(x, y) __builtin_shufflevector(__builtin_bit_cast(i32x4, x), __builtin_bit_cast(i32x4, y), 0, 1, 2, 3, 4, 5, 6, 7)
#define PG8_W8(c) __builtin_shufflevector(c, c, 0, 1, 2, 3, -1, -1, -1, -1)
#define PG8_MMA(ai, bj, At, Bt) do { __builtin_amdgcn_s_setprio(1); \
        if constexpr (FP8) { f32x32 a_ = acc32[ai][bj]; _Pragma("unroll") for (int m = 0; m < 4; ++m) _Pragma("unroll") for (int n = 0; n < 2; ++n) { \
            f32x4 c_ = {a_[(m * 2 + n) * 4], a_[(m * 2 + n) * 4 + 1], a_[(m * 2 + n) * 4 + 2], a_[(m * 2 + n) * 4 + 3]}; \
            c_ = __builtin_amdgcn_mfma_scale_f32_16x16x128_f8f6f4(PG8_CAT8(Bt[n][0], Bt[n][1]), PG8_CAT8(At[m][0], At[m][1]), c_, 0, 0, 0, 0, 0, 0); \
            a_[(m * 2 + n) * 4] = c_[0]; a_[(m * 2 + n) * 4 + 1] = c_[1]; a_[(m * 2 + n) * 4 + 2] = c_[2]; a_[(m * 2 + n) * 4 + 3] = c_[3]; } acc32[ai][bj] = a_; } \
        else { _Pragma("unroll") for (int m = 0; m < 4; ++m) _Pragma("unroll") for (int n = 0; n < 2; ++n) _Pragma("unroll") for (int k = 0; k < 2; ++k) \
            acc[ai][bj][m][n] = __builtin_amdgcn_mfma_f32_16x16x32_bf16(Bt[n][k], At[m][k], acc[ai][bj][m][n], 0, 0, 0); } __builtin_amdgcn_s_setprio(0); } while (0)
#define PG8_WAIT_V(n) asm volatile("s_waitcnt vmcnt(" #n ")" ::: "memory")
#define PG8_WAIT_L(n) asm volatile("s_waitcnt lgkmcnt(" #n ")" ::: "memory")
#define PG8_BAR __builtin_amdgcn_s_barrier()
#define PG8_SCHED __builtin_amdgcn_sched_barrier(0)
    Unit cur, nxt; int ui = 0;
    if (!S.next(0, cur)) return;
    f32x4 acc[2][2][4][2]; f32x32 acc32[2][2];
#pragma unroll
    for (int a = 0; a < 2; ++a)
#pragma unroll
        for (int b = 0; b < 2; ++b)
#pragma unroll
            for (int m = 0; m < 4; ++m) {
#pragma unroll
                for (int n = 0; n < 2; ++n) { acc[a][b][m][n] = (f32x4){0.f, 0.f, 0.f, 0.f};
#pragma unroll
                    for (int i = 0; i < 4; ++i) acc32[a][b][(m * 2 + n) * 4 + i] = 0.f; } }
    bf16x8 At[4][2], B0[2][2], B1[2][2];
    const char* cA = (const char*)g.A + (size_t)cur.pm * tstep + (size_t)cur.pk * kslice; const char* cB = (const char*)g.Bt + (size_t)cur.pn * tstep + (size_t)cur.pk * kslice;
    unsigned cvA0[2], cvA1[2], nvA0[2], nvA1[2];
#pragma unroll
    for (int i = 0; i < 2; ++i) { int R, C; stage_rc(tid * 16 + i * 8192, R, C);
        if constexpr (Sched::GATHER) { cvA0[i] = (unsigned)(S.arow(cur, R) * K + C) * 2u; cvA1[i] = (unsigned)(S.arow(cur, HALF + R) * K + C) * 2u; }
        else { cvA0[i] = voffA[i]; cvA1[i] = voffA[i] + (unsigned)hstep; }
        nvA0[i] = cvA0[i]; nvA1[i] = cvA1[i]; }
    if constexpr (Sched::GATHER) cA = (const char*)g.A;
    S.a_ready(cur);
    if constexpr (SP2) {
        PG8_STAGE(PG8_SB(0, 0), cB, voffB); PG8_STAGE(PG8_SB(0, 1), cB + hstep, voffB); PG8_STAGE(PG8_SA(0, 0), cA, cvA0); PG8_STAGE(PG8_SA(0, 1), cA, cvA1);
        if (wr == 1) PG8_BAR;
        PG8_WAIT_V(2); PG8_BAR;
        PG8_STAGE(PG8_SB(1, 0), cB + kstep, voffB); PG8_STAGE(PG8_SA(1, 0), cA + kstep, cvA0); PG8_STAGE(PG8_SB(1, 1), cB + hstep + kstep, voffB);
        PG8_WAIT_V(6); PG8_BAR;
    } else {
        PG8_STAGE(PG8_SB(0, 0), cB, voffB); PG8_STAGE(PG8_SA(0, 0), cA, voffA); PG8_STAGE(PG8_SB(0, 1), cB + hstep, voffB); PG8_STAGE(PG8_SA(0, 1), cA + hstep, voffA);
        if (wr == 1) PG8_BAR;
        PG8_WAIT_V(4); PG8_BAR;
        PG8_STAGE(PG8_SB(1, 0), cB + kstep, voffB); PG8_STAGE(PG8_SA(1, 0), cA + kstep, voffA); PG8_STAGE(PG8_SB(1, 1), cB + hstep + kstep, voffB);
        PG8_WAIT_V(6); PG8_BAR;
    }
    for (;;) {
        const bool has_next = S.next(ui + 1, nxt);
        const char* nA = Sched::GATHER ? (const char*)g.A : (has_next ? (const char*)g.A + (size_t)nxt.pm * tstep + (size_t)nxt.pk * kslice : cA);
        if constexpr (Sched::GATHER) { if (has_next) {
#pragma unroll
            for (int i = 0; i < 2; ++i) { int R, C; stage_rc(tid * 16 + i * 8192, R, C); nvA0[i] = (unsigned)(S.arow(nxt, R) * K + C) * 2u; nvA1[i] = (unsigned)(S.arow(nxt, HALF + R) * K + C) * 2u; } } } const char* nB = has_next ? (const char*)g.Bt + (size_t)nxt.pn * tstep + (size_t)nxt.pk * kslice : cB;
        for (int t = 0; t < nt; t += 2) {
            const bool last = (t == nt - 2);
            const char* a1 = cA + (size_t)(t + 1) * kstep;
            const char* a2 = last ? nA : cA + (size_t)(t + 2) * kstep; const char* b2 = last ? nB : cB + (size_t)(t + 2) * kstep;
            const char* a3 = a2 + kstep; const char* b3 = b2 + kstep;
            if (last && has_next) S.a_ready(nxt);
            unsigned sA0[2], sA1[2];
#pragma unroll
            for (int i = 0; i < 2; ++i) { sA0[i] = last ? nvA0[i] : cvA0[i]; sA1[i] = last ? nvA1[i] : cvA1[i]; }
            if constexpr (SP2) {
            PG8_LDB(B0, 0, 0); PG8_LDB(B1, 0, 1); PG8_SCHED; PG8_LDA(At, 0, 0); PG8_STAGE(PG8_SA(1, 1), a1, cvA1);
            PG8_WAIT_V(8); PG8_WAIT_L(0); PG8_BAR; PG8_MMA(0, 0, At, B0); PG8_MMA(0, 1, At, B1); PG8_BAR; PG8_SCHED;
            PG8_LDA(At, 0, 1); PG8_STAGE(PG8_SB(0, 0), b2, voffB); PG8_STAGE(PG8_SB(0, 1), b2 + hstep, voffB); PG8_STAGE(PG8_SA(0, 0), a2, sA0);
            PG8_WAIT_V(8); PG8_WAIT_L(0); PG8_BAR; PG8_MMA(1, 0, At, B0); PG8_MMA(1, 1, At, B1); PG8_BAR; PG8_SCHED;
            PG8_LDB(B0, 1, 0); PG8_LDB(B1, 1, 1); PG8_SCHED; PG8_LDA(At, 1, 0); PG8_STAGE(PG8_SA(0, 1), a2, sA1);
            PG8_WAIT_V(8); PG8_WAIT_L(0); PG8_BAR; PG8_MMA(0, 0, At, B0); PG8_MMA(0, 1, At, B1); PG8_BAR; PG8_SCHED;
            PG8_LDA(At, 1, 1); PG8_STAGE(PG8_SB(1, 0), b3, voffB); PG8_STAGE(PG8_SB(1, 1), b3 + hstep, voffB); PG8_STAGE(PG8_SA(1, 0), a3, sA0);
            PG8_WAIT_V(8); PG8_WAIT_L(0); PG8_BAR; PG8_MMA(1, 0, At, B0); PG8_MMA(1, 1, At, B1); PG8_BAR; PG8_SCHED;
            } else {
            PG8_LDB(B0, 0, 0); PG8_SCHED; PG8_LDA(At, 0, 0); PG8_STAGE(PG8_SA(1, 1), a1 + hstep, voffA);
            PG8_WAIT_L(8); PG8_BAR; PG8_WAIT_L(0); PG8_MMA(0, 0, At, B0); PG8_BAR; PG8_SCHED;
            PG8_LDB(B1, 0, 1); PG8_STAGE(PG8_SB(0, 0), b2, voffB);
            PG8_BAR; PG8_WAIT_L(0); PG8_MMA(0, 1, At, B1); PG8_BAR;
            PG8_LDA(At, 0, 1); PG8_STAGE(PG8_SA(0, 0), a2, voffA);
            PG8_BAR; PG8_WAIT_L(0); PG8_MMA(1, 0, At, B0); PG8_BAR; PG8_SCHED;
            PG8_STAGE(PG8_SB(0, 1), b2 + hstep, voffB);
            PG8_WAIT_V(6); PG8_BAR; PG8_MMA(1, 1, At, B1); PG8_BAR;
            PG8_LDB(B0, 1, 0); PG8_SCHED; PG8_LDA(At, 1, 0); PG8_STAGE(PG8_SA(0, 1), a2 + hstep, voffA);
            PG8_WAIT_L(8); PG8_BAR; PG8_WAIT_L(0); PG8_MMA(0, 0, At, B0); PG8_BAR; PG8_SCHED;
            PG8_LDB(B1, 1, 1); PG8_STAGE(PG8_SB(1, 0), b3, voffB);
            PG8_BAR; PG8_WAIT_L(0); PG8_MMA(0, 1, At, B1); PG8_BAR;
            PG8_LDA(At, 1, 1); PG8_STAGE(PG8_SA(1, 0), a3, voffA);
            PG8_BAR; PG8_WAIT_L(0); PG8_MMA(1, 0, At, B0); PG8_BAR; PG8_SCHED;
            PG8_STAGE(PG8_SB(1, 1), b3 + hstep, voffB);
            PG8_WAIT_V(6); PG8_BAR; PG8_MMA(1, 1, At, B1); PG8_BAR;
            }
        }
        if constexpr (ALIGN_EPI) { if (wr == 0) PG8_BAR; }
        if constexpr (FP8) {
#pragma unroll
            for (int a = 0; a < 2; ++a)
#pragma unroll
                for (int b = 0; b < 2; ++b)
#pragma unroll
                    for (int m = 0; m < 4; ++m)
#pragma unroll
                        for (int n = 0; n < 2; ++n)
#pragma unroll
                            for (int i = 0; i < 4; ++i) acc[a][b][m][n][i] = acc32[a][b][(m * 2 + n) * 4 + i]; }
        if constexpr (!Epi::AFTER_DRAIN) { E(acc, cur, wr, wc, fr, fq); S.done(cur); }
        if (!has_next) break;
#pragma unroll
        for (int a = 0; a < 2; ++a)
#pragma unroll
            for (int b = 0; b < 2; ++b)
#pragma unroll
                for (int m = 0; m < 4; ++m) {
#pragma unroll
                    for (int n = 0; n < 2; ++n) { acc[a][b][m][n] = (f32x4){0.f, 0.f, 0.f, 0.f};
#pragma unroll
                        for (int i = 0; i < 4; ++i) acc32[a][b][(m * 2 + n) * 4 + i] = 0.f; } }
        cur = nxt; cA = nA; cB = nB; ++ui;
#pragma unroll
        for (int i = 0; i < 2; ++i) { cvA0[i] = nvA0[i]; cvA1[i] = nvA1[i]; }
        if constexpr (ALIGN_EPI) { if (wr == 1) PG8_BAR; }
    }
    PG8_WAIT_V(0);
    if constexpr (!ALIGN_EPI) { if (wr == 0) PG8_BAR; }
    PG8_BAR;
    if constexpr (Epi::AFTER_DRAIN) { E.fused(acc, cur, wr, wc, fr, fq, lds, wid, lane); S.done(cur); }
#undef PG8_SA
#undef PG8_SB
#undef PG8_STAGE
#undef PG8_LDA
#undef PG8_LDB
#undef PG8_MMA
#undef PG8_CAT8
#undef PG8_W8
#undef PG8_WAIT_V
#undef PG8_WAIT_L
#undef PG8_BAR
#undef PG8_SCHED
}
}

namespace att {
constexpr int NW = 8, QBLK = 32, KVBLK = 64;
constexpr float THR = 8.f;
constexpr int SHM_V = KVBLK * 128 * 2, SHM_K = KVBLK * 64 * 2;
constexpr int SHM_ATTN = 2 * SHM_V + 2 * SHM_K + NW * 64 * 4;
#define KSWZ64(row, colB) ((row) * 128 + ((colB) ^ ((((row) >> 1) & 7) << 4)))
#define SBAR() __builtin_amdgcn_sched_barrier(0)
__device__ __forceinline__ int crow(int r, int hi) { return (r & 3) + 8 * (r >> 2) + 4 * hi; }

__device__ __forceinline__ void partialSM(f32x16& p0, f32x16& p1, float& m_reg, float& mn, float& alpha) {
  float pmax = p0[0];
#pragma unroll
  for (int r = 1; r < 16; ++r) pmax = fmaxf(pmax, p0[r]);
#pragma unroll
  for (int r = 0; r < 16; ++r) pmax = fmaxf(pmax, p1[r]);
  { auto rr = __builtin_amdgcn_permlane32_swap(__float_as_uint(pmax), __float_as_uint(pmax), false, false);
    pmax = fmaxf(__uint_as_float(rr[0]), __uint_as_float(rr[1])); }
  if (__builtin_expect(__all(pmax - m_reg <= THR), 1)) { mn = m_reg; alpha = 1.f; }
  else { mn = fmaxf(m_reg, pmax); alpha = __builtin_amdgcn_exp2f(m_reg - mn); m_reg = mn; }
#pragma unroll
  for (int r = 0; r < 16; ++r) p0[r] = p0[r] - mn;
#pragma unroll
  for (int r = 0; r < 16; ++r) p1[r] = p1[r] - mn;
#pragma unroll
  for (int r = 0; r < 16; ++r) p0[r] = __builtin_amdgcn_exp2f(p0[r]);
}
__device__ __forceinline__ void finishSM(f32x16& p0, f32x16& p1, float alpha, float& l_reg, bf16x8& pa0, bf16x8& pa1, bf16x8& pa2, bf16x8& pa3) {
#pragma unroll
  for (int r = 0; r < 16; ++r) p1[r] = __builtin_amdgcn_exp2f(p1[r]);
  float ps = 0;
#pragma unroll
  for (int r = 0; r < 16; ++r) ps += p0[r];
#pragma unroll
  for (int r = 0; r < 16; ++r) ps += p1[r];
  { auto rr = __builtin_amdgcn_permlane32_swap(__float_as_uint(ps), __float_as_uint(ps), false, false);
    ps = __uint_as_float(rr[0]) + __uint_as_float(rr[1]); }
  l_reg = l_reg * alpha + ps;
#define PK4(P, BASE, OUT) do { unsigned a0 = cvtpk(P[BASE + 0], P[BASE + 1]), a1 = cvtpk(P[BASE + 2], P[BASE + 3]);   \
    unsigned b0 = cvtpk(P[BASE + 4], P[BASE + 5]), b1 = cvtpk(P[BASE + 6], P[BASE + 7]);                              \
    auto r0 = __builtin_amdgcn_permlane32_swap(a0, b0, false, false); auto r1 = __builtin_amdgcn_permlane32_swap(a1, b1, false, false); \
    u32x4 w = {r0[0], r1[0], r0[1], r1[1]}; OUT = __builtin_bit_cast(bf16x8, w); } while (0)
  PK4(p0, 0, pa0); PK4(p0, 8, pa1); PK4(p1, 0, pa2); PK4(p1, 8, pa3);
#undef PK4
}
__device__ __forceinline__ void qkt(f32x16& p0, f32x16& p1, const char* Ks, const bf16x8* qr, int r32, int hi) {
  p0 = f32x16{}; p1 = f32x16{};
#pragma unroll
  for (int d0 = 0; d0 < 4; ++d0) { const int cb = (d0 * 16 + hi * 8) * 2;
    bf16x8 b0 = *reinterpret_cast<const bf16x8*>(Ks + KSWZ64(r32, cb));
    bf16x8 b1 = *reinterpret_cast<const bf16x8*>(Ks + KSWZ64(32 + r32, cb));
    p0 = __builtin_amdgcn_mfma_f32_32x32x16_bf16(b0, qr[d0], p0, 0, 0, 0);
    p1 = __builtin_amdgcn_mfma_f32_32x32x16_bf16(b1, qr[d0], p1, 0, 0, 0); }
}
__device__ __forceinline__ int v_st(int k, int c) { const int kk = (k & ~0xC) | ((k & 4) << 1) | ((k & 8) >> 1); return ((kk >> 3) * 4 + (c >> 5)) * 512 + ((kk & 7) * 32 + (c & 31)) * 2; }
__device__ __forceinline__ int v_rd_base(int lane) { return ((lane & 3) << 3) | (((lane >> 2) & 3) << 6) | (((lane >> 4) & 1) << 5) | (((lane >> 5) & 1) << 8); }
constexpr int v_rd_off(int d0, int ks, int half) { return d0 * 512 + ks * 4096 + half * 2048; }
template <int OFF> __device__ __forceinline__ s16x4 tr_read(int vb) {
  s16x4 r; asm volatile("ds_read_b64_tr_b16 %0, %1 offset:%2" : "=&v"(r) : "v"(vb), "i"(OFF) : "memory"); return r;
}
template <int D0> __device__ __forceinline__ void pv_one(f32x16& od, int vb, bf16x8 pa0, bf16x8 pa1, bf16x8 pa2, bf16x8 pa3) {
  const s16x4 l0 = tr_read<v_rd_off(D0, 0, 0)>(vb), h0 = tr_read<v_rd_off(D0, 0, 1)>(vb), l1 = tr_read<v_rd_off(D0, 1, 0)>(vb), h1 = tr_read<v_rd_off(D0, 1, 1)>(vb);
  const s16x4 l2 = tr_read<v_rd_off(D0, 2, 0)>(vb), h2 = tr_read<v_rd_off(D0, 2, 1)>(vb), l3 = tr_read<v_rd_off(D0, 3, 0)>(vb), h3 = tr_read<v_rd_off(D0, 3, 1)>(vb);
  asm volatile("s_waitcnt lgkmcnt(0)" ::: "memory"); SBAR();
#define PK(L, H) (bf16x8){L[0], L[1], L[2], L[3], H[0], H[1], H[2], H[3]}
  od = __builtin_amdgcn_mfma_f32_32x32x16_bf16(pa0, PK(l0, h0), od, 0, 0, 0);
  od = __builtin_amdgcn_mfma_f32_32x32x16_bf16(pa1, PK(l1, h1), od, 0, 0, 0);
  od = __builtin_amdgcn_mfma_f32_32x32x16_bf16(pa2, PK(l2, h2), od, 0, 0, 0);
  od = __builtin_amdgcn_mfma_f32_32x32x16_bf16(pa3, PK(l3, h3), od, 0, 0, 0);
#undef PK
}
__device__ __forceinline__ void pv_d0(f32x16* o, int vb, bf16x8 pa0, bf16x8 pa1, bf16x8 pa2, bf16x8 pa3) {
  pv_one<0>(o[0], vb, pa0, pa1, pa2, pa3); pv_one<1>(o[1], vb, pa0, pa1, pa2, pa3); pv_one<2>(o[2], vb, pa0, pa1, pa2, pa3); pv_one<3>(o[3], vb, pa0, pa1, pa2, pa3);
}

template <int LDQ>
__device__ __forceinline__ void attn_unit(const bf16_t* __restrict__ Qb, const bf16_t* __restrict__ Kh, const bf16_t* __restrict__ Vh, bf16_t* __restrict__ Ob, int seq, char* lds) {
  const int tid = threadIdx.x, wid = tid >> 6, lane = tid & 63, r32 = lane & 31, hi = lane >> 5;
  char* V_lds = lds; char* K_lds = lds + 2 * SHM_V;
  float* ws = (float*)(lds + 2 * SHM_V + 2 * SHM_K) + wid * 64; float* li_l = ws; float* al_l = ws + 32;
  float m_reg = -1e30f, l_reg = 0; f32x16 o[4] = {}; bf16x8 qr[4];
  const bf16_t* Qw = Qb + (long)(wid * QBLK + r32) * LDQ + hi * 8;
#pragma unroll
  for (int d0 = 0; d0 < 4; ++d0) qr[d0] = *reinterpret_cast<const bf16x8*>(Qw + d0 * 16);
  const int sr = tid >> 4, sc = (tid & 15) * 8, vst0 = v_st(sr, sc), vst1 = v_st(32 + sr, sc);
  const int kr = tid >> 3, kc8 = (tid & 7) * 8, kst = KSWZ64(kr, kc8 * 2);
  const int vb0 = (int)(uintptr_t)V_lds + v_rd_base(lane);
  struct { bf16x8 vs0, vs1, ks; } sr_[2];
  const bf16_t* Vp0 = Vh + (long)sr * LDQ + sc; const bf16_t* Kp0 = Kh + (long)kr * LDQ + kc8;
#define SLOAD(i, k0) do { const long ko_ = (long)(k0) * LDQ; sr_[i].vs0 = *reinterpret_cast<const bf16x8*>(Vp0 + ko_); sr_[i].vs1 = *reinterpret_cast<const bf16x8*>(Vp0 + ko_ + 32 * LDQ); \
    sr_[i].ks = *reinterpret_cast<const bf16x8*>(Kp0 + ko_); } while (0)
#define SWRITE(b, i) do { *(bf16x8*)(V_lds + (b) * SHM_V + vst0) = sr_[i].vs0; *(bf16x8*)(V_lds + (b) * SHM_V + vst1) = sr_[i].vs1; \
    *(bf16x8*)(K_lds + (b) * SHM_K + kst) = sr_[i].ks; } while (0)
#define SWAIT() asm volatile("s_waitcnt vmcnt(3)" ::: "memory")
#define RESC(a) do { if (__any((a) < 1.f)) { if (hi == 0) al_l[r32] = (a); asm volatile("s_waitcnt lgkmcnt(0)" ::: "memory"); \
    _Pragma("unroll") for (int d = 0; d < 4; ++d) _Pragma("unroll") for (int r = 0; r < 16; ++r) o[d][r] *= al_l[crow(r, hi)]; } } while (0)
  f32x16 pA0, pA1, pB0, pB1; float mnA, mnB, alA, alB; bf16x8 pa0, pa1, pa2, pa3; const int NT = seq / KVBLK;
  constexpr int SE = 0, SO = 1;
  SLOAD(SE, 0); asm volatile("s_waitcnt vmcnt(0)" ::: "memory"); SWRITE(0, SE); __syncthreads();
  qkt(pA0, pA1, K_lds, qr, r32, hi); partialSM(pA0, pA1, m_reg, mnA, alA);
  SLOAD(SO, KVBLK); if (2 < NT) SLOAD(SE, 2 * KVBLK);
  SWAIT(); SWRITE(1, SO); __syncthreads();
  for (int j = 1; j + 1 < NT; j += 2) {
    SBAR(); qkt(pB0, pB1, K_lds + SHM_K, qr, r32, hi);
    finishSM(pA0, pA1, alA, l_reg, pa0, pa1, pa2, pa3); SBAR();
    SLOAD(SO, (j + 2) * KVBLK); SBAR();
    pv_d0(o, vb0, pa0, pa1, pa2, pa3); partialSM(pB0, pB1, m_reg, mnB, alB);
    __syncthreads(); SWAIT(); SWRITE(0, SE);
    RESC(alB); __syncthreads();
    SBAR(); qkt(pA0, pA1, K_lds, qr, r32, hi);
    finishSM(pB0, pB1, alB, l_reg, pa0, pa1, pa2, pa3); SBAR();
    if (j + 3 < NT) SLOAD(SE, (j + 3) * KVBLK); SBAR();
    pv_d0(o, vb0 + SHM_V, pa0, pa1, pa2, pa3); partialSM(pA0, pA1, m_reg, mnA, alA);
    __syncthreads(); SWAIT(); SWRITE(1, SO);
    RESC(alA); __syncthreads();
  }
  SBAR(); qkt(pB0, pB1, K_lds + SHM_K, qr, r32, hi);
  finishSM(pA0, pA1, alA, l_reg, pa0, pa1, pa2, pa3); SBAR();
  pv_d0(o, vb0, pa0, pa1, pa2, pa3); partialSM(pB0, pB1, m_reg, mnB, alB);
  __syncthreads(); RESC(alB);
  finishSM(pB0, pB1, alB, l_reg, pa0, pa1, pa2, pa3); SBAR();
  pv_d0(o, vb0 + SHM_V, pa0, pa1, pa2, pa3);
  if (hi == 0) li_l[r32] = l_reg; asm volatile("s_waitcnt lgkmcnt(0)" ::: "memory");
  float rli[16];
#pragma unroll
  for (int r = 0; r < 16; ++r) rli[r] = __builtin_amdgcn_rcpf(li_l[crow(r, hi)]);
  bf16_t* Ow = Ob + (long)(wid * QBLK) * 1024;
#pragma unroll
  for (int r = 0; r < 16; ++r) { const int orow = crow(r, hi);
#pragma unroll
    for (int d0 = 0; d0 < 4; ++d0) Ow[(long)orow * 1024 + d0 * 32 + r32] = (bf16_t)(cvtpk(o[d0][r] * rli[r], 0.f) & 0xffffu); }
  __syncthreads();
#undef SLOAD
#undef SWRITE
#undef SWAIT
#undef RESC
}
#undef SBAR
}


typedef GAS unsigned gu32;
#define RLX_AGENT __ATOMIC_RELAXED, __HIP_MEMORY_SCOPE_AGENT
#define XB_TMO      128
#define XB_XCNT(j)  (256  + 64 * (j))
#define XB_XSUB(j)  (1280 + 64 * (j))
#define XB_XGEN(j)  (2304 + 64 * (j))
#define XB_TOP      3328
#define XB_TOPGEN   3392
#define XCD_BAR_WORDS 3456
#define XB_SPIN_CAP (1u << 22)
__device__ __forceinline__ unsigned xb_ld(unsigned* p)              { return __hip_atomic_load(p, __ATOMIC_RELAXED, __HIP_MEMORY_SCOPE_AGENT); }
__device__ __forceinline__ unsigned xb_add(unsigned* p, unsigned v) { return __hip_atomic_fetch_add(p, v, __ATOMIC_RELAXED, __HIP_MEMORY_SCOPE_AGENT); }
__device__ __forceinline__ unsigned xb_xcc_id() { return (unsigned)__builtin_amdgcn_s_getreg((3 << 11) | 20) & 0xFu; }
#define XB_SPIN(cond, bar) do { unsigned _sp = 0; while (cond) { __builtin_amdgcn_s_sleep(1); \
    if ((++_sp & 255u) == 0u) { if (xb_ld(&(bar)[XB_TMO])) break; if (_sp > XB_SPIN_CAP) { atomicAdd(&(bar)[XB_TMO], 1u); break; } } } } while (0)
struct XcdBarrier { unsigned* bar; unsigned x; volatile LAS unsigned* st; };
__device__ __forceinline__ XcdBarrier xcd_barrier_post(unsigned* bar, volatile LAS unsigned* st) {
    XcdBarrier b; b.bar = bar; b.x = xb_xcc_id(); b.st = st;
    if (threadIdx.x == 0) (void)xb_add(&bar[XB_XCNT(b.x)], 1u);
    return b;
}
__device__ __forceinline__ void xcd_barrier_complete(unsigned* bar, unsigned x, unsigned& nloc, unsigned& nx) {
    const unsigned G = gridDim.x * gridDim.y * gridDim.z;
    unsigned sum, cnt, mine, sp = 0u;
    for (;;) {
        sum = 0u; cnt = 0u; mine = 0u;
#pragma unroll
        for (unsigned j = 0; j < 16; ++j) { const unsigned c = xb_ld(&bar[XB_XCNT(j)]); sum += c; cnt += (c > 0u) ? 1u : 0u; mine = (j == x) ? c : mine; }
        if (sum == G) break;
        __builtin_amdgcn_s_sleep(1);
        if ((++sp & 255u) == 0u) { if (xb_ld(&bar[XB_TMO])) break; if (sp > XB_SPIN_CAP) { atomicAdd(&bar[XB_TMO], 1u); break; } }
    }
    nloc = mine > 0u ? mine : 1u; nx = cnt > 0u ? cnt : 1u;
}
__device__ __forceinline__ void xcd_barrier(const XcdBarrier& b) {
    asm volatile("s_waitcnt vmcnt(0)" ::: "memory");
    __syncthreads();
    if (threadIdx.x == 0) {
        unsigned* bar = b.bar;
        __builtin_amdgcn_s_waitcnt(0);
        unsigned nloc = b.st[0], nx = b.st[1];
        if (nloc == 0u) { xcd_barrier_complete(bar, b.x, nloc, nx); b.st[0] = nloc; b.st[1] = nx; }
        const unsigned old = xb_add(&bar[XB_XSUB(b.x)], 1u);
        const unsigned gen = old / nloc;
        if (old + 1u == (gen + 1u) * nloc) {
            __builtin_amdgcn_fence(__ATOMIC_RELEASE, "agent");
            asm volatile("s_waitcnt vmcnt(0)" ::: "memory");
            const unsigned og = xb_add(&bar[XB_TOP], 1u);
            const unsigned tg = og / nx;
            if (og + 1u == (tg + 1u) * nx) xb_add(&bar[XB_TOPGEN], 1u);
            else XB_SPIN(xb_ld(&bar[XB_TOPGEN]) == tg, bar);
            __builtin_amdgcn_fence(__ATOMIC_ACQUIRE, "agent");
            xb_add(&bar[XB_XGEN(b.x)], 1u);
            asm volatile("s_waitcnt vmcnt(0)" ::: "memory");
        } else {
            XB_SPIN(xb_ld(&bar[XB_XGEN(b.x)]) == gen, bar);
            __builtin_amdgcn_fence(__ATOMIC_ACQUIRE, "agent");
            asm volatile("s_waitcnt vmcnt(0)" ::: "memory");
        }
    }
    __syncthreads();
}

struct Frame {
    LAS unsigned char* lds; char* ldsg;
    int tid, lane, wave, vcu, G;
    const Args* a;
};
#define INP(F, i, T) ((const T*)(F).a->in[i])
#define WSP(F, off, T) ((T*)((F).a->ws + (off)))

__device__ __forceinline__ void cvt_load(f32x4 (&v)[16], const float* __restrict__ W, int N, int nvalid, int k0, int n0, int lane) {
    const int kq = lane >> 4, nq = lane & 15;
    const unsigned voff = (unsigned)(kq * N + 4 * nq) * 4u;
#pragma unroll
    for (int i = 0; i < 16; ++i) {
        const char* Wu = (const char*)(W + (size_t)(k0 + 4 * i) * N + n0);
        if (4 * nq < nvalid) v[i] = __builtin_nontemporal_load((const f32x4*)(Wu + (size_t)voff)); else v[i] = (f32x4){0.f, 0.f, 0.f, 0.f};
    }
}
__device__ __forceinline__ void cvt_finish(const f32x4 (&v)[16], int k0, bf16_t* __restrict__ WT, int rowb, LAS unsigned char* scr, int lane) {
    const int kq = lane >> 4, nq = lane & 15;
    const int g = lane >> 4, i16 = lane & 15, q = i16 >> 2, p = i16 & 3;
    typedef short v4i16_t __attribute__((ext_vector_type(4)));
#pragma unroll
    for (int hf = 0; hf < 2; ++hf) {
#pragma unroll
        for (int i = 0; i < 8; ++i) {
            const int k = 4 * i + kq, s = ((k >> 1) & 1) | (((k >> 3) & 1) << 1);
            u32x2 w; w.x = cvtpk(v[8 * hf + i].x, v[8 * hf + i].y); w.y = cvtpk(v[8 * hf + i].z, v[8 * hf + i].w);
            *(LAS u32x2*)(scr + k * 128 + ((nq * 8) ^ (s << 5))) = w;
        }
        const int klo = 8 * g + q, s = ((klo >> 1) & 1) | (((klo >> 3) & 1) << 1);
#pragma unroll
        for (int nb = 0; nb < 4; ++nb) {
            const int a_lo = klo * 128 + (((16 * nb + 4 * p) * 2) ^ (s << 5));
            const s16x4 lo = __builtin_bit_cast(s16x4, __builtin_amdgcn_ds_read_tr16_b64_v4i16((LAS v4i16_t*)(scr + a_lo)));
            const s16x4 hi = __builtin_bit_cast(s16x4, __builtin_amdgcn_ds_read_tr16_b64_v4i16((LAS v4i16_t*)(scr + a_lo + 512)));
            bf16x8 o = {lo[0], lo[1], lo[2], lo[3], hi[0], hi[1], hi[2], hi[3]};
            char* Wu = (char*)(WT + (size_t)(rowb + 16 * nb) * 2048 + k0 + 32 * hf);
            __builtin_nontemporal_store(o, (bf16x8*)(Wu + (size_t)(unsigned)((i16 * 2048 + 8 * g) * 2)));
        }
    }
}
__device__ __forceinline__ void cvt8_load(f32x4 (&v)[16], const float* __restrict__ W, int k0, int n0, int lane) {
    const int kq = lane >> 4, nq = lane & 15;
    const unsigned voff = (unsigned)(16 * kq * 2048 + 4 * nq) * 4u;
#pragma unroll
    for (int i = 0; i < 16; ++i) {
        const char* Wu = (const char*)(W + (size_t)(k0 + i) * 2048 + n0);
        v[i] = __builtin_nontemporal_load((const f32x4*)(Wu + (size_t)voff));
    }
}
__device__ __forceinline__ void cvt8_finish(const f32x4 (&v)[16], int k0, unsigned char* __restrict__ W8, int rowb, int lane) {
    const int kq = lane >> 4, nq = lane & 15;
    char* Wu = (char*)(W8 + (size_t)rowb * 2048 + k0);
    const unsigned voff = (unsigned)(4 * nq * 2048 + 16 * kq);
#pragma unroll
    for (int j = 0; j < 4; ++j) {
        u32x4 o;
#pragma unroll
        for (int q = 0; q < 4; ++q) {
            int w = __builtin_amdgcn_cvt_pk_fp8_f32(v[4 * q][j] * pg8::W8_SCALE, v[4 * q + 1][j] * pg8::W8_SCALE, 0, false);
            w = __builtin_amdgcn_cvt_pk_fp8_f32(v[4 * q + 2][j] * pg8::W8_SCALE, v[4 * q + 3][j] * pg8::W8_SCALE, w, true);
            o[q] = (unsigned)w;
        }
        __builtin_nontemporal_store(o, (u32x4*)(Wu + (size_t)(voff + (unsigned)(j * 2048))));
    }
}
__device__ __forceinline__ void cvt_expert_decode(const Frame& F, int r, const float*& W, int& k0, int& n0, unsigned char*& WT, int& rowb) {
    constexpr int I_E = 16 * 32 * 32;
    const int mat = r / I_E; r -= mat * I_E;
    const int e = r >> 10, kt = (r >> 5) & 31, nt = r & 31;
    k0 = kt * 64; n0 = nt * 64;
    if (mat < 2) { W = INP(F, 24 + mat, float) + (size_t)e * 2048 * 2048; WT = WSP(F, WS_WGU, unsigned char); rowb = e * 4096 + (n0 >> 7) * 256 + mat * 128 + (n0 & 127); }
    else { W = INP(F, 26, float) + (size_t)e * 2048 * 2048; WT = WSP(F, WS_WD, unsigned char); rowb = e * 2048 + n0; }
}
constexpr int N_EXPERT_ITEMS = 3 * 16 * 32 * 32;
__device__ __forceinline__ void p0_prologue(Frame& F) {
    LAS unsigned char* scr = F.lds + F.wave * 4096;
    const int gw = F.vcu * 8 + F.wave, NGW = F.G * 8, lane = F.lane;
    const float* w_in = INP(F, 3, float); const float* w_out = INP(F, 21, float);
    bf16_t* WinT = WSP(F, WS_WIN, bf16_t); bf16_t* WoutT = WSP(F, WS_WOUT, bf16_t);
    constexpr int I_IN = 32 * 101, I_OUT = 32 * 32, NITEMS = I_IN + I_OUT;
#define P0_TILE_LOAD(V_, it_) do { if ((it_) < I_IN) { const int kt_ = (it_) / 101, nt_ = (it_) % 101; cvt_load(V_, w_in, IN_COLS, (nt_ == 100) ? 32 : 64, kt_ * 64, nt_ * 64, lane); } \
        else { const int r_ = (it_) - I_IN; cvt_load(V_, w_out, 2048, 64, (r_ >> 5) * 64, (r_ & 31) * 64, lane); } } while (0)
#define P0_TILE_FIN(V_, it_) do { if ((it_) < I_IN) { const int kt_ = (it_) / 101, nt_ = (it_) % 101; cvt_finish(V_, kt_ * 64, WinT, nt_ * 64, scr, lane); } \
        else { const int r_ = (it_) - I_IN; cvt_finish(V_, (r_ >> 5) * 64, WoutT, (r_ & 31) * 64, scr, lane); } } while (0)
    for (int it = gw; it < NITEMS; it += 2 * NGW) {
        const int it2 = it + NGW; const bool has2 = it2 < NITEMS;
        f32x4 va[16], vb[16];
        P0_TILE_LOAD(va, it); if (has2) P0_TILE_LOAD(vb, it2);
        P0_TILE_FIN(va, it); if (has2) P0_TILE_FIN(vb, it2);
    }
#undef P0_TILE_LOAD
#undef P0_TILE_FIN
#if !CVT_IN_SCAN
    for (int it = gw; it < N_EXPERT_ITEMS; it += NGW) {
        f32x4 v[16]; const float* W; int k0, n0, rowb; unsigned char* WT;
        cvt_expert_decode(F, it, W, k0, n0, WT, rowb); cvt8_load(v, W, k0, n0, lane); cvt8_finish(v, k0, WT, rowb, lane);
    }
#endif
    { u32x4 z = {0u, 0u, 0u, 0u}; u32x4* zp = (u32x4*)(WinT + (size_t)6464 * 2048); const int nz = 192 * 2048 * 2 / 16;
      for (int i = gw * 64 + lane; i < nz; i += NGW * 64) zp[i] = z; }
    { const float* x = INP(F, 0, float); const float* nw = INP(F, 2, float); bf16_t* H1 = WSP(F, WS_H1, bf16_t);
      for (int m = gw; m < MTOK; m += 2 * NGW) {
          const int m2 = (m + NGW < MTOK) ? m + NGW : m;
          const f32x4* xr = (const f32x4*)(x + (size_t)m * DM) + lane; const f32x4* xs = (const f32x4*)(x + (size_t)m2 * DM) + lane; f32x4 v[8], u[8]; float s = 0.f, s2 = 0.f;
#pragma unroll
          for (int j = 0; j < 8; ++j) { v[j] = xr[64 * j]; u[j] = xs[64 * j]; }
#pragma unroll
          for (int j = 0; j < 8; ++j) { s += (v[j].x * v[j].x + v[j].y * v[j].y) + (v[j].z * v[j].z + v[j].w * v[j].w); s2 += (u[j].x * u[j].x + u[j].y * u[j].y) + (u[j].z * u[j].z + u[j].w * u[j].w); }
          const float rstd = 1.f / sqrtf(wave_sum(s) * (1.f / DM) + 1e-6f), rstd2 = 1.f / sqrtf(wave_sum(s2) * (1.f / DM) + 1e-6f);
          u32x2* o8 = (u32x2*)(H1 + (size_t)m * DM) + lane; u32x2* p8 = (u32x2*)(H1 + (size_t)m2 * DM) + lane;
#pragma unroll
          for (int j = 0; j < 8; ++j) { const f32x4 w = ((const f32x4*)nw)[lane + 64 * j];
              u32x2 o; o.x = cvtpk(v[j].x * rstd * w.x, v[j].y * rstd * w.y); o.y = cvtpk(v[j].z * rstd * w.z, v[j].w * rstd * w.w); o8[64 * j] = o;
              u32x2 q; q.x = cvtpk(u[j].x * rstd2 * w.x, u[j].y * rstd2 * w.y); q.y = cvtpk(u[j].z * rstd2 * w.z, u[j].w * rstd2 * w.w); p8[64 * j] = q; }
      } }
    { const float* dup = INP(F, 12, float); const float* iup = INP(F, 14, float); const float* gup = INP(F, 15, float);
      bf16_t* DUt = WSP(F, WS_LORA, bf16_t); bf16_t* IUt = DUt + 2 * 1024 * 64; bf16_t* GUt = IUt + 2 * 1024 * 64;
      for (int i = gw * 64 + lane; i < 2 * 1024 * 64; i += NGW * 64) { const int j = i & 63, c = (i >> 6) & 1023, d = i >> 16;
          DUt[i] = (bf16_t)(cvtpk(dup[(size_t)(d * 64 + j) * 1024 + c], 0.f) & 0xffffu); IUt[i] = (bf16_t)(cvtpk(iup[(size_t)(d * 64 + j) * 1024 + c], 0.f) & 0xffffu); }
      for (int i = gw * 64 + lane; i < 1024 * 160; i += NGW * 64) { const int c = i / 160, j = i - c * 160; GUt[i] = (bf16_t)(cvtpk(gup[(size_t)j * 1024 + c], 0.f) & 0xffffu); } }
    { const int* pos = INP(F, 1, int); float* rope = WSP(F, WS_ROPE, float);
      const float invf[8] = {1.0f, 0.19392274474868576f, 0.03760603093086393f, 0.007292664737217109f, 0.001414213562373095f, 0.0002742481756762073f, 5.318295896944988e-05f, 1.031338537721246e-05f};
      for (int i = gw * 64 + lane; i < MTOK * 8; i += NGW * 64) { const int m = i >> 3, j = i & 7; float fj = invf[0];
#pragma unroll
          for (int q = 1; q < 8; ++q) fj = (j == q) ? invf[q] : fj;
          const float ang = (float)pos[m] * fj; rope[m * 16 + j] = cosf(ang); rope[m * 16 + 8 + j] = sinf(ang); } }
}

#define WS32(F, T, byteoff) (*(T*)((F).a->ws + (size_t)(unsigned)(byteoff)))
template <int CTRL> __device__ __forceinline__ float dpp_add(float x) {
    return x + __int_as_float(__builtin_amdgcn_update_dpp(0, __float_as_int(x), CTRL, 0xf, 0xf, false));
}
__device__ __forceinline__ float row16_allsum(float x) { x = dpp_add<0x128>(x); x = dpp_add<0x124>(x); x = dpp_add<0x122>(x); x = dpp_add<0x121>(x); return x; }
__device__ __forceinline__ bf16_t f2bf(float x) { return (bf16_t)(cvtpk(x, 0.f) & 0xffffu); }
__device__ __forceinline__ u32x4 ld_row16(const Frame& F, unsigned off, bool ok) { u32x4 r = {0u, 0u, 0u, 0u}; if (ok) r = WS32(F, const u32x4, off); return r; }
__device__ __forceinline__ void unpack8(const u32x4 w, float (&o)[8]) { o[0] = bf_lo(w.x); o[1] = bf_hi(w.x); o[2] = bf_lo(w.y); o[3] = bf_hi(w.y); o[4] = bf_lo(w.z); o[5] = bf_hi(w.z); o[6] = bf_lo(w.w); o[7] = bf_hi(w.w); }
__device__ __forceinline__ void ld8f(const float* p, float (&o)[8]) { const f32x4 a = ((const f32x4*)p)[0], b = ((const f32x4*)p)[1]; o[0] = a.x; o[1] = a.y; o[2] = a.z; o[3] = a.w; o[4] = b.x; o[5] = b.y; o[6] = b.z; o[7] = b.w; }
__device__ __forceinline__ u32x4 pack8(const float (&v)[8]) { return (u32x4){cvtpk(v[0], v[1]), cvtpk(v[2], v[3]), cvtpk(v[4], v[5]), cvtpk(v[6], v[7])}; }
__device__ __forceinline__ void p3_prep(Frame& F, const int mode = 0) {
    constexpr int AP = 296;
    constexpr int PP = 264, PA = 16 * PP, PT = 5 * PA;
    LAS bf16_t* Al = (LAS bf16_t*)F.lds;
    LAS bf16_t* Pl = (LAS bf16_t*)(F.lds + 18944);
    LAS float* Zr = (LAS float*)(F.lds + 18944);
    LAS float* Zl = (LAS float*)(F.lds + 18944 + 20736);
    const int tid = F.tid, lane = F.lane, w = F.wave;
    const bf16_t* DUt = WSP(F, WS_LORA, bf16_t); const bf16_t* IUt = DUt + 2 * 1024 * 64; const bf16_t* GUt = IUt + 2 * 1024 * 64;
    for (int item = F.vcu; item < MTOK / 32; item += F.G) {
        __syncthreads();
#pragma unroll 1
        for (int tl = 0; tl < 2; ++tl) {
            const int m0 = item * 32 + tl * 16, t0 = m0 & (SEQ - 1);
            for (int p = tid; p < 18 * 36; p += 512) {
                const int rr = p / 36, ch = p - rr * 36, t = t0 + rr - 1, m = m0 + rr - 1;
                f32x4 a0 = {0.f, 0.f, 0.f, 0.f}, a1 = a0;
                if (t >= 0 && t < SEQ) {
                    const bf16_t* pp = WSP(F, WS_PART, bf16_t) + (((size_t)((ch >> 5) * 32 + (m >> 8)) * 4) << 16) + (size_t)(m & 255) * 256 + ((8 * ch) & 255);
                    u32x4 q[4];
#pragma unroll
                    for (int k = 0; k < 4; ++k) q[k] = *(const u32x4*)(pp + ((size_t)k << 16));
#pragma unroll
                    for (int k = 0; k < 4; ++k) { a0 += (f32x4){bf_lo(q[k].x), bf_hi(q[k].x), bf_lo(q[k].y), bf_hi(q[k].y)}; a1 += (f32x4){bf_lo(q[k].z), bf_hi(q[k].z), bf_lo(q[k].w), bf_hi(q[k].w)}; }
                }
                LAS f32x4* zp = (LAS f32x4*)(Zr + rr * 288 + 8 * ch); zp[0] = a0; zp[1] = a1;
            }
            __syncthreads();
            for (int p = tid; p < 16 * 36; p += 512) {
                const int i = p / 36, ch = p - i * 36, zc = 3072 + 8 * ch;
                float c[8], pv[8], nx[8], mp[8], mn[8];
                { const LAS f32x4* q = (const LAS f32x4*)(Zr + i * 288 + 8 * ch); const f32x4 x0 = q[0], x1 = q[1], y0 = q[72], y1 = q[73], w0 = q[144], w1 = q[145];
                  pv[0] = x0.x; pv[1] = x0.y; pv[2] = x0.z; pv[3] = x0.w; pv[4] = x1.x; pv[5] = x1.y; pv[6] = x1.z; pv[7] = x1.w;
                  c[0] = y0.x; c[1] = y0.y; c[2] = y0.z; c[3] = y0.w; c[4] = y1.x; c[5] = y1.y; c[6] = y1.z; c[7] = y1.w;
                  nx[0] = w0.x; nx[1] = w0.y; nx[2] = w0.z; nx[3] = w0.w; nx[4] = w1.x; nx[5] = w1.y; nx[6] = w1.z; nx[7] = w1.w; }
                ld8f(INP(F, 4, float) + zc, mp); ld8f(INP(F, 5, float) + zc, mn);
                LAS f32x4* zp = (LAS f32x4*)(Zl + i * 288 + 8 * ch); float z[8];
#pragma unroll
                for (int e = 0; e < 8; ++e) z[e] = c[e] + mp[e] * (pv[e] - c[e]) + mn[e] * (nx[e] - c[e]);
                zp[0] = (f32x4){z[0], z[1], z[2], z[3]}; zp[1] = (f32x4){z[4], z[5], z[6], z[7]};
            }
            __syncthreads();
            for (int e = tid; e < 16 * 288; e += 512) { const int i = e / 288, j = e - i * 288; float z = Zl[e];
                if (j < 64) z = 1.f - 2.f * __builtin_amdgcn_rcpf(__expf(2.f * z) + 1.f); else if (j >= 128) z = __builtin_amdgcn_rcpf(1.f + __expf(-z));
                Al[tl * 16 * AP + i * AP + j] = f2bf(z); }
        }
        __syncthreads();
        if (mode == 1) continue;
        const int chk = tid & 31, pidx = tid >> 5, tb = pidx >> 3, tp = pidx & 7;
        const int m0t = item * 32 + tb * 16, t0t = m0t & (SEQ - 1);
#pragma unroll 1
        for (int qi = 0; qi < 4; ++qi) {
            const int q = (qi + (F.vcu >> 2)) & 3;
            u32x4 rawr[4], rawk[4], rawv[4];
            { const unsigned off = (unsigned)WS_PROJ + ((unsigned)(m0t + 2 * tp) * LDP + ZC0 + 256 * q + 8 * chk) * 2u;
#pragma unroll
              for (int rr = 0; rr < 4; ++rr) { const int t = t0t + 2 * tp + rr - 1; const bool ok = (t >= 0) && (t < SEQ); const unsigned o = off + (unsigned)((rr - 1) * LDP * 2);
                  rawr[rr] = ld_row16(F, o, ok); rawk[rr] = ld_row16(F, o + 1024u * 2u, ok); rawv[rr] = ld_row16(F, o + 2048u * 2u, ok); } }
            {
                const int n16 = lane & 15, q4 = lane >> 4;
                struct BF { bf16x8 d0[2], d1[2], i0[2], i1[2], g[5]; };
#define LD_BF(X, nb_) do { const int cl_ = 256 * q + 32 * w + 16 * (nb_) + n16; _Pragma("unroll") for (int ks = 0; ks < 2; ++ks) { \
                    X.d0[ks] = *(const bf16x8*)(DUt + (size_t)cl_ * 64 + 32 * ks + 8 * q4); X.d1[ks] = *(const bf16x8*)(DUt + (size_t)(1024 + cl_) * 64 + 32 * ks + 8 * q4); \
                    X.i0[ks] = *(const bf16x8*)(IUt + (size_t)cl_ * 64 + 32 * ks + 8 * q4); X.i1[ks] = *(const bf16x8*)(IUt + (size_t)(1024 + cl_) * 64 + 32 * ks + 8 * q4); } \
                    _Pragma("unroll") for (int ks = 0; ks < 5; ++ks) X.g[ks] = *(const bf16x8*)(GUt + (size_t)cl_ * 160 + 32 * ks + 8 * q4); } while (0)
#define DO_NB(X, nb_, tl_) do { const int ch_ = 32 * w + 16 * (nb_); \
                    f32x4 aw0 = {0.f, 0.f, 0.f, 0.f}, aw1 = aw0, aa0 = aw0, aa1 = aw0, ag = aw0; \
                    _Pragma("unroll") for (int ks = 0; ks < 2; ++ks) { \
                        aw0 = __builtin_amdgcn_mfma_f32_16x16x32_bf16(X.d0[ks], af[ks], aw0, 0, 0, 0); aw1 = __builtin_amdgcn_mfma_f32_16x16x32_bf16(X.d1[ks], af[ks], aw1, 0, 0, 0); \
                        aa0 = __builtin_amdgcn_mfma_f32_16x16x32_bf16(X.i0[ks], af[2 + ks], aa0, 0, 0, 0); aa1 = __builtin_amdgcn_mfma_f32_16x16x32_bf16(X.i1[ks], af[2 + ks], aa1, 0, 0, 0); } \
                    _Pragma("unroll") for (int ks = 0; ks < 5; ++ks) ag = __builtin_amdgcn_mfma_f32_16x16x32_bf16(X.g[ks], af[4 + ks], ag, 0, 0, 0); \
                    LAS bf16_t* pp = Pl + (tl_) * PT + n16 * PP + ch_ + 4 * q4; \
                    *(LAS u32x2*)(pp) = (u32x2){cvtpk(aw0[0], aw0[1]), cvtpk(aw0[2], aw0[3])}; *(LAS u32x2*)(pp + PA) = (u32x2){cvtpk(aw1[0], aw1[1]), cvtpk(aw1[2], aw1[3])}; \
                    *(LAS u32x2*)(pp + 2 * PA) = (u32x2){cvtpk(aa0[0], aa0[1]), cvtpk(aa0[2], aa0[3])}; *(LAS u32x2*)(pp + 3 * PA) = (u32x2){cvtpk(aa1[0], aa1[1]), cvtpk(aa1[2], aa1[3])}; \
                    *(LAS u32x2*)(pp + 4 * PA) = (u32x2){cvtpk(ag[0], ag[1]), cvtpk(ag[2], ag[3])}; } while (0)
                BF fa, fb; LD_BF(fa, 0); LD_BF(fb, 1);
#pragma unroll
                for (int tl = 0; tl < 2; ++tl) {
                    bf16x8 af[9];
#pragma unroll
                    for (int ks = 0; ks < 9; ++ks) af[ks] = *(const LAS bf16x8*)(Al + tl * 16 * AP + n16 * AP + 32 * ks + 8 * q4);
                    DO_NB(fa, 0, tl); DO_NB(fb, 1, tl);
                }
#undef LD_BF
#undef DO_NB
            }
            __syncthreads();
            if (mode != 2) {
                const int c = 256 * q + 8 * chk;
                float r4[4][8], k4[4][8], v4[4][8];
#pragma unroll
                for (int rr = 0; rr < 4; ++rr) { unpack8(rawr[rr], r4[rr]); unpack8(rawk[rr], k4[rr]); unpack8(rawv[rr], v4[rr]); }
                float zr[2][8], zk[2][8], zv[2][8];
                { float mp[8], mn[8];
                  ld8f(INP(F, 4, float) + c, mp); ld8f(INP(F, 5, float) + c, mn);
#pragma unroll
                  for (int tk = 0; tk < 2; ++tk)
#pragma unroll
                      for (int e = 0; e < 8; ++e) zr[tk][e] = r4[tk + 1][e] + mp[e] * (r4[tk][e] - r4[tk + 1][e]) + mn[e] * (r4[tk + 2][e] - r4[tk + 1][e]);
                  ld8f(INP(F, 4, float) + 1024 + c, mp); ld8f(INP(F, 5, float) + 1024 + c, mn);
#pragma unroll
                  for (int tk = 0; tk < 2; ++tk)
#pragma unroll
                      for (int e = 0; e < 8; ++e) zk[tk][e] = k4[tk + 1][e] + mp[e] * (k4[tk][e] - k4[tk + 1][e]) + mn[e] * (k4[tk + 2][e] - k4[tk + 1][e]);
                  ld8f(INP(F, 4, float) + 2048 + c, mp); ld8f(INP(F, 5, float) + 2048 + c, mn);
#pragma unroll
                  for (int tk = 0; tk < 2; ++tk)
#pragma unroll
                      for (int e = 0; e < 8; ++e) zv[tk][e] = v4[tk + 1][e] + mp[e] * (v4[tk][e] - v4[tk + 1][e]) + mn[e] * (v4[tk + 2][e] - v4[tk + 1][e]); }
                float kkw[8], w00[8], w01[8], a00[8], a01[8], kac[8], rkc[8];
                ld8f(INP(F, 16, float) + c, kkw); ld8f(INP(F, 11, float) + c, w00); ld8f(INP(F, 11, float) + 1024 + c, w01);
                ld8f(INP(F, 13, float) + c, a00); ld8f(INP(F, 13, float) + 1024 + c, a01); ld8f(INP(F, 17, float) + c, kac); ld8f(INP(F, 18, float) + c, rkc);
#pragma unroll 1
                for (int tk = 0; tk < 2; ++tk) {
                    const int tkn = 2 * tp + tk; const unsigned o = (unsigned)(m0t + tkn) * 1024u + (unsigned)c;
                    const LAS bf16_t* pp = Pl + tb * PT + tkn * PP + 8 * chk;
                    float zrt[8], zkt[8], zvt[8];
#pragma unroll
                    for (int e = 0; e < 8; ++e) { zrt[e] = tk ? zr[1][e] : zr[0][e]; zkt[e] = tk ? zk[1][e] : zk[0][e]; zvt[e] = tk ? zv[1][e] : zv[0][e]; }
                    WS32(F, u32x4, (unsigned)WS_R + o * 2u) = pack8(zrt); WS32(F, u32x4, (unsigned)WS_V + o * 2u) = pack8(zvt);
                    float kk[8];
                    { float ss = 0.f;
#pragma unroll
                      for (int e = 0; e < 8; ++e) { kk[e] = zkt[e] * kkw[e]; ss += kk[e] * kk[e]; }
                      ss += __shfl_xor(ss, 1); ss += __shfl_xor(ss, 2); ss += __shfl_xor(ss, 4);
                      const float inv = 1.f / fmaxf(sqrtf(ss), 1e-12f);
#pragma unroll
                      for (int e = 0; e < 8; ++e) kk[e] *= inv;
                      WS32(F, u32x4, (unsigned)WS_KK + o * 2u) = pack8(kk); }
                    {
                        float pw0[8], pw1[8], d0[8], d1[8];
                        unpack8(*(const LAS u32x4*)(pp), pw0); unpack8(*(const LAS u32x4*)(pp + PA), pw1);
#pragma unroll
                        for (int e = 0; e < 8; ++e) {
                            d0[e] = 0.6065306597126334f * __builtin_amdgcn_rcpf(1.f + __expf(-(w00[e] + pw0[e]))); d1[e] = 0.6065306597126334f * __builtin_amdgcn_rcpf(1.f + __expf(-(w01[e] + pw1[e]))); }
                        WS32(F, u32x4, (unsigned)WS_WDEC + o * 2u) = pack8(d0); WS32(F, u32x4, (unsigned)WS_WDEC + ((unsigned)(MTOK * 1024) + o) * 2u) = pack8(d1);
                    }
                    {
                        float pa0[8], pa1[8], kd0[8], kd1[8], b0v[8], b1v[8]; float bs = 0.f;
                        unpack8(*(const LAS u32x4*)(pp + 2 * PA), pa0); unpack8(*(const LAS u32x4*)(pp + 3 * PA), pa1);
#pragma unroll
                        for (int e = 0; e < 8; ++e) {
                            const float av0 = __builtin_amdgcn_rcpf(1.f + __expf(-(a00[e] + pa0[e]))), av1 = __builtin_amdgcn_rcpf(1.f + __expf(-(a01[e] + pa1[e])));
                            kd0[e] = zkt[e] * (1.f + (av0 - 1.f) * kac[e]); kd1[e] = zkt[e] * (1.f + (av1 - 1.f) * kac[e]);
                            b0v[e] = kk[e] * av0; b1v[e] = kk[e] * av1;
                            bs += zrt[e] * (kd0[e] + kd1[e]) * rkc[e]; }
                        bs += __shfl_xor(bs, 1); bs += __shfl_xor(bs, 2); bs += __shfl_xor(bs, 4);
                        if ((chk & 7) == 0) WS32(F, float, (unsigned)WS_BONUS + ((unsigned)(m0t + tkn) * 16u + (unsigned)(4 * q + (chk >> 3))) * 4u) = bs;
                        WS32(F, u32x4, (unsigned)WS_KD + o * 2u) = pack8(kd0); WS32(F, u32x4, (unsigned)WS_KD + ((unsigned)(MTOK * 1024) + o) * 2u) = pack8(kd1);
                        WS32(F, u32x4, (unsigned)WS_BB + o * 2u) = pack8(b0v); WS32(F, u32x4, (unsigned)WS_BB + ((unsigned)(MTOK * 1024) + o) * 2u) = pack8(b1v);
                    }
                    WS32(F, u32x4, (unsigned)WS_G + o * 2u) = *(const LAS u32x4*)(pp + 4 * PA);
                }
            }
            __syncthreads();
        }
    }
}

struct P5aConst { float lam; };
__device__ __forceinline__ void p5a_init(const Frame& F, P5aConst& K) {
    const int lane = F.lane;
    const float q1 = INP(F, 6, float)[lane] * INP(F, 7, float)[lane], q2 = INP(F, 8, float)[lane] * INP(F, 9, float)[lane];
    K.lam = __expf(wave_sum(q1)) - __expf(wave_sum(q2)) + 0.2f;
}
__device__ __forceinline__ void p5a_token(const Frame& F, const P5aConst& K, int m) {
    const bf16_t* OC = WSP(F, WS_OC, bf16_t); bf16_t* MIX = WSP(F, WS_MIX, bf16_t); const float* subw = INP(F, 10, float);
    const int c0 = F.lane * 16; const float lam = K.lam;
    const u32x4* p0 = (const u32x4*)(OC + (size_t)m * 1024 + c0); const u32x4* p1 = (const u32x4*)(OC + (size_t)MTOK * 1024 + (size_t)m * 1024 + c0);
    const u32x4 a0 = p0[0], a1 = p0[1], b0 = p1[0], b1 = p1[1];
    float dv[16]; const unsigned aw[8] = {a0.x, a0.y, a0.z, a0.w, a1.x, a1.y, a1.z, a1.w}, bw[8] = {b0.x, b0.y, b0.z, b0.w, b1.x, b1.y, b1.z, b1.w};
    float ssq = 0.f;
#pragma unroll
    for (int i = 0; i < 8; ++i) { dv[2 * i] = bf_lo(aw[i]) - lam * bf_lo(bw[i]); dv[2 * i + 1] = bf_hi(aw[i]) - lam * bf_hi(bw[i]); ssq += dv[2 * i] * dv[2 * i] + dv[2 * i + 1] * dv[2 * i + 1]; }
    ssq += __shfl_xor(ssq, 1); ssq += __shfl_xor(ssq, 2); ssq += __shfl_xor(ssq, 4);
    const float rstd = 1.f / sqrtf(ssq * (1.f / 128.f) + 1e-5f);
    unsigned ow[8];
#pragma unroll
    for (int i = 0; i < 8; ++i) { const float s0 = subw[(c0 + 2 * i) & 127] * 0.8f, s1 = subw[(c0 + 2 * i + 1) & 127] * 0.8f; ow[i] = cvtpk(dv[2 * i] * rstd * s0, dv[2 * i + 1] * rstd * s1); }
    u32x4* op = (u32x4*)(MIX + (size_t)m * 2048 + c0); op[0] = (u32x4){ow[0], ow[1], ow[2], ow[3]}; op[1] = (u32x4){ow[4], ow[5], ow[6], ow[7]};
}

__device__ __forceinline__ void p4_scan(Frame& F, const int mode = 0) {
    constexpr int CH = 32, NCH = SEQ / CH;
    constexpr int VEC = CH * 64 * 4;
    constexpr int BUF = 5 * VEC + CH * 32 * 4;
    constexpr int YOFF = 2 * BUF, YB = CH * 32 * 4;
    constexpr int CVT_SCR = 2 * BUF + 2 * YB;
    const bf16_t* Wdec = WSP(F, WS_WDEC, bf16_t); const bf16_t* KDg = WSP(F, WS_KD, bf16_t); const bf16_t* BBg = WSP(F, WS_BB, bf16_t);
    const bf16_t* Rg = WSP(F, WS_R, bf16_t); const bf16_t* KKg = WSP(F, WS_KK, bf16_t); const bf16_t* Vg = WSP(F, WS_V, bf16_t); bf16_t* YS = WSP(F, WS_YS, bf16_t);
    const int tid = F.tid, lane = F.lane, wid = F.wave;
    const bool is_comp = wid < 4;
    const int ri = wid & 3;
    if (is_comp) __builtin_amdgcn_s_setprio(3);
    const int g = lane >> 3, j = lane & 7, rowl = ri * 8 + g;
    const int mt = ri * 64 + lane, mw = ri;
    int cvt_it = F.vcu * 4 + mw; f32x4 cvv[16]; int ck0 = 0, crowb = 0; unsigned char* cWT = nullptr;
    f32x4 cvvB[16]; int ck0B = 0, crowbB = 0; unsigned char* cWTB = nullptr;
    LAS unsigned* st_cnt = (LAS unsigned*)(F.lds + CVT_SCR + 4 * 4096); LAS unsigned* cons_cnt = st_cnt + 16;
    for (int item = F.vcu; item < 256; item += F.G) {
        const int chain = item >> 1, half = item & 1, d = chain >> 6, b = (chain >> 4) & 3, h = chain & 15;
        const size_t sh = (size_t)b * SEQ * 1024 + h * 64, pd = (size_t)d * MTOK * 1024 + sh;
        f32x2 S2[4] = {{0.f, 0.f}, {0.f, 0.f}, {0.f, 0.f}, {0.f, 0.f}};
        u32x2 rw[2], rkk[2], rbb[2], rkd[2], rr[2]; unsigned rv[2];
        const int cstep = d ? -CH * 1024 : CH * 1024;
        unsigned po[2], pv[2];
#pragma unroll
        for (int q_ = 0; q_ < 2; ++q_) { const int sl_ = mt + 256 * q_, ss_ = sl_ >> 4, sk_ = (sl_ & 15) * 4, tq_ = d ? (SEQ - 1 - ss_) : ss_; po[q_] = (unsigned)(tq_ * 1024 + sk_); pv[q_] = (unsigned)(tq_ * 1024 + half * 32 + 2 * (sl_ & 15)); }
        const char* bW = (const char*)(Wdec + pd); const char* bKK = (const char*)(KKg + sh); const char* bBB = (const char*)(BBg + pd); const char* bKD = (const char*)(KDg + pd); const char* bR = (const char*)(Rg + sh); const char* bV = (const char*)(Vg + sh);
#define SC_LOAD(c) do { const unsigned cu_ = (unsigned)((c) * cstep); _Pragma("unroll") for (int q_ = 0; q_ < 2; ++q_) { const unsigned e_ = po[q_] + cu_; \
        rw[q_] = *(const u32x2*)(bW + (size_t)(e_ * 2u)); rkk[q_] = *(const u32x2*)(bKK + (size_t)(e_ * 2u)); rbb[q_] = *(const u32x2*)(bBB + (size_t)(e_ * 2u)); rkd[q_] = *(const u32x2*)(bKD + (size_t)(e_ * 2u)); rr[q_] = *(const u32x2*)(bR + (size_t)(e_ * 2u)); \
        rv[q_] = *(const unsigned*)(bV + (size_t)((pv[q_] + cu_) * 2u)); } } while (0)
#define SC_STORE(bufi) do { LAS unsigned char* bp_ = F.lds + (bufi) * BUF; _Pragma("unroll") for (int q_ = 0; q_ < 2; ++q_) { const int sl_ = mt + 256 * q_, ss_ = sl_ >> 4, sk_ = (sl_ & 15) * 4; const int o_ = (ss_ * 64 + sk_) * 4; \
        *(LAS f32x4*)(bp_ + o_) = (f32x4){__expf(-bf_lo(rw[q_].x)), __expf(-bf_hi(rw[q_].x)), __expf(-bf_lo(rw[q_].y)), __expf(-bf_hi(rw[q_].y))}; \
        *(LAS f32x4*)(bp_ + VEC + o_) = (f32x4){bf_lo(rkk[q_].x), bf_hi(rkk[q_].x), bf_lo(rkk[q_].y), bf_hi(rkk[q_].y)}; \
        *(LAS f32x4*)(bp_ + 2 * VEC + o_) = (f32x4){bf_lo(rbb[q_].x), bf_hi(rbb[q_].x), bf_lo(rbb[q_].y), bf_hi(rbb[q_].y)}; \
        *(LAS f32x4*)(bp_ + 3 * VEC + o_) = (f32x4){bf_lo(rkd[q_].x), bf_hi(rkd[q_].x), bf_lo(rkd[q_].y), bf_hi(rkd[q_].y)}; \
        *(LAS f32x4*)(bp_ + 4 * VEC + o_) = (f32x4){bf_lo(rr[q_].x), bf_hi(rr[q_].x), bf_lo(rr[q_].y), bf_hi(rr[q_].y)}; \
        *(LAS f32x2*)(bp_ + 5 * VEC + (ss_ * 32 + 2 * (sl_ & 15)) * 4) = (f32x2){bf_lo(rv[q_]), bf_hi(rv[q_])}; } } while (0)
#define Y_OUT(c) do { const int ys_ = mt >> 3, yr_ = (mt & 7) * 4; const int tt_ = (c) * CH + ys_, t_ = d ? (SEQ - 1 - tt_) : tt_; \
        const f32x4 yv_ = *(const LAS f32x4*)(F.lds + YOFF + ((c) & 1) * YB + (ys_ * 32 + yr_) * 4); \
        *(u32x2*)(YS + pd + (size_t)t_ * 1024 + half * 32 + yr_) = (u32x2){cvtpk(yv_.x, yv_.y), cvtpk(yv_.z, yv_.w)}; } while (0)
#define SC_WAIT(cnt_, tgt_) do { for (;;) { const u32x4 q_ = *(volatile LAS u32x4*)(cnt_); const unsigned a_ = q_.x < q_.y ? q_.x : q_.y, b_ = q_.z < q_.w ? q_.z : q_.w; \
        if ((a_ < b_ ? a_ : b_) >= (tgt_)) break; if (is_comp) __builtin_amdgcn_s_sleep(1); else __builtin_amdgcn_s_sleep(12); } asm volatile("" ::: "memory"); } while (0)
#define SC_SIGNAL(cnt_, val_) do { asm volatile("s_waitcnt lgkmcnt(0)" ::: "memory"); if (lane == 0) *(volatile LAS unsigned*)((cnt_) + ri) = (val_); } while (0)
        __syncthreads();
        if (tid < 4) { st_cnt[tid] = 0u; cons_cnt[tid] = 0u; }
        if (!is_comp) { SC_LOAD(0); SC_STORE(0); SC_LOAD(1); }
        __syncthreads();
        if (is_comp) {
          for (int c = 0; c < NCH; ++c) {
            SC_WAIT(st_cnt, (unsigned)c);
            if (mode != 2) {
                const LAS unsigned char* bp = F.lds + (c & 1) * BUF;
                LAS float* yb = (LAS float*)(F.lds + YOFF + (c & 1) * YB);
                f32x4 cw_[2], ckk[2], cbb[2], ckd[2], cr[2]; float cv;
#define SC_RD(s_) do { const int o_ = ((s_) * 64 + j * 8) * 4; cw_[0] = *(const LAS f32x4*)(bp + o_); cw_[1] = *(const LAS f32x4*)(bp + o_ + 16); ckk[0] = *(const LAS f32x4*)(bp + VEC + o_); ckk[1] = *(const LAS f32x4*)(bp + VEC + o_ + 16); \
                cbb[0] = *(const LAS f32x4*)(bp + 2 * VEC + o_); cbb[1] = *(const LAS f32x4*)(bp + 2 * VEC + o_ + 16); ckd[0] = *(const LAS f32x4*)(bp + 3 * VEC + o_); ckd[1] = *(const LAS f32x4*)(bp + 3 * VEC + o_ + 16); \
                cr[0] = *(const LAS f32x4*)(bp + 4 * VEC + o_); cr[1] = *(const LAS f32x4*)(bp + 4 * VEC + o_ + 16); cv = *(const LAS float*)(bp + 5 * VEC + ((s_) * 32 + rowl) * 4); } while (0)
#define H2(v_, i_) ((f32x2){v_[(i_) >> 1][((i_) & 1) * 2], v_[(i_) >> 1][((i_) & 1) * 2 + 1]})
                SC_RD(0);
                float yk = 0.f;
#pragma unroll
                for (int s = 0; s < CH; ++s) {
                    f32x4 w[2] = {cw_[0], cw_[1]}, kk[2] = {ckk[0], ckk[1]}, bb[2] = {cbb[0], cbb[1]}, kd[2] = {ckd[0], ckd[1]}, r[2] = {cr[0], cr[1]}; const float v = cv;
                    if (s + 1 < CH) SC_RD(s + 1);
                    f32x2 pa = S2[0] * H2(kk, 0), pb = S2[1] * H2(kk, 1); pa = S2[2] * H2(kk, 2) + pa; pb = S2[3] * H2(kk, 3) + pb; pa = pa + pb;
                    const f32x2 vv = {v, v};
                    f32x2 u[4];
#pragma unroll
                    for (int i = 0; i < 4; ++i) u[i] = S2[i] * H2(w, i) + vv * H2(kd, i);
                    float p = pa.x + pa.y;
                    p = dpp_add<0xB1>(p); p = dpp_add<0x4E>(p); p = dpp_add<0x141>(p);
                    const f32x2 sa = {-p, -p};
#pragma unroll
                    for (int i = 0; i < 4; ++i) S2[i] = sa * H2(bb, i) + u[i];
                    f32x2 ya = S2[0] * H2(r, 0), yc = S2[1] * H2(r, 1); ya = S2[2] * H2(r, 2) + ya; yc = S2[3] * H2(r, 3) + yc; ya = ya + yc;
                    float y = ya.x + ya.y;
                    y = dpp_add<0xB1>(y); y = dpp_add<0x4E>(y); y = dpp_add<0x141>(y);
                    yk = (j == (s & 7)) ? y : yk;
                    if ((s & 7) == 7) yb[((s & 24) + j) * 32 + rowl] = yk;
                }
#undef SC_RD
#undef H2
            }
            SC_SIGNAL(cons_cnt, (unsigned)(c + 1));
          }
        } else {
#define MEM_DUTIES(c_) do { SC_WAIT(cons_cnt, (unsigned)(c_)); if ((c_) >= 1 && mode != 2) Y_OUT((c_) - 1); if ((c_) + 1 < NCH) SC_STORE(((c_) + 1) & 1); SC_SIGNAL(st_cnt, (unsigned)((c_) + 1)); if ((c_) + 2 < NCH) SC_LOAD((c_) + 2); } while (0)
#define CVT_LOAD_SET(V_, K0_, WT_, RB_) do { const int it_ = cvt_it < N_EXPERT_ITEMS ? cvt_it : N_EXPERT_ITEMS - 1; const float* cW_; int cn0_; cvt_expert_decode(F, it_, cW_, K0_, cn0_, WT_, RB_); cvt8_load(V_, cW_, K0_, cn0_, lane); cvt_it += F.G * 4; } while (0)
          if (item == F.vcu) { P5aConst p5k; p5a_init(F, p5k); for (int xm = F.vcu * 4 + mw; xm < MTOK; xm += F.G * 4) p5a_token(F, p5k, xm); }
          int ngrp = 0; { const int left = (N_EXPERT_ITEMS - cvt_it + F.G * 4 - 1) / (F.G * 4); ngrp = left > 0 ? left / 3 : 0; if (ngrp > NCH / 4) ngrp = NCH / 4; }
          int cg = 0;
#pragma unroll 1
          for (; cg < 4 * ngrp; cg += 4) {
            MEM_DUTIES(cg);
#if CVT_IN_SCAN
            if (cg > 0) cvt8_finish(cvv, ck0, cWT, crowb, lane);
            CVT_LOAD_SET(cvv, ck0, cWT, crowb);
#endif
            MEM_DUTIES(cg + 1);
#if CVT_IN_SCAN
            CVT_LOAD_SET(cvvB, ck0B, cWTB, crowbB);
#endif
            MEM_DUTIES(cg + 2);
#if CVT_IN_SCAN
            cvt8_finish(cvv, ck0, cWT, crowb, lane);
            CVT_LOAD_SET(cvv, ck0, cWT, crowb);
#endif
            MEM_DUTIES(cg + 3);
#if CVT_IN_SCAN
            cvt8_finish(cvvB, ck0B, cWTB, crowbB, lane);
#endif
          }
#if CVT_IN_SCAN
          if (ngrp > 0) cvt8_finish(cvv, ck0, cWT, crowb, lane);
#endif
#pragma unroll 1
          for (; cg < NCH; ++cg) MEM_DUTIES(cg);
#undef MEM_DUTIES
#undef CVT_LOAD_SET
          SC_WAIT(cons_cnt, (unsigned)NCH);
        }
        if (!is_comp && mode != 2) Y_OUT(NCH - 1);
#undef SC_LOAD
#undef SC_STORE
#undef Y_OUT
#undef SC_WAIT
#undef SC_SIGNAL
    }
    __builtin_amdgcn_s_setprio(0);
#if CVT_IN_SCAN
    if (!is_comp) {
        for (; cvt_it < N_EXPERT_ITEMS; cvt_it += F.G * 4) {
            const float* W; int k0, n0, rowb; unsigned char* WT;
            cvt_expert_decode(F, cvt_it, W, k0, n0, WT, rowb); cvt8_load(cvv, W, k0, n0, lane); cvt8_finish(cvv, k0, WT, rowb, lane);
        }
    }
#endif
}

__device__ __forceinline__ void p5_finalize(Frame& F) {
    const bf16_t* YS = WSP(F, WS_YS, bf16_t); const bf16_t* Vg = WSP(F, WS_V, bf16_t); const bf16_t* Gg = WSP(F, WS_G, bf16_t);
    const float* BON = WSP(F, WS_BONUS, float); bf16_t* MIX = WSP(F, WS_MIX, bf16_t);
    const float* lnw = INP(F, 19, float); const float* lnb = INP(F, 20, float);
    const int lane = F.lane, gw = F.vcu * 8 + F.wave, NGW = F.G * 8;
    const int c0 = lane * 16;
    float lw[16], lb[16];
#pragma unroll
    for (int i = 0; i < 16; ++i) { lw[i] = lnw[c0 + i]; lb[i] = lnb[c0 + i]; }
    struct Raw { u32x4 a0, a1, b0, b1, v0, v1, g0, g1; float bon; };
#define P5_LOAD(R_, m_) do { const u32x4* y0_ = (const u32x4*)(YS + (size_t)(m_) * 1024 + c0); const u32x4* y1_ = (const u32x4*)(YS + (size_t)MTOK * 1024 + (size_t)(m_) * 1024 + c0); \
        const u32x4* vp_ = (const u32x4*)(Vg + (size_t)(m_) * 1024 + c0); const u32x4* gp_ = (const u32x4*)(Gg + (size_t)(m_) * 1024 + c0); \
        R_.a0 = y0_[0]; R_.a1 = y0_[1]; R_.b0 = y1_[0]; R_.b1 = y1_[1]; R_.v0 = vp_[0]; R_.v1 = vp_[1]; R_.g0 = gp_[0]; R_.g1 = gp_[1]; R_.bon = BON[(size_t)(m_) * 16 + (lane >> 2)]; } while (0)
#define P5_FINISH(R_, m_) do { float y[16]; float s_ = 0.f; \
        { const unsigned aw[8] = {R_.a0.x, R_.a0.y, R_.a0.z, R_.a0.w, R_.a1.x, R_.a1.y, R_.a1.z, R_.a1.w}, bw[8] = {R_.b0.x, R_.b0.y, R_.b0.z, R_.b0.w, R_.b1.x, R_.b1.y, R_.b1.z, R_.b1.w}; \
          _Pragma("unroll") for (int i = 0; i < 8; ++i) { y[2 * i] = bf_lo(aw[i]) + bf_lo(bw[i]); y[2 * i + 1] = bf_hi(aw[i]) + bf_hi(bw[i]); } } \
        _Pragma("unroll") for (int i = 0; i < 16; ++i) s_ += y[i]; \
        s_ += __shfl_xor(s_, 1); s_ += __shfl_xor(s_, 2);                                              \
        const float mu_ = s_ * (1.f / 64.f); float q_ = 0.f; \
        _Pragma("unroll") for (int i = 0; i < 16; ++i) { y[i] -= mu_; q_ += y[i] * y[i]; } \
        q_ += __shfl_xor(q_, 1); q_ += __shfl_xor(q_, 2); \
        const float rstd_ = 1.f / sqrtf(q_ * (1.f / 64.f) + 64e-5f); \
        const unsigned vw[8] = {R_.v0.x, R_.v0.y, R_.v0.z, R_.v0.w, R_.v1.x, R_.v1.y, R_.v1.z, R_.v1.w}, gq[8] = {R_.g0.x, R_.g0.y, R_.g0.z, R_.g0.w, R_.g1.x, R_.g1.y, R_.g1.z, R_.g1.w}; \
        unsigned ow[8]; \
        _Pragma("unroll") for (int i = 0; i < 8; ++i) { \
            const float e0 = (y[2 * i] * rstd_ * lw[2 * i] + lb[2 * i] + R_.bon * bf_lo(vw[i])) * bf_lo(gq[i]); \
            const float e1 = (y[2 * i + 1] * rstd_ * lw[2 * i + 1] + lb[2 * i + 1] + R_.bon * bf_hi(vw[i])) * bf_hi(gq[i]); \
            ow[i] = cvtpk(e0, e1); } \
        u32x4* op = (u32x4*)(MIX + (size_t)(m_) * 2048 + 1024 + c0); op[0] = (u32x4){ow[0], ow[1], ow[2], ow[3]}; op[1] = (u32x4){ow[4], ow[5], ow[6], ow[7]}; } while (0)
    for (int m = gw; m < MTOK; m += 2 * NGW) {
        const int m2 = m + NGW; const bool has2 = m2 < MTOK;
        Raw ra, rb; P5_LOAD(ra, m); if (has2) P5_LOAD(rb, m2);
        P5_FINISH(ra, m); if (has2) P5_FINISH(rb, m2);
    }
#undef P5_LOAD
#undef P5_FINISH
}

__device__ __forceinline__ void p7_router(Frame& F) {
    const bf16_t* X1 = WSP(F, WS_X1, bf16_t); const float* nw = INP(F, 22, float); const float* wr = INP(F, 23, float);
    unsigned char* H2 = WSP(F, WS_H2, unsigned char); float* AFF = WSP(F, WS_AFF, float);
    const int lane = F.lane, w = F.wave, tok = lane & 15, kq = lane >> 4;
    LAS float* part = (LAS float*)F.lds;
    LAS float* ssqp = (LAS float*)(F.lds + 8192);
    const int kb = 256 * w + 8 * kq;
    float Bw[8][8];
#pragma unroll
    for (int g = 0; g < 8; ++g)
#pragma unroll
        for (int e = 0; e < 8; ++e) { const int k = kb + 32 * g + e; Bw[g][e] = nw[k] * wr[(size_t)k * 16 + tok]; }
    for (int item = F.vcu; item < MTOK / 16; item += F.G) {
        const int m0 = item * 16;
        u32x4 xr[8];
        const bf16_t* xp = X1 + (size_t)(m0 + tok) * DM + kb;
#pragma unroll
        for (int g = 0; g < 8; ++g) xr[g] = *(const u32x4*)(xp + 32 * g);
        f32x4 acc = {0.f, 0.f, 0.f, 0.f}; float ss = 0.f;
#pragma unroll
        for (int g = 0; g < 8; ++g) {
            float x[8]; unpack8(xr[g], x);
#pragma unroll
            for (int e = 0; e < 8; ++e) { ss += x[e] * x[e]; acc = __builtin_amdgcn_mfma_f32_16x16x4f32(x[e], Bw[g][e], acc, 0, 0, 0); }
        }
        __syncthreads();
        *(LAS f32x4*)(part + w * 256 + tok * 16 + 4 * kq) = acc;
        ss += __shfl_xor(ss, 16); ss += __shfl_xor(ss, 32);
        if (kq == 0) ssqp[w * 16 + tok] = ss;
        __syncthreads();
        float tot = 0.f;
#pragma unroll
        for (int i = 0; i < 8; ++i) tot += ssqp[i * 16 + tok];
        const float rstd = 1.f / sqrtf(tot * (1.f / DM) + 1e-6f);
        { unsigned char* hp = H2 + (size_t)(m0 + tok) * DM + kb;
#pragma unroll
          for (int g = 0; g < 8; ++g) { float x[8]; unpack8(xr[g], x); const f32x4 n0 = *(const f32x4*)(nw + kb + 32 * g), n1 = *(const f32x4*)(nw + kb + 32 * g + 4);
              u32x2 o; o.x = pg8::cvt4_fp8(x[0] * rstd * n0.x, x[1] * rstd * n0.y, x[2] * rstd * n0.z, x[3] * rstd * n0.w); o.y = pg8::cvt4_fp8(x[4] * rstd * n1.x, x[5] * rstd * n1.y, x[6] * rstd * n1.z, x[7] * rstd * n1.w);
              *(u32x2*)(hp + 32 * g) = o; } }
        if (lane < 32) {
            const int tt = 2 * w + (lane >> 4), ex = lane & 15;
            float lg = 0.f, t2 = 0.f;
#pragma unroll
            for (int i = 0; i < 8; ++i) { lg += part[i * 256 + ex * 16 + tt]; t2 += ssqp[i * 16 + tt]; }
            lg *= 1.f / sqrtf(t2 * (1.f / DM) + 1e-6f);
            float mx = lg;
            mx = fmaxf(mx, __shfl_xor(mx, 1)); mx = fmaxf(mx, __shfl_xor(mx, 2)); mx = fmaxf(mx, __shfl_xor(mx, 4)); mx = fmaxf(mx, __shfl_xor(mx, 8));
            const float pe = expf(lg - mx);
            float den = pe; den += __shfl_xor(den, 1); den += __shfl_xor(den, 2); den += __shfl_xor(den, 4); den += __shfl_xor(den, 8);
            const int mm = m0 + tt;
            AFF[((size_t)(mm >> 11) * 16 + ex) * SEQ + (mm & (SEQ - 1))] = pe / den;
        }
    }
    __syncthreads();
}

__device__ __forceinline__ int wave_count4(bool f0, bool f1, bool f2, bool f3) {
    return __builtin_popcountll(__ballot(f0)) + __builtin_popcountll(__ballot(f1)) + __builtin_popcountll(__ballot(f2)) + __builtin_popcountll(__ballot(f3));
}
__device__ __forceinline__ void p8_select(Frame& F) {
    const float* AFF = WSP(F, WS_AFF, float);
    int* XEIDX = WSP(F, WS_XEIDX, int); float* GATEX = WSP(F, WS_GATEX, float); int* SLOT = WSP(F, WS_SLOT, int);
    LAS int* part = (LAS int*)F.lds;
    LAS unsigned* cnt = (LAS unsigned*)(F.lds + 256);
    LAS unsigned* list = (LAS unsigned*)(F.lds + 512);
    const int tid = F.tid, lane = F.lane, w = F.wave;
    for (int item = F.vcu; item < 256; item += F.G) {
        const int be = item >> 2, q = item & 3, b = be >> 4, e = be & 15;
        __syncthreads();
        if (tid == 0) *cnt = 0u;
        const f32x4 a4 = ((const f32x4*)(AFF + (size_t)be * SEQ))[tid];
        const unsigned u0 = __float_as_uint(a4.x), u1 = __float_as_uint(a4.y), u2 = __float_as_uint(a4.z), u3 = __float_as_uint(a4.w);
        unsigned lo = 0u, hi = 0x7f800001u;
        int itn = 0;
        while (hi - lo > 1u) {
            const unsigned mid = lo + ((hi - lo) >> 1);
            const int c = wave_count4(u0 >= mid, u1 >= mid, u2 >= mid, u3 >= mid);
            LAS int* pp = part + (itn & 1) * 8;
            if (lane == 0) pp[w] = c;
            __syncthreads();
            int tot = 0;
#pragma unroll
            for (int i = 0; i < 8; ++i) tot += pp[i];
            if (tot >= CAP) lo = mid; else hi = mid;
            ++itn;
        }
        const unsigned T = lo;
        const bool g0 = u0 > T, g1 = u1 > T, g2 = u2 > T, g3 = u3 > T, q0 = u0 == T, q1 = u1 == T, q2 = u2 == T, q3 = u3 == T;
        const unsigned long long bg0 = __ballot(g0), bg1 = __ballot(g1), bg2 = __ballot(g2), bg3 = __ballot(g3), bq0 = __ballot(q0), bq1 = __ballot(q1), bq2 = __ballot(q2), bq3 = __ballot(q3);
        const unsigned long long below = (lane == 0) ? 0ull : (~0ull >> (64 - lane));
        int pg = __builtin_popcountll(bg0 & below) + __builtin_popcountll(bg1 & below) + __builtin_popcountll(bg2 & below) + __builtin_popcountll(bg3 & below);
        int pq = __builtin_popcountll(bq0 & below) + __builtin_popcountll(bq1 & below) + __builtin_popcountll(bq2 & below) + __builtin_popcountll(bq3 & below);
        const int wg = __builtin_popcountll(bg0) + __builtin_popcountll(bg1) + __builtin_popcountll(bg2) + __builtin_popcountll(bg3);
        const int wq = __builtin_popcountll(bq0) + __builtin_popcountll(bq1) + __builtin_popcountll(bq2) + __builtin_popcountll(bq3);
        if (lane == 0) { part[16 + w] = wg; part[32 + w] = wq; }
        __syncthreads();
        int gtc = 0, baseg = 0, baseq = 0;
#pragma unroll
        for (int i = 0; i < 8; ++i) { const int x = part[16 + i], y = part[32 + i]; gtc += x; if (i < w) { baseg += x; baseq += y; } }
        const int need = CAP - gtc;
        pg += baseg; pq += baseq;
        if ((w >> 1) == q) {
            const bool gs[4] = {g0, g1, g2, g3}, qs[4] = {q0, q1, q2, q3}; const float av[4] = {a4.x, a4.y, a4.z, a4.w};
            int cg_ = pg, cq_ = pq;
#pragma unroll
            for (int i = 0; i < 4; ++i) {
                const int t = 4 * tid + i, m = b * SEQ + t; int slot = -1;
                if (gs[i]) { slot = cg_; ++cg_; } else if (qs[i]) { if (cq_ < need) slot = gtc + cq_; ++cq_; }
                SLOT[m * 16 + e] = slot;
                if (slot >= 0) { GATEX[(e * 4 + b) * CAP + slot] = av[i]; XEIDX[(e * 4 + b) * CAP + slot] = m; }
            }
        }
    }
}

__device__ __forceinline__ void p11_final(Frame& F) {
    const bf16_t* X1 = WSP(F, WS_X1, bf16_t); const unsigned char* YE = WSP(F, WS_YE, unsigned char); const int* SLOT = WSP(F, WS_SLOT, int); const float* nw = INP(F, 27, float);
    float* out = F.a->out;
    const int lane = F.lane, gw = F.vcu * 8 + F.wave, NGW = F.G * 8;
    for (int mA = gw; mA < MTOK; mA += 2 * NGW) {
        const int mB = mA + NGW; const bool hasB = mB < MTOK; const int mBc = hasB ? mB : mA;
        int slA = (lane < 16) ? SLOT[mA * 16 + lane] : -1, slB = (lane < 16 && hasB) ? SLOT[mBc * 16 + lane] : -1;
        u32x4 xa[4], xb[4];
        { const u32x4* xr = (const u32x4*)(X1 + (size_t)mA * DM + lane * 8); const u32x4* xs = (const u32x4*)(X1 + (size_t)mBc * DM + lane * 8);
#pragma unroll
          for (int j = 0; j < 4; ++j) { xa[j] = xr[64 * j]; xb[j] = xs[64 * j]; } }
        unsigned mkA = (unsigned)(__ballot(slA >= 0) & 0xFFFFull), mkB = (unsigned)(__ballot(slB >= 0) & 0xFFFFull);
        float va[32], vb[32];
#pragma unroll
        for (int j = 0; j < 4; ++j) { const u32x4 a = xa[j], c = xb[j];
            va[8 * j] = bf_lo(a.x); va[8 * j + 1] = bf_hi(a.x); va[8 * j + 2] = bf_lo(a.y); va[8 * j + 3] = bf_hi(a.y); va[8 * j + 4] = bf_lo(a.z); va[8 * j + 5] = bf_hi(a.z); va[8 * j + 6] = bf_lo(a.w); va[8 * j + 7] = bf_hi(a.w);
            vb[8 * j] = bf_lo(c.x); vb[8 * j + 1] = bf_hi(c.x); vb[8 * j + 2] = bf_lo(c.y); vb[8 * j + 3] = bf_hi(c.y); vb[8 * j + 4] = bf_lo(c.z); vb[8 * j + 5] = bf_hi(c.z); vb[8 * j + 6] = bf_lo(c.w); vb[8 * j + 7] = bf_hi(c.w); }
        const int bA = mA >> 11, bB = mBc >> 11;
        while (mkA | mkB) {
            u32x2 ra[2][4], rb[2][4];
#pragma unroll
            for (int q = 0; q < 2; ++q) {
                if (mkA) { const int e = __builtin_ctz(mkA); mkA &= mkA - 1u; const int sl = __builtin_amdgcn_readlane(slA, e);
                    const u32x2* yr = (const u32x2*)(YE + (size_t)((e * 4 + bA) * CAP + sl) * DM + lane * 8);
#pragma unroll
                    for (int j = 0; j < 4; ++j) ra[q][j] = yr[64 * j]; }
                else {
#pragma unroll
                    for (int j = 0; j < 4; ++j) ra[q][j] = (u32x2){0u, 0u}; }
                if (mkB) { const int e = __builtin_ctz(mkB); mkB &= mkB - 1u; const int sl = __builtin_amdgcn_readlane(slB, e);
                    const u32x2* yr = (const u32x2*)(YE + (size_t)((e * 4 + bB) * CAP + sl) * DM + lane * 8);
#pragma unroll
                    for (int j = 0; j < 4; ++j) rb[q][j] = yr[64 * j]; }
                else {
#pragma unroll
                    for (int j = 0; j < 4; ++j) rb[q][j] = (u32x2){0u, 0u}; }
            }
#define P11_ACC(V_, W_, q_) do { V_[8 * j + (q_)] += __builtin_amdgcn_cvt_f32_fp8(W_.x, q_) * pg8::YE_DESCALE; V_[8 * j + 4 + (q_)] += __builtin_amdgcn_cvt_f32_fp8(W_.y, q_) * pg8::YE_DESCALE; } while (0)
#pragma unroll
            for (int q = 0; q < 2; ++q)
#pragma unroll
                for (int j = 0; j < 4; ++j) { const u32x2 wa = ra[q][j], wb = rb[q][j];
                    P11_ACC(va, wa, 0); P11_ACC(va, wa, 1); P11_ACC(va, wa, 2); P11_ACC(va, wa, 3); P11_ACC(vb, wb, 0); P11_ACC(vb, wb, 1); P11_ACC(vb, wb, 2); P11_ACC(vb, wb, 3); }
#undef P11_ACC
        }
        float sa = 0.f, sb = 0.f;
#pragma unroll
        for (int i = 0; i < 32; ++i) { sa += va[i] * va[i]; sb += vb[i] * vb[i]; }
        const float rsa = 1.f / sqrtf(wave_sum(sa) * (1.f / DM) + 1e-6f), rsb = 1.f / sqrtf(wave_sum(sb) * (1.f / DM) + 1e-6f);
#pragma unroll
        for (int j = 0; j < 4; ++j) { const int col = 512 * j + lane * 8; const f32x4 w0 = *(const f32x4*)(nw + col), w1 = *(const f32x4*)(nw + col + 4);
            { f32x4 o0 = {va[8 * j] * rsa * w0.x, va[8 * j + 1] * rsa * w0.y, va[8 * j + 2] * rsa * w0.z, va[8 * j + 3] * rsa * w0.w};
              f32x4 o1 = {va[8 * j + 4] * rsa * w1.x, va[8 * j + 5] * rsa * w1.y, va[8 * j + 6] * rsa * w1.z, va[8 * j + 7] * rsa * w1.w};
              *(f32x4*)(out + (size_t)mA * DM + col) = o0; *(f32x4*)(out + (size_t)mA * DM + col + 4) = o1; }
            if (hasB) { f32x4 o0 = {vb[8 * j] * rsb * w0.x, vb[8 * j + 1] * rsb * w0.y, vb[8 * j + 2] * rsb * w0.z, vb[8 * j + 3] * rsb * w0.w};
              f32x4 o1 = {vb[8 * j + 4] * rsb * w1.x, vb[8 * j + 5] * rsb * w1.y, vb[8 * j + 6] * rsb * w1.z, vb[8 * j + 7] * rsb * w1.w};
              *(f32x4*)(out + (size_t)mB * DM + col) = o0; *(f32x4*)(out + (size_t)mB * DM + col + 4) = o1; } }
    }
}


template <int PHM> __global__ void __launch_bounds__(512, 2) mk_fwd(Args args) {
    extern __shared__ __attribute__((aligned(16))) unsigned char lds[];
    Frame F;
    F.lds = (LAS unsigned char*)lds; F.ldsg = (char*)lds; F.a = &args;
    F.tid = threadIdx.x; F.lane = F.tid & 63; F.wave = __builtin_amdgcn_readfirstlane(F.tid >> 6);
    F.G = gridDim.x; { const int bx = blockIdx.x; F.vcu = (F.G % 8 == 0) ? (bx % 8) * (F.G / 8) + bx / 8 : bx; }
    volatile LAS unsigned* MISC = (volatile LAS unsigned*)(F.lds + MISC_OFF);
    for (int u = F.tid; u < (LDS_BYTES - 131072) / 4; u += 512) ((LAS unsigned*)(F.lds + 131072))[u] = 0u;
    __syncthreads();
    gu32* ctl = (gu32*)(args.ws + WS_CTL);
    XcdBarrier bar; bar.bar = (unsigned*)(ctl + CW_BAR); bar.x = 0; bar.st = nullptr;
    if (MK_N_LAUNCHES == 1) bar = xcd_barrier_post((unsigned*)(ctl + CW_BAR), MISC + 8);
    const int lo = args.ph_lo, hi = args.ph_hi;
#define IN(k) (((PHM >> (k)) & 1) && lo <= (k) && (k) < hi)
#ifndef DUP_MASK
#define DUP_MASK 0
#endif
#define REP(k) for (int rep_ = 0; rep_ < 1 + ((DUP_MASK >> (k)) & 1); ++rep_)
#define SEAM(k) do { if (IN(k) && IN((k) + 1)) xcd_barrier(bar); } while (0)

    if (IN(0)) REP(0) { p0_prologue(F); }
    SEAM(0);
    if (IN(1)) REP(1) {
        pg8::Gemm g{WSP(F, WS_H1, bf16_t), WSP(F, WS_WIN, bf16_t), MTOK, 6144, DM, DM}; pg8::StaticOrder S; S.init(MTOK, 6144, F.G, (int)blockIdx.x);
        pg8::EpiProj E{WSP(F, WS_PROJ, bf16_t), LDP, WSP(F, WS_ROPE, float), QSCALE};
        pg8::gemm_phase<pg8::EpiProj, pg8::StaticOrder, true, true>(F.lds, g, S, E);
        pg8::Gemm g2{WSP(F, WS_H1, bf16_t), WSP(F, WS_WIN, bf16_t), MTOK, 512, DM / 4, DM}; pg8::TailOrder S2{F.G, (int)blockIdx.x};
        pg8::EpiPart E2{WSP(F, WS_PART, bf16_t)};
        pg8::gemm_phase<pg8::EpiPart, pg8::TailOrder, true, true>(F.lds, g2, S2, E2);
    }
    SEAM(1);
    const bool prep_first = (F.vcu & 1) != 0;
    if (IN(3) && prep_first) { p3_prep(F, 0); }
    if (IN(2)) {
        const bf16_t* P = WSP(F, WS_PROJ, bf16_t); bf16_t* OC = WSP(F, WS_OC, bf16_t);
        for (int u = F.vcu * 2; u < 512; u += F.G * 2)
            for (int i = 0; i < 2; ++i) {
                const int uu = u + i, qb = uu & 7, c = (uu >> 3) & 1, h = (uu >> 4) & 7, b = uu >> 7;
                const size_t m0 = (size_t)b * SEQ;
                att::attn_unit<LDP>(P + (m0 + qb * 256) * LDP + h * 128 + c * 64, P + m0 * LDP + 1024 + h * 128 + c * 64, P + m0 * LDP + 2048 + h * 128,
                                    OC + (size_t)c * MTOK * 1024 + (m0 + qb * 256) * 1024 + h * 128, SEQ, F.ldsg);
            }
    }
    if (IN(3) && !prep_first) { p3_prep(F, 0); }
    SEAM(3);
    #ifndef SCAN_PROBE
#define SCAN_PROBE 0
#endif
    if (IN(4)) REP(4) { p4_scan(F, rep_ ? SCAN_PROBE : 0); }
    SEAM(4);
    if (IN(5)) REP(5) { p5_finalize(F); }
    SEAM(5);
    if (IN(6)) REP(6) {
        pg8::Gemm g{WSP(F, WS_MIX, bf16_t), WSP(F, WS_WOUT, bf16_t), MTOK, DM, DM, DM}; pg8::StaticOrder S; S.init(MTOK, DM, F.G, (int)blockIdx.x);
        pg8::EpiResid E{INP(F, 0, float), WSP(F, WS_X1, bf16_t), DM};
        pg8::gemm_phase<pg8::EpiResid, pg8::StaticOrder, true, true>(F.lds, g, S, E);
    }
    SEAM(6);
    if (IN(7)) REP(7) { p7_router(F); }
    SEAM(7);
    if (IN(8)) REP(8) { p8_select(F); }
    SEAM(8);
    if (IN(9)) REP(9) {
        pg8::Gemm g{WSP(F, WS_H2, bf16_t), WSP(F, WS_WGU, bf16_t), 16384, 65536, DM / 2, DM / 2}; pg8::MoeOrderT<true> S{F.G, F.vcu, 16, 1024, WSP(F, WS_XEIDX, int)};
        pg8::EpiSwiglu E{WSP(F, WS_HID, unsigned char), 16};
        pg8::gemm_phase<pg8::EpiSwiglu, pg8::MoeOrderT<true>, true, true, true>(F.lds, g, S, E);
    }
    SEAM(9);
    if (IN(10)) REP(10) {
        pg8::Gemm g{WSP(F, WS_HID, bf16_t), WSP(F, WS_WD, bf16_t), 16384, 32768, DM / 2, DM / 2}; pg8::MoeOrderT<false> S{F.G, F.vcu, 8, 512, nullptr};
        pg8::EpiDown E{WSP(F, WS_YE, unsigned char), WSP(F, WS_GATEX, float), 8};
        pg8::gemm_phase<pg8::EpiDown, pg8::MoeOrderT<false>, true, true, true>(F.lds, g, S, E);
    }
    SEAM(10);
    if (IN(11)) REP(11) { p11_final(F); }
#undef IN
#undef SEAM
}

static const void* kfn(int li) {
#if MK_N_LAUNCHES == 1
    (void)li; return (const void*)mk_fwd<0xFFF>;
#else
    switch (li) {
        case 0: return (const void*)mk_fwd<1>; case 1: return (const void*)mk_fwd<2>; case 2: return (const void*)mk_fwd<4>; case 3: return (const void*)mk_fwd<8>;
        case 4: return (const void*)mk_fwd<16>; case 5: return (const void*)mk_fwd<32>; case 6: return (const void*)mk_fwd<64>; case 7: return (const void*)mk_fwd<128>;
        case 8: return (const void*)mk_fwd<256>; case 9: return (const void*)mk_fwd<512>; case 10: return (const void*)mk_fwd<1024>; default: return (const void*)mk_fwd<2048>;
    }
#endif
}
extern "C" void kernel_launch(void* const* d_in, const int* in_sizes, int n_in, void* d_out, int out_size, void* d_ws, size_t ws_size, hipStream_t stream) {
    static int grid = 0;
    if (grid == 0) {
        if (n_in != 28 || out_size != MTOK * DM || ws_size < WS_END) { fprintf(stderr, "kernel_launch: unexpected shapes: n_in %d out %d ws %zu (need >= %zu)\n", n_in, out_size, ws_size, (size_t)WS_END); grid = -1; return; }
        int dev = 0, cus = 0, per_cu = 0;
        if (hipGetDevice(&dev) != hipSuccess || hipDeviceGetAttribute(&cus, hipDeviceAttributeMultiprocessorCount, dev) != hipSuccess) { fprintf(stderr, "kernel_launch: device query failed\n"); grid = -1; return; }
        for (int i = 0; i < MK_N_LAUNCHES; ++i) if (hipFuncSetAttribute(kfn(i), hipFuncAttributeMaxDynamicSharedMemorySize, LDS_BYTES) != hipSuccess) { fprintf(stderr, "kernel_launch: hipFuncSetAttribute failed\n"); grid = -1; return; }
        if (hipOccupancyMaxActiveBlocksPerMultiprocessor(&per_cu, kfn(0), 512, LDS_BYTES) != hipSuccess || per_cu < 1) { fprintf(stderr, "kernel_launch: occupancy query says %d blocks/CU\n", per_cu); }
        (void)hipGetLastError();
        grid = cus;
    }
    if (grid < 0) return;
    if (hipMemsetAsync((char*)d_ws + WS_CTL, 0, CTL_ZERO_BYTES, stream) != hipSuccess) { fprintf(stderr, "kernel_launch: memset failed\n"); return; }
    Args a{};
    for (int i = 0; i < 28; ++i) a.in[i] = d_in[i];
    a.out = (float*)d_out; a.ws = (unsigned char*)d_ws;
    const int nl = MK_N_LAUNCHES;
    for (int li = 0; li < nl; ++li) {
        a.ph_lo = (nl == 1) ? 0 : li; a.ph_hi = (nl == 1) ? N_PHASES : li + 1; a.li = li;
        void* kargs[] = {&a};
        (void)hipLaunchKernel(kfn(li), dim3(grid), dim3(512), kargs, LDS_BYTES, stream);
        const hipError_t le = hipPeekAtLastError();
        if (le != hipSuccess) { fprintf(stderr, "kernel_launch: launch %d failed: %s\n", li, hipGetErrorName(le)); break; }
    }
}
```

```cpp
#include <hip/hip_runtime.h>
#include <hip/hip_bf16.h>
#include <cstdio>
#include <cstdint>

#ifndef MK_N_LAUNCHES
#define MK_N_LAUNCHES 1
#endif
#ifndef CVT_IN_SCAN
#define CVT_IN_SCAN 1
#endif
constexpr int N_PHASES = 12;

constexpr int BATCH = 4, SEQ = 2048, DM = 2048, MTOK = BATCH * SEQ;
constexpr int IN_COLS = 6432, LDP = 6656;
constexpr int ZC0 = 3072;
constexpr int RW = 1024, NH_R = 16, HD_R = 64;
constexpr int NEXP = 16, CAP = 256, FF = 2048;
constexpr float QSCALE = 0.18033688011112042f;

constexpr size_t MiB = 1u << 20;
constexpr size_t WS_CTL = 0, CTL_ZERO_BYTES = 1 * MiB;
constexpr size_t WS_ROPE = 1 * MiB;
constexpr size_t WS_LORA = 2 * MiB;
constexpr size_t WS_AFF = 3 * MiB;
constexpr size_t WS_GATEX = 3 * MiB + 512 * 1024;
constexpr size_t WS_SLOT = 4 * MiB;
constexpr size_t WS_XEIDX = 6 * MiB;
constexpr size_t WS_BONUS = 5 * MiB;
constexpr size_t WS_WIN = 8 * MiB;
constexpr size_t WS_WOUT = 34 * MiB;
constexpr size_t WS_WGU = 48 * MiB;
constexpr size_t WS_WD = 304 * MiB;
constexpr size_t WS_H1 = 432 * MiB;
constexpr size_t WS_PROJ = 464 * MiB;
constexpr size_t WS_R = 568 * MiB, WS_KK = 584 * MiB, WS_V = 600 * MiB;
constexpr size_t WS_WDEC = 616 * MiB;
constexpr size_t WS_KD = 680 * MiB, WS_BB = 712 * MiB;
constexpr size_t WS_G = 744 * MiB;
constexpr size_t WS_OC = 760 * MiB;
constexpr size_t WS_YS = 792 * MiB;
constexpr size_t WS_MIX = 856 * MiB;
constexpr size_t WS_X1 = 888 * MiB;
constexpr size_t WS_H2 = 952 * MiB;
constexpr size_t WS_HID = 528 * MiB, WS_YE = 592 * MiB;
constexpr size_t WS_PART = WS_X1;
constexpr size_t WS_END = 984 * MiB;
constexpr int CW_BAR = 4096;

constexpr int LDS_BYTES = 147456;
constexpr int MISC_OFF = 131072 + 320;

#define GAS __attribute__((address_space(1)))
#define LAS __attribute__((address_space(3)))
typedef unsigned short bf16_t;
typedef float f32x4 __attribute__((ext_vector_type(4)));
typedef float f32x2 __attribute__((ext_vector_type(2)));
typedef float f32x16 __attribute__((ext_vector_type(16)));
typedef unsigned u32x4 __attribute__((ext_vector_type(4)));
typedef unsigned u32x2 __attribute__((ext_vector_type(2)));
typedef short bf16x8 __attribute__((ext_vector_type(8)));
typedef short s16x4 __attribute__((ext_vector_type(4)));
typedef __bf16 bf16x2_t __attribute__((ext_vector_type(2)));

__device__ __forceinline__ unsigned cvtpk(float lo, float hi) { f32x2 v = {lo, hi}; bf16x2_t b = __builtin_convertvector(v, bf16x2_t); return __builtin_bit_cast(unsigned, b); }
__device__ __forceinline__ float bf_lo(unsigned w) { return __uint_as_float(w << 16); }
__device__ __forceinline__ float bf_hi(unsigned w) { return __uint_as_float(w & 0xffff0000u); }
__device__ __forceinline__ float bf2f(bf16_t v) { return __uint_as_float((unsigned)v << 16); }
__device__ __forceinline__ float wave_sum(float v) {
#pragma unroll
    for (int o = 1; o < 64; o <<= 1) v += __shfl_xor(v, o);
    return v;
}
__device__ __forceinline__ float sigmoidf_(float x) { return 1.f / (1.f + __expf(-x)); }

struct Args { const void* in[28]; float* out; unsigned char* ws; int ph_lo, ph_hi, li, pad; };

namespace pg8 {
#define PG8_LAS __attribute__((address_space(3)))
typedef unsigned short bf16_t;
typedef short bf16x8 __attribute__((ext_vector_type(8)));
typedef float f32x4 __attribute__((ext_vector_type(4)));
typedef unsigned u32x4 __attribute__((ext_vector_type(4)));
typedef unsigned u32x2 __attribute__((ext_vector_type(2)));
typedef int i32x4 __attribute__((ext_vector_type(4)));
typedef int i32x8 __attribute__((ext_vector_type(8)));
typedef float f32x8 __attribute__((ext_vector_type(8)));
typedef float f32x32 __attribute__((ext_vector_type(32)));
constexpr int BM = 256, BK = 64, HALF = 128, HTB = HALF * BK * 2  , STAGE_BYTES = 8 * HTB, NXCD = 8, WGM = 8;

__host__ __device__ __forceinline__ int lds_byte(int r, int c) { const int st = (r >> 4) * 2 + (c >> 5), rr = r & 15, cc = c & 31, ob = rr * 64 + cc * 2; return st * 1024 + (ob ^ (((ob >> 9) & 1) << 5)); }
__host__ __device__ __forceinline__ void stage_rc(int b, int& R, int& C) { const int st = b / 1024, sb = b % 1024, swz = sb ^ (((sb >> 9) & 1) << 5); R = (st >> 1) * 16 + swz / 64; C = (st & 1) * 32 + (swz % 64) / 2; }
__host__ __device__ __forceinline__ int perm32(int rho) { const int n = rho >> 4, i = rho & 15; return 8 * (i >> 2) + 4 * n + (i & 3); }

struct Unit { int pm, pn, pk; };
struct Gemm { const bf16_t* A; const bf16_t* Bt; int M, N, K, Kp; };

struct StaticOrder {
    int nM, nN, nwg, G, c;
    __host__ __device__ void init(int M, int N, int G_, int c_) { nM = M / BM; nN = N / BM; nwg = nM * nN; G = G_; c = c_; }
    __host__ __device__ bool next(int i, Unit& u) const {
        const long L = (long)i * G + c; if (L >= nwg) return false;
        int wgid = (int)L; { const int q = nwg / NXCD, r = nwg % NXCD, xcd = wgid % NXCD, off = wgid / NXCD; wgid = (xcd < r ? xcd * (q + 1) : r * (q + 1) + (xcd - r) * q) + off; }
        const int nig = WGM * nN, gid = wgid / nig, fm = gid * WGM, gsz = (nM - fm) < WGM ? (nM - fm) : WGM;
        u.pm = fm + ((wgid % nig) % gsz); u.pn = (wgid % nig) / gsz; u.pk = 0; return true;
    }
    static constexpr bool GATHER = false;
    __device__ __forceinline__ int arow(const Unit&, int) const { return 0; }
    __device__ __forceinline__ void a_ready(const Unit&) const {}
    __device__ __forceinline__ void done(const Unit&) const {}
};


typedef float f32x2 __attribute__((ext_vector_type(2)));
typedef __bf16 bf16x2_t __attribute__((ext_vector_type(2)));
__device__ __forceinline__ unsigned cvt_pk_bf16(float lo, float hi) { f32x2 v = {lo, hi}; bf16x2_t b = __builtin_convertvector(v, bf16x2_t); return __builtin_bit_cast(unsigned, b); }

template <bool GATHER_> struct MoeOrderT {
    static constexpr bool GATHER = GATHER_;
    int G, vcu, npn, total; const int* idx;
    __device__ __forceinline__ int arow(const Unit& u, int r) const { return idx[u.pm * BM + r]; }
    __device__ bool next(int i, Unit& u) const {
        const int L = i * G + vcu; if (L >= total) return false;
        const int per_e = 4 * npn, e = L / per_e, r = L % per_e;
        u.pm = e * 4 + (r & 3); u.pn = e * npn + (r >> 2); u.pk = 0; return true;
    }
    __device__ __forceinline__ void a_ready(const Unit&) const {}
    __device__ __forceinline__ void done(const Unit&) const {}
};

struct TailOrder {
    int G, c; static constexpr bool GATHER = false;
    __device__ bool next(int i, Unit& u) const { const int L = i * G + c; if (L >= 256) return false; u.pk = L & 3; const int t = L >> 2; u.pm = t & 31; u.pn = 24 + (t >> 5); return true; }
    __device__ __forceinline__ int arow(const Unit&, int) const { return 0; }
    __device__ __forceinline__ void a_ready(const Unit&) const {}
    __device__ __forceinline__ void done(const Unit&) const {}
};
struct EpiPart {
    static constexpr bool PERM = true, AFTER_DRAIN = false;
    bf16_t* P;
    __device__ __forceinline__ void operator()(const f32x4 (&acc)[2][2][4][2], const Unit& u, int wr, int wc, int fr, int fq) const {
        bf16_t* base = P + ((size_t)(((u.pn - 24) * 32 + u.pm) * 4 + u.pk) << 16);
        const int row0 = wr * 64 + fr, col0 = wc * 32 + 8 * fq;
        const bool thin = (u.pn == 25);
        if (thin && wc != 0) return;
#pragma unroll
        for (int ai = 0; ai < 2; ++ai)
#pragma unroll
            for (int m = 0; m < 4; ++m) {
                bf16_t* rowp = base + (row0 + ai * HALF + m * 16) * 256 + col0;
#pragma unroll
                for (int bj = 0; bj < 2; ++bj) { if (bj == 1 && thin) break; const f32x4 v0 = acc[ai][bj][m][0], v1 = acc[ai][bj][m][1];
                    u32x4 w; w.x = cvt_pk_bf16(v0[0], v0[1]); w.y = cvt_pk_bf16(v0[2], v0[3]); w.z = cvt_pk_bf16(v1[0], v1[1]); w.w = cvt_pk_bf16(v1[2], v1[3]);
                    *(u32x4*)(rowp + bj * HALF) = w; }
            }
    }
};

struct EpiProj {
    static constexpr bool PERM = true, AFTER_DRAIN = false;
    bf16_t* P; int ldp; const float* rope; float qscale;
    __device__ __forceinline__ void operator()(const f32x4 (&acc)[2][2][4][2], const Unit& u, int wr, int wc, int fr, int fq) const {
        const int row0 = u.pm * BM + wr * 64 + fr, colt = u.pn * BM, col0 = colt + wc * 32 + 8 * fq;
        const bool ropew = (colt < 2048) && ((wc & 1) == 0);
        const float sc = (colt < 1024) ? qscale : 1.f, sgn = (fq == 0) ? -1.f : 1.f;
#pragma unroll
        for (int ai = 0; ai < 2; ++ai)
#pragma unroll
            for (int m = 0; m < 4; ++m) {
                const int row = row0 + ai * HALF + m * 16;
                f32x4 c0 = {1.f, 1.f, 1.f, 1.f}, c1 = c0, s0 = {0.f, 0.f, 0.f, 0.f}, s1 = s0;
                if (ropew) { const f32x4* rp = (const f32x4*)(rope + (size_t)row * 16); c0 = rp[0]; c1 = rp[1]; s0 = rp[2]; s1 = rp[3]; }
                bf16_t* rowp = P + (size_t)row * ldp + col0;
#pragma unroll
                for (int bj = 0; bj < 2; ++bj) {
                    f32x4 v0 = acc[ai][bj][m][0], v1 = acc[ai][bj][m][1];
                    if (ropew) {
                        f32x4 p0, p1;
#pragma unroll
                        for (int i = 0; i < 4; ++i) { p0[i] = __shfl_xor(v0[i], 16); p1[i] = __shfl_xor(v1[i], 16); }
                        if (fq < 2) { v0 = v0 * c0 + (p0 * s0) * sgn; v1 = v1 * c1 + (p1 * s1) * sgn; }
                    }
                    v0 = v0 * sc; v1 = v1 * sc;
                    u32x4 w; w.x = cvt_pk_bf16(v0[0], v0[1]); w.y = cvt_pk_bf16(v0[2], v0[3]); w.z = cvt_pk_bf16(v1[0], v1[1]); w.w = cvt_pk_bf16(v1[2], v1[3]);
                    *(u32x4*)(rowp + bj * HALF) = w;
                }
            }
    }
};

struct EpiResid {
    static constexpr bool PERM = true, AFTER_DRAIN = false;
    const float* base; bf16_t* out; int ldc;
    __device__ __forceinline__ void operator()(const f32x4 (&acc)[2][2][4][2], const Unit& u, int wr, int wc, int fr, int fq) const {
        const int row0 = u.pm * BM + wr * 64 + fr, col0 = u.pn * BM + wc * 32 + 8 * fq;
#pragma unroll
        for (int ai = 0; ai < 2; ++ai)
#pragma unroll
            for (int m = 0; m < 4; ++m) {
                const size_t off = (size_t)(row0 + ai * HALF + m * 16) * ldc + col0;
#pragma unroll
                for (int bj = 0; bj < 2; ++bj) { const f32x4 b0 = *(const f32x4*)(base + off + bj * HALF), b1 = *(const f32x4*)(base + off + bj * HALF + 4);
                    const f32x4 v0 = b0 + acc[ai][bj][m][0], v1 = b1 + acc[ai][bj][m][1];
                    u32x4 w; w.x = cvt_pk_bf16(v0[0], v0[1]); w.y = cvt_pk_bf16(v0[2], v0[3]); w.z = cvt_pk_bf16(v1[0], v1[1]); w.w = cvt_pk_bf16(v1[2], v1[3]);
                    *(u32x4*)(out + off + bj * HALF) = w; }
            }
    }
};

__device__ __forceinline__ float clamp8(float x) { return __builtin_fminf(__builtin_fmaxf(x, -448.f), 448.f); }
__device__ __forceinline__ unsigned cvt4_fp8(float a, float b, float c, float d) {
    int w = __builtin_amdgcn_cvt_pk_fp8_f32(clamp8(a), clamp8(b), 0, false); w = __builtin_amdgcn_cvt_pk_fp8_f32(clamp8(c), clamp8(d), w, true); return (unsigned)w; }
constexpr float W8_SCALE = 64.f, W8_DESCALE = 1.f / 64.f;

struct EpiSwiglu {
    static constexpr bool PERM = true, AFTER_DRAIN = false;
    unsigned char* H; int npn;
    __device__ __forceinline__ void operator()(const f32x4 (&acc)[2][2][4][2], const Unit& u, int wr, int wc, int fr, int fq) const {
        const int row0 = u.pm * BM + wr * 64 + fr, pnl = u.pn % npn, col0 = pnl * HALF + wc * 32 + 8 * fq;
#pragma unroll
        for (int ai = 0; ai < 2; ++ai)
#pragma unroll
            for (int m = 0; m < 4; ++m) {
                unsigned char* rowp = H + (size_t)(row0 + ai * HALF + m * 16) * 2048 + col0;
                float h[8];
#pragma unroll
                for (int n = 0; n < 2; ++n)
#pragma unroll
                    for (int i = 0; i < 4; ++i) { const float g = acc[ai][0][m][n][i] * W8_DESCALE, up = acc[ai][1][m][n][i] * W8_DESCALE; h[n * 4 + i] = g * up * __builtin_amdgcn_rcpf(1.f + __expf(-g)); }
                u32x2 w; w.x = cvt4_fp8(h[0], h[1], h[2], h[3]); w.y = cvt4_fp8(h[4], h[5], h[6], h[7]);
                *(u32x2*)rowp = w;
            }
    }
};

constexpr float YE_SCALE = 16.f, YE_DESCALE = 1.f / 16.f;
struct EpiDown {
    static constexpr bool PERM = true, AFTER_DRAIN = false;
    unsigned char* Y; const float* gate; int npn;
    __device__ __forceinline__ void operator()(const f32x4 (&acc)[2][2][4][2], const Unit& u, int wr, int wc, int fr, int fq) const {
        const int row0 = u.pm * BM + wr * 64 + fr, pnl = u.pn % npn, col0 = pnl * BM + wc * 32 + 8 * fq;
#pragma unroll
        for (int ai = 0; ai < 2; ++ai)
#pragma unroll
            for (int m = 0; m < 4; ++m) {
                const int row = row0 + ai * HALF + m * 16; const float gt = gate[row] * (W8_DESCALE * YE_SCALE);
                unsigned char* rowp = Y + (size_t)row * 2048 + col0;
#pragma unroll
                for (int bj = 0; bj < 2; ++bj) { const f32x4 v0 = acc[ai][bj][m][0] * gt, v1 = acc[ai][bj][m][1] * gt;
                    u32x2 w; w.x = cvt4_fp8(v0[0], v0[1], v0[2], v0[3]); w.y = cvt4_fp8(v1[0], v1[1], v1[2], v1[3]);
                    *(u32x2*)(rowp + bj * HALF) = w; }
            }
    }
};

template <class Epi, class Sched, bool ALIGN_EPI = false, bool SP2 = false, bool FP8 = false>
__device__ __forceinline__ void gemm_phase(PG8_LAS unsigned char* lds, const Gemm g, const Sched& S, const Epi& E) {
    const int tid = threadIdx.x, wid = __builtin_amdgcn_readfirstlane(tid >> 6), lane = tid & 63, wr = wid >> 2, wc = wid & 3, fr = lane & 15, fq = lane >> 4;
    const int K = g.Kp, nt = g.K / BK;
    const size_t kslice = (size_t)g.K * 2;
    unsigned voffA[2], voffB[2];
#pragma unroll
    for (int i = 0; i < 2; ++i) { int R, C; stage_rc(tid * 16 + i * 8192, R, C); const int Rb = Epi::PERM ? ((R & ~31) + perm32(R & 31)) : R;
        voffA[i] = (unsigned)(R * K + C) * 2u; voffB[i] = (unsigned)(Rb * K + C) * 2u; }
    static_assert(!Sched::GATHER || SP2, "gathered A rows: SP2 loop only");
    const size_t kstep = (size_t)(BK * 2);
    const size_t hstep = (size_t)HALF * K * 2;
    const size_t tstep = 2 * hstep;
    const unsigned ldsw = (unsigned)wid * 1024u;
    const int aoff = lds_byte(wr * 64 + fr, fq * 8), boff = lds_byte(wc * 32 + fr, fq * 8);
#define PG8_SA(b, h) (((b) * 2 + (h)) * HTB)
#define PG8_SB(b, h) ((4 + (b) * 2 + (h)) * HTB)
#define PG8_STAGE(bufoff, gbase, voff) do { _Pragma("unroll") for (int _i = 0; _i < 2; ++_i) \
        __builtin_amdgcn_global_load_lds((const unsigned*)((const char*)(gbase) + (voff)[_i]), (PG8_LAS unsigned*)(lds + (bufoff) + ldsw + _i * 8192), 16, 0, 0); } while (0)
#define PG8_LDA(dst, b, h) do { _Pragma("unroll") for (int m = 0; m < 4; ++m) _Pragma("unroll") for (int k = 0; k < 2; ++k) dst[m][k] = *(const PG8_LAS bf16x8*)(lds + PG8_SA(b, h) + aoff + m * 2048 + k * 1024); } while (0)
#define PG8_LDB(dst, b, h) do { _Pragma("unroll") for (int n = 0; n < 2; ++n) _Pragma("unroll") for (int k = 0; k < 2; ++k) dst[n][k] = *(const PG8_LAS bf16x8*)(lds + PG8_SB(b, h) + boff + n * 2048 + k * 1024); } while (0)
#define PG8_CAT8(x, y) __builtin_shufflevector(__builtin_bit_cast(i32x4, x), __builtin_bit_cast(i32x4, y), 0, 1, 2, 3, 4, 5, 6, 7)
#define PG8_W8(c) __builtin_shufflevector(c, c, 0, 1, 2, 3, -1, -1, -1, -1)
#define PG8_MMA(ai, bj, At, Bt) do { __builtin_amdgcn_s_setprio(1); \
        if constexpr (FP8) { f32x32 a_ = acc32[ai][bj]; _Pragma("unroll") for (int m = 0; m < 4; ++m) _Pragma("unroll") for (int n = 0; n < 2; ++n) { \
            f32x4 c_ = {a_[(m * 2 + n) * 4], a_[(m * 2 + n) * 4 + 1], a_[(m * 2 + n) * 4 + 2], a_[(m * 2 + n) * 4 + 3]}; \
            c_ = __builtin_amdgcn_mfma_scale_f32_16x16x128_f8f6f4(PG8_CAT8(Bt[n][0], Bt[n][1]), PG8_CAT8(At[m][0], At[m][1]), c_, 0, 0, 0, 0, 0, 0); \
            a_[(m * 2 + n) * 4] = c_[0]; a_[(m * 2 + n) * 4 + 1] = c_[1]; a_[(m * 2 + n) * 4 + 2] = c_[2]; a_[(m * 2 + n) * 4 + 3] = c_[3]; } acc32[ai][bj] = a_; } \
        else { _Pragma("unroll") for (int m = 0; m < 4; ++m) _Pragma("unroll") for (int n = 0; n < 2; ++n) _Pragma("unroll") for (int k = 0; k < 2; ++k) \
            acc[ai][bj][m][n] = __builtin_amdgcn_mfma_f32_16x16x32_bf16(Bt[n][k], At[m][k], acc[ai][bj][m][n], 0, 0, 0); } __builtin_amdgcn_s_setprio(0); } while (0)
#define PG8_WAIT_V(n) asm volatile("s_waitcnt vmcnt(" #n ")" ::: "memory")
#define PG8_WAIT_L(n) asm volatile("s_waitcnt lgkmcnt(" #n ")" ::: "memory")
#define PG8_BAR __builtin_amdgcn_s_barrier()
#define PG8_SCHED __builtin_amdgcn_sched_barrier(0)
    Unit cur, nxt; int ui = 0;
    if (!S.next(0, cur)) return;
    f32x4 acc[2][2][4][2]; f32x32 acc32[2][2];
#pragma unroll
    for (int a = 0; a < 2; ++a)
#pragma unroll
        for (int b = 0; b < 2; ++b)
#pragma unroll
            for (int m = 0; m < 4; ++m) {
#pragma unroll
                for (int n = 0; n < 2; ++n) { acc[a][b][m][n] = (f32x4){0.f, 0.f, 0.f, 0.f};
#pragma unroll
                    for (int i = 0; i < 4; ++i) acc32[a][b][(m * 2 + n) * 4 + i] = 0.f; } }
    bf16x8 At[4][2], B0[2][2], B1[2][2];
    const char* cA = (const char*)g.A + (size_t)cur.pm * tstep + (size_t)cur.pk * kslice; const char* cB = (const char*)g.Bt + (size_t)cur.pn * tstep + (size_t)cur.pk * kslice;
    unsigned cvA0[2], cvA1[2], nvA0[2], nvA1[2];
#pragma unroll
    for (int i = 0; i < 2; ++i) { int R, C; stage_rc(tid * 16 + i * 8192, R, C);
        if constexpr (Sched::GATHER) { cvA0[i] = (unsigned)(S.arow(cur, R) * K + C) * 2u; cvA1[i] = (unsigned)(S.arow(cur, HALF + R) * K + C) * 2u; }
        else { cvA0[i] = voffA[i]; cvA1[i] = voffA[i] + (unsigned)hstep; }
        nvA0[i] = cvA0[i]; nvA1[i] = cvA1[i]; }
    if constexpr (Sched::GATHER) cA = (const char*)g.A;
    S.a_ready(cur);
    if constexpr (SP2) {
        PG8_STAGE(PG8_SB(0, 0), cB, voffB); PG8_STAGE(PG8_SB(0, 1), cB + hstep, voffB); PG8_STAGE(PG8_SA(0, 0), cA, cvA0); PG8_STAGE(PG8_SA(0, 1), cA, cvA1);
        if (wr == 1) PG8_BAR;
        PG8_WAIT_V(2); PG8_BAR;
        PG8_STAGE(PG8_SB(1, 0), cB + kstep, voffB); PG8_STAGE(PG8_SA(1, 0), cA + kstep, cvA0); PG8_STAGE(PG8_SB(1, 1), cB + hstep + kstep, voffB);
        PG8_WAIT_V(6); PG8_BAR;
    } else {
        PG8_STAGE(PG8_SB(0, 0), cB, voffB); PG8_STAGE(PG8_SA(0, 0), cA, voffA); PG8_STAGE(PG8_SB(0, 1), cB + hstep, voffB); PG8_STAGE(PG8_SA(0, 1), cA + hstep, voffA);
        if (wr == 1) PG8_BAR;
        PG8_WAIT_V(4); PG8_BAR;
        PG8_STAGE(PG8_SB(1, 0), cB + kstep, voffB); PG8_STAGE(PG8_SA(1, 0), cA + kstep, voffA); PG8_STAGE(PG8_SB(1, 1), cB + hstep + kstep, voffB);
        PG8_WAIT_V(6); PG8_BAR;
    }
    for (;;) {
        const bool has_next = S.next(ui + 1, nxt);
        const char* nA = Sched::GATHER ? (const char*)g.A : (has_next ? (const char*)g.A + (size_t)nxt.pm * tstep + (size_t)nxt.pk * kslice : cA);
        if constexpr (Sched::GATHER) { if (has_next) {
#pragma unroll
            for (int i = 0; i < 2; ++i) { int R, C; stage_rc(tid * 16 + i * 8192, R, C); nvA0[i] = (unsigned)(S.arow(nxt, R) * K + C) * 2u; nvA1[i] = (unsigned)(S.arow(nxt, HALF + R) * K + C) * 2u; } } } const char* nB = has_next ? (const char*)g.Bt + (size_t)nxt.pn * tstep + (size_t)nxt.pk * kslice : cB;
        for (int t = 0; t < nt; t += 2) {
            const bool last = (t == nt - 2);
            const char* a1 = cA + (size_t)(t + 1) * kstep;
            const char* a2 = last ? nA : cA + (size_t)(t + 2) * kstep; const char* b2 = last ? nB : cB + (size_t)(t + 2) * kstep;
            const char* a3 = a2 + kstep; const char* b3 = b2 + kstep;
            if (last && has_next) S.a_ready(nxt);
            unsigned sA0[2], sA1[2];
#pragma unroll
            for (int i = 0; i < 2; ++i) { sA0[i] = last ? nvA0[i] : cvA0[i]; sA1[i] = last ? nvA1[i] : cvA1[i]; }
            if constexpr (SP2) {
            PG8_LDB(B0, 0, 0); PG8_LDB(B1, 0, 1); PG8_SCHED; PG8_LDA(At, 0, 0); PG8_STAGE(PG8_SA(1, 1), a1, cvA1);
            PG8_WAIT_V(8); PG8_WAIT_L(0); PG8_BAR; PG8_MMA(0, 0, At, B0); PG8_MMA(0, 1, At, B1); PG8_BAR; PG8_SCHED;
            PG8_LDA(At, 0, 1); PG8_STAGE(PG8_SB(0, 0), b2, voffB); PG8_STAGE(PG8_SB(0, 1), b2 + hstep, voffB); PG8_STAGE(PG8_SA(0, 0), a2, sA0);
            PG8_WAIT_V(8); PG8_WAIT_L(0); PG8_BAR; PG8_MMA(1, 0, At, B0); PG8_MMA(1, 1, At, B1); PG8_BAR; PG8_SCHED;
            PG8_LDB(B0, 1, 0); PG8_LDB(B1, 1, 1); PG8_SCHED; PG8_LDA(At, 1, 0); PG8_STAGE(PG8_SA(0, 1), a2, sA1);
            PG8_WAIT_V(8); PG8_WAIT_L(0); PG8_BAR; PG8_MMA(0, 0, At, B0); PG8_MMA(0, 1, At, B1); PG8_BAR; PG8_SCHED;
            PG8_LDA(At, 1, 1); PG8_STAGE(PG8_SB(1, 0), b3, voffB); PG8_STAGE(PG8_SB(1, 1), b3 + hstep, voffB); PG8_STAGE(PG8_SA(1, 0), a3, sA0);
            PG8_WAIT_V(8); PG8_WAIT_L(0); PG8_BAR; PG8_MMA(1, 0, At, B0); PG8_MMA(1, 1, At, B1); PG8_BAR; PG8_SCHED;
            } else {
            PG8_LDB(B0, 0, 0); PG8_SCHED; PG8_LDA(At, 0, 0); PG8_STAGE(PG8_SA(1, 1), a1 + hstep, voffA);
            PG8_WAIT_L(8); PG8_BAR; PG8_WAIT_L(0); PG8_MMA(0, 0, At, B0); PG8_BAR; PG8_SCHED;
            PG8_LDB(B1, 0, 1); PG8_STAGE(PG8_SB(0, 0), b2, voffB);
            PG8_BAR; PG8_WAIT_L(0); PG8_MMA(0, 1, At, B1); PG8_BAR;
            PG8_LDA(At, 0, 1); PG8_STAGE(PG8_SA(0, 0), a2, voffA);
            PG8_BAR; PG8_WAIT_L(0); PG8_MMA(1, 0, At, B0); PG8_BAR; PG8_SCHED;
            PG8_STAGE(PG8_SB(0, 1), b2 + hstep, voffB);
            PG8_WAIT_V(6); PG8_BAR; PG8_MMA(1, 1, At, B1); PG8_BAR;
            PG8_LDB(B0, 1, 0); PG8_SCHED; PG8_LDA(At, 1, 0); PG8_STAGE(PG8_SA(0, 1), a2 + hstep, voffA);
            PG8_WAIT_L(8); PG8_BAR; PG8_WAIT_L(0); PG8_MMA(0, 0, At, B0); PG8_BAR; PG8_SCHED;
            PG8_LDB(B1, 1, 1); PG8_STAGE(PG8_SB(1, 0), b3, voffB);
            PG8_BAR; PG8_WAIT_L(0); PG8_MMA(0, 1, At, B1); PG8_BAR;
            PG8_LDA(At, 1, 1); PG8_STAGE(PG8_SA(1, 0), a3, voffA);
            PG8_BAR; PG8_WAIT_L(0); PG8_MMA(1, 0, At, B0); PG8_BAR; PG8_SCHED;
            PG8_STAGE(PG8_SB(1, 1), b3 + hstep, voffB);
            PG8_WAIT_V(6); PG8_BAR; PG8_MMA(1, 1, At, B1); PG8_BAR;
            }
        }
        if constexpr (ALIGN_EPI) { if (wr == 0) PG8_BAR; }
        if constexpr (FP8) {
#pragma unroll
            for (int a = 0; a < 2; ++a)
#pragma unroll
                for (int b = 0; b < 2; ++b)
#pragma unroll
                    for (int m = 0; m < 4; ++m)
#pragma unroll
                        for (int n = 0; n < 2; ++n)
#pragma unroll
                            for (int i = 0; i < 4; ++i) acc[a][b][m][n][i] = acc32[a][b][(m * 2 + n) * 4 + i]; }
        if constexpr (!Epi::AFTER_DRAIN) { E(acc, cur, wr, wc, fr, fq); S.done(cur); }
        if (!has_next) break;
#pragma unroll
        for (int a = 0; a < 2; ++a)
#pragma unroll
            for (int b = 0; b < 2; ++b)
#pragma unroll
                for (int m = 0; m < 4; ++m) {
#pragma unroll
                    for (int n = 0; n < 2; ++n) { acc[a][b][m][n] = (f32x4){0.f, 0.f, 0.f, 0.f};
#pragma unroll
                        for (int i = 0; i < 4; ++i) acc32[a][b][(m * 2 + n) * 4 + i] = 0.f; } }
        cur = nxt; cA = nA; cB = nB; ++ui;
#pragma unroll
        for (int i = 0; i < 2; ++i) { cvA0[i] = nvA0[i]; cvA1[i] = nvA1[i]; }
        if constexpr (ALIGN_EPI) { if (wr == 1) PG8_BAR; }
    }
    PG8_WAIT_V(0);
    if constexpr (!ALIGN_EPI) { if (wr == 0) PG8_BAR; }
    PG8_BAR;
    if constexpr (Epi::AFTER_DRAIN) { E.fused(acc, cur, wr, wc, fr, fq, lds, wid, lane); S.done(cur); }
#undef PG8_SA
#undef PG8_SB
#undef PG8_STAGE
#undef PG8_LDA
#undef PG8_LDB
#undef PG8_MMA
#undef PG8_CAT8
#undef PG8_W8
#undef PG8_WAIT_V
#undef PG8_WAIT_L
#undef PG8_BAR
#undef PG8_SCHED
}
}

namespace att {
constexpr int NW = 8, QBLK = 32, KVBLK = 64;
constexpr float THR = 8.f;
constexpr int SHM_V = KVBLK * 128 * 2, SHM_K = KVBLK * 64 * 2;
constexpr int SHM_ATTN = 2 * SHM_V + 2 * SHM_K + NW * 64 * 4;
#define KSWZ64(row, colB) ((row) * 128 + ((colB) ^ ((((row) >> 1) & 7) << 4)))
#define SBAR() __builtin_amdgcn_sched_barrier(0)
__device__ __forceinline__ int crow(int r, int hi) { return (r & 3) + 8 * (r >> 2) + 4 * hi; }

__device__ __forceinline__ void partialSM(f32x16& p0, f32x16& p1, float& m_reg, float& mn, float& alpha) {
  float pmax = p0[0];
#pragma unroll
  for (int r = 1; r < 16; ++r) pmax = fmaxf(pmax, p0[r]);
#pragma unroll
  for (int r = 0; r < 16; ++r) pmax = fmaxf(pmax, p1[r]);
  { auto rr = __builtin_amdgcn_permlane32_swap(__float_as_uint(pmax), __float_as_uint(pmax), false, false);
    pmax = fmaxf(__uint_as_float(rr[0]), __uint_as_float(rr[1])); }
  if (__builtin_expect(__all(pmax - m_reg <= THR), 1)) { mn = m_reg; alpha = 1.f; }
  else { mn = fmaxf(m_reg, pmax); alpha = __builtin_amdgcn_exp2f(m_reg - mn); m_reg = mn; }
#pragma unroll
  for (int r = 0; r < 16; ++r) p0[r] = p0[r] - mn;
#pragma unroll
  for (int r = 0; r < 16; ++r) p1[r] = p1[r] - mn;
#pragma unroll
  for (int r = 0; r < 16; ++r) p0[r] = __builtin_amdgcn_exp2f(p0[r]);
}
__device__ __forceinline__ void finishSM(f32x16& p0, f32x16& p1, float alpha, float& l_reg, bf16x8& pa0, bf16x8& pa1, bf16x8& pa2, bf16x8& pa3) {
#pragma unroll
  for (int r = 0; r < 16; ++r) p1[r] = __builtin_amdgcn_exp2f(p1[r]);
  float ps = 0;
#pragma unroll
  for (int r = 0; r < 16; ++r) ps += p0[r];
#pragma unroll
  for (int r = 0; r < 16; ++r) ps += p1[r];
  { auto rr = __builtin_amdgcn_permlane32_swap(__float_as_uint(ps), __float_as_uint(ps), false, false);
    ps = __uint_as_float(rr[0]) + __uint_as_float(rr[1]); }
  l_reg = l_reg * alpha + ps;
#define PK4(P, BASE, OUT) do { unsigned a0 = cvtpk(P[BASE + 0], P[BASE + 1]), a1 = cvtpk(P[BASE + 2], P[BASE + 3]);   \
    unsigned b0 = cvtpk(P[BASE + 4], P[BASE + 5]), b1 = cvtpk(P[BASE + 6], P[BASE + 7]);                              \
    auto r0 = __builtin_amdgcn_permlane32_swap(a0, b0, false, false); auto r1 = __builtin_amdgcn_permlane32_swap(a1, b1, false, false); \
    u32x4 w = {r0[0], r1[0], r0[1], r1[1]}; OUT = __builtin_bit_cast(bf16x8, w); } while (0)
  PK4(p0, 0, pa0); PK4(p0, 8, pa1); PK4(p1, 0, pa2); PK4(p1, 8, pa3);
#undef PK4
}
__device__ __forceinline__ void qkt(f32x16& p0, f32x16& p1, const char* Ks, const bf16x8* qr, int r32, int hi) {
  p0 = f32x16{}; p1 = f32x16{};
#pragma unroll
  for (int d0 = 0; d0 < 4; ++d0) { const int cb = (d0 * 16 + hi * 8) * 2;
    bf16x8 b0 = *reinterpret_cast<const bf16x8*>(Ks + KSWZ64(r32, cb));
    bf16x8 b1 = *reinterpret_cast<const bf16x8*>(Ks + KSWZ64(32 + r32, cb));
    p0 = __builtin_amdgcn_mfma_f32_32x32x16_bf16(b0, qr[d0], p0, 0, 0, 0);
    p1 = __builtin_amdgcn_mfma_f32_32x32x16_bf16(b1, qr[d0], p1, 0, 0, 0); }
}
__device__ __forceinline__ int v_st(int k, int c) { const int kk = (k & ~0xC) | ((k & 4) << 1) | ((k & 8) >> 1); return ((kk >> 3) * 4 + (c >> 5)) * 512 + ((kk & 7) * 32 + (c & 31)) * 2; }
__device__ __forceinline__ int v_rd_base(int lane) { return ((lane & 3) << 3) | (((lane >> 2) & 3) << 6) | (((lane >> 4) & 1) << 5) | (((lane >> 5) & 1) << 8); }
constexpr int v_rd_off(int d0, int ks, int half) { return d0 * 512 + ks * 4096 + half * 2048; }
template <int OFF> __device__ __forceinline__ s16x4 tr_read(int vb) {
  s16x4 r; asm volatile("ds_read_b64_tr_b16 %0, %1 offset:%2" : "=&v"(r) : "v"(vb), "i"(OFF) : "memory"); return r;
}
template <int D0> __device__ __forceinline__ void pv_one(f32x16& od, int vb, bf16x8 pa0, bf16x8 pa1, bf16x8 pa2, bf16x8 pa3) {
  const s16x4 l0 = tr_read<v_rd_off(D0, 0, 0)>(vb), h0 = tr_read<v_rd_off(D0, 0, 1)>(vb), l1 = tr_read<v_rd_off(D0, 1, 0)>(vb), h1 = tr_read<v_rd_off(D0, 1, 1)>(vb);
  const s16x4 l2 = tr_read<v_rd_off(D0, 2, 0)>(vb), h2 = tr_read<v_rd_off(D0, 2, 1)>(vb), l3 = tr_read<v_rd_off(D0, 3, 0)>(vb), h3 = tr_read<v_rd_off(D0, 3, 1)>(vb);
  asm volatile("s_waitcnt lgkmcnt(0)" ::: "memory"); SBAR();
#define PK(L, H) (bf16x8){L[0], L[1], L[2], L[3], H[0], H[1], H[2], H[3]}
  od = __builtin_amdgcn_mfma_f32_32x32x16_bf16(pa0, PK(l0, h0), od, 0, 0, 0);
  od = __builtin_amdgcn_mfma_f32_32x32x16_bf16(pa1, PK(l1, h1), od, 0, 0, 0);
  od = __builtin_amdgcn_mfma_f32_32x32x16_bf16(pa2, PK(l2, h2), od, 0, 0, 0);
  od = __builtin_amdgcn_mfma_f32_32x32x16_bf16(pa3, PK(l3, h3), od, 0, 0, 0);
#undef PK
}
__device__ __forceinline__ void pv_d0(f32x16* o, int vb, bf16x8 pa0, bf16x8 pa1, bf16x8 pa2, bf16x8 pa3) {
  pv_one<0>(o[0], vb, pa0, pa1, pa2, pa3); pv_one<1>(o[1], vb, pa0, pa1, pa2, pa3); pv_one<2>(o[2], vb, pa0, pa1, pa2, pa3); pv_one<3>(o[3], vb, pa0, pa1, pa2, pa3);
}

template <int LDQ>
__device__ __forceinline__ void attn_unit(const bf16_t* __restrict__ Qb, const bf16_t* __restrict__ Kh, const bf16_t* __restrict__ Vh, bf16_t* __restrict__ Ob, int seq, char* lds) {
  const int tid = threadIdx.x, wid = tid >> 6, lane = tid & 63, r32 = lane & 31, hi = lane >> 5;
  char* V_lds = lds; char* K_lds = lds + 2 * SHM_V;
  float* ws = (float*)(lds + 2 * SHM_V + 2 * SHM_K) + wid * 64; float* li_l = ws; float* al_l = ws + 32;
  float m_reg = -1e30f, l_reg = 0; f32x16 o[4] = {}; bf16x8 qr[4];
  const bf16_t* Qw = Qb + (long)(wid * QBLK + r32) * LDQ + hi * 8;
#pragma unroll
  for (int d0 = 0; d0 < 4; ++d0) qr[d0] = *reinterpret_cast<const bf16x8*>(Qw + d0 * 16);
  const int sr = tid >> 4, sc = (tid & 15) * 8, vst0 = v_st(sr, sc), vst1 = v_st(32 + sr, sc);
  const int kr = tid >> 3, kc8 = (tid & 7) * 8, kst = KSWZ64(kr, kc8 * 2);
  const int vb0 = (int)(uintptr_t)V_lds + v_rd_base(lane);
  struct { bf16x8 vs0, vs1, ks; } sr_[2];
  const bf16_t* Vp0 = Vh + (long)sr * LDQ + sc; const bf16_t* Kp0 = Kh + (long)kr * LDQ + kc8;
#define SLOAD(i, k0) do { const long ko_ = (long)(k0) * LDQ; sr_[i].vs0 = *reinterpret_cast<const bf16x8*>(Vp0 + ko_); sr_[i].vs1 = *reinterpret_cast<const bf16x8*>(Vp0 + ko_ + 32 * LDQ); \
    sr_[i].ks = *reinterpret_cast<const bf16x8*>(Kp0 + ko_); } while (0)
#define SWRITE(b, i) do { *(bf16x8*)(V_lds + (b) * SHM_V + vst0) = sr_[i].vs0; *(bf16x8*)(V_lds + (b) * SHM_V + vst1) = sr_[i].vs1; \
    *(bf16x8*)(K_lds + (b) * SHM_K + kst) = sr_[i].ks; } while (0)
#define SWAIT() asm volatile("s_waitcnt vmcnt(3)" ::: "memory")
#define RESC(a) do { if (__any((a) < 1.f)) { if (hi == 0) al_l[r32] = (a); asm volatile("s_waitcnt lgkmcnt(0)" ::: "memory"); \
    _Pragma("unroll") for (int d = 0; d < 4; ++d) _Pragma("unroll") for (int r = 0; r < 16; ++r) o[d][r] *= al_l[crow(r, hi)]; } } while (0)
  f32x16 pA0, pA1, pB0, pB1; float mnA, mnB, alA, alB; bf16x8 pa0, pa1, pa2, pa3; const int NT = seq / KVBLK;
  constexpr int SE = 0, SO = 1;
  SLOAD(SE, 0); asm volatile("s_waitcnt vmcnt(0)" ::: "memory"); SWRITE(0, SE); __syncthreads();
  qkt(pA0, pA1, K_lds, qr, r32, hi); partialSM(pA0, pA1, m_reg, mnA, alA);
  SLOAD(SO, KVBLK); if (2 < NT) SLOAD(SE, 2 * KVBLK);
  SWAIT(); SWRITE(1, SO); __syncthreads();
  for (int j = 1; j + 1 < NT; j += 2) {
    SBAR(); qkt(pB0, pB1, K_lds + SHM_K, qr, r32, hi);
    finishSM(pA0, pA1, alA, l_reg, pa0, pa1, pa2, pa3); SBAR();
    SLOAD(SO, (j + 2) * KVBLK); SBAR();
    pv_d0(o, vb0, pa0, pa1, pa2, pa3); partialSM(pB0, pB1, m_reg, mnB, alB);
    __syncthreads(); SWAIT(); SWRITE(0, SE);
    RESC(alB); __syncthreads();
    SBAR(); qkt(pA0, pA1, K_lds, qr, r32, hi);
    finishSM(pB0, pB1, alB, l_reg, pa0, pa1, pa2, pa3); SBAR();
    if (j + 3 < NT) SLOAD(SE, (j + 3) * KVBLK); SBAR();
    pv_d0(o, vb0 + SHM_V, pa0, pa1, pa2, pa3); partialSM(pA0, pA1, m_reg, mnA, alA);
    __syncthreads(); SWAIT(); SWRITE(1, SO);
    RESC(alA); __syncthreads();
  }
  SBAR(); qkt(pB0, pB1, K_lds + SHM_K, qr, r32, hi);
  finishSM(pA0, pA1, alA, l_reg, pa0, pa1, pa2, pa3); SBAR();
  pv_d0(o, vb0, pa0, pa1, pa2, pa3); partialSM(pB0, pB1, m_reg, mnB, alB);
  __syncthreads(); RESC(alB);
  finishSM(pB0, pB1, alB, l_reg, pa0, pa1, pa2, pa3); SBAR();
  pv_d0(o, vb0 + SHM_V, pa0, pa1, pa2, pa3);
  if (hi == 0) li_l[r32] = l_reg; asm volatile("s_waitcnt lgkmcnt(0)" ::: "memory");
  float rli[16];
#pragma unroll
  for (int r = 0; r < 16; ++r) rli[r] = __builtin_amdgcn_rcpf(li_l[crow(r, hi)]);
  bf16_t* Ow = Ob + (long)(wid * QBLK) * 1024;
#pragma unroll
  for (int r = 0; r < 16; ++r) { const int orow = crow(r, hi);
#pragma unroll
    for (int d0 = 0; d0 < 4; ++d0) Ow[(long)orow * 1024 + d0 * 32 + r32] = (bf16_t)(cvtpk(o[d0][r] * rli[r], 0.f) & 0xffffu); }
  __syncthreads();
#undef SLOAD
#undef SWRITE
#undef SWAIT
#undef RESC
}
#undef SBAR
}


typedef GAS unsigned gu32;
#define RLX_AGENT __ATOMIC_RELAXED, __HIP_MEMORY_SCOPE_AGENT
#define XB_TMO      128
#define XB_XCNT(j)  (256  + 64 * (j))
#define XB_XSUB(j)  (1280 + 64 * (j))
#define XB_XGEN(j)  (2304 + 64 * (j))
#define XB_TOP      3328
#define XB_TOPGEN   3392
#define XCD_BAR_WORDS 3456
#define XB_SPIN_CAP (1u << 22)
__device__ __forceinline__ unsigned xb_ld(unsigned* p)              { return __hip_atomic_load(p, __ATOMIC_RELAXED, __HIP_MEMORY_SCOPE_AGENT); }
__device__ __forceinline__ unsigned xb_add(unsigned* p, unsigned v) { return __hip_atomic_fetch_add(p, v, __ATOMIC_RELAXED, __HIP_MEMORY_SCOPE_AGENT); }
__device__ __forceinline__ unsigned xb_xcc_id() { return (unsigned)__builtin_amdgcn_s_getreg((3 << 11) | 20) & 0xFu; }
#define XB_SPIN(cond, bar) do { unsigned _sp = 0; while (cond) { __builtin_amdgcn_s_sleep(1); \
    if ((++_sp & 255u) == 0u) { if (xb_ld(&(bar)[XB_TMO])) break; if (_sp > XB_SPIN_CAP) { atomicAdd(&(bar)[XB_TMO], 1u); break; } } } } while (0)
struct XcdBarrier { unsigned* bar; unsigned x; volatile LAS unsigned* st; };
__device__ __forceinline__ XcdBarrier xcd_barrier_post(unsigned* bar, volatile LAS unsigned* st) {
    XcdBarrier b; b.bar = bar; b.x = xb_xcc_id(); b.st = st;
    if (threadIdx.x == 0) (void)xb_add(&bar[XB_XCNT(b.x)], 1u);
    return b;
}
__device__ __forceinline__ void xcd_barrier_complete(unsigned* bar, unsigned x, unsigned& nloc, unsigned& nx) {
    const unsigned G = gridDim.x * gridDim.y * gridDim.z;
    unsigned sum, cnt, mine, sp = 0u;
    for (;;) {
        sum = 0u; cnt = 0u; mine = 0u;
#pragma unroll
        for (unsigned j = 0; j < 16; ++j) { const unsigned c = xb_ld(&bar[XB_XCNT(j)]); sum += c; cnt += (c > 0u) ? 1u : 0u; mine = (j == x) ? c : mine; }
        if (sum == G) break;
        __builtin_amdgcn_s_sleep(1);
        if ((++sp & 255u) == 0u) { if (xb_ld(&bar[XB_TMO])) break; if (sp > XB_SPIN_CAP) { atomicAdd(&bar[XB_TMO], 1u); break; } }
    }
    nloc = mine > 0u ? mine : 1u; nx = cnt > 0u ? cnt : 1u;
}
__device__ __forceinline__ void xcd_barrier(const XcdBarrier& b) {
    asm volatile("s_waitcnt vmcnt(0)" ::: "memory");
    __syncthreads();
    if (threadIdx.x == 0) {
        unsigned* bar = b.bar;
        __builtin_amdgcn_s_waitcnt(0);
        unsigned nloc = b.st[0], nx = b.st[1];
        if (nloc == 0u) { xcd_barrier_complete(bar, b.x, nloc, nx); b.st[0] = nloc; b.st[1] = nx; }
        const unsigned old = xb_add(&bar[XB_XSUB(b.x)], 1u);
        const unsigned gen = old / nloc;
        if (old + 1u == (gen + 1u) * nloc) {
            __builtin_amdgcn_fence(__ATOMIC_RELEASE, "agent");
            asm volatile("s_waitcnt vmcnt(0)" ::: "memory");
            const unsigned og = xb_add(&bar[XB_TOP], 1u);
            const unsigned tg = og / nx;
            if (og + 1u == (tg + 1u) * nx) xb_add(&bar[XB_TOPGEN], 1u);
            else XB_SPIN(xb_ld(&bar[XB_TOPGEN]) == tg, bar);
            __builtin_amdgcn_fence(__ATOMIC_ACQUIRE, "agent");
            xb_add(&bar[XB_XGEN(b.x)], 1u);
            asm volatile("s_waitcnt vmcnt(0)" ::: "memory");
        } else {
            XB_SPIN(xb_ld(&bar[XB_XGEN(b.x)]) == gen, bar);
            __builtin_amdgcn_fence(__ATOMIC_ACQUIRE, "agent");
            asm volatile("s_waitcnt vmcnt(0)" ::: "memory");
        }
    }
    __syncthreads();
}

struct Frame {
    LAS unsigned char* lds; char* ldsg;
    int tid, lane, wave, vcu, G;
    const Args* a;
};
#define INP(F, i, T) ((const T*)(F).a->in[i])
#define WSP(F, off, T) ((T*)((F).a->ws + (off)))

__device__ __forceinline__ void cvt_load(f32x4 (&v)[16], const float* __restrict__ W, int N, int nvalid, int k0, int n0, int lane) {
    const int kq = lane >> 4, nq = lane & 15;
    const unsigned voff = (unsigned)(kq * N + 4 * nq) * 4u;
#pragma unroll
    for (int i = 0; i < 16; ++i) {
        const char* Wu = (const char*)(W + (size_t)(k0 + 4 * i) * N + n0);
        if (4 * nq < nvalid) v[i] = __builtin_nontemporal_load((const f32x4*)(Wu + (size_t)voff)); else v[i] = (f32x4){0.f, 0.f, 0.f, 0.f};
    }
}
__device__ __forceinline__ void cvt_finish(const f32x4 (&v)[16], int k0, bf16_t* __restrict__ WT, int rowb, LAS unsigned char* scr, int lane) {
    const int kq = lane >> 4, nq = lane & 15;
    const int g = lane >> 4, i16 = lane & 15, q = i16 >> 2, p = i16 & 3;
    typedef short v4i16_t __attribute__((ext_vector_type(4)));
#pragma unroll
    for (int hf = 0; hf < 2; ++hf) {
#pragma unroll
        for (int i = 0; i < 8; ++i) {
            const int k = 4 * i + kq, s = ((k >> 1) & 1) | (((k >> 3) & 1) << 1);
            u32x2 w; w.x = cvtpk(v[8 * hf + i].x, v[8 * hf + i].y); w.y = cvtpk(v[8 * hf + i].z, v[8 * hf + i].w);
            *(LAS u32x2*)(scr + k * 128 + ((nq * 8) ^ (s << 5))) = w;
        }
        const int klo = 8 * g + q, s = ((klo >> 1) & 1) | (((klo >> 3) & 1) << 1);
#pragma unroll
        for (int nb = 0; nb < 4; ++nb) {
            const int a_lo = klo * 128 + (((16 * nb + 4 * p) * 2) ^ (s << 5));
            const s16x4 lo = __builtin_bit_cast(s16x4, __builtin_amdgcn_ds_read_tr16_b64_v4i16((LAS v4i16_t*)(scr + a_lo)));
            const s16x4 hi = __builtin_bit_cast(s16x4, __builtin_amdgcn_ds_read_tr16_b64_v4i16((LAS v4i16_t*)(scr + a_lo + 512)));
            bf16x8 o = {lo[0], lo[1], lo[2], lo[3], hi[0], hi[1], hi[2], hi[3]};
            char* Wu = (char*)(WT + (size_t)(rowb + 16 * nb) * 2048 + k0 + 32 * hf);
            __builtin_nontemporal_store(o, (bf16x8*)(Wu + (size_t)(unsigned)((i16 * 2048 + 8 * g) * 2)));
        }
    }
}
__device__ __forceinline__ void cvt8_load(f32x4 (&v)[16], const float* __restrict__ W, int k0, int n0, int lane) {
    const int kq = lane >> 4, nq = lane & 15;
    const unsigned voff = (unsigned)(16 * kq * 2048 + 4 * nq) * 4u;
#pragma unroll
    for (int i = 0; i < 16; ++i) {
        const char* Wu = (const char*)(W + (size_t)(k0 + i) * 2048 + n0);
        v[i] = __builtin_nontemporal_load((const f32x4*)(Wu + (size_t)voff));
    }
}
__device__ __forceinline__ void cvt8_finish(const f32x4 (&v)[16], int k0, unsigned char* __restrict__ W8, int rowb, int lane) {
    const int kq = lane >> 4, nq = lane & 15;
    char* Wu = (char*)(W8 + (size_t)rowb * 2048 + k0);
    const unsigned voff = (unsigned)(4 * nq * 2048 + 16 * kq);
#pragma unroll
    for (int j = 0; j < 4; ++j) {
        u32x4 o;
#pragma unroll
        for (int q = 0; q < 4; ++q) {
            int w = __builtin_amdgcn_cvt_pk_fp8_f32(v[4 * q][j] * pg8::W8_SCALE, v[4 * q + 1][j] * pg8::W8_SCALE, 0, false);
            w = __builtin_amdgcn_cvt_pk_fp8_f32(v[4 * q + 2][j] * pg8::W8_SCALE, v[4 * q + 3][j] * pg8::W8_SCALE, w, true);
            o[q] = (unsigned)w;
        }
        __builtin_nontemporal_store(o, (u32x4*)(Wu + (size_t)(voff + (unsigned)(j * 2048))));
    }
}
__device__ __forceinline__ void cvt_expert_decode(const Frame& F, int r, const float*& W, int& k0, int& n0, unsigned char*& WT, int& rowb) {
    constexpr int I_E = 16 * 32 * 32;
    const int mat = r / I_E; r -= mat * I_E;
    const int e = r >> 10, kt = (r >> 5) & 31, nt = r & 31;
    k0 = kt * 64; n0 = nt * 64;
    if (mat < 2) { W = INP(F, 24 + mat, float) + (size_t)e * 2048 * 2048; WT = WSP(F, WS_WGU, unsigned char); rowb = e * 4096 + (n0 >> 7) * 256 + mat * 128 + (n0 & 127); }
    else { W = INP(F, 26, float) + (size_t)e * 2048 * 2048; WT = WSP(F, WS_WD, unsigned char); rowb = e * 2048 + n0; }
}
constexpr int N_EXPERT_ITEMS = 3 * 16 * 32 * 32;
__device__ __forceinline__ void p0_prologue(Frame& F) {
    LAS unsigned char* scr = F.lds + F.wave * 4096;
    const int gw = F.vcu * 8 + F.wave, NGW = F.G * 8, lane = F.lane;
    const float* w_in = INP(F, 3, float); const float* w_out = INP(F, 21, float);
    bf16_t* WinT = WSP(F, WS_WIN, bf16_t); bf16_t* WoutT = WSP(F, WS_WOUT, bf16_t);
    constexpr int I_IN = 32 * 101, I_OUT = 32 * 32, NITEMS = I_IN + I_OUT;
#define P0_TILE_LOAD(V_, it_) do { if ((it_) < I_IN) { const int kt_ = (it_) / 101, nt_ = (it_) % 101; cvt_load(V_, w_in, IN_COLS, (nt_ == 100) ? 32 : 64, kt_ * 64, nt_ * 64, lane); } \
        else { const int r_ = (it_) - I_IN; cvt_load(V_, w_out, 2048, 64, (r_ >> 5) * 64, (r_ & 31) * 64, lane); } } while (0)
#define P0_TILE_FIN(V_, it_) do { if ((it_) < I_IN) { const int kt_ = (it_) / 101, nt_ = (it_) % 101; cvt_finish(V_, kt_ * 64, WinT, nt_ * 64, scr, lane); } \
        else { const int r_ = (it_) - I_IN; cvt_finish(V_, (r_ >> 5) * 64, WoutT, (r_ & 31) * 64, scr, lane); } } while (0)
    for (int it = gw; it < NITEMS; it += 2 * NGW) {
        const int it2 = it + NGW; const bool has2 = it2 < NITEMS;
        f32x4 va[16], vb[16];
        P0_TILE_LOAD(va, it); if (has2) P0_TILE_LOAD(vb, it2);
        P0_TILE_FIN(va, it); if (has2) P0_TILE_FIN(vb, it2);
    }
#undef P0_TILE_LOAD
#undef P0_TILE_FIN
#if !CVT_IN_SCAN
    for (int it = gw; it < N_EXPERT_ITEMS; it += NGW) {
        f32x4 v[16]; const float* W; int k0, n0, rowb; unsigned char* WT;
        cvt_expert_decode(F, it, W, k0, n0, WT, rowb); cvt8_load(v, W, k0, n0, lane); cvt8_finish(v, k0, WT, rowb, lane);
    }
#endif
    { u32x4 z = {0u, 0u, 0u, 0u}; u32x4* zp = (u32x4*)(WinT + (size_t)6464 * 2048); const int nz = 192 * 2048 * 2 / 16;
      for (int i = gw * 64 + lane; i < nz; i += NGW * 64) zp[i] = z; }
    { const float* x = INP(F, 0, float); const float* nw = INP(F, 2, float); bf16_t* H1 = WSP(F, WS_H1, bf16_t);
      for (int m = gw; m < MTOK; m += 2 * NGW) {
          const int m2 = (m + NGW < MTOK) ? m + NGW : m;
          const f32x4* xr = (const f32x4*)(x + (size_t)m * DM) + lane; const f32x4* xs = (const f32x4*)(x + (size_t)m2 * DM) + lane; f32x4 v[8], u[8]; float s = 0.f, s2 = 0.f;
#pragma unroll
          for (int j = 0; j < 8; ++j) { v[j] = xr[64 * j]; u[j] = xs[64 * j]; }
#pragma unroll
          for (int j = 0; j < 8; ++j) { s += (v[j].x * v[j].x + v[j].y * v[j].y) + (v[j].z * v[j].z + v[j].w * v[j].w); s2 += (u[j].x * u[j].x + u[j].y * u[j].y) + (u[j].z * u[j].z + u[j].w * u[j].w); }
          const float rstd = 1.f / sqrtf(wave_sum(s) * (1.f / DM) + 1e-6f), rstd2 = 1.f / sqrtf(wave_sum(s2) * (1.f / DM) + 1e-6f);
          u32x2* o8 = (u32x2*)(H1 + (size_t)m * DM) + lane; u32x2* p8 = (u32x2*)(H1 + (size_t)m2 * DM) + lane;
#pragma unroll
          for (int j = 0; j < 8; ++j) { const f32x4 w = ((const f32x4*)nw)[lane + 64 * j];
              u32x2 o; o.x = cvtpk(v[j].x * rstd * w.x, v[j].y * rstd * w.y); o.y = cvtpk(v[j].z * rstd * w.z, v[j].w * rstd * w.w); o8[64 * j] = o;
              u32x2 q; q.x = cvtpk(u[j].x * rstd2 * w.x, u[j].y * rstd2 * w.y); q.y = cvtpk(u[j].z * rstd2 * w.z, u[j].w * rstd2 * w.w); p8[64 * j] = q; }
      } }
    { const float* dup = INP(F, 12, float); const float* iup = INP(F, 14, float); const float* gup = INP(F, 15, float);
      bf16_t* DUt = WSP(F, WS_LORA, bf16_t); bf16_t* IUt = DUt + 2 * 1024 * 64; bf16_t* GUt = IUt + 2 * 1024 * 64;
      for (int i = gw * 64 + lane; i < 2 * 1024 * 64; i += NGW * 64) { const int j = i & 63, c = (i >> 6) & 1023, d = i >> 16;
          DUt[i] = (bf16_t)(cvtpk(dup[(size_t)(d * 64 + j) * 1024 + c], 0.f) & 0xffffu); IUt[i] = (bf16_t)(cvtpk(iup[(size_t)(d * 64 + j) * 1024 + c], 0.f) & 0xffffu); }
      for (int i = gw * 64 + lane; i < 1024 * 160; i += NGW * 64) { const int c = i / 160, j = i - c * 160; GUt[i] = (bf16_t)(cvtpk(gup[(size_t)j * 1024 + c], 0.f) & 0xffffu); } }
    { const int* pos = INP(F, 1, int); float* rope = WSP(F, WS_ROPE, float);
      const float invf[8] = {1.0f, 0.19392274474868576f, 0.03760603093086393f, 0.007292664737217109f, 0.001414213562373095f, 0.0002742481756762073f, 5.318295896944988e-05f, 1.031338537721246e-05f};
      for (int i = gw * 64 + lane; i < MTOK * 8; i += NGW * 64) { const int m = i >> 3, j = i & 7; float fj = invf[0];
#pragma unroll
          for (int q = 1; q < 8; ++q) fj = (j == q) ? invf[q] : fj;
          const float ang = (float)pos[m] * fj; rope[m * 16 + j] = cosf(ang); rope[m * 16 + 8 + j] = sinf(ang); } }
}

#define WS32(F, T, byteoff) (*(T*)((F).a->ws + (size_t)(unsigned)(byteoff)))
template <int CTRL> __device__ __forceinline__ float dpp_add(float x) {
    return x + __int_as_float(__builtin_amdgcn_update_dpp(0, __float_as_int(x), CTRL, 0xf, 0xf, false));
}
__device__ __forceinline__ float row16_allsum(float x) { x = dpp_add<0x128>(x); x = dpp_add<0x124>(x); x = dpp_add<0x122>(x); x = dpp_add<0x121>(x); return x; }
__device__ __forceinline__ bf16_t f2bf(float x) { return (bf16_t)(cvtpk(x, 0.f) & 0xffffu); }
__device__ __forceinline__ u32x4 ld_row16(const Frame& F, unsigned off, bool ok) { u32x4 r = {0u, 0u, 0u, 0u}; if (ok) r = WS32(F, const u32x4, off); return r; }
__device__ __forceinline__ void unpack8(const u32x4 w, float (&o)[8]) { o[0] = bf_lo(w.x); o[1] = bf_hi(w.x); o[2] = bf_lo(w.y); o[3] = bf_hi(w.y); o[4] = bf_lo(w.z); o[5] = bf_hi(w.z); o[6] = bf_lo(w.w); o[7] = bf_hi(w.w); }
__device__ __forceinline__ void ld8f(const float* p, float (&o)[8]) { const f32x4 a = ((const f32x4*)p)[0], b = ((const f32x4*)p)[1]; o[0] = a.x; o[1] = a.y; o[2] = a.z; o[3] = a.w; o[4] = b.x; o[5] = b.y; o[6] = b.z; o[7] = b.w; }
__device__ __forceinline__ u32x4 pack8(const float (&v)[8]) { return (u32x4){cvtpk(v[0], v[1]), cvtpk(v[2], v[3]), cvtpk(v[4], v[5]), cvtpk(v[6], v[7])}; }
__device__ __forceinline__ void p3_prep(Frame& F, const int mode = 0) {
    constexpr int AP = 296;
    constexpr int PP = 264, PA = 16 * PP, PT = 5 * PA;
    LAS bf16_t* Al = (LAS bf16_t*)F.lds;
    LAS bf16_t* Pl = (LAS bf16_t*)(F.lds + 18944);
    LAS float* Zr = (LAS float*)(F.lds + 18944);
    LAS float* Zl = (LAS float*)(F.lds + 18944 + 20736);
    const int tid = F.tid, lane = F.lane, w = F.wave;
    const bf16_t* DUt = WSP(F, WS_LORA, bf16_t); const bf16_t* IUt = DUt + 2 * 1024 * 64; const bf16_t* GUt = IUt + 2 * 1024 * 64;
    const int n16 = lane & 15, q4 = lane >> 4;
    struct BF { bf16x8 d0[2], d1[2], i0[2], i1[2], g[5]; };
#define LD_BF(X, nb_, qq_) do { const int cl_ = 256 * (qq_) + 32 * w + 16 * (nb_) + n16; _Pragma("unroll") for (int ks = 0; ks < 2; ++ks) { \
                    X.d0[ks] = *(const bf16x8*)(DUt + (size_t)cl_ * 64 + 32 * ks + 8 * q4); X.d1[ks] = *(const bf16x8*)(DUt + (size_t)(1024 + cl_) * 64 + 32 * ks + 8 * q4); \
                    X.i0[ks] = *(const bf16x8*)(IUt + (size_t)cl_ * 64 + 32 * ks + 8 * q4); X.i1[ks] = *(const bf16x8*)(IUt + (size_t)(1024 + cl_) * 64 + 32 * ks + 8 * q4); } \
                    _Pragma("unroll") for (int ks = 0; ks < 5; ++ks) X.g[ks] = *(const bf16x8*)(GUt + (size_t)cl_ * 160 + 32 * ks + 8 * q4); } while (0)
    for (int item = F.vcu; item < MTOK / 32; item += F.G) {
        __syncthreads();
#pragma unroll 1
        for (int tl = 0; tl < 2; ++tl) {
            const int m0 = item * 32 + tl * 16, t0 = m0 & (SEQ - 1);
            for (int p = tid; p < 18 * 36; p += 512) {
                const int rr = p / 36, ch = p - rr * 36, t = t0 + rr - 1, m = m0 + rr - 1;
                f32x4 a0 = {0.f, 0.f, 0.f, 0.f}, a1 = a0;
                if (t >= 0 && t < SEQ) {
                    const bf16_t* pp = WSP(F, WS_PART, bf16_t) + (((size_t)((ch >> 5) * 32 + (m >> 8)) * 4) << 16) + (size_t)(m & 255) * 256 + ((8 * ch) & 255);
                    u32x4 q[4];
#pragma unroll
                    for (int k = 0; k < 4; ++k) q[k] = *(const u32x4*)(pp + ((size_t)k << 16));
#pragma unroll
                    for (int k = 0; k < 4; ++k) { a0 += (f32x4){bf_lo(q[k].x), bf_hi(q[k].x), bf_lo(q[k].y), bf_hi(q[k].y)}; a1 += (f32x4){bf_lo(q[k].z), bf_hi(q[k].z), bf_lo(q[k].w), bf_hi(q[k].w)}; }
                }
                LAS f32x4* zp = (LAS f32x4*)(Zr + rr * 288 + 8 * ch); zp[0] = a0; zp[1] = a1;
            }
            __syncthreads();
            for (int p = tid; p < 16 * 36; p += 512) {
                const int i = p / 36, ch = p - i * 36, zc = 3072 + 8 * ch;
                float c[8], pv[8], nx[8], mp[8], mn[8];
                { const LAS f32x4* q = (const LAS f32x4*)(Zr + i * 288 + 8 * ch); const f32x4 x0 = q[0], x1 = q[1], y0 = q[72], y1 = q[73], w0 = q[144], w1 = q[145];
                  pv[0] = x0.x; pv[1] = x0.y; pv[2] = x0.z; pv[3] = x0.w; pv[4] = x1.x; pv[5] = x1.y; pv[6] = x1.z; pv[7] = x1.w;
                  c[0] = y0.x; c[1] = y0.y; c[2] = y0.z; c[3] = y0.w; c[4] = y1.x; c[5] = y1.y; c[6] = y1.z; c[7] = y1.w;
                  nx[0] = w0.x; nx[1] = w0.y; nx[2] = w0.z; nx[3] = w0.w; nx[4] = w1.x; nx[5] = w1.y; nx[6] = w1.z; nx[7] = w1.w; }
                ld8f(INP(F, 4, float) + zc, mp); ld8f(INP(F, 5, float) + zc, mn);
                LAS f32x4* zp = (LAS f32x4*)(Zl + i * 288 + 8 * ch); float z[8];
#pragma unroll
                for (int e = 0; e < 8; ++e) z[e] = c[e] + mp[e] * (pv[e] - c[e]) + mn[e] * (nx[e] - c[e]);
                zp[0] = (f32x4){z[0], z[1], z[2], z[3]}; zp[1] = (f32x4){z[4], z[5], z[6], z[7]};
            }
            __syncthreads();
            for (int e = tid; e < 16 * 288; e += 512) { const int i = e / 288, j = e - i * 288; float z = Zl[e];
                if (j < 64) z = 1.f - 2.f * __builtin_amdgcn_rcpf(__expf(2.f * z) + 1.f); else if (j >= 128) z = __builtin_amdgcn_rcpf(1.f + __expf(-z));
                Al[tl * 16 * AP + i * AP + j] = f2bf(z); }
        }
        __syncthreads();
        if (mode == 1) continue;
        const int chk = tid & 31, pidx = tid >> 5, tb = pidx >> 3, tp = pidx & 7;
        const int m0t = item * 32 + tb * 16, t0t = m0t & (SEQ - 1);
        BF fa, fb; LD_BF(fa, 0, (F.vcu >> 2) & 3); LD_BF(fb, 1, (F.vcu >> 2) & 3);
#pragma unroll 1
        for (int qi = 0; qi < 4; ++qi) {
            const int q = (qi + (F.vcu >> 2)) & 3;
            u32x4 rawr[4], rawk[4], rawv[4];
            const unsigned roff = (unsigned)WS_PROJ + ((unsigned)(m0t + 2 * tp) * LDP + ZC0 + 256 * q + 8 * chk) * 2u;
#pragma unroll
            for (int rr = 0; rr < 4; ++rr) { const int t = t0t + 2 * tp + rr - 1; const bool ok = (t >= 0) && (t < SEQ); const unsigned o = roff + (unsigned)((rr - 1) * LDP * 2);
                rawr[rr] = ld_row16(F, o, ok); rawk[rr] = ld_row16(F, o + 1024u * 2u, ok); }
            {
#define DO_NB(X, nb_, tl_) do { const int ch_ = 32 * w + 16 * (nb_); \
                    f32x4 aw0 = {0.f, 0.f, 0.f, 0.f}, aw1 = aw0, aa0 = aw0, aa1 = aw0, ag = aw0; \
                    _Pragma("unroll") for (int ks = 0; ks < 2; ++ks) { \
                        aw0 = __builtin_amdgcn_mfma_f32_16x16x32_bf16(X.d0[ks], af[ks], aw0, 0, 0, 0); aw1 = __builtin_amdgcn_mfma_f32_16x16x32_bf16(X.d1[ks], af[ks], aw1, 0, 0, 0); \
                        aa0 = __builtin_amdgcn_mfma_f32_16x16x32_bf16(X.i0[ks], af[2 + ks], aa0, 0, 0, 0); aa1 = __builtin_amdgcn_mfma_f32_16x16x32_bf16(X.i1[ks], af[2 + ks], aa1, 0, 0, 0); } \
                    _Pragma("unroll") for (int ks = 0; ks < 5; ++ks) ag = __builtin_amdgcn_mfma_f32_16x16x32_bf16(X.g[ks], af[4 + ks], ag, 0, 0, 0); \
                    LAS bf16_t* pp = Pl + (tl_) * PT + n16 * PP + ch_ + 4 * q4; \
                    *(LAS u32x2*)(pp) = (u32x2){cvtpk(aw0[0], aw0[1]), cvtpk(aw0[2], aw0[3])}; *(LAS u32x2*)(pp + PA) = (u32x2){cvtpk(aw1[0], aw1[1]), cvtpk(aw1[2], aw1[3])}; \
                    *(LAS u32x2*)(pp + 2 * PA) = (u32x2){cvtpk(aa0[0], aa0[1]), cvtpk(aa0[2], aa0[3])}; *(LAS u32x2*)(pp + 3 * PA) = (u32x2){cvtpk(aa1[0], aa1[1]), cvtpk(aa1[2], aa1[3])}; \
                    *(LAS u32x2*)(pp + 4 * PA) = (u32x2){cvtpk(ag[0], ag[1]), cvtpk(ag[2], ag[3])}; } while (0)
#pragma unroll
                for (int tl = 0; tl < 2; ++tl) {
                    bf16x8 af[9];
#pragma unroll
                    for (int ks = 0; ks < 9; ++ks) af[ks] = *(const LAS bf16x8*)(Al + tl * 16 * AP + n16 * AP + 32 * ks + 8 * q4);
                    DO_NB(fa, 0, tl); DO_NB(fb, 1, tl);
                }
#undef DO_NB
            }
#pragma unroll
            for (int rr = 0; rr < 4; ++rr) { const int t = t0t + 2 * tp + rr - 1; const bool ok = (t >= 0) && (t < SEQ); rawv[rr] = ld_row16(F, roff + (unsigned)((rr - 1) * LDP * 2) + 2048u * 2u, ok); }
            __syncthreads();
            if (mode != 2) {
                const int c = 256 * q + 8 * chk;
                float r4[4][8], k4[4][8], v4[4][8];
#pragma unroll
                for (int rr = 0; rr < 4; ++rr) { unpack8(rawr[rr], r4[rr]); unpack8(rawk[rr], k4[rr]); unpack8(rawv[rr], v4[rr]); }
                float zr[2][8], zk[2][8], zv[2][8];
                { float mp[8], mn[8];
                  ld8f(INP(F, 4, float) + c, mp); ld8f(INP(F, 5, float) + c, mn);
#pragma unroll
                  for (int tk = 0; tk < 2; ++tk)
#pragma unroll
                      for (int e = 0; e < 8; ++e) zr[tk][e] = r4[tk + 1][e] + mp[e] * (r4[tk][e] - r4[tk + 1][e]) + mn[e] * (r4[tk + 2][e] - r4[tk + 1][e]);
                  ld8f(INP(F, 4, float) + 1024 + c, mp); ld8f(INP(F, 5, float) + 1024 + c, mn);
#pragma unroll
                  for (int tk = 0; tk < 2; ++tk)
#pragma unroll
                      for (int e = 0; e < 8; ++e) zk[tk][e] = k4[tk + 1][e] + mp[e] * (k4[tk][e] - k4[tk + 1][e]) + mn[e] * (k4[tk + 2][e] - k4[tk + 1][e]);
                  ld8f(INP(F, 4, float) + 2048 + c, mp); ld8f(INP(F, 5, float) + 2048 + c, mn);
#pragma unroll
                  for (int tk = 0; tk < 2; ++tk)
#pragma unroll
                      for (int e = 0; e < 8; ++e) zv[tk][e] = v4[tk + 1][e] + mp[e] * (v4[tk][e] - v4[tk + 1][e]) + mn[e] * (v4[tk + 2][e] - v4[tk + 1][e]); }
                float kkw[8], w00[8], w01[8], a00[8], a01[8], kac[8], rkc[8];
                ld8f(INP(F, 16, float) + c, kkw); ld8f(INP(F, 11, float) + c, w00); ld8f(INP(F, 11, float) + 1024 + c, w01);
                ld8f(INP(F, 13, float) + c, a00); ld8f(INP(F, 13, float) + 1024 + c, a01); ld8f(INP(F, 17, float) + c, kac); ld8f(INP(F, 18, float) + c, rkc);
#pragma unroll 1
                for (int tk = 0; tk < 2; ++tk) {
                    const int tkn = 2 * tp + tk; const unsigned o = (unsigned)(m0t + tkn) * 1024u + (unsigned)c;
                    const LAS bf16_t* pp = Pl + tb * PT + tkn * PP + 8 * chk;
                    float zrt[8], zkt[8], zvt[8];
#pragma unroll
                    for (int e = 0; e < 8; ++e) { zrt[e] = tk ? zr[1][e] : zr[0][e]; zkt[e] = tk ? zk[1][e] : zk[0][e]; zvt[e] = tk ? zv[1][e] : zv[0][e]; }
                    WS32(F, u32x4, (unsigned)WS_R + o * 2u) = pack8(zrt); WS32(F, u32x4, (unsigned)WS_V + o * 2u) = pack8(zvt);
                    float kk[8];
                    { float ss = 0.f;
#pragma unroll
                      for (int e = 0; e < 8; ++e) { kk[e] = zkt[e] * kkw[e]; ss += kk[e] * kk[e]; }
                      ss += __shfl_xor(ss, 1); ss += __shfl_xor(ss, 2); ss += __shfl_xor(ss, 4);
                      const float inv = 1.f / fmaxf(sqrtf(ss), 1e-12f);
#pragma unroll
                      for (int e = 0; e < 8; ++e) kk[e] *= inv;
                      WS32(F, u32x4, (unsigned)WS_KK + o * 2u) = pack8(kk); }
                    {
                        float pw0[8], pw1[8], d0[8], d1[8];
                        unpack8(*(const LAS u32x4*)(pp), pw0); unpack8(*(const LAS u32x4*)(pp + PA), pw1);
#pragma unroll
                        for (int e = 0; e < 8; ++e) {
                            d0[e] = 0.6065306597126334f * __builtin_amdgcn_rcpf(1.f + __expf(-(w00[e] + pw0[e]))); d1[e] = 0.6065306597126334f * __builtin_amdgcn_rcpf(1.f + __expf(-(w01[e] + pw1[e]))); }
                        WS32(F, u32x4, (unsigned)WS_WDEC + o * 2u) = pack8(d0); WS32(F, u32x4, (unsigned)WS_WDEC + ((unsigned)(MTOK * 1024) + o) * 2u) = pack8(d1);
                    }
                    {
                        float pa0[8], pa1[8], kd0[8], kd1[8], b0v[8], b1v[8]; float bs = 0.f;
                        unpack8(*(const LAS u32x4*)(pp + 2 * PA), pa0); unpack8(*(const LAS u32x4*)(pp + 3 * PA), pa1);
#pragma unroll
                        for (int e = 0; e < 8; ++e) {
                            const float av0 = __builtin_amdgcn_rcpf(1.f + __expf(-(a00[e] + pa0[e]))), av1 = __builtin_amdgcn_rcpf(1.f + __expf(-(a01[e] + pa1[e])));
                            kd0[e] = zkt[e] * (1.f + (av0 - 1.f) * kac[e]); kd1[e] = zkt[e] * (1.f + (av1 - 1.f) * kac[e]);
                            b0v[e] = kk[e] * av0; b1v[e] = kk[e] * av1;
                            bs += zrt[e] * (kd0[e] + kd1[e]) * rkc[e]; }
                        bs += __shfl_xor(bs, 1); bs += __shfl_xor(bs, 2); bs += __shfl_xor(bs, 4);
                        if ((chk & 7) == 0) WS32(F, float, (unsigned)WS_BONUS + ((unsigned)(m0t + tkn) * 16u + (unsigned)(4 * q + (chk >> 3))) * 4u) = bs;
                        WS32(F, u32x4, (unsigned)WS_KD + o * 2u) = pack8(kd0); WS32(F, u32x4, (unsigned)WS_KD + ((unsigned)(MTOK * 1024) + o) * 2u) = pack8(kd1);
                        WS32(F, u32x4, (unsigned)WS_BB + o * 2u) = pack8(b0v); WS32(F, u32x4, (unsigned)WS_BB + ((unsigned)(MTOK * 1024) + o) * 2u) = pack8(b1v);
                    }
                    WS32(F, u32x4, (unsigned)WS_G + o * 2u) = *(const LAS u32x4*)(pp + 4 * PA);
                }
            }
            { const int qn = (qi + 1 + (F.vcu >> 2)) & 3; LD_BF(fa, 0, qn); LD_BF(fb, 1, qn); }
            __syncthreads();
        }
    }
#undef LD_BF
}

struct P5aConst { float lam; };
__device__ __forceinline__ void p5a_init(const Frame& F, P5aConst& K) {
    const int lane = F.lane;
    const float q1 = INP(F, 6, float)[lane] * INP(F, 7, float)[lane], q2 = INP(F, 8, float)[lane] * INP(F, 9, float)[lane];
    K.lam = __expf(wave_sum(q1)) - __expf(wave_sum(q2)) + 0.2f;
}
__device__ __forceinline__ void p5a_token(const Frame& F, const P5aConst& K, int m) {
    const bf16_t* OC = WSP(F, WS_OC, bf16_t); bf16_t* MIX = WSP(F, WS_MIX, bf16_t); const float* subw = INP(F, 10, float);
    const int c0 = F.lane * 16; const float lam = K.lam;
    const u32x4* p0 = (const u32x4*)(OC + (size_t)m * 1024 + c0); const u32x4* p1 = (const u32x4*)(OC + (size_t)MTOK * 1024 + (size_t)m * 1024 + c0);
    const u32x4 a0 = p0[0], a1 = p0[1], b0 = p1[0], b1 = p1[1];
    float dv[16]; const unsigned aw[8] = {a0.x, a0.y, a0.z, a0.w, a1.x, a1.y, a1.z, a1.w}, bw[8] = {b0.x, b0.y, b0.z, b0.w, b1.x, b1.y, b1.z, b1.w};
    float ssq = 0.f;
#pragma unroll
    for (int i = 0; i < 8; ++i) { dv[2 * i] = bf_lo(aw[i]) - lam * bf_lo(bw[i]); dv[2 * i + 1] = bf_hi(aw[i]) - lam * bf_hi(bw[i]); ssq += dv[2 * i] * dv[2 * i] + dv[2 * i + 1] * dv[2 * i + 1]; }
    ssq += __shfl_xor(ssq, 1); ssq += __shfl_xor(ssq, 2); ssq += __shfl_xor(ssq, 4);
    const float rstd = 1.f / sqrtf(ssq * (1.f / 128.f) + 1e-5f);
    unsigned ow[8];
#pragma unroll
    for (int i = 0; i < 8; ++i) { const float s0 = subw[(c0 + 2 * i) & 127] * 0.8f, s1 = subw[(c0 + 2 * i + 1) & 127] * 0.8f; ow[i] = cvtpk(dv[2 * i] * rstd * s0, dv[2 * i + 1] * rstd * s1); }
    u32x4* op = (u32x4*)(MIX + (size_t)m * 2048 + c0); op[0] = (u32x4){ow[0], ow[1], ow[2], ow[3]}; op[1] = (u32x4){ow[4], ow[5], ow[6], ow[7]};
}

__device__ __forceinline__ void p4_scan(Frame& F, const int mode = 0) {
    constexpr int CH = 32, NCH = SEQ / CH;
    constexpr int VEC = CH * 64 * 4;
    constexpr int BUF = 5 * VEC + CH * 32 * 4;
    constexpr int YOFF = 2 * BUF, YB = CH * 32 * 4;
    constexpr int CVT_SCR = 2 * BUF + 2 * YB;
    const bf16_t* Wdec = WSP(F, WS_WDEC, bf16_t); const bf16_t* KDg = WSP(F, WS_KD, bf16_t); const bf16_t* BBg = WSP(F, WS_BB, bf16_t);
    const bf16_t* Rg = WSP(F, WS_R, bf16_t); const bf16_t* KKg = WSP(F, WS_KK, bf16_t); const bf16_t* Vg = WSP(F, WS_V, bf16_t); bf16_t* YS = WSP(F, WS_YS, bf16_t);
    const int tid = F.tid, lane = F.lane, wid = F.wave;
    const bool is_comp = wid < 4;
    const int ri = wid & 3;
    if (is_comp) __builtin_amdgcn_s_setprio(3);
    const int g = lane >> 3, j = lane & 7, rowl = ri * 8 + g;
    const int mt = ri * 64 + lane, mw = ri;
    int cvt_it = F.vcu * 4 + mw; f32x4 cvv[16]; int ck0 = 0, crowb = 0; unsigned char* cWT = nullptr;
    f32x4 cvvB[16]; int ck0B = 0, crowbB = 0; unsigned char* cWTB = nullptr;
    LAS unsigned* st_cnt = (LAS unsigned*)(F.lds + CVT_SCR + 4 * 4096); LAS unsigned* cons_cnt = st_cnt + 16;
    for (int item = F.vcu; item < 256; item += F.G) {
        const int chain = item >> 1, half = item & 1, d = chain >> 6, b = (chain >> 4) & 3, h = chain & 15;
        const size_t sh = (size_t)b * SEQ * 1024 + h * 64, pd = (size_t)d * MTOK * 1024 + sh;
        f32x2 S2[4] = {{0.f, 0.f}, {0.f, 0.f}, {0.f, 0.f}, {0.f, 0.f}};
        u32x2 rw[2], rkk[2], rbb[2], rkd[2], rr[2]; unsigned rv[2];
        const int cstep = d ? -CH * 1024 : CH * 1024;
        unsigned po[2], pv[2];
#pragma unroll
        for (int q_ = 0; q_ < 2; ++q_) { const int sl_ = mt + 256 * q_, ss_ = sl_ >> 4, sk_ = (sl_ & 15) * 4, tq_ = d ? (SEQ - 1 - ss_) : ss_; po[q_] = (unsigned)(tq_ * 1024 + sk_); pv[q_] = (unsigned)(tq_ * 1024 + half * 32 + 2 * (sl_ & 15)); }
        const char* bW = (const char*)(Wdec + pd); const char* bKK = (const char*)(KKg + sh); const char* bBB = (const char*)(BBg + pd); const char* bKD = (const char*)(KDg + pd); const char* bR = (const char*)(Rg + sh); const char* bV = (const char*)(Vg + sh);
#define SC_LOAD(c) do { const unsigned cu_ = (unsigned)((c) * cstep); _Pragma("unroll") for (int q_ = 0; q_ < 2; ++q_) { const unsigned e_ = po[q_] + cu_; \
        rw[q_] = *(const u32x2*)(bW + (size_t)(e_ * 2u)); rkk[q_] = *(const u32x2*)(bKK + (size_t)(e_ * 2u)); rbb[q_] = *(const u32x2*)(bBB + (size_t)(e_ * 2u)); rkd[q_] = *(const u32x2*)(bKD + (size_t)(e_ * 2u)); rr[q_] = *(const u32x2*)(bR + (size_t)(e_ * 2u)); \
        rv[q_] = *(const unsigned*)(bV + (size_t)((pv[q_] + cu_) * 2u)); } } while (0)
#define SC_STORE(bufi) do { LAS unsigned char* bp_ = F.lds + (bufi) * BUF; _Pragma("unroll") for (int q_ = 0; q_ < 2; ++q_) { const int sl_ = mt + 256 * q_, ss_ = sl_ >> 4, sk_ = (sl_ & 15) * 4; const int o_ = (ss_ * 64 + sk_) * 4; \
        *(LAS f32x4*)(bp_ + o_) = (f32x4){__expf(-bf_lo(rw[q_].x)), __expf(-bf_hi(rw[q_].x)), __expf(-bf_lo(rw[q_].y)), __expf(-bf_hi(rw[q_].y))}; \
        *(LAS f32x4*)(bp_ + VEC + o_) = (f32x4){bf_lo(rkk[q_].x), bf_hi(rkk[q_].x), bf_lo(rkk[q_].y), bf_hi(rkk[q_].y)}; \
        *(LAS f32x4*)(bp_ + 2 * VEC + o_) = (f32x4){bf_lo(rbb[q_].x), bf_hi(rbb[q_].x), bf_lo(rbb[q_].y), bf_hi(rbb[q_].y)}; \
        *(LAS f32x4*)(bp_ + 3 * VEC + o_) = (f32x4){bf_lo(rkd[q_].x), bf_hi(rkd[q_].x), bf_lo(rkd[q_].y), bf_hi(rkd[q_].y)}; \
        *(LAS f32x4*)(bp_ + 4 * VEC + o_) = (f32x4){bf_lo(rr[q_].x), bf_hi(rr[q_].x), bf_lo(rr[q_].y), bf_hi(rr[q_].y)}; \
        *(LAS f32x2*)(bp_ + 5 * VEC + (ss_ * 32 + 2 * (sl_ & 15)) * 4) = (f32x2){bf_lo(rv[q_]), bf_hi(rv[q_])}; } } while (0)
#define Y_OUT(c) do { const int ys_ = mt >> 3, yr_ = (mt & 7) * 4; const int tt_ = (c) * CH + ys_, t_ = d ? (SEQ - 1 - tt_) : tt_; \
        const f32x4 yv_ = *(const LAS f32x4*)(F.lds + YOFF + ((c) & 1) * YB + (ys_ * 32 + yr_) * 4); \
        *(u32x2*)(YS + pd + (size_t)t_ * 1024 + half * 32 + yr_) = (u32x2){cvtpk(yv_.x, yv_.y), cvtpk(yv_.z, yv_.w)}; } while (0)
#define SC_WAIT(cnt_, tgt_) do { for (;;) { const u32x4 q_ = *(volatile LAS u32x4*)(cnt_); const unsigned a_ = q_.x < q_.y ? q_.x : q_.y, b_ = q_.z < q_.w ? q_.z : q_.w; \
        if ((a_ < b_ ? a_ : b_) >= (tgt_)) break; if (is_comp) __builtin_amdgcn_s_sleep(1); else __builtin_amdgcn_s_sleep(12); } asm volatile("" ::: "memory"); } while (0)
#define SC_SIGNAL(cnt_, val_) do { asm volatile("s_waitcnt lgkmcnt(0)" ::: "memory"); if (lane == 0) *(volatile LAS unsigned*)((cnt_) + ri) = (val_); } while (0)
        __syncthreads();
        if (tid < 4) { st_cnt[tid] = 0u; cons_cnt[tid] = 0u; }
        if (!is_comp) { SC_LOAD(0); SC_STORE(0); SC_LOAD(1); }
        __syncthreads();
        if (is_comp) {
          for (int c = 0; c < NCH; ++c) {
            SC_WAIT(st_cnt, (unsigned)c);
            if (mode != 2) {
                const LAS unsigned char* bp = F.lds + (c & 1) * BUF;
                LAS float* yb = (LAS float*)(F.lds + YOFF + (c & 1) * YB);
                f32x4 cw_[2], ckk[2], cbb[2], ckd[2], cr[2]; float cv;
#define SC_RD(s_) do { const int o_ = ((s_) * 64 + j * 8) * 4; cw_[0] = *(const LAS f32x4*)(bp + o_); cw_[1] = *(const LAS f32x4*)(bp + o_ + 16); ckk[0] = *(const LAS f32x4*)(bp + VEC + o_); ckk[1] = *(const LAS f32x4*)(bp + VEC + o_ + 16); \
                cbb[0] = *(const LAS f32x4*)(bp + 2 * VEC + o_); cbb[1] = *(const LAS f32x4*)(bp + 2 * VEC + o_ + 16); ckd[0] = *(const LAS f32x4*)(bp + 3 * VEC + o_); ckd[1] = *(const LAS f32x4*)(bp + 3 * VEC + o_ + 16); \
                cr[0] = *(const LAS f32x4*)(bp + 4 * VEC + o_); cr[1] = *(const LAS f32x4*)(bp + 4 * VEC + o_ + 16); cv = *(const LAS float*)(bp + 5 * VEC + ((s_) * 32 + rowl) * 4); } while (0)
#define H2(v_, i_) ((f32x2){v_[(i_) >> 1][((i_) & 1) * 2], v_[(i_) >> 1][((i_) & 1) * 2 + 1]})
                SC_RD(0);
                float yk = 0.f;
#pragma unroll
                for (int s = 0; s < CH; ++s) {
                    f32x4 w[2] = {cw_[0], cw_[1]}, kk[2] = {ckk[0], ckk[1]}, bb[2] = {cbb[0], cbb[1]}, kd[2] = {ckd[0], ckd[1]}, r[2] = {cr[0], cr[1]}; const float v = cv;
                    if (s + 1 < CH) SC_RD(s + 1);
                    f32x2 pa = S2[0] * H2(kk, 0), pb = S2[1] * H2(kk, 1); pa = S2[2] * H2(kk, 2) + pa; pb = S2[3] * H2(kk, 3) + pb; pa = pa + pb;
                    const f32x2 vv = {v, v};
                    f32x2 u[4];
#pragma unroll
                    for (int i = 0; i < 4; ++i) u[i] = S2[i] * H2(w, i) + vv * H2(kd, i);
                    float p = pa.x + pa.y;
                    p = dpp_add<0xB1>(p); p = dpp_add<0x4E>(p); p = dpp_add<0x141>(p);
                    const f32x2 sa = {-p, -p};
#pragma unroll
                    for (int i = 0; i < 4; ++i) S2[i] = sa * H2(bb, i) + u[i];
                    f32x2 ya = S2[0] * H2(r, 0), yc = S2[1] * H2(r, 1); ya = S2[2] * H2(r, 2) + ya; yc = S2[3] * H2(r, 3) + yc; ya = ya + yc;
                    float y = ya.x + ya.y;
                    y = dpp_add<0xB1>(y); y = dpp_add<0x4E>(y); y = dpp_add<0x141>(y);
                    yk = (j == (s & 7)) ? y : yk;
                    if ((s & 7) == 7) yb[((s & 24) + j) * 32 + rowl] = yk;
                }
#undef SC_RD
#undef H2
            }
            SC_SIGNAL(cons_cnt, (unsigned)(c + 1));
          }
        } else {
#define MEM_DUTIES(c_) do { SC_WAIT(cons_cnt, (unsigned)(c_)); if ((c_) >= 1 && mode != 2) Y_OUT((c_) - 1); if ((c_) + 1 < NCH) SC_STORE(((c_) + 1) & 1); SC_SIGNAL(st_cnt, (unsigned)((c_) + 1)); if ((c_) + 2 < NCH) SC_LOAD((c_) + 2); } while (0)
#define CVT_LOAD_SET(V_, K0_, WT_, RB_) do { const int it_ = cvt_it < N_EXPERT_ITEMS ? cvt_it : N_EXPERT_ITEMS - 1; const float* cW_; int cn0_; cvt_expert_decode(F, it_, cW_, K0_, cn0_, WT_, RB_); cvt8_load(V_, cW_, K0_, cn0_, lane); cvt_it += F.G * 4; } while (0)
          if (item == F.vcu) { P5aConst p5k; p5a_init(F, p5k); for (int xm = F.vcu * 4 + mw; xm < MTOK; xm += F.G * 4) p5a_token(F, p5k, xm); }
          int ngrp = 0; { const int left = (N_EXPERT_ITEMS - cvt_it + F.G * 4 - 1) / (F.G * 4); ngrp = left > 0 ? left / 3 : 0; if (ngrp > NCH / 4) ngrp = NCH / 4; }
          int cg = 0;
#pragma unroll 1
          for (; cg < 4 * ngrp; cg += 4) {
            MEM_DUTIES(cg);
#if CVT_IN_SCAN
            if (cg > 0) cvt8_finish(cvv, ck0, cWT, crowb, lane);
            CVT_LOAD_SET(cvv, ck0, cWT, crowb);
#endif
            MEM_DUTIES(cg + 1);
#if CVT_IN_SCAN
            CVT_LOAD_SET(cvvB, ck0B, cWTB, crowbB);
#endif
            MEM_DUTIES(cg + 2);
#if CVT_IN_SCAN
            cvt8_finish(cvv, ck0, cWT, crowb, lane);
            CVT_LOAD_SET(cvv, ck0, cWT, crowb);
#endif
            MEM_DUTIES(cg + 3);
#if CVT_IN_SCAN
            cvt8_finish(cvvB, ck0B, cWTB, crowbB, lane);
#endif
          }
#if CVT_IN_SCAN
          if (ngrp > 0) cvt8_finish(cvv, ck0, cWT, crowb, lane);
#endif
#pragma unroll 1
          for (; cg < NCH; ++cg) MEM_DUTIES(cg);
#undef MEM_DUTIES
#undef CVT_LOAD_SET
          SC_WAIT(cons_cnt, (unsigned)NCH);
        }
        if (!is_comp && mode != 2) Y_OUT(NCH - 1);
#undef SC_LOAD
#undef SC_STORE
#undef Y_OUT
#undef SC_WAIT
#undef SC_SIGNAL
    }
    __builtin_amdgcn_s_setprio(0);
#if CVT_IN_SCAN
    if (!is_comp) {
        for (; cvt_it < N_EXPERT_ITEMS; cvt_it += F.G * 4) {
            const float* W; int k0, n0, rowb; unsigned char* WT;
            cvt_expert_decode(F, cvt_it, W, k0, n0, WT, rowb); cvt8_load(cvv, W, k0, n0, lane); cvt8_finish(cvv, k0, WT, rowb, lane);
        }
    }
#endif
}

__device__ __forceinline__ void p5_finalize(Frame& F) {
    const bf16_t* YS = WSP(F, WS_YS, bf16_t); const bf16_t* Vg = WSP(F, WS_V, bf16_t); const bf16_t* Gg = WSP(F, WS_G, bf16_t);
    const float* BON = WSP(F, WS_BONUS, float); bf16_t* MIX = WSP(F, WS_MIX, bf16_t);
    const float* lnw = INP(F, 19, float); const float* lnb = INP(F, 20, float);
    const int lane = F.lane, gw = F.vcu * 8 + F.wave, NGW = F.G * 8;
    const int c0 = lane * 16;
    float lw[16], lb[16];
#pragma unroll
    for (int i = 0; i < 16; ++i) { lw[i] = lnw[c0 + i]; lb[i] = lnb[c0 + i]; }
    struct Raw { u32x4 a0, a1, b0, b1, v0, v1, g0, g1; float bon; };
#define P5_LOAD(R_, m_) do { const u32x4* y0_ = (const u32x4*)(YS + (size_t)(m_) * 1024 + c0); const u32x4* y1_ = (const u32x4*)(YS + (size_t)MTOK * 1024 + (size_t)(m_) * 1024 + c0); \
        const u32x4* vp_ = (const u32x4*)(Vg + (size_t)(m_) * 1024 + c0); const u32x4* gp_ = (const u32x4*)(Gg + (size_t)(m_) * 1024 + c0); \
        R_.a0 = y0_[0]; R_.a1 = y0_[1]; R_.b0 = y1_[0]; R_.b1 = y1_[1]; R_.v0 = vp_[0]; R_.v1 = vp_[1]; R_.g0 = gp_[0]; R_.g1 = gp_[1]; R_.bon = BON[(size_t)(m_) * 16 + (lane >> 2)]; } while (0)
#define P5_FINISH(R_, m_) do { float y[16]; float s_ = 0.f; \
        { const unsigned aw[8] = {R_.a0.x, R_.a0.y, R_.a0.z, R_.a0.w, R_.a1.x, R_.a1.y, R_.a1.z, R_.a1.w}, bw[8] = {R_.b0.x, R_.b0.y, R_.b0.z, R_.b0.w, R_.b1.x, R_.b1.y, R_.b1.z, R_.b1.w}; \
          _Pragma("unroll") for (int i = 0; i < 8; ++i) { y[2 * i] = bf_lo(aw[i]) + bf_lo(bw[i]); y[2 * i + 1] = bf_hi(aw[i]) + bf_hi(bw[i]); } } \
        _Pragma("unroll") for (int i = 0; i < 16; ++i) s_ += y[i]; \
        s_ += __shfl_xor(s_, 1); s_ += __shfl_xor(s_, 2);                                              \
        const float mu_ = s_ * (1.f / 64.f); float q_ = 0.f; \
        _Pragma("unroll") for (int i = 0; i < 16; ++i) { y[i] -= mu_; q_ += y[i] * y[i]; } \
        q_ += __shfl_xor(q_, 1); q_ += __shfl_xor(q_, 2); \
        const float rstd_ = 1.f / sqrtf(q_ * (1.f / 64.f) + 64e-5f); \
        const unsigned vw[8] = {R_.v0.x, R_.v0.y, R_.v0.z, R_.v0.w, R_.v1.x, R_.v1.y, R_.v1.z, R_.v1.w}, gq[8] = {R_.g0.x, R_.g0.y, R_.g0.z, R_.g0.w, R_.g1.x, R_.g1.y, R_.g1.z, R_.g1.w}; \
        unsigned ow[8]; \
        _Pragma("unroll") for (int i = 0; i < 8; ++i) { \
            const float e0 = (y[2 * i] * rstd_ * lw[2 * i] + lb[2 * i] + R_.bon * bf_lo(vw[i])) * bf_lo(gq[i]); \
            const float e1 = (y[2 * i + 1] * rstd_ * lw[2 * i + 1] + lb[2 * i + 1] + R_.bon * bf_hi(vw[i])) * bf_hi(gq[i]); \
            ow[i] = cvtpk(e0, e1); } \
        u32x4* op = (u32x4*)(MIX + (size_t)(m_) * 2048 + 1024 + c0); op[0] = (u32x4){ow[0], ow[1], ow[2], ow[3]}; op[1] = (u32x4){ow[4], ow[5], ow[6], ow[7]}; } while (0)
    for (int m = gw; m < MTOK; m += 2 * NGW) {
        const int m2 = m + NGW; const bool has2 = m2 < MTOK;
        Raw ra, rb; P5_LOAD(ra, m); if (has2) P5_LOAD(rb, m2);
        P5_FINISH(ra, m); if (has2) P5_FINISH(rb, m2);
    }
#undef P5_LOAD
#undef P5_FINISH
}

__device__ __forceinline__ void p7_router(Frame& F) {
    const bf16_t* X1 = WSP(F, WS_X1, bf16_t); const float* nw = INP(F, 22, float); const float* wr = INP(F, 23, float);
    unsigned char* H2 = WSP(F, WS_H2, unsigned char); float* AFF = WSP(F, WS_AFF, float);
    const int lane = F.lane, w = F.wave, tok = lane & 15, kq = lane >> 4;
    LAS float* part = (LAS float*)F.lds;
    LAS float* ssqp = (LAS float*)(F.lds + 8192);
    const int kb = 256 * w + 8 * kq;
    float Bw[8][8];
#pragma unroll
    for (int g = 0; g < 8; ++g)
#pragma unroll
        for (int e = 0; e < 8; ++e) { const int k = kb + 32 * g + e; Bw[g][e] = nw[k] * wr[(size_t)k * 16 + tok]; }
    for (int item = F.vcu; item < MTOK / 16; item += F.G) {
        const int m0 = item * 16;
        u32x4 xr[8];
        const bf16_t* xp = X1 + (size_t)(m0 + tok) * DM + kb;
#pragma unroll
        for (int g = 0; g < 8; ++g) xr[g] = *(const u32x4*)(xp + 32 * g);
        f32x4 acc = {0.f, 0.f, 0.f, 0.f}; float ss = 0.f;
#pragma unroll
        for (int g = 0; g < 8; ++g) {
            float x[8]; unpack8(xr[g], x);
#pragma unroll
            for (int e = 0; e < 8; ++e) { ss += x[e] * x[e]; acc = __builtin_amdgcn_mfma_f32_16x16x4f32(x[e], Bw[g][e], acc, 0, 0, 0); }
        }
        __syncthreads();
        *(LAS f32x4*)(part + w * 256 + tok * 16 + 4 * kq) = acc;
        ss += __shfl_xor(ss, 16); ss += __shfl_xor(ss, 32);
        if (kq == 0) ssqp[w * 16 + tok] = ss;
        __syncthreads();
        float tot = 0.f;
#pragma unroll
        for (int i = 0; i < 8; ++i) tot += ssqp[i * 16 + tok];
        const float rstd = 1.f / sqrtf(tot * (1.f / DM) + 1e-6f);
        { unsigned char* hp = H2 + (size_t)(m0 + tok) * DM + kb;
#pragma unroll
          for (int g = 0; g < 8; ++g) { float x[8]; unpack8(xr[g], x); const f32x4 n0 = *(const f32x4*)(nw + kb + 32 * g), n1 = *(const f32x4*)(nw + kb + 32 * g + 4);
              u32x2 o; o.x = pg8::cvt4_fp8(x[0] * rstd * n0.x, x[1] * rstd * n0.y, x[2] * rstd * n0.z, x[3] * rstd * n0.w); o.y = pg8::cvt4_fp8(x[4] * rstd * n1.x, x[5] * rstd * n1.y, x[6] * rstd * n1.z, x[7] * rstd * n1.w);
              *(u32x2*)(hp + 32 * g) = o; } }
        if (lane < 32) {
            const int tt = 2 * w + (lane >> 4), ex = lane & 15;
            float lg = 0.f, t2 = 0.f;
#pragma unroll
            for (int i = 0; i < 8; ++i) { lg += part[i * 256 + ex * 16 + tt]; t2 += ssqp[i * 16 + tt]; }
            lg *= 1.f / sqrtf(t2 * (1.f / DM) + 1e-6f);
            float mx = lg;
            mx = fmaxf(mx, __shfl_xor(mx, 1)); mx = fmaxf(mx, __shfl_xor(mx, 2)); mx = fmaxf(mx, __shfl_xor(mx, 4)); mx = fmaxf(mx, __shfl_xor(mx, 8));
            const float pe = expf(lg - mx);
            float den = pe; den += __shfl_xor(den, 1); den += __shfl_xor(den, 2); den += __shfl_xor(den, 4); den += __shfl_xor(den, 8);
            const int mm = m0 + tt;
            AFF[((size_t)(mm >> 11) * 16 + ex) * SEQ + (mm & (SEQ - 1))] = pe / den;
        }
    }
    __syncthreads();
}

__device__ __forceinline__ int wave_count4(bool f0, bool f1, bool f2, bool f3) {
    return __builtin_popcountll(__ballot(f0)) + __builtin_popcountll(__ballot(f1)) + __builtin_popcountll(__ballot(f2)) + __builtin_popcountll(__ballot(f3));
}
__device__ __forceinline__ void p8_select(Frame& F) {
    const float* AFF = WSP(F, WS_AFF, float);
    int* XEIDX = WSP(F, WS_XEIDX, int); float* GATEX = WSP(F, WS_GATEX, float); int* SLOT = WSP(F, WS_SLOT, int);
    LAS int* part = (LAS int*)F.lds;
    LAS unsigned* cnt = (LAS unsigned*)(F.lds + 256);
    LAS unsigned* list = (LAS unsigned*)(F.lds + 512);
    const int tid = F.tid, lane = F.lane, w = F.wave;
    for (int item = F.vcu; item < 256; item += F.G) {
        const int be = item >> 2, q = item & 3, b = be >> 4, e = be & 15;
        __syncthreads();
        if (tid == 0) *cnt = 0u;
        const f32x4 a4 = ((const f32x4*)(AFF + (size_t)be * SEQ))[tid];
        const unsigned u0 = __float_as_uint(a4.x), u1 = __float_as_uint(a4.y), u2 = __float_as_uint(a4.z), u3 = __float_as_uint(a4.w);
        unsigned lo = 0u, hi = 0x7f800001u;
        int itn = 0;
        while (hi - lo > 1u) {
            const unsigned mid = lo + ((hi - lo) >> 1);
            const int c = wave_count4(u0 >= mid, u1 >= mid, u2 >= mid, u3 >= mid);
            LAS int* pp = part + (itn & 1) * 8;
            if (lane == 0) pp[w] = c;
            __syncthreads();
            int tot = 0;
#pragma unroll
            for (int i = 0; i < 8; ++i) tot += pp[i];
            if (tot >= CAP) lo = mid; else hi = mid;
            ++itn;
        }
        const unsigned T = lo;
        const bool g0 = u0 > T, g1 = u1 > T, g2 = u2 > T, g3 = u3 > T, q0 = u0 == T, q1 = u1 == T, q2 = u2 == T, q3 = u3 == T;
        const unsigned long long bg0 = __ballot(g0), bg1 = __ballot(g1), bg2 = __ballot(g2), bg3 = __ballot(g3), bq0 = __ballot(q0), bq1 = __ballot(q1), bq2 = __ballot(q2), bq3 = __ballot(q3);
        const unsigned long long below = (lane == 0) ? 0ull : (~0ull >> (64 - lane));
        int pg = __builtin_popcountll(bg0 & below) + __builtin_popcountll(bg1 & below) + __builtin_popcountll(bg2 & below) + __builtin_popcountll(bg3 & below);
        int pq = __builtin_popcountll(bq0 & below) + __builtin_popcountll(bq1 & below) + __builtin_popcountll(bq2 & below) + __builtin_popcountll(bq3 & below);
        const int wg = __builtin_popcountll(bg0) + __builtin_popcountll(bg1) + __builtin_popcountll(bg2) + __builtin_popcountll(bg3);
        const int wq = __builtin_popcountll(bq0) + __builtin_popcountll(bq1) + __builtin_popcountll(bq2) + __builtin_popcountll(bq3);
        if (lane == 0) { part[16 + w] = wg; part[32 + w] = wq; }
        __syncthreads();
        int gtc = 0, baseg = 0, baseq = 0;
#pragma unroll
        for (int i = 0; i < 8; ++i) { const int x = part[16 + i], y = part[32 + i]; gtc += x; if (i < w) { baseg += x; baseq += y; } }
        const int need = CAP - gtc;
        pg += baseg; pq += baseq;
        if ((w >> 1) == q) {
            const bool gs[4] = {g0, g1, g2, g3}, qs[4] = {q0, q1, q2, q3}; const float av[4] = {a4.x, a4.y, a4.z, a4.w};
            int cg_ = pg, cq_ = pq;
#pragma unroll
            for (int i = 0; i < 4; ++i) {
                const int t = 4 * tid + i, m = b * SEQ + t; int slot = -1;
                if (gs[i]) { slot = cg_; ++cg_; } else if (qs[i]) { if (cq_ < need) slot = gtc + cq_; ++cq_; }
                SLOT[m * 16 + e] = slot;
                if (slot >= 0) { GATEX[(e * 4 + b) * CAP + slot] = av[i]; XEIDX[(e * 4 + b) * CAP + slot] = m; }
            }
        }
    }
}

__device__ __forceinline__ void p11_final(Frame& F) {
    const bf16_t* X1 = WSP(F, WS_X1, bf16_t); const unsigned char* YE = WSP(F, WS_YE, unsigned char); const int* SLOT = WSP(F, WS_SLOT, int); const float* nw = INP(F, 27, float);
    float* out = F.a->out;
    const int lane = F.lane, gw = F.vcu * 8 + F.wave, NGW = F.G * 8;
    for (int mA = gw; mA < MTOK; mA += 2 * NGW) {
        const int mB = mA + NGW; const bool hasB = mB < MTOK; const int mBc = hasB ? mB : mA;
        int slA = (lane < 16) ? SLOT[mA * 16 + lane] : -1, slB = (lane < 16 && hasB) ? SLOT[mBc * 16 + lane] : -1;
        u32x4 xa[4], xb[4];
        { const u32x4* xr = (const u32x4*)(X1 + (size_t)mA * DM + lane * 8); const u32x4* xs = (const u32x4*)(X1 + (size_t)mBc * DM + lane * 8);
#pragma unroll
          for (int j = 0; j < 4; ++j) { xa[j] = xr[64 * j]; xb[j] = xs[64 * j]; } }
        unsigned mkA = (unsigned)(__ballot(slA >= 0) & 0xFFFFull), mkB = (unsigned)(__ballot(slB >= 0) & 0xFFFFull);
        float va[32], vb[32];
#pragma unroll
        for (int j = 0; j < 4; ++j) { const u32x4 a = xa[j], c = xb[j];
            va[8 * j] = bf_lo(a.x); va[8 * j + 1] = bf_hi(a.x); va[8 * j + 2] = bf_lo(a.y); va[8 * j + 3] = bf_hi(a.y); va[8 * j + 4] = bf_lo(a.z); va[8 * j + 5] = bf_hi(a.z); va[8 * j + 6] = bf_lo(a.w); va[8 * j + 7] = bf_hi(a.w);
            vb[8 * j] = bf_lo(c.x); vb[8 * j + 1] = bf_hi(c.x); vb[8 * j + 2] = bf_lo(c.y); vb[8 * j + 3] = bf_hi(c.y); vb[8 * j + 4] = bf_lo(c.z); vb[8 * j + 5] = bf_hi(c.z); vb[8 * j + 6] = bf_lo(c.w); vb[8 * j + 7] = bf_hi(c.w); }
        const int bA = mA >> 11, bB = mBc >> 11;
        while (mkA | mkB) {
            u32x2 ra[2][4], rb[2][4];
#pragma unroll
            for (int q = 0; q < 2; ++q) {
                if (mkA) { const int e = __builtin_ctz(mkA); mkA &= mkA - 1u; const int sl = __builtin_amdgcn_readlane(slA, e);
                    const u32x2* yr = (const u32x2*)(YE + (size_t)((e * 4 + bA) * CAP + sl) * DM + lane * 8);
#pragma unroll
                    for (int j = 0; j < 4; ++j) ra[q][j] = yr[64 * j]; }
                else {
#pragma unroll
                    for (int j = 0; j < 4; ++j) ra[q][j] = (u32x2){0u, 0u}; }
                if (mkB) { const int e = __builtin_ctz(mkB); mkB &= mkB - 1u; const int sl = __builtin_amdgcn_readlane(slB, e);
                    const u32x2* yr = (const u32x2*)(YE + (size_t)((e * 4 + bB) * CAP + sl) * DM + lane * 8);
#pragma unroll
                    for (int j = 0; j < 4; ++j) rb[q][j] = yr[64 * j]; }
                else {
#pragma unroll
                    for (int j = 0; j < 4; ++j) rb[q][j] = (u32x2){0u, 0u}; }
            }
#define P11_ACC(V_, W_, q_) do { V_[8 * j + (q_)] += __builtin_amdgcn_cvt_f32_fp8(W_.x, q_) * pg8::YE_DESCALE; V_[8 * j + 4 + (q_)] += __builtin_amdgcn_cvt_f32_fp8(W_.y, q_) * pg8::YE_DESCALE; } while (0)
#pragma unroll
            for (int q = 0; q < 2; ++q)
#pragma unroll
                for (int j = 0; j < 4; ++j) { const u32x2 wa = ra[q][j], wb = rb[q][j];
                    P11_ACC(va, wa, 0); P11_ACC(va, wa, 1); P11_ACC(va, wa, 2); P11_ACC(va, wa, 3); P11_ACC(vb, wb, 0); P11_ACC(vb, wb, 1); P11_ACC(vb, wb, 2); P11_ACC(vb, wb, 3); }
#undef P11_ACC
        }
        float sa = 0.f, sb = 0.f;
#pragma unroll
        for (int i = 0; i < 32; ++i) { sa += va[i] * va[i]; sb += vb[i] * vb[i]; }
        const float rsa = 1.f / sqrtf(wave_sum(sa) * (1.f / DM) + 1e-6f), rsb = 1.f / sqrtf(wave_sum(sb) * (1.f / DM) + 1e-6f);
#pragma unroll
        for (int j = 0; j < 4; ++j) { const int col = 512 * j + lane * 8; const f32x4 w0 = *(const f32x4*)(nw + col), w1 = *(const f32x4*)(nw + col + 4);
            { f32x4 o0 = {va[8 * j] * rsa * w0.x, va[8 * j + 1] * rsa * w0.y, va[8 * j + 2] * rsa * w0.z, va[8 * j + 3] * rsa * w0.w};
              f32x4 o1 = {va[8 * j + 4] * rsa * w1.x, va[8 * j + 5] * rsa * w1.y, va[8 * j + 6] * rsa * w1.z, va[8 * j + 7] * rsa * w1.w};
              *(f32x4*)(out + (size_t)mA * DM + col) = o0; *(f32x4*)(out + (size_t)mA * DM + col + 4) = o1; }
            if (hasB) { f32x4 o0 = {vb[8 * j] * rsb * w0.x, vb[8 * j + 1] * rsb * w0.y, vb[8 * j + 2] * rsb * w0.z, vb[8 * j + 3] * rsb * w0.w};
              f32x4 o1 = {vb[8 * j + 4] * rsb * w1.x, vb[8 * j + 5] * rsb * w1.y, vb[8 * j + 6] * rsb * w1.z, vb[8 * j + 7] * rsb * w1.w};
              *(f32x4*)(out + (size_t)mB * DM + col) = o0; *(f32x4*)(out + (size_t)mB * DM + col + 4) = o1; } }
    }
}


template <int PHM> __global__ void __launch_bounds__(512, 2) mk_fwd(Args args) {
    extern __shared__ __attribute__((aligned(16))) unsigned char lds[];
    Frame F;
    F.lds = (LAS unsigned char*)lds; F.ldsg = (char*)lds; F.a = &args;
    F.tid = threadIdx.x; F.lane = F.tid & 63; F.wave = __builtin_amdgcn_readfirstlane(F.tid >> 6);
    F.G = gridDim.x; { const int bx = blockIdx.x; F.vcu = (F.G % 8 == 0) ? (bx % 8) * (F.G / 8) + bx / 8 : bx; }
    volatile LAS unsigned* MISC = (volatile LAS unsigned*)(F.lds + MISC_OFF);
    for (int u = F.tid; u < (LDS_BYTES - 131072) / 4; u += 512) ((LAS unsigned*)(F.lds + 131072))[u] = 0u;
    __syncthreads();
    gu32* ctl = (gu32*)(args.ws + WS_CTL);
    XcdBarrier bar; bar.bar = (unsigned*)(ctl + CW_BAR); bar.x = 0; bar.st = nullptr;
    if (MK_N_LAUNCHES == 1) bar = xcd_barrier_post((unsigned*)(ctl + CW_BAR), MISC + 8);
    const int lo = args.ph_lo, hi = args.ph_hi;
#define IN(k) (((PHM >> (k)) & 1) && lo <= (k) && (k) < hi)
#ifndef DUP_MASK
#define DUP_MASK 0
#endif
#define REP(k) for (int rep_ = 0; rep_ < 1 + ((DUP_MASK >> (k)) & 1); ++rep_)
#define SEAM(k) do { if (IN(k) && IN((k) + 1)) xcd_barrier(bar); } while (0)

    if (IN(0)) REP(0) { p0_prologue(F); }
    SEAM(0);
    if (IN(1)) REP(1) {
        pg8::Gemm g{WSP(F, WS_H1, bf16_t), WSP(F, WS_WIN, bf16_t), MTOK, 6144, DM, DM}; pg8::StaticOrder S; S.init(MTOK, 6144, F.G, (int)blockIdx.x);
        pg8::EpiProj E{WSP(F, WS_PROJ, bf16_t), LDP, WSP(F, WS_ROPE, float), QSCALE};
        pg8::gemm_phase<pg8::EpiProj, pg8::StaticOrder, true, true>(F.lds, g, S, E);
        pg8::Gemm g2{WSP(F, WS_H1, bf16_t), WSP(F, WS_WIN, bf16_t), MTOK, 512, DM / 4, DM}; pg8::TailOrder S2{F.G, (int)blockIdx.x};
        pg8::EpiPart E2{WSP(F, WS_PART, bf16_t)};
        pg8::gemm_phase<pg8::EpiPart, pg8::TailOrder, true, true>(F.lds, g2, S2, E2);
    }
    SEAM(1);
    const bool prep_first = (F.vcu & 1) != 0;
    if (IN(3) && prep_first) { p3_prep(F, 0); }
    if (IN(2)) {
        const bf16_t* P = WSP(F, WS_PROJ, bf16_t); bf16_t* OC = WSP(F, WS_OC, bf16_t);
        for (int u = F.vcu * 2; u < 512; u += F.G * 2)
            for (int i = 0; i < 2; ++i) {
                const int uu = u + i, qb = uu & 7, c = (uu >> 3) & 1, h = (uu >> 4) & 7, b = uu >> 7;
                const size_t m0 = (size_t)b * SEQ;
                att::attn_unit<LDP>(P + (m0 + qb * 256) * LDP + h * 128 + c * 64, P + m0 * LDP + 1024 + h * 128 + c * 64, P + m0 * LDP + 2048 + h * 128,
                                    OC + (size_t)c * MTOK * 1024 + (m0 + qb * 256) * 1024 + h * 128, SEQ, F.ldsg);
            }
    }
    if (IN(3) && !prep_first) { p3_prep(F, 0); }
    SEAM(3);
    #ifndef SCAN_PROBE
#define SCAN_PROBE 0
#endif
    if (IN(4)) REP(4) { p4_scan(F, rep_ ? SCAN_PROBE : 0); }
    SEAM(4);
    if (IN(5)) REP(5) { p5_finalize(F); }
    SEAM(5);
    if (IN(6)) REP(6) {
        pg8::Gemm g{WSP(F, WS_MIX, bf16_t), WSP(F, WS_WOUT, bf16_t), MTOK, DM, DM, DM}; pg8::StaticOrder S; S.init(MTOK, DM, F.G, (int)blockIdx.x);
        pg8::EpiResid E{INP(F, 0, float), WSP(F, WS_X1, bf16_t), DM};
        pg8::gemm_phase<pg8::EpiResid, pg8::StaticOrder, true, true>(F.lds, g, S, E);
    }
    SEAM(6);
    if (IN(7)) REP(7) { p7_router(F); }
    SEAM(7);
    if (IN(8)) REP(8) { p8_select(F); }
    SEAM(8);
    if (IN(9)) REP(9) {
        pg8::Gemm g{WSP(F, WS_H2, bf16_t), WSP(F, WS_WGU, bf16_t), 16384, 65536, DM / 2, DM / 2}; pg8::MoeOrderT<true> S{F.G, F.vcu, 16, 1024, WSP(F, WS_XEIDX, int)};
        pg8::EpiSwiglu E{WSP(F, WS_HID, unsigned char), 16};
        pg8::gemm_phase<pg8::EpiSwiglu, pg8::MoeOrderT<true>, true, true, true>(F.lds, g, S, E);
    }
    SEAM(9);
    if (IN(10)) REP(10) {
        pg8::Gemm g{WSP(F, WS_HID, bf16_t), WSP(F, WS_WD, bf16_t), 16384, 32768, DM / 2, DM / 2}; pg8::MoeOrderT<false> S{F.G, F.vcu, 8, 512, nullptr};
        pg8::EpiDown E{WSP(F, WS_YE, unsigned char), WSP(F, WS_GATEX, float), 8};
        pg8::gemm_phase<pg8::EpiDown, pg8::MoeOrderT<false>, true, true, true>(F.lds, g, S, E);
    }
    SEAM(10);
    if (IN(11)) REP(11) { p11_final(F); }
#undef IN
#undef SEAM
}

static const void* kfn(int li) {
#if MK_N_LAUNCHES == 1
    (void)li; return (const void*)mk_fwd<0xFFF>;
#else
    switch (li) {
        case 0: return (const void*)mk_fwd<1>; case 1: return (const void*)mk_fwd<2>; case 2: return (const void*)mk_fwd<4>; case 3: return (const void*)mk_fwd<8>;
        case 4: return (const void*)mk_fwd<16>; case 5: return (const void*)mk_fwd<32>; case 6: return (const void*)mk_fwd<64>; case 7: return (const void*)mk_fwd<128>;
        case 8: return (const void*)mk_fwd<256>; case 9: return (const void*)mk_fwd<512>; case 10: return (const void*)mk_fwd<1024>; default: return (const void*)mk_fwd<2048>;
    }
#endif
}
extern "C" void kernel_launch(void* const* d_in, const int* in_sizes, int n_in, void* d_out, int out_size, void* d_ws, size_t ws_size, hipStream_t stream) {
    static int grid = 0;
    if (grid == 0) {
        if (n_in != 28 || out_size != MTOK * DM || ws_size < WS_END) { fprintf(stderr, "kernel_launch: unexpected shapes: n_in %d out %d ws %zu (need >= %zu)\n", n_in, out_size, ws_size, (size_t)WS_END); grid = -1; return; }
        int dev = 0, cus = 0, per_cu = 0;
        if (hipGetDevice(&dev) != hipSuccess || hipDeviceGetAttribute(&cus, hipDeviceAttributeMultiprocessorCount, dev) != hipSuccess) { fprintf(stderr, "kernel_launch: device query failed\n"); grid = -1; return; }
        for (int i = 0; i < MK_N_LAUNCHES; ++i) if (hipFuncSetAttribute(kfn(i), hipFuncAttributeMaxDynamicSharedMemorySize, LDS_BYTES) != hipSuccess) { fprintf(stderr, "kernel_launch: hipFuncSetAttribute failed\n"); grid = -1; return; }
        if (hipOccupancyMaxActiveBlocksPerMultiprocessor(&per_cu, kfn(0), 512, LDS_BYTES) != hipSuccess || per_cu < 1) { fprintf(stderr, "kernel_launch: occupancy query says %d blocks/CU\n", per_cu); }
        (void)hipGetLastError();
        grid = cus;
    }
    if (grid < 0) return;
    if (hipMemsetAsync((char*)d_ws + WS_CTL, 0, CTL_ZERO_BYTES, stream) != hipSuccess) { fprintf(stderr, "kernel_launch: memset failed\n"); return; }
    Args a{};
    for (int i = 0; i < 28; ++i) a.in[i] = d_in[i];
    a.out = (float*)d_out; a.ws = (unsigned char*)d_ws;
    const int nl = MK_N_LAUNCHES;
    for (int li = 0; li < nl; ++li) {
        a.ph_lo = (nl == 1) ? 0 : li; a.ph_hi = (nl == 1) ? N_PHASES : li + 1; a.li = li;
        void* kargs[] = {&a};
        (void)hipLaunchKernel(kfn(li), dim3(grid), dim3(512), kargs, LDS_BYTES, stream);
        const hipError_t le = hipPeekAtLastError();
        if (le != hipSuccess) { fprintf(stderr, "kernel_launch: launch %d failed: %s\n", li, hipGetErrorName(le)); break; }
    }
}
```

```cpp
#include <hip/hip_runtime.h>
#include <hip/hip_bf16.h>
#include <cstdio>
#include <cstdint>

#ifndef MK_N_LAUNCHES
#define MK_N_LAUNCHES 1
#endif
#ifndef CVT_IN_SCAN
#define CVT_IN_SCAN 1
#endif
constexpr int N_PHASES = 12;

constexpr int BATCH = 4, SEQ = 2048, DM = 2048, MTOK = BATCH * SEQ;
constexpr int IN_COLS = 6432, LDP = 6656;
constexpr int ZC0 = 3072;
constexpr int RW = 1024, NH_R = 16, HD_R = 64;
constexpr int NEXP = 16, CAP = 256, FF = 2048;
constexpr float QSCALE = 0.18033688011112042f;

constexpr size_t MiB = 1u << 20;
constexpr size_t WS_CTL = 0, CTL_ZERO_BYTES = 1 * MiB;
constexpr size_t WS_ROPE = 1 * MiB;
constexpr size_t WS_LORA = 2 * MiB;
constexpr size_t WS_AFF = 3 * MiB;
constexpr size_t WS_GATEX = 3 * MiB + 512 * 1024;
constexpr size_t WS_SLOT = 4 * MiB;
constexpr size_t WS_XEIDX = 6 * MiB;
constexpr size_t WS_BONUS = 5 * MiB;
constexpr size_t WS_WIN = 8 * MiB;
constexpr size_t WS_WOUT = 34 * MiB;
constexpr size_t WS_WGU = 48 * MiB;
constexpr size_t WS_WD = 304 * MiB;
constexpr size_t WS_H1 = 432 * MiB;
constexpr size_t WS_PROJ = 464 * MiB;
constexpr size_t WS_R = 568 * MiB, WS_KK = 584 * MiB, WS_V = 600 * MiB;
constexpr size_t WS_WDEC = 616 * MiB;
constexpr size_t WS_KD = 680 * MiB, WS_BB = 712 * MiB;
constexpr size_t WS_G = 744 * MiB;
constexpr size_t WS_OC = 760 * MiB;
constexpr size_t WS_YS = 792 * MiB;
constexpr size_t WS_MIX = 856 * MiB;
constexpr size_t WS_X1 = 888 * MiB;
constexpr size_t WS_H2 = 952 * MiB;
constexpr size_t WS_HID = 528 * MiB, WS_YE = 592 * MiB;
constexpr size_t WS_PART = WS_X1;
constexpr size_t WS_END = 984 * MiB;
constexpr int CW_BAR = 4096;

constexpr int LDS_BYTES = 147456;
constexpr int MISC_OFF = 131072 + 320;

#define GAS __attribute__((address_space(1)))
#define LAS __attribute__((address_space(3)))
typedef unsigned short bf16_t;
typedef float f32x4 __attribute__((ext_vector_type(4)));
typedef float f32x2 __attribute__((ext_vector_type(2)));
typedef float f32x16 __attribute__((ext_vector_type(16)));
typedef unsigned u32x4 __attribute__((ext_vector_type(4)));
typedef unsigned u32x2 __attribute__((ext_vector_type(2)));
typedef short bf16x8 __attribute__((ext_vector_type(8)));
typedef short s16x4 __attribute__((ext_vector_type(4)));
typedef __bf16 bf16x2_t __attribute__((ext_vector_type(2)));

__device__ __forceinline__ unsigned cvtpk(float lo, float hi) { f32x2 v = {lo, hi}; bf16x2_t b = __builtin_convertvector(v, bf16x2_t); return __builtin_bit_cast(unsigned, b); }
__device__ __forceinline__ float bf_lo(unsigned w) { return __uint_as_float(w << 16); }
__device__ __forceinline__ float bf_hi(unsigned w) { return __uint_as_float(w & 0xffff0000u); }
__device__ __forceinline__ float bf2f(bf16_t v) { return __uint_as_float((unsigned)v << 16); }
__device__ __forceinline__ float wave_sum(float v) {
#pragma unroll
    for (int o = 1; o < 64; o <<= 1) v += __shfl_xor(v, o);
    return v;
}
__device__ __forceinline__ float sigmoidf_(float x) { return 1.f / (1.f + __expf(-x)); }

struct Args { const void* in[28]; float* out; unsigned char* ws; int ph_lo, ph_hi, li, pad; };

namespace pg8 {
#define PG8_LAS __attribute__((address_space(3)))
typedef unsigned short bf16_t;
typedef short bf16x8 __attribute__((ext_vector_type(8)));
typedef float f32x4 __attribute__((ext_vector_type(4)));
typedef unsigned u32x4 __attribute__((ext_vector_type(4)));
typedef unsigned u32x2 __attribute__((ext_vector_type(2)));
typedef int i32x4 __attribute__((ext_vector_type(4)));
typedef int i32x8 __attribute__((ext_vector_type(8)));
typedef float f32x8 __attribute__((ext_vector_type(8)));
typedef float f32x32 __attribute__((ext_vector_type(32)));
__device__ __forceinline__ void st_wt16(void* p, u32x4 v) { asm volatile("global_store_dwordx4 %0, %1, off sc1\n\ts_nop 1" :: "v"(p), "v"(v) : "memory"); }
__device__ __forceinline__ void st_wt8(void* p, u32x2 v) { asm volatile("global_store_dwordx2 %0, %1, off sc1\n\ts_nop 1" :: "v"(p), "v"(v) : "memory"); }
constexpr int BM = 256, BK = 64, HALF = 128, HTB = HALF * BK * 2  , STAGE_BYTES = 8 * HTB, NXCD = 8, WGM = 8;

__host__ __device__ __forceinline__ int lds_byte(int r, int c) { const int st = (r >> 4) * 2 + (c >> 5), rr = r & 15, cc = c & 31, ob = rr * 64 + cc * 2; return st * 1024 + (ob ^ (((ob >> 9) & 1) << 5)); }
__host__ __device__ __forceinline__ void stage_rc(int b, int& R, int& C) { const int st = b / 1024, sb = b % 1024, swz = sb ^ (((sb >> 9) & 1) << 5); R = (st >> 1) * 16 + swz / 64; C = (st & 1) * 32 + (swz % 64) / 2; }
__host__ __device__ __forceinline__ int perm32(int rho) { const int n = rho >> 4, i = rho & 15; return 8 * (i >> 2) + 4 * n + (i & 3); }

struct Unit { int pm, pn, pk; };
struct Gemm { const bf16_t* A; const bf16_t* Bt; int M, N, K, Kp; };

struct StaticOrder {
    int nM, nN, nwg, G, c;
    __host__ __device__ void init(int M, int N, int G_, int c_) { nM = M / BM; nN = N / BM; nwg = nM * nN; G = G_; c = c_; }
    __host__ __device__ bool next(int i, Unit& u) const {
        const long L = (long)i * G + c; if (L >= nwg) return false;
        int wgid = (int)L; { const int q = nwg / NXCD, r = nwg % NXCD, xcd = wgid % NXCD, off = wgid / NXCD; wgid = (xcd < r ? xcd * (q + 1) : r * (q + 1) + (xcd - r) * q) + off; }
        const int nig = WGM * nN, gid = wgid / nig, fm = gid * WGM, gsz = (nM - fm) < WGM ? (nM - fm) : WGM;
        u.pm = fm + ((wgid % nig) % gsz); u.pn = (wgid % nig) / gsz; u.pk = 0; return true;
    }
    static constexpr bool GATHER = false;
    __device__ __forceinline__ int arow(const Unit&, int) const { return 0; }
    __device__ __forceinline__ void a_ready(const Unit&) const {}
    __device__ __forceinline__ void done(const Unit&) const {}
};


typedef float f32x2 __attribute__((ext_vector_type(2)));
typedef __bf16 bf16x2_t __attribute__((ext_vector_type(2)));
__device__ __forceinline__ unsigned cvt_pk_bf16(float lo, float hi) { f32x2 v = {lo, hi}; bf16x2_t b = __builtin_convertvector(v, bf16x2_t); return __builtin_bit_cast(unsigned, b); }

template <bool GATHER_> struct MoeOrderT {
    static constexpr bool GATHER = GATHER_;
    int G, vcu, npn, total; const int* idx;
    __device__ __forceinline__ int arow(const Unit& u, int r) const { return idx[u.pm * BM + r]; }
    __device__ bool next(int i, Unit& u) const {
        const int L = i * G + vcu; if (L >= total) return false;
        const int per_e = 4 * npn, e = L / per_e, r = L % per_e;
        u.pm = e * 4 + (r & 3); u.pn = e * npn + (r >> 2); u.pk = 0; return true;
    }
    __device__ __forceinline__ void a_ready(const Unit&) const {}
    __device__ __forceinline__ void done(const Unit&) const {}
};

struct TailOrder {
    int G, c; static constexpr bool GATHER = false;
    __device__ bool next(int i, Unit& u) const { const int L = i * G + c; if (L >= 256) return false; u.pk = L & 3; const int t = L >> 2; u.pm = t & 31; u.pn = 24 + (t >> 5); return true; }
    __device__ __forceinline__ int arow(const Unit&, int) const { return 0; }
    __device__ __forceinline__ void a_ready(const Unit&) const {}
    __device__ __forceinline__ void done(const Unit&) const {}
};
struct EpiPart {
    static constexpr bool PERM = true, AFTER_DRAIN = false;
    bf16_t* P;
    __device__ __forceinline__ void operator()(const f32x4 (&acc)[2][2][4][2], const Unit& u, int wr, int wc, int fr, int fq) const {
        bf16_t* base = P + ((size_t)(((u.pn - 24) * 32 + u.pm) * 4 + u.pk) << 16);
        const int row0 = wr * 64 + fr, col0 = wc * 32 + 8 * fq;
        const bool thin = (u.pn == 25);
        if (thin && wc != 0) return;
#pragma unroll
        for (int ai = 0; ai < 2; ++ai)
#pragma unroll
            for (int m = 0; m < 4; ++m) {
                bf16_t* rowp = base + (row0 + ai * HALF + m * 16) * 256 + col0;
#pragma unroll
                for (int bj = 0; bj < 2; ++bj) { if (bj == 1 && thin) break; const f32x4 v0 = acc[ai][bj][m][0], v1 = acc[ai][bj][m][1];
                    u32x4 w; w.x = cvt_pk_bf16(v0[0], v0[1]); w.y = cvt_pk_bf16(v0[2], v0[3]); w.z = cvt_pk_bf16(v1[0], v1[1]); w.w = cvt_pk_bf16(v1[2], v1[3]);
                    *(u32x4*)(rowp + bj * HALF) = w; }
            }
    }
};

struct EpiProj {
    static constexpr bool PERM = true, AFTER_DRAIN = false;
    bf16_t* P; int ldp; const float* rope; float qscale;
    __device__ __forceinline__ void operator()(const f32x4 (&acc)[2][2][4][2], const Unit& u, int wr, int wc, int fr, int fq) const {
        const int row0 = u.pm * BM + wr * 64 + fr, colt = u.pn * BM, col0 = colt + wc * 32 + 8 * fq;
        const bool ropew = (colt < 2048) && ((wc & 1) == 0);
        const float sc = (colt < 1024) ? qscale : 1.f, sgn = (fq == 0) ? -1.f : 1.f;
#pragma unroll
        for (int ai = 0; ai < 2; ++ai)
#pragma unroll
            for (int m = 0; m < 4; ++m) {
                const int row = row0 + ai * HALF + m * 16;
                f32x4 c0 = {1.f, 1.f, 1.f, 1.f}, c1 = c0, s0 = {0.f, 0.f, 0.f, 0.f}, s1 = s0;
                if (ropew) { const f32x4* rp = (const f32x4*)(rope + (size_t)row * 16); c0 = rp[0]; c1 = rp[1]; s0 = rp[2]; s1 = rp[3]; }
                bf16_t* rowp = P + (size_t)row * ldp + col0;
#pragma unroll
                for (int bj = 0; bj < 2; ++bj) {
                    f32x4 v0 = acc[ai][bj][m][0], v1 = acc[ai][bj][m][1];
                    if (ropew) {
                        f32x4 p0, p1;
#pragma unroll
                        for (int i = 0; i < 4; ++i) { p0[i] = __shfl_xor(v0[i], 16); p1[i] = __shfl_xor(v1[i], 16); }
                        if (fq < 2) { v0 = v0 * c0 + (p0 * s0) * sgn; v1 = v1 * c1 + (p1 * s1) * sgn; }
                    }
                    v0 = v0 * sc; v1 = v1 * sc;
                    u32x4 w; w.x = cvt_pk_bf16(v0[0], v0[1]); w.y = cvt_pk_bf16(v0[2], v0[3]); w.z = cvt_pk_bf16(v1[0], v1[1]); w.w = cvt_pk_bf16(v1[2], v1[3]);
                    *(u32x4*)(rowp + bj * HALF) = w;
                }
            }
    }
};

struct EpiResid {
    static constexpr bool PERM = true, AFTER_DRAIN = false;
    const float* base; bf16_t* out; int ldc;
    __device__ __forceinline__ void operator()(const f32x4 (&acc)[2][2][4][2], const Unit& u, int wr, int wc, int fr, int fq) const {
        const int row0 = u.pm * BM + wr * 64 + fr, col0 = u.pn * BM + wc * 32 + 8 * fq;
#pragma unroll
        for (int ai = 0; ai < 2; ++ai)
#pragma unroll
            for (int m = 0; m < 4; ++m) {
                const size_t off = (size_t)(row0 + ai * HALF + m * 16) * ldc + col0;
#pragma unroll
                for (int bj = 0; bj < 2; ++bj) { const f32x4 b0 = *(const f32x4*)(base + off + bj * HALF), b1 = *(const f32x4*)(base + off + bj * HALF + 4);
                    const f32x4 v0 = b0 + acc[ai][bj][m][0], v1 = b1 + acc[ai][bj][m][1];
                    u32x4 w; w.x = cvt_pk_bf16(v0[0], v0[1]); w.y = cvt_pk_bf16(v0[2], v0[3]); w.z = cvt_pk_bf16(v1[0], v1[1]); w.w = cvt_pk_bf16(v1[2], v1[3]);
                    st_wt16(out + off + bj * HALF, w); }
            }
    }
};

__device__ __forceinline__ float clamp8(float x) { return __builtin_fminf(__builtin_fmaxf(x, -448.f), 448.f); }
__device__ __forceinline__ unsigned cvt4_fp8(float a, float b, float c, float d) {
    int w = __builtin_amdgcn_cvt_pk_fp8_f32(clamp8(a), clamp8(b), 0, false); w = __builtin_amdgcn_cvt_pk_fp8_f32(clamp8(c), clamp8(d), w, true); return (unsigned)w; }
constexpr float W8_SCALE = 64.f, W8_DESCALE = 1.f / 64.f;

struct EpiSwiglu {
    static constexpr bool PERM = true, AFTER_DRAIN = false;
    unsigned char* H; int npn;
    __device__ __forceinline__ void operator()(const f32x4 (&acc)[2][2][4][2], const Unit& u, int wr, int wc, int fr, int fq) const {
        const int row0 = u.pm * BM + wr * 64 + fr, pnl = u.pn % npn, col0 = pnl * HALF + wc * 32 + 8 * fq;
#pragma unroll
        for (int ai = 0; ai < 2; ++ai)
#pragma unroll
            for (int m = 0; m < 4; ++m) {
                unsigned char* rowp = H + (size_t)(row0 + ai * HALF + m * 16) * 2048 + col0;
                float h[8];
#pragma unroll
                for (int n = 0; n < 2; ++n)
#pragma unroll
                    for (int i = 0; i < 4; ++i) { const float g = acc[ai][0][m][n][i] * W8_DESCALE, up = acc[ai][1][m][n][i] * W8_DESCALE; h[n * 4 + i] = g * up * __builtin_amdgcn_rcpf(1.f + __expf(-g)); }
                u32x2 w; w.x = cvt4_fp8(h[0], h[1], h[2], h[3]); w.y = cvt4_fp8(h[4], h[5], h[6], h[7]);
                *(u32x2*)rowp = w;
            }
    }
};

constexpr float YE_SCALE = 16.f, YE_DESCALE = 1.f / 16.f;
struct EpiDown {
    static constexpr bool PERM = true, AFTER_DRAIN = false;
    unsigned char* Y; const float* gate; int npn;
    __device__ __forceinline__ void operator()(const f32x4 (&acc)[2][2][4][2], const Unit& u, int wr, int wc, int fr, int fq) const {
        const int row0 = u.pm * BM + wr * 64 + fr, pnl = u.pn % npn, col0 = pnl * BM + wc * 32 + 8 * fq;
#pragma unroll
        for (int ai = 0; ai < 2; ++ai)
#pragma unroll
            for (int m = 0; m < 4; ++m) {
                const int row = row0 + ai * HALF + m * 16; const float gt = gate[row] * (W8_DESCALE * YE_SCALE);
                unsigned char* rowp = Y + (size_t)row * 2048 + col0;
#pragma unroll
                for (int bj = 0; bj < 2; ++bj) { const f32x4 v0 = acc[ai][bj][m][0] * gt, v1 = acc[ai][bj][m][1] * gt;
                    u32x2 w; w.x = cvt4_fp8(v0[0], v0[1], v0[2], v0[3]); w.y = cvt4_fp8(v1[0], v1[1], v1[2], v1[3]);
                    *(u32x2*)(rowp + bj * HALF) = w; }
            }
    }
};

template <class Epi, class Sched, bool ALIGN_EPI = false, bool SP2 = false, bool FP8 = false>
__device__ __forceinline__ void gemm_phase(PG8_LAS unsigned char* lds, const Gemm g, const Sched& S, const Epi& E) {
    const int tid = threadIdx.x, wid = __builtin_amdgcn_readfirstlane(tid >> 6), lane = tid & 63, wr = wid >> 2, wc = wid & 3, fr = lane & 15, fq = lane >> 4;
    const int K = g.Kp, nt = g.K / BK;
    const size_t kslice = (size_t)g.K * 2;
    unsigned voffA[2], voffB[2];
#pragma unroll
    for (int i = 0; i < 2; ++i) { int R, C; stage_rc(tid * 16 + i * 8192, R, C); const int Rb = Epi::PERM ? ((R & ~31) + perm32(R & 31)) : R;
        voffA[i] = (unsigned)(R * K + C) * 2u; voffB[i] = (unsigned)(Rb * K + C) * 2u; }
    static_assert(!Sched::GATHER || SP2, "gathered A rows: SP2 loop only");
    const size_t kstep = (size_t)(BK * 2);
    const size_t hstep = (size_t)HALF * K * 2;
    const size_t tstep = 2 * hstep;
    const unsigned ldsw = (unsigned)wid * 1024u;
    const int aoff = lds_byte(wr * 64 + fr, fq * 8), boff = lds_byte(wc * 32 + fr, fq * 8);
#define PG8_SA(b, h) (((b) * 2 + (h)) * HTB)
#define PG8_SB(b, h) ((4 + (b) * 2 + (h)) * HTB)
#define PG8_STAGE(bufoff, gbase, voff) do { _Pragma("unroll") for (int _i = 0; _i < 2; ++_i) \
        __builtin_amdgcn_global_load_lds((const unsigned*)((const char*)(gbase) + (voff)[_i]), (PG8_LAS unsigned*)(lds + (bufoff) + ldsw + _i * 8192), 16, 0, 0); } while (0)
#define PG8_LDA(dst, b, h) do { _Pragma("unroll") for (int m = 0; m < 4; ++m) _Pragma("unroll") for (int k = 0; k < 2; ++k) dst[m][k] = *(const PG8_LAS bf16x8*)(lds + PG8_SA(b, h) + aoff + m * 2048 + k * 1024); } while (0)
#define PG8_LDB(dst, b, h) do { _Pragma("unroll") for (int n = 0; n < 2; ++n) _Pragma("unroll") for (int k = 0; k < 2; ++k) dst[n][k] = *(const PG8_LAS bf16x8*)(lds + PG8_SB(b, h) + boff + n * 2048 + k * 1024); } while (0)
#define PG8_CAT8(x, y) __builtin_shufflevector(__builtin_bit_cast(i32x4, x), __builtin_bit_cast(i32x4, y), 0, 1, 2, 3, 4, 5, 6, 7)
#define PG8_W8(c) __builtin_shufflevector(c, c, 0, 1, 2, 3, -1, -1, -1, -1)
#define PG8_MMA(ai, bj, At, Bt) do { __builtin_amdgcn_s_setprio(1); \
        if constexpr (FP8) { f32x32 a_ = acc32[ai][bj]; _Pragma("unroll") for (int m = 0; m < 4; ++m) _Pragma("unroll") for (int n = 0; n < 2; ++n) { \
            f32x4 c_ = {a_[(m * 2 + n) * 4], a_[(m * 2 + n) * 4 + 1], a_[(m * 2 + n) * 4 + 2], a_[(m * 2 + n) * 4 + 3]}; \
            c_ = __builtin_amdgcn_mfma_scale_f32_16x16x128_f8f6f4(PG8_CAT8(Bt[n][0], Bt[n][1]), PG8_CAT8(At[m][0], At[m][1]), c_, 0, 0, 0, 0, 0, 0); \
            a_[(m * 2 + n) * 4] = c_[0]; a_[(m * 2 + n) * 4 + 1] = c_[1]; a_[(m * 2 + n) * 4 + 2] = c_[2]; a_[(m * 2 + n) * 4 + 3] = c_[3]; } acc32[ai][bj] = a_; } \
        else { _Pragma("unroll") for (int m = 0; m < 4; ++m) _Pragma("unroll") for (int n = 0; n < 2; ++n) _Pragma("unroll") for (int k = 0; k < 2; ++k) \
            acc[ai][bj][m][n] = __builtin_amdgcn_mfma_f32_16x16x32_bf16(Bt[n][k], At[m][k], acc[ai][bj][m][n], 0, 0, 0); } __builtin_amdgcn_s_setprio(0); } while (0)
#define PG8_WAIT_V(n) asm volatile("s_waitcnt vmcnt(" #n ")" ::: "memory")
#define PG8_WAIT_L(n) asm volatile("s_waitcnt lgkmcnt(" #n ")" ::: "memory")
#define PG8_BAR __builtin_amdgcn_s_barrier()
#define PG8_SCHED __builtin_amdgcn_sched_barrier(0)
    Unit cur, nxt; int ui = 0;
    if (!S.next(0, cur)) return;
    f32x4 acc[2][2][4][2]; f32x32 acc32[2][2];
#pragma unroll
    for (int a = 0; a < 2; ++a)
#pragma unroll
        for (int b = 0; b < 2; ++b)
#pragma unroll
            for (int m = 0; m < 4; ++m) {
#pragma unroll
                for (int n = 0; n < 2; ++n) { acc[a][b][m][n] = (f32x4){0.f, 0.f, 0.f, 0.f};
#pragma unroll
                    for (int i = 0; i < 4; ++i) acc32[a][b][(m * 2 + n) * 4 + i] = 0.f; } }
    bf16x8 At[4][2], B0[2][2], B1[2][2];
    const char* cA = (const char*)g.A + (size_t)cur.pm * tstep + (size_t)cur.pk * kslice; const char* cB = (const char*)g.Bt + (size_t)cur.pn * tstep + (size_t)cur.pk * kslice;
    unsigned cvA0[2], cvA1[2], nvA0[2], nvA1[2];
#pragma unroll
    for (int i = 0; i < 2; ++i) { int R, C; stage_rc(tid * 16 + i * 8192, R, C);
        if constexpr (Sched::GATHER) { cvA0[i] = (unsigned)(S.arow(cur, R) * K + C) * 2u; cvA1[i] = (unsigned)(S.arow(cur, HALF + R) * K + C) * 2u; }
        else { cvA0[i] = voffA[i]; cvA1[i] = voffA[i] + (unsigned)hstep; }
        nvA0[i] = cvA0[i]; nvA1[i] = cvA1[i]; }
    if constexpr (Sched::GATHER) cA = (const char*)g.A;
    S.a_ready(cur);
    if constexpr (SP2) {
        PG8_STAGE(PG8_SB(0, 0), cB, voffB); PG8_STAGE(PG8_SB(0, 1), cB + hstep, voffB); PG8_STAGE(PG8_SA(0, 0), cA, cvA0); PG8_STAGE(PG8_SA(0, 1), cA, cvA1);
        if (wr == 1) PG8_BAR;
        PG8_WAIT_V(2); PG8_BAR;
        PG8_STAGE(PG8_SB(1, 0), cB + kstep, voffB); PG8_STAGE(PG8_SA(1, 0), cA + kstep, cvA0); PG8_STAGE(PG8_SB(1, 1), cB + hstep + kstep, voffB);
        PG8_WAIT_V(6); PG8_BAR;
    } else {
        PG8_STAGE(PG8_SB(0, 0), cB, voffB); PG8_STAGE(PG8_SA(0, 0), cA, voffA); PG8_STAGE(PG8_SB(0, 1), cB + hstep, voffB); PG8_STAGE(PG8_SA(0, 1), cA + hstep, voffA);
        if (wr == 1) PG8_BAR;
        PG8_WAIT_V(4); PG8_BAR;
        PG8_STAGE(PG8_SB(1, 0), cB + kstep, voffB); PG8_STAGE(PG8_SA(1, 0), cA + kstep, voffA); PG8_STAGE(PG8_SB(1, 1), cB + hstep + kstep, voffB);
        PG8_WAIT_V(6); PG8_BAR;
    }
    for (;;) {
        const bool has_next = S.next(ui + 1, nxt);
        const char* nA = Sched::GATHER ? (const char*)g.A : (has_next ? (const char*)g.A + (size_t)nxt.pm * tstep + (size_t)nxt.pk * kslice : cA);
        if constexpr (Sched::GATHER) { if (has_next) {
#pragma unroll
            for (int i = 0; i < 2; ++i) { int R, C; stage_rc(tid * 16 + i * 8192, R, C); nvA0[i] = (unsigned)(S.arow(nxt, R) * K + C) * 2u; nvA1[i] = (unsigned)(S.arow(nxt, HALF + R) * K + C) * 2u; } } } const char* nB = has_next ? (const char*)g.Bt + (size_t)nxt.pn * tstep + (size_t)nxt.pk * kslice : cB;
        for (int t = 0; t < nt; t += 2) {
            const bool last = (t == nt - 2);
            const char* a1 = cA + (size_t)(t + 1) * kstep;
            const char* a2 = last ? nA : cA + (size_t)(t + 2) * kstep; const char* b2 = last ? nB : cB + (size_t)(t + 2) * kstep;
            const char* a3 = a2 + kstep; const char* b3 = b2 + kstep;
            if (last && has_next) S.a_ready(nxt);
            unsigned sA0[2], sA1[2];
#pragma unroll
            for (int i = 0; i < 2; ++i) { sA0[i] = last ? nvA0[i] : cvA0[i]; sA1[i] = last ? nvA1[i] : cvA1[i]; }
            if constexpr (SP2) {
            PG8_LDB(B0, 0, 0); PG8_LDB(B1, 0, 1); PG8_SCHED; PG8_LDA(At, 0, 0); PG8_STAGE(PG8_SA(1, 1), a1, cvA1);
            PG8_WAIT_V(8); PG8_WAIT_L(0); PG8_BAR; PG8_MMA(0, 0, At, B0); PG8_MMA(0, 1, At, B1); PG8_BAR; PG8_SCHED;
            PG8_LDA(At, 0, 1); PG8_STAGE(PG8_SB(0, 0), b2, voffB); PG8_STAGE(PG8_SB(0, 1), b2 + hstep, voffB); PG8_STAGE(PG8_SA(0, 0), a2, sA0);
            PG8_WAIT_V(8); PG8_WAIT_L(0); PG8_BAR; PG8_MMA(1, 0, At, B0); PG8_MMA(1, 1, At, B1); PG8_BAR; PG8_SCHED;
            PG8_LDB(B0, 1, 0); PG8_LDB(B1, 1, 1); PG8_SCHED; PG8_LDA(At, 1, 0); PG8_STAGE(PG8_SA(0, 1), a2, sA1);
            PG8_WAIT_V(8); PG8_WAIT_L(0); PG8_BAR; PG8_MMA(0, 0, At, B0); PG8_MMA(0, 1, At, B1); PG8_BAR; PG8_SCHED;
            PG8_LDA(At, 1, 1); PG8_STAGE(PG8_SB(1, 0), b3, voffB); PG8_STAGE(PG8_SB(1, 1), b3 + hstep, voffB); PG8_STAGE(PG8_SA(1, 0), a3, sA0);
            PG8_WAIT_V(8); PG8_WAIT_L(0); PG8_BAR; PG8_MMA(1, 0, At, B0); PG8_MMA(1, 1, At, B1); PG8_BAR; PG8_SCHED;
            } else {
            PG8_LDB(B0, 0, 0); PG8_SCHED; PG8_LDA(At, 0, 0); PG8_STAGE(PG8_SA(1, 1), a1 + hstep, voffA);
            PG8_WAIT_L(8); PG8_BAR; PG8_WAIT_L(0); PG8_MMA(0, 0, At, B0); PG8_BAR; PG8_SCHED;
            PG8_LDB(B1, 0, 1); PG8_STAGE(PG8_SB(0, 0), b2, voffB);
            PG8_BAR; PG8_WAIT_L(0); PG8_MMA(0, 1, At, B1); PG8_BAR;
            PG8_LDA(At, 0, 1); PG8_STAGE(PG8_SA(0, 0), a2, voffA);
            PG8_BAR; PG8_WAIT_L(0); PG8_MMA(1, 0, At, B0); PG8_BAR; PG8_SCHED;
            PG8_STAGE(PG8_SB(0, 1), b2 + hstep, voffB);
            PG8_WAIT_V(6); PG8_BAR; PG8_MMA(1, 1, At, B1); PG8_BAR;
            PG8_LDB(B0, 1, 0); PG8_SCHED; PG8_LDA(At, 1, 0); PG8_STAGE(PG8_SA(0, 1), a2 + hstep, voffA);
            PG8_WAIT_L(8); PG8_BAR; PG8_WAIT_L(0); PG8_MMA(0, 0, At, B0); PG8_BAR; PG8_SCHED;
            PG8_LDB(B1, 1, 1); PG8_STAGE(PG8_SB(1, 0), b3, voffB);
            PG8_BAR; PG8_WAIT_L(0); PG8_MMA(0, 1, At, B1); PG8_BAR;
            PG8_LDA(At, 1, 1); PG8_STAGE(PG8_SA(1, 0), a3, voffA);
            PG8_BAR; PG8_WAIT_L(0); PG8_MMA(1, 0, At, B0); PG8_BAR; PG8_SCHED;
            PG8_STAGE(PG8_SB(1, 1), b3 + hstep, voffB);
            PG8_WAIT_V(6); PG8_BAR; PG8_MMA(1, 1, At, B1); PG8_BAR;
            }
        }
        if constexpr (ALIGN_EPI) { if (wr == 0) PG8_BAR; }
        if constexpr (FP8) {
#pragma unroll
            for (int a = 0; a < 2; ++a)
#pragma unroll
                for (int b = 0; b < 2; ++b)
#pragma unroll
                    for (int m = 0; m < 4; ++m)
#pragma unroll
                        for (int n = 0; n < 2; ++n)
#pragma unroll
                            for (int i = 0; i < 4; ++i) acc[a][b][m][n][i] = acc32[a][b][(m * 2 + n) * 4 + i]; }
        if constexpr (!Epi::AFTER_DRAIN) { E(acc, cur, wr, wc, fr, fq); S.done(cur); }
        if (!has_next) break;
#pragma unroll
        for (int a = 0; a < 2; ++a)
#pragma unroll
            for (int b = 0; b < 2; ++b)
#pragma unroll
                for (int m = 0; m < 4; ++m) {
#pragma unroll
                    for (int n = 0; n < 2; ++n) { acc[a][b][m][n] = (f32x4){0.f, 0.f, 0.f, 0.f};
#pragma unroll
                        for (int i = 0; i < 4; ++i) acc32[a][b][(m * 2 + n) * 4 + i] = 0.f; } }
        cur = nxt; cA = nA; cB = nB; ++ui;
#pragma unroll
        for (int i = 0; i < 2; ++i) { cvA0[i] = nvA0[i]; cvA1[i] = nvA1[i]; }
        if constexpr (ALIGN_EPI) { if (wr == 1) PG8_BAR; }
    }
    PG8_WAIT_V(0);
    if constexpr (!ALIGN_EPI) { if (wr == 0) PG8_BAR; }
    PG8_BAR;
    if constexpr (Epi::AFTER_DRAIN) { E.fused(acc, cur, wr, wc, fr, fq, lds, wid, lane); S.done(cur); }
#undef PG8_SA
#undef PG8_SB
#undef PG8_STAGE
#undef PG8_LDA
#undef PG8_LDB
#undef PG8_MMA
#undef PG8_CAT8
#undef PG8_W8
#undef PG8_WAIT_V
#undef PG8_WAIT_L
#undef PG8_BAR
#undef PG8_SCHED
}
}

namespace att {
constexpr int NW = 8, QBLK = 32, KVBLK = 64;
constexpr float THR = 8.f;
constexpr int SHM_V = KVBLK * 128 * 2, SHM_K = KVBLK * 64 * 2;
constexpr int SHM_ATTN = 2 * SHM_V + 2 * SHM_K + NW * 64 * 4;
#define KSWZ64(row, colB) ((row) * 128 + ((colB) ^ ((((row) >> 1) & 7) << 4)))
#define SBAR() __builtin_amdgcn_sched_barrier(0)
__device__ __forceinline__ int crow(int r, int hi) { return (r & 3) + 8 * (r >> 2) + 4 * hi; }

__device__ __forceinline__ void partialSM(f32x16& p0, f32x16& p1, float& m_reg, float& mn, float& alpha) {
  float pmax = p0[0];
#pragma unroll
  for (int r = 1; r < 16; ++r) pmax = fmaxf(pmax, p0[r]);
#pragma unroll
  for (int r = 0; r < 16; ++r) pmax = fmaxf(pmax, p1[r]);
  { auto rr = __builtin_amdgcn_permlane32_swap(__float_as_uint(pmax), __float_as_uint(pmax), false, false);
    pmax = fmaxf(__uint_as_float(rr[0]), __uint_as_float(rr[1])); }
  if (__builtin_expect(__all(pmax - m_reg <= THR), 1)) { mn = m_reg; alpha = 1.f; }
  else { mn = fmaxf(m_reg, pmax); alpha = __builtin_amdgcn_exp2f(m_reg - mn); m_reg = mn; }
#pragma unroll
  for (int r = 0; r < 16; ++r) p0[r] = p0[r] - mn;
#pragma unroll
  for (int r = 0; r < 16; ++r) p1[r] = p1[r] - mn;
#pragma unroll
  for (int r = 0; r < 16; ++r) p0[r] = __builtin_amdgcn_exp2f(p0[r]);
}
__device__ __forceinline__ void finishSM(f32x16& p0, f32x16& p1, float alpha, float& l_reg, bf16x8& pa0, bf16x8& pa1, bf16x8& pa2, bf16x8& pa3) {
#pragma unroll
  for (int r = 0; r < 16; ++r) p1[r] = __builtin_amdgcn_exp2f(p1[r]);
  float ps = 0;
#pragma unroll
  for (int r = 0; r < 16; ++r) ps += p0[r];
#pragma unroll
  for (int r = 0; r < 16; ++r) ps += p1[r];
  { auto rr = __builtin_amdgcn_permlane32_swap(__float_as_uint(ps), __float_as_uint(ps), false, false);
    ps = __uint_as_float(rr[0]) + __uint_as_float(rr[1]); }
  l_reg = l_reg * alpha + ps;
#define PK4(P, BASE, OUT) do { unsigned a0 = cvtpk(P[BASE + 0], P[BASE + 1]), a1 = cvtpk(P[BASE + 2], P[BASE + 3]);   \
    unsigned b0 = cvtpk(P[BASE + 4], P[BASE + 5]), b1 = cvtpk(P[BASE + 6], P[BASE + 7]);                              \
    auto r0 = __builtin_amdgcn_permlane32_swap(a0, b0, false, false); auto r1 = __builtin_amdgcn_permlane32_swap(a1, b1, false, false); \
    u32x4 w = {r0[0], r1[0], r0[1], r1[1]}; OUT = __builtin_bit_cast(bf16x8, w); } while (0)
  PK4(p0, 0, pa0); PK4(p0, 8, pa1); PK4(p1, 0, pa2); PK4(p1, 8, pa3);
#undef PK4
}
__device__ __forceinline__ void qkt(f32x16& p0, f32x16& p1, const char* Ks, const bf16x8* qr, int r32, int hi) {
  p0 = f32x16{}; p1 = f32x16{};
#pragma unroll
  for (int d0 = 0; d0 < 4; ++d0) { const int cb = (d0 * 16 + hi * 8) * 2;
    bf16x8 b0 = *reinterpret_cast<const bf16x8*>(Ks + KSWZ64(r32, cb));
    bf16x8 b1 = *reinterpret_cast<const bf16x8*>(Ks + KSWZ64(32 + r32, cb));
    p0 = __builtin_amdgcn_mfma_f32_32x32x16_bf16(b0, qr[d0], p0, 0, 0, 0);
    p1 = __builtin_amdgcn_mfma_f32_32x32x16_bf16(b1, qr[d0], p1, 0, 0, 0); }
}
__device__ __forceinline__ int v_st(int k, int c) { const int kk = (k & ~0xC) | ((k & 4) << 1) | ((k & 8) >> 1); return ((kk >> 3) * 4 + (c >> 5)) * 512 + ((kk & 7) * 32 + (c & 31)) * 2; }
__device__ __forceinline__ int v_rd_base(int lane) { return ((lane & 3) << 3) | (((lane >> 2) & 3) << 6) | (((lane >> 4) & 1) << 5) | (((lane >> 5) & 1) << 8); }
constexpr int v_rd_off(int d0, int ks, int half) { return d0 * 512 + ks * 4096 + half * 2048; }
template <int OFF> __device__ __forceinline__ s16x4 tr_read(int vb) {
  s16x4 r; asm volatile("ds_read_b64_tr_b16 %0, %1 offset:%2" : "=&v"(r) : "v"(vb), "i"(OFF) : "memory"); return r;
}
template <int D0> __device__ __forceinline__ void pv_one(f32x16& od, int vb, bf16x8 pa0, bf16x8 pa1, bf16x8 pa2, bf16x8 pa3) {
  const s16x4 l0 = tr_read<v_rd_off(D0, 0, 0)>(vb), h0 = tr_read<v_rd_off(D0, 0, 1)>(vb), l1 = tr_read<v_rd_off(D0, 1, 0)>(vb), h1 = tr_read<v_rd_off(D0, 1, 1)>(vb);
  const s16x4 l2 = tr_read<v_rd_off(D0, 2, 0)>(vb), h2 = tr_read<v_rd_off(D0, 2, 1)>(vb), l3 = tr_read<v_rd_off(D0, 3, 0)>(vb), h3 = tr_read<v_rd_off(D0, 3, 1)>(vb);
  asm volatile("s_waitcnt lgkmcnt(0)" ::: "memory"); SBAR();
#define PK(L, H) (bf16x8){L[0], L[1], L[2], L[3], H[0], H[1], H[2], H[3]}
  od = __builtin_amdgcn_mfma_f32_32x32x16_bf16(pa0, PK(l0, h0), od, 0, 0, 0);
  od = __builtin_amdgcn_mfma_f32_32x32x16_bf16(pa1, PK(l1, h1), od, 0, 0, 0);
  od = __builtin_amdgcn_mfma_f32_32x32x16_bf16(pa2, PK(l2, h2), od, 0, 0, 0);
  od = __builtin_amdgcn_mfma_f32_32x32x16_bf16(pa3, PK(l3, h3), od, 0, 0, 0);
#undef PK
}
__device__ __forceinline__ void pv_d0(f32x16* o, int vb, bf16x8 pa0, bf16x8 pa1, bf16x8 pa2, bf16x8 pa3) {
  pv_one<0>(o[0], vb, pa0, pa1, pa2, pa3); pv_one<1>(o[1], vb, pa0, pa1, pa2, pa3); pv_one<2>(o[2], vb, pa0, pa1, pa2, pa3); pv_one<3>(o[3], vb, pa0, pa1, pa2, pa3);
}

template <int LDQ>
__device__ __forceinline__ void attn_unit(const bf16_t* __restrict__ Qb, const bf16_t* __restrict__ Kh, const bf16_t* __restrict__ Vh, bf16_t* __restrict__ Ob, int seq, char* lds) {
  const int tid = threadIdx.x, wid = tid >> 6, lane = tid & 63, r32 = lane & 31, hi = lane >> 5;
  char* V_lds = lds; char* K_lds = lds + 2 * SHM_V;
  float* ws = (float*)(lds + 2 * SHM_V + 2 * SHM_K) + wid * 64; float* li_l = ws; float* al_l = ws + 32;
  float m_reg = -1e30f, l_reg = 0; f32x16 o[4] = {}; bf16x8 qr[4];
  const bf16_t* Qw = Qb + (long)(wid * QBLK + r32) * LDQ + hi * 8;
#pragma unroll
  for (int d0 = 0; d0 < 4; ++d0) qr[d0] = *reinterpret_cast<const bf16x8*>(Qw + d0 * 16);
  const int sr = tid >> 4, sc = (tid & 15) * 8, vst0 = v_st(sr, sc), vst1 = v_st(32 + sr, sc);
  const int kr = tid >> 3, kc8 = (tid & 7) * 8, kst = KSWZ64(kr, kc8 * 2);
  const int vb0 = (int)(uintptr_t)V_lds + v_rd_base(lane);
  struct { bf16x8 vs0, vs1, ks; } sr_[2];
  const bf16_t* Vp0 = Vh + (long)sr * LDQ + sc; const bf16_t* Kp0 = Kh + (long)kr * LDQ + kc8;
#define SLOAD(i, k0) do { const long ko_ = (long)(k0) * LDQ; sr_[i].vs0 = *reinterpret_cast<const bf16x8*>(Vp0 + ko_); sr_[i].vs1 = *reinterpret_cast<const bf16x8*>(Vp0 + ko_ + 32 * LDQ); \
    sr_[i].ks = *reinterpret_cast<const bf16x8*>(Kp0 + ko_); } while (0)
#define SWRITE(b, i) do { *(bf16x8*)(V_lds + (b) * SHM_V + vst0) = sr_[i].vs0; *(bf16x8*)(V_lds + (b) * SHM_V + vst1) = sr_[i].vs1; \
    *(bf16x8*)(K_lds + (b) * SHM_K + kst) = sr_[i].ks; } while (0)
#define SWAIT() asm volatile("s_waitcnt vmcnt(3)" ::: "memory")
#define RESC(a) do { if (__any((a) < 1.f)) { if (hi == 0) al_l[r32] = (a); asm volatile("s_waitcnt lgkmcnt(0)" ::: "memory"); \
    _Pragma("unroll") for (int d = 0; d < 4; ++d) _Pragma("unroll") for (int r = 0; r < 16; ++r) o[d][r] *= al_l[crow(r, hi)]; } } while (0)
  f32x16 pA0, pA1, pB0, pB1; float mnA, mnB, alA, alB; bf16x8 pa0, pa1, pa2, pa3; const int NT = seq / KVBLK;
  constexpr int SE = 0, SO = 1;
  SLOAD(SE, 0); asm volatile("s_waitcnt vmcnt(0)" ::: "memory"); SWRITE(0, SE); __syncthreads();
  qkt(pA0, pA1, K_lds, qr, r32, hi); partialSM(pA0, pA1, m_reg, mnA, alA);
  SLOAD(SO, KVBLK); if (2 < NT) SLOAD(SE, 2 * KVBLK);
  SWAIT(); SWRITE(1, SO); __syncthreads();
  for (int j = 1; j + 1 < NT; j += 2) {
    SBAR(); qkt(pB0, pB1, K_lds + SHM_K, qr, r32, hi);
    finishSM(pA0, pA1, alA, l_reg, pa0, pa1, pa2, pa3); SBAR();
    SLOAD(SO, (j + 2) * KVBLK); SBAR();
    pv_d0(o, vb0, pa0, pa1, pa2, pa3); partialSM(pB0, pB1, m_reg, mnB, alB);
    __syncthreads(); SWAIT(); SWRITE(0, SE);
    RESC(alB); __syncthreads();
    SBAR(); qkt(pA0, pA1, K_lds, qr, r32, hi);
    finishSM(pB0, pB1, alB, l_reg, pa0, pa1, pa2, pa3); SBAR();
    if (j + 3 < NT) SLOAD(SE, (j + 3) * KVBLK); SBAR();
    pv_d0(o, vb0 + SHM_V, pa0, pa1, pa2, pa3); partialSM(pA0, pA1, m_reg, mnA, alA);
    __syncthreads(); SWAIT(); SWRITE(1, SO);
    RESC(alA); __syncthreads();
  }
  SBAR(); qkt(pB0, pB1, K_lds + SHM_K, qr, r32, hi);
  finishSM(pA0, pA1, alA, l_reg, pa0, pa1, pa2, pa3); SBAR();
  pv_d0(o, vb0, pa0, pa1, pa2, pa3); partialSM(pB0, pB1, m_reg, mnB, alB);
  __syncthreads(); RESC(alB);
  finishSM(pB0, pB1, alB, l_reg, pa0, pa1, pa2, pa3); SBAR();
  pv_d0(o, vb0 + SHM_V, pa0, pa1, pa2, pa3);
  if (hi == 0) li_l[r32] = l_reg; asm volatile("s_waitcnt lgkmcnt(0)" ::: "memory");
  float rli[16];
#pragma unroll
  for (int r = 0; r < 16; ++r) rli[r] = __builtin_amdgcn_rcpf(li_l[crow(r, hi)]);
  bf16_t* Ow = Ob + (long)(wid * QBLK) * 1024;
#pragma unroll
  for (int r = 0; r < 16; ++r) { const int orow = crow(r, hi);
#pragma unroll
    for (int d0 = 0; d0 < 4; ++d0) Ow[(long)orow * 1024 + d0 * 32 + r32] = (bf16_t)(cvtpk(o[d0][r] * rli[r], 0.f) & 0xffffu); }
  __syncthreads();
#undef SLOAD
#undef SWRITE
#undef SWAIT
#undef RESC
}
#undef SBAR
}


typedef GAS unsigned gu32;
#define RLX_AGENT __ATOMIC_RELAXED, __HIP_MEMORY_SCOPE_AGENT
#define XB_TMO      128
#define XB_XCNT(j)  (256  + 64 * (j))
#define XB_XSUB(j)  (1280 + 64 * (j))
#define XB_XGEN(j)  (2304 + 64 * (j))
#define XB_TOP      3328
#define XB_TOPGEN   3392
#define XCD_BAR_WORDS 3456
#define XB_SPIN_CAP (1u << 22)
__device__ __forceinline__ unsigned xb_ld(unsigned* p)              { return __hip_atomic_load(p, __ATOMIC_RELAXED, __HIP_MEMORY_SCOPE_AGENT); }
__device__ __forceinline__ unsigned xb_add(unsigned* p, unsigned v) { return __hip_atomic_fetch_add(p, v, __ATOMIC_RELAXED, __HIP_MEMORY_SCOPE_AGENT); }
__device__ __forceinline__ unsigned xb_xcc_id() { return (unsigned)__builtin_amdgcn_s_getreg((3 << 11) | 20) & 0xFu; }
#define XB_SPIN(cond, bar) do { unsigned _sp = 0; while (cond) { __builtin_amdgcn_s_sleep(1); \
    if ((++_sp & 255u) == 0u) { if (xb_ld(&(bar)[XB_TMO])) break; if (_sp > XB_SPIN_CAP) { atomicAdd(&(bar)[XB_TMO], 1u); break; } } } } while (0)
struct XcdBarrier { unsigned* bar; unsigned x; volatile LAS unsigned* st; };
__device__ __forceinline__ XcdBarrier xcd_barrier_post(unsigned* bar, volatile LAS unsigned* st) {
    XcdBarrier b; b.bar = bar; b.x = xb_xcc_id(); b.st = st;
    if (threadIdx.x == 0) (void)xb_add(&bar[XB_XCNT(b.x)], 1u);
    return b;
}
__device__ __forceinline__ void xcd_barrier_complete(unsigned* bar, unsigned x, unsigned& nloc, unsigned& nx) {
    const unsigned G = gridDim.x * gridDim.y * gridDim.z;
    unsigned sum, cnt, mine, sp = 0u;
    for (;;) {
        sum = 0u; cnt = 0u; mine = 0u;
#pragma unroll
        for (unsigned j = 0; j < 16; ++j) { const unsigned c = xb_ld(&bar[XB_XCNT(j)]); sum += c; cnt += (c > 0u) ? 1u : 0u; mine = (j == x) ? c : mine; }
        if (sum == G) break;
        __builtin_amdgcn_s_sleep(1);
        if ((++sp & 255u) == 0u) { if (xb_ld(&bar[XB_TMO])) break; if (sp > XB_SPIN_CAP) { atomicAdd(&bar[XB_TMO], 1u); break; } }
    }
    nloc = mine > 0u ? mine : 1u; nx = cnt > 0u ? cnt : 1u;
}
__device__ __forceinline__ void xcd_barrier(const XcdBarrier& b) {
    asm volatile("s_waitcnt vmcnt(0)" ::: "memory");
    __syncthreads();
    if (threadIdx.x == 0) {
        unsigned* bar = b.bar;
        __builtin_amdgcn_s_waitcnt(0);
        unsigned nloc = b.st[0], nx = b.st[1];
        if (nloc == 0u) { xcd_barrier_complete(bar, b.x, nloc, nx); b.st[0] = nloc; b.st[1] = nx; }
        const unsigned old = xb_add(&bar[XB_XSUB(b.x)], 1u);
        const unsigned gen = old / nloc;
        if (old + 1u == (gen + 1u) * nloc) {
            __builtin_amdgcn_fence(__ATOMIC_RELEASE, "agent");
            asm volatile("s_waitcnt vmcnt(0)" ::: "memory");
            const unsigned og = xb_add(&bar[XB_TOP], 1u);
            const unsigned tg = og / nx;
            if (og + 1u == (tg + 1u) * nx) xb_add(&bar[XB_TOPGEN], 1u);
            else XB_SPIN(xb_ld(&bar[XB_TOPGEN]) == tg, bar);
            __builtin_amdgcn_fence(__ATOMIC_ACQUIRE, "agent");
            xb_add(&bar[XB_XGEN(b.x)], 1u);
            asm volatile("s_waitcnt vmcnt(0)" ::: "memory");
        } else {
            XB_SPIN(xb_ld(&bar[XB_XGEN(b.x)]) == gen, bar);
            __builtin_amdgcn_fence(__ATOMIC_ACQUIRE, "agent");
            asm volatile("s_waitcnt vmcnt(0)" ::: "memory");
        }
    }
    __syncthreads();
}

struct Frame {
    LAS unsigned char* lds; char* ldsg;
    int tid, lane, wave, vcu, G;
    const Args* a;
};
#define INP(F, i, T) ((const T*)(F).a->in[i])
#define WSP(F, off, T) ((T*)((F).a->ws + (off)))

__device__ __forceinline__ void cvt_load(f32x4 (&v)[16], const float* __restrict__ W, int N, int nvalid, int k0, int n0, int lane) {
    const int kq = lane >> 4, nq = lane & 15;
    const unsigned voff = (unsigned)(kq * N + 4 * nq) * 4u;
#pragma unroll
    for (int i = 0; i < 16; ++i) {
        const char* Wu = (const char*)(W + (size_t)(k0 + 4 * i) * N + n0);
        if (4 * nq < nvalid) v[i] = __builtin_nontemporal_load((const f32x4*)(Wu + (size_t)voff)); else v[i] = (f32x4){0.f, 0.f, 0.f, 0.f};
    }
}
__device__ __forceinline__ void cvt_finish(const f32x4 (&v)[16], int k0, bf16_t* __restrict__ WT, int rowb, LAS unsigned char* scr, int lane) {
    const int kq = lane >> 4, nq = lane & 15;
    const int g = lane >> 4, i16 = lane & 15, q = i16 >> 2, p = i16 & 3;
    typedef short v4i16_t __attribute__((ext_vector_type(4)));
#pragma unroll
    for (int hf = 0; hf < 2; ++hf) {
#pragma unroll
        for (int i = 0; i < 8; ++i) {
            const int k = 4 * i + kq, s = ((k >> 1) & 1) | (((k >> 3) & 1) << 1);
            u32x2 w; w.x = cvtpk(v[8 * hf + i].x, v[8 * hf + i].y); w.y = cvtpk(v[8 * hf + i].z, v[8 * hf + i].w);
            *(LAS u32x2*)(scr + k * 128 + ((nq * 8) ^ (s << 5))) = w;
        }
        const int klo = 8 * g + q, s = ((klo >> 1) & 1) | (((klo >> 3) & 1) << 1);
#pragma unroll
        for (int nb = 0; nb < 4; ++nb) {
            const int a_lo = klo * 128 + (((16 * nb + 4 * p) * 2) ^ (s << 5));
            const s16x4 lo = __builtin_bit_cast(s16x4, __builtin_amdgcn_ds_read_tr16_b64_v4i16((LAS v4i16_t*)(scr + a_lo)));
            const s16x4 hi = __builtin_bit_cast(s16x4, __builtin_amdgcn_ds_read_tr16_b64_v4i16((LAS v4i16_t*)(scr + a_lo + 512)));
            bf16x8 o = {lo[0], lo[1], lo[2], lo[3], hi[0], hi[1], hi[2], hi[3]};
            char* Wu = (char*)(WT + (size_t)(rowb + 16 * nb) * 2048 + k0 + 32 * hf);
            __builtin_nontemporal_store(o, (bf16x8*)(Wu + (size_t)(unsigned)((i16 * 2048 + 8 * g) * 2)));
        }
    }
}
__device__ __forceinline__ void cvt8_load(f32x4 (&v)[16], const float* __restrict__ W, int k0, int n0, int lane) {
    const int kq = lane >> 4, nq = lane & 15;
    const unsigned voff = (unsigned)(16 * kq * 2048 + 4 * nq) * 4u;
#pragma unroll
    for (int i = 0; i < 16; ++i) {
        const char* Wu = (const char*)(W + (size_t)(k0 + i) * 2048 + n0);
        v[i] = __builtin_nontemporal_load((const f32x4*)(Wu + (size_t)voff));
    }
}
__device__ __forceinline__ void cvt8_finish(const f32x4 (&v)[16], int k0, unsigned char* __restrict__ W8, int rowb, int lane) {
    const int kq = lane >> 4, nq = lane & 15;
    char* Wu = (char*)(W8 + (size_t)rowb * 2048 + k0);
    const unsigned voff = (unsigned)(4 * nq * 2048 + 16 * kq);
#pragma unroll
    for (int j = 0; j < 4; ++j) {
        u32x4 o;
#pragma unroll
        for (int q = 0; q < 4; ++q) {
            int w = __builtin_amdgcn_cvt_pk_fp8_f32(v[4 * q][j] * pg8::W8_SCALE, v[4 * q + 1][j] * pg8::W8_SCALE, 0, false);
            w = __builtin_amdgcn_cvt_pk_fp8_f32(v[4 * q + 2][j] * pg8::W8_SCALE, v[4 * q + 3][j] * pg8::W8_SCALE, w, true);
            o[q] = (unsigned)w;
        }
        __builtin_nontemporal_store(o, (u32x4*)(Wu + (size_t)(voff + (unsigned)(j * 2048))));
    }
}
__device__ __forceinline__ void cvt_expert_decode(const Frame& F, int r, const float*& W, int& k0, int& n0, unsigned char*& WT, int& rowb) {
    constexpr int I_E = 16 * 32 * 32;
    const int mat = r / I_E; r -= mat * I_E;
    const int e = r >> 10, kt = (r >> 5) & 31, nt = r & 31;
    k0 = kt * 64; n0 = nt * 64;
    if (mat < 2) { W = INP(F, 24 + mat, float) + (size_t)e * 2048 * 2048; WT = WSP(F, WS_WGU, unsigned char); rowb = e * 4096 + (n0 >> 7) * 256 + mat * 128 + (n0 & 127); }
    else { W = INP(F, 26, float) + (size_t)e * 2048 * 2048; WT = WSP(F, WS_WD, unsigned char); rowb = e * 2048 + n0; }
}
constexpr int N_EXPERT_ITEMS = 3 * 16 * 32 * 32;
__device__ __forceinline__ void p0_prologue(Frame& F) {
    LAS unsigned char* scr = F.lds + F.wave * 4096;
    const int gw = F.vcu * 8 + F.wave, NGW = F.G * 8, lane = F.lane;
    const float* w_in = INP(F, 3, float); const float* w_out = INP(F, 21, float);
    bf16_t* WinT = WSP(F, WS_WIN, bf16_t); bf16_t* WoutT = WSP(F, WS_WOUT, bf16_t);
    constexpr int I_IN = 32 * 101, I_OUT = 32 * 32, NITEMS = I_IN + I_OUT;
#define P0_TILE_LOAD(V_, it_) do { if ((it_) < I_IN) { const int kt_ = (it_) / 101, nt_ = (it_) % 101; cvt_load(V_, w_in, IN_COLS, (nt_ == 100) ? 32 : 64, kt_ * 64, nt_ * 64, lane); } \
        else { const int r_ = (it_) - I_IN; cvt_load(V_, w_out, 2048, 64, (r_ >> 5) * 64, (r_ & 31) * 64, lane); } } while (0)
#define P0_TILE_FIN(V_, it_) do { if ((it_) < I_IN) { const int kt_ = (it_) / 101, nt_ = (it_) % 101; cvt_finish(V_, kt_ * 64, WinT, nt_ * 64, scr, lane); } \
        else { const int r_ = (it_) - I_IN; cvt_finish(V_, (r_ >> 5) * 64, WoutT, (r_ & 31) * 64, scr, lane); } } while (0)
    for (int it = gw; it < NITEMS; it += 2 * NGW) {
        const int it2 = it + NGW; const bool has2 = it2 < NITEMS;
        f32x4 va[16], vb[16];
        P0_TILE_LOAD(va, it); if (has2) P0_TILE_LOAD(vb, it2);
        P0_TILE_FIN(va, it); if (has2) P0_TILE_FIN(vb, it2);
    }
#undef P0_TILE_LOAD
#undef P0_TILE_FIN
#if !CVT_IN_SCAN
    for (int it = gw; it < N_EXPERT_ITEMS; it += NGW) {
        f32x4 v[16]; const float* W; int k0, n0, rowb; unsigned char* WT;
        cvt_expert_decode(F, it, W, k0, n0, WT, rowb); cvt8_load(v, W, k0, n0, lane); cvt8_finish(v, k0, WT, rowb, lane);
    }
#endif
    { u32x4 z = {0u, 0u, 0u, 0u}; u32x4* zp = (u32x4*)(WinT + (size_t)6464 * 2048); const int nz = 192 * 2048 * 2 / 16;
      for (int i = gw * 64 + lane; i < nz; i += NGW * 64) zp[i] = z; }
    { const float* x = INP(F, 0, float); const float* nw = INP(F, 2, float); bf16_t* H1 = WSP(F, WS_H1, bf16_t);
      for (int m = gw; m < MTOK; m += 2 * NGW) {
          const int m2 = (m + NGW < MTOK) ? m + NGW : m;
          const f32x4* xr = (const f32x4*)(x + (size_t)m * DM) + lane; const f32x4* xs = (const f32x4*)(x + (size_t)m2 * DM) + lane; f32x4 v[8], u[8]; float s = 0.f, s2 = 0.f;
#pragma unroll
          for (int j = 0; j < 8; ++j) { v[j] = xr[64 * j]; u[j] = xs[64 * j]; }
#pragma unroll
          for (int j = 0; j < 8; ++j) { s += (v[j].x * v[j].x + v[j].y * v[j].y) + (v[j].z * v[j].z + v[j].w * v[j].w); s2 += (u[j].x * u[j].x + u[j].y * u[j].y) + (u[j].z * u[j].z + u[j].w * u[j].w); }
          const float rstd = 1.f / sqrtf(wave_sum(s) * (1.f / DM) + 1e-6f), rstd2 = 1.f / sqrtf(wave_sum(s2) * (1.f / DM) + 1e-6f);
          u32x2* o8 = (u32x2*)(H1 + (size_t)m * DM) + lane; u32x2* p8 = (u32x2*)(H1 + (size_t)m2 * DM) + lane;
#pragma unroll
          for (int j = 0; j < 8; ++j) { const f32x4 w = ((const f32x4*)nw)[lane + 64 * j];
              u32x2 o; o.x = cvtpk(v[j].x * rstd * w.x, v[j].y * rstd * w.y); o.y = cvtpk(v[j].z * rstd * w.z, v[j].w * rstd * w.w); o8[64 * j] = o;
              u32x2 q; q.x = cvtpk(u[j].x * rstd2 * w.x, u[j].y * rstd2 * w.y); q.y = cvtpk(u[j].z * rstd2 * w.z, u[j].w * rstd2 * w.w); p8[64 * j] = q; }
      } }
    { const float* dup = INP(F, 12, float); const float* iup = INP(F, 14, float); const float* gup = INP(F, 15, float);
      bf16_t* DUt = WSP(F, WS_LORA, bf16_t); bf16_t* IUt = DUt + 2 * 1024 * 64; bf16_t* GUt = IUt + 2 * 1024 * 64;
      for (int i = gw * 64 + lane; i < 2 * 1024 * 64; i += NGW * 64) { const int j = i & 63, c = (i >> 6) & 1023, d = i >> 16;
          DUt[i] = (bf16_t)(cvtpk(dup[(size_t)(d * 64 + j) * 1024 + c], 0.f) & 0xffffu); IUt[i] = (bf16_t)(cvtpk(iup[(size_t)(d * 64 + j) * 1024 + c], 0.f) & 0xffffu); }
      for (int i = gw * 64 + lane; i < 1024 * 160; i += NGW * 64) { const int c = i / 160, j = i - c * 160; GUt[i] = (bf16_t)(cvtpk(gup[(size_t)j * 1024 + c], 0.f) & 0xffffu); } }
    { const int* pos = INP(F, 1, int); float* rope = WSP(F, WS_ROPE, float);
      const float invf[8] = {1.0f, 0.19392274474868576f, 0.03760603093086393f, 0.007292664737217109f, 0.001414213562373095f, 0.0002742481756762073f, 5.318295896944988e-05f, 1.031338537721246e-05f};
      for (int i = gw * 64 + lane; i < MTOK * 8; i += NGW * 64) { const int m = i >> 3, j = i & 7; float fj = invf[0];
#pragma unroll
          for (int q = 1; q < 8; ++q) fj = (j == q) ? invf[q] : fj;
          const float ang = (float)pos[m] * fj; rope[m * 16 + j] = cosf(ang); rope[m * 16 + 8 + j] = sinf(ang); } }
}

#define WS32(F, T, byteoff) (*(T*)((F).a->ws + (size_t)(unsigned)(byteoff)))
template <int CTRL> __device__ __forceinline__ float dpp_add(float x) {
    return x + __int_as_float(__builtin_amdgcn_update_dpp(0, __float_as_int(x), CTRL, 0xf, 0xf, false));
}
__device__ __forceinline__ float row16_allsum(float x) { x = dpp_add<0x128>(x); x = dpp_add<0x124>(x); x = dpp_add<0x122>(x); x = dpp_add<0x121>(x); return x; }
__device__ __forceinline__ bf16_t f2bf(float x) { return (bf16_t)(cvtpk(x, 0.f) & 0xffffu); }
__device__ __forceinline__ u32x4 ld_row16(const Frame& F, unsigned off, bool ok) { u32x4 r = {0u, 0u, 0u, 0u}; if (ok) r = WS32(F, const u32x4, off); return r; }
__device__ __forceinline__ void unpack8(const u32x4 w, float (&o)[8]) { o[0] = bf_lo(w.x); o[1] = bf_hi(w.x); o[2] = bf_lo(w.y); o[3] = bf_hi(w.y); o[4] = bf_lo(w.z); o[5] = bf_hi(w.z); o[6] = bf_lo(w.w); o[7] = bf_hi(w.w); }
__device__ __forceinline__ void ld8f(const float* p, float (&o)[8]) { const f32x4 a = ((const f32x4*)p)[0], b = ((const f32x4*)p)[1]; o[0] = a.x; o[1] = a.y; o[2] = a.z; o[3] = a.w; o[4] = b.x; o[5] = b.y; o[6] = b.z; o[7] = b.w; }
__device__ __forceinline__ u32x4 pack8(const float (&v)[8]) { return (u32x4){cvtpk(v[0], v[1]), cvtpk(v[2], v[3]), cvtpk(v[4], v[5]), cvtpk(v[6], v[7])}; }
__device__ __forceinline__ void p3_prep(Frame& F, const int mode = 0) {
    constexpr int AP = 296;
    constexpr int PP = 264, PA = 16 * PP, PT = 5 * PA;
    LAS bf16_t* Al = (LAS bf16_t*)F.lds;
    LAS bf16_t* Pl = (LAS bf16_t*)(F.lds + 18944);
    LAS float* Zr = (LAS float*)(F.lds + 18944);
    LAS float* Zl = (LAS float*)(F.lds + 18944 + 20736);
    const int tid = F.tid, lane = F.lane, w = F.wave;
    const bf16_t* DUt = WSP(F, WS_LORA, bf16_t); const bf16_t* IUt = DUt + 2 * 1024 * 64; const bf16_t* GUt = IUt + 2 * 1024 * 64;
    for (int item = F.vcu; item < MTOK / 32; item += F.G) {
        __syncthreads();
#pragma unroll 1
        for (int tl = 0; tl < 2; ++tl) {
            const int m0 = item * 32 + tl * 16, t0 = m0 & (SEQ - 1);
            for (int p = tid; p < 18 * 36; p += 512) {
                const int rr = p / 36, ch = p - rr * 36, t = t0 + rr - 1, m = m0 + rr - 1;
                f32x4 a0 = {0.f, 0.f, 0.f, 0.f}, a1 = a0;
                if (t >= 0 && t < SEQ) {
                    const bf16_t* pp = WSP(F, WS_PART, bf16_t) + (((size_t)((ch >> 5) * 32 + (m >> 8)) * 4) << 16) + (size_t)(m & 255) * 256 + ((8 * ch) & 255);
                    u32x4 q[4];
#pragma unroll
                    for (int k = 0; k < 4; ++k) q[k] = *(const u32x4*)(pp + ((size_t)k << 16));
#pragma unroll
                    for (int k = 0; k < 4; ++k) { a0 += (f32x4){bf_lo(q[k].x), bf_hi(q[k].x), bf_lo(q[k].y), bf_hi(q[k].y)}; a1 += (f32x4){bf_lo(q[k].z), bf_hi(q[k].z), bf_lo(q[k].w), bf_hi(q[k].w)}; }
                }
                LAS f32x4* zp = (LAS f32x4*)(Zr + rr * 288 + 8 * ch); zp[0] = a0; zp[1] = a1;
            }
            __syncthreads();
            for (int p = tid; p < 16 * 36; p += 512) {
                const int i = p / 36, ch = p - i * 36, zc = 3072 + 8 * ch;
                float c[8], pv[8], nx[8], mp[8], mn[8];
                { const LAS f32x4* q = (const LAS f32x4*)(Zr + i * 288 + 8 * ch); const f32x4 x0 = q[0], x1 = q[1], y0 = q[72], y1 = q[73], w0 = q[144], w1 = q[145];
                  pv[0] = x0.x; pv[1] = x0.y; pv[2] = x0.z; pv[3] = x0.w; pv[4] = x1.x; pv[5] = x1.y; pv[6] = x1.z; pv[7] = x1.w;
                  c[0] = y0.x; c[1] = y0.y; c[2] = y0.z; c[3] = y0.w; c[4] = y1.x; c[5] = y1.y; c[6] = y1.z; c[7] = y1.w;
                  nx[0] = w0.x; nx[1] = w0.y; nx[2] = w0.z; nx[3] = w0.w; nx[4] = w1.x; nx[5] = w1.y; nx[6] = w1.z; nx[7] = w1.w; }
                ld8f(INP(F, 4, float) + zc, mp); ld8f(INP(F, 5, float) + zc, mn);
                LAS f32x4* zp = (LAS f32x4*)(Zl + i * 288 + 8 * ch); float z[8];
#pragma unroll
                for (int e = 0; e < 8; ++e) z[e] = c[e] + mp[e] * (pv[e] - c[e]) + mn[e] * (nx[e] - c[e]);
                zp[0] = (f32x4){z[0], z[1], z[2], z[3]}; zp[1] = (f32x4){z[4], z[5], z[6], z[7]};
            }
            __syncthreads();
            for (int e = tid; e < 16 * 288; e += 512) { const int i = e / 288, j = e - i * 288; float z = Zl[e];
                if (j < 64) z = 1.f - 2.f * __builtin_amdgcn_rcpf(__expf(2.f * z) + 1.f); else if (j >= 128) z = __builtin_amdgcn_rcpf(1.f + __expf(-z));
                Al[tl * 16 * AP + i * AP + j] = f2bf(z); }
        }
        __syncthreads();
        if (mode == 1) continue;
        const int chk = tid & 31, pidx = tid >> 5, tb = pidx >> 3, tp = pidx & 7;
        const int m0t = item * 32 + tb * 16, t0t = m0t & (SEQ - 1);
#pragma unroll 1
        for (int qi = 0; qi < 4; ++qi) {
            const int q = (qi + (F.vcu >> 2)) & 3;
            u32x4 rawr[4], rawk[4], rawv[4];
            { const unsigned off = (unsigned)WS_PROJ + ((unsigned)(m0t + 2 * tp) * LDP + ZC0 + 256 * q + 8 * chk) * 2u;
#pragma unroll
              for (int rr = 0; rr < 4; ++rr) { const int t = t0t + 2 * tp + rr - 1; const bool ok = (t >= 0) && (t < SEQ); const unsigned o = off + (unsigned)((rr - 1) * LDP * 2);
                  rawr[rr] = ld_row16(F, o, ok); rawk[rr] = ld_row16(F, o + 1024u * 2u, ok); rawv[rr] = ld_row16(F, o + 2048u * 2u, ok); } }
            {
                const int n16 = lane & 15, q4 = lane >> 4;
                struct BF { bf16x8 d0[2], d1[2], i0[2], i1[2], g[5]; };
#define LD_BF(X, nb_) do { const int cl_ = 256 * q + 32 * w + 16 * (nb_) + n16; _Pragma("unroll") for (int ks = 0; ks < 2; ++ks) { \
                    X.d0[ks] = *(const bf16x8*)(DUt + (size_t)cl_ * 64 + 32 * ks + 8 * q4); X.d1[ks] = *(const bf16x8*)(DUt + (size_t)(1024 + cl_) * 64 + 32 * ks + 8 * q4); \
                    X.i0[ks] = *(const bf16x8*)(IUt + (size_t)cl_ * 64 + 32 * ks + 8 * q4); X.i1[ks] = *(const bf16x8*)(IUt + (size_t)(1024 + cl_) * 64 + 32 * ks + 8 * q4); } \
                    _Pragma("unroll") for (int ks = 0; ks < 5; ++ks) X.g[ks] = *(const bf16x8*)(GUt + (size_t)cl_ * 160 + 32 * ks + 8 * q4); } while (0)
#define DO_NB(X, nb_, tl_) do { const int ch_ = 32 * w + 16 * (nb_); \
                    f32x4 aw0 = {0.f, 0.f, 0.f, 0.f}, aw1 = aw0, aa0 = aw0, aa1 = aw0, ag = aw0; \
                    _Pragma("unroll") for (int ks = 0; ks < 2; ++ks) { \
                        aw0 = __builtin_amdgcn_mfma_f32_16x16x32_bf16(X.d0[ks], af[ks], aw0, 0, 0, 0); aw1 = __builtin_amdgcn_mfma_f32_16x16x32_bf16(X.d1[ks], af[ks], aw1, 0, 0, 0); \
                        aa0 = __builtin_amdgcn_mfma_f32_16x16x32_bf16(X.i0[ks], af[2 + ks], aa0, 0, 0, 0); aa1 = __builtin_amdgcn_mfma_f32_16x16x32_bf16(X.i1[ks], af[2 + ks], aa1, 0, 0, 0); } \
                    _Pragma("unroll") for (int ks = 0; ks < 5; ++ks) ag = __builtin_amdgcn_mfma_f32_16x16x32_bf16(X.g[ks], af[4 + ks], ag, 0, 0, 0); \
                    LAS bf16_t* pp = Pl + (tl_) * PT + n16 * PP + ch_ + 4 * q4; \
                    *(LAS u32x2*)(pp) = (u32x2){cvtpk(aw0[0], aw0[1]), cvtpk(aw0[2], aw0[3])}; *(LAS u32x2*)(pp + PA) = (u32x2){cvtpk(aw1[0], aw1[1]), cvtpk(aw1[2], aw1[3])}; \
                    *(LAS u32x2*)(pp + 2 * PA) = (u32x2){cvtpk(aa0[0], aa0[1]), cvtpk(aa0[2], aa0[3])}; *(LAS u32x2*)(pp + 3 * PA) = (u32x2){cvtpk(aa1[0], aa1[1]), cvtpk(aa1[2], aa1[3])}; \
                    *(LAS u32x2*)(pp + 4 * PA) = (u32x2){cvtpk(ag[0], ag[1]), cvtpk(ag[2], ag[3])}; } while (0)
                BF fa, fb; LD_BF(fa, 0); LD_BF(fb, 1);
#pragma unroll
                for (int tl = 0; tl < 2; ++tl) {
                    bf16x8 af[9];
#pragma unroll
                    for (int ks = 0; ks < 9; ++ks) af[ks] = *(const LAS bf16x8*)(Al + tl * 16 * AP + n16 * AP + 32 * ks + 8 * q4);
                    DO_NB(fa, 0, tl); DO_NB(fb, 1, tl);
                }
#undef LD_BF
#undef DO_NB
            }
            __syncthreads();
            if (mode != 2) {
                const int c = 256 * q + 8 * chk;
                float r4[4][8], k4[4][8], v4[4][8];
#pragma unroll
                for (int rr = 0; rr < 4; ++rr) { unpack8(rawr[rr], r4[rr]); unpack8(rawk[rr], k4[rr]); unpack8(rawv[rr], v4[rr]); }
                float zr[2][8], zk[2][8], zv[2][8];
                { float mp[8], mn[8];
                  ld8f(INP(F, 4, float) + c, mp); ld8f(INP(F, 5, float) + c, mn);
#pragma unroll
                  for (int tk = 0; tk < 2; ++tk)
#pragma unroll
                      for (int e = 0; e < 8; ++e) zr[tk][e] = r4[tk + 1][e] + mp[e] * (r4[tk][e] - r4[tk + 1][e]) + mn[e] * (r4[tk + 2][e] - r4[tk + 1][e]);
                  ld8f(INP(F, 4, float) + 1024 + c, mp); ld8f(INP(F, 5, float) + 1024 + c, mn);
#pragma unroll
                  for (int tk = 0; tk < 2; ++tk)
#pragma unroll
                      for (int e = 0; e < 8; ++e) zk[tk][e] = k4[tk + 1][e] + mp[e] * (k4[tk][e] - k4[tk + 1][e]) + mn[e] * (k4[tk + 2][e] - k4[tk + 1][e]);
                  ld8f(INP(F, 4, float) + 2048 + c, mp); ld8f(INP(F, 5, float) + 2048 + c, mn);
#pragma unroll
                  for (int tk = 0; tk < 2; ++tk)
#pragma unroll
                      for (int e = 0; e < 8; ++e) zv[tk][e] = v4[tk + 1][e] + mp[e] * (v4[tk][e] - v4[tk + 1][e]) + mn[e] * (v4[tk + 2][e] - v4[tk + 1][e]); }
                float kkw[8], w00[8], w01[8], a00[8], a01[8], kac[8], rkc[8];
                ld8f(INP(F, 16, float) + c, kkw); ld8f(INP(F, 11, float) + c, w00); ld8f(INP(F, 11, float) + 1024 + c, w01);
                ld8f(INP(F, 13, float) + c, a00); ld8f(INP(F, 13, float) + 1024 + c, a01); ld8f(INP(F, 17, float) + c, kac); ld8f(INP(F, 18, float) + c, rkc);
#pragma unroll 1
                for (int tk = 0; tk < 2; ++tk) {
                    const int tkn = 2 * tp + tk; const unsigned o = (unsigned)(m0t + tkn) * 1024u + (unsigned)c;
                    const LAS bf16_t* pp = Pl + tb * PT + tkn * PP + 8 * chk;
                    float zrt[8], zkt[8], zvt[8];
#pragma unroll
                    for (int e = 0; e < 8; ++e) { zrt[e] = tk ? zr[1][e] : zr[0][e]; zkt[e] = tk ? zk[1][e] : zk[0][e]; zvt[e] = tk ? zv[1][e] : zv[0][e]; }
                    WS32(F, u32x4, (unsigned)WS_R + o * 2u) = pack8(zrt); WS32(F, u32x4, (unsigned)WS_V + o * 2u) = pack8(zvt);
                    float kk[8];
                    { float ss = 0.f;
#pragma unroll
                      for (int e = 0; e < 8; ++e) { kk[e] = zkt[e] * kkw[e]; ss += kk[e] * kk[e]; }
                      ss += __shfl_xor(ss, 1); ss += __shfl_xor(ss, 2); ss += __shfl_xor(ss, 4);
                      const float inv = 1.f / fmaxf(sqrtf(ss), 1e-12f);
#pragma unroll
                      for (int e = 0; e < 8; ++e) kk[e] *= inv;
                      WS32(F, u32x4, (unsigned)WS_KK + o * 2u) = pack8(kk); }
                    {
                        float pw0[8], pw1[8], d0[8], d1[8];
                        unpack8(*(const LAS u32x4*)(pp), pw0); unpack8(*(const LAS u32x4*)(pp + PA), pw1);
#pragma unroll
                        for (int e = 0; e < 8; ++e) {
                            d0[e] = 0.6065306597126334f * __builtin_amdgcn_rcpf(1.f + __expf(-(w00[e] + pw0[e]))); d1[e] = 0.6065306597126334f * __builtin_amdgcn_rcpf(1.f + __expf(-(w01[e] + pw1[e]))); }
                        WS32(F, u32x4, (unsigned)WS_WDEC + o * 2u) = pack8(d0); WS32(F, u32x4, (unsigned)WS_WDEC + ((unsigned)(MTOK * 1024) + o) * 2u) = pack8(d1);
                    }
                    {
                        float pa0[8], pa1[8], kd0[8], kd1[8], b0v[8], b1v[8]; float bs = 0.f;
                        unpack8(*(const LAS u32x4*)(pp + 2 * PA), pa0); unpack8(*(const LAS u32x4*)(pp + 3 * PA), pa1);
#pragma unroll
                        for (int e = 0; e < 8; ++e) {
                            const float av0 = __builtin_amdgcn_rcpf(1.f + __expf(-(a00[e] + pa0[e]))), av1 = __builtin_amdgcn_rcpf(1.f + __expf(-(a01[e] + pa1[e])));
                            kd0[e] = zkt[e] * (1.f + (av0 - 1.f) * kac[e]); kd1[e] = zkt[e] * (1.f + (av1 - 1.f) * kac[e]);
                            b0v[e] = kk[e] * av0; b1v[e] = kk[e] * av1;
                            bs += zrt[e] * (kd0[e] + kd1[e]) * rkc[e]; }
                        bs += __shfl_xor(bs, 1); bs += __shfl_xor(bs, 2); bs += __shfl_xor(bs, 4);
                        if ((chk & 7) == 0) WS32(F, float, (unsigned)WS_BONUS + ((unsigned)(m0t + tkn) * 16u + (unsigned)(4 * q + (chk >> 3))) * 4u) = bs;
                        WS32(F, u32x4, (unsigned)WS_KD + o * 2u) = pack8(kd0); WS32(F, u32x4, (unsigned)WS_KD + ((unsigned)(MTOK * 1024) + o) * 2u) = pack8(kd1);
                        WS32(F, u32x4, (unsigned)WS_BB + o * 2u) = pack8(b0v); WS32(F, u32x4, (unsigned)WS_BB + ((unsigned)(MTOK * 1024) + o) * 2u) = pack8(b1v);
                    }
                    WS32(F, u32x4, (unsigned)WS_G + o * 2u) = *(const LAS u32x4*)(pp + 4 * PA);
                }
            }
            __syncthreads();
        }
    }
}

struct P5aConst { float lam; };
__device__ __forceinline__ void p5a_init(const Frame& F, P5aConst& K) {
    const int lane = F.lane;
    const float q1 = INP(F, 6, float)[lane] * INP(F, 7, float)[lane], q2 = INP(F, 8, float)[lane] * INP(F, 9, float)[lane];
    K.lam = __expf(wave_sum(q1)) - __expf(wave_sum(q2)) + 0.2f;
}
__device__ __forceinline__ void p5a_token(const Frame& F, const P5aConst& K, int m) {
    const bf16_t* OC = WSP(F, WS_OC, bf16_t); bf16_t* MIX = WSP(F, WS_MIX, bf16_t); const float* subw = INP(F, 10, float);
    const int c0 = F.lane * 16; const float lam = K.lam;
    const u32x4* p0 = (const u32x4*)(OC + (size_t)m * 1024 + c0); const u32x4* p1 = (const u32x4*)(OC + (size_t)MTOK * 1024 + (size_t)m * 1024 + c0);
    const u32x4 a0 = p0[0], a1 = p0[1], b0 = p1[0], b1 = p1[1];
    float dv[16]; const unsigned aw[8] = {a0.x, a0.y, a0.z, a0.w, a1.x, a1.y, a1.z, a1.w}, bw[8] = {b0.x, b0.y, b0.z, b0.w, b1.x, b1.y, b1.z, b1.w};
    float ssq = 0.f;
#pragma unroll
    for (int i = 0; i < 8; ++i) { dv[2 * i] = bf_lo(aw[i]) - lam * bf_lo(bw[i]); dv[2 * i + 1] = bf_hi(aw[i]) - lam * bf_hi(bw[i]); ssq += dv[2 * i] * dv[2 * i] + dv[2 * i + 1] * dv[2 * i + 1]; }
    ssq += __shfl_xor(ssq, 1); ssq += __shfl_xor(ssq, 2); ssq += __shfl_xor(ssq, 4);
    const float rstd = 1.f / sqrtf(ssq * (1.f / 128.f) + 1e-5f);
    unsigned ow[8];
#pragma unroll
    for (int i = 0; i < 8; ++i) { const float s0 = subw[(c0 + 2 * i) & 127] * 0.8f, s1 = subw[(c0 + 2 * i + 1) & 127] * 0.8f; ow[i] = cvtpk(dv[2 * i] * rstd * s0, dv[2 * i + 1] * rstd * s1); }
    u32x4* op = (u32x4*)(MIX + (size_t)m * 2048 + c0); op[0] = (u32x4){ow[0], ow[1], ow[2], ow[3]}; op[1] = (u32x4){ow[4], ow[5], ow[6], ow[7]};
}

__device__ __forceinline__ void p4_scan(Frame& F, const int mode = 0) {
    constexpr int CH = 32, NCH = SEQ / CH;
    constexpr int VEC = CH * 64 * 4;
    constexpr int BUF = 5 * VEC + CH * 32 * 4;
    constexpr int YOFF = 2 * BUF, YB = CH * 32 * 4;
    constexpr int CVT_SCR = 2 * BUF + 2 * YB;
    const bf16_t* Wdec = WSP(F, WS_WDEC, bf16_t); const bf16_t* KDg = WSP(F, WS_KD, bf16_t); const bf16_t* BBg = WSP(F, WS_BB, bf16_t);
    const bf16_t* Rg = WSP(F, WS_R, bf16_t); const bf16_t* KKg = WSP(F, WS_KK, bf16_t); const bf16_t* Vg = WSP(F, WS_V, bf16_t); bf16_t* YS = WSP(F, WS_YS, bf16_t);
    const int tid = F.tid, lane = F.lane, wid = F.wave;
    const bool is_comp = wid < 4;
    const int ri = wid & 3;
    if (is_comp) __builtin_amdgcn_s_setprio(3);
    const int g = lane >> 3, j = lane & 7, rowl = ri * 8 + g;
    const int mt = ri * 64 + lane, mw = ri;
    int cvt_it = F.vcu * 4 + mw; f32x4 cvv[16]; int ck0 = 0, crowb = 0; unsigned char* cWT = nullptr;
    f32x4 cvvB[16]; int ck0B = 0, crowbB = 0; unsigned char* cWTB = nullptr;
    LAS unsigned* st_cnt = (LAS unsigned*)(F.lds + CVT_SCR + 4 * 4096); LAS unsigned* cons_cnt = st_cnt + 16;
    for (int item = F.vcu; item < 256; item += F.G) {
        const int chain = item >> 1, half = item & 1, d = chain >> 6, b = (chain >> 4) & 3, h = chain & 15;
        const size_t sh = (size_t)b * SEQ * 1024 + h * 64, pd = (size_t)d * MTOK * 1024 + sh;
        f32x2 S2[4] = {{0.f, 0.f}, {0.f, 0.f}, {0.f, 0.f}, {0.f, 0.f}};
        u32x2 rw[2], rkk[2], rbb[2], rkd[2], rr[2]; unsigned rv[2];
        const int cstep = d ? -CH * 1024 : CH * 1024;
        unsigned po[2], pv[2];
#pragma unroll
        for (int q_ = 0; q_ < 2; ++q_) { const int sl_ = mt + 256 * q_, ss_ = sl_ >> 4, sk_ = (sl_ & 15) * 4, tq_ = d ? (SEQ - 1 - ss_) : ss_; po[q_] = (unsigned)(tq_ * 1024 + sk_); pv[q_] = (unsigned)(tq_ * 1024 + half * 32 + 2 * (sl_ & 15)); }
        const char* bW = (const char*)(Wdec + pd); const char* bKK = (const char*)(KKg + sh); const char* bBB = (const char*)(BBg + pd); const char* bKD = (const char*)(KDg + pd); const char* bR = (const char*)(Rg + sh); const char* bV = (const char*)(Vg + sh);
#define SC_LOAD(c) do { const unsigned cu_ = (unsigned)((c) * cstep); _Pragma("unroll") for (int q_ = 0; q_ < 2; ++q_) { const unsigned e_ = po[q_] + cu_; \
        rw[q_] = *(const u32x2*)(bW + (size_t)(e_ * 2u)); rkk[q_] = *(const u32x2*)(bKK + (size_t)(e_ * 2u)); rbb[q_] = *(const u32x2*)(bBB + (size_t)(e_ * 2u)); rkd[q_] = *(const u32x2*)(bKD + (size_t)(e_ * 2u)); rr[q_] = *(const u32x2*)(bR + (size_t)(e_ * 2u)); \
        rv[q_] = *(const unsigned*)(bV + (size_t)((pv[q_] + cu_) * 2u)); } } while (0)
#define SC_STORE(bufi) do { LAS unsigned char* bp_ = F.lds + (bufi) * BUF; _Pragma("unroll") for (int q_ = 0; q_ < 2; ++q_) { const int sl_ = mt + 256 * q_, ss_ = sl_ >> 4, sk_ = (sl_ & 15) * 4; const int o_ = (ss_ * 64 + sk_) * 4; \
        *(LAS f32x4*)(bp_ + o_) = (f32x4){__expf(-bf_lo(rw[q_].x)), __expf(-bf_hi(rw[q_].x)), __expf(-bf_lo(rw[q_].y)), __expf(-bf_hi(rw[q_].y))}; \
        *(LAS f32x4*)(bp_ + VEC + o_) = (f32x4){bf_lo(rkk[q_].x), bf_hi(rkk[q_].x), bf_lo(rkk[q_].y), bf_hi(rkk[q_].y)}; \
        *(LAS f32x4*)(bp_ + 2 * VEC + o_) = (f32x4){bf_lo(rbb[q_].x), bf_hi(rbb[q_].x), bf_lo(rbb[q_].y), bf_hi(rbb[q_].y)}; \
        *(LAS f32x4*)(bp_ + 3 * VEC + o_) = (f32x4){bf_lo(rkd[q_].x), bf_hi(rkd[q_].x), bf_lo(rkd[q_].y), bf_hi(rkd[q_].y)}; \
        *(LAS f32x4*)(bp_ + 4 * VEC + o_) = (f32x4){bf_lo(rr[q_].x), bf_hi(rr[q_].x), bf_lo(rr[q_].y), bf_hi(rr[q_].y)}; \
        *(LAS f32x2*)(bp_ + 5 * VEC + (ss_ * 32 + 2 * (sl_ & 15)) * 4) = (f32x2){bf_lo(rv[q_]), bf_hi(rv[q_])}; } } while (0)
#define Y_OUT(c) do { const int ys_ = mt >> 3, yr_ = (mt & 7) * 4; const int tt_ = (c) * CH + ys_, t_ = d ? (SEQ - 1 - tt_) : tt_; \
        const f32x4 yv_ = *(const LAS f32x4*)(F.lds + YOFF + ((c) & 1) * YB + (ys_ * 32 + yr_) * 4); \
        *(u32x2*)(YS + pd + (size_t)t_ * 1024 + half * 32 + yr_) = (u32x2){cvtpk(yv_.x, yv_.y), cvtpk(yv_.z, yv_.w)}; } while (0)
#define SC_WAIT(cnt_, tgt_) do { for (;;) { const u32x4 q_ = *(volatile LAS u32x4*)(cnt_); const unsigned a_ = q_.x < q_.y ? q_.x : q_.y, b_ = q_.z < q_.w ? q_.z : q_.w; \
        if ((a_ < b_ ? a_ : b_) >= (tgt_)) break; if (is_comp) __builtin_amdgcn_s_sleep(1); else __builtin_amdgcn_s_sleep(12); } asm volatile("" ::: "memory"); } while (0)
#define SC_SIGNAL(cnt_, val_) do { asm volatile("s_waitcnt lgkmcnt(0)" ::: "memory"); if (lane == 0) *(volatile LAS unsigned*)((cnt_) + ri) = (val_); } while (0)
        __syncthreads();
        if (tid < 4) { st_cnt[tid] = 0u; cons_cnt[tid] = 0u; }
        if (!is_comp) { SC_LOAD(0); SC_STORE(0); SC_LOAD(1); }
        __syncthreads();
        if (is_comp) {
          for (int c = 0; c < NCH; ++c) {
            SC_WAIT(st_cnt, (unsigned)c);
            if (mode != 2) {
                const LAS unsigned char* bp = F.lds + (c & 1) * BUF;
                LAS float* yb = (LAS float*)(F.lds + YOFF + (c & 1) * YB);
                f32x4 cw_[2], ckk[2], cbb[2], ckd[2], cr[2]; float cv;
#define SC_RD(s_) do { const int o_ = ((s_) * 64 + j * 8) * 4; cw_[0] = *(const LAS f32x4*)(bp + o_); cw_[1] = *(const LAS f32x4*)(bp + o_ + 16); ckk[0] = *(const LAS f32x4*)(bp + VEC + o_); ckk[1] = *(const LAS f32x4*)(bp + VEC + o_ + 16); \
                cbb[0] = *(const LAS f32x4*)(bp + 2 * VEC + o_); cbb[1] = *(const LAS f32x4*)(bp + 2 * VEC + o_ + 16); ckd[0] = *(const LAS f32x4*)(bp + 3 * VEC + o_); ckd[1] = *(const LAS f32x4*)(bp + 3 * VEC + o_ + 16); \
                cr[0] = *(const LAS f32x4*)(bp + 4 * VEC + o_); cr[1] = *(const LAS f32x4*)(bp + 4 * VEC + o_ + 16); cv = *(const LAS float*)(bp + 5 * VEC + ((s_) * 32 + rowl) * 4); } while (0)
#define H2(v_, i_) ((f32x2){v_[(i_) >> 1][((i_) & 1) * 2], v_[(i_) >> 1][((i_) & 1) * 2 + 1]})
                SC_RD(0);
                float yk = 0.f;
#pragma unroll
                for (int s = 0; s < CH; ++s) {
                    f32x4 w[2] = {cw_[0], cw_[1]}, kk[2] = {ckk[0], ckk[1]}, bb[2] = {cbb[0], cbb[1]}, kd[2] = {ckd[0], ckd[1]}, r[2] = {cr[0], cr[1]}; const float v = cv;
                    if (s + 1 < CH) SC_RD(s + 1);
                    f32x2 pa = S2[0] * H2(kk, 0), pb = S2[1] * H2(kk, 1); pa = S2[2] * H2(kk, 2) + pa; pb = S2[3] * H2(kk, 3) + pb; pa = pa + pb;
                    const f32x2 vv = {v, v};
                    f32x2 u[4];
#pragma unroll
                    for (int i = 0; i < 4; ++i) u[i] = S2[i] * H2(w, i) + vv * H2(kd, i);
                    float p = pa.x + pa.y;
                    p = dpp_add<0xB1>(p); p = dpp_add<0x4E>(p); p = dpp_add<0x141>(p);
                    const f32x2 sa = {-p, -p};
#pragma unroll
                    for (int i = 0; i < 4; ++i) S2[i] = sa * H2(bb, i) + u[i];
                    f32x2 ya = S2[0] * H2(r, 0), yc = S2[1] * H2(r, 1); ya = S2[2] * H2(r, 2) + ya; yc = S2[3] * H2(r, 3) + yc; ya = ya + yc;
                    float y = ya.x + ya.y;
                    y = dpp_add<0xB1>(y); y = dpp_add<0x4E>(y); y = dpp_add<0x141>(y);
                    yk = (j == (s & 7)) ? y : yk;
                    if ((s & 7) == 7) yb[((s & 24) + j) * 32 + rowl] = yk;
                }
#undef SC_RD
#undef H2
            }
            SC_SIGNAL(cons_cnt, (unsigned)(c + 1));
          }
        } else {
#define MEM_DUTIES(c_) do { SC_WAIT(cons_cnt, (unsigned)(c_)); if ((c_) >= 1 && mode != 2) Y_OUT((c_) - 1); if ((c_) + 1 < NCH) SC_STORE(((c_) + 1) & 1); SC_SIGNAL(st_cnt, (unsigned)((c_) + 1)); if ((c_) + 2 < NCH) SC_LOAD((c_) + 2); } while (0)
#define CVT_LOAD_SET(V_, K0_, WT_, RB_) do { const int it_ = cvt_it < N_EXPERT_ITEMS ? cvt_it : N_EXPERT_ITEMS - 1; const float* cW_; int cn0_; cvt_expert_decode(F, it_, cW_, K0_, cn0_, WT_, RB_); cvt8_load(V_, cW_, K0_, cn0_, lane); cvt_it += F.G * 4; } while (0)
          if (item == F.vcu) { P5aConst p5k; p5a_init(F, p5k); for (int xm = F.vcu * 4 + mw; xm < MTOK; xm += F.G * 4) p5a_token(F, p5k, xm); }
          int ngrp = 0; { const int left = (N_EXPERT_ITEMS - cvt_it + F.G * 4 - 1) / (F.G * 4); ngrp = left > 0 ? left / 3 : 0; if (ngrp > NCH / 4) ngrp = NCH / 4; }
          int cg = 0;
#pragma unroll 1
          for (; cg < 4 * ngrp; cg += 4) {
            MEM_DUTIES(cg);
#if CVT_IN_SCAN
            if (cg > 0) cvt8_finish(cvv, ck0, cWT, crowb, lane);
            CVT_LOAD_SET(cvv, ck0, cWT, crowb);
#endif
            MEM_DUTIES(cg + 1);
#if CVT_IN_SCAN
            CVT_LOAD_SET(cvvB, ck0B, cWTB, crowbB);
#endif
            MEM_DUTIES(cg + 2);
#if CVT_IN_SCAN
            cvt8_finish(cvv, ck0, cWT, crowb, lane);
            CVT_LOAD_SET(cvv, ck0, cWT, crowb);
#endif
            MEM_DUTIES(cg + 3);
#if CVT_IN_SCAN
            cvt8_finish(cvvB, ck0B, cWTB, crowbB, lane);
#endif
          }
#if CVT_IN_SCAN
          if (ngrp > 0) cvt8_finish(cvv, ck0, cWT, crowb, lane);
#endif
#pragma unroll 1
          for (; cg < NCH; ++cg) MEM_DUTIES(cg);
#undef MEM_DUTIES
#undef CVT_LOAD_SET
          SC_WAIT(cons_cnt, (unsigned)NCH);
        }
        if (!is_comp && mode != 2) Y_OUT(NCH - 1);
#undef SC_LOAD
#undef SC_STORE
#undef Y_OUT
#undef SC_WAIT
#undef SC_SIGNAL
    }
    __builtin_amdgcn_s_setprio(0);
#if CVT_IN_SCAN
    if (!is_comp) {
        for (; cvt_it < N_EXPERT_ITEMS; cvt_it += F.G * 4) {
            const float* W; int k0, n0, rowb; unsigned char* WT;
            cvt_expert_decode(F, cvt_it, W, k0, n0, WT, rowb); cvt8_load(cvv, W, k0, n0, lane); cvt8_finish(cvv, k0, WT, rowb, lane);
        }
    }
#endif
}

__device__ __forceinline__ void p5_finalize(Frame& F) {
    const bf16_t* YS = WSP(F, WS_YS, bf16_t); const bf16_t* Vg = WSP(F, WS_V, bf16_t); const bf16_t* Gg = WSP(F, WS_G, bf16_t);
    const float* BON = WSP(F, WS_BONUS, float); bf16_t* MIX = WSP(F, WS_MIX, bf16_t);
    const float* lnw = INP(F, 19, float); const float* lnb = INP(F, 20, float);
    const int lane = F.lane, gw = F.vcu * 8 + F.wave, NGW = F.G * 8;
    const int c0 = lane * 16;
    float lw[16], lb[16];
#pragma unroll
    for (int i = 0; i < 16; ++i) { lw[i] = lnw[c0 + i]; lb[i] = lnb[c0 + i]; }
    struct Raw { u32x4 a0, a1, b0, b1, v0, v1, g0, g1; float bon; };
#define P5_LOAD(R_, m_) do { const u32x4* y0_ = (const u32x4*)(YS + (size_t)(m_) * 1024 + c0); const u32x4* y1_ = (const u32x4*)(YS + (size_t)MTOK * 1024 + (size_t)(m_) * 1024 + c0); \
        const u32x4* vp_ = (const u32x4*)(Vg + (size_t)(m_) * 1024 + c0); const u32x4* gp_ = (const u32x4*)(Gg + (size_t)(m_) * 1024 + c0); \
        R_.a0 = y0_[0]; R_.a1 = y0_[1]; R_.b0 = y1_[0]; R_.b1 = y1_[1]; R_.v0 = vp_[0]; R_.v1 = vp_[1]; R_.g0 = gp_[0]; R_.g1 = gp_[1]; R_.bon = BON[(size_t)(m_) * 16 + (lane >> 2)]; } while (0)
#define P5_FINISH(R_, m_) do { float y[16]; float s_ = 0.f; \
        { const unsigned aw[8] = {R_.a0.x, R_.a0.y, R_.a0.z, R_.a0.w, R_.a1.x, R_.a1.y, R_.a1.z, R_.a1.w}, bw[8] = {R_.b0.x, R_.b0.y, R_.b0.z, R_.b0.w, R_.b1.x, R_.b1.y, R_.b1.z, R_.b1.w}; \
          _Pragma("unroll") for (int i = 0; i < 8; ++i) { y[2 * i] = bf_lo(aw[i]) + bf_lo(bw[i]); y[2 * i + 1] = bf_hi(aw[i]) + bf_hi(bw[i]); } } \
        _Pragma("unroll") for (int i = 0; i < 16; ++i) s_ += y[i]; \
        s_ += __shfl_xor(s_, 1); s_ += __shfl_xor(s_, 2);                                              \
        const float mu_ = s_ * (1.f / 64.f); float q_ = 0.f; \
        _Pragma("unroll") for (int i = 0; i < 16; ++i) { y[i] -= mu_; q_ += y[i] * y[i]; } \
        q_ += __shfl_xor(q_, 1); q_ += __shfl_xor(q_, 2); \
        const float rstd_ = 1.f / sqrtf(q_ * (1.f / 64.f) + 64e-5f); \
        const unsigned vw[8] = {R_.v0.x, R_.v0.y, R_.v0.z, R_.v0.w, R_.v1.x, R_.v1.y, R_.v1.z, R_.v1.w}, gq[8] = {R_.g0.x, R_.g0.y, R_.g0.z, R_.g0.w, R_.g1.x, R_.g1.y, R_.g1.z, R_.g1.w}; \
        unsigned ow[8]; \
        _Pragma("unroll") for (int i = 0; i < 8; ++i) { \
            const float e0 = (y[2 * i] * rstd_ * lw[2 * i] + lb[2 * i] + R_.bon * bf_lo(vw[i])) * bf_lo(gq[i]); \
            const float e1 = (y[2 * i + 1] * rstd_ * lw[2 * i + 1] + lb[2 * i + 1] + R_.bon * bf_hi(vw[i])) * bf_hi(gq[i]); \
            ow[i] = cvtpk(e0, e1); } \
        u32x4* op = (u32x4*)(MIX + (size_t)(m_) * 2048 + 1024 + c0); op[0] = (u32x4){ow[0], ow[1], ow[2], ow[3]}; op[1] = (u32x4){ow[4], ow[5], ow[6], ow[7]}; } while (0)
    for (int m = gw; m < MTOK; m += 2 * NGW) {
        const int m2 = m + NGW; const bool has2 = m2 < MTOK;
        Raw ra, rb; P5_LOAD(ra, m); if (has2) P5_LOAD(rb, m2);
        P5_FINISH(ra, m); if (has2) P5_FINISH(rb, m2);
    }
#undef P5_LOAD
#undef P5_FINISH
}

__device__ __forceinline__ void p7_router(Frame& F) {
    const bf16_t* X1 = WSP(F, WS_X1, bf16_t); const float* nw = INP(F, 22, float); const float* wr = INP(F, 23, float);
    unsigned char* H2 = WSP(F, WS_H2, unsigned char); float* AFF = WSP(F, WS_AFF, float);
    const int lane = F.lane, w = F.wave, tok = lane & 15, kq = lane >> 4;
    LAS float* part = (LAS float*)F.lds;
    LAS float* ssqp = (LAS float*)(F.lds + 8192);
    const int kb = 256 * w + 8 * kq;
    float Bw[8][8];
#pragma unroll
    for (int g = 0; g < 8; ++g)
#pragma unroll
        for (int e = 0; e < 8; ++e) { const int k = kb + 32 * g + e; Bw[g][e] = nw[k] * wr[(size_t)k * 16 + tok]; }
    for (int item = F.vcu; item < MTOK / 16; item += F.G) {
        const int m0 = item * 16;
        u32x4 xr[8];
        const bf16_t* xp = X1 + (size_t)(m0 + tok) * DM + kb;
#pragma unroll
        for (int g = 0; g < 8; ++g) xr[g] = *(const u32x4*)(xp + 32 * g);
        f32x4 acc = {0.f, 0.f, 0.f, 0.f}; float ss = 0.f;
#pragma unroll
        for (int g = 0; g < 8; ++g) {
            float x[8]; unpack8(xr[g], x);
#pragma unroll
            for (int e = 0; e < 8; ++e) { ss += x[e] * x[e]; acc = __builtin_amdgcn_mfma_f32_16x16x4f32(x[e], Bw[g][e], acc, 0, 0, 0); }
        }
        __syncthreads();
        *(LAS f32x4*)(part + w * 256 + tok * 16 + 4 * kq) = acc;
        ss += __shfl_xor(ss, 16); ss += __shfl_xor(ss, 32);
        if (kq == 0) ssqp[w * 16 + tok] = ss;
        __syncthreads();
        float tot = 0.f;
#pragma unroll
        for (int i = 0; i < 8; ++i) tot += ssqp[i * 16 + tok];
        const float rstd = 1.f / sqrtf(tot * (1.f / DM) + 1e-6f);
        { unsigned char* hp = H2 + (size_t)(m0 + tok) * DM + kb;
#pragma unroll
          for (int g = 0; g < 8; ++g) { float x[8]; unpack8(xr[g], x); const f32x4 n0 = *(const f32x4*)(nw + kb + 32 * g), n1 = *(const f32x4*)(nw + kb + 32 * g + 4);
              u32x2 o; o.x = pg8::cvt4_fp8(x[0] * rstd * n0.x, x[1] * rstd * n0.y, x[2] * rstd * n0.z, x[3] * rstd * n0.w); o.y = pg8::cvt4_fp8(x[4] * rstd * n1.x, x[5] * rstd * n1.y, x[6] * rstd * n1.z, x[7] * rstd * n1.w);
              *(u32x2*)(hp + 32 * g) = o; } }
        if (lane < 32) {
            const int tt = 2 * w + (lane >> 4), ex = lane & 15;
            float lg = 0.f, t2 = 0.f;
#pragma unroll
            for (int i = 0; i < 8; ++i) { lg += part[i * 256 + ex * 16 + tt]; t2 += ssqp[i * 16 + tt]; }
            lg *= 1.f / sqrtf(t2 * (1.f / DM) + 1e-6f);
            float mx = lg;
            mx = fmaxf(mx, __shfl_xor(mx, 1)); mx = fmaxf(mx, __shfl_xor(mx, 2)); mx = fmaxf(mx, __shfl_xor(mx, 4)); mx = fmaxf(mx, __shfl_xor(mx, 8));
            const float pe = expf(lg - mx);
            float den = pe; den += __shfl_xor(den, 1); den += __shfl_xor(den, 2); den += __shfl_xor(den, 4); den += __shfl_xor(den, 8);
            const int mm = m0 + tt;
            AFF[((size_t)(mm >> 11) * 16 + ex) * SEQ + (mm & (SEQ - 1))] = pe / den;
        }
    }
    __syncthreads();
}

__device__ __forceinline__ int wave_count4(bool f0, bool f1, bool f2, bool f3) {
    return __builtin_popcountll(__ballot(f0)) + __builtin_popcountll(__ballot(f1)) + __builtin_popcountll(__ballot(f2)) + __builtin_popcountll(__ballot(f3));
}
__device__ __forceinline__ void p8_select(Frame& F) {
    const float* AFF = WSP(F, WS_AFF, float);
    int* XEIDX = WSP(F, WS_XEIDX, int); float* GATEX = WSP(F, WS_GATEX, float); int* SLOT = WSP(F, WS_SLOT, int);
    LAS int* part = (LAS int*)F.lds;
    LAS unsigned* cnt = (LAS unsigned*)(F.lds + 256);
    LAS unsigned* list = (LAS unsigned*)(F.lds + 512);
    const int tid = F.tid, lane = F.lane, w = F.wave;
    for (int item = F.vcu; item < 256; item += F.G) {
        const int be = item >> 2, q = item & 3, b = be >> 4, e = be & 15;
        __syncthreads();
        if (tid == 0) *cnt = 0u;
        const f32x4 a4 = ((const f32x4*)(AFF + (size_t)be * SEQ))[tid];
        const unsigned u0 = __float_as_uint(a4.x), u1 = __float_as_uint(a4.y), u2 = __float_as_uint(a4.z), u3 = __float_as_uint(a4.w);
        unsigned lo = 0u, hi = 0x7f800001u;
        int itn = 0;
        while (hi - lo > 1u) {
            const unsigned mid = lo + ((hi - lo) >> 1);
            const int c = wave_count4(u0 >= mid, u1 >= mid, u2 >= mid, u3 >= mid);
            LAS int* pp = part + (itn & 1) * 8;
            if (lane == 0) pp[w] = c;
            __syncthreads();
            int tot = 0;
#pragma unroll
            for (int i = 0; i < 8; ++i) tot += pp[i];
            if (tot >= CAP) lo = mid; else hi = mid;
            ++itn;
        }
        const unsigned T = lo;
        const bool g0 = u0 > T, g1 = u1 > T, g2 = u2 > T, g3 = u3 > T, q0 = u0 == T, q1 = u1 == T, q2 = u2 == T, q3 = u3 == T;
        const unsigned long long bg0 = __ballot(g0), bg1 = __ballot(g1), bg2 = __ballot(g2), bg3 = __ballot(g3), bq0 = __ballot(q0), bq1 = __ballot(q1), bq2 = __ballot(q2), bq3 = __ballot(q3);
        const unsigned long long below = (lane == 0) ? 0ull : (~0ull >> (64 - lane));
        int pg = __builtin_popcountll(bg0 & below) + __builtin_popcountll(bg1 & below) + __builtin_popcountll(bg2 & below) + __builtin_popcountll(bg3 & below);
        int pq = __builtin_popcountll(bq0 & below) + __builtin_popcountll(bq1 & below) + __builtin_popcountll(bq2 & below) + __builtin_popcountll(bq3 & below);
        const int wg = __builtin_popcountll(bg0) + __builtin_popcountll(bg1) + __builtin_popcountll(bg2) + __builtin_popcountll(bg3);
        const int wq = __builtin_popcountll(bq0) + __builtin_popcountll(bq1) + __builtin_popcountll(bq2) + __builtin_popcountll(bq3);
        if (lane == 0) { part[16 + w] = wg; part[32 + w] = wq; }
        __syncthreads();
        int gtc = 0, baseg = 0, baseq = 0;
#pragma unroll
        for (int i = 0; i < 8; ++i) { const int x = part[16 + i], y = part[32 + i]; gtc += x; if (i < w) { baseg += x; baseq += y; } }
        const int need = CAP - gtc;
        pg += baseg; pq += baseq;
        if ((w >> 1) == q) {
            const bool gs[4] = {g0, g1, g2, g3}, qs[4] = {q0, q1, q2, q3}; const float av[4] = {a4.x, a4.y, a4.z, a4.w};
            int cg_ = pg, cq_ = pq;
#pragma unroll
            for (int i = 0; i < 4; ++i) {
                const int t = 4 * tid + i, m = b * SEQ + t; int slot = -1;
                if (gs[i]) { slot = cg_; ++cg_; } else if (qs[i]) { if (cq_ < need) slot = gtc + cq_; ++cq_; }
                SLOT[m * 16 + e] = slot;
                if (slot >= 0) { GATEX[(e * 4 + b) * CAP + slot] = av[i]; XEIDX[(e * 4 + b) * CAP + slot] = m; }
            }
        }
    }
}

__device__ __forceinline__ void p11_final(Frame& F) {
    const bf16_t* X1 = WSP(F, WS_X1, bf16_t); const unsigned char* YE = WSP(F, WS_YE, unsigned char); const int* SLOT = WSP(F, WS_SLOT, int); const float* nw = INP(F, 27, float);
    float* out = F.a->out;
    const int lane = F.lane, gw = F.vcu * 8 + F.wave, NGW = F.G * 8;
    for (int mA = gw; mA < MTOK; mA += 2 * NGW) {
        const int mB = mA + NGW; const bool hasB = mB < MTOK; const int mBc = hasB ? mB : mA;
        int slA = (lane < 16) ? SLOT[mA * 16 + lane] : -1, slB = (lane < 16 && hasB) ? SLOT[mBc * 16 + lane] : -1;
        u32x4 xa[4], xb[4];
        { const u32x4* xr = (const u32x4*)(X1 + (size_t)mA * DM + lane * 8); const u32x4* xs = (const u32x4*)(X1 + (size_t)mBc * DM + lane * 8);
#pragma unroll
          for (int j = 0; j < 4; ++j) { xa[j] = xr[64 * j]; xb[j] = xs[64 * j]; } }
        unsigned mkA = (unsigned)(__ballot(slA >= 0) & 0xFFFFull), mkB = (unsigned)(__ballot(slB >= 0) & 0xFFFFull);
        float va[32], vb[32];
#pragma unroll
        for (int j = 0; j < 4; ++j) { const u32x4 a = xa[j], c = xb[j];
            va[8 * j] = bf_lo(a.x); va[8 * j + 1] = bf_hi(a.x); va[8 * j + 2] = bf_lo(a.y); va[8 * j + 3] = bf_hi(a.y); va[8 * j + 4] = bf_lo(a.z); va[8 * j + 5] = bf_hi(a.z); va[8 * j + 6] = bf_lo(a.w); va[8 * j + 7] = bf_hi(a.w);
            vb[8 * j] = bf_lo(c.x); vb[8 * j + 1] = bf_hi(c.x); vb[8 * j + 2] = bf_lo(c.y); vb[8 * j + 3] = bf_hi(c.y); vb[8 * j + 4] = bf_lo(c.z); vb[8 * j + 5] = bf_hi(c.z); vb[8 * j + 6] = bf_lo(c.w); vb[8 * j + 7] = bf_hi(c.w); }
        const int bA = mA >> 11, bB = mBc >> 11;
        while (mkA | mkB) {
            u32x2 ra[2][4], rb[2][4];
#pragma unroll
            for (int q = 0; q < 2; ++q) {
                if (mkA) { const int e = __builtin_ctz(mkA); mkA &= mkA - 1u; const int sl = __builtin_amdgcn_readlane(slA, e);
                    const u32x2* yr = (const u32x2*)(YE + (size_t)((e * 4 + bA) * CAP + sl) * DM + lane * 8);
#pragma unroll
                    for (int j = 0; j < 4; ++j) ra[q][j] = yr[64 * j]; }
                else {
#pragma unroll
                    for (int j = 0; j < 4; ++j) ra[q][j] = (u32x2){0u, 0u}; }
                if (mkB) { const int e = __builtin_ctz(mkB); mkB &= mkB - 1u; const int sl = __builtin_amdgcn_readlane(slB, e);
                    const u32x2* yr = (const u32x2*)(YE + (size_t)((e * 4 + bB) * CAP + sl) * DM + lane * 8);
#pragma unroll
                    for (int j = 0; j < 4; ++j) rb[q][j] = yr[64 * j]; }
                else {
#pragma unroll
                    for (int j = 0; j < 4; ++j) rb[q][j] = (u32x2){0u, 0u}; }
            }
#define P11_ACC(V_, W_, q_) do { V_[8 * j + (q_)] += __builtin_amdgcn_cvt_f32_fp8(W_.x, q_) * pg8::YE_DESCALE; V_[8 * j + 4 + (q_)] += __builtin_amdgcn_cvt_f32_fp8(W_.y, q_) * pg8::YE_DESCALE; } while (0)
#pragma unroll
            for (int q = 0; q < 2; ++q)
#pragma unroll
                for (int j = 0; j < 4; ++j) { const u32x2 wa = ra[q][j], wb = rb[q][j];
                    P11_ACC(va, wa, 0); P11_ACC(va, wa, 1); P11_ACC(va, wa, 2); P11_ACC(va, wa, 3); P11_ACC(vb, wb, 0); P11_ACC(vb, wb, 1); P11_ACC(vb, wb, 2); P11_ACC(vb, wb, 3); }
#undef P11_ACC
        }
        float sa = 0.f, sb = 0.f;
#pragma unroll
        for (int i = 0; i < 32; ++i) { sa += va[i] * va[i]; sb += vb[i] * vb[i]; }
        const float rsa = 1.f / sqrtf(wave_sum(sa) * (1.f / DM) + 1e-6f), rsb = 1.f / sqrtf(wave_sum(sb) * (1.f / DM) + 1e-6f);
#pragma unroll
        for (int j = 0; j < 4; ++j) { const int col = 512 * j + lane * 8; const f32x4 w0 = *(const f32x4*)(nw + col), w1 = *(const f32x4*)(nw + col + 4);
            { f32x4 o0 = {va[8 * j] * rsa * w0.x, va[8 * j + 1] * rsa * w0.y, va[8 * j + 2] * rsa * w0.z, va[8 * j + 3] * rsa * w0.w};
              f32x4 o1 = {va[8 * j + 4] * rsa * w1.x, va[8 * j + 5] * rsa * w1.y, va[8 * j + 6] * rsa * w1.z, va[8 * j + 7] * rsa * w1.w};
              *(f32x4*)(out + (size_t)mA * DM + col) = o0; *(f32x4*)(out + (size_t)mA * DM + col + 4) = o1; }
            if (hasB) { f32x4 o0 = {vb[8 * j] * rsb * w0.x, vb[8 * j + 1] * rsb * w0.y, vb[8 * j + 2] * rsb * w0.z, vb[8 * j + 3] * rsb * w0.w};
              f32x4 o1 = {vb[8 * j + 4] * rsb * w1.x, vb[8 * j + 5] * rsb * w1.y, vb[8 * j + 6] * rsb * w1.z, vb[8 * j + 7] * rsb * w1.w};
              *(f32x4*)(out + (size_t)mB * DM + col) = o0; *(f32x4*)(out + (size_t)mB * DM + col + 4) = o1; } }
    }
}


template <int PHM> __global__ void __launch_bounds__(512, 2) mk_fwd(Args args) {
    extern __shared__ __attribute__((aligned(16))) unsigned char lds[];
    Frame F;
    F.lds = (LAS unsigned char*)lds; F.ldsg = (char*)lds; F.a = &args;
    F.tid = threadIdx.x; F.lane = F.tid & 63; F.wave = __builtin_amdgcn_readfirstlane(F.tid >> 6);
    F.G = gridDim.x; { const int bx = blockIdx.x; F.vcu = (F.G % 8 == 0) ? (bx % 8) * (F.G / 8) + bx / 8 : bx; }
    volatile LAS unsigned* MISC = (volatile LAS unsigned*)(F.lds + MISC_OFF);
    for (int u = F.tid; u < (LDS_BYTES - 131072) / 4; u += 512) ((LAS unsigned*)(F.lds + 131072))[u] = 0u;
    __syncthreads();
    gu32* ctl = (gu32*)(args.ws + WS_CTL);
    XcdBarrier bar; bar.bar = (unsigned*)(ctl + CW_BAR); bar.x = 0; bar.st = nullptr;
    if (MK_N_LAUNCHES == 1) bar = xcd_barrier_post((unsigned*)(ctl + CW_BAR), MISC + 8);
    const int lo = args.ph_lo, hi = args.ph_hi;
#define IN(k) (((PHM >> (k)) & 1) && lo <= (k) && (k) < hi)
#ifndef DUP_MASK
#define DUP_MASK 0
#endif
#define REP(k) for (int rep_ = 0; rep_ < 1 + ((DUP_MASK >> (k)) & 1); ++rep_)
#define SEAM(k) do { if (IN(k) && IN((k) + 1)) xcd_barrier(bar); } while (0)

    if (IN(0)) REP(0) { p0_prologue(F); }
    SEAM(0);
    if (IN(1)) REP(1) {
        pg8::Gemm g{WSP(F, WS_H1, bf16_t), WSP(F, WS_WIN, bf16_t), MTOK, 6144, DM, DM}; pg8::StaticOrder S; S.init(MTOK, 6144, F.G, (int)blockIdx.x);
        pg8::EpiProj E{WSP(F, WS_PROJ, bf16_t), LDP, WSP(F, WS_ROPE, float), QSCALE};
        pg8::gemm_phase<pg8::EpiProj, pg8::StaticOrder, true, true>(F.lds, g, S, E);
        pg8::Gemm g2{WSP(F, WS_H1, bf16_t), WSP(F, WS_WIN, bf16_t), MTOK, 512, DM / 4, DM}; pg8::TailOrder S2{F.G, (int)blockIdx.x};
        pg8::EpiPart E2{WSP(F, WS_PART, bf16_t)};
        pg8::gemm_phase<pg8::EpiPart, pg8::TailOrder, true, true>(F.lds, g2, S2, E2);
    }
    SEAM(1);
    const bool prep_first = (F.vcu & 1) != 0;
    if (IN(3) && prep_first) { p3_prep(F, 0); }
    if (IN(2)) {
        const bf16_t* P = WSP(F, WS_PROJ, bf16_t); bf16_t* OC = WSP(F, WS_OC, bf16_t);
        for (int u = F.vcu * 2; u < 512; u += F.G * 2)
            for (int i = 0; i < 2; ++i) {
                const int uu = u + i, qb = uu & 7, c = (uu >> 3) & 1, h = (uu >> 4) & 7, b = uu >> 7;
                const size_t m0 = (size_t)b * SEQ;
                att::attn_unit<LDP>(P + (m0 + qb * 256) * LDP + h * 128 + c * 64, P + m0 * LDP + 1024 + h * 128 + c * 64, P + m0 * LDP + 2048 + h * 128,
                                    OC + (size_t)c * MTOK * 1024 + (m0 + qb * 256) * 1024 + h * 128, SEQ, F.ldsg);
            }
    }
    if (IN(3) && !prep_first) { p3_prep(F, 0); }
    SEAM(3);
    #ifndef SCAN_PROBE
#define SCAN_PROBE 0
#endif
    if (IN(4)) REP(4) { p4_scan(F, rep_ ? SCAN_PROBE : 0); }
    SEAM(4);
    if (IN(5)) REP(5) { p5_finalize(F); }
    SEAM(5);
    if (IN(6)) REP(6) {
        pg8::Gemm g{WSP(F, WS_MIX, bf16_t), WSP(F, WS_WOUT, bf16_t), MTOK, DM, DM, DM}; pg8::StaticOrder S; S.init(MTOK, DM, F.G, (int)blockIdx.x);
        pg8::EpiResid E{INP(F, 0, float), WSP(F, WS_X1, bf16_t), DM};
        pg8::gemm_phase<pg8::EpiResid, pg8::StaticOrder, true, true>(F.lds, g, S, E);
    }
    SEAM(6);
    if (IN(7)) REP(7) { p7_router(F); }
    SEAM(7);
    if (IN(8)) REP(8) { p8_select(F); }
    SEAM(8);
    if (IN(9)) REP(9) {
        pg8::Gemm g{WSP(F, WS_H2, bf16_t), WSP(F, WS_WGU, bf16_t), 16384, 65536, DM / 2, DM / 2}; pg8::MoeOrderT<true> S{F.G, F.vcu, 16, 1024, WSP(F, WS_XEIDX, int)};
        pg8::EpiSwiglu E{WSP(F, WS_HID, unsigned char), 16};
        pg8::gemm_phase<pg8::EpiSwiglu, pg8::MoeOrderT<true>, true, true, true>(F.lds, g, S, E);
    }
    SEAM(9);
    if (IN(10)) REP(10) {
        pg8::Gemm g{WSP(F, WS_HID, bf16_t), WSP(F, WS_WD, bf16_t), 16384, 32768, DM / 2, DM / 2}; pg8::MoeOrderT<false> S{F.G, F.vcu, 8, 512, nullptr};
        pg8::EpiDown E{WSP(F, WS_YE, unsigned char), WSP(F, WS_GATEX, float), 8};
        pg8::gemm_phase<pg8::EpiDown, pg8::MoeOrderT<false>, true, true, true>(F.lds, g, S, E);
    }
    SEAM(10);
    if (IN(11)) REP(11) { p11_final(F); }
#undef IN
#undef SEAM
}

static const void* kfn(int li) {
#if MK_N_LAUNCHES == 1
    (void)li; return (const void*)mk_fwd<0xFFF>;
#else
    switch (li) {
        case 0: return (const void*)mk_fwd<1>; case 1: return (const void*)mk_fwd<2>; case 2: return (const void*)mk_fwd<4>; case 3: return (const void*)mk_fwd<8>;
        case 4: return (const void*)mk_fwd<16>; case 5: return (const void*)mk_fwd<32>; case 6: return (const void*)mk_fwd<64>; case 7: return (const void*)mk_fwd<128>;
        case 8: return (const void*)mk_fwd<256>; case 9: return (const void*)mk_fwd<512>; case 10: return (const void*)mk_fwd<1024>; default: return (const void*)mk_fwd<2048>;
    }
#endif
}
extern "C" void kernel_launch(void* const* d_in, const int* in_sizes, int n_in, void* d_out, int out_size, void* d_ws, size_t ws_size, hipStream_t stream) {
    static int grid = 0;
    if (grid == 0) {
        if (n_in != 28 || out_size != MTOK * DM || ws_size < WS_END) { fprintf(stderr, "kernel_launch: unexpected shapes: n_in %d out %d ws %zu (need >= %zu)\n", n_in, out_size, ws_size, (size_t)WS_END); grid = -1; return; }
        int dev = 0, cus = 0, per_cu = 0;
        if (hipGetDevice(&dev) != hipSuccess || hipDeviceGetAttribute(&cus, hipDeviceAttributeMultiprocessorCount, dev) != hipSuccess) { fprintf(stderr, "kernel_launch: device query failed\n"); grid = -1; return; }
        for (int i = 0; i < MK_N_LAUNCHES; ++i) if (hipFuncSetAttribute(kfn(i), hipFuncAttributeMaxDynamicSharedMemorySize, LDS_BYTES) != hipSuccess) { fprintf(stderr, "kernel_launch: hipFuncSetAttribute failed\n"); grid = -1; return; }
        if (hipOccupancyMaxActiveBlocksPerMultiprocessor(&per_cu, kfn(0), 512, LDS_BYTES) != hipSuccess || per_cu < 1) { fprintf(stderr, "kernel_launch: occupancy query says %d blocks/CU\n", per_cu); }
        (void)hipGetLastError();
        grid = cus;
    }
    if (grid < 0) return;
    if (hipMemsetAsync((char*)d_ws + WS_CTL, 0, CTL_ZERO_BYTES, stream) != hipSuccess) { fprintf(stderr, "kernel_launch: memset failed\n"); return; }
    Args a{};
    for (int i = 0; i < 28; ++i) a.in[i] = d_in[i];
    a.out = (float*)d_out; a.ws = (unsigned char*)d_ws;
    const int nl = MK_N_LAUNCHES;
    for (int li = 0; li < nl; ++li) {
        a.ph_lo = (nl == 1) ? 0 : li; a.ph_hi = (nl == 1) ? N_PHASES : li + 1; a.li = li;
        void* kargs[] = {&a};
        (void)hipLaunchKernel(kfn(li), dim3(grid), dim3(512), kargs, LDS_BYTES, stream);
        const hipError_t le = hipPeekAtLastError();
        if (le != hipSuccess) { fprintf(stderr, "kernel_launch: launch %d failed: %s\n", li, hipGetErrorName(le)); break; }
    }
}
```
